# Optimizing an MI355X kernel written in HIP

```python
import jax, jax.numpy as jnp
from jax import lax
import numpy as np

D_MODEL = 1024
BATCH = 2
SEQ = 8192
DEPTH = 2

GRID_W = 64
CTX_LEN = 256

MIX_HALF = D_MODEL // 2
RET_HEADS = 4
RET_DV = MIX_HALF // RET_HEADS
RET_DK = RET_DV // 2
RET_DECAY_BASE = 5
GLA_HEADS = 4
GLA_DV = MIX_HALF // GLA_HEADS
GLA_DK = GLA_DV // 2
GLA_GATE_RANK = 16
GLA_GATE_TAU = 16.0
SCAN_CHUNK = 64
RET_QK = RET_HEADS * RET_DK
RET_V = RET_HEADS * RET_DV
GLA_QK = GLA_HEADS * GLA_DK
GLA_V = GLA_HEADS * GLA_DV
EVEN_SPLITS = (RET_QK, RET_QK, RET_V, RET_V, GLA_QK, GLA_QK, GLA_V, GLA_V, 2 * GLA_GATE_RANK)
EVEN_PROJ = 2 * RET_QK + 2 * RET_V + 2 * GLA_QK + 2 * GLA_V + 2 * GLA_GATE_RANK

ATT_HEAD_DIM = 64
ATT_Q_HEADS = D_MODEL // ATT_HEAD_DIM
ATT_GROUP = 4
ATT_KV_HEADS = ATT_Q_HEADS // ATT_GROUP
WINDOW = 128
ATT_BLOCK = 128
ATT_QW = ATT_Q_HEADS * ATT_HEAD_DIM
ATT_KVW = ATT_KV_HEADS * ATT_HEAD_DIM
ATT_PROJ = ATT_QW + 2 * ATT_KVW
ROPE_BASE = 10000.0

D_FF = 4 * D_MODEL
DEEPNORM_ALPHA = (2.0 * DEPTH) ** 0.25
DEEPNORM_BETA = (8.0 * DEPTH) ** -0.25
LN_EPS = 1e-5
RMS_EPS = 1e-6
N_EVEN = (DEPTH + 1) // 2
N_ODD = DEPTH // 2

kernel_name = 'hybrid_retention_gla_swa_dit'


def layer_norm(x, g, b):
    xf = x.astype(jnp.float32)
    mu = jnp.mean(xf, axis=-1, keepdims=True)
    var = jnp.mean(jnp.square(xf - mu), axis=-1, keepdims=True)
    return ((xf - mu) * lax.rsqrt(var + LN_EPS) * g + b).astype(x.dtype)


def rms_norm(x, g=None):
    xf = x.astype(jnp.float32)
    y = xf * lax.rsqrt(jnp.mean(jnp.square(xf), axis=-1, keepdims=True) + RMS_EPS)
    if g is not None:
        y = y * g
    return y.astype(x.dtype)


def modulation(cvec, w, b):
    m = jax.nn.silu(cvec) @ w + b
    return jnp.split(m[..., None, :], 6, axis=-1)


def sublayer_residual(x, y, gate, g, b):
    return layer_norm(DEEPNORM_ALPHA * x + gate * y, g, b)


def split_cols(t, sizes):
    idx = np.cumsum(sizes)[:-1].tolist()
    return jnp.split(t, idx, axis=-1)


def split_heads(t, h):
    b, n, _ = t.shape
    return t.reshape(b, n, h, -1).transpose(0, 2, 1, 3)


def merge_heads(t):
    b, h, n, d = t.shape
    return t.transpose(0, 2, 1, 3).reshape(b, n, h * d)


def sq_relu_mlp(h, w1, w2):
    return jnp.square(jax.nn.relu(h @ w1)) @ w2


def chunk_gated_scan(q, k, v, log_a, s0, strict):
    f32 = jnp.float32
    B, H, T, dk = q.shape
    dv = v.shape[-1]
    n = T // SCAN_CHUNK
    qc = q.astype(f32).reshape(B, H, n, SCAN_CHUNK, dk)
    kc = k.astype(f32).reshape(B, H, n, SCAN_CHUNK, dk)
    vc = v.astype(f32).reshape(B, H, n, SCAN_CHUNK, dv)
    bcum = jnp.cumsum(log_a.astype(f32).reshape(B, H, n, SCAN_CHUNK, dk), axis=3)
    b_last = bcum[:, :, :, -1:, :]
    q_dec = qc * jnp.exp(bcum)
    k_inv = kc * jnp.exp(-bcum)
    k_end = kc * jnp.exp(b_last - bcum)
    mask = jnp.tril(jnp.ones((SCAN_CHUNK, SCAN_CHUNK), bool), k=-1 if strict else 0)
    scores = jnp.einsum('bhncd,bhnsd->bhncs', q_dec, k_inv)
    o_intra = jnp.einsum('bhncs,bhnse->bhnce', jnp.where(mask, scores, 0.0), vc)
    kv = jnp.einsum('bhnsd,bhnse->bhnde', k_end, vc)
    chunk_decay = jnp.exp(b_last[:, :, :, 0, :])

    def step(s, inp):
        kv_n, dec_n = inp
        return dec_n[..., None] * s + kv_n, s

    s_final, s_prev = lax.scan(step, s0.astype(f32),
                               (jnp.moveaxis(kv, 2, 0), jnp.moveaxis(chunk_decay, 2, 0)))
    s_prev = jnp.moveaxis(s_prev, 0, 2)
    o_inter = jnp.einsum('bhncd,bhnde->bhnce', q_dec, s_prev)
    o = (o_intra + o_inter).reshape(B, H, T, dv)
    return o.astype(v.dtype), s_final


def bidir_scan(q, k, v, log_a_f, log_a_b, s0_f, s0_b):
    flip = lambda t: jnp.flip(t, axis=2)
    o_f, s_f = chunk_gated_scan(q, k, v, log_a_f, s0_f, strict=False)
    o_b, s_b = chunk_gated_scan(flip(q), flip(k), flip(v), flip(log_a_b), s0_b, strict=True)
    return o_f + flip(o_b), s_f, s_b


def retention_gla_mixer(h, w_in, ret_theta, gla_gk_w, gla_gk_b, gla_norm_g, s0):
    f32 = jnp.float32
    qa, ka, va, ga, qb, kb, vb, gb, lr = split_cols(h @ w_in, EVEN_SPLITS)
    qa = split_heads(qa, RET_HEADS)
    ka = split_heads(ka, RET_HEADS) * RET_DK ** -0.5
    va = split_heads(va, RET_HEADS)
    log_gamma = jnp.log1p(-jnp.exp(ret_theta.astype(f32)))
    la_f = jnp.broadcast_to(log_gamma[0][None, :, None, None], qa.shape)
    la_b = jnp.broadcast_to(log_gamma[1][None, :, None, None], qa.shape)
    o_a, ra_f, ra_b = bidir_scan(qa, ka, va, la_f, la_b, s0[0], s0[1])
    y_a = jax.nn.silu(ga) * merge_heads(rms_norm(o_a))
    qb = split_heads(qb, GLA_HEADS) * GLA_DK ** -0.5
    kb = split_heads(kb, GLA_HEADS)
    vb = split_heads(vb, GLA_HEADS)
    lr_f, lr_b = jnp.split(lr, 2, axis=-1)

    def gate(u, w, b):
        z = (u @ w + b).astype(f32)
        return split_heads(jax.nn.log_sigmoid(z) / GLA_GATE_TAU, GLA_HEADS)

    o_b, sb_f, sb_b = bidir_scan(qb, kb, vb, gate(lr_f, gla_gk_w[0], gla_gk_b[0]),
                                 gate(lr_b, gla_gk_w[1], gla_gk_b[1]), s0[2], s0[3])
    y_b = jax.nn.silu(gb) * merge_heads(rms_norm(o_b, gla_norm_g))
    return jnp.concatenate([y_a, y_b], axis=-1), (ra_f, ra_b, sb_f, sb_b)


def axial_rope(t, row, col):
    f32 = jnp.float32
    half = ATT_HEAD_DIM // 2
    inv_freq = ROPE_BASE ** (-jnp.arange(0, half, 2, dtype=f32) / half)

    def rot(u, p):
        ang = p.astype(f32)[:, None] * inv_freq[None, :]
        cos, sin = jnp.cos(ang), jnp.sin(ang)
        u1, u2 = u[..., :half // 2], u[..., half // 2:]
        return jnp.concatenate([u1 * cos - u2 * sin, u1 * sin + u2 * cos], axis=-1)

    return jnp.concatenate([rot(t[..., :half], row), rot(t[..., half:], col)], axis=-1).astype(t.dtype)


def window_attention(q, k, v, k_c, v_c, sink):
    f32 = jnp.float32
    B, Hq, T, dh = q.shape
    nb = T // ATT_BLOCK
    scale = dh ** -0.5
    qb = q.reshape(B, ATT_KV_HEADS, ATT_GROUP, nb, ATT_BLOCK, dh)
    pad = ((0, 0), (0, 0), (ATT_BLOCK, ATT_BLOCK), (0, 0))
    kp = jnp.pad(k, pad).reshape(B, ATT_KV_HEADS, nb + 2, ATT_BLOCK, dh)
    vp = jnp.pad(v, pad).reshape(B, ATT_KV_HEADS, nb + 2, ATT_BLOCK, dh)
    kb = jnp.concatenate([kp[:, :, 0:nb], kp[:, :, 1:nb + 1], kp[:, :, 2:nb + 2]], axis=3)
    vb = jnp.concatenate([vp[:, :, 0:nb], vp[:, :, 1:nb + 1], vp[:, :, 2:nb + 2]], axis=3)
    qi = jnp.arange(ATT_BLOCK)[:, None]
    kj = jnp.arange(3 * ATT_BLOCK)[None, :]
    in_window = jnp.abs(kj - ATT_BLOCK - qi) <= WINDOW
    kpos = (jnp.arange(nb)[:, None] - 1) * ATT_BLOCK + jnp.arange(3 * ATT_BLOCK)[None, :]
    in_range = (kpos >= 0) & (kpos < T)
    valid = in_window[None] & in_range[:, None, :]
    s_loc = jnp.einsum('bkgnqd,bkncd->bkgnqc', qb, kb).astype(f32) * scale
    s_loc = jnp.where(valid, s_loc, -jnp.inf)
    s_ctx = jnp.einsum('bkgnqd,bkld->bkgnql', qb, k_c).astype(f32) * scale
    s_sink = sink.astype(f32).reshape(1, ATT_KV_HEADS, ATT_GROUP, 1, 1, 1)
    m = jnp.maximum(jnp.maximum(jnp.max(s_loc, -1, keepdims=True), jnp.max(s_ctx, -1, keepdims=True)), s_sink)
    e_loc = jnp.exp(s_loc - m)
    e_ctx = jnp.exp(s_ctx - m)
    denom = jnp.sum(e_loc, -1, keepdims=True) + jnp.sum(e_ctx, -1, keepdims=True) + jnp.exp(s_sink - m)
    o = (jnp.einsum('bkgnqc,bkncd->bkgnqd', e_loc, vb.astype(f32))
         + jnp.einsum('bkgnql,bkld->bkgnqd', e_ctx, v_c.astype(f32))) / denom
    return o.reshape(B, Hq, T, dh).astype(q.dtype)


def context_attention(q_c, k_c, v_c, sink):
    f32 = jnp.float32
    B, Hq, L, dh = q_c.shape
    qg = q_c.reshape(B, ATT_KV_HEADS, ATT_GROUP, L, dh)
    s = jnp.einsum('bkgqd,bkld->bkgql', qg, k_c).astype(f32) * dh ** -0.5
    s_sink = jnp.broadcast_to(sink.astype(f32).reshape(1, ATT_KV_HEADS, ATT_GROUP, 1, 1), s.shape[:-1] + (1,))
    p = jax.nn.softmax(jnp.concatenate([s, s_sink], axis=-1), axis=-1)[..., :L]
    return jnp.einsum('bkgql,bkld->bkgqd', p, v_c.astype(f32)).reshape(B, Hq, L, dh).astype(q_c.dtype)


def setup_inputs(seed: int = 0) -> dict:
    key = jax.random.key(seed)
    ks = jax.random.split(key, 19)
    f32 = jnp.float32
    D = D_MODEL

    def nrm(k, shape, fan_in, scale=1.0):
        return jax.random.normal(k, shape, f32) * (scale * fan_in ** -0.5)

    ret_init = -(RET_DECAY_BASE + jnp.arange(RET_HEADS, dtype=f32)) * jnp.log(2.0)
    return {
        'x': jax.random.normal(ks[0], (BATCH, SEQ, D), f32),
        'c': jax.random.normal(ks[1], (BATCH, D), f32),
        'ctx': jax.random.normal(ks[2], (BATCH, CTX_LEN, D), f32),
        'c_ctx': jax.random.normal(ks[3], (D,), f32),
        'w_mod': nrm(ks[4], (DEPTH, D, 6 * D), D),
        'b_mod': 0.02 * jax.random.normal(ks[5], (DEPTH, 6 * D), f32),
        'ln_g': 1.0 + 0.02 * jax.random.normal(ks[6], (DEPTH, 2, D), f32),
        'ln_b': 0.02 * jax.random.normal(ks[7], (DEPTH, 2, D), f32),
        'mlp_w1': nrm(ks[8], (DEPTH, D, D_FF), D),
        'mlp_w2': nrm(ks[9], (DEPTH, D_FF, D), D_FF, DEEPNORM_BETA),
        'ev_w_in': nrm(ks[10], (N_EVEN, D, EVEN_PROJ), D),
        'ev_ret_theta': ret_init + 0.05 * jax.random.normal(ks[11], (N_EVEN, 2, RET_HEADS), f32),
        'ev_gla_gk_w': nrm(ks[12], (N_EVEN, 2, GLA_GATE_RANK, GLA_QK), GLA_GATE_RANK),
        'ev_gla_gk_b': 0.02 * jax.random.normal(ks[13], (N_EVEN, 2, GLA_QK), f32),
        'ev_gla_norm_g': 1.0 + 0.02 * jax.random.normal(ks[14], (N_EVEN, GLA_DV), f32),
        'ev_w_out': nrm(ks[15], (N_EVEN, D, D), D, DEEPNORM_BETA),
        'od_w_qkv': nrm(ks[16], (N_ODD, D, ATT_PROJ), D),
        'od_sink': 0.5 * jax.random.normal(ks[17], (N_ODD, ATT_Q_HEADS), f32),
        'od_w_out': nrm(ks[18], (N_ODD, D, D), D, DEEPNORM_BETA),
    }


def reference(x, c, ctx, c_ctx, w_mod, b_mod, ln_g, ln_b, mlp_w1, mlp_w2,
              ev_w_in, ev_ret_theta, ev_gla_gk_w, ev_gla_gk_b, ev_gla_norm_g, ev_w_out,
              od_w_qkv, od_sink, od_w_out):
    B, T, _ = x.shape
    rows = T // GRID_W
    row = jnp.repeat(jnp.arange(rows), GRID_W)
    col = jnp.tile(jnp.arange(GRID_W), rows)
    xc = ctx
    for i in range(DEPTH):
        last = i == DEPTH - 1
        j = i // 2
        sh1, sc1, g1, sh2, sc2, g2 = modulation(c, w_mod[i], b_mod[i])
        csh1, csc1, cg1, csh2, csc2, cg2 = modulation(c_ctx, w_mod[i], b_mod[i])
        h = x * (1.0 + sc1) + sh1
        hc = xc * (1.0 + csc1) + csh1
        if i % 2 == 0:
            prm = (ev_w_in[j], ev_ret_theta[j], ev_gla_gk_w[j], ev_gla_gk_b[j], ev_gla_norm_g[j])
            s0 = (jnp.zeros((B, RET_HEADS, RET_DK, RET_DV), jnp.float32),
                  jnp.zeros((B, RET_HEADS, RET_DK, RET_DV), jnp.float32),
                  jnp.zeros((B, GLA_HEADS, GLA_DK, GLA_DV), jnp.float32),
                  jnp.zeros((B, GLA_HEADS, GLA_DK, GLA_DV), jnp.float32))
            yc, ctx_states = retention_gla_mixer(hc, *prm, s0)
            y, _ = retention_gla_mixer(h, *prm, ctx_states)
            y = y @ ev_w_out[j]
            if not last:
                yc = yc @ ev_w_out[j]
        else:
            w = od_w_qkv[j]
            q, k, v = split_cols(h @ w, (ATT_QW, ATT_KVW, ATT_KVW))
            q = axial_rope(split_heads(q, ATT_Q_HEADS), row, col)
            k = axial_rope(split_heads(k, ATT_KV_HEADS), row, col)
            v = split_heads(v, ATT_KV_HEADS)
            k_c, v_c = split_cols(hc @ w[:, ATT_QW:], (ATT_KVW, ATT_KVW))
            k_c = split_heads(k_c, ATT_KV_HEADS)
            v_c = split_heads(v_c, ATT_KV_HEADS)
            y = merge_heads(window_attention(q, k, v, k_c, v_c, od_sink[j])) @ od_w_out[j]
            if not last:
                q_c = split_heads(hc @ w[:, :ATT_QW], ATT_Q_HEADS)
                yc = merge_heads(context_attention(q_c, k_c, v_c, od_sink[j])) @ od_w_out[j]
        x = sublayer_residual(x, y, g1, ln_g[i, 0], ln_b[i, 0])
        x = sublayer_residual(x, sq_relu_mlp(x * (1.0 + sc2) + sh2, mlp_w1[i], mlp_w2[i]), g2, ln_g[i, 1], ln_b[i, 1])
        if not last:
            xc = sublayer_residual(xc, yc, cg1, ln_g[i, 0], ln_b[i, 0])
            xc = sublayer_residual(xc, sq_relu_mlp(xc * (1.0 + csc2) + csh2, mlp_w1[i], mlp_w2[i]), cg2, ln_g[i, 1], ln_b[i, 1])
    return x
```

```cpp
#include <hip/hip_runtime.h>
#include <hip/hip_cooperative_groups.h>
#include <cstdio>
#include <cstdint>
namespace cg = cooperative_groups;
namespace pg8 {
#define PG8_LAS __attribute__((address_space(3)))
typedef unsigned short bf16_t;
typedef short bf16x8 __attribute__((ext_vector_type(8)));
typedef float f32x4 __attribute__((ext_vector_type(4)));
typedef unsigned u32x4 __attribute__((ext_vector_type(4)));
constexpr int BM = 256, BK = 64, HALF = 128, HTB = HALF * BK * 2  , STAGE_BYTES = 8 * HTB, NXCD = 8, WGM = 8;

__host__ __device__ __forceinline__ int lds_byte(int r, int c) { const int st = (r >> 4) * 2 + (c >> 5), rr = r & 15, cc = c & 31, ob = rr * 64 + cc * 2; return st * 1024 + (ob ^ (((ob >> 9) & 1) << 5)); }
__host__ __device__ __forceinline__ void stage_rc(int b, int& R, int& C) { const int st = b / 1024, sb = b % 1024, swz = sb ^ (((sb >> 9) & 1) << 5); R = (st >> 1) * 16 + swz / 64; C = (st & 1) * 32 + (swz % 64) / 2; }
__host__ __device__ __forceinline__ int perm32(int rho) { const int n = rho >> 4, i = rho & 15; return 8 * (i >> 2) + 4 * n + (i & 3); }

struct Unit { int pm, pn; };
struct Gemm { const bf16_t* A; const bf16_t* Bt; int M, N, K; };

struct StaticOrder {
    int nM, nN, nwg, G, c;
    __host__ __device__ void init(int M, int N, int G_, int c_) { nM = M / BM; nN = N / BM; nwg = nM * nN; G = G_; c = c_; }
    __host__ __device__ bool next(int i, Unit& u) const {
        const long L = (long)i * G + c; if (L >= nwg) return false;
        int wgid = (int)L; { const int q = nwg / NXCD, r = nwg % NXCD, xcd = wgid % NXCD, off = wgid / NXCD; wgid = (xcd < r ? xcd * (q + 1) : r * (q + 1) + (xcd - r) * q) + off; }
        const int nig = WGM * nN, gid = wgid / nig, fm = gid * WGM, gsz = (nM - fm) < WGM ? (nM - fm) : WGM;
        u.pm = fm + ((wgid % nig) % gsz); u.pn = (wgid % nig) / gsz; return true;
    }
    __device__ __forceinline__ void a_ready(const Unit&) const {}
    __device__ __forceinline__ void done(const Unit&) const {}
};

__device__ __forceinline__ unsigned cvt_pk_bf16(float lo, float hi) { unsigned r; asm volatile("v_cvt_pk_bf16_f32 %0, %1, %2" : "=v"(r) : "v"(lo), "v"(hi)); return r; }

template <class Epi, class Sched, bool ALIGN_EPI = false, bool SP2 = false>
__device__ __forceinline__ void gemm_phase(PG8_LAS unsigned char* lds, const Gemm g, const Sched& S, const Epi& E) {
    const int tid = threadIdx.x, wid = __builtin_amdgcn_readfirstlane(tid >> 6), lane = tid & 63, wr = wid >> 2, wc = wid & 3, fr = lane & 15, fq = lane >> 4;
    const int K = g.K, nt = K / BK;
    unsigned voffA[2], voffB[2];
#pragma unroll
    for (int i = 0; i < 2; ++i) { int R, C; stage_rc(tid * 16 + i * 8192, R, C); const int Rb = Epi::PERM ? ((R & ~31) + perm32(R & 31)) : R;
        voffA[i] = (unsigned)(R * K + C) * 2u; voffB[i] = (unsigned)(Rb * K + C) * 2u; }
    const size_t kstep = (size_t)(BK * 2);
    const size_t hstep = (size_t)HALF * K * 2;
    const size_t tstep = 2 * hstep;
    const unsigned ldsw = (unsigned)wid * 1024u;
    const int aoff = lds_byte(wr * 64 + fr, fq * 8), boff = lds_byte(wc * 32 + fr, fq * 8);
#define PG8_SA(b, h) (((b) * 2 + (h)) * HTB)
#define PG8_SB(b, h) ((4 + (b) * 2 + (h)) * HTB)
#define PG8_STAGE(bufoff, gbase, voff) do { _Pragma("unroll") for (int _i = 0; _i < 2; ++_i) \
        __builtin_amdgcn_global_load_lds((const unsigned*)((const char*)(gbase) + (voff)[_i]), (PG8_LAS unsigned*)(lds + (bufoff) + ldsw + _i * 8192), 16, 0, 0); } while (0)
#define PG8_LDA(dst, b, h) do { _Pragma("unroll") for (int m = 0; m < 4; ++m) _Pragma("unroll") for (int k = 0; k < 2; ++k) dst[m][k] = *(const PG8_LAS bf16x8*)(lds + PG8_SA(b, h) + aoff + m * 2048 + k * 1024); } while (0)
#define PG8_LDB(dst, b, h) do { _Pragma("unroll") for (int n = 0; n < 2; ++n) _Pragma("unroll") for (int k = 0; k < 2; ++k) dst[n][k] = *(const PG8_LAS bf16x8*)(lds + PG8_SB(b, h) + boff + n * 2048 + k * 1024); } while (0)
#define PG8_MMA(ai, bj, At, Bt) do { __builtin_amdgcn_s_setprio(1); _Pragma("unroll") for (int m = 0; m < 4; ++m) _Pragma("unroll") for (int n = 0; n < 2; ++n) _Pragma("unroll") for (int k = 0; k < 2; ++k) \
        acc[ai][bj][m][n] = __builtin_amdgcn_mfma_f32_16x16x32_bf16(Bt[n][k], At[m][k], acc[ai][bj][m][n], 0, 0, 0); __builtin_amdgcn_s_setprio(0); } while (0)
#define PG8_WAIT_V(n) asm volatile("s_waitcnt vmcnt(" #n ")" ::: "memory")
#define PG8_WAIT_L(n) asm volatile("s_waitcnt lgkmcnt(" #n ")" ::: "memory")
#define PG8_BAR __builtin_amdgcn_s_barrier()
#define PG8_SCHED __builtin_amdgcn_sched_barrier(0)
    Unit cur, nxt; int ui = 0;
    if (!S.next(0, cur)) return;
    f32x4 acc[2][2][4][2];
#pragma unroll
    for (int a = 0; a < 2; ++a)
#pragma unroll
        for (int b = 0; b < 2; ++b)
#pragma unroll
            for (int m = 0; m < 4; ++m)
#pragma unroll
                for (int n = 0; n < 2; ++n) acc[a][b][m][n] = (f32x4){0.f, 0.f, 0.f, 0.f};
    bf16x8 At[4][2], B0[2][2], B1[2][2];
    const char* cA = (const char*)g.A + (size_t)cur.pm * tstep; const char* cB = (const char*)g.Bt + (size_t)cur.pn * tstep;
    S.a_ready(cur);
    if constexpr (SP2) {
        PG8_STAGE(PG8_SB(0, 0), cB, voffB); PG8_STAGE(PG8_SB(0, 1), cB + hstep, voffB); PG8_STAGE(PG8_SA(0, 0), cA, voffA); PG8_STAGE(PG8_SA(0, 1), cA + hstep, voffA);
        if (wr == 1) PG8_BAR;
        PG8_WAIT_V(2); PG8_BAR;
        PG8_STAGE(PG8_SB(1, 0), cB + kstep, voffB); PG8_STAGE(PG8_SA(1, 0), cA + kstep, voffA); PG8_STAGE(PG8_SB(1, 1), cB + hstep + kstep, voffB);
        PG8_WAIT_V(6); PG8_BAR;
    } else {
        PG8_STAGE(PG8_SB(0, 0), cB, voffB); PG8_STAGE(PG8_SA(0, 0), cA, voffA); PG8_STAGE(PG8_SB(0, 1), cB + hstep, voffB); PG8_STAGE(PG8_SA(0, 1), cA + hstep, voffA);
        if (wr == 1) PG8_BAR;
        PG8_WAIT_V(4); PG8_BAR;
        PG8_STAGE(PG8_SB(1, 0), cB + kstep, voffB); PG8_STAGE(PG8_SA(1, 0), cA + kstep, voffA); PG8_STAGE(PG8_SB(1, 1), cB + hstep + kstep, voffB);
        PG8_WAIT_V(6); PG8_BAR;
    }
    for (;;) {
        const bool has_next = S.next(ui + 1, nxt);
        const char* nA = has_next ? (const char*)g.A + (size_t)nxt.pm * tstep : cA; const char* nB = has_next ? (const char*)g.Bt + (size_t)nxt.pn * tstep : cB;
        for (int t = 0; t < nt; t += 2) {
            const bool last = (t == nt - 2);
            const char* a1 = cA + (size_t)(t + 1) * kstep;
            const char* a2 = last ? nA : cA + (size_t)(t + 2) * kstep; const char* b2 = last ? nB : cB + (size_t)(t + 2) * kstep;
            const char* a3 = a2 + kstep; const char* b3 = b2 + kstep;
            if (last && has_next) S.a_ready(nxt);
            if constexpr (SP2) {
            PG8_LDB(B0, 0, 0); PG8_LDB(B1, 0, 1); PG8_SCHED; PG8_LDA(At, 0, 0); PG8_STAGE(PG8_SA(1, 1), a1 + hstep, voffA);
            PG8_WAIT_V(8); PG8_WAIT_L(0); PG8_BAR; PG8_MMA(0, 0, At, B0); PG8_MMA(0, 1, At, B1); PG8_BAR; PG8_SCHED;
            PG8_LDA(At, 0, 1); PG8_STAGE(PG8_SB(0, 0), b2, voffB); PG8_STAGE(PG8_SB(0, 1), b2 + hstep, voffB); PG8_STAGE(PG8_SA(0, 0), a2, voffA);
            PG8_WAIT_V(8); PG8_WAIT_L(0); PG8_BAR; PG8_MMA(1, 0, At, B0); PG8_MMA(1, 1, At, B1); PG8_BAR; PG8_SCHED;
            PG8_LDB(B0, 1, 0); PG8_LDB(B1, 1, 1); PG8_SCHED; PG8_LDA(At, 1, 0); PG8_STAGE(PG8_SA(0, 1), a2 + hstep, voffA);
            PG8_WAIT_V(8); PG8_WAIT_L(0); PG8_BAR; PG8_MMA(0, 0, At, B0); PG8_MMA(0, 1, At, B1); PG8_BAR; PG8_SCHED;
            PG8_LDA(At, 1, 1); PG8_STAGE(PG8_SB(1, 0), b3, voffB); PG8_STAGE(PG8_SB(1, 1), b3 + hstep, voffB); PG8_STAGE(PG8_SA(1, 0), a3, voffA);
            PG8_WAIT_V(8); PG8_WAIT_L(0); PG8_BAR; PG8_MMA(1, 0, At, B0); PG8_MMA(1, 1, At, B1); PG8_BAR; PG8_SCHED;
            } else {
            PG8_LDB(B0, 0, 0); PG8_SCHED; PG8_LDA(At, 0, 0); PG8_STAGE(PG8_SA(1, 1), a1 + hstep, voffA);
            PG8_WAIT_L(8); PG8_BAR; PG8_WAIT_L(0); PG8_MMA(0, 0, At, B0); PG8_BAR; PG8_SCHED;
            PG8_LDB(B1, 0, 1); PG8_STAGE(PG8_SB(0, 0), b2, voffB);
            PG8_BAR; PG8_WAIT_L(0); PG8_MMA(0, 1, At, B1); PG8_BAR;
            PG8_LDA(At, 0, 1); PG8_STAGE(PG8_SA(0, 0), a2, voffA);
            PG8_BAR; PG8_WAIT_L(0); PG8_MMA(1, 0, At, B0); PG8_BAR; PG8_SCHED;
            PG8_STAGE(PG8_SB(0, 1), b2 + hstep, voffB);
            PG8_WAIT_V(6); PG8_BAR; PG8_MMA(1, 1, At, B1); PG8_BAR;
            PG8_LDB(B0, 1, 0); PG8_SCHED; PG8_LDA(At, 1, 0); PG8_STAGE(PG8_SA(0, 1), a2 + hstep, voffA);
            PG8_WAIT_L(8); PG8_BAR; PG8_WAIT_L(0); PG8_MMA(0, 0, At, B0); PG8_BAR; PG8_SCHED;
            PG8_LDB(B1, 1, 1); PG8_STAGE(PG8_SB(1, 0), b3, voffB);
            PG8_BAR; PG8_WAIT_L(0); PG8_MMA(0, 1, At, B1); PG8_BAR;
            PG8_LDA(At, 1, 1); PG8_STAGE(PG8_SA(1, 0), a3, voffA);
            PG8_BAR; PG8_WAIT_L(0); PG8_MMA(1, 0, At, B0); PG8_BAR; PG8_SCHED;
            PG8_STAGE(PG8_SB(1, 1), b3 + hstep, voffB);
            PG8_WAIT_V(6); PG8_BAR; PG8_MMA(1, 1, At, B1); PG8_BAR;
            }
        }
        if constexpr (ALIGN_EPI) { if (wr == 0) PG8_BAR; }
        if constexpr (!Epi::AFTER_DRAIN) { E(acc, cur, wr, wc, fr, fq); S.done(cur); }
        if (!has_next) break;
#pragma unroll
        for (int a = 0; a < 2; ++a)
#pragma unroll
            for (int b = 0; b < 2; ++b)
#pragma unroll
                for (int m = 0; m < 4; ++m)
#pragma unroll
                    for (int n = 0; n < 2; ++n) acc[a][b][m][n] = (f32x4){0.f, 0.f, 0.f, 0.f};
        cur = nxt; cA = nA; cB = nB; ++ui;
        if constexpr (ALIGN_EPI) { if (wr == 1) PG8_BAR; }
    }
    PG8_WAIT_V(0);
    if constexpr (!ALIGN_EPI) { if (wr == 0) PG8_BAR; }
    PG8_BAR;
    if constexpr (Epi::AFTER_DRAIN) { E.fused(acc, cur, wr, wc, fr, fq, lds, wid, lane); S.done(cur); }
#undef PG8_SA
#undef PG8_SB
#undef PG8_STAGE
#undef PG8_LDA
#undef PG8_LDB
#undef PG8_MMA
#undef PG8_WAIT_V
#undef PG8_WAIT_L
#undef PG8_BAR
#undef PG8_SCHED
}
}

constexpr int NB = 2, T = 8192, L = 256, D = 1024, TP = T + L, R = NB * TP;
constexpr int FF = 4096, NPROJ = 3104, NPROJ_PAD = 3328, NQKV = 1536, NCH = TP / 64;
constexpr float ALPHA = 1.4142135623730951f;
constexpr int LDS_BYTES = 147456;

typedef unsigned short bf16;
typedef float f32x4 __attribute__((ext_vector_type(4)));
typedef short bf16x8 __attribute__((ext_vector_type(8)));
typedef short s16x4 __attribute__((ext_vector_type(4)));
typedef unsigned u32x4 __attribute__((ext_vector_type(4)));
typedef unsigned u32x2 __attribute__((ext_vector_type(2)));

constexpr size_t OFF_WIN = 0;
constexpr size_t OFF_WOUT0 = OFF_WIN + (size_t)NPROJ_PAD * D * 2;
constexpr size_t OFF_W1_0 = OFF_WOUT0 + (size_t)D * D * 2;
constexpr size_t OFF_W2_0 = OFF_W1_0 + (size_t)FF * D * 2;
constexpr size_t OFF_WQKV = OFF_W2_0 + (size_t)FF * D * 2;
constexpr size_t OFF_WOUT1 = OFF_WQKV + (size_t)NQKV * D * 2;
constexpr size_t OFF_W1_1 = OFF_WOUT1 + (size_t)D * D * 2;
constexpr size_t OFF_W2_1 = OFF_W1_1 + (size_t)FF * D * 2;
constexpr size_t OFF_MOD = OFF_W2_1 + (size_t)FF * D * 2;
constexpr size_t OFF_ROPE = OFF_MOD + 2 * 3 * 6144 * 4;
constexpr size_t OFF_XCTX = OFF_ROPE + 128 * 16 * 8;
constexpr size_t OFF_DEC = OFF_XCTX + (size_t)NB * L * D * 4;
constexpr size_t OFF_H = OFF_DEC + (size_t)32 * NCH * 64 * 4;
constexpr size_t OFF_P = OFF_H + (size_t)R * D * 2;
constexpr size_t OFF_ST = OFF_P + (size_t)R * NPROJ * 2;
constexpr size_t WS_TOTAL = OFF_ST + (size_t)32 * NCH * 8192 * 2;
static_assert(WS_TOTAL <= 268435456, "workspace map exceeds 256 MiB");
static_assert(OFF_P + (size_t)R * FF * 2 <= WS_TOTAL, "MLP hidden overlay");

__device__ __forceinline__ unsigned f2bf(float f) { unsigned u = __float_as_uint(f); return (u + 0x7fffu + ((u >> 16) & 1u)) >> 16; }
__device__ __forceinline__ float bf2f(unsigned h) { return __uint_as_float(h << 16); }
__device__ __forceinline__ unsigned pk2(float lo, float hi) { return f2bf(lo) | (f2bf(hi) << 16); }
__device__ __forceinline__ float bflo(unsigned u) { return __uint_as_float(u << 16); }
__device__ __forceinline__ float bfhi(unsigned u) { return __uint_as_float(u & 0xffff0000u); }
__device__ __forceinline__ float wave_sum(float v) {
#pragma unroll
    for (int o = 1; o < 64; o <<= 1) v += __shfl_xor(v, o);
    return v;
}
#define MFMA16(a, b, c) __builtin_amdgcn_mfma_f32_16x16x32_bf16((a), (b), (c), 0, 0, 0)

__device__ __forceinline__ size_t row_off(int r, bool& isc, int& b) { b = (r >= TP) ? 1 : 0; const int p = r - b * TP; isc = p < L; return isc ? (size_t)(b * L + p) * D : (size_t)(b * T + p - L) * D; }

template <int ACT> struct EpiStore {
    static constexpr bool PERM = true, AFTER_DRAIN = false;
    bf16* O; int ldc; int ncols;
    __device__ __forceinline__ void operator()(const pg8::f32x4 (&acc)[2][2][4][2], const pg8::Unit& u, int wr, int wc, int fr, int fq) const {
        const int row0 = u.pm * 256 + wr * 64 + fr, col0 = u.pn * 256 + wc * 32 + 8 * fq;
#pragma unroll
        for (int ai = 0; ai < 2; ++ai)
#pragma unroll
            for (int m = 0; m < 4; ++m) {
                bf16* rowp = O + (size_t)(row0 + ai * 128 + m * 16) * ldc;
#pragma unroll
                for (int bj = 0; bj < 2; ++bj) {
                    const int col = col0 + bj * 128;
                    pg8::f32x4 v0 = acc[ai][bj][m][0], v1 = acc[ai][bj][m][1];
                    if (ACT == 1) {
#pragma unroll
                        for (int i = 0; i < 4; ++i) { float a = fmaxf(v0[i], 0.f), b = fmaxf(v1[i], 0.f); v0[i] = a * a; v1[i] = b * b; }
                    }
                    u32x4 w; w.x = pg8::cvt_pk_bf16(v0[0], v0[1]); w.y = pg8::cvt_pk_bf16(v0[2], v0[3]); w.z = pg8::cvt_pk_bf16(v1[0], v1[1]); w.w = pg8::cvt_pk_bf16(v1[2], v1[3]);
                    if (col < ncols) *(u32x4*)(rowp + col) = w;
                }
            }
    }
};
struct EpiResid {
    static constexpr bool PERM = true, AFTER_DRAIN = false;
    const float* src_lat; const float* src_ctx; float* dst_lat; float* dst_ctx; const float* gate;
    __device__ __forceinline__ void operator()(const pg8::f32x4 (&acc)[2][2][4][2], const pg8::Unit& u, int wr, int wc, int fr, int fq) const {
        const int row0 = u.pm * 256 + wr * 64 + fr, col0 = u.pn * 256 + wc * 32 + 8 * fq;
#pragma unroll
        for (int ai = 0; ai < 2; ++ai)
#pragma unroll
            for (int m = 0; m < 4; ++m) {
                const int row = row0 + ai * 128 + m * 16;
                bool isc; int b; const size_t off = row_off(row, isc, b);
                const float* s = (isc ? src_ctx : src_lat) + off; float* d = (isc ? dst_ctx : dst_lat) + off; const float* gt = gate + (isc ? 2 : b) * 6144;
#pragma unroll
                for (int bj = 0; bj < 2; ++bj)
#pragma unroll
                    for (int n = 0; n < 2; ++n) {
                        const int col = col0 + bj * 128 + 4 * n;
                        const f32x4 x4 = *(const f32x4*)(s + col), g4 = *(const f32x4*)(gt + col);
                        const pg8::f32x4 a4 = acc[ai][bj][m][n];
                        f32x4 o; o.x = ALPHA * x4.x + g4.x * a4[0]; o.y = ALPHA * x4.y + g4.y * a4[1]; o.z = ALPHA * x4.z + g4.z * a4[2]; o.w = ALPHA * x4.w + g4.w * a4[3];
                        *(f32x4*)(d + col) = o;
                    }
            }
    }
};

__device__ __forceinline__ void transpose_item(const float* __restrict__ W, int K, int N, bf16* WT, float* scr, int item, int lane) {
    const int nblk = N / 32, kb = item / nblk, nb = item % nblk, k0 = 64 * kb, n0 = 32 * nb;
#pragma unroll 8
    for (int i = 0; i < 32; ++i) { const int kk = 2 * i + (lane >> 5); scr[kk * 33 + (lane & 31)] = W[(size_t)(k0 + kk) * N + n0 + (lane & 31)]; }
    asm volatile("s_waitcnt lgkmcnt(0)" ::: "memory");
    const int c = lane & 7;
#pragma unroll
    for (int j = 0; j < 4; ++j) { const int n = (lane >> 3) + 8 * j; const float* s = scr + (8 * c) * 33 + n;
        u32x4 o; o.x = pk2(s[0 * 33], s[1 * 33]); o.y = pk2(s[2 * 33], s[3 * 33]); o.z = pk2(s[4 * 33], s[5 * 33]); o.w = pk2(s[6 * 33], s[7 * 33]);
        *(u32x4*)(WT + (size_t)(n0 + n) * K + k0 + 8 * c) = o; }
    asm volatile("s_waitcnt lgkmcnt(0)" ::: "memory");
}

template <bool LAST>
__device__ __forceinline__ void ln_phase(float* xlat, float* xctx, const float* __restrict__ g, const float* __restrict__ bt, const float* __restrict__ modn, bf16* H, int gw, int NGW, int lane) {
    for (int r = gw; r < R; r += NGW) {
        bool isc; int b; const size_t off = row_off(r, isc, b);
        if (LAST && isc) continue;
        float* xr = (isc ? xctx : xlat) + off;
        f32x4 v[4]; float s = 0.f;
#pragma unroll
        for (int j = 0; j < 4; ++j) { v[j] = *(const f32x4*)(xr + lane * 4 + 256 * j); s += (v[j].x + v[j].y) + (v[j].z + v[j].w); }
        const float mean = wave_sum(s) * (1.f / D); float s2 = 0.f;
#pragma unroll
        for (int j = 0; j < 4; ++j) { v[j] = v[j] - mean; s2 += (v[j].x * v[j].x + v[j].y * v[j].y) + (v[j].z * v[j].z + v[j].w * v[j].w); }
        const float rstd = 1.f / sqrtf(wave_sum(s2) * (1.f / D) + 1e-5f);
        const float* md = modn + (isc ? 2 : b) * 6144;
#pragma unroll
        for (int j = 0; j < 4; ++j) {
            const int idx = lane * 4 + 256 * j;
            const f32x4 gg = *(const f32x4*)(g + idx), bb = *(const f32x4*)(bt + idx);
            const f32x4 y = v[j] * rstd * gg + bb;
            *(f32x4*)(xr + idx) = y;
            if (!LAST) {
                const f32x4 sh = *(const f32x4*)(md + idx), sc = *(const f32x4*)(md + 1024 + idx);
                const f32x4 h = y * (sc + 1.f) + sh;
                u32x2 o; o.x = pk2(h.x, h.y); o.y = pk2(h.z, h.w);
                *(u32x2*)(H + (size_t)r * D + idx) = o;
            }
        }
    }
}

__device__ __forceinline__ float log_sigmoid(float z) { return fminf(z, 0.f) - log1pf(expf(-fabsf(z))); }

__device__ __forceinline__ void fill_cum(float* cf, float* cb, float* lrs, int g, int h, const bf16* Pr, const float* theta, const float* gkw, const float* gkb, int tid) {
    if (g == 0) {
        const float lgf = log1pf(-expf(theta[h])), lgb = log1pf(-expf(theta[4 + h]));
        for (int i = tid; i < 4096; i += 512) { const int c = i >> 6; cf[i] = (float)(c + 1) * lgf; cb[i] = (float)(64 - c) * lgb; }
    } else {
        for (int i = tid; i < 64 * 32; i += 512) { const int c = i >> 5, rr = i & 31; lrs[i] = bf2f(Pr[(size_t)c * NPROJ + 3072 + rr]); }
        __syncthreads();
        if (tid < 128) {
            const int dir = tid >> 6, d = tid & 63;
            float w[16];
#pragma unroll
            for (int r = 0; r < 16; ++r) w[r] = gkw[(dir * 16 + r) * 256 + h * 64 + d];
            const float bb = gkb[dir * 256 + h * 64 + d];
            float run = 0.f;
            for (int i = 0; i < 64; ++i) {
                const int c = dir ? 63 - i : i;
                float z = bb;
#pragma unroll
                for (int r = 0; r < 16; ++r) z += lrs[c * 32 + dir * 16 + r] * w[r];
                run += log_sigmoid(z) * (1.f / 16.f);
                (dir ? cb : cf)[c * 64 + d] = run;
            }
        }
    }
    __syncthreads();
}

struct Args { const float* in[19]; float* out; unsigned char* ws; };

__global__ void __launch_bounds__(512, 2) fwd_kernel(Args a) {
    extern __shared__ __attribute__((aligned(16))) unsigned char lds[];
    cg::grid_group grid = cg::this_grid();
    const int tid = threadIdx.x, lane = tid & 63, wave = __builtin_amdgcn_readfirstlane(tid >> 6), quad = lane >> 4, l15 = lane & 15;
    const int G = gridDim.x, bid = blockIdx.x, gw = bid * 8 + wave, NGW = G * 8;
    unsigned char* ws = a.ws;
    const float* x = a.in[0]; const float* cvec = a.in[1]; const float* ctx = a.in[2]; const float* cctx = a.in[3];
    const float* w_mod = a.in[4]; const float* b_mod = a.in[5]; const float* ln_g = a.in[6]; const float* ln_b = a.in[7];
    const float* theta = a.in[11]; const float* gkw = a.in[12]; const float* gkb = a.in[13]; const float* normg = a.in[14]; const float* sink = a.in[17];
    bf16* WIN_T = (bf16*)(ws + OFF_WIN); bf16* WOUT0_T = (bf16*)(ws + OFF_WOUT0); bf16* W1_0_T = (bf16*)(ws + OFF_W1_0); bf16* W2_0_T = (bf16*)(ws + OFF_W2_0);
    bf16* WQKV_T = (bf16*)(ws + OFF_WQKV); bf16* WOUT1_T = (bf16*)(ws + OFF_WOUT1); bf16* W1_1_T = (bf16*)(ws + OFF_W1_1); bf16* W2_1_T = (bf16*)(ws + OFF_W2_1);
    float* mod = (float*)(ws + OFF_MOD); float* rope = (float*)(ws + OFF_ROPE); float* xctx = (float*)(ws + OFF_XCTX); float* DEC = (float*)(ws + OFF_DEC);
    bf16* H = (bf16*)(ws + OFF_H); bf16* P = (bf16*)(ws + OFF_P); bf16* ST = (bf16*)(ws + OFF_ST);
    float* xlat = a.out;
    PG8_LAS unsigned char* ldsg = (PG8_LAS unsigned char*)lds;

    {
        float* sl = (float*)lds; float* red = (float*)(lds + 12288);
        for (int item = bid; item < 192; item += G) {
            for (int i = tid; i < 3072; i += 512) { const int j = i >> 10, k = i & 1023; const float v = (j < 2) ? cvec[j * 1024 + k] : cctx[k]; sl[i] = v / (1.f + expf(-v)); }
            __syncthreads();
            const int layer = item / 96, n0 = (item % 96) * 64;
            const float* W = w_mod + (size_t)layer * 1024 * 6144 + n0 + lane;
            float a0 = 0.f, a1 = 0.f, a2 = 0.f; const int k0 = wave * 128;
#pragma unroll 8
            for (int kk = 0; kk < 128; ++kk) { const int k = k0 + kk; const float w = W[(size_t)k * 6144]; a0 += sl[k] * w; a1 += sl[1024 + k] * w; a2 += sl[2048 + k] * w; }
            red[(wave * 3 + 0) * 64 + lane] = a0; red[(wave * 3 + 1) * 64 + lane] = a1; red[(wave * 3 + 2) * 64 + lane] = a2;
            __syncthreads();
            if (tid < 192) { const int j = tid >> 6, col = tid & 63; float s = b_mod[layer * 6144 + n0 + col];
#pragma unroll
                for (int w = 0; w < 8; ++w) s += red[(w * 3 + j) * 64 + col];
                mod[(layer * 3 + j) * 6144 + n0 + col] = s; }
            __syncthreads();
        }
        if (bid == G - 1 && tid < 16) {
            double f = 1.0; for (int i = 0; i < tid; ++i) f *= 0.56234132519034908;
            const double x2 = f * f; double cs = 1.0, sn = f, tc = 1.0, ts = f;
            for (int n = 1; n <= 12; ++n) { tc *= -x2 / (double)((2 * n - 1) * (2 * n)); cs += tc; ts *= -x2 / (double)((2 * n) * (2 * n + 1)); sn += ts; }
            double c = 1.0, s = 0.0;
            for (int p = 0; p < 128; ++p) { rope[(p * 16 + tid) * 2] = (float)c; rope[(p * 16 + tid) * 2 + 1] = (float)s; const double nc = c * cs - s * sn; s = s * cs + c * sn; c = nc; }
        }
        float* scr = (float*)(lds + 32768 + wave * 8448);
        for (int it = gw; it < 11536; it += NGW) {
            int r = it;
            if (r < 1552) { transpose_item(a.in[10], 1024, NPROJ, WIN_T, scr, r, lane); continue; } r -= 1552;
            if (r < 512) { transpose_item(a.in[15], 1024, 1024, WOUT0_T, scr, r, lane); continue; } r -= 512;
            if (r < 2048) { transpose_item(a.in[8], 1024, FF, W1_0_T, scr, r, lane); continue; } r -= 2048;
            if (r < 2048) { transpose_item(a.in[9], FF, 1024, W2_0_T, scr, r, lane); continue; } r -= 2048;
            if (r < 768) { transpose_item(a.in[16], 1024, NQKV, WQKV_T, scr, r, lane); continue; } r -= 768;
            if (r < 512) { transpose_item(a.in[18], 1024, 1024, WOUT1_T, scr, r, lane); continue; } r -= 512;
            if (r < 2048) { transpose_item(a.in[8] + (size_t)1024 * FF, 1024, FF, W1_1_T, scr, r, lane); continue; } r -= 2048;
            transpose_item(a.in[9] + (size_t)FF * 1024, FF, 1024, W2_1_T, scr, r, lane);
        }
        { u32x4* z = (u32x4*)(WIN_T + (size_t)NPROJ * D); const u32x4 zero = {0u, 0u, 0u, 0u};
          for (int i = bid * 512 + tid; i < (NPROJ_PAD - NPROJ) * D / 8; i += G * 512) z[i] = zero; }
    }
    grid.sync();

    for (int r = gw; r < R; r += NGW) {
        bool isc; int b; const size_t off = row_off(r, isc, b);
        const float* xr = (isc ? ctx : x) + off; const float* md = mod + (isc ? 2 : b) * 6144;
#pragma unroll
        for (int j = 0; j < 4; ++j) {
            const int idx = lane * 4 + 256 * j;
            const f32x4 v = *(const f32x4*)(xr + idx), sh = *(const f32x4*)(md + idx), sc = *(const f32x4*)(md + 1024 + idx);
            const f32x4 h = v * (sc + 1.f) + sh;
            u32x2 o; o.x = pk2(h.x, h.y); o.y = pk2(h.z, h.w);
            *(u32x2*)(H + (size_t)r * D + idx) = o;
        }
    }
    grid.sync();

    { pg8::Gemm g{H, WIN_T, R, NPROJ_PAD, D}; pg8::StaticOrder S; S.init(R, NPROJ_PAD, G, bid); EpiStore<0> E{P, NPROJ, NPROJ};
      pg8::gemm_phase<EpiStore<0>, pg8::StaticOrder, true, true>(ldsg, g, S, E); }
    grid.sync();

#ifndef NO_P3
    {
        float* cf = (float*)lds; float* cb = (float*)(lds + 16384); float* lrs = (float*)(lds + 32768);
        bf16* kTf = (bf16*)(lds + 40960); bf16* kTb = (bf16*)(lds + 50176); bf16* vT = (bf16*)(lds + 59392);
        for (int unit = bid; unit < NB * 2 * 4 * NCH; unit += G) {
            const int pc = unit % NCH, t = unit / NCH, h = t & 3, g = (t >> 2) & 1, b = t >> 3;
            const int r0 = b * TP + pc * 64;
            const bf16* Pr = P + (size_t)r0 * NPROJ;
            const int kcol = g ? 1792 + h * 64 : 256 + h * 64, vcol = g ? 2048 + h * 128 : 512 + h * 128;
            const float kscale = g ? 1.f : 0.125f;
            fill_cum(cf, cb, lrs, g, h, Pr, theta, gkw, gkb, tid);
            { const int s = tid & 63, dc = tid >> 6;
              const u32x4 kv = *(const u32x4*)(Pr + (size_t)s * NPROJ + kcol + dc * 8);
#pragma unroll
              for (int j = 0; j < 8; ++j) { const int d = dc * 8 + j; const unsigned u = kv[j >> 1]; const float kf = ((j & 1) ? bfhi(u) : bflo(u)) * kscale;
                  kTf[d * 72 + s] = (bf16)f2bf(kf * expf(cf[63 * 64 + d] - cf[s * 64 + d]));
                  kTb[d * 72 + s] = (bf16)f2bf(kf * expf(cb[d] - cb[s * 64 + d])); }
#pragma unroll
              for (int i = 0; i < 2; ++i) { const int ec = dc + 8 * i;
                  const u32x4 vv = *(const u32x4*)(Pr + (size_t)s * NPROJ + vcol + ec * 8);
#pragma unroll
                  for (int j = 0; j < 8; ++j) { const unsigned u = vv[j >> 1]; vT[(ec * 8 + j) * 72 + s] = (bf16)((j & 1) ? (u >> 16) : (u & 0xffffu)); } }
            }
            const int seq0 = ((b * 2 + g) * 4 + h) * 2;
            const int nf = pc, nbk = (pc < 4) ? 3 - pc : 135 - pc;
            if (tid < 128) { const int dir = tid >> 6, d = tid & 63;
                DEC[((size_t)(seq0 + dir) * NCH + (dir ? nbk : nf)) * 64 + d] = dir ? expf(cb[d]) : expf(cf[63 * 64 + d]); }
            __syncthreads();
            bf16x8 bfr[2];
#pragma unroll
            for (int ks = 0; ks < 2; ++ks) bfr[ks] = *(const bf16x8*)(vT + (wave * 16 + l15) * 72 + ks * 32 + quad * 8);
#pragma unroll
            for (int dir = 0; dir < 2; ++dir) {
                const bf16* kT = dir ? kTb : kTf;
                bf16* dst = ST + ((size_t)(seq0 + dir) * NCH + (dir ? nbk : nf)) * 8192 + (size_t)(wave * 16 + l15) * 64;
#pragma unroll
                for (int dt = 0; dt < 4; ++dt) {
                    pg8::f32x4 acc = {0.f, 0.f, 0.f, 0.f};
#pragma unroll
                    for (int ks = 0; ks < 2; ++ks) { const bf16x8 af = *(const bf16x8*)(kT + (dt * 16 + l15) * 72 + ks * 32 + quad * 8); acc = MFMA16(af, bfr[ks], acc); }
                    u32x2 o; o.x = pk2(acc[0], acc[1]); o.y = pk2(acc[2], acc[3]);
                    *(u32x2*)(dst + dt * 16 + quad * 4) = o;
                }
            }
            __syncthreads();
        }
    }
    grid.sync();

#endif
    for (int i = bid * 512 + tid; i < 32 * 4096; i += G * 512) {
        const int seq = i >> 12, pi = i & 4095, d = (2 * pi) & 63;
        unsigned* sp = (unsigned*)(ST + (size_t)seq * NCH * 8192) + pi; const float* dp = DEC + (size_t)seq * NCH * 64 + d;
        float s0 = 0.f, s1 = 0.f;
#pragma unroll 4
        for (int n = 0; n < NCH; ++n) {
            const unsigned kv = sp[(size_t)n * 4096]; const float d0 = dp[n * 64], d1 = dp[n * 64 + 1];
            sp[(size_t)n * 4096] = pk2(s0, s1);
            s0 = d0 * s0 + bflo(kv); s1 = d1 * s1 + bfhi(kv);
        }
    }
    grid.sync();

#ifndef NO_P5
    {
        float* cf = (float*)lds; float* cb = (float*)(lds + 16384); float* lrs = (float*)(lds + 32768);
        bf16* qdf = (bf16*)(lds + 40960); bf16* kif = (bf16*)(lds + 50176); bf16* qdb = (bf16*)(lds + 59392); bf16* kib = (bf16*)(lds + 68608);
        bf16* vT = (bf16*)(lds + 77824); bf16* Am = (bf16*)(lds + 96256); float* red = (float*)(lds + 105472);
        for (int unit = bid; unit < NB * 2 * 4 * NCH; unit += G) {
            const int pc = unit % NCH, t = unit / NCH, h = t & 3, g = (t >> 2) & 1, b = t >> 3;
            const int r0 = b * TP + pc * 64;
            const bf16* Pr = P + (size_t)r0 * NPROJ;
            const int qcol = g ? 1536 + h * 64 : h * 64, kcol = g ? 1792 + h * 64 : 256 + h * 64, vcol = g ? 2048 + h * 128 : 512 + h * 128, gcol = g ? 2560 + h * 128 : 1024 + h * 128;
            const float qscale = g ? 0.125f : 1.f, kscale = g ? 1.f : 0.125f;
            fill_cum(cf, cb, lrs, g, h, Pr, theta, gkw, gkb, tid);
            { const int dc = tid & 7, s = tid >> 3;
              const u32x4 qv = *(const u32x4*)(Pr + (size_t)s * NPROJ + qcol + dc * 8), kv = *(const u32x4*)(Pr + (size_t)s * NPROJ + kcol + dc * 8);
              u32x4 o1, o2, o3, o4;
#pragma unroll
              for (int j2 = 0; j2 < 4; ++j2) {
                  const int d = dc * 8 + 2 * j2;
                  const float f0 = cf[s * 64 + d], f1 = cf[s * 64 + d + 1], b0 = cb[s * 64 + d], b1 = cb[s * 64 + d + 1];
                  const float q0 = bflo(qv[j2]) * qscale, q1 = bfhi(qv[j2]) * qscale, k0 = bflo(kv[j2]) * kscale, k1 = bfhi(kv[j2]) * kscale;
                  o1[j2] = pk2(q0 * expf(f0), q1 * expf(f1)); o2[j2] = pk2(k0 * expf(-f0), k1 * expf(-f1));
                  o3[j2] = pk2(q0 * expf(b0), q1 * expf(b1)); o4[j2] = pk2(k0 * expf(-b0), k1 * expf(-b1));
              }
              *(u32x4*)(qdf + s * 72 + dc * 8) = o1; *(u32x4*)(kif + s * 72 + dc * 8) = o2; *(u32x4*)(qdb + s * 72 + dc * 8) = o3; *(u32x4*)(kib + s * 72 + dc * 8) = o4;
            }
            { const int s = tid & 63, dc = tid >> 6;
#pragma unroll
              for (int i = 0; i < 2; ++i) { const int ec = dc + 8 * i;
                  const u32x4 vv = *(const u32x4*)(Pr + (size_t)s * NPROJ + vcol + ec * 8);
#pragma unroll
                  for (int j = 0; j < 8; ++j) { const unsigned u = vv[j >> 1]; vT[(ec * 8 + j) * 72 + s] = (bf16)((j & 1) ? (u >> 16) : (u & 0xffffu)); } }
            }
            __syncthreads();
            { const int ct = wave & 3;
              bf16x8 af[2], ab[2];
#pragma unroll
              for (int ks = 0; ks < 2; ++ks) { af[ks] = *(const bf16x8*)(qdf + (ct * 16 + l15) * 72 + ks * 32 + quad * 8); ab[ks] = *(const bf16x8*)(qdb + (ct * 16 + l15) * 72 + ks * 32 + quad * 8); }
#pragma unroll
              for (int i = 0; i < 2; ++i) { const int st = (wave >> 2) * 2 + i;
                  pg8::f32x4 accf = {0.f, 0.f, 0.f, 0.f}, accb = {0.f, 0.f, 0.f, 0.f};
#pragma unroll
                  for (int ks = 0; ks < 2; ++ks) {
                      const bf16x8 bf_ = *(const bf16x8*)(kif + (st * 16 + l15) * 72 + ks * 32 + quad * 8), bb_ = *(const bf16x8*)(kib + (st * 16 + l15) * 72 + ks * 32 + quad * 8);
                      accf = MFMA16(af[ks], bf_, accf); accb = MFMA16(ab[ks], bb_, accb); }
                  const int scol = st * 16 + l15;
#pragma unroll
                  for (int rg = 0; rg < 4; ++rg) { const int c = ct * 16 + quad * 4 + rg; Am[c * 72 + scol] = (bf16)f2bf(scol <= c ? accf[rg] : accb[rg]); }
              }
            }
            __syncthreads();
            { const int ct = wave & 3, eh = wave >> 2;
              const int seq0 = ((b * 2 + g) * 4 + h) * 2;
              const int nf = pc, nbk = (pc < 4) ? 3 - pc : 135 - pc;
              const bf16* Sf = ST + ((size_t)seq0 * NCH + nf) * 8192; const bf16* Sb = ST + ((size_t)(seq0 + 1) * NCH + nbk) * 8192;
              bf16x8 bA[2], bQf[2], bQb[2];
#pragma unroll
              for (int ks = 0; ks < 2; ++ks) { const int o = (ct * 16 + l15) * 72 + ks * 32 + quad * 8; bA[ks] = *(const bf16x8*)(Am + o); bQf[ks] = *(const bf16x8*)(qdf + o); bQb[ks] = *(const bf16x8*)(qdb + o); }
              pg8::f32x4 acc[4]; float ss = 0.f;
#pragma unroll
              for (int et = 0; et < 4; ++et) { const int e = (eh * 4 + et) * 16 + l15;
                  pg8::f32x4 c4 = {0.f, 0.f, 0.f, 0.f};
#pragma unroll
                  for (int ks = 0; ks < 2; ++ks) {
                      const bf16x8 a1 = *(const bf16x8*)(vT + e * 72 + ks * 32 + quad * 8);
                      const bf16x8 a2 = *(const bf16x8*)(Sf + e * 64 + ks * 32 + quad * 8);
                      const bf16x8 a3 = *(const bf16x8*)(Sb + e * 64 + ks * 32 + quad * 8);
                      c4 = MFMA16(a1, bA[ks], c4); c4 = MFMA16(a2, bQf[ks], c4); c4 = MFMA16(a3, bQb[ks], c4); }
                  acc[et] = c4; ss += (c4[0] * c4[0] + c4[1] * c4[1]) + (c4[2] * c4[2] + c4[3] * c4[3]); }
              ss += __shfl_xor(ss, 16); ss += __shfl_xor(ss, 32);
              if (quad == 0) red[eh * 64 + ct * 16 + l15] = ss;
              __syncthreads();
              const float tot = red[ct * 16 + l15] + red[64 + ct * 16 + l15];
              const float rinv = 1.f / sqrtf(tot * (1.f / 128.f) + 1e-6f);
              const int r = r0 + ct * 16 + l15;
#pragma unroll
              for (int et = 0; et < 4; ++et) { const int e0 = (eh * 4 + et) * 16 + quad * 4;
                  const u32x2 gv = *(const u32x2*)(P + (size_t)r * NPROJ + gcol + e0);
                  float gt[4] = {bflo(gv.x), bfhi(gv.x), bflo(gv.y), bfhi(gv.y)}; float y[4];
#pragma unroll
                  for (int i = 0; i < 4; ++i) { const float ng = g ? normg[e0 + i] : 1.f; const float sg = gt[i] / (1.f + expf(-gt[i])); y[i] = sg * acc[et][i] * rinv * ng; }
                  u32x2 o; o.x = pk2(y[0], y[1]); o.y = pk2(y[2], y[3]);
                  *(u32x2*)(H + (size_t)r * D + g * 512 + h * 128 + e0) = o; }
            }
            __syncthreads();
        }
    }
    grid.sync();

#endif
    { pg8::Gemm g{H, WOUT0_T, R, D, D}; pg8::StaticOrder S; S.init(R, D, G, bid); EpiResid E{x, ctx, xlat, xctx, mod + 2 * 1024};
      pg8::gemm_phase<EpiResid, pg8::StaticOrder, true, true>(ldsg, g, S, E); }
    grid.sync();
    ln_phase<false>(xlat, xctx, ln_g, ln_b, mod + 3 * 1024, H, gw, NGW, lane);
    grid.sync();
    { pg8::Gemm g{H, W1_0_T, R, FF, D}; pg8::StaticOrder S; S.init(R, FF, G, bid); EpiStore<1> E{P, FF, FF};
      pg8::gemm_phase<EpiStore<1>, pg8::StaticOrder, true, true>(ldsg, g, S, E); }
    grid.sync();
    { pg8::Gemm g{P, W2_0_T, R, D, FF}; pg8::StaticOrder S; S.init(R, D, G, bid); EpiResid E{xlat, xctx, xlat, xctx, mod + 5 * 1024};
      pg8::gemm_phase<EpiResid, pg8::StaticOrder, true, true>(ldsg, g, S, E); }
    grid.sync();
    ln_phase<false>(xlat, xctx, ln_g + 1024, ln_b + 1024, mod + 3 * 6144, H, gw, NGW, lane);
    grid.sync();

    { pg8::Gemm g{H, WQKV_T, R, NQKV, D}; pg8::StaticOrder S; S.init(R, NQKV, G, bid); EpiStore<0> E{P, NQKV, NQKV};
      pg8::gemm_phase<EpiStore<0>, pg8::StaticOrder, true, true>(ldsg, g, S, E); }
    grid.sync();

#ifndef NO_P12
    {
        bf16* Qs = (bf16*)lds; bf16* Ks = (bf16*)(lds + 73728); bf16* Vt = (bf16*)(lds + 82944);
        for (int unit = bid; unit < NB * 4 * 64; unit += G) {
            const int nb = unit & 63, kvh = (unit >> 6) & 3, b = unit >> 8;
            __syncthreads();
#pragma unroll
            for (int i = 0; i < 4; ++i) {
                const int it = tid + i * 512, pcq = it & 3, row = it >> 2, g = row >> 7, qi = row & 127, pos = nb * 128 + qi;
                const bf16* src = P + (size_t)(b * TP + L + pos) * NQKV + (kvh * 4 + g) * 64;
                const int c1 = (pcq & 1) + (pcq >> 1) * 4;
                const u32x4 u1 = *(const u32x4*)(src + c1 * 8), u2 = *(const u32x4*)(src + (c1 + 2) * 8);
                const int pv = (pcq < 2) ? (pos >> 6) : (pos & 63);
                const f32x4* tab = (const f32x4*)(rope + (pv * 16 + (c1 & 1) * 8) * 2);
                u32x4 o1, o2;
#pragma unroll
                for (int j2 = 0; j2 < 4; ++j2) { const f32x4 cs = tab[j2];
                    const float a0 = bflo(u1[j2]), a1 = bfhi(u1[j2]), b0 = bflo(u2[j2]), b1 = bfhi(u2[j2]);
                    o1[j2] = pk2(a0 * cs.x - b0 * cs.y, a1 * cs.z - b1 * cs.w); o2[j2] = pk2(a0 * cs.y + b0 * cs.x, a1 * cs.w + b1 * cs.z); }
                *(u32x4*)(Qs + row * 72 + c1 * 8) = o1; *(u32x4*)(Qs + row * 72 + (c1 + 2) * 8) = o2;
            }
            __syncthreads();
            const int g = wave >> 1, qrow0 = g * 128 + (wave & 1) * 64, qpos0 = nb * 128 + (wave & 1) * 64;
            bf16x8 qf[4][2];
#pragma unroll
            for (int qt = 0; qt < 4; ++qt)
#pragma unroll
                for (int ks = 0; ks < 2; ++ks) qf[qt][ks] = *(const bf16x8*)(Qs + (qrow0 + qt * 16 + l15) * 72 + ks * 32 + quad * 8);
            float mrun[4], lrun[4]; pg8::f32x4 O[4][4];
            const float sk = sink[kvh * 4 + g];
#pragma unroll
            for (int qt = 0; qt < 4; ++qt) { mrun[qt] = sk; lrun[qt] = (quad == 0) ? 1.f : 0.f;
#pragma unroll
                for (int dt = 0; dt < 4; ++dt) O[dt][qt] = (pg8::f32x4){0.f, 0.f, 0.f, 0.f}; }
            for (int ti = 0; ti < 10; ++ti) {
                const bool local = ti >= 4;
                int krow0, kpos0 = 0;
                if (!local) krow0 = b * TP + ti * 64;
                else { const int j = ti - 4, kb = nb - 1 + (j >> 1); if (kb < 0 || kb > 63) continue; kpos0 = kb * 128 + (j & 1) * 64; krow0 = b * TP + L + kpos0; }
                __syncthreads();
                if (tid < 256) {
                    const int key = tid >> 2, pck = tid & 3, c1 = (pck & 1) + (pck >> 1) * 4;
                    const bf16* src = P + (size_t)(krow0 + key) * NQKV + 1024 + kvh * 64;
                    const u32x4 u1 = *(const u32x4*)(src + c1 * 8), u2 = *(const u32x4*)(src + (c1 + 2) * 8);
                    u32x4 o1 = u1, o2 = u2;
                    if (local) {
                        const int pos = kpos0 + key, pv = (pck < 2) ? (pos >> 6) : (pos & 63);
                        const f32x4* tab = (const f32x4*)(rope + (pv * 16 + (c1 & 1) * 8) * 2);
#pragma unroll
                        for (int j2 = 0; j2 < 4; ++j2) { const f32x4 cs = tab[j2];
                            const float a0 = bflo(u1[j2]), a1 = bfhi(u1[j2]), b0 = bflo(u2[j2]), b1 = bfhi(u2[j2]);
                            o1[j2] = pk2(a0 * cs.x - b0 * cs.y, a1 * cs.z - b1 * cs.w); o2[j2] = pk2(a0 * cs.y + b0 * cs.x, a1 * cs.w + b1 * cs.z); }
                    }
                    *(u32x4*)(Ks + key * 72 + c1 * 8) = o1; *(u32x4*)(Ks + key * 72 + (c1 + 2) * 8) = o2;
                }
                { const int key = tid & 63, dc = tid >> 6;
                  const u32x4 vv = *(const u32x4*)(P + (size_t)(krow0 + key) * NQKV + 1280 + kvh * 64 + dc * 8);
#pragma unroll
                  for (int j = 0; j < 8; ++j) { const unsigned u = vv[j >> 1]; Vt[(dc * 8 + j) * 72 + key] = (bf16)((j & 1) ? (u >> 16) : (u & 0xffffu)); } }
                __syncthreads();
#pragma unroll
                for (int qt = 0; qt < 4; ++qt) {
                    asm volatile("" ::: "memory");
                    pg8::f32x4 S[4];
#pragma unroll
                    for (int kt = 0; kt < 4; ++kt) S[kt] = (pg8::f32x4){0.f, 0.f, 0.f, 0.f};
#pragma unroll
                    for (int ks = 0; ks < 2; ++ks)
#pragma unroll
                        for (int kt = 0; kt < 4; ++kt) { const bf16x8 af = *(const bf16x8*)(Ks + (kt * 16 + l15) * 72 + ks * 32 + quad * 8); S[kt] = MFMA16(af, qf[qt][ks], S[kt]); }
                    const int qpos = qpos0 + qt * 16 + l15;
                    float mx = -INFINITY;
#pragma unroll
                    for (int kt = 0; kt < 4; ++kt)
#pragma unroll
                        for (int rg = 0; rg < 4; ++rg) { float s = S[kt][rg] * 0.125f;
                            if (local) { const int dlt = kpos0 + kt * 16 + quad * 4 + rg - qpos; if (dlt > 128 || dlt < -128) s = -INFINITY; }
                            S[kt][rg] = s; mx = fmaxf(mx, s); }
                    mx = fmaxf(mx, __shfl_xor(mx, 16)); mx = fmaxf(mx, __shfl_xor(mx, 32));
                    const float mnew = fmaxf(mrun[qt], mx), al = __expf(mrun[qt] - mnew); mrun[qt] = mnew;
                    float ps = 0.f;
#pragma unroll
                    for (int kt = 0; kt < 4; ++kt)
#pragma unroll
                        for (int rg = 0; rg < 4; ++rg) { const float p = __expf(S[kt][rg] - mnew); S[kt][rg] = p; ps += p; }
                    lrun[qt] = lrun[qt] * al + ps;
#pragma unroll
                    for (int dt = 0; dt < 4; ++dt) O[dt][qt] = O[dt][qt] * al;
#pragma unroll
                    for (int s2 = 0; s2 < 2; ++s2) {
                        u32x4 pw; pw.x = pk2(S[2 * s2][0], S[2 * s2][1]); pw.y = pk2(S[2 * s2][2], S[2 * s2][3]);
                        pw.z = pk2(S[2 * s2 + 1][0], S[2 * s2 + 1][1]); pw.w = pk2(S[2 * s2 + 1][2], S[2 * s2 + 1][3]);
                        const bf16x8 pf = __builtin_bit_cast(bf16x8, pw);
#pragma unroll
                        for (int dt = 0; dt < 4; ++dt) {
                            const s16x4 lo = *(const s16x4*)(Vt + (dt * 16 + l15) * 72 + s2 * 32 + quad * 4), hi = *(const s16x4*)(Vt + (dt * 16 + l15) * 72 + s2 * 32 + 16 + quad * 4);
                            const bf16x8 av = __builtin_shufflevector(lo, hi, 0, 1, 2, 3, 4, 5, 6, 7);
                            O[dt][qt] = MFMA16(av, pf, O[dt][qt]); }
                    }
                }
            }
#pragma unroll
            for (int qt = 0; qt < 4; ++qt) {
                float lt = lrun[qt]; lt += __shfl_xor(lt, 16); lt += __shfl_xor(lt, 32);
                const float inv = 1.f / lt;
                const int r = b * TP + L + qpos0 + qt * 16 + l15;
#pragma unroll
                for (int dt = 0; dt < 4; ++dt) { u32x2 o; o.x = pk2(O[dt][qt][0] * inv, O[dt][qt][1] * inv); o.y = pk2(O[dt][qt][2] * inv, O[dt][qt][3] * inv);
                    *(u32x2*)(H + (size_t)r * D + (kvh * 4 + g) * 64 + dt * 16 + quad * 4) = o; }
            }
        }
    }
    grid.sync();

#endif
    { pg8::Gemm g{H, WOUT1_T, R, D, D}; pg8::StaticOrder S; S.init(R, D, G, bid); EpiResid E{xlat, xctx, xlat, xctx, mod + 3 * 6144 + 2 * 1024};
      pg8::gemm_phase<EpiResid, pg8::StaticOrder, true, true>(ldsg, g, S, E); }
    grid.sync();
    ln_phase<false>(xlat, xctx, ln_g + 2048, ln_b + 2048, mod + 3 * 6144 + 3 * 1024, H, gw, NGW, lane);
    grid.sync();
    { pg8::Gemm g{H, W1_1_T, R, FF, D}; pg8::StaticOrder S; S.init(R, FF, G, bid); EpiStore<1> E{P, FF, FF};
      pg8::gemm_phase<EpiStore<1>, pg8::StaticOrder, true, true>(ldsg, g, S, E); }
    grid.sync();
    { pg8::Gemm g{P, W2_1_T, R, D, FF}; pg8::StaticOrder S; S.init(R, D, G, bid); EpiResid E{xlat, xctx, xlat, xctx, mod + 3 * 6144 + 5 * 1024};
      pg8::gemm_phase<EpiResid, pg8::StaticOrder, true, true>(ldsg, g, S, E); }
    grid.sync();
    ln_phase<true>(xlat, xctx, ln_g + 3072, ln_b + 3072, mod, H, gw, NGW, lane);
}

extern "C" void kernel_launch(void* const* d_in, const int* in_sizes, int n_in, void* d_out, int out_size, void* d_ws, size_t ws_size, hipStream_t stream) {
    static int grid = 0;
    if (grid == 0) {
        if (n_in != 19 || out_size != NB * T * D || ws_size < WS_TOTAL) { fprintf(stderr, "kernel_launch: unexpected shapes (n_in %d out %d ws %zu)\n", n_in, out_size, ws_size); grid = -1; return; }
        int dev = 0, cus = 0, per_cu = 0;
        hipGetDevice(&dev); hipDeviceGetAttribute(&cus, hipDeviceAttributeMultiprocessorCount, dev);
        if (hipFuncSetAttribute((const void*)fwd_kernel, hipFuncAttributeMaxDynamicSharedMemorySize, LDS_BYTES) != hipSuccess) { fprintf(stderr, "kernel_launch: hipFuncSetAttribute failed\n"); grid = -1; return; }
        if (hipOccupancyMaxActiveBlocksPerMultiprocessor(&per_cu, (const void*)fwd_kernel, 512, LDS_BYTES) != hipSuccess || per_cu < 1) per_cu = 1;
        (void)hipGetLastError();
        grid = cus > 0 ? cus : 256;
    }
    if (grid < 0) return;
    Args a{};
    for (int i = 0; i < 19; ++i) a.in[i] = (const float*)d_in[i];
    a.out = (float*)d_out; a.ws = (unsigned char*)d_ws;
    void* args[] = {&a};
    hipError_t e = hipLaunchCooperativeKernel((const void*)fwd_kernel, dim3(grid), dim3(512), args, LDS_BYTES, stream);
    if (e != hipSuccess) fprintf(stderr, "cooperative launch failed: %s (grid %d)\n", hipGetErrorString(e), grid);
}
```

```cpp
#include <hip/hip_runtime.h>
#include <hip/hip_cooperative_groups.h>
#include <cstdio>
#include <cstdint>
namespace cg = cooperative_groups;
namespace pg8 {
#define PG8_LAS __attribute__((address_space(3)))
typedef unsigned short bf16_t;
typedef short bf16x8 __attribute__((ext_vector_type(8)));
typedef float f32x4 __attribute__((ext_vector_type(4)));
typedef unsigned u32x4 __attribute__((ext_vector_type(4)));
constexpr int BM = 256, BK = 64, HALF = 128, HTB = HALF * BK * 2  , STAGE_BYTES = 8 * HTB, NXCD = 8, WGM = 8;

__host__ __device__ __forceinline__ int lds_byte(int r, int c) { const int st = (r >> 4) * 2 + (c >> 5), rr = r & 15, cc = c & 31, ob = rr * 64 + cc * 2; return st * 1024 + (ob ^ (((ob >> 9) & 1) << 5)); }
__host__ __device__ __forceinline__ void stage_rc(int b, int& R, int& C) { const int st = b / 1024, sb = b % 1024, swz = sb ^ (((sb >> 9) & 1) << 5); R = (st >> 1) * 16 + swz / 64; C = (st & 1) * 32 + (swz % 64) / 2; }
__host__ __device__ __forceinline__ int perm32(int rho) { const int n = rho >> 4, i = rho & 15; return 8 * (i >> 2) + 4 * n + (i & 3); }

struct Unit { int pm, pn; };
struct Gemm { const bf16_t* A; const bf16_t* Bt; int M, N, K; };

struct StaticOrder {
    int nM, nN, nwg, G, c;
    __host__ __device__ void init(int M, int N, int G_, int c_) { nM = M / BM; nN = N / BM; nwg = nM * nN; G = G_; c = c_; }
    __host__ __device__ bool next(int i, Unit& u) const {
        const long L = (long)i * G + c; if (L >= nwg) return false;
        int wgid = (int)L; { const int q = nwg / NXCD, r = nwg % NXCD, xcd = wgid % NXCD, off = wgid / NXCD; wgid = (xcd < r ? xcd * (q + 1) : r * (q + 1) + (xcd - r) * q) + off; }
        const int nig = WGM * nN, gid = wgid / nig, fm = gid * WGM, gsz = (nM - fm) < WGM ? (nM - fm) : WGM;
        u.pm = fm + ((wgid % nig) % gsz); u.pn = (wgid % nig) / gsz; return true;
    }
    __device__ __forceinline__ void a_ready(const Unit&) const {}
    __device__ __forceinline__ void done(const Unit&) const {}
};

__device__ __forceinline__ unsigned cvt_pk_bf16(float lo, float hi) { unsigned r; asm volatile("v_cvt_pk_bf16_f32 %0, %1, %2" : "=v"(r) : "v"(lo), "v"(hi)); return r; }

template <class Epi, class Sched, bool ALIGN_EPI = false, bool SP2 = false>
__device__ __forceinline__ void gemm_phase(PG8_LAS unsigned char* lds, const Gemm g, const Sched& S, const Epi& E) {
    int tid = threadIdx.x; asm volatile("" : "+v"(tid));
    const int wid = __builtin_amdgcn_readfirstlane(tid >> 6), lane = tid & 63, wr = wid >> 2, wc = wid & 3, fr = lane & 15, fq = lane >> 4;
    const int K = g.K, nt = K / BK;
    unsigned voffA[2], voffB[2];
#pragma unroll
    for (int i = 0; i < 2; ++i) { int R, C; stage_rc(tid * 16 + i * 8192, R, C); const int Rb = Epi::PERM ? ((R & ~31) + perm32(R & 31)) : R;
        voffA[i] = (unsigned)(R * K + C) * 2u; voffB[i] = (unsigned)(Rb * K + C) * 2u; }
    const size_t kstep = (size_t)(BK * 2);
    const size_t hstep = (size_t)HALF * K * 2;
    const size_t tstep = 2 * hstep;
    const unsigned ldsw = (unsigned)wid * 1024u;
    const int aoff = lds_byte(wr * 64 + fr, fq * 8), boff = lds_byte(wc * 32 + fr, fq * 8);
#define PG8_SA(b, h) (((b) * 2 + (h)) * HTB)
#define PG8_SB(b, h) ((4 + (b) * 2 + (h)) * HTB)
#define PG8_STAGE(bufoff, gbase, voff) do { _Pragma("unroll") for (int _i = 0; _i < 2; ++_i) \
        __builtin_amdgcn_global_load_lds((const unsigned*)((const char*)(gbase) + (voff)[_i]), (PG8_LAS unsigned*)(lds + (bufoff) + ldsw + _i * 8192), 16, 0, 0); } while (0)
#define PG8_LDA(dst, b, h) do { _Pragma("unroll") for (int m = 0; m < 4; ++m) _Pragma("unroll") for (int k = 0; k < 2; ++k) dst[m][k] = *(const PG8_LAS bf16x8*)(lds + PG8_SA(b, h) + aoff + m * 2048 + k * 1024); } while (0)
#define PG8_LDB(dst, b, h) do { _Pragma("unroll") for (int n = 0; n < 2; ++n) _Pragma("unroll") for (int k = 0; k < 2; ++k) dst[n][k] = *(const PG8_LAS bf16x8*)(lds + PG8_SB(b, h) + boff + n * 2048 + k * 1024); } while (0)
#define PG8_MMA(ai, bj, At, Bt) do { __builtin_amdgcn_s_setprio(1); _Pragma("unroll") for (int m = 0; m < 4; ++m) _Pragma("unroll") for (int n = 0; n < 2; ++n) _Pragma("unroll") for (int k = 0; k < 2; ++k) \
        acc[ai][bj][m][n] = __builtin_amdgcn_mfma_f32_16x16x32_bf16(Bt[n][k], At[m][k], acc[ai][bj][m][n], 0, 0, 0); __builtin_amdgcn_s_setprio(0); } while (0)
#define PG8_WAIT_V(n) asm volatile("s_waitcnt vmcnt(" #n ")" ::: "memory")
#define PG8_WAIT_L(n) asm volatile("s_waitcnt lgkmcnt(" #n ")" ::: "memory")
#define PG8_BAR __builtin_amdgcn_s_barrier()
#define PG8_SCHED __builtin_amdgcn_sched_barrier(0)
    Unit cur, nxt; int ui = 0;
    if (!S.next(0, cur)) return;
    f32x4 acc[2][2][4][2];
#pragma unroll
    for (int a = 0; a < 2; ++a)
#pragma unroll
        for (int b = 0; b < 2; ++b)
#pragma unroll
            for (int m = 0; m < 4; ++m)
#pragma unroll
                for (int n = 0; n < 2; ++n) acc[a][b][m][n] = (f32x4){0.f, 0.f, 0.f, 0.f};
    bf16x8 At[4][2], B0[2][2], B1[2][2];
    const char* cA = (const char*)g.A + (size_t)cur.pm * tstep; const char* cB = (const char*)g.Bt + (size_t)cur.pn * tstep;
    S.a_ready(cur);
    if constexpr (SP2) {
        PG8_STAGE(PG8_SB(0, 0), cB, voffB); PG8_STAGE(PG8_SB(0, 1), cB + hstep, voffB); PG8_STAGE(PG8_SA(0, 0), cA, voffA); PG8_STAGE(PG8_SA(0, 1), cA + hstep, voffA);
        if (wr == 1) PG8_BAR;
        PG8_WAIT_V(2); PG8_BAR;
        PG8_STAGE(PG8_SB(1, 0), cB + kstep, voffB); PG8_STAGE(PG8_SA(1, 0), cA + kstep, voffA); PG8_STAGE(PG8_SB(1, 1), cB + hstep + kstep, voffB);
        PG8_WAIT_V(6); PG8_BAR;
    } else {
        PG8_STAGE(PG8_SB(0, 0), cB, voffB); PG8_STAGE(PG8_SA(0, 0), cA, voffA); PG8_STAGE(PG8_SB(0, 1), cB + hstep, voffB); PG8_STAGE(PG8_SA(0, 1), cA + hstep, voffA);
        if (wr == 1) PG8_BAR;
        PG8_WAIT_V(4); PG8_BAR;
        PG8_STAGE(PG8_SB(1, 0), cB + kstep, voffB); PG8_STAGE(PG8_SA(1, 0), cA + kstep, voffA); PG8_STAGE(PG8_SB(1, 1), cB + hstep + kstep, voffB);
        PG8_WAIT_V(6); PG8_BAR;
    }
    for (;;) {
        const bool has_next = S.next(ui + 1, nxt);
        const char* nA = has_next ? (const char*)g.A + (size_t)nxt.pm * tstep : cA; const char* nB = has_next ? (const char*)g.Bt + (size_t)nxt.pn * tstep : cB;
        for (int t = 0; t < nt; t += 2) {
            const bool last = (t == nt - 2);
            const char* a1 = cA + (size_t)(t + 1) * kstep;
            const char* a2 = last ? nA : cA + (size_t)(t + 2) * kstep; const char* b2 = last ? nB : cB + (size_t)(t + 2) * kstep;
            const char* a3 = a2 + kstep; const char* b3 = b2 + kstep;
            if (last && has_next) S.a_ready(nxt);
            if constexpr (SP2) {
            PG8_LDB(B0, 0, 0); PG8_LDB(B1, 0, 1); PG8_SCHED; PG8_LDA(At, 0, 0); PG8_STAGE(PG8_SA(1, 1), a1 + hstep, voffA);
            PG8_WAIT_V(8); PG8_WAIT_L(0); PG8_BAR; PG8_MMA(0, 0, At, B0); PG8_MMA(0, 1, At, B1); PG8_BAR; PG8_SCHED;
            PG8_LDA(At, 0, 1); PG8_STAGE(PG8_SB(0, 0), b2, voffB); PG8_STAGE(PG8_SB(0, 1), b2 + hstep, voffB); PG8_STAGE(PG8_SA(0, 0), a2, voffA);
            PG8_WAIT_V(8); PG8_WAIT_L(0); PG8_BAR; PG8_MMA(1, 0, At, B0); PG8_MMA(1, 1, At, B1); PG8_BAR; PG8_SCHED;
            PG8_LDB(B0, 1, 0); PG8_LDB(B1, 1, 1); PG8_SCHED; PG8_LDA(At, 1, 0); PG8_STAGE(PG8_SA(0, 1), a2 + hstep, voffA);
            PG8_WAIT_V(8); PG8_WAIT_L(0); PG8_BAR; PG8_MMA(0, 0, At, B0); PG8_MMA(0, 1, At, B1); PG8_BAR; PG8_SCHED;
            PG8_LDA(At, 1, 1); PG8_STAGE(PG8_SB(1, 0), b3, voffB); PG8_STAGE(PG8_SB(1, 1), b3 + hstep, voffB); PG8_STAGE(PG8_SA(1, 0), a3, voffA);
            PG8_WAIT_V(8); PG8_WAIT_L(0); PG8_BAR; PG8_MMA(1, 0, At, B0); PG8_MMA(1, 1, At, B1); PG8_BAR; PG8_SCHED;
            } else {
            PG8_LDB(B0, 0, 0); PG8_SCHED; PG8_LDA(At, 0, 0); PG8_STAGE(PG8_SA(1, 1), a1 + hstep, voffA);
            PG8_WAIT_L(8); PG8_BAR; PG8_WAIT_L(0); PG8_MMA(0, 0, At, B0); PG8_BAR; PG8_SCHED;
            PG8_LDB(B1, 0, 1); PG8_STAGE(PG8_SB(0, 0), b2, voffB);
            PG8_BAR; PG8_WAIT_L(0); PG8_MMA(0, 1, At, B1); PG8_BAR;
            PG8_LDA(At, 0, 1); PG8_STAGE(PG8_SA(0, 0), a2, voffA);
            PG8_BAR; PG8_WAIT_L(0); PG8_MMA(1, 0, At, B0); PG8_BAR; PG8_SCHED;
            PG8_STAGE(PG8_SB(0, 1), b2 + hstep, voffB);
            PG8_WAIT_V(6); PG8_BAR; PG8_MMA(1, 1, At, B1); PG8_BAR;
            PG8_LDB(B0, 1, 0); PG8_SCHED; PG8_LDA(At, 1, 0); PG8_STAGE(PG8_SA(0, 1), a2 + hstep, voffA);
            PG8_WAIT_L(8); PG8_BAR; PG8_WAIT_L(0); PG8_MMA(0, 0, At, B0); PG8_BAR; PG8_SCHED;
            PG8_LDB(B1, 1, 1); PG8_STAGE(PG8_SB(1, 0), b3, voffB);
            PG8_BAR; PG8_WAIT_L(0); PG8_MMA(0, 1, At, B1); PG8_BAR;
            PG8_LDA(At, 1, 1); PG8_STAGE(PG8_SA(1, 0), a3, voffA);
            PG8_BAR; PG8_WAIT_L(0); PG8_MMA(1, 0, At, B0); PG8_BAR; PG8_SCHED;
            PG8_STAGE(PG8_SB(1, 1), b3 + hstep, voffB);
            PG8_WAIT_V(6); PG8_BAR; PG8_MMA(1, 1, At, B1); PG8_BAR;
            }
        }
        if constexpr (ALIGN_EPI) { if (wr == 0) PG8_BAR; }
        if constexpr (!Epi::AFTER_DRAIN) { E(acc, cur, wr, wc, fr, fq); S.done(cur); }
        if (!has_next) break;
#pragma unroll
        for (int a = 0; a < 2; ++a)
#pragma unroll
            for (int b = 0; b < 2; ++b)
#pragma unroll
                for (int m = 0; m < 4; ++m)
#pragma unroll
                    for (int n = 0; n < 2; ++n) acc[a][b][m][n] = (f32x4){0.f, 0.f, 0.f, 0.f};
        cur = nxt; cA = nA; cB = nB; ++ui;
        if constexpr (ALIGN_EPI) { if (wr == 1) PG8_BAR; }
    }
    PG8_WAIT_V(0);
    if constexpr (!ALIGN_EPI) { if (wr == 0) PG8_BAR; }
    PG8_BAR;
    if constexpr (Epi::AFTER_DRAIN) { E.fused(acc, cur, wr, wc, fr, fq, lds, wid, lane); S.done(cur); }
#undef PG8_SA
#undef PG8_SB
#undef PG8_STAGE
#undef PG8_LDA
#undef PG8_LDB
#undef PG8_MMA
#undef PG8_WAIT_V
#undef PG8_WAIT_L
#undef PG8_BAR
#undef PG8_SCHED
}
}

constexpr int NB = 2, T = 8192, L = 256, D = 1024, TP = T + L, R = NB * TP;
constexpr int FF = 4096, NPROJ = 3104, NPROJ_PAD = 3328, NQKV = 1536, NCH = TP / 64;
constexpr float ALPHA = 1.4142135623730951f;
constexpr int LDS_BYTES = 147456;

typedef unsigned short bf16;
typedef float f32x4 __attribute__((ext_vector_type(4)));
typedef short bf16x8 __attribute__((ext_vector_type(8)));
typedef short s16x4 __attribute__((ext_vector_type(4)));
typedef unsigned u32x4 __attribute__((ext_vector_type(4)));
typedef unsigned u32x2 __attribute__((ext_vector_type(2)));

constexpr size_t OFF_WIN = 0;
constexpr size_t OFF_WOUT0 = OFF_WIN + (size_t)NPROJ_PAD * D * 2;
constexpr size_t OFF_W1_0 = OFF_WOUT0 + (size_t)D * D * 2;
constexpr size_t OFF_W2_0 = OFF_W1_0 + (size_t)FF * D * 2;
constexpr size_t OFF_WQKV = OFF_W2_0 + (size_t)FF * D * 2;
constexpr size_t OFF_WOUT1 = OFF_WQKV + (size_t)NQKV * D * 2;
constexpr size_t OFF_W1_1 = OFF_WOUT1 + (size_t)D * D * 2;
constexpr size_t OFF_W2_1 = OFF_W1_1 + (size_t)FF * D * 2;
constexpr size_t OFF_MOD = OFF_W2_1 + (size_t)FF * D * 2;
constexpr size_t OFF_ROPE = OFF_MOD + 2 * 3 * 6144 * 4;
constexpr size_t OFF_BAR = OFF_ROPE + 128 * 16 * 8;
constexpr size_t OFF_XBAR = OFF_BAR + 256;
constexpr size_t OFF_XCTX = OFF_XBAR + 16384;
constexpr size_t OFF_DEC = OFF_XCTX + (size_t)NB * L * D * 4;
constexpr size_t OFF_H = OFF_DEC + (size_t)32 * NCH * 64 * 4;
constexpr size_t OFF_P = OFF_H + (size_t)R * D * 2;
constexpr size_t OFF_ST = OFF_P + (size_t)R * NPROJ * 2;
constexpr size_t WS_TOTAL = OFF_ST + (size_t)32 * NCH * 8192 * 2;
static_assert(WS_TOTAL <= 268435456, "workspace map exceeds 256 MiB");
static_assert(OFF_P + (size_t)R * FF * 2 <= WS_TOTAL, "MLP hidden overlay");

typedef float f32x2_t __attribute__((ext_vector_type(2)));
typedef __bf16 bf16x2_t __attribute__((ext_vector_type(2)));
__device__ __forceinline__ unsigned pk2(float lo, float hi) { const f32x2_t v = {lo, hi}; const bf16x2_t b = __builtin_convertvector(v, bf16x2_t); return __builtin_bit_cast(unsigned, b); }
__device__ __forceinline__ unsigned f2bf(float f) { return pk2(f, f) & 0xffffu; }
__device__ __forceinline__ float bf2f(unsigned h) { return __uint_as_float(h << 16); }
__device__ __forceinline__ float bflo(unsigned u) { return __uint_as_float(u << 16); }
__device__ __forceinline__ float bfhi(unsigned u) { return __uint_as_float(u & 0xffff0000u); }
__device__ __forceinline__ float wave_sum(float v) {
#pragma unroll
    for (int o = 1; o < 64; o <<= 1) v += __shfl_xor(v, o);
    return v;
}
__device__ __forceinline__ float quad_max(float x) {
    const unsigned u = __float_as_uint(x);
    const auto r = __builtin_amdgcn_permlane32_swap(u, u, false, false);
    const float m = fmaxf(__uint_as_float(r[0]), __uint_as_float(r[1]));
    const unsigned v = __float_as_uint(m);
    const auto q = __builtin_amdgcn_permlane16_swap(v, v, false, false);
    return fmaxf(__uint_as_float(q[0]), __uint_as_float(q[1]));
}
__device__ __forceinline__ float quad_sum(float x) {
    const unsigned u = __float_as_uint(x);
    const auto r = __builtin_amdgcn_permlane32_swap(u, u, false, false);
    const float m = __uint_as_float(r[0]) + __uint_as_float(r[1]);
    const unsigned v = __float_as_uint(m);
    const auto q = __builtin_amdgcn_permlane16_swap(v, v, false, false);
    return __uint_as_float(q[0]) + __uint_as_float(q[1]);
}
#define MFMA16(a, b, c) __builtin_amdgcn_mfma_f32_16x16x32_bf16((a), (b), (c), 0, 0, 0)

__device__ __forceinline__ size_t row_off(int r, bool& isc, int& b) { b = (r >= TP) ? 1 : 0; const int p = r - b * TP; isc = p < L; return isc ? (size_t)(b * L + p) * D : (size_t)(b * T + p - L) * D; }

template <int ACT> struct EpiStore {
    static constexpr bool PERM = true, AFTER_DRAIN = false;
    bf16* O; int ldc; int ncols;
    __device__ __forceinline__ void operator()(const pg8::f32x4 (&acc)[2][2][4][2], const pg8::Unit& u, int wr, int wc, int fr, int fq) const {
        const int row0 = u.pm * 256 + wr * 64 + fr, col0 = u.pn * 256 + wc * 32 + 8 * fq;
#pragma unroll
        for (int ai = 0; ai < 2; ++ai)
#pragma unroll
            for (int m = 0; m < 4; ++m) {
                bf16* rowp = O + (size_t)(row0 + ai * 128 + m * 16) * ldc;
#pragma unroll
                for (int bj = 0; bj < 2; ++bj) {
                    const int col = col0 + bj * 128;
                    pg8::f32x4 v0 = acc[ai][bj][m][0], v1 = acc[ai][bj][m][1];
                    if (ACT == 1) {
#pragma unroll
                        for (int i = 0; i < 4; ++i) { float a = fmaxf(v0[i], 0.f), b = fmaxf(v1[i], 0.f); v0[i] = a * a; v1[i] = b * b; }
                    }
                    u32x4 w; w.x = pg8::cvt_pk_bf16(v0[0], v0[1]); w.y = pg8::cvt_pk_bf16(v0[2], v0[3]); w.z = pg8::cvt_pk_bf16(v1[0], v1[1]); w.w = pg8::cvt_pk_bf16(v1[2], v1[3]);
                    if (col < ncols) *(u32x4*)(rowp + col) = w;
                }
            }
    }
};
struct EpiResid {
    static constexpr bool PERM = true, AFTER_DRAIN = false;
    const float* src_lat; const float* src_ctx; float* dst_lat; float* dst_ctx; const float* gate;
    __device__ __forceinline__ void operator()(const pg8::f32x4 (&acc)[2][2][4][2], const pg8::Unit& u, int wr, int wc, int fr, int fq) const {
        const int row0 = u.pm * 256 + wr * 64 + fr, col0 = u.pn * 256 + wc * 32 + 8 * fq;
#pragma unroll
        for (int ai = 0; ai < 2; ++ai)
#pragma unroll
            for (int m = 0; m < 4; ++m) {
                const int row = row0 + ai * 128 + m * 16;
                bool isc; int b; const size_t off = row_off(row, isc, b);
                const float* s = (isc ? src_ctx : src_lat) + off; float* d = (isc ? dst_ctx : dst_lat) + off; const float* gt = gate + (isc ? 2 : b) * 6144;
#pragma unroll
                for (int bj = 0; bj < 2; ++bj)
#pragma unroll
                    for (int n = 0; n < 2; ++n) {
                        const int col = col0 + bj * 128 + 4 * n;
                        const f32x4 x4 = *(const f32x4*)(s + col), g4 = *(const f32x4*)(gt + col);
                        const pg8::f32x4 a4 = acc[ai][bj][m][n];
                        f32x4 o; o.x = ALPHA * x4.x + g4.x * a4[0]; o.y = ALPHA * x4.y + g4.y * a4[1]; o.z = ALPHA * x4.z + g4.z * a4[2]; o.w = ALPHA * x4.w + g4.w * a4[3];
                        *(f32x4*)(d + col) = o;
                    }
            }
    }
};

__device__ __forceinline__ void transpose_item(const float* __restrict__ W, int K, int N, bf16* WT, float* scr, int item, int lane) {
    const int nblk = N / 32, kb = item / nblk, nb = item % nblk, k0 = 64 * kb, n0 = 32 * nb;
#pragma unroll 8
    for (int i = 0; i < 32; ++i) { const int kk = 2 * i + (lane >> 5); scr[kk * 33 + (lane & 31)] = W[(size_t)(k0 + kk) * N + n0 + (lane & 31)]; }
    asm volatile("s_waitcnt lgkmcnt(0)" ::: "memory");
    const int c = lane & 7;
#pragma unroll
    for (int j = 0; j < 4; ++j) { const int n = (lane >> 3) + 8 * j; const float* s = scr + (8 * c) * 33 + n;
        u32x4 o; o.x = pk2(s[0 * 33], s[1 * 33]); o.y = pk2(s[2 * 33], s[3 * 33]); o.z = pk2(s[4 * 33], s[5 * 33]); o.w = pk2(s[6 * 33], s[7 * 33]);
        *(u32x4*)(WT + (size_t)(n0 + n) * K + k0 + 8 * c) = o; }
    asm volatile("s_waitcnt lgkmcnt(0)" ::: "memory");
}

template <bool LAST, bool SKIPCTX>
__device__ __forceinline__ void ln_phase(float* xlat, float* xctx, const float* __restrict__ g, const float* __restrict__ bt, const float* __restrict__ modn, bf16* H, int gw, int NGW, int lane) {
    int r = gw;
    if (SKIPCTX) { while (r < R) { const int p = r >= TP ? r - TP : r; if (p >= L) break; r += NGW; } }
    f32x4 vn[4];
    if (r < R) { bool isc; int b; const size_t off = row_off(r, isc, b); const float* xr = (isc ? xctx : xlat) + off;
#pragma unroll
        for (int j = 0; j < 4; ++j) vn[j] = *(const f32x4*)(xr + lane * 4 + 256 * j); }
    while (r < R) {
        bool isc; int b; const size_t off = row_off(r, isc, b);
        float* xr = (isc ? xctx : xlat) + off;
        f32x4 v[4];
#pragma unroll
        for (int j = 0; j < 4; ++j) v[j] = vn[j];
        int rn = r + NGW;
        if (SKIPCTX) { while (rn < R) { const int p = rn >= TP ? rn - TP : rn; if (p >= L) break; rn += NGW; } }
        if (rn < R) { bool isc2; int b2; const size_t off2 = row_off(rn, isc2, b2); const float* xr2 = (isc2 ? xctx : xlat) + off2;
#pragma unroll
            for (int j = 0; j < 4; ++j) vn[j] = *(const f32x4*)(xr2 + lane * 4 + 256 * j); }
        float s = 0.f;
#pragma unroll
        for (int j = 0; j < 4; ++j) s += (v[j].x + v[j].y) + (v[j].z + v[j].w);
        const float mean = wave_sum(s) * (1.f / D); float s2 = 0.f;
#pragma unroll
        for (int j = 0; j < 4; ++j) { v[j] = v[j] - mean; s2 += (v[j].x * v[j].x + v[j].y * v[j].y) + (v[j].z * v[j].z + v[j].w * v[j].w); }
        const float rstd = 1.f / sqrtf(wave_sum(s2) * (1.f / D) + 1e-5f);
        const float* md = modn + (isc ? 2 : b) * 6144;
#pragma unroll
        for (int j = 0; j < 4; ++j) {
            const int idx = lane * 4 + 256 * j;
            const f32x4 gg = *(const f32x4*)(g + idx), bb = *(const f32x4*)(bt + idx);
            const f32x4 y = v[j] * rstd * gg + bb;
            *(f32x4*)(xr + idx) = y;
            if (!LAST) {
                const f32x4 sh = *(const f32x4*)(md + idx), sc = *(const f32x4*)(md + 1024 + idx);
                const f32x4 h = y * (sc + 1.f) + sh;
                u32x2 o; o.x = pk2(h.x, h.y); o.y = pk2(h.z, h.w);
                *(u32x2*)(H + (size_t)r * D + idx) = o;
            }
        }
        r = rn;
    }
}

__device__ __forceinline__ float log_sigmoid(float z) { return fminf(z, 0.f) - __logf(1.f + __expf(-fabsf(z))); }

constexpr int CS = 65;
constexpr float QSC = 0.125f * 1.4426950408889634f;
struct GatePre { u32x2 lr; f32x4 w; float bias; };
__device__ __forceinline__ GatePre gate_prefetch(int g, int h, const bf16* Pr, const float* gkw, const float* gkb, int tid) {
    GatePre p; p.lr = (u32x2){0u, 0u}; p.w = (f32x4){0.f, 0.f, 0.f, 0.f}; p.bias = 0.f;
    if (g) { const int c = tid >> 3, part = tid & 7;
        p.lr = *(const u32x2*)(Pr + (size_t)c * NPROJ + 3072 + part * 4);
        const int idx = tid * 4, dir = idx >> 10, r = (idx >> 6) & 15, d = idx & 63;
        p.w = *(const f32x4*)(gkw + (dir * 16 + r) * 256 + h * 64 + d);
        if (tid < 128) p.bias = gkb[(tid >> 6) * 256 + h * 64 + (tid & 63)]; }
    return p;
}
__device__ __forceinline__ void fill_cum3(float* cf, float* cb, float* lrs, float* wl, int g, int h, const GatePre& gp, const float* theta, int tid) {
    if (g == 0) {
        const float lgf = log1pf(-expf(theta[h])), lgb = log1pf(-expf(theta[4 + h]));
        for (int i = tid; i < 4096; i += 512) { const int c = i >> 6, d = i & 63; cf[c * CS + d] = (float)(c + 1) * lgf; cb[c * CS + d] = (float)(64 - c) * lgb; }
        __syncthreads();
        return;
    }
    { const int c = tid >> 3, part = tid & 7;
      float* lp = lrs + c * 33 + part * 4; lp[0] = bflo(gp.lr.x); lp[1] = bfhi(gp.lr.x); lp[2] = bflo(gp.lr.y); lp[3] = bfhi(gp.lr.y);
      *(f32x4*)(wl + tid * 4) = gp.w;
      if (tid < 128) wl[2048 + tid] = gp.bias; }
    __syncthreads();
    { const int c = tid >> 3, dg = tid & 7;
#pragma unroll
      for (int dir = 0; dir < 2; ++dir) {
          f32x4 za = *(const f32x4*)(wl + 2048 + dir * 64 + dg * 8), zb = *(const f32x4*)(wl + 2048 + dir * 64 + dg * 8 + 4);
#pragma unroll
          for (int r = 0; r < 16; ++r) { const float lv = lrs[c * 33 + dir * 16 + r];
              za += lv * *(const f32x4*)(wl + (dir * 16 + r) * 64 + dg * 8); zb += lv * *(const f32x4*)(wl + (dir * 16 + r) * 64 + dg * 8 + 4); }
          float* dst = (dir ? cb : cf) + c * CS + dg * 8;
#pragma unroll
          for (int j = 0; j < 4; ++j) { dst[j] = log_sigmoid(za[j]) * (1.f / 16.f); dst[4 + j] = log_sigmoid(zb[j]) * (1.f / 16.f); } } }
    __syncthreads();
    if (tid < 128) {
        const int dir = tid >> 6; float* arr = (dir ? cb : cf) + (tid & 63);
        float run = 0.f;
#pragma unroll
        for (int hh = 0; hh < 2; ++hh) {
            float v[32];
            const int base = dir ? (1 - hh) * 32 : hh * 32;
#pragma unroll
            for (int c = 0; c < 32; ++c) v[c] = arr[(base + c) * CS];
            if (dir == 0) {
#pragma unroll
                for (int c = 0; c < 32; ++c) { run += v[c]; arr[(base + c) * CS] = run; }
            } else {
#pragma unroll
                for (int c = 31; c >= 0; --c) { run += v[c]; arr[(base + c) * CS] = run; }
            }
        }
    }
    __syncthreads();
}

__device__ __forceinline__ void fast_bar(unsigned* ctr, unsigned& target) {
    asm volatile("s_waitcnt vmcnt(0)" ::: "memory");
    __syncthreads();
    target += gridDim.x;
    if (threadIdx.x == 0) {
        __builtin_amdgcn_fence(__ATOMIC_RELEASE, "agent");
        asm volatile("s_waitcnt vmcnt(0)" ::: "memory");
        __hip_atomic_fetch_add(ctr, 1u, __ATOMIC_RELAXED, __HIP_MEMORY_SCOPE_AGENT);
        while (__hip_atomic_load(ctr, __ATOMIC_RELAXED, __HIP_MEMORY_SCOPE_AGENT) < target) __builtin_amdgcn_s_sleep(1);
        __builtin_amdgcn_fence(__ATOMIC_ACQUIRE, "agent");
        asm volatile("s_waitcnt vmcnt(0)" ::: "memory");
    }
    __syncthreads();
}
#define RLX_AGENT __ATOMIC_RELAXED, __HIP_MEMORY_SCOPE_AGENT
#define XB_TMO      128
#define XB_XCNT(j)  (256  + 64 * (j))
#define XB_XSUB(j)  (1280 + 64 * (j))
#define XB_XGEN(j)  (2304 + 64 * (j))
#define XB_TOP      3328
#define XB_TOPGEN   3392
#define XCD_BAR_WORDS 3456
#define XB_SPIN_CAP (1u << 18)

__device__ __forceinline__ unsigned xb_ld(unsigned* p)              { return __hip_atomic_load(p, __ATOMIC_RELAXED, __HIP_MEMORY_SCOPE_AGENT); }
__device__ __forceinline__ unsigned xb_add(unsigned* p, unsigned v) { return __hip_atomic_fetch_add(p, v, __ATOMIC_RELAXED, __HIP_MEMORY_SCOPE_AGENT); }
__device__ __forceinline__ unsigned xb_xcc_id() { return (unsigned)__builtin_amdgcn_s_getreg((3 << 11) | 20) & 0xFu; }
#define XB_SPIN(cond, bar) do { unsigned _sp = 0; while (cond) { __builtin_amdgcn_s_sleep(1); \
    if ((++_sp & 255u) == 0u) { if (xb_ld(&(bar)[XB_TMO])) break; if (_sp > XB_SPIN_CAP) { atomicAdd(&(bar)[XB_TMO], 1u); break; } } } } while (0)

struct XcdBarrier {
    unsigned* bar; unsigned x;
    volatile unsigned* st;
};

__device__ __forceinline__ XcdBarrier xcd_barrier_post(unsigned* bar, volatile unsigned* st) {
    XcdBarrier b; b.bar = bar; b.x = xb_xcc_id(); b.st = st;
    if (threadIdx.x == 0) (void)xb_add(&bar[XB_XCNT(b.x)], 1u);
    return b;
}
__device__ __forceinline__ void xcd_barrier_complete(unsigned* bar, unsigned x, unsigned& nloc, unsigned& nx) {
    const unsigned G = gridDim.x * gridDim.y * gridDim.z;
    unsigned sum, cnt, mine, sp = 0u;
    for (;;) {
        sum = 0u; cnt = 0u; mine = 0u;
#pragma unroll
        for (unsigned j = 0; j < 16; ++j) { const unsigned c = xb_ld(&bar[XB_XCNT(j)]); sum += c; cnt += (c > 0u) ? 1u : 0u; mine = (j == x) ? c : mine; }
        if (sum == G) break;
        __builtin_amdgcn_s_sleep(1);
        if ((++sp & 255u) == 0u) { if (xb_ld(&bar[XB_TMO])) break; if (sp > XB_SPIN_CAP) { atomicAdd(&bar[XB_TMO], 1u); break; } }
    }
    nloc = mine > 0u ? mine : 1u; nx = cnt > 0u ? cnt : 1u;
}

__device__ __forceinline__ void xcd_barrier(const XcdBarrier& b) {
    asm volatile("s_waitcnt vmcnt(0)" ::: "memory");
    __syncthreads();
    if (threadIdx.x == 0) {
        unsigned* bar = b.bar;
        __builtin_amdgcn_s_waitcnt(0);
        unsigned nloc = b.st[0], nx = b.st[1];
        if (nloc == 0u) { xcd_barrier_complete(bar, b.x, nloc, nx); b.st[0] = nloc; b.st[1] = nx; }
        const unsigned old = xb_add(&bar[XB_XSUB(b.x)], 1u);
        const unsigned gen = old / nloc;
        if (old + 1u == (gen + 1u) * nloc) {
            __builtin_amdgcn_fence(__ATOMIC_RELEASE, "agent");
            asm volatile("s_waitcnt vmcnt(0)" ::: "memory");
            const unsigned og = xb_add(&bar[XB_TOP], 1u);
            const unsigned tg = og / nx;
            if (og + 1u == (tg + 1u) * nx) xb_add(&bar[XB_TOPGEN], 1u);
            else XB_SPIN(xb_ld(&bar[XB_TOPGEN]) == tg, bar);
            __builtin_amdgcn_fence(__ATOMIC_ACQUIRE, "agent");
            xb_add(&bar[XB_XGEN(b.x)], 1u);
            asm volatile("s_waitcnt vmcnt(0)" ::: "memory");
        } else {
            XB_SPIN(xb_ld(&bar[XB_XGEN(b.x)]) == gen, bar);
            __builtin_amdgcn_fence(__ATOMIC_ACQUIRE, "agent");
            asm volatile("s_waitcnt vmcnt(0)" ::: "memory");
        }
    }
    __syncthreads();
}

struct LatOrder {
    pg8::StaticOrder S;
    __device__ void init(int N, int G, int c) { S.init(NB * T, N, G, c); }
    __device__ bool next(int i, pg8::Unit& u) const { if (!S.next(i, u)) return false; u.pm = u.pm + 1 + (u.pm >= 32 ? 1 : 0); return true; }
    __device__ __forceinline__ void a_ready(const pg8::Unit&) const {}
    __device__ __forceinline__ void done(const pg8::Unit&) const {}
};
#ifndef PROBE_SEL
#define PROBE_SEL 0
#endif
#ifndef PROBE_MUL
#define PROBE_MUL 3
#endif
#define PACC_DECL unsigned long long pacc = 0, pacc_t0 = 0; (void)pacc; (void)pacc_t0;
#define PACC_BEGIN(k) if (PROBE_SEL == (k)) pacc_t0 = __builtin_amdgcn_s_memrealtime();
#define PACC_END(k) if (PROBE_SEL == (k)) pacc += __builtin_amdgcn_s_memrealtime() - pacc_t0;
#define PACC_SLEEP() if (PROBE_SEL >= 40 && PROBE_SEL < 60) { const unsigned long long t1 = __builtin_amdgcn_s_memrealtime(), dt = pacc * PROBE_MUL; while (__builtin_amdgcn_s_memrealtime() - t1 < dt) __builtin_amdgcn_s_sleep(8); }
#define PROBE_BEGIN(k) unsigned long long pt0_##k = 0; if (PROBE_SEL == (k)) pt0_##k = __builtin_amdgcn_s_memrealtime();
#define PROBE_END(k) if (PROBE_SEL == (k)) { const unsigned long long t1 = __builtin_amdgcn_s_memrealtime(), dt = (t1 - pt0_##k) * PROBE_MUL; while (__builtin_amdgcn_s_memrealtime() - t1 < dt) __builtin_amdgcn_s_sleep(8); }


template <int XT, int YT>
__device__ __forceinline__ void frag_gemm(pg8::f32x4 (&acc)[XT][YT], const bf16* X, int ldx, const bf16* Y, int ldy, int k0, int k1, int l15, int quad) {
#pragma unroll 4
    for (int k = k0; k < k1; k += 32) {
        bf16x8 xf[XT], yf[YT];
#pragma unroll
        for (int i = 0; i < XT; ++i) xf[i] = *(const bf16x8*)(X + (size_t)(i * 16 + l15) * ldx + k + quad * 8);
#pragma unroll
        for (int j = 0; j < YT; ++j) yf[j] = *(const bf16x8*)(Y + (size_t)(j * 16 + l15) * ldy + k + quad * 8);
#pragma unroll
        for (int i = 0; i < XT; ++i)
#pragma unroll
            for (int j = 0; j < YT; ++j) acc[i][j] = MFMA16(xf[i], yf[j], acc[i][j]);
    }
}
__device__ __forceinline__ void ctx_resid_tiles(const bf16* A, const bf16* Bt, int K, const float* src_ctx, float* dst_ctx, const float* gate_ctx, float* part, int bid, int G, int tid, int wave, int l15, int quad) {
    for (int t = bid; t < 256; t += G) {
        const int rt = t >> 5, c0 = (t & 31) * 32, b = rt >> 2, p0 = (rt & 3) * 64, r0 = b * TP + p0;
        pg8::f32x4 acc[4][2];
#pragma unroll
        for (int i = 0; i < 4; ++i)
#pragma unroll
            for (int j = 0; j < 2; ++j) acc[i][j] = (pg8::f32x4){0.f, 0.f, 0.f, 0.f};
        const int ksl = K >> 3;
        frag_gemm<4, 2>(acc, A + (size_t)r0 * K, K, Bt + (size_t)c0 * K, K, wave * ksl, (wave + 1) * ksl, l15, quad);
        float* pw = part + wave * 2048;
#pragma unroll
        for (int i = 0; i < 4; ++i)
#pragma unroll
            for (int j = 0; j < 2; ++j)
#pragma unroll
                for (int rg = 0; rg < 4; ++rg) pw[(i * 16 + quad * 4 + rg) * 32 + j * 16 + l15] = acc[i][j][rg];
        __syncthreads();
        { const int row = tid >> 3, c4 = (tid & 7) * 4;
          f32x4 sum = *(const f32x4*)(part + row * 32 + c4);
#pragma unroll
          for (int w = 1; w < 8; ++w) sum += *(const f32x4*)(part + w * 2048 + row * 32 + c4);
          const size_t off = (size_t)(b * L + p0 + row) * D + c0 + c4;
          const f32x4 x4 = *(const f32x4*)(src_ctx + off), g4 = *(const f32x4*)(gate_ctx + c0 + c4);
          *(f32x4*)(dst_ctx + off) = x4 * ALPHA + g4 * sum; }
        __syncthreads();
    }
}
__device__ __forceinline__ void ctx_up_tiles(const bf16* A, const bf16* Bt, bf16* O, int bid, int G, int wave, int l15, int quad) {
    for (int t = bid; t < 256; t += G) {
        const int rt = t >> 5, c0 = (t & 31) * 128 + (wave & 3) * 32, b = rt >> 2, r0 = b * TP + (rt & 3) * 64 + (wave >> 2) * 32;
        pg8::f32x4 acc[2][2];
#pragma unroll
        for (int i = 0; i < 2; ++i)
#pragma unroll
            for (int j = 0; j < 2; ++j) acc[i][j] = (pg8::f32x4){0.f, 0.f, 0.f, 0.f};
        frag_gemm<2, 2>(acc, Bt + (size_t)c0 * D, D, A + (size_t)r0 * D, D, 0, D, l15, quad);
#pragma unroll
        for (int i = 0; i < 2; ++i)
#pragma unroll
            for (int j = 0; j < 2; ++j) { float v[4];
#pragma unroll
                for (int rg = 0; rg < 4; ++rg) { const float a_ = fmaxf(acc[i][j][rg], 0.f); v[rg] = a_ * a_; }
                u32x2 o; o.x = pk2(v[0], v[1]); o.y = pk2(v[2], v[3]);
                *(u32x2*)(O + (size_t)(r0 + j * 16 + l15) * FF + c0 + i * 16 + quad * 4) = o; }
    }
}

struct Args { const float* in[19]; float* out; unsigned char* ws; };

__global__ void __launch_bounds__(512, 2) fwd_kernel(Args a) {
    extern __shared__ __attribute__((aligned(16))) unsigned char lds[];
    cg::grid_group grid = cg::this_grid();
    const int G = gridDim.x, bid = blockIdx.x, NGW = G * 8;
#define IDS int tid = threadIdx.x; asm volatile("" : "+v"(tid)); const int lane = tid & 63, wave = __builtin_amdgcn_readfirstlane(tid >> 6), quad = lane >> 4, l15 = lane & 15, gw = bid * 8 + wave; (void)quad; (void)l15; (void)gw; (void)lane;
#define xin (a.in[0])
#define cvec (a.in[1])
#define ctx (a.in[2])
#define cctx (a.in[3])
#define w_mod (a.in[4])
#define b_mod (a.in[5])
#define ln_g (a.in[6])
#define ln_b (a.in[7])
#define theta (a.in[11])
#define gkw (a.in[12])
#define gkb (a.in[13])
#define normg (a.in[14])
#define sink (a.in[17])
#define WIN_T ((bf16*)(a.ws + OFF_WIN))
#define WOUT0_T ((bf16*)(a.ws + OFF_WOUT0))
#define W1_0_T ((bf16*)(a.ws + OFF_W1_0))
#define W2_0_T ((bf16*)(a.ws + OFF_W2_0))
#define WQKV_T ((bf16*)(a.ws + OFF_WQKV))
#define WOUT1_T ((bf16*)(a.ws + OFF_WOUT1))
#define W1_1_T ((bf16*)(a.ws + OFF_W1_1))
#define W2_1_T ((bf16*)(a.ws + OFF_W2_1))
#define mod ((float*)(a.ws + OFF_MOD))
#define rope ((float*)(a.ws + OFF_ROPE))
#define xctx ((float*)(a.ws + OFF_XCTX))
#define DEC ((float*)(a.ws + OFF_DEC))
#define H ((bf16*)(a.ws + OFF_H))
#define P ((bf16*)(a.ws + OFF_P))
#define ST ((bf16*)(a.ws + OFF_ST))
#define xlat (a.out)

#define LATE_ITEMS 9472
#define LATE_CHUNK 16
#define DRAIN_LATE(scr_, maxc_) do { int nclaim_ = 0; unsigned* qc_ = (unsigned*)(a.ws + OFF_XBAR) + 3584; volatile unsigned* qw_ = (volatile unsigned*)(lds + 131072 + 1024); \
        for (;;) { if (nclaim_++ >= (maxc_)) break; if (tid == 0) qw_[0] = __hip_atomic_fetch_add(qc_, (unsigned)LATE_CHUNK, __ATOMIC_RELAXED, __HIP_MEMORY_SCOPE_AGENT);     \
            __syncthreads(); const int base_ = (int)__builtin_amdgcn_readfirstlane(qw_[0]); __syncthreads(); \
            if (base_ >= LATE_ITEMS) break; \
            for (int k_ = wave; k_ < LATE_CHUNK; k_ += 8) { int r_ = base_ + k_; if (r_ >= LATE_ITEMS) break; \
                if (r_ < 2048) { transpose_item(a.in[8], 1024, FF, W1_0_T, (scr_), r_, lane); continue; } r_ -= 2048; \
                if (r_ < 2048) { transpose_item(a.in[9], FF, 1024, W2_0_T, (scr_), r_, lane); continue; } r_ -= 2048; \
                if (r_ < 768) { transpose_item(a.in[16], 1024, NQKV, WQKV_T, (scr_), r_, lane); continue; } r_ -= 768; \
                if (r_ < 512) { transpose_item(a.in[18], 1024, 1024, WOUT1_T, (scr_), r_, lane); continue; } r_ -= 512; \
                if (r_ < 2048) { transpose_item(a.in[8] + (size_t)1024 * FF, 1024, FF, W1_1_T, (scr_), r_, lane); continue; } r_ -= 2048; \
                transpose_item(a.in[9] + (size_t)FF * 1024, FF, 1024, W2_1_T, (scr_), r_, lane); } } } while (0)

#define MOD_ITEM(item_) do { float* sl_ = (float*)lds; float* red_ = (float*)(lds + 12288); \
        for (int i_ = tid; i_ < 3072; i_ += 512) { const int j_ = i_ >> 10, k_ = i_ & 1023; const float v_ = (j_ < 2) ? cvec[j_ * 1024 + k_] : cctx[k_]; sl_[i_] = v_ / (1.f + expf(-v_)); } \
        __syncthreads(); \
        const int layer_ = (item_) / 192, n0_ = ((item_) % 192) * 32, c_ = lane & 31, kh_ = lane >> 5; \
        const float* W_ = w_mod + (size_t)layer_ * 1024 * 6144 + n0_ + c_; \
        float a0_ = 0.f, a1_ = 0.f, a2_ = 0.f; \
        _Pragma("unroll 8") for (int i_ = 0; i_ < 64; ++i_) { const int k_ = wave * 128 + 2 * i_ + kh_; const float w_ = W_[(size_t)k_ * 6144]; a0_ += sl_[k_] * w_; a1_ += sl_[1024 + k_] * w_; a2_ += sl_[2048 + k_] * w_; } \
        a0_ += __shfl_xor(a0_, 32); a1_ += __shfl_xor(a1_, 32); a2_ += __shfl_xor(a2_, 32); \
        if (lane < 32) { red_[(wave * 3 + 0) * 32 + lane] = a0_; red_[(wave * 3 + 1) * 32 + lane] = a1_; red_[(wave * 3 + 2) * 32 + lane] = a2_; } \
        __syncthreads(); \
        if (tid < 96) { const int j_ = tid >> 5, col_ = tid & 31; float s_ = b_mod[layer_ * 6144 + n0_ + col_]; \
            _Pragma("unroll") for (int w_ = 0; w_ < 8; ++w_) s_ += red_[(w_ * 3 + j_) * 32 + col_]; \
            mod[(layer_ * 3 + j_) * 6144 + n0_ + col_] = s_; } \
        __syncthreads(); } while (0)
#define DRAIN_MOD1(maxc_) do { int nclaim_ = 0; unsigned* qc_ = (unsigned*)(a.ws + OFF_XBAR) + 3648; volatile unsigned* qw_ = (volatile unsigned*)(lds + 131072 + 1024); \
        for (;;) { if (nclaim_++ >= (maxc_)) break; if (tid == 0) qw_[0] = __hip_atomic_fetch_add(qc_, 1u, __ATOMIC_RELAXED, __HIP_MEMORY_SCOPE_AGENT); \
            __syncthreads(); const int it_ = (int)__builtin_amdgcn_readfirstlane(qw_[0]); __syncthreads(); \
            if (it_ >= 192) break; MOD_ITEM(192 + it_); } } while (0)
    PG8_LAS unsigned char* ldsg = (PG8_LAS unsigned char*)lds;
    unsigned* barw = (unsigned*)(a.ws + OFF_BAR); unsigned bar_target = 0u; (void)barw; (void)bar_target;
    unsigned* xbw = (unsigned*)(a.ws + OFF_XBAR);
    volatile unsigned* xst = (volatile unsigned*)(lds + 131072 + 512);
    if (threadIdx.x == 0) { xst[0] = 0u; xst[1] = 0u; }
    XcdBarrier xbar = xcd_barrier_post(xbw, xst);
    if (a.ws == nullptr) grid.sync();

PROBE_BEGIN(1)
    { IDS
        for (int item = bid; item < 192; item += G) MOD_ITEM(item);
        if (bid == G - 1 && tid < 16) {
            double f = 1.0; for (int i = 0; i < tid; ++i) f *= 0.56234132519034908;
            const double x2 = f * f; double cs = 1.0, sn = f, tc = 1.0, ts = f;
            for (int n = 1; n <= 12; ++n) { tc *= -x2 / (double)((2 * n - 1) * (2 * n)); cs += tc; ts *= -x2 / (double)((2 * n) * (2 * n + 1)); sn += ts; }
            double c = 1.0, s = 0.0;
            for (int p = 0; p < 128; ++p) { rope[(p * 16 + tid) * 2] = (float)c; rope[(p * 16 + tid) * 2 + 1] = (float)s; const double nc = c * cs - s * sn; s = s * cs + c * sn; c = nc; }
        }
        float* scr = (float*)(lds + 32768 + wave * 8448);
        for (int it = gw; it < 2064; it += NGW) {
            int r = it;
            if (r < 1552) { transpose_item(a.in[10], 1024, NPROJ, WIN_T, scr, r, lane); continue; } r -= 1552;
            transpose_item(a.in[15], 1024, 1024, WOUT0_T, scr, r, lane);
        }
        { u32x4* z = (u32x4*)(WIN_T + (size_t)NPROJ * D); const u32x4 zero = {0u, 0u, 0u, 0u};
          for (int i = bid * 512 + tid; i < (NPROJ_PAD - NPROJ) * D / 8; i += G * 512) z[i] = zero; }
    }
PROBE_END(1)
    xcd_barrier(xbar);


PROBE_BEGIN(2)
    { IDS
    for (int r = gw; r < R; r += 2 * NGW) {
        const int r2 = r + NGW; const bool has2 = r2 < R;
        bool isc, isc2; int b, b2; const size_t off = row_off(r, isc, b), off2 = row_off(has2 ? r2 : r, isc2, b2);
        const float* xr = (isc ? ctx : xin) + off; const float* md = mod + (isc ? 2 : b) * 6144;
        const float* xr2 = (isc2 ? ctx : xin) + off2; const float* md2 = mod + (isc2 ? 2 : b2) * 6144;
        f32x4 va[4], vb[4];
#pragma unroll
        for (int j = 0; j < 4; ++j) { va[j] = *(const f32x4*)(xr + lane * 4 + 256 * j); vb[j] = *(const f32x4*)(xr2 + lane * 4 + 256 * j); }
#pragma unroll
        for (int j = 0; j < 4; ++j) {
            const int idx = lane * 4 + 256 * j;
            { const f32x4 sh = *(const f32x4*)(md + idx), sc = *(const f32x4*)(md + 1024 + idx);
              const f32x4 h = va[j] * (sc + 1.f) + sh; u32x2 o; o.x = pk2(h.x, h.y); o.y = pk2(h.z, h.w);
              *(u32x2*)(H + (size_t)r * D + idx) = o; }
            if (has2) { const f32x4 sh = *(const f32x4*)(md2 + idx), sc = *(const f32x4*)(md2 + 1024 + idx);
              const f32x4 h = vb[j] * (sc + 1.f) + sh; u32x2 o; o.x = pk2(h.x, h.y); o.y = pk2(h.z, h.w);
              *(u32x2*)(H + (size_t)r2 * D + idx) = o; }
        }
    }
    }
PROBE_END(2)
    xcd_barrier(xbar);
    if (PROBE_SEL == 10) { for (int i = 0; i < 10; ++i) xcd_barrier(xbar); }

PROBE_BEGIN(8)
    { pg8::Gemm g{H, WIN_T, R, NPROJ_PAD, D}; pg8::StaticOrder S; S.init(R, NPROJ_PAD, G, bid); EpiStore<0> E{P, NPROJ, NPROJ};
      pg8::gemm_phase<EpiStore<0>, pg8::StaticOrder, true, true>(ldsg, g, S, E); }
    { IDS
      constexpr int NU2 = (R / 256) * (NPROJ_PAD / 256);
      if ((NU2 - bid + G - 1) / G < (NU2 + G - 1) / G) DRAIN_MOD1(2); }
PROBE_END(8)
    xcd_barrier(xbar);

PROBE_BEGIN(3)
#ifndef NO_P3
    { IDS
        float* cf = (float*)lds; float* cb = (float*)(lds + 16640); float* lrs = (float*)(lds + 33280); float* wl = (float*)(lds + 41728);
        bf16* kTf = (bf16*)(lds + 50432); bf16* kTb = (bf16*)(lds + 59648); bf16* vT = (bf16*)(lds + 68864);
        constexpr int NU = NB * 2 * 4 * NCH;
        const int s = tid & 63, dc = tid >> 6;
        u32x4 kv = {0u, 0u, 0u, 0u}, vv0 = kv, vv1 = kv; GatePre gp; gp.lr = (u32x2){0u, 0u}; gp.w = (f32x4){0.f, 0.f, 0.f, 0.f}; gp.bias = 0.f;
#define P3_LOAD(U) do { const int pc_ = (U) % NCH, t_ = (U) / NCH, h_ = t_ & 3, g_ = (t_ >> 2) & 1, b_ = t_ >> 3; const bf16* Pr_ = P + (size_t)(b_ * TP + pc_ * 64) * NPROJ; \
            const int kcol_ = g_ ? 1792 + h_ * 64 : 256 + h_ * 64, vcol_ = g_ ? 2048 + h_ * 128 : 512 + h_ * 128; \
            kv = *(const u32x4*)(Pr_ + (size_t)s * NPROJ + kcol_ + dc * 8); vv0 = *(const u32x4*)(Pr_ + (size_t)s * NPROJ + vcol_ + dc * 8); vv1 = *(const u32x4*)(Pr_ + (size_t)s * NPROJ + vcol_ + (dc + 8) * 8); \
            gp = gate_prefetch(g_, h_, Pr_, gkw, gkb, tid); } while (0)
        if (bid < NU) P3_LOAD(bid);
        for (int unit = bid; unit < NU; unit += G) {
            const int pc = unit % NCH, t = unit / NCH, h = t & 3, g = (t >> 2) & 1, b = t >> 3;
            const float kscale = g ? 1.f : 0.125f;
            fill_cum3(cf, cb, lrs, wl, g, h, gp, theta, tid);
            {
#pragma unroll
              for (int j = 0; j < 8; ++j) { const int d = dc * 8 + j; const unsigned u = kv[j >> 1]; const float kf = ((j & 1) ? bfhi(u) : bflo(u)) * kscale;
                  kTf[d * 72 + s] = (bf16)f2bf(kf * __expf(cf[63 * CS + d] - cf[s * CS + d]));
                  kTb[d * 72 + s] = (bf16)f2bf(kf * __expf(cb[d] - cb[s * CS + d])); }
#pragma unroll
              for (int j = 0; j < 8; ++j) { const unsigned u0 = vv0[j >> 1], u1 = vv1[j >> 1];
                  vT[(dc * 8 + j) * 72 + s] = (bf16)((j & 1) ? (u0 >> 16) : (u0 & 0xffffu)); vT[((dc + 8) * 8 + j) * 72 + s] = (bf16)((j & 1) ? (u1 >> 16) : (u1 & 0xffffu)); }
            }
            const int seq0 = ((b * 2 + g) * 4 + h) * 2;
            const int nf = pc, nbk = (pc < 4) ? 3 - pc : 135 - pc;
            if (tid < 128) { const int dir = tid >> 6, d = tid & 63;
                DEC[((size_t)(seq0 + dir) * NCH + (dir ? nbk : nf)) * 64 + d] = dir ? expf(cb[d]) : expf(cf[63 * CS + d]); }
            if (unit + G < NU) P3_LOAD(unit + G);
            __syncthreads();
            bf16x8 bfr[2];
#pragma unroll
            for (int ks = 0; ks < 2; ++ks) bfr[ks] = *(const bf16x8*)(vT + (wave * 16 + l15) * 72 + ks * 32 + quad * 8);
#pragma unroll
            for (int dir = 0; dir < 2; ++dir) {
                const bf16* kT = dir ? kTb : kTf;
                bf16* dst = ST + ((size_t)(seq0 + dir) * NCH + (dir ? nbk : nf)) * 8192 + (size_t)(wave * 16 + l15) * 64;
#pragma unroll
                for (int dt = 0; dt < 4; ++dt) {
                    pg8::f32x4 acc = {0.f, 0.f, 0.f, 0.f};
#pragma unroll
                    for (int ks = 0; ks < 2; ++ks) { const bf16x8 af = *(const bf16x8*)(kT + (dt * 16 + l15) * 72 + ks * 32 + quad * 8); acc = MFMA16(af, bfr[ks], acc); }
                    u32x2 o; o.x = pk2(acc[0], acc[1]); o.y = pk2(acc[2], acc[3]);
                    *(u32x2*)(dst + dt * 16 + quad * 4) = o;
                }
            }
            __syncthreads();
        }
#undef P3_LOAD
        if ((NU - bid + G - 1) / G < (NU + G - 1) / G) DRAIN_LATE((float*)(lds + wave * 8448), 1);
    }
#endif
PROBE_END(3)
    xcd_barrier(xbar);

PROBE_BEGIN(4)
    { IDS
    for (int i = bid * 512 + tid; i < 32 * 4096; i += G * 512) {
        const int seq = i >> 12, pi = i & 4095, d = (2 * pi) & 63;
        unsigned* sp = (unsigned*)(ST + (size_t)seq * NCH * 8192) + pi; const float* dp = DEC + (size_t)seq * NCH * 64 + d;
        float s0 = 0.f, s1 = 0.f;
#pragma unroll 4
        for (int n = 0; n < NCH; ++n) {
            const unsigned kv = sp[(size_t)n * 4096]; const float d0 = dp[n * 64], d1 = dp[n * 64 + 1];
            sp[(size_t)n * 4096] = pk2(s0, s1);
            s0 = d0 * s0 + bflo(kv); s1 = d1 * s1 + bfhi(kv);
        }
    }
    }
PROBE_END(4)
    xcd_barrier(xbar);

PROBE_BEGIN(5)
#ifndef NO_P5
    { IDS
        float* cf = (float*)lds; float* cb = (float*)(lds + 16640); float* lrs = (float*)(lds + 33280); float* wl = (float*)(lds + 41728);
        bf16* qdf = (bf16*)(lds + 50432); bf16* kif = (bf16*)(lds + 59648); bf16* qdb = (bf16*)(lds + 68864); bf16* kib = (bf16*)(lds + 78080);
        bf16* vT = (bf16*)(lds + 87296); bf16* Am = (bf16*)(lds + 105728); float* red = (float*)(lds + 114944);
        constexpr int NU = NB * 2 * 4 * NCH;
        const int dcq = tid & 7, sq = tid >> 3, sv = tid & 63, dcv = tid >> 6;
        u32x4 qv = {0u, 0u, 0u, 0u}, kv = qv, vv0 = qv, vv1 = qv; GatePre gp; gp.lr = (u32x2){0u, 0u}; gp.w = (f32x4){0.f, 0.f, 0.f, 0.f}; gp.bias = 0.f;
#define P5_LOAD(U) do { const int pc_ = (U) % NCH, t_ = (U) / NCH, h_ = t_ & 3, g_ = (t_ >> 2) & 1, b_ = t_ >> 3; const bf16* Pr_ = P + (size_t)(b_ * TP + pc_ * 64) * NPROJ; \
            const int qcol_ = g_ ? 1536 + h_ * 64 : h_ * 64, kcol_ = g_ ? 1792 + h_ * 64 : 256 + h_ * 64, vcol_ = g_ ? 2048 + h_ * 128 : 512 + h_ * 128; \
            qv = *(const u32x4*)(Pr_ + (size_t)sq * NPROJ + qcol_ + dcq * 8); kv = *(const u32x4*)(Pr_ + (size_t)sq * NPROJ + kcol_ + dcq * 8); \
            vv0 = *(const u32x4*)(Pr_ + (size_t)sv * NPROJ + vcol_ + dcv * 8); vv1 = *(const u32x4*)(Pr_ + (size_t)sv * NPROJ + vcol_ + (dcv + 8) * 8); \
            gp = gate_prefetch(g_, h_, Pr_, gkw, gkb, tid); } while (0)
        if (bid < NU) P5_LOAD(bid);
        for (int unit = bid; unit < NU; unit += G) {
            const int pc = unit % NCH, t = unit / NCH, h = t & 3, g = (t >> 2) & 1, b = t >> 3;
            const int r0 = b * TP + pc * 64;
            const int gcol = g ? 2560 + h * 128 : 1024 + h * 128;
            const float qscale = g ? 0.125f : 1.f, kscale = g ? 1.f : 0.125f;
            fill_cum3(cf, cb, lrs, wl, g, h, gp, theta, tid);
            { u32x4 o1, o2, o3, o4;
#pragma unroll
              for (int j2 = 0; j2 < 4; ++j2) {
                  const int d = dcq * 8 + 2 * j2;
                  const float f0 = cf[sq * CS + d], f1 = cf[sq * CS + d + 1], b0 = cb[sq * CS + d], b1 = cb[sq * CS + d + 1];
                  const float q0 = bflo(qv[j2]) * qscale, q1 = bfhi(qv[j2]) * qscale, k0 = bflo(kv[j2]) * kscale, k1 = bfhi(kv[j2]) * kscale;
                  o1[j2] = pk2(q0 * __expf(f0), q1 * __expf(f1)); o2[j2] = pk2(k0 * __expf(-f0), k1 * __expf(-f1));
                  o3[j2] = pk2(q0 * __expf(b0), q1 * __expf(b1)); o4[j2] = pk2(k0 * __expf(-b0), k1 * __expf(-b1));
              }
              *(u32x4*)(qdf + sq * 72 + dcq * 8) = o1; *(u32x4*)(kif + sq * 72 + dcq * 8) = o2; *(u32x4*)(qdb + sq * 72 + dcq * 8) = o3; *(u32x4*)(kib + sq * 72 + dcq * 8) = o4;
#pragma unroll
              for (int j = 0; j < 8; ++j) { const unsigned u0 = vv0[j >> 1], u1 = vv1[j >> 1];
                  vT[(dcv * 8 + j) * 72 + sv] = (bf16)((j & 1) ? (u0 >> 16) : (u0 & 0xffffu)); vT[((dcv + 8) * 8 + j) * 72 + sv] = (bf16)((j & 1) ? (u1 >> 16) : (u1 & 0xffffu)); }
            }
            __syncthreads();
            const int ct = wave & 3, eh = wave >> 2;
            const int seq0 = ((b * 2 + g) * 4 + h) * 2;
            const int nf = pc, nbk = (pc < 4) ? 3 - pc : 135 - pc;
            const bf16* Sf = ST + ((size_t)seq0 * NCH + nf) * 8192; const bf16* Sb = ST + ((size_t)(seq0 + 1) * NCH + nbk) * 8192;
            const int r = r0 + ct * 16 + l15;
            bf16x8 a2[4][2], a3[4][2]; u32x2 gv[4];
#pragma unroll
            for (int et = 0; et < 4; ++et) { const int e = (eh * 4 + et) * 16 + l15;
#pragma unroll
                for (int ks = 0; ks < 2; ++ks) { a2[et][ks] = *(const bf16x8*)(Sf + e * 64 + ks * 32 + quad * 8); a3[et][ks] = *(const bf16x8*)(Sb + e * 64 + ks * 32 + quad * 8); }
                gv[et] = *(const u32x2*)(P + (size_t)r * NPROJ + gcol + (eh * 4 + et) * 16 + quad * 4); }
            { bf16x8 af[2], ab[2];
#pragma unroll
              for (int ks = 0; ks < 2; ++ks) { af[ks] = *(const bf16x8*)(qdf + (ct * 16 + l15) * 72 + ks * 32 + quad * 8); ab[ks] = *(const bf16x8*)(qdb + (ct * 16 + l15) * 72 + ks * 32 + quad * 8); }
#pragma unroll
              for (int i = 0; i < 2; ++i) { const int st = (wave >> 2) * 2 + i;
                  pg8::f32x4 accf = {0.f, 0.f, 0.f, 0.f}, accb = {0.f, 0.f, 0.f, 0.f};
#pragma unroll
                  for (int ks = 0; ks < 2; ++ks) {
                      const bf16x8 bf_ = *(const bf16x8*)(kif + (st * 16 + l15) * 72 + ks * 32 + quad * 8), bb_ = *(const bf16x8*)(kib + (st * 16 + l15) * 72 + ks * 32 + quad * 8);
                      accf = MFMA16(af[ks], bf_, accf); accb = MFMA16(ab[ks], bb_, accb); }
                  const int scol = st * 16 + l15;
#pragma unroll
                  for (int rg = 0; rg < 4; ++rg) { const int c = ct * 16 + quad * 4 + rg; Am[c * 72 + scol] = (bf16)f2bf(scol <= c ? accf[rg] : accb[rg]); }
              }
            }
            if (unit + G < NU) P5_LOAD(unit + G);
            __syncthreads();
            { bf16x8 bA[2], bQf[2], bQb[2];
#pragma unroll
              for (int ks = 0; ks < 2; ++ks) { const int o = (ct * 16 + l15) * 72 + ks * 32 + quad * 8; bA[ks] = *(const bf16x8*)(Am + o); bQf[ks] = *(const bf16x8*)(qdf + o); bQb[ks] = *(const bf16x8*)(qdb + o); }
              pg8::f32x4 acc[4]; float ss = 0.f;
#pragma unroll
              for (int et = 0; et < 4; ++et) { const int e = (eh * 4 + et) * 16 + l15;
                  pg8::f32x4 c4 = {0.f, 0.f, 0.f, 0.f};
#pragma unroll
                  for (int ks = 0; ks < 2; ++ks) {
                      const bf16x8 a1 = *(const bf16x8*)(vT + e * 72 + ks * 32 + quad * 8);
                      c4 = MFMA16(a1, bA[ks], c4); c4 = MFMA16(a2[et][ks], bQf[ks], c4); c4 = MFMA16(a3[et][ks], bQb[ks], c4); }
                  acc[et] = c4; ss += (c4[0] * c4[0] + c4[1] * c4[1]) + (c4[2] * c4[2] + c4[3] * c4[3]); }
              ss = quad_sum(ss);
              if (quad == 0) red[eh * 64 + ct * 16 + l15] = ss;
              __syncthreads();
              const float tot = red[ct * 16 + l15] + red[64 + ct * 16 + l15];
              const float rinv = 1.f / sqrtf(tot * (1.f / 128.f) + 1e-6f);
#pragma unroll
              for (int et = 0; et < 4; ++et) { const int e0 = (eh * 4 + et) * 16 + quad * 4;
                  float gt[4] = {bflo(gv[et].x), bfhi(gv[et].x), bflo(gv[et].y), bfhi(gv[et].y)}; float y[4];
#pragma unroll
                  for (int i = 0; i < 4; ++i) { const float ng = g ? normg[e0 + i] : 1.f; const float sg = gt[i] * __builtin_amdgcn_rcpf(1.f + __expf(-gt[i])); y[i] = sg * acc[et][i] * rinv * ng; }
                  u32x2 o; o.x = pk2(y[0], y[1]); o.y = pk2(y[2], y[3]);
                  *(u32x2*)(H + (size_t)r * D + g * 512 + h * 128 + e0) = o; }
            }
            __syncthreads();
        }
#undef P5_LOAD
        if ((NU - bid + G - 1) / G < (NU + G - 1) / G) DRAIN_LATE((float*)(lds + wave * 8448), 2);
    }
#endif
PROBE_END(5)
    xcd_barrier(xbar);

PROBE_BEGIN(12)
    { pg8::Gemm g{H, WOUT0_T, R, D, D}; LatOrder S; S.init(D, G, bid); EpiResid E{xin, ctx, xlat, xctx, mod + 2 * 1024};
      pg8::gemm_phase<EpiResid, LatOrder, true, true>(ldsg, g, S, E); }
    { IDS
      ctx_resid_tiles(H, WOUT0_T, D, ctx, xctx, mod + 2 * 6144 + 2 * 1024, (float*)lds, bid, G, tid, wave, l15, quad); }
PROBE_END(12)
    xcd_barrier(xbar);
PROBE_BEGIN(7)
    { IDS
    DRAIN_MOD1(1 << 30);
    DRAIN_LATE((float*)(lds + wave * 8448), 1 << 30);
    ln_phase<false, false>(xlat, xctx, ln_g, ln_b, mod + 3 * 1024, H, gw, NGW, lane);
    }
PROBE_END(7)
    xcd_barrier(xbar);
PROBE_BEGIN(11)
    { pg8::Gemm g{H, W1_0_T, R, FF, D}; LatOrder S; S.init(FF, G, bid); EpiStore<1> E{P, FF, FF};
      pg8::gemm_phase<EpiStore<1>, LatOrder, true, true>(ldsg, g, S, E); }
    { IDS
      ctx_up_tiles(H, W1_0_T, P, bid, G, wave, l15, quad); }
PROBE_END(11)
    xcd_barrier(xbar);
PROBE_BEGIN(9)
    { pg8::Gemm g{P, W2_0_T, R, D, FF}; LatOrder S; S.init(D, G, bid); EpiResid E{xlat, xctx, xlat, xctx, mod + 5 * 1024};
      pg8::gemm_phase<EpiResid, LatOrder, true, true>(ldsg, g, S, E); }
    { IDS
      ctx_resid_tiles(P, W2_0_T, FF, xctx, xctx, mod + 2 * 6144 + 5 * 1024, (float*)lds, bid, G, tid, wave, l15, quad); }
PROBE_END(9)
    xcd_barrier(xbar);
    { IDS
    ln_phase<false, false>(xlat, xctx, ln_g + 1024, ln_b + 1024, mod + 3 * 6144, H, gw, NGW, lane);
    }
    xcd_barrier(xbar);

PROBE_BEGIN(13)
    { pg8::Gemm g{H, WQKV_T, R, NQKV, D}; pg8::StaticOrder S; S.init(R, NQKV, G, bid); EpiStore<0> E{P, NQKV, NQKV};
      pg8::gemm_phase<EpiStore<0>, pg8::StaticOrder, true, true>(ldsg, g, S, E); }
PROBE_END(13)
    xcd_barrier(xbar);

PROBE_BEGIN(6)
#ifndef NO_P12
    { IDS
        bf16* Qs = (bf16*)lds; bf16* Ks = (bf16*)(lds + 73728); bf16* Vt = (bf16*)(lds + 82944); float* ropes = (float*)(lds + 92160);
        for (int i = tid; i < 1024; i += 512) ((f32x4*)ropes)[i] = ((const f32x4*)rope)[i];
        PACC_DECL
        for (int unit = bid; unit < NB * 4 * 64; unit += G) {
            PACC_BEGIN(40)
            const int nb = unit & 63, kvh = (unit >> 6) & 3, b = unit >> 8;
#define ATT_VALID(t) ((t) < 4 || (unsigned)(nb - 1 + (((t) - 4) >> 1)) < 64u)
#define ATT_KPOS(t) ((nb - 1 + (((t) - 4) >> 1)) * 128 + (((t) - 4) & 1) * 64)
#define ATT_KROW(t) ((t) < 4 ? b * TP + (t) * 64 : b * TP + L + ATT_KPOS(t))
            const int keyk = tid >> 2, pck = tid & 3, c1k = (pck & 1) + (pck >> 1) * 4, keyv = tid & 63, dcv = tid >> 6;
            u32x4 pk1 = {0u, 0u, 0u, 0u}, pk2_ = pk1, pvv = pk1;
#define ATT_LOAD(t) do { const int kr_ = ATT_KROW(t); \
                if (tid < 256) { const bf16* src_ = P + (size_t)(kr_ + keyk) * NQKV + 1024 + kvh * 64; pk1 = *(const u32x4*)(src_ + c1k * 8); pk2_ = *(const u32x4*)(src_ + (c1k + 2) * 8); } \
                pvv = *(const u32x4*)(P + (size_t)(kr_ + keyv) * NQKV + 1280 + kvh * 64 + dcv * 8); } while (0)
            ATT_LOAD(0);
            __syncthreads();
#pragma unroll
            for (int i = 0; i < 4; ++i) {
                const int it = tid + i * 512, pcq = it & 3, row = it >> 2, g = row >> 7, qi = row & 127, pos = nb * 128 + qi;
                const bf16* src = P + (size_t)(b * TP + L + pos) * NQKV + (kvh * 4 + g) * 64;
                const int c1 = (pcq & 1) + (pcq >> 1) * 4;
                const u32x4 u1 = *(const u32x4*)(src + c1 * 8), u2 = *(const u32x4*)(src + (c1 + 2) * 8);
                const int pv = (pcq < 2) ? (pos >> 6) : (pos & 63);
                const f32x4* tab = (const f32x4*)(ropes + (pv * 16 + (c1 & 1) * 8) * 2);
                u32x4 o1, o2;
#pragma unroll
                for (int j2 = 0; j2 < 4; ++j2) { const f32x4 cs = tab[j2];
                    const float a0 = bflo(u1[j2]), a1 = bfhi(u1[j2]), b0 = bflo(u2[j2]), b1 = bfhi(u2[j2]);
                    o1[j2] = pk2((a0 * cs.x - b0 * cs.y) * QSC, (a1 * cs.z - b1 * cs.w) * QSC); o2[j2] = pk2((a0 * cs.y + b0 * cs.x) * QSC, (a1 * cs.w + b1 * cs.z) * QSC); }
                *(u32x4*)(Qs + row * 72 + c1 * 8) = o1; *(u32x4*)(Qs + row * 72 + (c1 + 2) * 8) = o2;
            }
            const int g = wave >> 1, qrow0 = g * 128 + (wave & 1) * 64, qpos0 = nb * 128 + (wave & 1) * 64;
            float mrun[4], lrun[4]; pg8::f32x4 O[4][4];
            const float sk = sink[kvh * 4 + g] * 1.4426950408889634f;
#pragma unroll
            for (int qt = 0; qt < 4; ++qt) { mrun[qt] = sk; lrun[qt] = (quad == 0) ? 1.f : 0.f;
#pragma unroll
                for (int dt = 0; dt < 4; ++dt) O[dt][qt] = (pg8::f32x4){0.f, 0.f, 0.f, 0.f}; }
            PACC_END(40)
            int ti = 0;
            while (ti < 10) {
                PACC_BEGIN(41)
                const bool local = ti >= 4;
                const int kpos0 = local ? ATT_KPOS(ti) : 0;
                const int side = local ? ((ti - 4) >> 1) - 1 : 0;
                __syncthreads();
                if (tid < 256) {
                    u32x4 o1 = pk1, o2 = pk2_;
                    if (local) {
                        const int pos = kpos0 + keyk, pv = (pck < 2) ? (pos >> 6) : (pos & 63);
                        const f32x4* tab = (const f32x4*)(ropes + (pv * 16 + (c1k & 1) * 8) * 2);
#pragma unroll
                        for (int j2 = 0; j2 < 4; ++j2) { const f32x4 cs = tab[j2];
                            const float a0 = bflo(pk1[j2]), a1 = bfhi(pk1[j2]), b0 = bflo(pk2_[j2]), b1 = bfhi(pk2_[j2]);
                            o1[j2] = pk2(a0 * cs.x - b0 * cs.y, a1 * cs.z - b1 * cs.w); o2[j2] = pk2(a0 * cs.y + b0 * cs.x, a1 * cs.w + b1 * cs.z); }
                    }
                    *(u32x4*)(Ks + keyk * 72 + c1k * 8) = o1; *(u32x4*)(Ks + keyk * 72 + (c1k + 2) * 8) = o2;
                }
#pragma unroll
                for (int j = 0; j < 8; ++j) { const unsigned u = pvv[j >> 1]; Vt[(dcv * 8 + j) * 72 + keyv] = (bf16)((j & 1) ? (u >> 16) : (u & 0xffffu)); }
                __syncthreads();
                PACC_END(41)
                PACC_BEGIN(42)
                int tn = ti + 1;
                while (tn < 10 && !ATT_VALID(tn)) ++tn;
                if (tn < 10) ATT_LOAD(tn);
                bf16x8 kfr[4][2];
#pragma unroll
                for (int kt = 0; kt < 4; ++kt)
#pragma unroll
                    for (int ks = 0; ks < 2; ++ks) kfr[kt][ks] = *(const bf16x8*)(Ks + (kt * 16 + l15) * 72 + ks * 32 + quad * 8);
#pragma unroll
                for (int qt = 0; qt < 4; ++qt) {
                    pg8::f32x4 S[4];
#pragma unroll
                    for (int kt = 0; kt < 4; ++kt) S[kt] = (pg8::f32x4){0.f, 0.f, 0.f, 0.f};
#pragma unroll
                    for (int ks = 0; ks < 2; ++ks) { const bf16x8 qf = *(const bf16x8*)(Qs + (qrow0 + qt * 16 + l15) * 72 + ks * 32 + quad * 8);
#pragma unroll
                        for (int kt = 0; kt < 4; ++kt) S[kt] = MFMA16(kfr[kt][ks], qf, S[kt]); }
                    float mx = -INFINITY;
                    if (side < 0) {
                        const int tl = quad * 4 - (qpos0 + qt * 16 + l15 - kpos0 - 128);
#pragma unroll
                        for (int kt = 0; kt < 4; ++kt)
#pragma unroll
                            for (int rg = 0; rg < 4; ++rg) { const float sv_ = (tl >= -(kt * 16 + rg)) ? S[kt][rg] : -INFINITY; S[kt][rg] = sv_; mx = fmaxf(mx, sv_); }
                    } else if (side > 0) {
                        const int th = (qpos0 + qt * 16 + l15 - kpos0 + 128) - quad * 4;
#pragma unroll
                        for (int kt = 0; kt < 4; ++kt)
#pragma unroll
                            for (int rg = 0; rg < 4; ++rg) { const float sv_ = (th >= (kt * 16 + rg)) ? S[kt][rg] : -INFINITY; S[kt][rg] = sv_; mx = fmaxf(mx, sv_); }
                    } else {
#pragma unroll
                        for (int kt = 0; kt < 4; ++kt)
#pragma unroll
                            for (int rg = 0; rg < 4; ++rg) mx = fmaxf(mx, S[kt][rg]);
                    }
                    mx = quad_max(mx);
                    const float mnew = fmaxf(mrun[qt], mx), al = __builtin_amdgcn_exp2f(mrun[qt] - mnew); mrun[qt] = mnew;
                    float ps = 0.f;
#pragma unroll
                    for (int kt = 0; kt < 4; ++kt)
#pragma unroll
                        for (int rg = 0; rg < 4; ++rg) { const float p = __builtin_amdgcn_exp2f(S[kt][rg] - mnew); S[kt][rg] = p; ps += p; }
                    lrun[qt] = lrun[qt] * al + ps;
#pragma unroll
                    for (int dt = 0; dt < 4; ++dt) O[dt][qt] = O[dt][qt] * al;
#pragma unroll
                    for (int s2 = 0; s2 < 2; ++s2) {
                        u32x4 pw; pw.x = pk2(S[2 * s2][0], S[2 * s2][1]); pw.y = pk2(S[2 * s2][2], S[2 * s2][3]);
                        pw.z = pk2(S[2 * s2 + 1][0], S[2 * s2 + 1][1]); pw.w = pk2(S[2 * s2 + 1][2], S[2 * s2 + 1][3]);
                        const bf16x8 pf = __builtin_bit_cast(bf16x8, pw);
#pragma unroll
                        for (int dt = 0; dt < 4; ++dt) {
                            const s16x4 lo = *(const s16x4*)(Vt + (dt * 16 + l15) * 72 + s2 * 32 + quad * 4), hi = *(const s16x4*)(Vt + (dt * 16 + l15) * 72 + s2 * 32 + 16 + quad * 4);
                            O[dt][qt] = MFMA16(__builtin_shufflevector(lo, hi, 0, 1, 2, 3, 4, 5, 6, 7), pf, O[dt][qt]); }
                    }
                }
                ti = tn;
                PACC_END(42)
            }
            PACC_BEGIN(43)
#pragma unroll
            for (int qt = 0; qt < 4; ++qt) {
                const float lt = quad_sum(lrun[qt]);
                const float inv = 1.f / lt;
                const int r = b * TP + L + qpos0 + qt * 16 + l15;
#pragma unroll
                for (int dt = 0; dt < 4; ++dt) { u32x2 o; o.x = pk2(O[dt][qt][0] * inv, O[dt][qt][1] * inv); o.y = pk2(O[dt][qt][2] * inv, O[dt][qt][3] * inv);
                    *(u32x2*)(H + (size_t)r * D + (kvh * 4 + g) * 64 + dt * 16 + quad * 4) = o; }
            }
            PACC_END(43)
#undef ATT_VALID
#undef ATT_KPOS
#undef ATT_KROW
#undef ATT_LOAD
        }
        PACC_SLEEP()
    }
#endif
PROBE_END(6)
    xcd_barrier(xbar);

PROBE_BEGIN(14)
    { pg8::Gemm g{H, WOUT1_T, R, D, D}; LatOrder S; S.init(D, G, bid); EpiResid E{xlat, xctx, xlat, xctx, mod + 3 * 6144 + 2 * 1024};
      pg8::gemm_phase<EpiResid, LatOrder, true, true>(ldsg, g, S, E); }
PROBE_END(14)
    xcd_barrier(xbar);
    { IDS
    ln_phase<false, true>(xlat, xctx, ln_g + 2048, ln_b + 2048, mod + 3 * 6144 + 3 * 1024, H, gw, NGW, lane);
    }
    xcd_barrier(xbar);
PROBE_BEGIN(15)
    { pg8::Gemm g{H, W1_1_T, R, FF, D}; LatOrder S; S.init(FF, G, bid); EpiStore<1> E{P, FF, FF};
      pg8::gemm_phase<EpiStore<1>, LatOrder, true, true>(ldsg, g, S, E); }
PROBE_END(15)
    xcd_barrier(xbar);
PROBE_BEGIN(16)
    { pg8::Gemm g{P, W2_1_T, R, D, FF}; LatOrder S; S.init(D, G, bid); EpiResid E{xlat, xctx, xlat, xctx, mod + 3 * 6144 + 5 * 1024};
      pg8::gemm_phase<EpiResid, LatOrder, true, true>(ldsg, g, S, E); }
PROBE_END(16)
    xcd_barrier(xbar);
    { IDS
    ln_phase<true, true>(xlat, xctx, ln_g + 3072, ln_b + 3072, mod, H, gw, NGW, lane);
    }
}

extern "C" void kernel_launch(void* const* d_in, const int* in_sizes, int n_in, void* d_out, int out_size, void* d_ws, size_t ws_size, hipStream_t stream) {
    static int grid = 0;
    if (grid == 0) {
        if (n_in != 19 || out_size != NB * T * D || ws_size < WS_TOTAL) { fprintf(stderr, "kernel_launch: unexpected shapes (n_in %d out %d ws %zu)\n", n_in, out_size, ws_size); grid = -1; return; }
        int dev = 0, cus = 0, per_cu = 0;
        hipGetDevice(&dev); hipDeviceGetAttribute(&cus, hipDeviceAttributeMultiprocessorCount, dev);
        if (hipFuncSetAttribute((const void*)fwd_kernel, hipFuncAttributeMaxDynamicSharedMemorySize, LDS_BYTES) != hipSuccess) { fprintf(stderr, "kernel_launch: hipFuncSetAttribute failed\n"); grid = -1; return; }
        if (hipOccupancyMaxActiveBlocksPerMultiprocessor(&per_cu, (const void*)fwd_kernel, 512, LDS_BYTES) != hipSuccess || per_cu < 1) per_cu = 1;
        (void)hipGetLastError();
        grid = cus > 0 ? cus : 256;
    }
    if (grid < 0) return;
    Args a{};
    for (int i = 0; i < 19; ++i) a.in[i] = (const float*)d_in[i];
    a.out = (float*)d_out; a.ws = (unsigned char*)d_ws;
    if (hipMemsetAsync((char*)d_ws + OFF_XBAR, 0, 16384, stream) != hipSuccess) { fprintf(stderr, "kernel_launch: hipMemsetAsync of the barrier words failed\n"); return; }
    void* args[] = {&a};
    hipError_t e = hipLaunchCooperativeKernel((const void*)fwd_kernel, dim3(grid), dim3(512), args, LDS_BYTES, stream);
    if (e != hipSuccess) fprintf(stderr, "cooperative launch failed: %s (grid %d)\n", hipGetErrorString(e), grid);
}
```

```cpp
#include <hip/hip_runtime.h>
#include <hip/hip_cooperative_groups.h>
#include <cstdio>
#include <cstdint>
namespace cg = cooperative_groups;
namespace pg8 {
#define PG8_LAS __attribute__((address_space(3)))
typedef unsigned short bf16_t;
typedef short bf16x8 __attribute__((ext_vector_type(8)));
typedef float f32x4 __attribute__((ext_vector_type(4)));
typedef unsigned u32x4 __attribute__((ext_vector_type(4)));
constexpr int BM = 256, BK = 64, HALF = 128, HTB = HALF * BK * 2  , STAGE_BYTES = 8 * HTB, NXCD = 8, WGM = 8;

__host__ __device__ __forceinline__ int lds_byte(int r, int c) { const int st = (r >> 4) * 2 + (c >> 5), rr = r & 15, cc = c & 31, ob = rr * 64 + cc * 2; return st * 1024 + (ob ^ (((ob >> 9) & 1) << 5)); }
__host__ __device__ __forceinline__ void stage_rc(int b, int& R, int& C) { const int st = b / 1024, sb = b % 1024, swz = sb ^ (((sb >> 9) & 1) << 5); R = (st >> 1) * 16 + swz / 64; C = (st & 1) * 32 + (swz % 64) / 2; }
__host__ __device__ __forceinline__ int perm32(int rho) { const int n = rho >> 4, i = rho & 15; return 8 * (i >> 2) + 4 * n + (i & 3); }

struct Unit { int pm, pn; };
struct Gemm { const bf16_t* A; const bf16_t* Bt; int M, N, K; };

struct StaticOrder {
    int nM, nN, nwg, G, c;
    __host__ __device__ void init(int M, int N, int G_, int c_) { nM = M / BM; nN = N / BM; nwg = nM * nN; G = G_; c = c_; }
    __host__ __device__ bool next(int i, Unit& u) const {
        const long L = (long)i * G + c; if (L >= nwg) return false;
        int wgid = (int)L; { const int q = nwg / NXCD, r = nwg % NXCD, xcd = wgid % NXCD, off = wgid / NXCD; wgid = (xcd < r ? xcd * (q + 1) : r * (q + 1) + (xcd - r) * q) + off; }
        const int nig = WGM * nN, gid = wgid / nig, fm = gid * WGM, gsz = (nM - fm) < WGM ? (nM - fm) : WGM;
        u.pm = fm + ((wgid % nig) % gsz); u.pn = (wgid % nig) / gsz; return true;
    }
    __device__ __forceinline__ void a_ready(const Unit&) const {}
    __device__ __forceinline__ void done(const Unit&) const {}
};

__device__ __forceinline__ unsigned cvt_pk_bf16(float lo, float hi) { unsigned r; asm volatile("v_cvt_pk_bf16_f32 %0, %1, %2" : "=v"(r) : "v"(lo), "v"(hi)); return r; }

template <class Epi, class Sched, bool ALIGN_EPI = false, bool SP2 = false>
__device__ __forceinline__ void gemm_phase(PG8_LAS unsigned char* lds, const Gemm g, const Sched& S, const Epi& E) {
    int tid = threadIdx.x; asm volatile("" : "+v"(tid));
    const int wid = __builtin_amdgcn_readfirstlane(tid >> 6), lane = tid & 63, wr = wid >> 2, wc = wid & 3, fr = lane & 15, fq = lane >> 4;
    const int K = g.K, nt = K / BK;
    unsigned voffA[2], voffB[2];
#pragma unroll
    for (int i = 0; i < 2; ++i) { int R, C; stage_rc(tid * 16 + i * 8192, R, C); const int Rb = Epi::PERM ? ((R & ~31) + perm32(R & 31)) : R;
        voffA[i] = (unsigned)(R * K + C) * 2u; voffB[i] = (unsigned)(Rb * K + C) * 2u; }
    const size_t kstep = (size_t)(BK * 2);
    const size_t hstep = (size_t)HALF * K * 2;
    const size_t tstep = 2 * hstep;
    const unsigned ldsw = (unsigned)wid * 1024u;
    const int aoff = lds_byte(wr * 64 + fr, fq * 8), boff = lds_byte(wc * 32 + fr, fq * 8);
#define PG8_SA(b, h) (((b) * 2 + (h)) * HTB)
#define PG8_SB(b, h) ((4 + (b) * 2 + (h)) * HTB)
#define PG8_STAGE(bufoff, gbase, voff) do { _Pragma("unroll") for (int _i = 0; _i < 2; ++_i) \
        __builtin_amdgcn_global_load_lds((const unsigned*)((const char*)(gbase) + (voff)[_i]), (PG8_LAS unsigned*)(lds + (bufoff) + ldsw + _i * 8192), 16, 0, 0); } while (0)
#define PG8_LDA(dst, b, h) do { _Pragma("unroll") for (int m = 0; m < 4; ++m) _Pragma("unroll") for (int k = 0; k < 2; ++k) dst[m][k] = *(const PG8_LAS bf16x8*)(lds + PG8_SA(b, h) + aoff + m * 2048 + k * 1024); } while (0)
#define PG8_LDB(dst, b, h) do { _Pragma("unroll") for (int n = 0; n < 2; ++n) _Pragma("unroll") for (int k = 0; k < 2; ++k) dst[n][k] = *(const PG8_LAS bf16x8*)(lds + PG8_SB(b, h) + boff + n * 2048 + k * 1024); } while (0)
#define PG8_MMA(ai, bj, At, Bt) do { __builtin_amdgcn_s_setprio(1); _Pragma("unroll") for (int m = 0; m < 4; ++m) _Pragma("unroll") for (int n = 0; n < 2; ++n) _Pragma("unroll") for (int k = 0; k < 2; ++k) \
        acc[ai][bj][m][n] = __builtin_amdgcn_mfma_f32_16x16x32_bf16(Bt[n][k], At[m][k], acc[ai][bj][m][n], 0, 0, 0); __builtin_amdgcn_s_setprio(0); } while (0)
#define PG8_WAIT_V(n) asm volatile("s_waitcnt vmcnt(" #n ")" ::: "memory")
#define PG8_WAIT_L(n) asm volatile("s_waitcnt lgkmcnt(" #n ")" ::: "memory")
#define PG8_BAR __builtin_amdgcn_s_barrier()
#define PG8_SCHED __builtin_amdgcn_sched_barrier(0)
    Unit cur, nxt; int ui = 0;
    if (!S.next(0, cur)) return;
    f32x4 acc[2][2][4][2];
#pragma unroll
    for (int a = 0; a < 2; ++a)
#pragma unroll
        for (int b = 0; b < 2; ++b)
#pragma unroll
            for (int m = 0; m < 4; ++m)
#pragma unroll
                for (int n = 0; n < 2; ++n) acc[a][b][m][n] = (f32x4){0.f, 0.f, 0.f, 0.f};
    bf16x8 At[4][2], B0[2][2], B1[2][2];
    const char* cA = (const char*)g.A + (size_t)cur.pm * tstep; const char* cB = (const char*)g.Bt + (size_t)cur.pn * tstep;
    S.a_ready(cur);
    if constexpr (SP2) {
        PG8_STAGE(PG8_SB(0, 0), cB, voffB); PG8_STAGE(PG8_SB(0, 1), cB + hstep, voffB); PG8_STAGE(PG8_SA(0, 0), cA, voffA); PG8_STAGE(PG8_SA(0, 1), cA + hstep, voffA);
        if (wr == 1) PG8_BAR;
        PG8_WAIT_V(2); PG8_BAR;
        PG8_STAGE(PG8_SB(1, 0), cB + kstep, voffB); PG8_STAGE(PG8_SA(1, 0), cA + kstep, voffA); PG8_STAGE(PG8_SB(1, 1), cB + hstep + kstep, voffB);
        PG8_WAIT_V(6); PG8_BAR;
    } else {
        PG8_STAGE(PG8_SB(0, 0), cB, voffB); PG8_STAGE(PG8_SA(0, 0), cA, voffA); PG8_STAGE(PG8_SB(0, 1), cB + hstep, voffB); PG8_STAGE(PG8_SA(0, 1), cA + hstep, voffA);
        if (wr == 1) PG8_BAR;
        PG8_WAIT_V(4); PG8_BAR;
        PG8_STAGE(PG8_SB(1, 0), cB + kstep, voffB); PG8_STAGE(PG8_SA(1, 0), cA + kstep, voffA); PG8_STAGE(PG8_SB(1, 1), cB + hstep + kstep, voffB);
        PG8_WAIT_V(6); PG8_BAR;
    }
    for (;;) {
        const bool has_next = S.next(ui + 1, nxt);
        const char* nA = has_next ? (const char*)g.A + (size_t)nxt.pm * tstep : cA; const char* nB = has_next ? (const char*)g.Bt + (size_t)nxt.pn * tstep : cB;
        for (int t = 0; t < nt; t += 2) {
            const bool last = (t == nt - 2);
            const char* a1 = cA + (size_t)(t + 1) * kstep;
            const char* a2 = last ? nA : cA + (size_t)(t + 2) * kstep; const char* b2 = last ? nB : cB + (size_t)(t + 2) * kstep;
            const char* a3 = a2 + kstep; const char* b3 = b2 + kstep;
            if (last && has_next) S.a_ready(nxt);
            if constexpr (SP2) {
            PG8_LDB(B0, 0, 0); PG8_LDB(B1, 0, 1); PG8_SCHED; PG8_LDA(At, 0, 0); PG8_STAGE(PG8_SA(1, 1), a1 + hstep, voffA);
            PG8_WAIT_V(8); PG8_WAIT_L(0); PG8_BAR; PG8_MMA(0, 0, At, B0); PG8_MMA(0, 1, At, B1); PG8_BAR; PG8_SCHED;
            PG8_LDA(At, 0, 1); PG8_STAGE(PG8_SB(0, 0), b2, voffB); PG8_STAGE(PG8_SB(0, 1), b2 + hstep, voffB); PG8_STAGE(PG8_SA(0, 0), a2, voffA);
            PG8_WAIT_V(8); PG8_WAIT_L(0); PG8_BAR; PG8_MMA(1, 0, At, B0); PG8_MMA(1, 1, At, B1); PG8_BAR; PG8_SCHED;
            PG8_LDB(B0, 1, 0); PG8_LDB(B1, 1, 1); PG8_SCHED; PG8_LDA(At, 1, 0); PG8_STAGE(PG8_SA(0, 1), a2 + hstep, voffA);
            PG8_WAIT_V(8); PG8_WAIT_L(0); PG8_BAR; PG8_MMA(0, 0, At, B0); PG8_MMA(0, 1, At, B1); PG8_BAR; PG8_SCHED;
            PG8_LDA(At, 1, 1); PG8_STAGE(PG8_SB(1, 0), b3, voffB); PG8_STAGE(PG8_SB(1, 1), b3 + hstep, voffB); PG8_STAGE(PG8_SA(1, 0), a3, voffA);
            PG8_WAIT_V(8); PG8_WAIT_L(0); PG8_BAR; PG8_MMA(1, 0, At, B0); PG8_MMA(1, 1, At, B1); PG8_BAR; PG8_SCHED;
            } else {
            PG8_LDB(B0, 0, 0); PG8_SCHED; PG8_LDA(At, 0, 0); PG8_STAGE(PG8_SA(1, 1), a1 + hstep, voffA);
            PG8_WAIT_L(8); PG8_BAR; PG8_WAIT_L(0); PG8_MMA(0, 0, At, B0); PG8_BAR; PG8_SCHED;
            PG8_LDB(B1, 0, 1); PG8_STAGE(PG8_SB(0, 0), b2, voffB);
            PG8_BAR; PG8_WAIT_L(0); PG8_MMA(0, 1, At, B1); PG8_BAR;
            PG8_LDA(At, 0, 1); PG8_STAGE(PG8_SA(0, 0), a2, voffA);
            PG8_BAR; PG8_WAIT_L(0); PG8_MMA(1, 0, At, B0); PG8_BAR; PG8_SCHED;
            PG8_STAGE(PG8_SB(0, 1), b2 + hstep, voffB);
            PG8_WAIT_V(6); PG8_BAR; PG8_MMA(1, 1, At, B1); PG8_BAR;
            PG8_LDB(B0, 1, 0); PG8_SCHED; PG8_LDA(At, 1, 0); PG8_STAGE(PG8_SA(0, 1), a2 + hstep, voffA);
            PG8_WAIT_L(8); PG8_BAR; PG8_WAIT_L(0); PG8_MMA(0, 0, At, B0); PG8_BAR; PG8_SCHED;
            PG8_LDB(B1, 1, 1); PG8_STAGE(PG8_SB(1, 0), b3, voffB);
            PG8_BAR; PG8_WAIT_L(0); PG8_MMA(0, 1, At, B1); PG8_BAR;
            PG8_LDA(At, 1, 1); PG8_STAGE(PG8_SA(1, 0), a3, voffA);
            PG8_BAR; PG8_WAIT_L(0); PG8_MMA(1, 0, At, B0); PG8_BAR; PG8_SCHED;
            PG8_STAGE(PG8_SB(1, 1), b3 + hstep, voffB);
            PG8_WAIT_V(6); PG8_BAR; PG8_MMA(1, 1, At, B1); PG8_BAR;
            }
        }
        if constexpr (ALIGN_EPI) { if (wr == 0) PG8_BAR; }
        if constexpr (!Epi::AFTER_DRAIN) { E(acc, cur, wr, wc, fr, fq); S.done(cur); }
        if (!has_next) break;
#pragma unroll
        for (int a = 0; a < 2; ++a)
#pragma unroll
            for (int b = 0; b < 2; ++b)
#pragma unroll
                for (int m = 0; m < 4; ++m)
#pragma unroll
                    for (int n = 0; n < 2; ++n) acc[a][b][m][n] = (f32x4){0.f, 0.f, 0.f, 0.f};
        cur = nxt; cA = nA; cB = nB; ++ui;
        if constexpr (ALIGN_EPI) { if (wr == 1) PG8_BAR; }
    }
    PG8_WAIT_V(0);
    if constexpr (!ALIGN_EPI) { if (wr == 0) PG8_BAR; }
    PG8_BAR;
    if constexpr (Epi::AFTER_DRAIN) { E.fused(acc, cur, wr, wc, fr, fq, lds, wid, lane); S.done(cur); }
#undef PG8_SA
#undef PG8_SB
#undef PG8_STAGE
#undef PG8_LDA
#undef PG8_LDB
#undef PG8_MMA
#undef PG8_WAIT_V
#undef PG8_WAIT_L
#undef PG8_BAR
#undef PG8_SCHED
}
}

constexpr int NB = 2, T = 8192, L = 256, D = 1024, TP = T + L, R = NB * TP;
constexpr int FF = 4096, NPROJ = 3104, NPROJ_PAD = 3328, NQKV = 1536, NCH = TP / 64;
constexpr float ALPHA = 1.4142135623730951f;
constexpr int LDS_BYTES = 147456;

typedef unsigned short bf16;
typedef float f32x4 __attribute__((ext_vector_type(4)));
typedef short bf16x8 __attribute__((ext_vector_type(8)));
typedef short s16x4 __attribute__((ext_vector_type(4)));
typedef unsigned u32x4 __attribute__((ext_vector_type(4)));
typedef unsigned u32x2 __attribute__((ext_vector_type(2)));

constexpr size_t OFF_WIN = 0;
constexpr size_t OFF_WOUT0 = OFF_WIN + (size_t)NPROJ_PAD * D * 2;
constexpr size_t OFF_W1_0 = OFF_WOUT0 + (size_t)D * D * 2;
constexpr size_t OFF_W2_0 = OFF_W1_0 + (size_t)FF * D * 2;
constexpr size_t OFF_WQKV = OFF_W2_0 + (size_t)FF * D * 2;
constexpr size_t OFF_WOUT1 = OFF_WQKV + (size_t)NQKV * D * 2;
constexpr size_t OFF_W1_1 = OFF_WOUT1 + (size_t)D * D * 2;
constexpr size_t OFF_W2_1 = OFF_W1_1 + (size_t)FF * D * 2;
constexpr size_t OFF_MOD = OFF_W2_1 + (size_t)FF * D * 2;
constexpr size_t OFF_ROPE = OFF_MOD + 2 * 3 * 6144 * 4;
constexpr size_t OFF_BAR = OFF_ROPE + 128 * 16 * 8;
constexpr size_t OFF_XBAR = OFF_BAR + 256;
constexpr size_t OFF_RST = OFF_XBAR + 16384;
constexpr size_t OFF_XCTX = OFF_RST + (size_t)3 * R * 2 * 4;
constexpr size_t OFF_DEC = OFF_XCTX + (size_t)NB * L * D * 4;
constexpr size_t OFF_H = OFF_DEC + (size_t)32 * NCH * 64 * 4;
constexpr size_t OFF_P = OFF_H + (size_t)R * D * 2;
constexpr size_t OFF_ST = OFF_P + (size_t)R * NPROJ * 2;
constexpr size_t WS_TOTAL = OFF_ST + (size_t)32 * NCH * 8192 * 2;
static_assert(WS_TOTAL <= 268435456, "workspace map exceeds 256 MiB");
static_assert(OFF_P + (size_t)R * FF * 2 <= WS_TOTAL, "MLP hidden overlay");

typedef float f32x2_t __attribute__((ext_vector_type(2)));
typedef __bf16 bf16x2_t __attribute__((ext_vector_type(2)));
__device__ __forceinline__ unsigned pk2(float lo, float hi) { const f32x2_t v = {lo, hi}; const bf16x2_t b = __builtin_convertvector(v, bf16x2_t); return __builtin_bit_cast(unsigned, b); }
__device__ __forceinline__ unsigned f2bf(float f) { return pk2(f, f) & 0xffffu; }
__device__ __forceinline__ float bf2f(unsigned h) { return __uint_as_float(h << 16); }
__device__ __forceinline__ float bflo(unsigned u) { return __uint_as_float(u << 16); }
__device__ __forceinline__ float bfhi(unsigned u) { return __uint_as_float(u & 0xffff0000u); }
__device__ __forceinline__ float wave_sum(float v) {
#pragma unroll
    for (int o = 1; o < 64; o <<= 1) v += __shfl_xor(v, o);
    return v;
}
__device__ __forceinline__ float quad_max(float x) {
    const unsigned u = __float_as_uint(x);
    const auto r = __builtin_amdgcn_permlane32_swap(u, u, false, false);
    const float m = fmaxf(__uint_as_float(r[0]), __uint_as_float(r[1]));
    const unsigned v = __float_as_uint(m);
    const auto q = __builtin_amdgcn_permlane16_swap(v, v, false, false);
    return fmaxf(__uint_as_float(q[0]), __uint_as_float(q[1]));
}
__device__ __forceinline__ float quad_sum(float x) {
    const unsigned u = __float_as_uint(x);
    const auto r = __builtin_amdgcn_permlane32_swap(u, u, false, false);
    const float m = __uint_as_float(r[0]) + __uint_as_float(r[1]);
    const unsigned v = __float_as_uint(m);
    const auto q = __builtin_amdgcn_permlane16_swap(v, v, false, false);
    return __uint_as_float(q[0]) + __uint_as_float(q[1]);
}
#define MFMA16(a, b, c) __builtin_amdgcn_mfma_f32_16x16x32_bf16((a), (b), (c), 0, 0, 0)

__device__ __forceinline__ size_t row_off(int r, bool& isc, int& b) { b = (r >= TP) ? 1 : 0; const int p = r - b * TP; isc = p < L; return isc ? (size_t)(b * L + p) * D : (size_t)(b * T + p - L) * D; }

template <int ACT> struct EpiStore {
    static constexpr bool PERM = true, AFTER_DRAIN = false;
    bf16* O; int ldc; int ncols;
    __device__ __forceinline__ void operator()(const pg8::f32x4 (&acc)[2][2][4][2], const pg8::Unit& u, int wr, int wc, int fr, int fq) const {
        const int row0 = u.pm * 256 + wr * 64 + fr, col0 = u.pn * 256 + wc * 32 + 8 * fq;
#pragma unroll
        for (int ai = 0; ai < 2; ++ai)
#pragma unroll
            for (int m = 0; m < 4; ++m) {
                bf16* rowp = O + (size_t)(row0 + ai * 128 + m * 16) * ldc;
#pragma unroll
                for (int bj = 0; bj < 2; ++bj) {
                    const int col = col0 + bj * 128;
                    pg8::f32x4 v0 = acc[ai][bj][m][0], v1 = acc[ai][bj][m][1];
                    if (ACT == 1) {
#pragma unroll
                        for (int i = 0; i < 4; ++i) { float a = fmaxf(v0[i], 0.f), b = fmaxf(v1[i], 0.f); v0[i] = a * a; v1[i] = b * b; }
                    }
                    u32x4 w; w.x = pg8::cvt_pk_bf16(v0[0], v0[1]); w.y = pg8::cvt_pk_bf16(v0[2], v0[3]); w.z = pg8::cvt_pk_bf16(v1[0], v1[1]); w.w = pg8::cvt_pk_bf16(v1[2], v1[3]);
                    if (col < ncols) *(u32x4*)(rowp + col) = w;
                }
            }
    }
};
template <bool SRC_LN> struct EpiResid {
    static constexpr bool PERM = true, AFTER_DRAIN = false;
    const float* src_lat; const float* src_ctx; float* dst_lat; float* dst_ctx; const float* gate;
    const float* rst; const float* lg; const float* lb;
    __device__ __forceinline__ void operator()(const pg8::f32x4 (&acc)[2][2][4][2], const pg8::Unit& u, int wr, int wc, int fr, int fq) const {
        const int row0 = u.pm * 256 + wr * 64 + fr, col0 = u.pn * 256 + wc * 32 + 8 * fq;
#pragma unroll
        for (int ai = 0; ai < 2; ++ai)
#pragma unroll
            for (int m = 0; m < 4; ++m) {
                const int row = row0 + ai * 128 + m * 16;
                bool isc; int b; const size_t off = row_off(row, isc, b);
                const float* s = (isc ? src_ctx : src_lat) + off; float* d = (isc ? dst_ctx : dst_lat) + off; const float* gt = gate + (isc ? 2 : b) * 6144;
                float mean = 0.f, rstd = 1.f; if (SRC_LN) { mean = rst[2 * row]; rstd = rst[2 * row + 1]; }
#pragma unroll
                for (int bj = 0; bj < 2; ++bj)
#pragma unroll
                    for (int n = 0; n < 2; ++n) {
                        const int col = col0 + bj * 128 + 4 * n;
                        f32x4 x4 = *(const f32x4*)(s + col); const f32x4 g4 = *(const f32x4*)(gt + col);
                        if (SRC_LN) x4 = (x4 - mean) * rstd * *(const f32x4*)(lg + col) + *(const f32x4*)(lb + col);
                        const pg8::f32x4 a4 = acc[ai][bj][m][n];
                        f32x4 o; o.x = ALPHA * x4.x + g4.x * a4[0]; o.y = ALPHA * x4.y + g4.y * a4[1]; o.z = ALPHA * x4.z + g4.z * a4[2]; o.w = ALPHA * x4.w + g4.w * a4[3];
                        *(f32x4*)(d + col) = o;
                    }
            }
    }
};

__device__ __forceinline__ void transpose_item(const float* __restrict__ W, int K, int N, bf16* WT, float* scr, int item, int lane) {
    const int nblk = N / 32, kb = item / nblk, nb = item % nblk, k0 = 64 * kb, n0 = 32 * nb;
#pragma unroll 8
    for (int i = 0; i < 32; ++i) { const int kk = 2 * i + (lane >> 5); scr[kk * 33 + (lane & 31)] = W[(size_t)(k0 + kk) * N + n0 + (lane & 31)]; }
    asm volatile("s_waitcnt lgkmcnt(0)" ::: "memory");
    const int c = lane & 7;
#pragma unroll
    for (int j = 0; j < 4; ++j) { const int n = (lane >> 3) + 8 * j; const float* s = scr + (8 * c) * 33 + n;
        u32x4 o; o.x = pk2(s[0 * 33], s[1 * 33]); o.y = pk2(s[2 * 33], s[3 * 33]); o.z = pk2(s[4 * 33], s[5 * 33]); o.w = pk2(s[6 * 33], s[7 * 33]);
        *(u32x4*)(WT + (size_t)(n0 + n) * K + k0 + 8 * c) = o; }
    asm volatile("s_waitcnt lgkmcnt(0)" ::: "memory");
}

template <bool LAST, bool SKIPCTX>
__device__ __forceinline__ void ln_phase(float* rst, float* xlat, float* xctx, const float* __restrict__ g, const float* __restrict__ bt, const float* __restrict__ modn, bf16* H, int gw, int NGW, int lane) {
    int r = gw;
    if (SKIPCTX) { while (r < R) { const int p = r >= TP ? r - TP : r; if (p >= L) break; r += NGW; } }
    f32x4 vn[4];
    if (r < R) { bool isc; int b; const size_t off = row_off(r, isc, b); const float* xr = (isc ? xctx : xlat) + off;
#pragma unroll
        for (int j = 0; j < 4; ++j) vn[j] = *(const f32x4*)(xr + lane * 4 + 256 * j); }
    while (r < R) {
        bool isc; int b; const size_t off = row_off(r, isc, b);
        float* xr = (isc ? xctx : xlat) + off;
        f32x4 v[4];
#pragma unroll
        for (int j = 0; j < 4; ++j) v[j] = vn[j];
        int rn = r + NGW;
        if (SKIPCTX) { while (rn < R) { const int p = rn >= TP ? rn - TP : rn; if (p >= L) break; rn += NGW; } }
        if (rn < R) { bool isc2; int b2; const size_t off2 = row_off(rn, isc2, b2); const float* xr2 = (isc2 ? xctx : xlat) + off2;
#pragma unroll
            for (int j = 0; j < 4; ++j) vn[j] = *(const f32x4*)(xr2 + lane * 4 + 256 * j); }
        float s = 0.f;
#pragma unroll
        for (int j = 0; j < 4; ++j) s += (v[j].x + v[j].y) + (v[j].z + v[j].w);
        const float mean = wave_sum(s) * (1.f / D); float s2 = 0.f;
#pragma unroll
        for (int j = 0; j < 4; ++j) { v[j] = v[j] - mean; s2 += (v[j].x * v[j].x + v[j].y * v[j].y) + (v[j].z * v[j].z + v[j].w * v[j].w); }
        const float rstd = 1.f / sqrtf(wave_sum(s2) * (1.f / D) + 1e-5f);
        const float* md = modn + (isc ? 2 : b) * 6144;
        if (!LAST && lane == 0) { rst[2 * r] = mean; rst[2 * r + 1] = rstd; }
#pragma unroll
        for (int j = 0; j < 4; ++j) {
            const int idx = lane * 4 + 256 * j;
            const f32x4 gg = *(const f32x4*)(g + idx), bb = *(const f32x4*)(bt + idx);
            const f32x4 y = v[j] * rstd * gg + bb;
            if (LAST) *(f32x4*)(xr + idx) = y;
            if (!LAST) {
                const f32x4 sh = *(const f32x4*)(md + idx), sc = *(const f32x4*)(md + 1024 + idx);
                const f32x4 h = y * (sc + 1.f) + sh;
                u32x2 o; o.x = pk2(h.x, h.y); o.y = pk2(h.z, h.w);
                *(u32x2*)(H + (size_t)r * D + idx) = o;
            }
        }
        r = rn;
    }
}

__device__ __forceinline__ float log_sigmoid(float z) { return fminf(z, 0.f) - __logf(1.f + __expf(-fabsf(z))); }

constexpr int CS = 65;
constexpr float QSC = 0.125f * 1.4426950408889634f;
struct GatePre { u32x2 lr; f32x4 w; float bias; };
__device__ __forceinline__ GatePre gate_prefetch(int g, int h, const bf16* Pr, const float* gkw, const float* gkb, int tid) {
    GatePre p; p.lr = (u32x2){0u, 0u}; p.w = (f32x4){0.f, 0.f, 0.f, 0.f}; p.bias = 0.f;
    if (g) { const int c = tid >> 3, part = tid & 7;
        p.lr = *(const u32x2*)(Pr + (size_t)c * NPROJ + 3072 + part * 4);
        const int idx = tid * 4, dir = idx >> 10, r = (idx >> 6) & 15, d = idx & 63;
        p.w = *(const f32x4*)(gkw + (dir * 16 + r) * 256 + h * 64 + d);
        if (tid < 128) p.bias = gkb[(tid >> 6) * 256 + h * 64 + (tid & 63)]; }
    return p;
}
__device__ __forceinline__ void fill_cum3(float* cf, float* cb, float* lrs, float* wl, int g, int h, const GatePre& gp, const float* theta, int tid) {
    if (g == 0) {
        const float lgf = log1pf(-expf(theta[h])), lgb = log1pf(-expf(theta[4 + h]));
        for (int i = tid; i < 4096; i += 512) { const int c = i >> 6, d = i & 63; cf[c * CS + d] = (float)(c + 1) * lgf; cb[c * CS + d] = (float)(64 - c) * lgb; }
        __syncthreads();
        return;
    }
    { const int c = tid >> 3, part = tid & 7;
      float* lp = lrs + c * 33 + part * 4; lp[0] = bflo(gp.lr.x); lp[1] = bfhi(gp.lr.x); lp[2] = bflo(gp.lr.y); lp[3] = bfhi(gp.lr.y);
      *(f32x4*)(wl + tid * 4) = gp.w;
      if (tid < 128) wl[2048 + tid] = gp.bias; }
    __syncthreads();
    { const int c = tid >> 3, dg = tid & 7;
#pragma unroll
      for (int dir = 0; dir < 2; ++dir) {
          f32x4 za = *(const f32x4*)(wl + 2048 + dir * 64 + dg * 8), zb = *(const f32x4*)(wl + 2048 + dir * 64 + dg * 8 + 4);
#pragma unroll
          for (int r = 0; r < 16; ++r) { const float lv = lrs[c * 33 + dir * 16 + r];
              za += lv * *(const f32x4*)(wl + (dir * 16 + r) * 64 + dg * 8); zb += lv * *(const f32x4*)(wl + (dir * 16 + r) * 64 + dg * 8 + 4); }
          float* dst = (dir ? cb : cf) + c * CS + dg * 8;
#pragma unroll
          for (int j = 0; j < 4; ++j) { dst[j] = log_sigmoid(za[j]) * (1.f / 16.f); dst[4 + j] = log_sigmoid(zb[j]) * (1.f / 16.f); } } }
    __syncthreads();
    if (tid < 128) {
        const int dir = tid >> 6; float* arr = (dir ? cb : cf) + (tid & 63);
        float run = 0.f;
#pragma unroll
        for (int hh = 0; hh < 2; ++hh) {
            float v[32];
            const int base = dir ? (1 - hh) * 32 : hh * 32;
#pragma unroll
            for (int c = 0; c < 32; ++c) v[c] = arr[(base + c) * CS];
            if (dir == 0) {
#pragma unroll
                for (int c = 0; c < 32; ++c) { run += v[c]; arr[(base + c) * CS] = run; }
            } else {
#pragma unroll
                for (int c = 31; c >= 0; --c) { run += v[c]; arr[(base + c) * CS] = run; }
            }
        }
    }
    __syncthreads();
}

__device__ __forceinline__ void fast_bar(unsigned* ctr, unsigned& target) {
    asm volatile("s_waitcnt vmcnt(0)" ::: "memory");
    __syncthreads();
    target += gridDim.x;
    if (threadIdx.x == 0) {
        __builtin_amdgcn_fence(__ATOMIC_RELEASE, "agent");
        asm volatile("s_waitcnt vmcnt(0)" ::: "memory");
        __hip_atomic_fetch_add(ctr, 1u, __ATOMIC_RELAXED, __HIP_MEMORY_SCOPE_AGENT);
        while (__hip_atomic_load(ctr, __ATOMIC_RELAXED, __HIP_MEMORY_SCOPE_AGENT) < target) __builtin_amdgcn_s_sleep(1);
        __builtin_amdgcn_fence(__ATOMIC_ACQUIRE, "agent");
        asm volatile("s_waitcnt vmcnt(0)" ::: "memory");
    }
    __syncthreads();
}
#define RLX_AGENT __ATOMIC_RELAXED, __HIP_MEMORY_SCOPE_AGENT
#define XB_TMO      128
#define XB_XCNT(j)  (256  + 64 * (j))
#define XB_XSUB(j)  (1280 + 64 * (j))
#define XB_XGEN(j)  (2304 + 64 * (j))
#define XB_TOP      3328
#define XB_TOPGEN   3392
#define XCD_BAR_WORDS 3456
#define XB_SPIN_CAP (1u << 18)

__device__ __forceinline__ unsigned xb_ld(unsigned* p)              { return __hip_atomic_load(p, __ATOMIC_RELAXED, __HIP_MEMORY_SCOPE_AGENT); }
__device__ __forceinline__ unsigned xb_add(unsigned* p, unsigned v) { return __hip_atomic_fetch_add(p, v, __ATOMIC_RELAXED, __HIP_MEMORY_SCOPE_AGENT); }
__device__ __forceinline__ unsigned xb_xcc_id() { return (unsigned)__builtin_amdgcn_s_getreg((3 << 11) | 20) & 0xFu; }
#define XB_SPIN(cond, bar) do { unsigned _sp = 0; while (cond) { __builtin_amdgcn_s_sleep(1); \
    if ((++_sp & 255u) == 0u) { if (xb_ld(&(bar)[XB_TMO])) break; if (_sp > XB_SPIN_CAP) { atomicAdd(&(bar)[XB_TMO], 1u); break; } } } } while (0)

struct XcdBarrier {
    unsigned* bar; unsigned x;
    volatile unsigned* st;
};

__device__ __forceinline__ XcdBarrier xcd_barrier_post(unsigned* bar, volatile unsigned* st) {
    XcdBarrier b; b.bar = bar; b.x = xb_xcc_id(); b.st = st;
    if (threadIdx.x == 0) (void)xb_add(&bar[XB_XCNT(b.x)], 1u);
    return b;
}
__device__ __forceinline__ void xcd_barrier_complete(unsigned* bar, unsigned x, unsigned& nloc, unsigned& nx) {
    const unsigned G = gridDim.x * gridDim.y * gridDim.z;
    unsigned sum, cnt, mine, sp = 0u;
    for (;;) {
        sum = 0u; cnt = 0u; mine = 0u;
#pragma unroll
        for (unsigned j = 0; j < 16; ++j) { const unsigned c = xb_ld(&bar[XB_XCNT(j)]); sum += c; cnt += (c > 0u) ? 1u : 0u; mine = (j == x) ? c : mine; }
        if (sum == G) break;
        __builtin_amdgcn_s_sleep(1);
        if ((++sp & 255u) == 0u) { if (xb_ld(&bar[XB_TMO])) break; if (sp > XB_SPIN_CAP) { atomicAdd(&bar[XB_TMO], 1u); break; } }
    }
    nloc = mine > 0u ? mine : 1u; nx = cnt > 0u ? cnt : 1u;
}

__device__ __forceinline__ void xcd_barrier(const XcdBarrier& b) {
    asm volatile("s_waitcnt vmcnt(0)" ::: "memory");
    __syncthreads();
    if (threadIdx.x == 0) {
        unsigned* bar = b.bar;
        __builtin_amdgcn_s_waitcnt(0);
        unsigned nloc = b.st[0], nx = b.st[1];
        if (nloc == 0u) { xcd_barrier_complete(bar, b.x, nloc, nx); b.st[0] = nloc; b.st[1] = nx; }
        const unsigned old = xb_add(&bar[XB_XSUB(b.x)], 1u);
        const unsigned gen = old / nloc;
        if (old + 1u == (gen + 1u) * nloc) {
            __builtin_amdgcn_fence(__ATOMIC_RELEASE, "agent");
            asm volatile("s_waitcnt vmcnt(0)" ::: "memory");
            const unsigned og = xb_add(&bar[XB_TOP], 1u);
            const unsigned tg = og / nx;
            if (og + 1u == (tg + 1u) * nx) xb_add(&bar[XB_TOPGEN], 1u);
            else XB_SPIN(xb_ld(&bar[XB_TOPGEN]) == tg, bar);
            __builtin_amdgcn_fence(__ATOMIC_ACQUIRE, "agent");
            xb_add(&bar[XB_XGEN(b.x)], 1u);
            asm volatile("s_waitcnt vmcnt(0)" ::: "memory");
        } else {
            XB_SPIN(xb_ld(&bar[XB_XGEN(b.x)]) == gen, bar);
            __builtin_amdgcn_fence(__ATOMIC_ACQUIRE, "agent");
            asm volatile("s_waitcnt vmcnt(0)" ::: "memory");
        }
    }
    __syncthreads();
}

struct LatOrder {
    pg8::StaticOrder S;
    __device__ void init(int N, int G, int c) { S.init(NB * T, N, G, c); }
    __device__ bool next(int i, pg8::Unit& u) const { if (!S.next(i, u)) return false; u.pm = u.pm + 1 + (u.pm >= 32 ? 1 : 0); return true; }
    __device__ __forceinline__ void a_ready(const pg8::Unit&) const {}
    __device__ __forceinline__ void done(const pg8::Unit&) const {}
};
#ifndef PROBE_SEL
#define PROBE_SEL 0
#endif
#ifndef PROBE_MUL
#define PROBE_MUL 3
#endif
#define PACC_DECL unsigned long long pacc = 0, pacc_t0 = 0; (void)pacc; (void)pacc_t0;
#define PACC_BEGIN(k) if (PROBE_SEL == (k)) pacc_t0 = __builtin_amdgcn_s_memrealtime();
#define PACC_END(k) if (PROBE_SEL == (k)) pacc += __builtin_amdgcn_s_memrealtime() - pacc_t0;
#define PACC_SLEEP() if (PROBE_SEL >= 40 && PROBE_SEL < 60) { const unsigned long long t1 = __builtin_amdgcn_s_memrealtime(), dt = pacc * PROBE_MUL; while (__builtin_amdgcn_s_memrealtime() - t1 < dt) __builtin_amdgcn_s_sleep(8); }
#define PROBE_BEGIN(k) unsigned long long pt0_##k = 0; if (PROBE_SEL == (k)) pt0_##k = __builtin_amdgcn_s_memrealtime();
#define PROBE_END(k) if (PROBE_SEL == (k)) { const unsigned long long t1 = __builtin_amdgcn_s_memrealtime(), dt = (t1 - pt0_##k) * PROBE_MUL; while (__builtin_amdgcn_s_memrealtime() - t1 < dt) __builtin_amdgcn_s_sleep(8); }


template <int XT, int YT>
__device__ __forceinline__ void frag_gemm(pg8::f32x4 (&acc)[XT][YT], const bf16* X, int ldx, const bf16* Y, int ldy, int k0, int k1, int l15, int quad) {
#pragma unroll 4
    for (int k = k0; k < k1; k += 32) {
        bf16x8 xf[XT], yf[YT];
#pragma unroll
        for (int i = 0; i < XT; ++i) xf[i] = *(const bf16x8*)(X + (size_t)(i * 16 + l15) * ldx + k + quad * 8);
#pragma unroll
        for (int j = 0; j < YT; ++j) yf[j] = *(const bf16x8*)(Y + (size_t)(j * 16 + l15) * ldy + k + quad * 8);
#pragma unroll
        for (int i = 0; i < XT; ++i)
#pragma unroll
            for (int j = 0; j < YT; ++j) acc[i][j] = MFMA16(xf[i], yf[j], acc[i][j]);
    }
}
template <bool SRC_LN>
__device__ __forceinline__ void ctx_resid_tiles(const bf16* A, const bf16* Bt, int K, const float* src_ctx, float* dst_ctx, const float* gate_ctx, const float* rst, const float* lg, const float* lb, float* part, int bid, int G, int tid, int wave, int l15, int quad) {
    for (int t = bid; t < 256; t += G) {
        const int rt = t >> 5, c0 = (t & 31) * 32, b = rt >> 2, p0 = (rt & 3) * 64, r0 = b * TP + p0;
        pg8::f32x4 acc[4][2];
#pragma unroll
        for (int i = 0; i < 4; ++i)
#pragma unroll
            for (int j = 0; j < 2; ++j) acc[i][j] = (pg8::f32x4){0.f, 0.f, 0.f, 0.f};
        const int ksl = K >> 3;
        frag_gemm<4, 2>(acc, A + (size_t)r0 * K, K, Bt + (size_t)c0 * K, K, wave * ksl, (wave + 1) * ksl, l15, quad);
        float* pw = part + wave * 2048;
#pragma unroll
        for (int i = 0; i < 4; ++i)
#pragma unroll
            for (int j = 0; j < 2; ++j)
#pragma unroll
                for (int rg = 0; rg < 4; ++rg) pw[(i * 16 + quad * 4 + rg) * 32 + j * 16 + l15] = acc[i][j][rg];
        __syncthreads();
        { const int row = tid >> 3, c4 = (tid & 7) * 4;
          f32x4 sum = *(const f32x4*)(part + row * 32 + c4);
#pragma unroll
          for (int w = 1; w < 8; ++w) sum += *(const f32x4*)(part + w * 2048 + row * 32 + c4);
          const size_t off = (size_t)(b * L + p0 + row) * D + c0 + c4;
          f32x4 x4 = *(const f32x4*)(src_ctx + off); const f32x4 g4 = *(const f32x4*)(gate_ctx + c0 + c4);
          if (SRC_LN) { const int rU = r0 + row; x4 = (x4 - rst[2 * rU]) * rst[2 * rU + 1] * *(const f32x4*)(lg + c0 + c4) + *(const f32x4*)(lb + c0 + c4); }
          *(f32x4*)(dst_ctx + off) = x4 * ALPHA + g4 * sum; }
        __syncthreads();
    }
}
__device__ __forceinline__ void ctx_up_tiles(const bf16* A, const bf16* Bt, bf16* O, int bid, int G, int wave, int l15, int quad) {
    for (int t = bid; t < 256; t += G) {
        const int rt = t >> 5, c0 = (t & 31) * 128 + (wave & 3) * 32, b = rt >> 2, r0 = b * TP + (rt & 3) * 64 + (wave >> 2) * 32;
        pg8::f32x4 acc[2][2];
#pragma unroll
        for (int i = 0; i < 2; ++i)
#pragma unroll
            for (int j = 0; j < 2; ++j) acc[i][j] = (pg8::f32x4){0.f, 0.f, 0.f, 0.f};
        frag_gemm<2, 2>(acc, Bt + (size_t)c0 * D, D, A + (size_t)r0 * D, D, 0, D, l15, quad);
#pragma unroll
        for (int i = 0; i < 2; ++i)
#pragma unroll
            for (int j = 0; j < 2; ++j) { float v[4];
#pragma unroll
                for (int rg = 0; rg < 4; ++rg) { const float a_ = fmaxf(acc[i][j][rg], 0.f); v[rg] = a_ * a_; }
                u32x2 o; o.x = pk2(v[0], v[1]); o.y = pk2(v[2], v[3]);
                *(u32x2*)(O + (size_t)(r0 + j * 16 + l15) * FF + c0 + i * 16 + quad * 4) = o; }
    }
}

struct Args { const float* in[19]; float* out; unsigned char* ws; };

__global__ void __launch_bounds__(512, 2) fwd_kernel(Args a) {
    extern __shared__ __attribute__((aligned(16))) unsigned char lds[];
    cg::grid_group grid = cg::this_grid();
    const int G = gridDim.x, bid = blockIdx.x, NGW = G * 8;
#define IDS int tid = threadIdx.x; asm volatile("" : "+v"(tid)); const int lane = tid & 63, wave = __builtin_amdgcn_readfirstlane(tid >> 6), quad = lane >> 4, l15 = lane & 15, gw = bid * 8 + wave; (void)quad; (void)l15; (void)gw; (void)lane;
#define xin (a.in[0])
#define cvec (a.in[1])
#define ctx (a.in[2])
#define cctx (a.in[3])
#define w_mod (a.in[4])
#define b_mod (a.in[5])
#define ln_g (a.in[6])
#define ln_b (a.in[7])
#define theta (a.in[11])
#define gkw (a.in[12])
#define gkb (a.in[13])
#define normg (a.in[14])
#define sink (a.in[17])
#define WIN_T ((bf16*)(a.ws + OFF_WIN))
#define WOUT0_T ((bf16*)(a.ws + OFF_WOUT0))
#define W1_0_T ((bf16*)(a.ws + OFF_W1_0))
#define W2_0_T ((bf16*)(a.ws + OFF_W2_0))
#define WQKV_T ((bf16*)(a.ws + OFF_WQKV))
#define WOUT1_T ((bf16*)(a.ws + OFF_WOUT1))
#define W1_1_T ((bf16*)(a.ws + OFF_W1_1))
#define W2_1_T ((bf16*)(a.ws + OFF_W2_1))
#define mod ((float*)(a.ws + OFF_MOD))
#define rope ((float*)(a.ws + OFF_ROPE))
#define xctx ((float*)(a.ws + OFF_XCTX))
#define DEC ((float*)(a.ws + OFF_DEC))
#define H ((bf16*)(a.ws + OFF_H))
#define P ((bf16*)(a.ws + OFF_P))
#define ST ((bf16*)(a.ws + OFF_ST))
#define xlat (a.out)
#define RST(i) ((float*)(a.ws + OFF_RST) + (size_t)(i) * R * 2)

#define LATE_ITEMS 9472
#define LATE_CHUNK 16
#define DRAIN_LATE(scr_, maxc_) do { int nclaim_ = 0; unsigned* qc_ = (unsigned*)(a.ws + OFF_XBAR) + 3584; volatile unsigned* qw_ = (volatile unsigned*)(lds + 131072 + 1024); \
        for (;;) { if (nclaim_++ >= (maxc_)) break; if (tid == 0) qw_[0] = __hip_atomic_fetch_add(qc_, (unsigned)LATE_CHUNK, __ATOMIC_RELAXED, __HIP_MEMORY_SCOPE_AGENT);     \
            __syncthreads(); const int base_ = (int)__builtin_amdgcn_readfirstlane(qw_[0]); __syncthreads(); \
            if (base_ >= LATE_ITEMS) break; \
            for (int k_ = wave; k_ < LATE_CHUNK; k_ += 8) { int r_ = base_ + k_; if (r_ >= LATE_ITEMS) break; \
                if (r_ < 2048) { transpose_item(a.in[8], 1024, FF, W1_0_T, (scr_), r_, lane); continue; } r_ -= 2048; \
                if (r_ < 2048) { transpose_item(a.in[9], FF, 1024, W2_0_T, (scr_), r_, lane); continue; } r_ -= 2048; \
                if (r_ < 768) { transpose_item(a.in[16], 1024, NQKV, WQKV_T, (scr_), r_, lane); continue; } r_ -= 768; \
                if (r_ < 512) { transpose_item(a.in[18], 1024, 1024, WOUT1_T, (scr_), r_, lane); continue; } r_ -= 512; \
                if (r_ < 2048) { transpose_item(a.in[8] + (size_t)1024 * FF, 1024, FF, W1_1_T, (scr_), r_, lane); continue; } r_ -= 2048; \
                transpose_item(a.in[9] + (size_t)FF * 1024, FF, 1024, W2_1_T, (scr_), r_, lane); } } } while (0)
    PG8_LAS unsigned char* ldsg = (PG8_LAS unsigned char*)lds;
    unsigned* barw = (unsigned*)(a.ws + OFF_BAR); unsigned bar_target = 0u; (void)barw; (void)bar_target;
    unsigned* xbw = (unsigned*)(a.ws + OFF_XBAR);
    volatile unsigned* xst = (volatile unsigned*)(lds + 131072 + 512);
    if (threadIdx.x == 0) { xst[0] = 0u; xst[1] = 0u; }
    XcdBarrier xbar = xcd_barrier_post(xbw, xst);
    if (a.ws == nullptr) grid.sync();

PROBE_BEGIN(1)
    { IDS
        float* sl = (float*)lds; float* red = (float*)(lds + 12288);
        for (int item = bid; item < 192; item += G) {
            for (int i = tid; i < 3072; i += 512) { const int j = i >> 10, k = i & 1023; const float v = (j < 2) ? cvec[j * 1024 + k] : cctx[k]; sl[i] = v / (1.f + expf(-v)); }
            __syncthreads();
            const int layer = item / 96, n0 = (item % 96) * 64;
            const float* W = w_mod + (size_t)layer * 1024 * 6144 + n0 + lane;
            float a0 = 0.f, a1 = 0.f, a2 = 0.f; const int k0 = wave * 128;
#pragma unroll 8
            for (int kk = 0; kk < 128; ++kk) { const int k = k0 + kk; const float w = W[(size_t)k * 6144]; a0 += sl[k] * w; a1 += sl[1024 + k] * w; a2 += sl[2048 + k] * w; }
            red[(wave * 3 + 0) * 64 + lane] = a0; red[(wave * 3 + 1) * 64 + lane] = a1; red[(wave * 3 + 2) * 64 + lane] = a2;
            __syncthreads();
            if (tid < 192) { const int j = tid >> 6, col = tid & 63; float s = b_mod[layer * 6144 + n0 + col];
#pragma unroll
                for (int w = 0; w < 8; ++w) s += red[(w * 3 + j) * 64 + col];
                mod[(layer * 3 + j) * 6144 + n0 + col] = s; }
            __syncthreads();
        }
        if (bid == G - 1 && tid < 16) {
            double f = 1.0; for (int i = 0; i < tid; ++i) f *= 0.56234132519034908;
            const double x2 = f * f; double cs = 1.0, sn = f, tc = 1.0, ts = f;
            for (int n = 1; n <= 12; ++n) { tc *= -x2 / (double)((2 * n - 1) * (2 * n)); cs += tc; ts *= -x2 / (double)((2 * n) * (2 * n + 1)); sn += ts; }
            double c = 1.0, s = 0.0;
            for (int p = 0; p < 128; ++p) { rope[(p * 16 + tid) * 2] = (float)c; rope[(p * 16 + tid) * 2 + 1] = (float)s; const double nc = c * cs - s * sn; s = s * cs + c * sn; c = nc; }
        }
        float* scr = (float*)(lds + 32768 + wave * 8448);
        for (int it = gw; it < 2064; it += NGW) {
            int r = it;
            if (r < 1552) { transpose_item(a.in[10], 1024, NPROJ, WIN_T, scr, r, lane); continue; } r -= 1552;
            transpose_item(a.in[15], 1024, 1024, WOUT0_T, scr, r, lane);
        }
        { u32x4* z = (u32x4*)(WIN_T + (size_t)NPROJ * D); const u32x4 zero = {0u, 0u, 0u, 0u};
          for (int i = bid * 512 + tid; i < (NPROJ_PAD - NPROJ) * D / 8; i += G * 512) z[i] = zero; }
    }
PROBE_END(1)
    xcd_barrier(xbar);


PROBE_BEGIN(2)
    { IDS
    for (int r = gw; r < R; r += 2 * NGW) {
        const int r2 = r + NGW; const bool has2 = r2 < R;
        bool isc, isc2; int b, b2; const size_t off = row_off(r, isc, b), off2 = row_off(has2 ? r2 : r, isc2, b2);
        const float* xr = (isc ? ctx : xin) + off; const float* md = mod + (isc ? 2 : b) * 6144;
        const float* xr2 = (isc2 ? ctx : xin) + off2; const float* md2 = mod + (isc2 ? 2 : b2) * 6144;
        f32x4 va[4], vb[4];
#pragma unroll
        for (int j = 0; j < 4; ++j) { va[j] = *(const f32x4*)(xr + lane * 4 + 256 * j); vb[j] = *(const f32x4*)(xr2 + lane * 4 + 256 * j); }
#pragma unroll
        for (int j = 0; j < 4; ++j) {
            const int idx = lane * 4 + 256 * j;
            { const f32x4 sh = *(const f32x4*)(md + idx), sc = *(const f32x4*)(md + 1024 + idx);
              const f32x4 h = va[j] * (sc + 1.f) + sh; u32x2 o; o.x = pk2(h.x, h.y); o.y = pk2(h.z, h.w);
              *(u32x2*)(H + (size_t)r * D + idx) = o; }
            if (has2) { const f32x4 sh = *(const f32x4*)(md2 + idx), sc = *(const f32x4*)(md2 + 1024 + idx);
              const f32x4 h = vb[j] * (sc + 1.f) + sh; u32x2 o; o.x = pk2(h.x, h.y); o.y = pk2(h.z, h.w);
              *(u32x2*)(H + (size_t)r2 * D + idx) = o; }
        }
    }
    }
PROBE_END(2)
    xcd_barrier(xbar);
    if (PROBE_SEL == 10) { for (int i = 0; i < 10; ++i) xcd_barrier(xbar); }

PROBE_BEGIN(8)
    { pg8::Gemm g{H, WIN_T, R, NPROJ_PAD, D}; pg8::StaticOrder S; S.init(R, NPROJ_PAD, G, bid); EpiStore<0> E{P, NPROJ, NPROJ};
      pg8::gemm_phase<EpiStore<0>, pg8::StaticOrder, true, true>(ldsg, g, S, E); }
PROBE_END(8)
    xcd_barrier(xbar);

PROBE_BEGIN(3)
#ifndef NO_P3
    { IDS
        float* cf = (float*)lds; float* cb = (float*)(lds + 16640); float* lrs = (float*)(lds + 33280); float* wl = (float*)(lds + 41728);
        bf16* kTf = (bf16*)(lds + 50432); bf16* kTb = (bf16*)(lds + 59648); bf16* vT = (bf16*)(lds + 68864);
        constexpr int NU = NB * 2 * 4 * NCH;
        const int s = tid & 63, dc = tid >> 6;
        u32x4 kv = {0u, 0u, 0u, 0u}, vv0 = kv, vv1 = kv; GatePre gp; gp.lr = (u32x2){0u, 0u}; gp.w = (f32x4){0.f, 0.f, 0.f, 0.f}; gp.bias = 0.f;
#define P3_LOAD(U) do { const int pc_ = (U) % NCH, t_ = (U) / NCH, h_ = t_ & 3, g_ = (t_ >> 2) & 1, b_ = t_ >> 3; const bf16* Pr_ = P + (size_t)(b_ * TP + pc_ * 64) * NPROJ; \
            const int kcol_ = g_ ? 1792 + h_ * 64 : 256 + h_ * 64, vcol_ = g_ ? 2048 + h_ * 128 : 512 + h_ * 128; \
            kv = *(const u32x4*)(Pr_ + (size_t)s * NPROJ + kcol_ + dc * 8); vv0 = *(const u32x4*)(Pr_ + (size_t)s * NPROJ + vcol_ + dc * 8); vv1 = *(const u32x4*)(Pr_ + (size_t)s * NPROJ + vcol_ + (dc + 8) * 8); \
            gp = gate_prefetch(g_, h_, Pr_, gkw, gkb, tid); } while (0)
        if (bid < NU) P3_LOAD(bid);
        for (int unit = bid; unit < NU; unit += G) {
            const int pc = unit % NCH, t = unit / NCH, h = t & 3, g = (t >> 2) & 1, b = t >> 3;
            const float kscale = g ? 1.f : 0.125f;
            fill_cum3(cf, cb, lrs, wl, g, h, gp, theta, tid);
            {
#pragma unroll
              for (int j = 0; j < 8; ++j) { const int d = dc * 8 + j; const unsigned u = kv[j >> 1]; const float kf = ((j & 1) ? bfhi(u) : bflo(u)) * kscale;
                  kTf[d * 72 + s] = (bf16)f2bf(kf * __expf(cf[63 * CS + d] - cf[s * CS + d]));
                  kTb[d * 72 + s] = (bf16)f2bf(kf * __expf(cb[d] - cb[s * CS + d])); }
#pragma unroll
              for (int j = 0; j < 8; ++j) { const unsigned u0 = vv0[j >> 1], u1 = vv1[j >> 1];
                  vT[(dc * 8 + j) * 72 + s] = (bf16)((j & 1) ? (u0 >> 16) : (u0 & 0xffffu)); vT[((dc + 8) * 8 + j) * 72 + s] = (bf16)((j & 1) ? (u1 >> 16) : (u1 & 0xffffu)); }
            }
            const int seq0 = ((b * 2 + g) * 4 + h) * 2;
            const int nf = pc, nbk = (pc < 4) ? 3 - pc : 135 - pc;
            if (tid < 128) { const int dir = tid >> 6, d = tid & 63;
                DEC[((size_t)(seq0 + dir) * NCH + (dir ? nbk : nf)) * 64 + d] = dir ? expf(cb[d]) : expf(cf[63 * CS + d]); }
            if (unit + G < NU) P3_LOAD(unit + G);
            __syncthreads();
            bf16x8 bfr[2];
#pragma unroll
            for (int ks = 0; ks < 2; ++ks) bfr[ks] = *(const bf16x8*)(vT + (wave * 16 + l15) * 72 + ks * 32 + quad * 8);
#pragma unroll
            for (int dir = 0; dir < 2; ++dir) {
                const bf16* kT = dir ? kTb : kTf;
                bf16* dst = ST + ((size_t)(seq0 + dir) * NCH + (dir ? nbk : nf)) * 8192 + (size_t)(wave * 16 + l15) * 64;
#pragma unroll
                for (int dt = 0; dt < 4; ++dt) {
                    pg8::f32x4 acc = {0.f, 0.f, 0.f, 0.f};
#pragma unroll
                    for (int ks = 0; ks < 2; ++ks) { const bf16x8 af = *(const bf16x8*)(kT + (dt * 16 + l15) * 72 + ks * 32 + quad * 8); acc = MFMA16(af, bfr[ks], acc); }
                    u32x2 o; o.x = pk2(acc[0], acc[1]); o.y = pk2(acc[2], acc[3]);
                    *(u32x2*)(dst + dt * 16 + quad * 4) = o;
                }
            }
            __syncthreads();
        }
#undef P3_LOAD
        if ((NU - bid + G - 1) / G < (NU + G - 1) / G) DRAIN_LATE((float*)(lds + wave * 8448), 1);
    }
#endif
PROBE_END(3)
    xcd_barrier(xbar);

PROBE_BEGIN(4)
    { IDS
    for (int i = bid * 512 + tid; i < 32 * 4096; i += G * 512) {
        const int seq = i >> 12, pi = i & 4095, d = (2 * pi) & 63;
        unsigned* sp = (unsigned*)(ST + (size_t)seq * NCH * 8192) + pi; const float* dp = DEC + (size_t)seq * NCH * 64 + d;
        float s0 = 0.f, s1 = 0.f;
#pragma unroll 4
        for (int n = 0; n < NCH; ++n) {
            const unsigned kv = sp[(size_t)n * 4096]; const float d0 = dp[n * 64], d1 = dp[n * 64 + 1];
            sp[(size_t)n * 4096] = pk2(s0, s1);
            s0 = d0 * s0 + bflo(kv); s1 = d1 * s1 + bfhi(kv);
        }
    }
    }
PROBE_END(4)
    xcd_barrier(xbar);

PROBE_BEGIN(5)
#ifndef NO_P5
    { IDS
        float* cf = (float*)lds; float* cb = (float*)(lds + 16640); float* lrs = (float*)(lds + 33280); float* wl = (float*)(lds + 41728);
        bf16* qdf = (bf16*)(lds + 50432); bf16* kif = (bf16*)(lds + 59648); bf16* qdb = (bf16*)(lds + 68864); bf16* kib = (bf16*)(lds + 78080);
        bf16* vT = (bf16*)(lds + 87296); bf16* Am = (bf16*)(lds + 105728); float* red = (float*)(lds + 114944);
        constexpr int NU = NB * 2 * 4 * NCH;
        const int dcq = tid & 7, sq = tid >> 3, sv = tid & 63, dcv = tid >> 6;
        u32x4 qv = {0u, 0u, 0u, 0u}, kv = qv, vv0 = qv, vv1 = qv; GatePre gp; gp.lr = (u32x2){0u, 0u}; gp.w = (f32x4){0.f, 0.f, 0.f, 0.f}; gp.bias = 0.f;
#define P5_LOAD(U) do { const int pc_ = (U) % NCH, t_ = (U) / NCH, h_ = t_ & 3, g_ = (t_ >> 2) & 1, b_ = t_ >> 3; const bf16* Pr_ = P + (size_t)(b_ * TP + pc_ * 64) * NPROJ; \
            const int qcol_ = g_ ? 1536 + h_ * 64 : h_ * 64, kcol_ = g_ ? 1792 + h_ * 64 : 256 + h_ * 64, vcol_ = g_ ? 2048 + h_ * 128 : 512 + h_ * 128; \
            qv = *(const u32x4*)(Pr_ + (size_t)sq * NPROJ + qcol_ + dcq * 8); kv = *(const u32x4*)(Pr_ + (size_t)sq * NPROJ + kcol_ + dcq * 8); \
            vv0 = *(const u32x4*)(Pr_ + (size_t)sv * NPROJ + vcol_ + dcv * 8); vv1 = *(const u32x4*)(Pr_ + (size_t)sv * NPROJ + vcol_ + (dcv + 8) * 8); \
            gp = gate_prefetch(g_, h_, Pr_, gkw, gkb, tid); } while (0)
        if (bid < NU) P5_LOAD(bid);
        for (int unit = bid; unit < NU; unit += G) {
            const int pc = unit % NCH, t = unit / NCH, h = t & 3, g = (t >> 2) & 1, b = t >> 3;
            const int r0 = b * TP + pc * 64;
            const int gcol = g ? 2560 + h * 128 : 1024 + h * 128;
            const float qscale = g ? 0.125f : 1.f, kscale = g ? 1.f : 0.125f;
            fill_cum3(cf, cb, lrs, wl, g, h, gp, theta, tid);
            { u32x4 o1, o2, o3, o4;
#pragma unroll
              for (int j2 = 0; j2 < 4; ++j2) {
                  const int d = dcq * 8 + 2 * j2;
                  const float f0 = cf[sq * CS + d], f1 = cf[sq * CS + d + 1], b0 = cb[sq * CS + d], b1 = cb[sq * CS + d + 1];
                  const float q0 = bflo(qv[j2]) * qscale, q1 = bfhi(qv[j2]) * qscale, k0 = bflo(kv[j2]) * kscale, k1 = bfhi(kv[j2]) * kscale;
                  o1[j2] = pk2(q0 * __expf(f0), q1 * __expf(f1)); o2[j2] = pk2(k0 * __expf(-f0), k1 * __expf(-f1));
                  o3[j2] = pk2(q0 * __expf(b0), q1 * __expf(b1)); o4[j2] = pk2(k0 * __expf(-b0), k1 * __expf(-b1));
              }
              *(u32x4*)(qdf + sq * 72 + dcq * 8) = o1; *(u32x4*)(kif + sq * 72 + dcq * 8) = o2; *(u32x4*)(qdb + sq * 72 + dcq * 8) = o3; *(u32x4*)(kib + sq * 72 + dcq * 8) = o4;
#pragma unroll
              for (int j = 0; j < 8; ++j) { const unsigned u0 = vv0[j >> 1], u1 = vv1[j >> 1];
                  vT[(dcv * 8 + j) * 72 + sv] = (bf16)((j & 1) ? (u0 >> 16) : (u0 & 0xffffu)); vT[((dcv + 8) * 8 + j) * 72 + sv] = (bf16)((j & 1) ? (u1 >> 16) : (u1 & 0xffffu)); }
            }
            __syncthreads();
            const int ct = wave & 3, eh = wave >> 2;
            const int seq0 = ((b * 2 + g) * 4 + h) * 2;
            const int nf = pc, nbk = (pc < 4) ? 3 - pc : 135 - pc;
            const bf16* Sf = ST + ((size_t)seq0 * NCH + nf) * 8192; const bf16* Sb = ST + ((size_t)(seq0 + 1) * NCH + nbk) * 8192;
            const int r = r0 + ct * 16 + l15;
            bf16x8 a2[4][2], a3[4][2]; u32x2 gv[4];
#pragma unroll
            for (int et = 0; et < 4; ++et) { const int e = (eh * 4 + et) * 16 + l15;
#pragma unroll
                for (int ks = 0; ks < 2; ++ks) { a2[et][ks] = *(const bf16x8*)(Sf + e * 64 + ks * 32 + quad * 8); a3[et][ks] = *(const bf16x8*)(Sb + e * 64 + ks * 32 + quad * 8); }
                gv[et] = *(const u32x2*)(P + (size_t)r * NPROJ + gcol + (eh * 4 + et) * 16 + quad * 4); }
            { bf16x8 af[2], ab[2];
#pragma unroll
              for (int ks = 0; ks < 2; ++ks) { af[ks] = *(const bf16x8*)(qdf + (ct * 16 + l15) * 72 + ks * 32 + quad * 8); ab[ks] = *(const bf16x8*)(qdb + (ct * 16 + l15) * 72 + ks * 32 + quad * 8); }
#pragma unroll
              for (int i = 0; i < 2; ++i) { const int st = (wave >> 2) * 2 + i;
                  pg8::f32x4 accf = {0.f, 0.f, 0.f, 0.f}, accb = {0.f, 0.f, 0.f, 0.f};
#pragma unroll
                  for (int ks = 0; ks < 2; ++ks) {
                      const bf16x8 bf_ = *(const bf16x8*)(kif + (st * 16 + l15) * 72 + ks * 32 + quad * 8), bb_ = *(const bf16x8*)(kib + (st * 16 + l15) * 72 + ks * 32 + quad * 8);
                      accf = MFMA16(af[ks], bf_, accf); accb = MFMA16(ab[ks], bb_, accb); }
                  const int scol = st * 16 + l15;
#pragma unroll
                  for (int rg = 0; rg < 4; ++rg) { const int c = ct * 16 + quad * 4 + rg; Am[c * 72 + scol] = (bf16)f2bf(scol <= c ? accf[rg] : accb[rg]); }
              }
            }
            if (unit + G < NU) P5_LOAD(unit + G);
            __syncthreads();
            { bf16x8 bA[2], bQf[2], bQb[2];
#pragma unroll
              for (int ks = 0; ks < 2; ++ks) { const int o = (ct * 16 + l15) * 72 + ks * 32 + quad * 8; bA[ks] = *(const bf16x8*)(Am + o); bQf[ks] = *(const bf16x8*)(qdf + o); bQb[ks] = *(const bf16x8*)(qdb + o); }
              pg8::f32x4 acc[4]; float ss = 0.f;
#pragma unroll
              for (int et = 0; et < 4; ++et) { const int e = (eh * 4 + et) * 16 + l15;
                  pg8::f32x4 c4 = {0.f, 0.f, 0.f, 0.f};
#pragma unroll
                  for (int ks = 0; ks < 2; ++ks) {
                      const bf16x8 a1 = *(const bf16x8*)(vT + e * 72 + ks * 32 + quad * 8);
                      c4 = MFMA16(a1, bA[ks], c4); c4 = MFMA16(a2[et][ks], bQf[ks], c4); c4 = MFMA16(a3[et][ks], bQb[ks], c4); }
                  acc[et] = c4; ss += (c4[0] * c4[0] + c4[1] * c4[1]) + (c4[2] * c4[2] + c4[3] * c4[3]); }
              ss = quad_sum(ss);
              if (quad == 0) red[eh * 64 + ct * 16 + l15] = ss;
              __syncthreads();
              const float tot = red[ct * 16 + l15] + red[64 + ct * 16 + l15];
              const float rinv = 1.f / sqrtf(tot * (1.f / 128.f) + 1e-6f);
#pragma unroll
              for (int et = 0; et < 4; ++et) { const int e0 = (eh * 4 + et) * 16 + quad * 4;
                  float gt[4] = {bflo(gv[et].x), bfhi(gv[et].x), bflo(gv[et].y), bfhi(gv[et].y)}; float y[4];
#pragma unroll
                  for (int i = 0; i < 4; ++i) { const float ng = g ? normg[e0 + i] : 1.f; const float sg = gt[i] * __builtin_amdgcn_rcpf(1.f + __expf(-gt[i])); y[i] = sg * acc[et][i] * rinv * ng; }
                  u32x2 o; o.x = pk2(y[0], y[1]); o.y = pk2(y[2], y[3]);
                  *(u32x2*)(H + (size_t)r * D + g * 512 + h * 128 + e0) = o; }
            }
            __syncthreads();
        }
#undef P5_LOAD
        if ((NU - bid + G - 1) / G < (NU + G - 1) / G) DRAIN_LATE((float*)(lds + wave * 8448), 2);
    }
#endif
PROBE_END(5)
    xcd_barrier(xbar);

PROBE_BEGIN(12)
    { pg8::Gemm g{H, WOUT0_T, R, D, D}; LatOrder S; S.init(D, G, bid); EpiResid<false> E{xin, ctx, xlat, xctx, mod + 2 * 1024, nullptr, nullptr, nullptr};
      pg8::gemm_phase<EpiResid<false>, LatOrder, true, true>(ldsg, g, S, E); }
    { IDS
      ctx_resid_tiles<false>(H, WOUT0_T, D, ctx, xctx, mod + 2 * 6144 + 2 * 1024, nullptr, nullptr, nullptr, (float*)lds, bid, G, tid, wave, l15, quad); }
PROBE_END(12)
    xcd_barrier(xbar);
PROBE_BEGIN(7)
    { IDS
    DRAIN_LATE((float*)(lds + wave * 8448), 1 << 30);
    ln_phase<false, false>(RST(0), xlat, xctx, ln_g, ln_b, mod + 3 * 1024, H, gw, NGW, lane);
    }
PROBE_END(7)
    xcd_barrier(xbar);
PROBE_BEGIN(11)
    { pg8::Gemm g{H, W1_0_T, R, FF, D}; LatOrder S; S.init(FF, G, bid); EpiStore<1> E{P, FF, FF};
      pg8::gemm_phase<EpiStore<1>, LatOrder, true, true>(ldsg, g, S, E); }
    { IDS
      ctx_up_tiles(H, W1_0_T, P, bid, G, wave, l15, quad); }
PROBE_END(11)
    xcd_barrier(xbar);
PROBE_BEGIN(9)
    { pg8::Gemm g{P, W2_0_T, R, D, FF}; LatOrder S; S.init(D, G, bid); EpiResid<true> E{xlat, xctx, xlat, xctx, mod + 5 * 1024, RST(0), ln_g, ln_b};
      pg8::gemm_phase<EpiResid<true>, LatOrder, true, true>(ldsg, g, S, E); }
    { IDS
      ctx_resid_tiles<true>(P, W2_0_T, FF, xctx, xctx, mod + 2 * 6144 + 5 * 1024, RST(0), ln_g, ln_b, (float*)lds, bid, G, tid, wave, l15, quad); }
PROBE_END(9)
    xcd_barrier(xbar);
    { IDS
    ln_phase<false, false>(RST(1), xlat, xctx, ln_g + 1024, ln_b + 1024, mod + 3 * 6144, H, gw, NGW, lane);
    }
    xcd_barrier(xbar);

PROBE_BEGIN(13)
    { pg8::Gemm g{H, WQKV_T, R, NQKV, D}; pg8::StaticOrder S; S.init(R, NQKV, G, bid); EpiStore<0> E{P, NQKV, NQKV};
      pg8::gemm_phase<EpiStore<0>, pg8::StaticOrder, true, true>(ldsg, g, S, E); }
PROBE_END(13)
    xcd_barrier(xbar);

PROBE_BEGIN(6)
#ifndef NO_P12
    { IDS
        bf16* Qs = (bf16*)lds; bf16* Ks = (bf16*)(lds + 73728); bf16* Vt = (bf16*)(lds + 82944); float* ropes = (float*)(lds + 92160);
        for (int i = tid; i < 1024; i += 512) ((f32x4*)ropes)[i] = ((const f32x4*)rope)[i];
        PACC_DECL
        for (int unit = bid; unit < NB * 4 * 64; unit += G) {
            PACC_BEGIN(40)
            const int nb = unit & 63, kvh = (unit >> 6) & 3, b = unit >> 8;
#define ATT_VALID(t) ((t) < 4 || (unsigned)(nb - 1 + (((t) - 4) >> 1)) < 64u)
#define ATT_KPOS(t) ((nb - 1 + (((t) - 4) >> 1)) * 128 + (((t) - 4) & 1) * 64)
#define ATT_KROW(t) ((t) < 4 ? b * TP + (t) * 64 : b * TP + L + ATT_KPOS(t))
            const int keyk = tid >> 2, pck = tid & 3, c1k = (pck & 1) + (pck >> 1) * 4, keyv = tid & 63, dcv = tid >> 6;
            u32x4 pk1 = {0u, 0u, 0u, 0u}, pk2_ = pk1, pvv = pk1;
#define ATT_LOAD(t) do { const int kr_ = ATT_KROW(t); \
                if (tid < 256) { const bf16* src_ = P + (size_t)(kr_ + keyk) * NQKV + 1024 + kvh * 64; pk1 = *(const u32x4*)(src_ + c1k * 8); pk2_ = *(const u32x4*)(src_ + (c1k + 2) * 8); } \
                pvv = *(const u32x4*)(P + (size_t)(kr_ + keyv) * NQKV + 1280 + kvh * 64 + dcv * 8); } while (0)
            ATT_LOAD(0);
            __syncthreads();
#pragma unroll
            for (int i = 0; i < 4; ++i) {
                const int it = tid + i * 512, pcq = it & 3, row = it >> 2, g = row >> 7, qi = row & 127, pos = nb * 128 + qi;
                const bf16* src = P + (size_t)(b * TP + L + pos) * NQKV + (kvh * 4 + g) * 64;
                const int c1 = (pcq & 1) + (pcq >> 1) * 4;
                const u32x4 u1 = *(const u32x4*)(src + c1 * 8), u2 = *(const u32x4*)(src + (c1 + 2) * 8);
                const int pv = (pcq < 2) ? (pos >> 6) : (pos & 63);
                const f32x4* tab = (const f32x4*)(ropes + (pv * 16 + (c1 & 1) * 8) * 2);
                u32x4 o1, o2;
#pragma unroll
                for (int j2 = 0; j2 < 4; ++j2) { const f32x4 cs = tab[j2];
                    const float a0 = bflo(u1[j2]), a1 = bfhi(u1[j2]), b0 = bflo(u2[j2]), b1 = bfhi(u2[j2]);
                    o1[j2] = pk2((a0 * cs.x - b0 * cs.y) * QSC, (a1 * cs.z - b1 * cs.w) * QSC); o2[j2] = pk2((a0 * cs.y + b0 * cs.x) * QSC, (a1 * cs.w + b1 * cs.z) * QSC); }
                *(u32x4*)(Qs + row * 72 + c1 * 8) = o1; *(u32x4*)(Qs + row * 72 + (c1 + 2) * 8) = o2;
            }
            const int g = wave >> 1, qrow0 = g * 128 + (wave & 1) * 64, qpos0 = nb * 128 + (wave & 1) * 64;
            float mrun[4], lrun[4]; pg8::f32x4 O[4][4];
            const float sk = sink[kvh * 4 + g] * 1.4426950408889634f;
#pragma unroll
            for (int qt = 0; qt < 4; ++qt) { mrun[qt] = sk; lrun[qt] = (quad == 0) ? 1.f : 0.f;
#pragma unroll
                for (int dt = 0; dt < 4; ++dt) O[dt][qt] = (pg8::f32x4){0.f, 0.f, 0.f, 0.f}; }
            PACC_END(40)
            int ti = 0;
            while (ti < 10) {
                PACC_BEGIN(41)
                const bool local = ti >= 4;
                const int kpos0 = local ? ATT_KPOS(ti) : 0;
                const int side = local ? ((ti - 4) >> 1) - 1 : 0;
                __syncthreads();
                if (tid < 256) {
                    u32x4 o1 = pk1, o2 = pk2_;
                    if (local) {
                        const int pos = kpos0 + keyk, pv = (pck < 2) ? (pos >> 6) : (pos & 63);
                        const f32x4* tab = (const f32x4*)(ropes + (pv * 16 + (c1k & 1) * 8) * 2);
#pragma unroll
                        for (int j2 = 0; j2 < 4; ++j2) { const f32x4 cs = tab[j2];
                            const float a0 = bflo(pk1[j2]), a1 = bfhi(pk1[j2]), b0 = bflo(pk2_[j2]), b1 = bfhi(pk2_[j2]);
                            o1[j2] = pk2(a0 * cs.x - b0 * cs.y, a1 * cs.z - b1 * cs.w); o2[j2] = pk2(a0 * cs.y + b0 * cs.x, a1 * cs.w + b1 * cs.z); }
                    }
                    *(u32x4*)(Ks + keyk * 72 + c1k * 8) = o1; *(u32x4*)(Ks + keyk * 72 + (c1k + 2) * 8) = o2;
                }
#pragma unroll
                for (int j = 0; j < 8; ++j) { const unsigned u = pvv[j >> 1]; Vt[(dcv * 8 + j) * 72 + keyv] = (bf16)((j & 1) ? (u >> 16) : (u & 0xffffu)); }
                __syncthreads();
                PACC_END(41)
                PACC_BEGIN(42)
                int tn = ti + 1;
                while (tn < 10 && !ATT_VALID(tn)) ++tn;
                if (tn < 10) ATT_LOAD(tn);
                bf16x8 kfr[4][2];
#pragma unroll
                for (int kt = 0; kt < 4; ++kt)
#pragma unroll
                    for (int ks = 0; ks < 2; ++ks) kfr[kt][ks] = *(const bf16x8*)(Ks + (kt * 16 + l15) * 72 + ks * 32 + quad * 8);
#pragma unroll
                for (int qt = 0; qt < 4; ++qt) {
                    pg8::f32x4 S[4];
#pragma unroll
                    for (int kt = 0; kt < 4; ++kt) S[kt] = (pg8::f32x4){0.f, 0.f, 0.f, 0.f};
#pragma unroll
                    for (int ks = 0; ks < 2; ++ks) { const bf16x8 qf = *(const bf16x8*)(Qs + (qrow0 + qt * 16 + l15) * 72 + ks * 32 + quad * 8);
#pragma unroll
                        for (int kt = 0; kt < 4; ++kt) S[kt] = MFMA16(kfr[kt][ks], qf, S[kt]); }
                    float mx = -INFINITY;
                    if (side < 0) {
                        const int tl = quad * 4 - (qpos0 + qt * 16 + l15 - kpos0 - 128);
#pragma unroll
                        for (int kt = 0; kt < 4; ++kt)
#pragma unroll
                            for (int rg = 0; rg < 4; ++rg) { const float sv_ = (tl >= -(kt * 16 + rg)) ? S[kt][rg] : -INFINITY; S[kt][rg] = sv_; mx = fmaxf(mx, sv_); }
                    } else if (side > 0) {
                        const int th = (qpos0 + qt * 16 + l15 - kpos0 + 128) - quad * 4;
#pragma unroll
                        for (int kt = 0; kt < 4; ++kt)
#pragma unroll
                            for (int rg = 0; rg < 4; ++rg) { const float sv_ = (th >= (kt * 16 + rg)) ? S[kt][rg] : -INFINITY; S[kt][rg] = sv_; mx = fmaxf(mx, sv_); }
                    } else {
#pragma unroll
                        for (int kt = 0; kt < 4; ++kt)
#pragma unroll
                            for (int rg = 0; rg < 4; ++rg) mx = fmaxf(mx, S[kt][rg]);
                    }
                    mx = quad_max(mx);
                    const float mnew = fmaxf(mrun[qt], mx), al = __builtin_amdgcn_exp2f(mrun[qt] - mnew); mrun[qt] = mnew;
                    float ps = 0.f;
#pragma unroll
                    for (int kt = 0; kt < 4; ++kt)
#pragma unroll
                        for (int rg = 0; rg < 4; ++rg) { const float p = __builtin_amdgcn_exp2f(S[kt][rg] - mnew); S[kt][rg] = p; ps += p; }
                    lrun[qt] = lrun[qt] * al + ps;
#pragma unroll
                    for (int dt = 0; dt < 4; ++dt) O[dt][qt] = O[dt][qt] * al;
#pragma unroll
                    for (int s2 = 0; s2 < 2; ++s2) {
                        u32x4 pw; pw.x = pk2(S[2 * s2][0], S[2 * s2][1]); pw.y = pk2(S[2 * s2][2], S[2 * s2][3]);
                        pw.z = pk2(S[2 * s2 + 1][0], S[2 * s2 + 1][1]); pw.w = pk2(S[2 * s2 + 1][2], S[2 * s2 + 1][3]);
                        const bf16x8 pf = __builtin_bit_cast(bf16x8, pw);
#pragma unroll
                        for (int dt = 0; dt < 4; ++dt) {
                            const s16x4 lo = *(const s16x4*)(Vt + (dt * 16 + l15) * 72 + s2 * 32 + quad * 4), hi = *(const s16x4*)(Vt + (dt * 16 + l15) * 72 + s2 * 32 + 16 + quad * 4);
                            O[dt][qt] = MFMA16(__builtin_shufflevector(lo, hi, 0, 1, 2, 3, 4, 5, 6, 7), pf, O[dt][qt]); }
                    }
                }
                ti = tn;
                PACC_END(42)
            }
            PACC_BEGIN(43)
#pragma unroll
            for (int qt = 0; qt < 4; ++qt) {
                const float lt = quad_sum(lrun[qt]);
                const float inv = 1.f / lt;
                const int r = b * TP + L + qpos0 + qt * 16 + l15;
#pragma unroll
                for (int dt = 0; dt < 4; ++dt) { u32x2 o; o.x = pk2(O[dt][qt][0] * inv, O[dt][qt][1] * inv); o.y = pk2(O[dt][qt][2] * inv, O[dt][qt][3] * inv);
                    *(u32x2*)(H + (size_t)r * D + (kvh * 4 + g) * 64 + dt * 16 + quad * 4) = o; }
            }
            PACC_END(43)
#undef ATT_VALID
#undef ATT_KPOS
#undef ATT_KROW
#undef ATT_LOAD
        }
        PACC_SLEEP()
    }
#endif
PROBE_END(6)
    xcd_barrier(xbar);

PROBE_BEGIN(14)
    { pg8::Gemm g{H, WOUT1_T, R, D, D}; LatOrder S; S.init(D, G, bid); EpiResid<true> E{xlat, xctx, xlat, xctx, mod + 3 * 6144 + 2 * 1024, RST(1), ln_g + 1024, ln_b + 1024};
      pg8::gemm_phase<EpiResid<true>, LatOrder, true, true>(ldsg, g, S, E); }
PROBE_END(14)
    xcd_barrier(xbar);
    { IDS
    ln_phase<false, true>(RST(2), xlat, xctx, ln_g + 2048, ln_b + 2048, mod + 3 * 6144 + 3 * 1024, H, gw, NGW, lane);
    }
    xcd_barrier(xbar);
PROBE_BEGIN(15)
    { pg8::Gemm g{H, W1_1_T, R, FF, D}; LatOrder S; S.init(FF, G, bid); EpiStore<1> E{P, FF, FF};
      pg8::gemm_phase<EpiStore<1>, LatOrder, true, true>(ldsg, g, S, E); }
PROBE_END(15)
    xcd_barrier(xbar);
PROBE_BEGIN(16)
    { pg8::Gemm g{P, W2_1_T, R, D, FF}; LatOrder S; S.init(D, G, bid); EpiResid<true> E{xlat, xctx, xlat, xctx, mod + 3 * 6144 + 5 * 1024, RST(2), ln_g + 2048, ln_b + 2048};
      pg8::gemm_phase<EpiResid<true>, LatOrder, true, true>(ldsg, g, S, E); }
PROBE_END(16)
    xcd_barrier(xbar);
    { IDS
    ln_phase<true, true>(nullptr, xlat, xctx, ln_g + 3072, ln_b + 3072, mod, H, gw, NGW, lane);
    }
}

extern "C" void kernel_launch(void* const* d_in, const int* in_sizes, int n_in, void* d_out, int out_size, void* d_ws, size_t ws_size, hipStream_t stream) {
    static int grid = 0;
    if (grid == 0) {
        if (n_in != 19 || out_size != NB * T * D || ws_size < WS_TOTAL) { fprintf(stderr, "kernel_launch: unexpected shapes (n_in %d out %d ws %zu)\n", n_in, out_size, ws_size); grid = -1; return; }
        int dev = 0, cus = 0, per_cu = 0;
        hipGetDevice(&dev); hipDeviceGetAttribute(&cus, hipDeviceAttributeMultiprocessorCount, dev);
        if (hipFuncSetAttribute((const void*)fwd_kernel, hipFuncAttributeMaxDynamicSharedMemorySize, LDS_BYTES) != hipSuccess) { fprintf(stderr, "kernel_launch: hipFuncSetAttribute failed\n"); grid = -1; return; }
        if (hipOccupancyMaxActiveBlocksPerMultiprocessor(&per_cu, (const void*)fwd_kernel, 512, LDS_BYTES) != hipSuccess || per_cu < 1) per_cu = 1;
        (void)hipGetLastError();
        grid = cus > 0 ? cus : 256;
    }
    if (grid < 0) return;
    Args a{};
    for (int i = 0; i < 19; ++i) a.in[i] = (const float*)d_in[i];
    a.out = (float*)d_out; a.ws = (unsigned char*)d_ws;
    if (hipMemsetAsync((char*)d_ws + OFF_XBAR, 0, 16384, stream) != hipSuccess) { fprintf(stderr, "kernel_launch: hipMemsetAsync of the barrier words failed\n"); return; }
    void* args[] = {&a};
    hipError_t e = hipLaunchCooperativeKernel((const void*)fwd_kernel, dim3(grid), dim3(512), args, LDS_BYTES, stream);
    if (e != hipSuccess) fprintf(stderr, "cooperative launch failed: %s (grid %d)\n", hipGetErrorString(e), grid);
}
```

```cpp
#include <hip/hip_runtime.h>
#include <hip/hip_cooperative_groups.h>
#include <cstdio>
#include <cstdint>
namespace cg = cooperative_groups;
namespace pg8 {
#define PG8_LAS __attribute__((address_space(3)))
typedef unsigned short bf16_t;
typedef short bf16x8 __attribute__((ext_vector_type(8)));
typedef float f32x4 __attribute__((ext_vector_type(4)));
typedef unsigned u32x4 __attribute__((ext_vector_type(4)));
constexpr int BM = 256, BK = 64, HALF = 128, HTB = HALF * BK * 2  , STAGE_BYTES = 8 * HTB, NXCD = 8, WGM = 8;

__host__ __device__ __forceinline__ int lds_byte(int r, int c) { const int st = (r >> 4) * 2 + (c >> 5), rr = r & 15, cc = c & 31, ob = rr * 64 + cc * 2; return st * 1024 + (ob ^ (((ob >> 9) & 1) << 5)); }
__host__ __device__ __forceinline__ void stage_rc(int b, int& R, int& C) { const int st = b / 1024, sb = b % 1024, swz = sb ^ (((sb >> 9) & 1) << 5); R = (st >> 1) * 16 + swz / 64; C = (st & 1) * 32 + (swz % 64) / 2; }
__host__ __device__ __forceinline__ int perm32(int rho) { const int n = rho >> 4, i = rho & 15; return 8 * (i >> 2) + 4 * n + (i & 3); }

struct Unit { int pm, pn; };
struct Gemm { const bf16_t* A; const bf16_t* Bt; int M, N, K; };

struct StaticOrder {
    int nM, nN, nwg, G, c;
    __host__ __device__ void init(int M, int N, int G_, int c_) { nM = M / BM; nN = N / BM; nwg = nM * nN; G = G_; c = c_; }
    __host__ __device__ bool next(int i, Unit& u) const {
        const long L = (long)i * G + c; if (L >= nwg) return false;
        int wgid = (int)L; { const int q = nwg / NXCD, r = nwg % NXCD, xcd = wgid % NXCD, off = wgid / NXCD; wgid = (xcd < r ? xcd * (q + 1) : r * (q + 1) + (xcd - r) * q) + off; }
        const int nig = WGM * nN, gid = wgid / nig, fm = gid * WGM, gsz = (nM - fm) < WGM ? (nM - fm) : WGM;
        u.pm = fm + ((wgid % nig) % gsz); u.pn = (wgid % nig) / gsz; return true;
    }
    __device__ __forceinline__ void a_ready(const Unit&) const {}
    __device__ __forceinline__ void done(const Unit&) const {}
};

__device__ __forceinline__ unsigned cvt_pk_bf16(float lo, float hi) { unsigned r; asm volatile("v_cvt_pk_bf16_f32 %0, %1, %2" : "=v"(r) : "v"(lo), "v"(hi)); return r; }

template <class Epi, class Sched, bool ALIGN_EPI = false, bool SP2 = false>
__device__ __forceinline__ void gemm_phase(PG8_LAS unsigned char* lds, const Gemm g, const Sched& S, const Epi& E) {
    int tid = threadIdx.x; asm volatile("" : "+v"(tid));
    const int wid = __builtin_amdgcn_readfirstlane(tid >> 6), lane = tid & 63, wr = wid >> 2, wc = wid & 3, fr = lane & 15, fq = lane >> 4;
    const int K = g.K, nt = K / BK;
    unsigned voffA[2], voffB[2];
#pragma unroll
    for (int i = 0; i < 2; ++i) { int R, C; stage_rc(tid * 16 + i * 8192, R, C); const int Rb = Epi::PERM ? ((R & ~31) + perm32(R & 31)) : R;
        voffA[i] = (unsigned)(R * K + C) * 2u; voffB[i] = (unsigned)(Rb * K + C) * 2u; }
    const size_t kstep = (size_t)(BK * 2);
    const size_t hstep = (size_t)HALF * K * 2;
    const size_t tstep = 2 * hstep;
    const unsigned ldsw = (unsigned)wid * 1024u;
    const int aoff = lds_byte(wr * 64 + fr, fq * 8), boff = lds_byte(wc * 32 + fr, fq * 8);
#define PG8_SA(b, h) (((b) * 2 + (h)) * HTB)
#define PG8_SB(b, h) ((4 + (b) * 2 + (h)) * HTB)
#define PG8_STAGE(bufoff, gbase, voff) do { _Pragma("unroll") for (int _i = 0; _i < 2; ++_i) \
        __builtin_amdgcn_global_load_lds((const unsigned*)((const char*)(gbase) + (voff)[_i]), (PG8_LAS unsigned*)(lds + (bufoff) + ldsw + _i * 8192), 16, 0, 0); } while (0)
#define PG8_LDA(dst, b, h) do { _Pragma("unroll") for (int m = 0; m < 4; ++m) _Pragma("unroll") for (int k = 0; k < 2; ++k) dst[m][k] = *(const PG8_LAS bf16x8*)(lds + PG8_SA(b, h) + aoff + m * 2048 + k * 1024); } while (0)
#define PG8_LDB(dst, b, h) do { _Pragma("unroll") for (int n = 0; n < 2; ++n) _Pragma("unroll") for (int k = 0; k < 2; ++k) dst[n][k] = *(const PG8_LAS bf16x8*)(lds + PG8_SB(b, h) + boff + n * 2048 + k * 1024); } while (0)
#define PG8_MMA(ai, bj, At, Bt) do { __builtin_amdgcn_s_setprio(1); _Pragma("unroll") for (int m = 0; m < 4; ++m) _Pragma("unroll") for (int n = 0; n < 2; ++n) _Pragma("unroll") for (int k = 0; k < 2; ++k) \
        acc[ai][bj][m][n] = __builtin_amdgcn_mfma_f32_16x16x32_bf16(Bt[n][k], At[m][k], acc[ai][bj][m][n], 0, 0, 0); __builtin_amdgcn_s_setprio(0); } while (0)
#define PG8_WAIT_V(n) asm volatile("s_waitcnt vmcnt(" #n ")" ::: "memory")
#define PG8_WAIT_L(n) asm volatile("s_waitcnt lgkmcnt(" #n ")" ::: "memory")
#define PG8_BAR __builtin_amdgcn_s_barrier()
#define PG8_SCHED __builtin_amdgcn_sched_barrier(0)
    Unit cur, nxt; int ui = 0;
    if (!S.next(0, cur)) return;
    f32x4 acc[2][2][4][2];
#pragma unroll
    for (int a = 0; a < 2; ++a)
#pragma unroll
        for (int b = 0; b < 2; ++b)
#pragma unroll
            for (int m = 0; m < 4; ++m)
#pragma unroll
                for (int n = 0; n < 2; ++n) acc[a][b][m][n] = (f32x4){0.f, 0.f, 0.f, 0.f};
    bf16x8 At[4][2], B0[2][2], B1[2][2];
    const char* cA = (const char*)g.A + (size_t)cur.pm * tstep; const char* cB = (const char*)g.Bt + (size_t)cur.pn * tstep;
    S.a_ready(cur);
    if constexpr (SP2) {
        PG8_STAGE(PG8_SB(0, 0), cB, voffB); PG8_STAGE(PG8_SB(0, 1), cB + hstep, voffB); PG8_STAGE(PG8_SA(0, 0), cA, voffA); PG8_STAGE(PG8_SA(0, 1), cA + hstep, voffA);
        if (wr == 1) PG8_BAR;
        PG8_WAIT_V(2); PG8_BAR;
        PG8_STAGE(PG8_SB(1, 0), cB + kstep, voffB); PG8_STAGE(PG8_SA(1, 0), cA + kstep, voffA); PG8_STAGE(PG8_SB(1, 1), cB + hstep + kstep, voffB);
        PG8_WAIT_V(6); PG8_BAR;
    } else {
        PG8_STAGE(PG8_SB(0, 0), cB, voffB); PG8_STAGE(PG8_SA(0, 0), cA, voffA); PG8_STAGE(PG8_SB(0, 1), cB + hstep, voffB); PG8_STAGE(PG8_SA(0, 1), cA + hstep, voffA);
        if (wr == 1) PG8_BAR;
        PG8_WAIT_V(4); PG8_BAR;
        PG8_STAGE(PG8_SB(1, 0), cB + kstep, voffB); PG8_STAGE(PG8_SA(1, 0), cA + kstep, voffA); PG8_STAGE(PG8_SB(1, 1), cB + hstep + kstep, voffB);
        PG8_WAIT_V(6); PG8_BAR;
    }
    for (;;) {
        const bool has_next = S.next(ui + 1, nxt);
        const char* nA = has_next ? (const char*)g.A + (size_t)nxt.pm * tstep : cA; const char* nB = has_next ? (const char*)g.Bt + (size_t)nxt.pn * tstep : cB;
        for (int t = 0; t < nt; t += 2) {
            const bool last = (t == nt - 2);
            const char* a1 = cA + (size_t)(t + 1) * kstep;
            const char* a2 = last ? nA : cA + (size_t)(t + 2) * kstep; const char* b2 = last ? nB : cB + (size_t)(t + 2) * kstep;
            const char* a3 = a2 + kstep; const char* b3 = b2 + kstep;
            if (last && has_next) S.a_ready(nxt);
            if constexpr (SP2) {
            PG8_LDB(B0, 0, 0); PG8_LDB(B1, 0, 1); PG8_SCHED; PG8_LDA(At, 0, 0); PG8_STAGE(PG8_SA(1, 1), a1 + hstep, voffA);
            PG8_WAIT_V(8); PG8_WAIT_L(0); PG8_BAR; PG8_MMA(0, 0, At, B0); PG8_MMA(0, 1, At, B1); PG8_BAR; PG8_SCHED;
            PG8_LDA(At, 0, 1); PG8_STAGE(PG8_SB(0, 0), b2, voffB); PG8_STAGE(PG8_SB(0, 1), b2 + hstep, voffB); PG8_STAGE(PG8_SA(0, 0), a2, voffA);
            PG8_WAIT_V(8); PG8_WAIT_L(0); PG8_BAR; PG8_MMA(1, 0, At, B0); PG8_MMA(1, 1, At, B1); PG8_BAR; PG8_SCHED;
            PG8_LDB(B0, 1, 0); PG8_LDB(B1, 1, 1); PG8_SCHED; PG8_LDA(At, 1, 0); PG8_STAGE(PG8_SA(0, 1), a2 + hstep, voffA);
            PG8_WAIT_V(8); PG8_WAIT_L(0); PG8_BAR; PG8_MMA(0, 0, At, B0); PG8_MMA(0, 1, At, B1); PG8_BAR; PG8_SCHED;
            PG8_LDA(At, 1, 1); PG8_STAGE(PG8_SB(1, 0), b3, voffB); PG8_STAGE(PG8_SB(1, 1), b3 + hstep, voffB); PG8_STAGE(PG8_SA(1, 0), a3, voffA);
            PG8_WAIT_V(8); PG8_WAIT_L(0); PG8_BAR; PG8_MMA(1, 0, At, B0); PG8_MMA(1, 1, At, B1); PG8_BAR; PG8_SCHED;
            } else {
            PG8_LDB(B0, 0, 0); PG8_SCHED; PG8_LDA(At, 0, 0); PG8_STAGE(PG8_SA(1, 1), a1 + hstep, voffA);
            PG8_WAIT_L(8); PG8_BAR; PG8_WAIT_L(0); PG8_MMA(0, 0, At, B0); PG8_BAR; PG8_SCHED;
            PG8_LDB(B1, 0, 1); PG8_STAGE(PG8_SB(0, 0), b2, voffB);
            PG8_BAR; PG8_WAIT_L(0); PG8_MMA(0, 1, At, B1); PG8_BAR;
            PG8_LDA(At, 0, 1); PG8_STAGE(PG8_SA(0, 0), a2, voffA);
            PG8_BAR; PG8_WAIT_L(0); PG8_MMA(1, 0, At, B0); PG8_BAR; PG8_SCHED;
            PG8_STAGE(PG8_SB(0, 1), b2 + hstep, voffB);
            PG8_WAIT_V(6); PG8_BAR; PG8_MMA(1, 1, At, B1); PG8_BAR;
            PG8_LDB(B0, 1, 0); PG8_SCHED; PG8_LDA(At, 1, 0); PG8_STAGE(PG8_SA(0, 1), a2 + hstep, voffA);
            PG8_WAIT_L(8); PG8_BAR; PG8_WAIT_L(0); PG8_MMA(0, 0, At, B0); PG8_BAR; PG8_SCHED;
            PG8_LDB(B1, 1, 1); PG8_STAGE(PG8_SB(1, 0), b3, voffB);
            PG8_BAR; PG8_WAIT_L(0); PG8_MMA(0, 1, At, B1); PG8_BAR;
            PG8_LDA(At, 1, 1); PG8_STAGE(PG8_SA(1, 0), a3, voffA);
            PG8_BAR; PG8_WAIT_L(0); PG8_MMA(1, 0, At, B0); PG8_BAR; PG8_SCHED;
            PG8_STAGE(PG8_SB(1, 1), b3 + hstep, voffB);
            PG8_WAIT_V(6); PG8_BAR; PG8_MMA(1, 1, At, B1); PG8_BAR;
            }
        }
        if constexpr (ALIGN_EPI) { if (wr == 0) PG8_BAR; }
        if constexpr (!Epi::AFTER_DRAIN) { E(acc, cur, wr, wc, fr, fq); S.done(cur); }
        if (!has_next) break;
#pragma unroll
        for (int a = 0; a < 2; ++a)
#pragma unroll
            for (int b = 0; b < 2; ++b)
#pragma unroll
                for (int m = 0; m < 4; ++m)
#pragma unroll
                    for (int n = 0; n < 2; ++n) acc[a][b][m][n] = (f32x4){0.f, 0.f, 0.f, 0.f};
        cur = nxt; cA = nA; cB = nB; ++ui;
        if constexpr (ALIGN_EPI) { if (wr == 1) PG8_BAR; }
    }
    PG8_WAIT_V(0);
    if constexpr (!ALIGN_EPI) { if (wr == 0) PG8_BAR; }
    PG8_BAR;
    if constexpr (Epi::AFTER_DRAIN) { E.fused(acc, cur, wr, wc, fr, fq, lds, wid, lane); S.done(cur); }
#undef PG8_SA
#undef PG8_SB
#undef PG8_STAGE
#undef PG8_LDA
#undef PG8_LDB
#undef PG8_MMA
#undef PG8_WAIT_V
#undef PG8_WAIT_L
#undef PG8_BAR
#undef PG8_SCHED
}
}

constexpr int NB = 2, T = 8192, L = 256, D = 1024, TP = T + L, R = NB * TP;
constexpr int FF = 4096, NPROJ = 3104, NPROJ_PAD = 3328, NQKV = 1536, NCH = TP / 64;
constexpr float ALPHA = 1.4142135623730951f;
constexpr int LDS_BYTES = 147456;

typedef unsigned short bf16;
typedef float f32x4 __attribute__((ext_vector_type(4)));
typedef short bf16x8 __attribute__((ext_vector_type(8)));
typedef short s16x4 __attribute__((ext_vector_type(4)));
typedef unsigned u32x4 __attribute__((ext_vector_type(4)));
typedef unsigned u32x2 __attribute__((ext_vector_type(2)));

constexpr size_t OFF_WIN = 0;
constexpr size_t OFF_WOUT0 = OFF_WIN + (size_t)NPROJ_PAD * D * 2;
constexpr size_t OFF_W1_0 = OFF_WOUT0 + (size_t)D * D * 2;
constexpr size_t OFF_W2_0 = OFF_W1_0 + (size_t)FF * D * 2;
constexpr size_t OFF_WQKV = OFF_W2_0 + (size_t)FF * D * 2;
constexpr size_t OFF_WOUT1 = OFF_WQKV + (size_t)NQKV * D * 2;
constexpr size_t OFF_W1_1 = OFF_WOUT1 + (size_t)D * D * 2;
constexpr size_t OFF_W2_1 = OFF_W1_1 + (size_t)FF * D * 2;
constexpr size_t OFF_MOD = OFF_W2_1 + (size_t)FF * D * 2;
constexpr size_t OFF_ROPE = OFF_MOD + 2 * 3 * 6144 * 4;
constexpr size_t OFF_BAR = OFF_ROPE + 128 * 16 * 8;
constexpr size_t OFF_XBAR = OFF_BAR + 256;
constexpr size_t OFF_RST = OFF_XBAR + 16384;
constexpr size_t OFF_XCTX = OFF_RST + (size_t)3 * R * 2 * 4;
constexpr size_t OFF_DEC = OFF_XCTX + (size_t)NB * L * D * 4;
constexpr size_t OFF_H = OFF_DEC + (size_t)32 * NCH * 64 * 4;
constexpr size_t OFF_P = OFF_H + (size_t)R * D * 2;
constexpr size_t OFF_ST = OFF_P + (size_t)R * NPROJ * 2;
constexpr size_t WS_TOTAL = OFF_ST + (size_t)32 * NCH * 8192 * 2;
static_assert(WS_TOTAL <= 268435456, "workspace map exceeds 256 MiB");
static_assert(OFF_P + (size_t)R * FF * 2 <= WS_TOTAL, "MLP hidden overlay");

typedef float f32x2_t __attribute__((ext_vector_type(2)));
typedef __bf16 bf16x2_t __attribute__((ext_vector_type(2)));
__device__ __forceinline__ unsigned pk2(float lo, float hi) { const f32x2_t v = {lo, hi}; const bf16x2_t b = __builtin_convertvector(v, bf16x2_t); return __builtin_bit_cast(unsigned, b); }
__device__ __forceinline__ unsigned f2bf(float f) { return pk2(f, f) & 0xffffu; }
__device__ __forceinline__ float bf2f(unsigned h) { return __uint_as_float(h << 16); }
__device__ __forceinline__ float bflo(unsigned u) { return __uint_as_float(u << 16); }
__device__ __forceinline__ float bfhi(unsigned u) { return __uint_as_float(u & 0xffff0000u); }
__device__ __forceinline__ float wave_sum(float v) {
#pragma unroll
    for (int o = 1; o < 64; o <<= 1) v += __shfl_xor(v, o);
    return v;
}
__device__ __forceinline__ float quad_max(float x) {
    const unsigned u = __float_as_uint(x);
    const auto r = __builtin_amdgcn_permlane32_swap(u, u, false, false);
    const float m = fmaxf(__uint_as_float(r[0]), __uint_as_float(r[1]));
    const unsigned v = __float_as_uint(m);
    const auto q = __builtin_amdgcn_permlane16_swap(v, v, false, false);
    return fmaxf(__uint_as_float(q[0]), __uint_as_float(q[1]));
}
__device__ __forceinline__ float quad_sum(float x) {
    const unsigned u = __float_as_uint(x);
    const auto r = __builtin_amdgcn_permlane32_swap(u, u, false, false);
    const float m = __uint_as_float(r[0]) + __uint_as_float(r[1]);
    const unsigned v = __float_as_uint(m);
    const auto q = __builtin_amdgcn_permlane16_swap(v, v, false, false);
    return __uint_as_float(q[0]) + __uint_as_float(q[1]);
}
#define MFMA16(a, b, c) __builtin_amdgcn_mfma_f32_16x16x32_bf16((a), (b), (c), 0, 0, 0)

__device__ __forceinline__ size_t row_off(int r, bool& isc, int& b) { b = (r >= TP) ? 1 : 0; const int p = r - b * TP; isc = p < L; return isc ? (size_t)(b * L + p) * D : (size_t)(b * T + p - L) * D; }

template <int ACT> struct EpiStore {
    static constexpr bool PERM = true, AFTER_DRAIN = false;
    bf16* O; int ldc; int ncols;
    __device__ __forceinline__ void operator()(const pg8::f32x4 (&acc)[2][2][4][2], const pg8::Unit& u, int wr, int wc, int fr, int fq) const {
        const int row0 = u.pm * 256 + wr * 64 + fr, col0 = u.pn * 256 + wc * 32 + 8 * fq;
#pragma unroll
        for (int ai = 0; ai < 2; ++ai)
#pragma unroll
            for (int m = 0; m < 4; ++m) {
                bf16* rowp = O + (size_t)(row0 + ai * 128 + m * 16) * ldc;
#pragma unroll
                for (int bj = 0; bj < 2; ++bj) {
                    const int col = col0 + bj * 128;
                    pg8::f32x4 v0 = acc[ai][bj][m][0], v1 = acc[ai][bj][m][1];
                    if (ACT == 1) {
#pragma unroll
                        for (int i = 0; i < 4; ++i) { float a = fmaxf(v0[i], 0.f), b = fmaxf(v1[i], 0.f); v0[i] = a * a; v1[i] = b * b; }
                    }
                    u32x4 w; w.x = pg8::cvt_pk_bf16(v0[0], v0[1]); w.y = pg8::cvt_pk_bf16(v0[2], v0[3]); w.z = pg8::cvt_pk_bf16(v1[0], v1[1]); w.w = pg8::cvt_pk_bf16(v1[2], v1[3]);
                    if (col < ncols) *(u32x4*)(rowp + col) = w;
                }
            }
    }
};
template <int SRC, bool DST_FIN> struct EpiResid {
    static constexpr bool PERM = true, AFTER_DRAIN = false;
    const void* src_lat; const void* src_ctx; bf16* dst_lat; bf16* dst_ctx; bf16* dst_fin; const float* gate;
    const float* rst; const float* lg; const float* lb;
    __device__ __forceinline__ void operator()(const pg8::f32x4 (&acc)[2][2][4][2], const pg8::Unit& u, int wr, int wc, int fr, int fq) const {
        const int row0 = u.pm * 256 + wr * 64 + fr, col0 = u.pn * 256 + wc * 32 + 8 * fq;
#pragma unroll
        for (int ai = 0; ai < 2; ++ai)
#pragma unroll
            for (int m = 0; m < 4; ++m) {
                const int row = row0 + ai * 128 + m * 16;
                bool isc; int b; const size_t off = row_off(row, isc, b);
                const float* gt = gate + (isc ? 2 : b) * 6144;
                float mean = 0.f, rstd = 1.f; if (SRC == 1) { mean = rst[2 * row]; rstd = rst[2 * row + 1]; }
#pragma unroll
                for (int bj = 0; bj < 2; ++bj) {
                    const int col = col0 + bj * 128;
                    f32x4 x0, x1;
                    if (SRC == 0) { const float* sp = (const float*)(isc ? src_ctx : src_lat) + off + col; x0 = *(const f32x4*)sp; x1 = *(const f32x4*)(sp + 4); }
                    else { const u32x4 w = *(const u32x4*)((const bf16*)(isc ? src_ctx : src_lat) + off + col);
                        x0 = (f32x4){bflo(w.x), bfhi(w.x), bflo(w.y), bfhi(w.y)}; x1 = (f32x4){bflo(w.z), bfhi(w.z), bflo(w.w), bfhi(w.w)};
                        x0 = (x0 - mean) * rstd * *(const f32x4*)(lg + col) + *(const f32x4*)(lb + col); x1 = (x1 - mean) * rstd * *(const f32x4*)(lg + col + 4) + *(const f32x4*)(lb + col + 4); }
                    const f32x4 g0 = *(const f32x4*)(gt + col), g1 = *(const f32x4*)(gt + col + 4);
                    const pg8::f32x4 a0 = acc[ai][bj][m][0], a1 = acc[ai][bj][m][1];
                    u32x4 o; o.x = pk2(ALPHA * x0.x + g0.x * a0[0], ALPHA * x0.y + g0.y * a0[1]); o.y = pk2(ALPHA * x0.z + g0.z * a0[2], ALPHA * x0.w + g0.w * a0[3]);
                    o.z = pk2(ALPHA * x1.x + g1.x * a1[0], ALPHA * x1.y + g1.y * a1[1]); o.w = pk2(ALPHA * x1.z + g1.z * a1[2], ALPHA * x1.w + g1.w * a1[3]);
                    bf16* dp = DST_FIN ? dst_fin + (size_t)row * D + col : (isc ? dst_ctx : dst_lat) + off + col;
                    *(u32x4*)dp = o;
                }
            }
    }
};

__device__ __forceinline__ void transpose_item(const float* __restrict__ W, int K, int N, bf16* WT, float* scr, int item, int lane) {
    const int nblk = N / 32, kb = item / nblk, nb = item % nblk, k0 = 64 * kb, n0 = 32 * nb;
#pragma unroll 8
    for (int i = 0; i < 32; ++i) { const int kk = 2 * i + (lane >> 5); scr[kk * 33 + (lane & 31)] = W[(size_t)(k0 + kk) * N + n0 + (lane & 31)]; }
    asm volatile("s_waitcnt lgkmcnt(0)" ::: "memory");
    const int c = lane & 7;
#pragma unroll
    for (int j = 0; j < 4; ++j) { const int n = (lane >> 3) + 8 * j; const float* s = scr + (8 * c) * 33 + n;
        u32x4 o; o.x = pk2(s[0 * 33], s[1 * 33]); o.y = pk2(s[2 * 33], s[3 * 33]); o.z = pk2(s[4 * 33], s[5 * 33]); o.w = pk2(s[6 * 33], s[7 * 33]);
        *(u32x4*)(WT + (size_t)(n0 + n) * K + k0 + 8 * c) = o; }
    asm volatile("s_waitcnt lgkmcnt(0)" ::: "memory");
}

template <bool LAST, bool SKIPCTX>
__device__ __forceinline__ void ln_phase(float* rst, const bf16* vlat, const bf16* vctx, const bf16* vfin, float* outp, const float* __restrict__ g, const float* __restrict__ bt, const float* __restrict__ modn, bf16* H, int gw, int NGW, int lane) {
    int r = gw;
    if (SKIPCTX) { while (r < R) { const int p = r >= TP ? r - TP : r; if (p >= L) break; r += NGW; } }
    u32x4 vn[2];
    if (r < R) { bool isc; int b; const size_t off = row_off(r, isc, b); const bf16* xr = LAST ? vfin + (size_t)r * D : (isc ? vctx : vlat) + off;
#pragma unroll
        for (int j = 0; j < 2; ++j) vn[j] = *(const u32x4*)(xr + lane * 8 + 512 * j); }
    while (r < R) {
        bool isc; int b; const size_t off = row_off(r, isc, b);
        float v[16];
#pragma unroll
        for (int j = 0; j < 2; ++j)
#pragma unroll
            for (int i = 0; i < 4; ++i) { v[j * 8 + 2 * i] = bflo(vn[j][i]); v[j * 8 + 2 * i + 1] = bfhi(vn[j][i]); }
        int rn = r + NGW;
        if (SKIPCTX) { while (rn < R) { const int p = rn >= TP ? rn - TP : rn; if (p >= L) break; rn += NGW; } }
        if (rn < R) { bool isc2; int b2; const size_t off2 = row_off(rn, isc2, b2); const bf16* xr2 = LAST ? vfin + (size_t)rn * D : (isc2 ? vctx : vlat) + off2;
#pragma unroll
            for (int j = 0; j < 2; ++j) vn[j] = *(const u32x4*)(xr2 + lane * 8 + 512 * j); }
        float s = 0.f;
#pragma unroll
        for (int i = 0; i < 16; ++i) s += v[i];
        const float mean = wave_sum(s) * (1.f / D); float s2 = 0.f;
#pragma unroll
        for (int i = 0; i < 16; ++i) { v[i] -= mean; s2 += v[i] * v[i]; }
        const float rstd = 1.f / sqrtf(wave_sum(s2) * (1.f / D) + 1e-5f);
        const float* md = modn + (isc ? 2 : b) * 6144;
        if (!LAST && lane == 0) { rst[2 * r] = mean; rst[2 * r + 1] = rstd; }
#pragma unroll
        for (int j = 0; j < 2; ++j) {
            const int idx = lane * 8 + 512 * j;
            float y[8];
#pragma unroll
            for (int q = 0; q < 2; ++q) { const f32x4 gg = *(const f32x4*)(g + idx + 4 * q), bb = *(const f32x4*)(bt + idx + 4 * q);
#pragma unroll
                for (int i = 0; i < 4; ++i) y[q * 4 + i] = v[j * 8 + q * 4 + i] * rstd * gg[i] + bb[i]; }
            if (LAST) { *(f32x4*)(outp + off + idx) = (f32x4){y[0], y[1], y[2], y[3]}; *(f32x4*)(outp + off + idx + 4) = (f32x4){y[4], y[5], y[6], y[7]}; }
            else {
                float h[8];
#pragma unroll
                for (int q = 0; q < 2; ++q) { const f32x4 sh = *(const f32x4*)(md + idx + 4 * q), sc = *(const f32x4*)(md + 1024 + idx + 4 * q);
#pragma unroll
                    for (int i = 0; i < 4; ++i) h[q * 4 + i] = y[q * 4 + i] * (sc[i] + 1.f) + sh[i]; }
                u32x4 o; o.x = pk2(h[0], h[1]); o.y = pk2(h[2], h[3]); o.z = pk2(h[4], h[5]); o.w = pk2(h[6], h[7]);
                *(u32x4*)(H + (size_t)r * D + idx) = o;
            }
        }
        r = rn;
    }
}

__device__ __forceinline__ float log_sigmoid(float z) { return fminf(z, 0.f) - __logf(1.f + __expf(-fabsf(z))); }

constexpr int CS = 65;
constexpr float QSC = 0.125f * 1.4426950408889634f;
struct GatePre { u32x2 lr; f32x4 w; float bias; };
__device__ __forceinline__ GatePre gate_prefetch(int g, int h, const bf16* Pr, const float* gkw, const float* gkb, int tid) {
    GatePre p; p.lr = (u32x2){0u, 0u}; p.w = (f32x4){0.f, 0.f, 0.f, 0.f}; p.bias = 0.f;
    if (g) { const int c = tid >> 3, part = tid & 7;
        p.lr = *(const u32x2*)(Pr + (size_t)c * NPROJ + 3072 + part * 4);
        const int idx = tid * 4, dir = idx >> 10, r = (idx >> 6) & 15, d = idx & 63;
        p.w = *(const f32x4*)(gkw + (dir * 16 + r) * 256 + h * 64 + d);
        if (tid < 128) p.bias = gkb[(tid >> 6) * 256 + h * 64 + (tid & 63)]; }
    return p;
}
__device__ __forceinline__ void fill_cum3(float* cf, float* cb, float* lrs, float* wl, int g, int h, const GatePre& gp, const float* theta, int tid) {
    if (g == 0) {
        const float lgf = log1pf(-expf(theta[h])), lgb = log1pf(-expf(theta[4 + h]));
        for (int i = tid; i < 4096; i += 512) { const int c = i >> 6, d = i & 63; cf[c * CS + d] = (float)(c + 1) * lgf; cb[c * CS + d] = (float)(64 - c) * lgb; }
        __syncthreads();
        return;
    }
    { const int c = tid >> 3, part = tid & 7;
      float* lp = lrs + c * 33 + part * 4; lp[0] = bflo(gp.lr.x); lp[1] = bfhi(gp.lr.x); lp[2] = bflo(gp.lr.y); lp[3] = bfhi(gp.lr.y);
      *(f32x4*)(wl + tid * 4) = gp.w;
      if (tid < 128) wl[2048 + tid] = gp.bias; }
    __syncthreads();
    { const int c = tid >> 3, dg = tid & 7;
#pragma unroll
      for (int dir = 0; dir < 2; ++dir) {
          f32x4 za = *(const f32x4*)(wl + 2048 + dir * 64 + dg * 8), zb = *(const f32x4*)(wl + 2048 + dir * 64 + dg * 8 + 4);
#pragma unroll
          for (int r = 0; r < 16; ++r) { const float lv = lrs[c * 33 + dir * 16 + r];
              za += lv * *(const f32x4*)(wl + (dir * 16 + r) * 64 + dg * 8); zb += lv * *(const f32x4*)(wl + (dir * 16 + r) * 64 + dg * 8 + 4); }
          float* dst = (dir ? cb : cf) + c * CS + dg * 8;
#pragma unroll
          for (int j = 0; j < 4; ++j) { dst[j] = log_sigmoid(za[j]) * (1.f / 16.f); dst[4 + j] = log_sigmoid(zb[j]) * (1.f / 16.f); } } }
    __syncthreads();
    if (tid < 128) {
        const int dir = tid >> 6; float* arr = (dir ? cb : cf) + (tid & 63);
        float run = 0.f;
#pragma unroll
        for (int hh = 0; hh < 2; ++hh) {
            float v[32];
            const int base = dir ? (1 - hh) * 32 : hh * 32;
#pragma unroll
            for (int c = 0; c < 32; ++c) v[c] = arr[(base + c) * CS];
            if (dir == 0) {
#pragma unroll
                for (int c = 0; c < 32; ++c) { run += v[c]; arr[(base + c) * CS] = run; }
            } else {
#pragma unroll
                for (int c = 31; c >= 0; --c) { run += v[c]; arr[(base + c) * CS] = run; }
            }
        }
    }
    __syncthreads();
}

__device__ __forceinline__ void fast_bar(unsigned* ctr, unsigned& target) {
    asm volatile("s_waitcnt vmcnt(0)" ::: "memory");
    __syncthreads();
    target += gridDim.x;
    if (threadIdx.x == 0) {
        __builtin_amdgcn_fence(__ATOMIC_RELEASE, "agent");
        asm volatile("s_waitcnt vmcnt(0)" ::: "memory");
        __hip_atomic_fetch_add(ctr, 1u, __ATOMIC_RELAXED, __HIP_MEMORY_SCOPE_AGENT);
        while (__hip_atomic_load(ctr, __ATOMIC_RELAXED, __HIP_MEMORY_SCOPE_AGENT) < target) __builtin_amdgcn_s_sleep(1);
        __builtin_amdgcn_fence(__ATOMIC_ACQUIRE, "agent");
        asm volatile("s_waitcnt vmcnt(0)" ::: "memory");
    }
    __syncthreads();
}
#define RLX_AGENT __ATOMIC_RELAXED, __HIP_MEMORY_SCOPE_AGENT
#define XB_TMO      128
#define XB_XCNT(j)  (256  + 64 * (j))
#define XB_XSUB(j)  (1280 + 64 * (j))
#define XB_XGEN(j)  (2304 + 64 * (j))
#define XB_TOP      3328
#define XB_TOPGEN   3392
#define XCD_BAR_WORDS 3456
#define XB_SPIN_CAP (1u << 18)

__device__ __forceinline__ unsigned xb_ld(unsigned* p)              { return __hip_atomic_load(p, __ATOMIC_RELAXED, __HIP_MEMORY_SCOPE_AGENT); }
__device__ __forceinline__ unsigned xb_add(unsigned* p, unsigned v) { return __hip_atomic_fetch_add(p, v, __ATOMIC_RELAXED, __HIP_MEMORY_SCOPE_AGENT); }
__device__ __forceinline__ unsigned xb_xcc_id() { return (unsigned)__builtin_amdgcn_s_getreg((3 << 11) | 20) & 0xFu; }
#define XB_SPIN(cond, bar) do { unsigned _sp = 0; while (cond) { __builtin_amdgcn_s_sleep(1); \
    if ((++_sp & 255u) == 0u) { if (xb_ld(&(bar)[XB_TMO])) break; if (_sp > XB_SPIN_CAP) { atomicAdd(&(bar)[XB_TMO], 1u); break; } } } } while (0)

struct XcdBarrier {
    unsigned* bar; unsigned x;
    volatile unsigned* st;
};

__device__ __forceinline__ XcdBarrier xcd_barrier_post(unsigned* bar, volatile unsigned* st) {
    XcdBarrier b; b.bar = bar; b.x = xb_xcc_id(); b.st = st;
    if (threadIdx.x == 0) (void)xb_add(&bar[XB_XCNT(b.x)], 1u);
    return b;
}
__device__ __forceinline__ void xcd_barrier_complete(unsigned* bar, unsigned x, unsigned& nloc, unsigned& nx) {
    const unsigned G = gridDim.x * gridDim.y * gridDim.z;
    unsigned sum, cnt, mine, sp = 0u;
    for (;;) {
        sum = 0u; cnt = 0u; mine = 0u;
#pragma unroll
        for (unsigned j = 0; j < 16; ++j) { const unsigned c = xb_ld(&bar[XB_XCNT(j)]); sum += c; cnt += (c > 0u) ? 1u : 0u; mine = (j == x) ? c : mine; }
        if (sum == G) break;
        __builtin_amdgcn_s_sleep(1);
        if ((++sp & 255u) == 0u) { if (xb_ld(&bar[XB_TMO])) break; if (sp > XB_SPIN_CAP) { atomicAdd(&bar[XB_TMO], 1u); break; } }
    }
    nloc = mine > 0u ? mine : 1u; nx = cnt > 0u ? cnt : 1u;
}

__device__ __forceinline__ void xcd_barrier(const XcdBarrier& b) {
    asm volatile("s_waitcnt vmcnt(0)" ::: "memory");
    __syncthreads();
    if (threadIdx.x == 0) {
        unsigned* bar = b.bar;
        __builtin_amdgcn_s_waitcnt(0);
        unsigned nloc = b.st[0], nx = b.st[1];
        if (nloc == 0u) { xcd_barrier_complete(bar, b.x, nloc, nx); b.st[0] = nloc; b.st[1] = nx; }
        const unsigned old = xb_add(&bar[XB_XSUB(b.x)], 1u);
        const unsigned gen = old / nloc;
        if (old + 1u == (gen + 1u) * nloc) {
            __builtin_amdgcn_fence(__ATOMIC_RELEASE, "agent");
            asm volatile("s_waitcnt vmcnt(0)" ::: "memory");
            const unsigned og = xb_add(&bar[XB_TOP], 1u);
            const unsigned tg = og / nx;
            if (og + 1u == (tg + 1u) * nx) xb_add(&bar[XB_TOPGEN], 1u);
            else XB_SPIN(xb_ld(&bar[XB_TOPGEN]) == tg, bar);
            __builtin_amdgcn_fence(__ATOMIC_ACQUIRE, "agent");
            xb_add(&bar[XB_XGEN(b.x)], 1u);
            asm volatile("s_waitcnt vmcnt(0)" ::: "memory");
        } else {
            XB_SPIN(xb_ld(&bar[XB_XGEN(b.x)]) == gen, bar);
            __builtin_amdgcn_fence(__ATOMIC_ACQUIRE, "agent");
            asm volatile("s_waitcnt vmcnt(0)" ::: "memory");
        }
    }
    __syncthreads();
}

struct LatOrder {
    pg8::StaticOrder S;
    __device__ void init(int N, int G, int c) { S.init(NB * T, N, G, c); }
    __device__ bool next(int i, pg8::Unit& u) const { if (!S.next(i, u)) return false; u.pm = u.pm + 1 + (u.pm >= 32 ? 1 : 0); return true; }
    __device__ __forceinline__ void a_ready(const pg8::Unit&) const {}
    __device__ __forceinline__ void done(const pg8::Unit&) const {}
};
#ifndef PROBE_SEL
#define PROBE_SEL 0
#endif
#ifndef PROBE_MUL
#define PROBE_MUL 3
#endif
#define PACC_DECL unsigned long long pacc = 0, pacc_t0 = 0; (void)pacc; (void)pacc_t0;
#define PACC_BEGIN(k) if (PROBE_SEL == (k)) pacc_t0 = __builtin_amdgcn_s_memrealtime();
#define PACC_END(k) if (PROBE_SEL == (k)) pacc += __builtin_amdgcn_s_memrealtime() - pacc_t0;
#define PACC_SLEEP() if (PROBE_SEL >= 40 && PROBE_SEL < 60) { const unsigned long long t1 = __builtin_amdgcn_s_memrealtime(), dt = pacc * PROBE_MUL; while (__builtin_amdgcn_s_memrealtime() - t1 < dt) __builtin_amdgcn_s_sleep(8); }
#define PROBE_BEGIN(k) unsigned long long pt0_##k = 0; if (PROBE_SEL == (k)) pt0_##k = __builtin_amdgcn_s_memrealtime();
#define PROBE_END(k) if (PROBE_SEL == (k)) { const unsigned long long t1 = __builtin_amdgcn_s_memrealtime(), dt = (t1 - pt0_##k) * PROBE_MUL; while (__builtin_amdgcn_s_memrealtime() - t1 < dt) __builtin_amdgcn_s_sleep(8); }


template <int XT, int YT>
__device__ __forceinline__ void frag_gemm(pg8::f32x4 (&acc)[XT][YT], const bf16* X, int ldx, const bf16* Y, int ldy, int k0, int k1, int l15, int quad) {
#pragma unroll 4
    for (int k = k0; k < k1; k += 32) {
        bf16x8 xf[XT], yf[YT];
#pragma unroll
        for (int i = 0; i < XT; ++i) xf[i] = *(const bf16x8*)(X + (size_t)(i * 16 + l15) * ldx + k + quad * 8);
#pragma unroll
        for (int j = 0; j < YT; ++j) yf[j] = *(const bf16x8*)(Y + (size_t)(j * 16 + l15) * ldy + k + quad * 8);
#pragma unroll
        for (int i = 0; i < XT; ++i)
#pragma unroll
            for (int j = 0; j < YT; ++j) acc[i][j] = MFMA16(xf[i], yf[j], acc[i][j]);
    }
}
template <bool SRC_LN>
__device__ __forceinline__ void ctx_resid_tiles(const bf16* A, const bf16* Bt, int K, const void* src_ctx, bf16* dst_ctx, const float* gate_ctx, const float* rst, const float* lg, const float* lb, float* part, int bid, int G, int tid, int wave, int l15, int quad) {
    for (int t = bid; t < 256; t += G) {
        const int rt = t >> 5, c0 = (t & 31) * 32, b = rt >> 2, p0 = (rt & 3) * 64, r0 = b * TP + p0;
        pg8::f32x4 acc[4][2];
#pragma unroll
        for (int i = 0; i < 4; ++i)
#pragma unroll
            for (int j = 0; j < 2; ++j) acc[i][j] = (pg8::f32x4){0.f, 0.f, 0.f, 0.f};
        const int ksl = K >> 3;
        frag_gemm<4, 2>(acc, A + (size_t)r0 * K, K, Bt + (size_t)c0 * K, K, wave * ksl, (wave + 1) * ksl, l15, quad);
        float* pw = part + wave * 2048;
#pragma unroll
        for (int i = 0; i < 4; ++i)
#pragma unroll
            for (int j = 0; j < 2; ++j)
#pragma unroll
                for (int rg = 0; rg < 4; ++rg) pw[(i * 16 + quad * 4 + rg) * 32 + j * 16 + l15] = acc[i][j][rg];
        __syncthreads();
        { const int row = tid >> 3, c4 = (tid & 7) * 4;
          f32x4 sum = *(const f32x4*)(part + row * 32 + c4);
#pragma unroll
          for (int w = 1; w < 8; ++w) sum += *(const f32x4*)(part + w * 2048 + row * 32 + c4);
          const size_t off = (size_t)(b * L + p0 + row) * D + c0 + c4;
          f32x4 x4; const f32x4 g4 = *(const f32x4*)(gate_ctx + c0 + c4);
          if (!SRC_LN) x4 = *(const f32x4*)((const float*)src_ctx + off);
          else { const int rU = r0 + row; const u32x2 w = *(const u32x2*)((const bf16*)src_ctx + off); x4 = (f32x4){bflo(w.x), bfhi(w.x), bflo(w.y), bfhi(w.y)};
              x4 = (x4 - rst[2 * rU]) * rst[2 * rU + 1] * *(const f32x4*)(lg + c0 + c4) + *(const f32x4*)(lb + c0 + c4); }
          const f32x4 vv = x4 * ALPHA + g4 * sum; u32x2 o; o.x = pk2(vv.x, vv.y); o.y = pk2(vv.z, vv.w);
          *(u32x2*)(dst_ctx + off) = o; }
        __syncthreads();
    }
}
__device__ __forceinline__ void ctx_up_tiles(const bf16* A, const bf16* Bt, bf16* O, int bid, int G, int wave, int l15, int quad) {
    for (int t = bid; t < 256; t += G) {
        const int rt = t >> 5, c0 = (t & 31) * 128 + (wave & 3) * 32, b = rt >> 2, r0 = b * TP + (rt & 3) * 64 + (wave >> 2) * 32;
        pg8::f32x4 acc[2][2];
#pragma unroll
        for (int i = 0; i < 2; ++i)
#pragma unroll
            for (int j = 0; j < 2; ++j) acc[i][j] = (pg8::f32x4){0.f, 0.f, 0.f, 0.f};
        frag_gemm<2, 2>(acc, Bt + (size_t)c0 * D, D, A + (size_t)r0 * D, D, 0, D, l15, quad);
#pragma unroll
        for (int i = 0; i < 2; ++i)
#pragma unroll
            for (int j = 0; j < 2; ++j) { float v[4];
#pragma unroll
                for (int rg = 0; rg < 4; ++rg) { const float a_ = fmaxf(acc[i][j][rg], 0.f); v[rg] = a_ * a_; }
                u32x2 o; o.x = pk2(v[0], v[1]); o.y = pk2(v[2], v[3]);
                *(u32x2*)(O + (size_t)(r0 + j * 16 + l15) * FF + c0 + i * 16 + quad * 4) = o; }
    }
}

struct Args { const float* in[19]; float* out; unsigned char* ws; };

__global__ void __launch_bounds__(512, 2) fwd_kernel(Args a) {
    extern __shared__ __attribute__((aligned(16))) unsigned char lds[];
    cg::grid_group grid = cg::this_grid();
    const int G = gridDim.x, bid = blockIdx.x, NGW = G * 8;
#define IDS int tid = threadIdx.x; asm volatile("" : "+v"(tid)); const int lane = tid & 63, wave = __builtin_amdgcn_readfirstlane(tid >> 6), quad = lane >> 4, l15 = lane & 15, gw = bid * 8 + wave; (void)quad; (void)l15; (void)gw; (void)lane;
#define xin (a.in[0])
#define cvec (a.in[1])
#define ctx (a.in[2])
#define cctx (a.in[3])
#define w_mod (a.in[4])
#define b_mod (a.in[5])
#define ln_g (a.in[6])
#define ln_b (a.in[7])
#define theta (a.in[11])
#define gkw (a.in[12])
#define gkb (a.in[13])
#define normg (a.in[14])
#define sink (a.in[17])
#define WIN_T ((bf16*)(a.ws + OFF_WIN))
#define WOUT0_T ((bf16*)(a.ws + OFF_WOUT0))
#define W1_0_T ((bf16*)(a.ws + OFF_W1_0))
#define W2_0_T ((bf16*)(a.ws + OFF_W2_0))
#define WQKV_T ((bf16*)(a.ws + OFF_WQKV))
#define WOUT1_T ((bf16*)(a.ws + OFF_WOUT1))
#define W1_1_T ((bf16*)(a.ws + OFF_W1_1))
#define W2_1_T ((bf16*)(a.ws + OFF_W2_1))
#define mod ((float*)(a.ws + OFF_MOD))
#define rope ((float*)(a.ws + OFF_ROPE))
#define xctx ((float*)(a.ws + OFF_XCTX))
#define DEC ((float*)(a.ws + OFF_DEC))
#define H ((bf16*)(a.ws + OFF_H))
#define P ((bf16*)(a.ws + OFF_P))
#define ST ((bf16*)(a.ws + OFF_ST))
#define xlat (a.out)
#define RST(i) ((float*)(a.ws + OFF_RST) + (size_t)(i) * R * 2)
#define VLAT ((bf16*)a.out)
#define VCTX ((bf16*)(a.ws + OFF_XCTX))

#define LATE_ITEMS 9472
#define LATE_CHUNK 16
#define DRAIN_LATE(scr_, maxc_) do { int nclaim_ = 0; unsigned* qc_ = (unsigned*)(a.ws + OFF_XBAR) + 3584; volatile unsigned* qw_ = (volatile unsigned*)(lds + 131072 + 1024); \
        for (;;) { if (nclaim_++ >= (maxc_)) break; if (tid == 0) qw_[0] = __hip_atomic_fetch_add(qc_, (unsigned)LATE_CHUNK, __ATOMIC_RELAXED, __HIP_MEMORY_SCOPE_AGENT);     \
            __syncthreads(); const int base_ = (int)__builtin_amdgcn_readfirstlane(qw_[0]); __syncthreads(); \
            if (base_ >= LATE_ITEMS) break; \
            for (int k_ = wave; k_ < LATE_CHUNK; k_ += 8) { int r_ = base_ + k_; if (r_ >= LATE_ITEMS) break; \
                if (r_ < 2048) { transpose_item(a.in[8], 1024, FF, W1_0_T, (scr_), r_, lane); continue; } r_ -= 2048; \
                if (r_ < 2048) { transpose_item(a.in[9], FF, 1024, W2_0_T, (scr_), r_, lane); continue; } r_ -= 2048; \
                if (r_ < 768) { transpose_item(a.in[16], 1024, NQKV, WQKV_T, (scr_), r_, lane); continue; } r_ -= 768; \
                if (r_ < 512) { transpose_item(a.in[18], 1024, 1024, WOUT1_T, (scr_), r_, lane); continue; } r_ -= 512; \
                if (r_ < 2048) { transpose_item(a.in[8] + (size_t)1024 * FF, 1024, FF, W1_1_T, (scr_), r_, lane); continue; } r_ -= 2048; \
                transpose_item(a.in[9] + (size_t)FF * 1024, FF, 1024, W2_1_T, (scr_), r_, lane); } } } while (0)
    PG8_LAS unsigned char* ldsg = (PG8_LAS unsigned char*)lds;
    unsigned* barw = (unsigned*)(a.ws + OFF_BAR); unsigned bar_target = 0u; (void)barw; (void)bar_target;
    unsigned* xbw = (unsigned*)(a.ws + OFF_XBAR);
    volatile unsigned* xst = (volatile unsigned*)(lds + 131072 + 512);
    if (threadIdx.x == 0) { xst[0] = 0u; xst[1] = 0u; }
    XcdBarrier xbar = xcd_barrier_post(xbw, xst);
    if (a.ws == nullptr) grid.sync();

PROBE_BEGIN(1)
    { IDS
        float* sl = (float*)lds; float* red = (float*)(lds + 12288);
        for (int item = bid; item < 192; item += G) {
            for (int i = tid; i < 3072; i += 512) { const int j = i >> 10, k = i & 1023; const float v = (j < 2) ? cvec[j * 1024 + k] : cctx[k]; sl[i] = v / (1.f + expf(-v)); }
            __syncthreads();
            const int layer = item / 96, n0 = (item % 96) * 64;
            const float* W = w_mod + (size_t)layer * 1024 * 6144 + n0 + lane;
            float a0 = 0.f, a1 = 0.f, a2 = 0.f; const int k0 = wave * 128;
#pragma unroll 8
            for (int kk = 0; kk < 128; ++kk) { const int k = k0 + kk; const float w = W[(size_t)k * 6144]; a0 += sl[k] * w; a1 += sl[1024 + k] * w; a2 += sl[2048 + k] * w; }
            red[(wave * 3 + 0) * 64 + lane] = a0; red[(wave * 3 + 1) * 64 + lane] = a1; red[(wave * 3 + 2) * 64 + lane] = a2;
            __syncthreads();
            if (tid < 192) { const int j = tid >> 6, col = tid & 63; float s = b_mod[layer * 6144 + n0 + col];
#pragma unroll
                for (int w = 0; w < 8; ++w) s += red[(w * 3 + j) * 64 + col];
                mod[(layer * 3 + j) * 6144 + n0 + col] = s; }
            __syncthreads();
        }
        if (bid == G - 1 && tid < 16) {
            double f = 1.0; for (int i = 0; i < tid; ++i) f *= 0.56234132519034908;
            const double x2 = f * f; double cs = 1.0, sn = f, tc = 1.0, ts = f;
            for (int n = 1; n <= 12; ++n) { tc *= -x2 / (double)((2 * n - 1) * (2 * n)); cs += tc; ts *= -x2 / (double)((2 * n) * (2 * n + 1)); sn += ts; }
            double c = 1.0, s = 0.0;
            for (int p = 0; p < 128; ++p) { rope[(p * 16 + tid) * 2] = (float)c; rope[(p * 16 + tid) * 2 + 1] = (float)s; const double nc = c * cs - s * sn; s = s * cs + c * sn; c = nc; }
        }
        float* scr = (float*)(lds + 32768 + wave * 8448);
        for (int it = gw; it < 2064; it += NGW) {
            int r = it;
            if (r < 1552) { transpose_item(a.in[10], 1024, NPROJ, WIN_T, scr, r, lane); continue; } r -= 1552;
            transpose_item(a.in[15], 1024, 1024, WOUT0_T, scr, r, lane);
        }
        { u32x4* z = (u32x4*)(WIN_T + (size_t)NPROJ * D); const u32x4 zero = {0u, 0u, 0u, 0u};
          for (int i = bid * 512 + tid; i < (NPROJ_PAD - NPROJ) * D / 8; i += G * 512) z[i] = zero; }
    }
PROBE_END(1)
    xcd_barrier(xbar);


PROBE_BEGIN(2)
    { IDS
    for (int r = gw; r < R; r += 2 * NGW) {
        const int r2 = r + NGW; const bool has2 = r2 < R;
        bool isc, isc2; int b, b2; const size_t off = row_off(r, isc, b), off2 = row_off(has2 ? r2 : r, isc2, b2);
        const float* xr = (isc ? ctx : xin) + off; const float* md = mod + (isc ? 2 : b) * 6144;
        const float* xr2 = (isc2 ? ctx : xin) + off2; const float* md2 = mod + (isc2 ? 2 : b2) * 6144;
        f32x4 va[4], vb[4];
#pragma unroll
        for (int j = 0; j < 4; ++j) { va[j] = *(const f32x4*)(xr + lane * 4 + 256 * j); vb[j] = *(const f32x4*)(xr2 + lane * 4 + 256 * j); }
#pragma unroll
        for (int j = 0; j < 4; ++j) {
            const int idx = lane * 4 + 256 * j;
            { const f32x4 sh = *(const f32x4*)(md + idx), sc = *(const f32x4*)(md + 1024 + idx);
              const f32x4 h = va[j] * (sc + 1.f) + sh; u32x2 o; o.x = pk2(h.x, h.y); o.y = pk2(h.z, h.w);
              *(u32x2*)(H + (size_t)r * D + idx) = o; }
            if (has2) { const f32x4 sh = *(const f32x4*)(md2 + idx), sc = *(const f32x4*)(md2 + 1024 + idx);
              const f32x4 h = vb[j] * (sc + 1.f) + sh; u32x2 o; o.x = pk2(h.x, h.y); o.y = pk2(h.z, h.w);
              *(u32x2*)(H + (size_t)r2 * D + idx) = o; }
        }
    }
    }
PROBE_END(2)
    xcd_barrier(xbar);
    if (PROBE_SEL == 10) { for (int i = 0; i < 10; ++i) xcd_barrier(xbar); }

PROBE_BEGIN(8)
    { pg8::Gemm g{H, WIN_T, R, NPROJ_PAD, D}; pg8::StaticOrder S; S.init(R, NPROJ_PAD, G, bid); EpiStore<0> E{P, NPROJ, NPROJ};
      pg8::gemm_phase<EpiStore<0>, pg8::StaticOrder, true, true>(ldsg, g, S, E); }
PROBE_END(8)
    xcd_barrier(xbar);

PROBE_BEGIN(3)
#ifndef NO_P3
    { IDS
        float* cf = (float*)lds; float* cb = (float*)(lds + 16640); float* lrs = (float*)(lds + 33280); float* wl = (float*)(lds + 41728);
        bf16* kTf = (bf16*)(lds + 50432); bf16* kTb = (bf16*)(lds + 59648); bf16* vT = (bf16*)(lds + 68864);
        constexpr int NU = NB * 2 * 4 * NCH;
        const int s = tid & 63, dc = tid >> 6;
        u32x4 kv = {0u, 0u, 0u, 0u}, vv0 = kv, vv1 = kv; GatePre gp; gp.lr = (u32x2){0u, 0u}; gp.w = (f32x4){0.f, 0.f, 0.f, 0.f}; gp.bias = 0.f;
#define P3_LOAD(U) do { const int pc_ = (U) % NCH, t_ = (U) / NCH, h_ = t_ & 3, g_ = (t_ >> 2) & 1, b_ = t_ >> 3; const bf16* Pr_ = P + (size_t)(b_ * TP + pc_ * 64) * NPROJ; \
            const int kcol_ = g_ ? 1792 + h_ * 64 : 256 + h_ * 64, vcol_ = g_ ? 2048 + h_ * 128 : 512 + h_ * 128; \
            kv = *(const u32x4*)(Pr_ + (size_t)s * NPROJ + kcol_ + dc * 8); vv0 = *(const u32x4*)(Pr_ + (size_t)s * NPROJ + vcol_ + dc * 8); vv1 = *(const u32x4*)(Pr_ + (size_t)s * NPROJ + vcol_ + (dc + 8) * 8); \
            gp = gate_prefetch(g_, h_, Pr_, gkw, gkb, tid); } while (0)
        if (bid < NU) P3_LOAD(bid);
        for (int unit = bid; unit < NU; unit += G) {
            const int pc = unit % NCH, t = unit / NCH, h = t & 3, g = (t >> 2) & 1, b = t >> 3;
            const float kscale = g ? 1.f : 0.125f;
            fill_cum3(cf, cb, lrs, wl, g, h, gp, theta, tid);
            {
#pragma unroll
              for (int j = 0; j < 8; ++j) { const int d = dc * 8 + j; const unsigned u = kv[j >> 1]; const float kf = ((j & 1) ? bfhi(u) : bflo(u)) * kscale;
                  kTf[d * 72 + s] = (bf16)f2bf(kf * __expf(cf[63 * CS + d] - cf[s * CS + d]));
                  kTb[d * 72 + s] = (bf16)f2bf(kf * __expf(cb[d] - cb[s * CS + d])); }
#pragma unroll
              for (int j = 0; j < 8; ++j) { const unsigned u0 = vv0[j >> 1], u1 = vv1[j >> 1];
                  vT[(dc * 8 + j) * 72 + s] = (bf16)((j & 1) ? (u0 >> 16) : (u0 & 0xffffu)); vT[((dc + 8) * 8 + j) * 72 + s] = (bf16)((j & 1) ? (u1 >> 16) : (u1 & 0xffffu)); }
            }
            const int seq0 = ((b * 2 + g) * 4 + h) * 2;
            const int nf = pc, nbk = (pc < 4) ? 3 - pc : 135 - pc;
            if (tid < 128) { const int dir = tid >> 6, d = tid & 63;
                DEC[((size_t)(seq0 + dir) * NCH + (dir ? nbk : nf)) * 64 + d] = dir ? expf(cb[d]) : expf(cf[63 * CS + d]); }
            if (unit + G < NU) P3_LOAD(unit + G);
            __syncthreads();
            bf16x8 bfr[2];
#pragma unroll
            for (int ks = 0; ks < 2; ++ks) bfr[ks] = *(const bf16x8*)(vT + (wave * 16 + l15) * 72 + ks * 32 + quad * 8);
#pragma unroll
            for (int dir = 0; dir < 2; ++dir) {
                const bf16* kT = dir ? kTb : kTf;
                bf16* dst = ST + ((size_t)(seq0 + dir) * NCH + (dir ? nbk : nf)) * 8192 + (size_t)(wave * 16 + l15) * 64;
#pragma unroll
                for (int dt = 0; dt < 4; ++dt) {
                    pg8::f32x4 acc = {0.f, 0.f, 0.f, 0.f};
#pragma unroll
                    for (int ks = 0; ks < 2; ++ks) { const bf16x8 af = *(const bf16x8*)(kT + (dt * 16 + l15) * 72 + ks * 32 + quad * 8); acc = MFMA16(af, bfr[ks], acc); }
                    u32x2 o; o.x = pk2(acc[0], acc[1]); o.y = pk2(acc[2], acc[3]);
                    *(u32x2*)(dst + dt * 16 + quad * 4) = o;
                }
            }
            __syncthreads();
        }
#undef P3_LOAD
        if ((NU - bid + G - 1) / G < (NU + G - 1) / G) DRAIN_LATE((float*)(lds + wave * 8448), 1);
    }
#endif
PROBE_END(3)
    xcd_barrier(xbar);

PROBE_BEGIN(4)
    { IDS
    for (int i = bid * 512 + tid; i < 32 * 4096; i += G * 512) {
        const int seq = i >> 12, pi = i & 4095, d = (2 * pi) & 63;
        unsigned* sp = (unsigned*)(ST + (size_t)seq * NCH * 8192) + pi; const float* dp = DEC + (size_t)seq * NCH * 64 + d;
        float s0 = 0.f, s1 = 0.f;
#pragma unroll 4
        for (int n = 0; n < NCH; ++n) {
            const unsigned kv = sp[(size_t)n * 4096]; const float d0 = dp[n * 64], d1 = dp[n * 64 + 1];
            sp[(size_t)n * 4096] = pk2(s0, s1);
            s0 = d0 * s0 + bflo(kv); s1 = d1 * s1 + bfhi(kv);
        }
    }
    }
PROBE_END(4)
    xcd_barrier(xbar);

PROBE_BEGIN(5)
#ifndef NO_P5
    { IDS
        float* cf = (float*)lds; float* cb = (float*)(lds + 16640); float* lrs = (float*)(lds + 33280); float* wl = (float*)(lds + 41728);
        bf16* qdf = (bf16*)(lds + 50432); bf16* kif = (bf16*)(lds + 59648); bf16* qdb = (bf16*)(lds + 68864); bf16* kib = (bf16*)(lds + 78080);
        bf16* vT = (bf16*)(lds + 87296); bf16* Am = (bf16*)(lds + 105728); float* red = (float*)(lds + 114944);
        constexpr int NU = NB * 2 * 4 * NCH;
        const int dcq = tid & 7, sq = tid >> 3, sv = tid & 63, dcv = tid >> 6;
        u32x4 qv = {0u, 0u, 0u, 0u}, kv = qv, vv0 = qv, vv1 = qv; GatePre gp; gp.lr = (u32x2){0u, 0u}; gp.w = (f32x4){0.f, 0.f, 0.f, 0.f}; gp.bias = 0.f;
#define P5_LOAD(U) do { const int pc_ = (U) % NCH, t_ = (U) / NCH, h_ = t_ & 3, g_ = (t_ >> 2) & 1, b_ = t_ >> 3; const bf16* Pr_ = P + (size_t)(b_ * TP + pc_ * 64) * NPROJ; \
            const int qcol_ = g_ ? 1536 + h_ * 64 : h_ * 64, kcol_ = g_ ? 1792 + h_ * 64 : 256 + h_ * 64, vcol_ = g_ ? 2048 + h_ * 128 : 512 + h_ * 128; \
            qv = *(const u32x4*)(Pr_ + (size_t)sq * NPROJ + qcol_ + dcq * 8); kv = *(const u32x4*)(Pr_ + (size_t)sq * NPROJ + kcol_ + dcq * 8); \
            vv0 = *(const u32x4*)(Pr_ + (size_t)sv * NPROJ + vcol_ + dcv * 8); vv1 = *(const u32x4*)(Pr_ + (size_t)sv * NPROJ + vcol_ + (dcv + 8) * 8); \
            gp = gate_prefetch(g_, h_, Pr_, gkw, gkb, tid); } while (0)
        if (bid < NU) P5_LOAD(bid);
        for (int unit = bid; unit < NU; unit += G) {
            const int pc = unit % NCH, t = unit / NCH, h = t & 3, g = (t >> 2) & 1, b = t >> 3;
            const int r0 = b * TP + pc * 64;
            const int gcol = g ? 2560 + h * 128 : 1024 + h * 128;
            const float qscale = g ? 0.125f : 1.f, kscale = g ? 1.f : 0.125f;
            fill_cum3(cf, cb, lrs, wl, g, h, gp, theta, tid);
            { u32x4 o1, o2, o3, o4;
#pragma unroll
              for (int j2 = 0; j2 < 4; ++j2) {
                  const int d = dcq * 8 + 2 * j2;
                  const float f0 = cf[sq * CS + d], f1 = cf[sq * CS + d + 1], b0 = cb[sq * CS + d], b1 = cb[sq * CS + d + 1];
                  const float q0 = bflo(qv[j2]) * qscale, q1 = bfhi(qv[j2]) * qscale, k0 = bflo(kv[j2]) * kscale, k1 = bfhi(kv[j2]) * kscale;
                  o1[j2] = pk2(q0 * __expf(f0), q1 * __expf(f1)); o2[j2] = pk2(k0 * __expf(-f0), k1 * __expf(-f1));
                  o3[j2] = pk2(q0 * __expf(b0), q1 * __expf(b1)); o4[j2] = pk2(k0 * __expf(-b0), k1 * __expf(-b1));
              }
              *(u32x4*)(qdf + sq * 72 + dcq * 8) = o1; *(u32x4*)(kif + sq * 72 + dcq * 8) = o2; *(u32x4*)(qdb + sq * 72 + dcq * 8) = o3; *(u32x4*)(kib + sq * 72 + dcq * 8) = o4;
#pragma unroll
              for (int j = 0; j < 8; ++j) { const unsigned u0 = vv0[j >> 1], u1 = vv1[j >> 1];
                  vT[(dcv * 8 + j) * 72 + sv] = (bf16)((j & 1) ? (u0 >> 16) : (u0 & 0xffffu)); vT[((dcv + 8) * 8 + j) * 72 + sv] = (bf16)((j & 1) ? (u1 >> 16) : (u1 & 0xffffu)); }
            }
            __syncthreads();
            const int ct = wave & 3, eh = wave >> 2;
            const int seq0 = ((b * 2 + g) * 4 + h) * 2;
            const int nf = pc, nbk = (pc < 4) ? 3 - pc : 135 - pc;
            const bf16* Sf = ST + ((size_t)seq0 * NCH + nf) * 8192; const bf16* Sb = ST + ((size_t)(seq0 + 1) * NCH + nbk) * 8192;
            const int r = r0 + ct * 16 + l15;
            bf16x8 a2[4][2], a3[4][2]; u32x2 gv[4];
#pragma unroll
            for (int et = 0; et < 4; ++et) { const int e = (eh * 4 + et) * 16 + l15;
#pragma unroll
                for (int ks = 0; ks < 2; ++ks) { a2[et][ks] = *(const bf16x8*)(Sf + e * 64 + ks * 32 + quad * 8); a3[et][ks] = *(const bf16x8*)(Sb + e * 64 + ks * 32 + quad * 8); }
                gv[et] = *(const u32x2*)(P + (size_t)r * NPROJ + gcol + (eh * 4 + et) * 16 + quad * 4); }
            { bf16x8 af[2], ab[2];
#pragma unroll
              for (int ks = 0; ks < 2; ++ks) { af[ks] = *(const bf16x8*)(qdf + (ct * 16 + l15) * 72 + ks * 32 + quad * 8); ab[ks] = *(const bf16x8*)(qdb + (ct * 16 + l15) * 72 + ks * 32 + quad * 8); }
#pragma unroll
              for (int i = 0; i < 2; ++i) { const int st = (wave >> 2) * 2 + i;
                  pg8::f32x4 accf = {0.f, 0.f, 0.f, 0.f}, accb = {0.f, 0.f, 0.f, 0.f};
#pragma unroll
                  for (int ks = 0; ks < 2; ++ks) {
                      const bf16x8 bf_ = *(const bf16x8*)(kif + (st * 16 + l15) * 72 + ks * 32 + quad * 8), bb_ = *(const bf16x8*)(kib + (st * 16 + l15) * 72 + ks * 32 + quad * 8);
                      accf = MFMA16(af[ks], bf_, accf); accb = MFMA16(ab[ks], bb_, accb); }
                  const int scol = st * 16 + l15;
#pragma unroll
                  for (int rg = 0; rg < 4; ++rg) { const int c = ct * 16 + quad * 4 + rg; Am[c * 72 + scol] = (bf16)f2bf(scol <= c ? accf[rg] : accb[rg]); }
              }
            }
            if (unit + G < NU) P5_LOAD(unit + G);
            __syncthreads();
            { bf16x8 bA[2], bQf[2], bQb[2];
#pragma unroll
              for (int ks = 0; ks < 2; ++ks) { const int o = (ct * 16 + l15) * 72 + ks * 32 + quad * 8; bA[ks] = *(const bf16x8*)(Am + o); bQf[ks] = *(const bf16x8*)(qdf + o); bQb[ks] = *(const bf16x8*)(qdb + o); }
              pg8::f32x4 acc[4]; float ss = 0.f;
#pragma unroll
              for (int et = 0; et < 4; ++et) { const int e = (eh * 4 + et) * 16 + l15;
                  pg8::f32x4 c4 = {0.f, 0.f, 0.f, 0.f};
#pragma unroll
                  for (int ks = 0; ks < 2; ++ks) {
                      const bf16x8 a1 = *(const bf16x8*)(vT + e * 72 + ks * 32 + quad * 8);
                      c4 = MFMA16(a1, bA[ks], c4); c4 = MFMA16(a2[et][ks], bQf[ks], c4); c4 = MFMA16(a3[et][ks], bQb[ks], c4); }
                  acc[et] = c4; ss += (c4[0] * c4[0] + c4[1] * c4[1]) + (c4[2] * c4[2] + c4[3] * c4[3]); }
              ss = quad_sum(ss);
              if (quad == 0) red[eh * 64 + ct * 16 + l15] = ss;
              __syncthreads();
              const float tot = red[ct * 16 + l15] + red[64 + ct * 16 + l15];
              const float rinv = 1.f / sqrtf(tot * (1.f / 128.f) + 1e-6f);
#pragma unroll
              for (int et = 0; et < 4; ++et) { const int e0 = (eh * 4 + et) * 16 + quad * 4;
                  float gt[4] = {bflo(gv[et].x), bfhi(gv[et].x), bflo(gv[et].y), bfhi(gv[et].y)}; float y[4];
#pragma unroll
                  for (int i = 0; i < 4; ++i) { const float ng = g ? normg[e0 + i] : 1.f; const float sg = gt[i] * __builtin_amdgcn_rcpf(1.f + __expf(-gt[i])); y[i] = sg * acc[et][i] * rinv * ng; }
                  u32x2 o; o.x = pk2(y[0], y[1]); o.y = pk2(y[2], y[3]);
                  *(u32x2*)(H + (size_t)r * D + g * 512 + h * 128 + e0) = o; }
            }
            __syncthreads();
        }
#undef P5_LOAD
        if ((NU - bid + G - 1) / G < (NU + G - 1) / G) DRAIN_LATE((float*)(lds + wave * 8448), 2);
    }
#endif
PROBE_END(5)
    xcd_barrier(xbar);

PROBE_BEGIN(12)
    { pg8::Gemm g{H, WOUT0_T, R, D, D}; LatOrder S; S.init(D, G, bid); EpiResid<0, false> E{xin, ctx, VLAT, VCTX, nullptr, mod + 2 * 1024, nullptr, nullptr, nullptr};
      pg8::gemm_phase<EpiResid<0, false>, LatOrder, true, true>(ldsg, g, S, E); }
    { IDS
      ctx_resid_tiles<false>(H, WOUT0_T, D, ctx, VCTX, mod + 2 * 6144 + 2 * 1024, nullptr, nullptr, nullptr, (float*)lds, bid, G, tid, wave, l15, quad); }
PROBE_END(12)
    xcd_barrier(xbar);
PROBE_BEGIN(7)
    { IDS
    DRAIN_LATE((float*)(lds + wave * 8448), 1 << 30);
    ln_phase<false, false>(RST(0), VLAT, VCTX, nullptr, nullptr, ln_g, ln_b, mod + 3 * 1024, H, gw, NGW, lane);
    }
PROBE_END(7)
    xcd_barrier(xbar);
PROBE_BEGIN(11)
    { pg8::Gemm g{H, W1_0_T, R, FF, D}; LatOrder S; S.init(FF, G, bid); EpiStore<1> E{P, FF, FF};
      pg8::gemm_phase<EpiStore<1>, LatOrder, true, true>(ldsg, g, S, E); }
    { IDS
      ctx_up_tiles(H, W1_0_T, P, bid, G, wave, l15, quad); }
PROBE_END(11)
    xcd_barrier(xbar);
PROBE_BEGIN(9)
    { pg8::Gemm g{P, W2_0_T, R, D, FF}; LatOrder S; S.init(D, G, bid); EpiResid<1, false> E{VLAT, VCTX, VLAT, VCTX, nullptr, mod + 5 * 1024, RST(0), ln_g, ln_b};
      pg8::gemm_phase<EpiResid<1, false>, LatOrder, true, true>(ldsg, g, S, E); }
    { IDS
      ctx_resid_tiles<true>(P, W2_0_T, FF, VCTX, VCTX, mod + 2 * 6144 + 5 * 1024, RST(0), ln_g, ln_b, (float*)lds, bid, G, tid, wave, l15, quad); }
PROBE_END(9)
    xcd_barrier(xbar);
    { IDS
    ln_phase<false, false>(RST(1), VLAT, VCTX, nullptr, nullptr, ln_g + 1024, ln_b + 1024, mod + 3 * 6144, H, gw, NGW, lane);
    }
    xcd_barrier(xbar);

PROBE_BEGIN(13)
    { pg8::Gemm g{H, WQKV_T, R, NQKV, D}; pg8::StaticOrder S; S.init(R, NQKV, G, bid); EpiStore<0> E{P, NQKV, NQKV};
      pg8::gemm_phase<EpiStore<0>, pg8::StaticOrder, true, true>(ldsg, g, S, E); }
PROBE_END(13)
    xcd_barrier(xbar);

PROBE_BEGIN(6)
#ifndef NO_P12
    { IDS
        bf16* Qs = (bf16*)lds; bf16* Ks = (bf16*)(lds + 73728); bf16* Vt = (bf16*)(lds + 82944); float* ropes = (float*)(lds + 92160);
        for (int i = tid; i < 1024; i += 512) ((f32x4*)ropes)[i] = ((const f32x4*)rope)[i];
        PACC_DECL
        for (int unit = bid; unit < NB * 4 * 64; unit += G) {
            PACC_BEGIN(40)
            const int nb = unit & 63, kvh = (unit >> 6) & 3, b = unit >> 8;
#define ATT_VALID(t) ((t) < 4 || (unsigned)(nb - 1 + (((t) - 4) >> 1)) < 64u)
#define ATT_KPOS(t) ((nb - 1 + (((t) - 4) >> 1)) * 128 + (((t) - 4) & 1) * 64)
#define ATT_KROW(t) ((t) < 4 ? b * TP + (t) * 64 : b * TP + L + ATT_KPOS(t))
            const int keyk = tid >> 2, pck = tid & 3, c1k = (pck & 1) + (pck >> 1) * 4, keyv = tid & 63, dcv = tid >> 6;
            u32x4 pk1 = {0u, 0u, 0u, 0u}, pk2_ = pk1, pvv = pk1;
#define ATT_LOAD(t) do { const int kr_ = ATT_KROW(t); \
                if (tid < 256) { const bf16* src_ = P + (size_t)(kr_ + keyk) * NQKV + 1024 + kvh * 64; pk1 = *(const u32x4*)(src_ + c1k * 8); pk2_ = *(const u32x4*)(src_ + (c1k + 2) * 8); } \
                pvv = *(const u32x4*)(P + (size_t)(kr_ + keyv) * NQKV + 1280 + kvh * 64 + dcv * 8); } while (0)
            ATT_LOAD(0);
            __syncthreads();
#pragma unroll
            for (int i = 0; i < 4; ++i) {
                const int it = tid + i * 512, pcq = it & 3, row = it >> 2, g = row >> 7, qi = row & 127, pos = nb * 128 + qi;
                const bf16* src = P + (size_t)(b * TP + L + pos) * NQKV + (kvh * 4 + g) * 64;
                const int c1 = (pcq & 1) + (pcq >> 1) * 4;
                const u32x4 u1 = *(const u32x4*)(src + c1 * 8), u2 = *(const u32x4*)(src + (c1 + 2) * 8);
                const int pv = (pcq < 2) ? (pos >> 6) : (pos & 63);
                const f32x4* tab = (const f32x4*)(ropes + (pv * 16 + (c1 & 1) * 8) * 2);
                u32x4 o1, o2;
#pragma unroll
                for (int j2 = 0; j2 < 4; ++j2) { const f32x4 cs = tab[j2];
                    const float a0 = bflo(u1[j2]), a1 = bfhi(u1[j2]), b0 = bflo(u2[j2]), b1 = bfhi(u2[j2]);
                    o1[j2] = pk2((a0 * cs.x - b0 * cs.y) * QSC, (a1 * cs.z - b1 * cs.w) * QSC); o2[j2] = pk2((a0 * cs.y + b0 * cs.x) * QSC, (a1 * cs.w + b1 * cs.z) * QSC); }
                *(u32x4*)(Qs + row * 72 + c1 * 8) = o1; *(u32x4*)(Qs + row * 72 + (c1 + 2) * 8) = o2;
            }
            const int g = wave >> 1, qrow0 = g * 128 + (wave & 1) * 64, qpos0 = nb * 128 + (wave & 1) * 64;
            float mrun[4], lrun[4]; pg8::f32x4 O[4][4];
            const float sk = sink[kvh * 4 + g] * 1.4426950408889634f;
#pragma unroll
            for (int qt = 0; qt < 4; ++qt) { mrun[qt] = sk; lrun[qt] = (quad == 0) ? 1.f : 0.f;
#pragma unroll
                for (int dt = 0; dt < 4; ++dt) O[dt][qt] = (pg8::f32x4){0.f, 0.f, 0.f, 0.f}; }
            PACC_END(40)
            int ti = 0;
            while (ti < 10) {
                PACC_BEGIN(41)
                const bool local = ti >= 4;
                const int kpos0 = local ? ATT_KPOS(ti) : 0;
                const int side = local ? ((ti - 4) >> 1) - 1 : 0;
                __syncthreads();
                if (tid < 256) {
                    u32x4 o1 = pk1, o2 = pk2_;
                    if (local) {
                        const int pos = kpos0 + keyk, pv = (pck < 2) ? (pos >> 6) : (pos & 63);
                        const f32x4* tab = (const f32x4*)(ropes + (pv * 16 + (c1k & 1) * 8) * 2);
#pragma unroll
                        for (int j2 = 0; j2 < 4; ++j2) { const f32x4 cs = tab[j2];
                            const float a0 = bflo(pk1[j2]), a1 = bfhi(pk1[j2]), b0 = bflo(pk2_[j2]), b1 = bfhi(pk2_[j2]);
                            o1[j2] = pk2(a0 * cs.x - b0 * cs.y, a1 * cs.z - b1 * cs.w); o2[j2] = pk2(a0 * cs.y + b0 * cs.x, a1 * cs.w + b1 * cs.z); }
                    }
                    *(u32x4*)(Ks + keyk * 72 + c1k * 8) = o1; *(u32x4*)(Ks + keyk * 72 + (c1k + 2) * 8) = o2;
                }
#pragma unroll
                for (int j = 0; j < 8; ++j) { const unsigned u = pvv[j >> 1]; Vt[(dcv * 8 + j) * 72 + keyv] = (bf16)((j & 1) ? (u >> 16) : (u & 0xffffu)); }
                __syncthreads();
                PACC_END(41)
                PACC_BEGIN(42)
                int tn = ti + 1;
                while (tn < 10 && !ATT_VALID(tn)) ++tn;
                if (tn < 10) ATT_LOAD(tn);
                bf16x8 kfr[4][2];
#pragma unroll
                for (int kt = 0; kt < 4; ++kt)
#pragma unroll
                    for (int ks = 0; ks < 2; ++ks) kfr[kt][ks] = *(const bf16x8*)(Ks + (kt * 16 + l15) * 72 + ks * 32 + quad * 8);
#pragma unroll
                for (int qt = 0; qt < 4; ++qt) {
                    pg8::f32x4 S[4];
#pragma unroll
                    for (int kt = 0; kt < 4; ++kt) S[kt] = (pg8::f32x4){0.f, 0.f, 0.f, 0.f};
#pragma unroll
                    for (int ks = 0; ks < 2; ++ks) { const bf16x8 qf = *(const bf16x8*)(Qs + (qrow0 + qt * 16 + l15) * 72 + ks * 32 + quad * 8);
#pragma unroll
                        for (int kt = 0; kt < 4; ++kt) S[kt] = MFMA16(kfr[kt][ks], qf, S[kt]); }
                    float mx = -INFINITY;
                    if (side < 0) {
                        const int tl = quad * 4 - (qpos0 + qt * 16 + l15 - kpos0 - 128);
#pragma unroll
                        for (int kt = 0; kt < 4; ++kt)
#pragma unroll
                            for (int rg = 0; rg < 4; ++rg) { const float sv_ = (tl >= -(kt * 16 + rg)) ? S[kt][rg] : -INFINITY; S[kt][rg] = sv_; mx = fmaxf(mx, sv_); }
                    } else if (side > 0) {
                        const int th = (qpos0 + qt * 16 + l15 - kpos0 + 128) - quad * 4;
#pragma unroll
                        for (int kt = 0; kt < 4; ++kt)
#pragma unroll
                            for (int rg = 0; rg < 4; ++rg) { const float sv_ = (th >= (kt * 16 + rg)) ? S[kt][rg] : -INFINITY; S[kt][rg] = sv_; mx = fmaxf(mx, sv_); }
                    } else {
#pragma unroll
                        for (int kt = 0; kt < 4; ++kt)
#pragma unroll
                            for (int rg = 0; rg < 4; ++rg) mx = fmaxf(mx, S[kt][rg]);
                    }
                    mx = quad_max(mx);
                    const float mnew = fmaxf(mrun[qt], mx), al = __builtin_amdgcn_exp2f(mrun[qt] - mnew); mrun[qt] = mnew;
                    float ps = 0.f;
#pragma unroll
                    for (int kt = 0; kt < 4; ++kt)
#pragma unroll
                        for (int rg = 0; rg < 4; ++rg) { const float p = __builtin_amdgcn_exp2f(S[kt][rg] - mnew); S[kt][rg] = p; ps += p; }
                    lrun[qt] = lrun[qt] * al + ps;
#pragma unroll
                    for (int dt = 0; dt < 4; ++dt) O[dt][qt] = O[dt][qt] * al;
#pragma unroll
                    for (int s2 = 0; s2 < 2; ++s2) {
                        u32x4 pw; pw.x = pk2(S[2 * s2][0], S[2 * s2][1]); pw.y = pk2(S[2 * s2][2], S[2 * s2][3]);
                        pw.z = pk2(S[2 * s2 + 1][0], S[2 * s2 + 1][1]); pw.w = pk2(S[2 * s2 + 1][2], S[2 * s2 + 1][3]);
                        const bf16x8 pf = __builtin_bit_cast(bf16x8, pw);
#pragma unroll
                        for (int dt = 0; dt < 4; ++dt) {
                            const s16x4 lo = *(const s16x4*)(Vt + (dt * 16 + l15) * 72 + s2 * 32 + quad * 4), hi = *(const s16x4*)(Vt + (dt * 16 + l15) * 72 + s2 * 32 + 16 + quad * 4);
                            O[dt][qt] = MFMA16(__builtin_shufflevector(lo, hi, 0, 1, 2, 3, 4, 5, 6, 7), pf, O[dt][qt]); }
                    }
                }
                ti = tn;
                PACC_END(42)
            }
            PACC_BEGIN(43)
#pragma unroll
            for (int qt = 0; qt < 4; ++qt) {
                const float lt = quad_sum(lrun[qt]);
                const float inv = 1.f / lt;
                const int r = b * TP + L + qpos0 + qt * 16 + l15;
#pragma unroll
                for (int dt = 0; dt < 4; ++dt) { u32x2 o; o.x = pk2(O[dt][qt][0] * inv, O[dt][qt][1] * inv); o.y = pk2(O[dt][qt][2] * inv, O[dt][qt][3] * inv);
                    *(u32x2*)(H + (size_t)r * D + (kvh * 4 + g) * 64 + dt * 16 + quad * 4) = o; }
            }
            PACC_END(43)
#undef ATT_VALID
#undef ATT_KPOS
#undef ATT_KROW
#undef ATT_LOAD
        }
        PACC_SLEEP()
    }
#endif
PROBE_END(6)
    xcd_barrier(xbar);

PROBE_BEGIN(14)
    { pg8::Gemm g{H, WOUT1_T, R, D, D}; LatOrder S; S.init(D, G, bid); EpiResid<1, false> E{VLAT, VCTX, VLAT, VCTX, nullptr, mod + 3 * 6144 + 2 * 1024, RST(1), ln_g + 1024, ln_b + 1024};
      pg8::gemm_phase<EpiResid<1, false>, LatOrder, true, true>(ldsg, g, S, E); }
PROBE_END(14)
    xcd_barrier(xbar);
    { IDS
    ln_phase<false, true>(RST(2), VLAT, VCTX, nullptr, nullptr, ln_g + 2048, ln_b + 2048, mod + 3 * 6144 + 3 * 1024, H, gw, NGW, lane);
    }
    xcd_barrier(xbar);
PROBE_BEGIN(15)
    { pg8::Gemm g{H, W1_1_T, R, FF, D}; LatOrder S; S.init(FF, G, bid); EpiStore<1> E{P, FF, FF};
      pg8::gemm_phase<EpiStore<1>, LatOrder, true, true>(ldsg, g, S, E); }
PROBE_END(15)
    xcd_barrier(xbar);
PROBE_BEGIN(16)
    { pg8::Gemm g{P, W2_1_T, R, D, FF}; LatOrder S; S.init(D, G, bid); EpiResid<1, true> E{VLAT, VCTX, nullptr, nullptr, H, mod + 3 * 6144 + 5 * 1024, RST(2), ln_g + 2048, ln_b + 2048};
      pg8::gemm_phase<EpiResid<1, true>, LatOrder, true, true>(ldsg, g, S, E); }
PROBE_END(16)
    xcd_barrier(xbar);
    { IDS
    ln_phase<true, true>(nullptr, nullptr, nullptr, H, a.out, ln_g + 3072, ln_b + 3072, mod, H, gw, NGW, lane);
    }
}

extern "C" void kernel_launch(void* const* d_in, const int* in_sizes, int n_in, void* d_out, int out_size, void* d_ws, size_t ws_size, hipStream_t stream) {
    static int grid = 0;
    if (grid == 0) {
        if (n_in != 19 || out_size != NB * T * D || ws_size < WS_TOTAL) { fprintf(stderr, "kernel_launch: unexpected shapes (n_in %d out %d ws %zu)\n", n_in, out_size, ws_size); grid = -1; return; }
        int dev = 0, cus = 0, per_cu = 0;
        hipGetDevice(&dev); hipDeviceGetAttribute(&cus, hipDeviceAttributeMultiprocessorCount, dev);
        if (hipFuncSetAttribute((const void*)fwd_kernel, hipFuncAttributeMaxDynamicSharedMemorySize, LDS_BYTES) != hipSuccess) { fprintf(stderr, "kernel_launch: hipFuncSetAttribute failed\n"); grid = -1; return; }
        if (hipOccupancyMaxActiveBlocksPerMultiprocessor(&per_cu, (const void*)fwd_kernel, 512, LDS_BYTES) != hipSuccess || per_cu < 1) per_cu = 1;
        (void)hipGetLastError();
        grid = cus > 0 ? cus : 256;
    }
    if (grid < 0) return;
    Args a{};
    for (int i = 0; i < 19; ++i) a.in[i] = (const float*)d_in[i];
    a.out = (float*)d_out; a.ws = (unsigned char*)d_ws;
    if (hipMemsetAsync((char*)d_ws + OFF_XBAR, 0, 16384, stream) != hipSuccess) { fprintf(stderr, "kernel_launch: hipMemsetAsync of the barrier words failed\n"); return; }
    void* args[] = {&a};
    hipError_t e = hipLaunchCooperativeKernel((const void*)fwd_kernel, dim3(grid), dim3(512), args, LDS_BYTES, stream);
    if (e != hipSuccess) fprintf(stderr, "cooperative launch failed: %s (grid %d)\n", hipGetErrorString(e), grid);
}
```

```cpp
#include <hip/hip_runtime.h>
#include <hip/hip_cooperative_groups.h>
#include <cstdio>
#include <cstdint>
namespace cg = cooperative_groups;
namespace pg8 {
#define PG8_LAS __attribute__((address_space(3)))
typedef unsigned short bf16_t;
typedef short bf16x8 __attribute__((ext_vector_type(8)));
typedef float f32x4 __attribute__((ext_vector_type(4)));
typedef unsigned u32x4 __attribute__((ext_vector_type(4)));
constexpr int BM = 256, BK = 64, HALF = 128, HTB = HALF * BK * 2  , STAGE_BYTES = 8 * HTB, NXCD = 8, WGM = 8;

__host__ __device__ __forceinline__ int lds_byte(int r, int c) { const int st = (r >> 4) * 2 + (c >> 5), rr = r & 15, cc = c & 31, ob = rr * 64 + cc * 2; return st * 1024 + (ob ^ (((ob >> 9) & 1) << 5)); }
__host__ __device__ __forceinline__ void stage_rc(int b, int& R, int& C) { const int st = b / 1024, sb = b % 1024, swz = sb ^ (((sb >> 9) & 1) << 5); R = (st >> 1) * 16 + swz / 64; C = (st & 1) * 32 + (swz % 64) / 2; }
__host__ __device__ __forceinline__ int perm32(int rho) { const int n = rho >> 4, i = rho & 15; return 8 * (i >> 2) + 4 * n + (i & 3); }

struct Unit { int pm, pn; };
struct Gemm { const bf16_t* A; const bf16_t* Bt; int M, N, K; };

struct StaticOrder {
    int nM, nN, nwg, G, c;
    __host__ __device__ void init(int M, int N, int G_, int c_) { nM = M / BM; nN = N / BM; nwg = nM * nN; G = G_; c = c_; }
    __host__ __device__ bool next(int i, Unit& u) const {
        const long L = (long)i * G + c; if (L >= nwg) return false;
        int wgid = (int)L; { const int q = nwg / NXCD, r = nwg % NXCD, xcd = wgid % NXCD, off = wgid / NXCD; wgid = (xcd < r ? xcd * (q + 1) : r * (q + 1) + (xcd - r) * q) + off; }
        const int nig = WGM * nN, gid = wgid / nig, fm = gid * WGM, gsz = (nM - fm) < WGM ? (nM - fm) : WGM;
        u.pm = fm + ((wgid % nig) % gsz); u.pn = (wgid % nig) / gsz; return true;
    }
    __device__ __forceinline__ void a_ready(const Unit&) const {}
    __device__ __forceinline__ void done(const Unit&) const {}
};

__device__ __forceinline__ unsigned cvt_pk_bf16(float lo, float hi) { unsigned r; asm volatile("v_cvt_pk_bf16_f32 %0, %1, %2" : "=v"(r) : "v"(lo), "v"(hi)); return r; }

template <class Epi, class Sched, bool ALIGN_EPI = false, bool SP2 = false>
__device__ __forceinline__ void gemm_phase(PG8_LAS unsigned char* lds, const Gemm g, const Sched& S, const Epi& E) {
    int tid = threadIdx.x; asm volatile("" : "+v"(tid));
    const int wid = __builtin_amdgcn_readfirstlane(tid >> 6), lane = tid & 63, wr = wid >> 2, wc = wid & 3, fr = lane & 15, fq = lane >> 4;
    const int K = g.K, nt = K / BK;
    unsigned voffA[2], voffB[2];
#pragma unroll
    for (int i = 0; i < 2; ++i) { int R, C; stage_rc(tid * 16 + i * 8192, R, C); const int Rb = Epi::PERM ? ((R & ~31) + perm32(R & 31)) : R;
        voffA[i] = (unsigned)(R * K + C) * 2u; voffB[i] = (unsigned)(Rb * K + C) * 2u; }
    const size_t kstep = (size_t)(BK * 2);
    const size_t hstep = (size_t)HALF * K * 2;
    const size_t tstep = 2 * hstep;
    const unsigned ldsw = (unsigned)wid * 1024u;
    const int aoff = lds_byte(wr * 64 + fr, fq * 8), boff = lds_byte(wc * 32 + fr, fq * 8);
#define PG8_SA(b, h) (((b) * 2 + (h)) * HTB)
#define PG8_SB(b, h) ((4 + (b) * 2 + (h)) * HTB)
#define PG8_STAGE(bufoff, gbase, voff) do { _Pragma("unroll") for (int _i = 0; _i < 2; ++_i) \
        __builtin_amdgcn_global_load_lds((const unsigned*)((const char*)(gbase) + (voff)[_i]), (PG8_LAS unsigned*)(lds + (bufoff) + ldsw + _i * 8192), 16, 0, 0); } while (0)
#define PG8_LDA(dst, b, h) do { _Pragma("unroll") for (int m = 0; m < 4; ++m) _Pragma("unroll") for (int k = 0; k < 2; ++k) dst[m][k] = *(const PG8_LAS bf16x8*)(lds + PG8_SA(b, h) + aoff + m * 2048 + k * 1024); } while (0)
#define PG8_LDB(dst, b, h) do { _Pragma("unroll") for (int n = 0; n < 2; ++n) _Pragma("unroll") for (int k = 0; k < 2; ++k) dst[n][k] = *(const PG8_LAS bf16x8*)(lds + PG8_SB(b, h) + boff + n * 2048 + k * 1024); } while (0)
#define PG8_MMA(ai, bj, At, Bt) do { __builtin_amdgcn_s_setprio(1); _Pragma("unroll") for (int m = 0; m < 4; ++m) _Pragma("unroll") for (int n = 0; n < 2; ++n) _Pragma("unroll") for (int k = 0; k < 2; ++k) \
        acc[ai][bj][m][n] = __builtin_amdgcn_mfma_f32_16x16x32_bf16(Bt[n][k], At[m][k], acc[ai][bj][m][n], 0, 0, 0); __builtin_amdgcn_s_setprio(0); } while (0)
#define PG8_WAIT_V(n) asm volatile("s_waitcnt vmcnt(" #n ")" ::: "memory")
#define PG8_WAIT_L(n) asm volatile("s_waitcnt lgkmcnt(" #n ")" ::: "memory")
#define PG8_BAR __builtin_amdgcn_s_barrier()
#define PG8_SCHED __builtin_amdgcn_sched_barrier(0)
    Unit cur, nxt; int ui = 0;
    if (!S.next(0, cur)) return;
    f32x4 acc[2][2][4][2];
#pragma unroll
    for (int a = 0; a < 2; ++a)
#pragma unroll
        for (int b = 0; b < 2; ++b)
#pragma unroll
            for (int m = 0; m < 4; ++m)
#pragma unroll
                for (int n = 0; n < 2; ++n) acc[a][b][m][n] = (f32x4){0.f, 0.f, 0.f, 0.f};
    bf16x8 At[4][2], B0[2][2], B1[2][2];
    const char* cA = (const char*)g.A + (size_t)cur.pm * tstep; const char* cB = (const char*)g.Bt + (size_t)cur.pn * tstep;
    S.a_ready(cur);
    if constexpr (SP2) {
        PG8_STAGE(PG8_SB(0, 0), cB, voffB); PG8_STAGE(PG8_SB(0, 1), cB + hstep, voffB); PG8_STAGE(PG8_SA(0, 0), cA, voffA); PG8_STAGE(PG8_SA(0, 1), cA + hstep, voffA);
        if (wr == 1) PG8_BAR;
        PG8_WAIT_V(2); PG8_BAR;
        PG8_STAGE(PG8_SB(1, 0), cB + kstep, voffB); PG8_STAGE(PG8_SA(1, 0), cA + kstep, voffA); PG8_STAGE(PG8_SB(1, 1), cB + hstep + kstep, voffB);
        PG8_WAIT_V(6); PG8_BAR;
    } else {
        PG8_STAGE(PG8_SB(0, 0), cB, voffB); PG8_STAGE(PG8_SA(0, 0), cA, voffA); PG8_STAGE(PG8_SB(0, 1), cB + hstep, voffB); PG8_STAGE(PG8_SA(0, 1), cA + hstep, voffA);
        if (wr == 1) PG8_BAR;
        PG8_WAIT_V(4); PG8_BAR;
        PG8_STAGE(PG8_SB(1, 0), cB + kstep, voffB); PG8_STAGE(PG8_SA(1, 0), cA + kstep, voffA); PG8_STAGE(PG8_SB(1, 1), cB + hstep + kstep, voffB);
        PG8_WAIT_V(6); PG8_BAR;
    }
    for (;;) {
        const bool has_next = S.next(ui + 1, nxt);
        const char* nA = has_next ? (const char*)g.A + (size_t)nxt.pm * tstep : cA; const char* nB = has_next ? (const char*)g.Bt + (size_t)nxt.pn * tstep : cB;
        for (int t = 0; t < nt; t += 2) {
            const bool last = (t == nt - 2);
            const char* a1 = cA + (size_t)(t + 1) * kstep;
            const char* a2 = last ? nA : cA + (size_t)(t + 2) * kstep; const char* b2 = last ? nB : cB + (size_t)(t + 2) * kstep;
            const char* a3 = a2 + kstep; const char* b3 = b2 + kstep;
            if (last && has_next) S.a_ready(nxt);
            if constexpr (SP2) {
            PG8_LDB(B0, 0, 0); PG8_LDB(B1, 0, 1); PG8_SCHED; PG8_LDA(At, 0, 0); PG8_STAGE(PG8_SA(1, 1), a1 + hstep, voffA);
            PG8_WAIT_V(8); PG8_WAIT_L(0); PG8_BAR; PG8_MMA(0, 0, At, B0); PG8_MMA(0, 1, At, B1); PG8_BAR; PG8_SCHED;
            PG8_LDA(At, 0, 1); PG8_STAGE(PG8_SB(0, 0), b2, voffB); PG8_STAGE(PG8_SB(0, 1), b2 + hstep, voffB); PG8_STAGE(PG8_SA(0, 0), a2, voffA);
            PG8_WAIT_V(8); PG8_WAIT_L(0); PG8_BAR; PG8_MMA(1, 0, At, B0); PG8_MMA(1, 1, At, B1); PG8_BAR; PG8_SCHED;
            PG8_LDB(B0, 1, 0); PG8_LDB(B1, 1, 1); PG8_SCHED; PG8_LDA(At, 1, 0); PG8_STAGE(PG8_SA(0, 1), a2 + hstep, voffA);
            PG8_WAIT_V(8); PG8_WAIT_L(0); PG8_BAR; PG8_MMA(0, 0, At, B0); PG8_MMA(0, 1, At, B1); PG8_BAR; PG8_SCHED;
            PG8_LDA(At, 1, 1); PG8_STAGE(PG8_SB(1, 0), b3, voffB); PG8_STAGE(PG8_SB(1, 1), b3 + hstep, voffB); PG8_STAGE(PG8_SA(1, 0), a3, voffA);
            PG8_WAIT_V(8); PG8_WAIT_L(0); PG8_BAR; PG8_MMA(1, 0, At, B0); PG8_MMA(1, 1, At, B1); PG8_BAR; PG8_SCHED;
            } else {
            PG8_LDB(B0, 0, 0); PG8_SCHED; PG8_LDA(At, 0, 0); PG8_STAGE(PG8_SA(1, 1), a1 + hstep, voffA);
            PG8_WAIT_L(8); PG8_BAR; PG8_WAIT_L(0); PG8_MMA(0, 0, At, B0); PG8_BAR; PG8_SCHED;
            PG8_LDB(B1, 0, 1); PG8_STAGE(PG8_SB(0, 0), b2, voffB);
            PG8_BAR; PG8_WAIT_L(0); PG8_MMA(0, 1, At, B1); PG8_BAR;
            PG8_LDA(At, 0, 1); PG8_STAGE(PG8_SA(0, 0), a2, voffA);
            PG8_BAR; PG8_WAIT_L(0); PG8_MMA(1, 0, At, B0); PG8_BAR; PG8_SCHED;
            PG8_STAGE(PG8_SB(0, 1), b2 + hstep, voffB);
            PG8_WAIT_V(6); PG8_BAR; PG8_MMA(1, 1, At, B1); PG8_BAR;
            PG8_LDB(B0, 1, 0); PG8_SCHED; PG8_LDA(At, 1, 0); PG8_STAGE(PG8_SA(0, 1), a2 + hstep, voffA);
            PG8_WAIT_L(8); PG8_BAR; PG8_WAIT_L(0); PG8_MMA(0, 0, At, B0); PG8_BAR; PG8_SCHED;
            PG8_LDB(B1, 1, 1); PG8_STAGE(PG8_SB(1, 0), b3, voffB);
            PG8_BAR; PG8_WAIT_L(0); PG8_MMA(0, 1, At, B1); PG8_BAR;
            PG8_LDA(At, 1, 1); PG8_STAGE(PG8_SA(1, 0), a3, voffA);
            PG8_BAR; PG8_WAIT_L(0); PG8_MMA(1, 0, At, B0); PG8_BAR; PG8_SCHED;
            PG8_STAGE(PG8_SB(1, 1), b3 + hstep, voffB);
            PG8_WAIT_V(6); PG8_BAR; PG8_MMA(1, 1, At, B1); PG8_BAR;
            }
        }
        if constexpr (ALIGN_EPI) { if (wr == 0) PG8_BAR; }
        if constexpr (!Epi::AFTER_DRAIN) { E(acc, cur, wr, wc, fr, fq); S.done(cur); }
        if (!has_next) break;
#pragma unroll
        for (int a = 0; a < 2; ++a)
#pragma unroll
            for (int b = 0; b < 2; ++b)
#pragma unroll
                for (int m = 0; m < 4; ++m)
#pragma unroll
                    for (int n = 0; n < 2; ++n) acc[a][b][m][n] = (f32x4){0.f, 0.f, 0.f, 0.f};
        cur = nxt; cA = nA; cB = nB; ++ui;
        if constexpr (ALIGN_EPI) { if (wr == 1) PG8_BAR; }
    }
    PG8_WAIT_V(0);
    if constexpr (!ALIGN_EPI) { if (wr == 0) PG8_BAR; }
    PG8_BAR;
    if constexpr (Epi::AFTER_DRAIN) { E.fused(acc, cur, wr, wc, fr, fq, lds, wid, lane); S.done(cur); }
#undef PG8_SA
#undef PG8_SB
#undef PG8_STAGE
#undef PG8_LDA
#undef PG8_LDB
#undef PG8_MMA
#undef PG8_WAIT_V
#undef PG8_WAIT_L
#undef PG8_BAR
#undef PG8_SCHED
}
}

constexpr int NB = 2, T = 8192, L = 256, D = 1024, TP = T + L, R = NB * TP;
constexpr int FF = 4096, NPROJ = 3104, NPROJ_PAD = 3328, NQKV = 1536, NCH = TP / 64;
constexpr float ALPHA = 1.4142135623730951f;
constexpr int LDS_BYTES = 147456;

typedef unsigned short bf16;
typedef float f32x4 __attribute__((ext_vector_type(4)));
typedef short bf16x8 __attribute__((ext_vector_type(8)));
typedef short s16x4 __attribute__((ext_vector_type(4)));
typedef unsigned u32x4 __attribute__((ext_vector_type(4)));
typedef unsigned u32x2 __attribute__((ext_vector_type(2)));

constexpr size_t OFF_WIN = 0;
constexpr size_t OFF_WOUT0 = OFF_WIN + (size_t)NPROJ_PAD * D * 2;
constexpr size_t OFF_W1_0 = OFF_WOUT0 + (size_t)D * D * 2;
constexpr size_t OFF_W2_0 = OFF_W1_0 + (size_t)FF * D * 2;
constexpr size_t OFF_WQKV = OFF_W2_0 + (size_t)FF * D * 2;
constexpr size_t OFF_WOUT1 = OFF_WQKV + (size_t)NQKV * D * 2;
constexpr size_t OFF_W1_1 = OFF_WOUT1 + (size_t)D * D * 2;
constexpr size_t OFF_W2_1 = OFF_W1_1 + (size_t)FF * D * 2;
constexpr size_t OFF_MOD = OFF_W2_1 + (size_t)FF * D * 2;
constexpr size_t OFF_ROPE = OFF_MOD + 2 * 3 * 6144 * 4;
constexpr size_t OFF_BAR = OFF_ROPE + 128 * 16 * 8;
constexpr size_t OFF_XBAR = OFF_BAR + 256;
constexpr size_t OFF_RST = OFF_XBAR + 16384;
constexpr size_t OFF_XCTX = OFF_RST + (size_t)3 * R * 2 * 4;
constexpr size_t OFF_DEC = OFF_XCTX + (size_t)NB * L * D * 4;
constexpr size_t OFF_H = OFF_DEC + (size_t)32 * NCH * 64 * 4;
constexpr size_t OFF_P = OFF_H + (size_t)R * D * 2;
constexpr size_t OFF_ST = OFF_P + (size_t)R * NPROJ * 2;
constexpr size_t WS_TOTAL = OFF_ST + (size_t)32 * NCH * 8192 * 2;
static_assert(WS_TOTAL <= 268435456, "workspace map exceeds 256 MiB");
static_assert(OFF_P + (size_t)R * FF * 2 <= WS_TOTAL, "MLP hidden overlay");

typedef float f32x2_t __attribute__((ext_vector_type(2)));
typedef __bf16 bf16x2_t __attribute__((ext_vector_type(2)));
__device__ __forceinline__ unsigned pk2(float lo, float hi) { const f32x2_t v = {lo, hi}; const bf16x2_t b = __builtin_convertvector(v, bf16x2_t); return __builtin_bit_cast(unsigned, b); }
__device__ __forceinline__ unsigned f2bf(float f) { return pk2(f, f) & 0xffffu; }
__device__ __forceinline__ float bf2f(unsigned h) { return __uint_as_float(h << 16); }
__device__ __forceinline__ float bflo(unsigned u) { return __uint_as_float(u << 16); }
__device__ __forceinline__ float bfhi(unsigned u) { return __uint_as_float(u & 0xffff0000u); }
__device__ __forceinline__ float wave_sum(float v) {
#pragma unroll
    for (int o = 1; o < 64; o <<= 1) v += __shfl_xor(v, o);
    return v;
}
__device__ __forceinline__ float quad_max(float x) {
    const unsigned u = __float_as_uint(x);
    const auto r = __builtin_amdgcn_permlane32_swap(u, u, false, false);
    const float m = fmaxf(__uint_as_float(r[0]), __uint_as_float(r[1]));
    const unsigned v = __float_as_uint(m);
    const auto q = __builtin_amdgcn_permlane16_swap(v, v, false, false);
    return fmaxf(__uint_as_float(q[0]), __uint_as_float(q[1]));
}
__device__ __forceinline__ float quad_sum(float x) {
    const unsigned u = __float_as_uint(x);
    const auto r = __builtin_amdgcn_permlane32_swap(u, u, false, false);
    const float m = __uint_as_float(r[0]) + __uint_as_float(r[1]);
    const unsigned v = __float_as_uint(m);
    const auto q = __builtin_amdgcn_permlane16_swap(v, v, false, false);
    return __uint_as_float(q[0]) + __uint_as_float(q[1]);
}
#define MFMA16(a, b, c) __builtin_amdgcn_mfma_f32_16x16x32_bf16((a), (b), (c), 0, 0, 0)

__device__ __forceinline__ size_t row_off(int r, bool& isc, int& b) { b = (r >= TP) ? 1 : 0; const int p = r - b * TP; isc = p < L; return isc ? (size_t)(b * L + p) * D : (size_t)(b * T + p - L) * D; }

template <int ACT> struct EpiStore {
    static constexpr bool PERM = true, AFTER_DRAIN = false;
    bf16* O; int ldc; int ncols;
    __device__ __forceinline__ void operator()(const pg8::f32x4 (&acc)[2][2][4][2], const pg8::Unit& u, int wr, int wc, int fr, int fq) const {
        const int row0 = u.pm * 256 + wr * 64 + fr, col0 = u.pn * 256 + wc * 32 + 8 * fq;
#pragma unroll
        for (int ai = 0; ai < 2; ++ai)
#pragma unroll
            for (int m = 0; m < 4; ++m) {
                bf16* rowp = O + (size_t)(row0 + ai * 128 + m * 16) * ldc;
#pragma unroll
                for (int bj = 0; bj < 2; ++bj) {
                    const int col = col0 + bj * 128;
                    pg8::f32x4 v0 = acc[ai][bj][m][0], v1 = acc[ai][bj][m][1];
                    if (ACT == 1) {
#pragma unroll
                        for (int i = 0; i < 4; ++i) { float a = fmaxf(v0[i], 0.f), b = fmaxf(v1[i], 0.f); v0[i] = a * a; v1[i] = b * b; }
                    }
                    u32x4 w; w.x = pg8::cvt_pk_bf16(v0[0], v0[1]); w.y = pg8::cvt_pk_bf16(v0[2], v0[3]); w.z = pg8::cvt_pk_bf16(v1[0], v1[1]); w.w = pg8::cvt_pk_bf16(v1[2], v1[3]);
                    if (col < ncols) *(u32x4*)(rowp + col) = w;
                }
            }
    }
};
template <int SRC, bool DST_FIN> struct EpiResid {
    static constexpr bool PERM = true, AFTER_DRAIN = false;
    const void* src_lat; const void* src_ctx; bf16* dst_lat; bf16* dst_ctx; bf16* dst_fin; const float* gate;
    const float* rst; const float* lg; const float* lb;
    __device__ __forceinline__ void operator()(const pg8::f32x4 (&acc)[2][2][4][2], const pg8::Unit& u, int wr, int wc, int fr, int fq) const {
        const int row0 = u.pm * 256 + wr * 64 + fr, col0 = u.pn * 256 + wc * 32 + 8 * fq;
#pragma unroll
        for (int ai = 0; ai < 2; ++ai)
#pragma unroll
            for (int m = 0; m < 4; ++m) {
                const int row = row0 + ai * 128 + m * 16;
                bool isc; int b; const size_t off = row_off(row, isc, b);
                const float* gt = gate + (isc ? 2 : b) * 6144;
                float mean = 0.f, rstd = 1.f; if (SRC == 1) { mean = rst[2 * row]; rstd = rst[2 * row + 1]; }
#pragma unroll
                for (int bj = 0; bj < 2; ++bj) {
                    const int col = col0 + bj * 128;
                    f32x4 x0, x1;
                    if (SRC == 0) { const float* sp = (const float*)(isc ? src_ctx : src_lat) + off + col; x0 = *(const f32x4*)sp; x1 = *(const f32x4*)(sp + 4); }
                    else { const u32x4 w = *(const u32x4*)((const bf16*)(isc ? src_ctx : src_lat) + off + col);
                        x0 = (f32x4){bflo(w.x), bfhi(w.x), bflo(w.y), bfhi(w.y)}; x1 = (f32x4){bflo(w.z), bfhi(w.z), bflo(w.w), bfhi(w.w)};
                        x0 = (x0 - mean) * rstd * *(const f32x4*)(lg + col) + *(const f32x4*)(lb + col); x1 = (x1 - mean) * rstd * *(const f32x4*)(lg + col + 4) + *(const f32x4*)(lb + col + 4); }
                    const f32x4 g0 = *(const f32x4*)(gt + col), g1 = *(const f32x4*)(gt + col + 4);
                    const pg8::f32x4 a0 = acc[ai][bj][m][0], a1 = acc[ai][bj][m][1];
                    u32x4 o; o.x = pk2(ALPHA * x0.x + g0.x * a0[0], ALPHA * x0.y + g0.y * a0[1]); o.y = pk2(ALPHA * x0.z + g0.z * a0[2], ALPHA * x0.w + g0.w * a0[3]);
                    o.z = pk2(ALPHA * x1.x + g1.x * a1[0], ALPHA * x1.y + g1.y * a1[1]); o.w = pk2(ALPHA * x1.z + g1.z * a1[2], ALPHA * x1.w + g1.w * a1[3]);
                    bf16* dp = DST_FIN ? dst_fin + (size_t)row * D + col : (isc ? dst_ctx : dst_lat) + off + col;
                    *(u32x4*)dp = o;
                }
            }
    }
};

__device__ __forceinline__ void transpose_item(const float* __restrict__ W, int K, int N, bf16* WT, float* scr, int item, int lane) {
    const int nblk = N / 32, kb = item / nblk, nb = item % nblk, k0 = 64 * kb, n0 = 32 * nb;
#pragma unroll 8
    for (int i = 0; i < 32; ++i) { const int kk = 2 * i + (lane >> 5); scr[kk * 33 + (lane & 31)] = W[(size_t)(k0 + kk) * N + n0 + (lane & 31)]; }
    asm volatile("s_waitcnt lgkmcnt(0)" ::: "memory");
    const int c = lane & 7;
#pragma unroll
    for (int j = 0; j < 4; ++j) { const int n = (lane >> 3) + 8 * j; const float* s = scr + (8 * c) * 33 + n;
        u32x4 o; o.x = pk2(s[0 * 33], s[1 * 33]); o.y = pk2(s[2 * 33], s[3 * 33]); o.z = pk2(s[4 * 33], s[5 * 33]); o.w = pk2(s[6 * 33], s[7 * 33]);
        *(u32x4*)(WT + (size_t)(n0 + n) * K + k0 + 8 * c) = o; }
    asm volatile("s_waitcnt lgkmcnt(0)" ::: "memory");
}

template <bool LAST, bool SKIPCTX>
__device__ __forceinline__ void ln_phase(float* rst, const bf16* vlat, const bf16* vctx, const bf16* vfin, float* outp, const float* __restrict__ g, const float* __restrict__ bt, const float* __restrict__ modn, bf16* H, int gw, int NGW, int lane) {
    int r = gw;
    if (SKIPCTX) { while (r < R) { const int p = r >= TP ? r - TP : r; if (p >= L) break; r += NGW; } }
    u32x4 vn[2];
    if (r < R) { bool isc; int b; const size_t off = row_off(r, isc, b); const bf16* xr = LAST ? vfin + (size_t)r * D : (isc ? vctx : vlat) + off;
#pragma unroll
        for (int j = 0; j < 2; ++j) vn[j] = *(const u32x4*)(xr + lane * 8 + 512 * j); }
    while (r < R) {
        bool isc; int b; const size_t off = row_off(r, isc, b);
        float v[16];
#pragma unroll
        for (int j = 0; j < 2; ++j)
#pragma unroll
            for (int i = 0; i < 4; ++i) { v[j * 8 + 2 * i] = bflo(vn[j][i]); v[j * 8 + 2 * i + 1] = bfhi(vn[j][i]); }
        int rn = r + NGW;
        if (SKIPCTX) { while (rn < R) { const int p = rn >= TP ? rn - TP : rn; if (p >= L) break; rn += NGW; } }
        if (rn < R) { bool isc2; int b2; const size_t off2 = row_off(rn, isc2, b2); const bf16* xr2 = LAST ? vfin + (size_t)rn * D : (isc2 ? vctx : vlat) + off2;
#pragma unroll
            for (int j = 0; j < 2; ++j) vn[j] = *(const u32x4*)(xr2 + lane * 8 + 512 * j); }
        float s = 0.f;
#pragma unroll
        for (int i = 0; i < 16; ++i) s += v[i];
        const float mean = wave_sum(s) * (1.f / D); float s2 = 0.f;
#pragma unroll
        for (int i = 0; i < 16; ++i) { v[i] -= mean; s2 += v[i] * v[i]; }
        const float rstd = 1.f / sqrtf(wave_sum(s2) * (1.f / D) + 1e-5f);
        const float* md = modn + (isc ? 2 : b) * 6144;
        if (!LAST && lane == 0) { rst[2 * r] = mean; rst[2 * r + 1] = rstd; }
#pragma unroll
        for (int j = 0; j < 2; ++j) {
            const int idx = lane * 8 + 512 * j;
            float y[8];
#pragma unroll
            for (int q = 0; q < 2; ++q) { const f32x4 gg = *(const f32x4*)(g + idx + 4 * q), bb = *(const f32x4*)(bt + idx + 4 * q);
#pragma unroll
                for (int i = 0; i < 4; ++i) y[q * 4 + i] = v[j * 8 + q * 4 + i] * rstd * gg[i] + bb[i]; }
            if (LAST) { *(f32x4*)(outp + off + idx) = (f32x4){y[0], y[1], y[2], y[3]}; *(f32x4*)(outp + off + idx + 4) = (f32x4){y[4], y[5], y[6], y[7]}; }
            else {
                float h[8];
#pragma unroll
                for (int q = 0; q < 2; ++q) { const f32x4 sh = *(const f32x4*)(md + idx + 4 * q), sc = *(const f32x4*)(md + 1024 + idx + 4 * q);
#pragma unroll
                    for (int i = 0; i < 4; ++i) h[q * 4 + i] = y[q * 4 + i] * (sc[i] + 1.f) + sh[i]; }
                u32x4 o; o.x = pk2(h[0], h[1]); o.y = pk2(h[2], h[3]); o.z = pk2(h[4], h[5]); o.w = pk2(h[6], h[7]);
                *(u32x4*)(H + (size_t)r * D + idx) = o;
            }
        }
        r = rn;
    }
}

__device__ __forceinline__ float log_sigmoid(float z) { return fminf(z, 0.f) - __logf(1.f + __expf(-fabsf(z))); }

constexpr int CS = 65;
constexpr float QSC = 0.125f * 1.4426950408889634f;
struct GatePre { u32x2 lr; f32x4 w; float bias; };
__device__ __forceinline__ GatePre gate_prefetch(int g, int h, const bf16* Pr, const float* gkw, const float* gkb, int tid) {
    GatePre p; p.lr = (u32x2){0u, 0u}; p.w = (f32x4){0.f, 0.f, 0.f, 0.f}; p.bias = 0.f;
    if (g) { const int c = tid >> 3, part = tid & 7;
        p.lr = *(const u32x2*)(Pr + (size_t)c * NPROJ + 3072 + part * 4);
        const int idx = tid * 4, dir = idx >> 10, r = (idx >> 6) & 15, d = idx & 63;
        p.w = *(const f32x4*)(gkw + (dir * 16 + r) * 256 + h * 64 + d);
        if (tid < 128) p.bias = gkb[(tid >> 6) * 256 + h * 64 + (tid & 63)]; }
    return p;
}
__device__ __forceinline__ void fill_cum3(float* cf, float* cb, float* lrs, float* wl, int g, int h, const GatePre& gp, const float* theta, int tid) {
    if (g == 0) {
        const float lgf = log1pf(-expf(theta[h])), lgb = log1pf(-expf(theta[4 + h]));
        for (int i = tid; i < 4096; i += 512) { const int c = i >> 6, d = i & 63; cf[c * CS + d] = (float)(c + 1) * lgf; cb[c * CS + d] = (float)(64 - c) * lgb; }
        __syncthreads();
        return;
    }
    { const int c = tid >> 3, part = tid & 7;
      float* lp = lrs + c * 33 + part * 4; lp[0] = bflo(gp.lr.x); lp[1] = bfhi(gp.lr.x); lp[2] = bflo(gp.lr.y); lp[3] = bfhi(gp.lr.y);
      *(f32x4*)(wl + tid * 4) = gp.w;
      if (tid < 128) wl[2048 + tid] = gp.bias; }
    __syncthreads();
    { const int c = tid >> 3, dg = tid & 7;
#pragma unroll
      for (int dir = 0; dir < 2; ++dir) {
          f32x4 za = *(const f32x4*)(wl + 2048 + dir * 64 + dg * 8), zb = *(const f32x4*)(wl + 2048 + dir * 64 + dg * 8 + 4);
#pragma unroll
          for (int r = 0; r < 16; ++r) { const float lv = lrs[c * 33 + dir * 16 + r];
              za += lv * *(const f32x4*)(wl + (dir * 16 + r) * 64 + dg * 8); zb += lv * *(const f32x4*)(wl + (dir * 16 + r) * 64 + dg * 8 + 4); }
          float* dst = (dir ? cb : cf) + c * CS + dg * 8;
#pragma unroll
          for (int j = 0; j < 4; ++j) { dst[j] = log_sigmoid(za[j]) * (1.f / 16.f); dst[4 + j] = log_sigmoid(zb[j]) * (1.f / 16.f); } } }
    __syncthreads();
    if (tid < 128) {
        const int dir = tid >> 6; float* arr = (dir ? cb : cf) + (tid & 63);
        float run = 0.f;
#pragma unroll
        for (int hh = 0; hh < 2; ++hh) {
            float v[32];
            const int base = dir ? (1 - hh) * 32 : hh * 32;
#pragma unroll
            for (int c = 0; c < 32; ++c) v[c] = arr[(base + c) * CS];
            if (dir == 0) {
#pragma unroll
                for (int c = 0; c < 32; ++c) { run += v[c]; arr[(base + c) * CS] = run; }
            } else {
#pragma unroll
                for (int c = 31; c >= 0; --c) { run += v[c]; arr[(base + c) * CS] = run; }
            }
        }
    }
    __syncthreads();
}

__device__ __forceinline__ void fast_bar(unsigned* ctr, unsigned& target) {
    asm volatile("s_waitcnt vmcnt(0)" ::: "memory");
    __syncthreads();
    target += gridDim.x;
    if (threadIdx.x == 0) {
        __builtin_amdgcn_fence(__ATOMIC_RELEASE, "agent");
        asm volatile("s_waitcnt vmcnt(0)" ::: "memory");
        __hip_atomic_fetch_add(ctr, 1u, __ATOMIC_RELAXED, __HIP_MEMORY_SCOPE_AGENT);
        while (__hip_atomic_load(ctr, __ATOMIC_RELAXED, __HIP_MEMORY_SCOPE_AGENT) < target) __builtin_amdgcn_s_sleep(1);
        __builtin_amdgcn_fence(__ATOMIC_ACQUIRE, "agent");
        asm volatile("s_waitcnt vmcnt(0)" ::: "memory");
    }
    __syncthreads();
}
#define RLX_AGENT __ATOMIC_RELAXED, __HIP_MEMORY_SCOPE_AGENT
#define XB_TMO      128
#define XB_XCNT(j)  (256  + 64 * (j))
#define XB_XSUB(j)  (1280 + 64 * (j))
#define XB_XGEN(j)  (2304 + 64 * (j))
#define XB_TOP      3328
#define XB_TOPGEN   3392
#define XCD_BAR_WORDS 3456
#define XB_SPIN_CAP (1u << 18)

__device__ __forceinline__ unsigned xb_ld(unsigned* p)              { return __hip_atomic_load(p, __ATOMIC_RELAXED, __HIP_MEMORY_SCOPE_AGENT); }
__device__ __forceinline__ unsigned xb_add(unsigned* p, unsigned v) { return __hip_atomic_fetch_add(p, v, __ATOMIC_RELAXED, __HIP_MEMORY_SCOPE_AGENT); }
__device__ __forceinline__ unsigned xb_xcc_id() { return (unsigned)__builtin_amdgcn_s_getreg((3 << 11) | 20) & 0xFu; }
#define XB_SPIN(cond, bar) do { unsigned _sp = 0; while (cond) { __builtin_amdgcn_s_sleep(1); \
    if ((++_sp & 255u) == 0u) { if (xb_ld(&(bar)[XB_TMO])) break; if (_sp > XB_SPIN_CAP) { atomicAdd(&(bar)[XB_TMO], 1u); break; } } } } while (0)

struct XcdBarrier {
    unsigned* bar; unsigned x;
    volatile unsigned* st;
};

__device__ __forceinline__ XcdBarrier xcd_barrier_post(unsigned* bar, volatile unsigned* st) {
    XcdBarrier b; b.bar = bar; b.x = xb_xcc_id(); b.st = st;
    if (threadIdx.x == 0) (void)xb_add(&bar[XB_XCNT(b.x)], 1u);
    return b;
}
__device__ __forceinline__ void xcd_barrier_complete(unsigned* bar, unsigned x, unsigned& nloc, unsigned& nx) {
    const unsigned G = gridDim.x * gridDim.y * gridDim.z;
    unsigned sum, cnt, mine, sp = 0u;
    for (;;) {
        sum = 0u; cnt = 0u; mine = 0u;
#pragma unroll
        for (unsigned j = 0; j < 16; ++j) { const unsigned c = xb_ld(&bar[XB_XCNT(j)]); sum += c; cnt += (c > 0u) ? 1u : 0u; mine = (j == x) ? c : mine; }
        if (sum == G) break;
        __builtin_amdgcn_s_sleep(1);
        if ((++sp & 255u) == 0u) { if (xb_ld(&bar[XB_TMO])) break; if (sp > XB_SPIN_CAP) { atomicAdd(&bar[XB_TMO], 1u); break; } }
    }
    nloc = mine > 0u ? mine : 1u; nx = cnt > 0u ? cnt : 1u;
}

__device__ __forceinline__ void xcd_barrier(const XcdBarrier& b) {
    asm volatile("s_waitcnt vmcnt(0)" ::: "memory");
    __syncthreads();
    if (threadIdx.x == 0) {
        unsigned* bar = b.bar;
        __builtin_amdgcn_s_waitcnt(0);
        unsigned nloc = b.st[0], nx = b.st[1];
        if (nloc == 0u) { xcd_barrier_complete(bar, b.x, nloc, nx); b.st[0] = nloc; b.st[1] = nx; }
        const unsigned old = xb_add(&bar[XB_XSUB(b.x)], 1u);
        const unsigned gen = old / nloc;
        if (old + 1u == (gen + 1u) * nloc) {
            __builtin_amdgcn_fence(__ATOMIC_RELEASE, "agent");
            asm volatile("s_waitcnt vmcnt(0)" ::: "memory");
            const unsigned og = xb_add(&bar[XB_TOP], 1u);
            const unsigned tg = og / nx;
            if (og + 1u == (tg + 1u) * nx) xb_add(&bar[XB_TOPGEN], 1u);
            else XB_SPIN(xb_ld(&bar[XB_TOPGEN]) == tg, bar);
            __builtin_amdgcn_fence(__ATOMIC_ACQUIRE, "agent");
            xb_add(&bar[XB_XGEN(b.x)], 1u);
            asm volatile("s_waitcnt vmcnt(0)" ::: "memory");
        } else {
            XB_SPIN(xb_ld(&bar[XB_XGEN(b.x)]) == gen, bar);
            __builtin_amdgcn_fence(__ATOMIC_ACQUIRE, "agent");
            asm volatile("s_waitcnt vmcnt(0)" ::: "memory");
        }
    }
    __syncthreads();
}

struct LatOrder {
    pg8::StaticOrder S;
    __device__ void init(int N, int G, int c) { S.init(NB * T, N, G, c); }
    __device__ bool next(int i, pg8::Unit& u) const { if (!S.next(i, u)) return false; u.pm = u.pm + 1 + (u.pm >= 32 ? 1 : 0); return true; }
    __device__ __forceinline__ void a_ready(const pg8::Unit&) const {}
    __device__ __forceinline__ void done(const pg8::Unit&) const {}
};
#ifndef PROBE_SEL
#define PROBE_SEL 0
#endif
#ifndef PROBE_MUL
#define PROBE_MUL 3
#endif
#define PACC_DECL unsigned long long pacc = 0, pacc_t0 = 0; (void)pacc; (void)pacc_t0;
#define PACC_BEGIN(k) if (PROBE_SEL == (k)) pacc_t0 = __builtin_amdgcn_s_memrealtime();
#define PACC_END(k) if (PROBE_SEL == (k)) pacc += __builtin_amdgcn_s_memrealtime() - pacc_t0;
#define PACC_SLEEP() if (PROBE_SEL >= 40 && PROBE_SEL < 60) { const unsigned long long t1 = __builtin_amdgcn_s_memrealtime(), dt = pacc * PROBE_MUL; while (__builtin_amdgcn_s_memrealtime() - t1 < dt) __builtin_amdgcn_s_sleep(8); }
#define PROBE_BEGIN(k) unsigned long long pt0_##k = 0; if (PROBE_SEL == (k)) pt0_##k = __builtin_amdgcn_s_memrealtime();
#define PROBE_END(k) if (PROBE_SEL == (k)) { const unsigned long long t1 = __builtin_amdgcn_s_memrealtime(), dt = (t1 - pt0_##k) * PROBE_MUL; while (__builtin_amdgcn_s_memrealtime() - t1 < dt) __builtin_amdgcn_s_sleep(8); }


template <int XT, int YT>
__device__ __forceinline__ void frag_gemm(pg8::f32x4 (&acc)[XT][YT], const bf16* X, int ldx, const bf16* Y, int ldy, int k0, int k1, int l15, int quad) {
#pragma unroll 4
    for (int k = k0; k < k1; k += 32) {
        bf16x8 xf[XT], yf[YT];
#pragma unroll
        for (int i = 0; i < XT; ++i) xf[i] = *(const bf16x8*)(X + (size_t)(i * 16 + l15) * ldx + k + quad * 8);
#pragma unroll
        for (int j = 0; j < YT; ++j) yf[j] = *(const bf16x8*)(Y + (size_t)(j * 16 + l15) * ldy + k + quad * 8);
#pragma unroll
        for (int i = 0; i < XT; ++i)
#pragma unroll
            for (int j = 0; j < YT; ++j) acc[i][j] = MFMA16(xf[i], yf[j], acc[i][j]);
    }
}
template <bool SRC_LN>
__device__ __forceinline__ void ctx_resid_tiles(const bf16* A, const bf16* Bt, int K, const void* src_ctx, bf16* dst_ctx, const float* gate_ctx, const float* rst, const float* lg, const float* lb, float* part, int bid, int G, int tid, int wave, int l15, int quad) {
    for (int t = bid; t < 256; t += G) {
        const int rt = t >> 5, c0 = (t & 31) * 32, b = rt >> 2, p0 = (rt & 3) * 64, r0 = b * TP + p0;
        pg8::f32x4 acc[4][2];
#pragma unroll
        for (int i = 0; i < 4; ++i)
#pragma unroll
            for (int j = 0; j < 2; ++j) acc[i][j] = (pg8::f32x4){0.f, 0.f, 0.f, 0.f};
        const int ksl = K >> 3;
        frag_gemm<4, 2>(acc, A + (size_t)r0 * K, K, Bt + (size_t)c0 * K, K, wave * ksl, (wave + 1) * ksl, l15, quad);
        float* pw = part + wave * 2048;
#pragma unroll
        for (int i = 0; i < 4; ++i)
#pragma unroll
            for (int j = 0; j < 2; ++j)
#pragma unroll
                for (int rg = 0; rg < 4; ++rg) pw[(i * 16 + quad * 4 + rg) * 32 + j * 16 + l15] = acc[i][j][rg];
        __syncthreads();
        { const int row = tid >> 3, c4 = (tid & 7) * 4;
          f32x4 sum = *(const f32x4*)(part + row * 32 + c4);
#pragma unroll
          for (int w = 1; w < 8; ++w) sum += *(const f32x4*)(part + w * 2048 + row * 32 + c4);
          const size_t off = (size_t)(b * L + p0 + row) * D + c0 + c4;
          f32x4 x4; const f32x4 g4 = *(const f32x4*)(gate_ctx + c0 + c4);
          if (!SRC_LN) x4 = *(const f32x4*)((const float*)src_ctx + off);
          else { const int rU = r0 + row; const u32x2 w = *(const u32x2*)((const bf16*)src_ctx + off); x4 = (f32x4){bflo(w.x), bfhi(w.x), bflo(w.y), bfhi(w.y)};
              x4 = (x4 - rst[2 * rU]) * rst[2 * rU + 1] * *(const f32x4*)(lg + c0 + c4) + *(const f32x4*)(lb + c0 + c4); }
          const f32x4 vv = x4 * ALPHA + g4 * sum; u32x2 o; o.x = pk2(vv.x, vv.y); o.y = pk2(vv.z, vv.w);
          *(u32x2*)(dst_ctx + off) = o; }
        __syncthreads();
    }
}
__device__ __forceinline__ void ctx_up_tiles(const bf16* A, const bf16* Bt, bf16* O, int bid, int G, int wave, int l15, int quad) {
    for (int t = bid; t < 256; t += G) {
        const int rt = t >> 5, c0 = (t & 31) * 128 + (wave & 3) * 32, b = rt >> 2, r0 = b * TP + (rt & 3) * 64 + (wave >> 2) * 32;
        pg8::f32x4 acc[2][2];
#pragma unroll
        for (int i = 0; i < 2; ++i)
#pragma unroll
            for (int j = 0; j < 2; ++j) acc[i][j] = (pg8::f32x4){0.f, 0.f, 0.f, 0.f};
        frag_gemm<2, 2>(acc, Bt + (size_t)c0 * D, D, A + (size_t)r0 * D, D, 0, D, l15, quad);
#pragma unroll
        for (int i = 0; i < 2; ++i)
#pragma unroll
            for (int j = 0; j < 2; ++j) { float v[4];
#pragma unroll
                for (int rg = 0; rg < 4; ++rg) { const float a_ = fmaxf(acc[i][j][rg], 0.f); v[rg] = a_ * a_; }
                u32x2 o; o.x = pk2(v[0], v[1]); o.y = pk2(v[2], v[3]);
                *(u32x2*)(O + (size_t)(r0 + j * 16 + l15) * FF + c0 + i * 16 + quad * 4) = o; }
    }
}

struct Args { const float* in[19]; float* out; unsigned char* ws; };

__global__ void __launch_bounds__(512, 2) fwd_kernel(Args a) {
    extern __shared__ __attribute__((aligned(16))) unsigned char lds[];
    cg::grid_group grid = cg::this_grid();
    const int G = gridDim.x, bid = blockIdx.x, NGW = G * 8;
#define IDS int tid = threadIdx.x; asm volatile("" : "+v"(tid)); const int lane = tid & 63, wave = __builtin_amdgcn_readfirstlane(tid >> 6), quad = lane >> 4, l15 = lane & 15, gw = bid * 8 + wave; (void)quad; (void)l15; (void)gw; (void)lane;
#define xin (a.in[0])
#define cvec (a.in[1])
#define ctx (a.in[2])
#define cctx (a.in[3])
#define w_mod (a.in[4])
#define b_mod (a.in[5])
#define ln_g (a.in[6])
#define ln_b (a.in[7])
#define theta (a.in[11])
#define gkw (a.in[12])
#define gkb (a.in[13])
#define normg (a.in[14])
#define sink (a.in[17])
#define WIN_T ((bf16*)(a.ws + OFF_WIN))
#define WOUT0_T ((bf16*)(a.ws + OFF_WOUT0))
#define W1_0_T ((bf16*)(a.ws + OFF_W1_0))
#define W2_0_T ((bf16*)(a.ws + OFF_W2_0))
#define WQKV_T ((bf16*)(a.ws + OFF_WQKV))
#define WOUT1_T ((bf16*)(a.ws + OFF_WOUT1))
#define W1_1_T ((bf16*)(a.ws + OFF_W1_1))
#define W2_1_T ((bf16*)(a.ws + OFF_W2_1))
#define mod ((float*)(a.ws + OFF_MOD))
#define rope ((float*)(a.ws + OFF_ROPE))
#define xctx ((float*)(a.ws + OFF_XCTX))
#define DEC ((float*)(a.ws + OFF_DEC))
#define H ((bf16*)(a.ws + OFF_H))
#define P ((bf16*)(a.ws + OFF_P))
#define ST ((bf16*)(a.ws + OFF_ST))
#define xlat (a.out)
#define RST(i) ((float*)(a.ws + OFF_RST) + (size_t)(i) * R * 2)
#define VLAT ((bf16*)a.out)
#define VCTX ((bf16*)(a.ws + OFF_XCTX))

#define LATE_ITEMS 9472
#define LATE_CHUNK 16
#define DRAIN_LATE(scr_, maxc_) do { int nclaim_ = 0; unsigned* qc_ = (unsigned*)(a.ws + OFF_XBAR) + 3584; volatile unsigned* qw_ = (volatile unsigned*)(lds + 131072 + 1024); \
        for (;;) { if (nclaim_++ >= (maxc_)) break; if (tid == 0) qw_[0] = __hip_atomic_fetch_add(qc_, (unsigned)LATE_CHUNK, __ATOMIC_RELAXED, __HIP_MEMORY_SCOPE_AGENT);     \
            __syncthreads(); const int base_ = (int)__builtin_amdgcn_readfirstlane(qw_[0]); __syncthreads(); \
            if (base_ >= LATE_ITEMS) break; \
            for (int k_ = wave; k_ < LATE_CHUNK; k_ += 8) { int r_ = base_ + k_; if (r_ >= LATE_ITEMS) break; \
                if (r_ < 2048) { transpose_item(a.in[8], 1024, FF, W1_0_T, (scr_), r_, lane); continue; } r_ -= 2048; \
                if (r_ < 2048) { transpose_item(a.in[9], FF, 1024, W2_0_T, (scr_), r_, lane); continue; } r_ -= 2048; \
                if (r_ < 768) { transpose_item(a.in[16], 1024, NQKV, WQKV_T, (scr_), r_, lane); continue; } r_ -= 768; \
                if (r_ < 512) { transpose_item(a.in[18], 1024, 1024, WOUT1_T, (scr_), r_, lane); continue; } r_ -= 512; \
                if (r_ < 2048) { transpose_item(a.in[8] + (size_t)1024 * FF, 1024, FF, W1_1_T, (scr_), r_, lane); continue; } r_ -= 2048; \
                transpose_item(a.in[9] + (size_t)FF * 1024, FF, 1024, W2_1_T, (scr_), r_, lane); } } } while (0)
    PG8_LAS unsigned char* ldsg = (PG8_LAS unsigned char*)lds;
    unsigned* barw = (unsigned*)(a.ws + OFF_BAR); unsigned bar_target = 0u; (void)barw; (void)bar_target;
    unsigned* xbw = (unsigned*)(a.ws + OFF_XBAR);
    volatile unsigned* xst = (volatile unsigned*)(lds + 131072 + 512);
    if (threadIdx.x == 0) { xst[0] = 0u; xst[1] = 0u; }
    XcdBarrier xbar = xcd_barrier_post(xbw, xst);
    if (a.ws == nullptr) grid.sync();

PROBE_BEGIN(1)
    { IDS
        float* sl = (float*)lds; float* red = (float*)(lds + 12288);
        for (int item = bid; item < 192; item += G) {
            for (int i = tid; i < 3072; i += 512) { const int j = i >> 10, k = i & 1023; const float v = (j < 2) ? cvec[j * 1024 + k] : cctx[k]; sl[i] = v / (1.f + expf(-v)); }
            __syncthreads();
            const int layer = item / 96, n0 = (item % 96) * 64;
            const float* W = w_mod + (size_t)layer * 1024 * 6144 + n0 + lane;
            float a0 = 0.f, a1 = 0.f, a2 = 0.f; const int k0 = wave * 128;
#pragma unroll 8
            for (int kk = 0; kk < 128; ++kk) { const int k = k0 + kk; const float w = W[(size_t)k * 6144]; a0 += sl[k] * w; a1 += sl[1024 + k] * w; a2 += sl[2048 + k] * w; }
            red[(wave * 3 + 0) * 64 + lane] = a0; red[(wave * 3 + 1) * 64 + lane] = a1; red[(wave * 3 + 2) * 64 + lane] = a2;
            __syncthreads();
            if (tid < 192) { const int j = tid >> 6, col = tid & 63; float s = b_mod[layer * 6144 + n0 + col];
#pragma unroll
                for (int w = 0; w < 8; ++w) s += red[(w * 3 + j) * 64 + col];
                mod[(layer * 3 + j) * 6144 + n0 + col] = s; }
            __syncthreads();
        }
        if (bid == G - 1 && tid < 16) {
            double f = 1.0; for (int i = 0; i < tid; ++i) f *= 0.56234132519034908;
            const double x2 = f * f; double cs = 1.0, sn = f, tc = 1.0, ts = f;
            for (int n = 1; n <= 12; ++n) { tc *= -x2 / (double)((2 * n - 1) * (2 * n)); cs += tc; ts *= -x2 / (double)((2 * n) * (2 * n + 1)); sn += ts; }
            double c = 1.0, s = 0.0;
            for (int p = 0; p < 128; ++p) { rope[(p * 16 + tid) * 2] = (float)c; rope[(p * 16 + tid) * 2 + 1] = (float)s; const double nc = c * cs - s * sn; s = s * cs + c * sn; c = nc; }
        }
        float* scr = (float*)(lds + 32768 + wave * 8448);
        for (int it = gw; it < 2064; it += NGW) {
            int r = it;
            if (r < 1552) { transpose_item(a.in[10], 1024, NPROJ, WIN_T, scr, r, lane); continue; } r -= 1552;
            transpose_item(a.in[15], 1024, 1024, WOUT0_T, scr, r, lane);
        }
        { u32x4* z = (u32x4*)(WIN_T + (size_t)NPROJ * D); const u32x4 zero = {0u, 0u, 0u, 0u};
          for (int i = bid * 512 + tid; i < (NPROJ_PAD - NPROJ) * D / 8; i += G * 512) z[i] = zero; }
    }
PROBE_END(1)
    xcd_barrier(xbar);


PROBE_BEGIN(2)
    { IDS
    for (int r = gw; r < R; r += 2 * NGW) {
        const int r2 = r + NGW; const bool has2 = r2 < R;
        bool isc, isc2; int b, b2; const size_t off = row_off(r, isc, b), off2 = row_off(has2 ? r2 : r, isc2, b2);
        const float* xr = (isc ? ctx : xin) + off; const float* md = mod + (isc ? 2 : b) * 6144;
        const float* xr2 = (isc2 ? ctx : xin) + off2; const float* md2 = mod + (isc2 ? 2 : b2) * 6144;
        f32x4 va[4], vb[4];
#pragma unroll
        for (int j = 0; j < 4; ++j) { va[j] = *(const f32x4*)(xr + lane * 4 + 256 * j); vb[j] = *(const f32x4*)(xr2 + lane * 4 + 256 * j); }
#pragma unroll
        for (int j = 0; j < 4; ++j) {
            const int idx = lane * 4 + 256 * j;
            { const f32x4 sh = *(const f32x4*)(md + idx), sc = *(const f32x4*)(md + 1024 + idx);
              const f32x4 h = va[j] * (sc + 1.f) + sh; u32x2 o; o.x = pk2(h.x, h.y); o.y = pk2(h.z, h.w);
              *(u32x2*)(H + (size_t)r * D + idx) = o; }
            if (has2) { const f32x4 sh = *(const f32x4*)(md2 + idx), sc = *(const f32x4*)(md2 + 1024 + idx);
              const f32x4 h = vb[j] * (sc + 1.f) + sh; u32x2 o; o.x = pk2(h.x, h.y); o.y = pk2(h.z, h.w);
              *(u32x2*)(H + (size_t)r2 * D + idx) = o; }
        }
    }
    }
PROBE_END(2)
    xcd_barrier(xbar);
    if (PROBE_SEL == 10) { for (int i = 0; i < 10; ++i) xcd_barrier(xbar); }

PROBE_BEGIN(8)
    { pg8::Gemm g{H, WIN_T, R, NPROJ_PAD, D}; pg8::StaticOrder S; S.init(R, NPROJ_PAD, G, bid); EpiStore<0> E{P, NPROJ, NPROJ};
      pg8::gemm_phase<EpiStore<0>, pg8::StaticOrder, true, true>(ldsg, g, S, E); }
PROBE_END(8)
    xcd_barrier(xbar);

PROBE_BEGIN(3)
#ifndef NO_P3
    { IDS
        float* cf = (float*)lds; float* cb = (float*)(lds + 16640); float* lrs = (float*)(lds + 33280); float* wl = (float*)(lds + 41728);
        bf16* kTf = (bf16*)(lds + 50432); bf16* kTb = (bf16*)(lds + 59648); bf16* vT = (bf16*)(lds + 68864);
        constexpr int NU = NB * 2 * 4 * NCH;
        const int s = tid & 63, dc = tid >> 6;
        u32x4 kv = {0u, 0u, 0u, 0u}, vv0 = kv, vv1 = kv; GatePre gp; gp.lr = (u32x2){0u, 0u}; gp.w = (f32x4){0.f, 0.f, 0.f, 0.f}; gp.bias = 0.f;
#define P3_LOAD(U) do { const int pc_ = (U) % NCH, t_ = (U) / NCH, h_ = t_ & 3, g_ = (t_ >> 2) & 1, b_ = t_ >> 3; const bf16* Pr_ = P + (size_t)(b_ * TP + pc_ * 64) * NPROJ; \
            const int kcol_ = g_ ? 1792 + h_ * 64 : 256 + h_ * 64, vcol_ = g_ ? 2048 + h_ * 128 : 512 + h_ * 128; \
            kv = *(const u32x4*)(Pr_ + (size_t)s * NPROJ + kcol_ + dc * 8); vv0 = *(const u32x4*)(Pr_ + (size_t)s * NPROJ + vcol_ + dc * 8); vv1 = *(const u32x4*)(Pr_ + (size_t)s * NPROJ + vcol_ + (dc + 8) * 8); \
            gp = gate_prefetch(g_, h_, Pr_, gkw, gkb, tid); } while (0)
        if (bid < NU) P3_LOAD(bid);
        for (int unit = bid; unit < NU; unit += G) {
            const int pc = unit % NCH, t = unit / NCH, h = t & 3, g = (t >> 2) & 1, b = t >> 3;
            const float kscale = g ? 1.f : 0.125f;
            fill_cum3(cf, cb, lrs, wl, g, h, gp, theta, tid);
            {
#pragma unroll
              for (int j = 0; j < 8; ++j) { const int d = dc * 8 + j; const unsigned u = kv[j >> 1]; const float kf = ((j & 1) ? bfhi(u) : bflo(u)) * kscale;
                  kTf[d * 72 + s] = (bf16)f2bf(kf * __expf(cf[63 * CS + d] - cf[s * CS + d]));
                  kTb[d * 72 + s] = (bf16)f2bf(kf * __expf(cb[d] - cb[s * CS + d])); }
#pragma unroll
              for (int j = 0; j < 8; ++j) { const unsigned u0 = vv0[j >> 1], u1 = vv1[j >> 1];
                  vT[(dc * 8 + j) * 72 + s] = (bf16)((j & 1) ? (u0 >> 16) : (u0 & 0xffffu)); vT[((dc + 8) * 8 + j) * 72 + s] = (bf16)((j & 1) ? (u1 >> 16) : (u1 & 0xffffu)); }
            }
            const int seq0 = ((b * 2 + g) * 4 + h) * 2;
            const int nf = pc, nbk = (pc < 4) ? 3 - pc : 135 - pc;
            if (tid < 128) { const int dir = tid >> 6, d = tid & 63;
                DEC[((size_t)(seq0 + dir) * NCH + (dir ? nbk : nf)) * 64 + d] = dir ? expf(cb[d]) : expf(cf[63 * CS + d]); }
            if (unit + G < NU) P3_LOAD(unit + G);
            __syncthreads();
            bf16x8 bfr[2];
#pragma unroll
            for (int ks = 0; ks < 2; ++ks) bfr[ks] = *(const bf16x8*)(vT + (wave * 16 + l15) * 72 + ks * 32 + quad * 8);
#pragma unroll
            for (int dir = 0; dir < 2; ++dir) {
                const bf16* kT = dir ? kTb : kTf;
                bf16* dst = ST + ((size_t)(seq0 + dir) * NCH + (dir ? nbk : nf)) * 8192 + (size_t)(wave * 16 + l15) * 64;
#pragma unroll
                for (int dt = 0; dt < 4; ++dt) {
                    pg8::f32x4 acc = {0.f, 0.f, 0.f, 0.f};
#pragma unroll
                    for (int ks = 0; ks < 2; ++ks) { const bf16x8 af = *(const bf16x8*)(kT + (dt * 16 + l15) * 72 + ks * 32 + quad * 8); acc = MFMA16(af, bfr[ks], acc); }
                    u32x2 o; o.x = pk2(acc[0], acc[1]); o.y = pk2(acc[2], acc[3]);
                    *(u32x2*)(dst + dt * 16 + quad * 4) = o;
                }
            }
            __syncthreads();
        }
#undef P3_LOAD
        if ((NU - bid + G - 1) / G < (NU + G - 1) / G) DRAIN_LATE((float*)(lds + wave * 8448), 1);
    }
#endif
PROBE_END(3)
    xcd_barrier(xbar);

PROBE_BEGIN(4)
    { IDS
    for (int i = bid * 512 + tid; i < 32 * 4096; i += G * 512) {
        const int seq = i >> 12, pi = i & 4095, d = (2 * pi) & 63;
        unsigned* sp = (unsigned*)(ST + (size_t)seq * NCH * 8192) + pi; const float* dp = DEC + (size_t)seq * NCH * 64 + d;
        float s0 = 0.f, s1 = 0.f;
#pragma unroll 4
        for (int n = 0; n < NCH; ++n) {
            const unsigned kv = sp[(size_t)n * 4096]; const float d0 = dp[n * 64], d1 = dp[n * 64 + 1];
            sp[(size_t)n * 4096] = pk2(s0, s1);
            s0 = d0 * s0 + bflo(kv); s1 = d1 * s1 + bfhi(kv);
        }
    }
    }
PROBE_END(4)
    xcd_barrier(xbar);

PROBE_BEGIN(5)
#ifndef NO_P5
    { IDS
        float* cf = (float*)lds; float* cb = (float*)(lds + 16640); float* lrs = (float*)(lds + 33280); float* wl = (float*)(lds + 41728);
        bf16* qdf = (bf16*)(lds + 50432); bf16* kif = (bf16*)(lds + 59648); bf16* qdb = (bf16*)(lds + 68864); bf16* kib = (bf16*)(lds + 78080);
        bf16* vT = (bf16*)(lds + 87296); bf16* Am = (bf16*)(lds + 105728); float* red = (float*)(lds + 114944);
        constexpr int NU = NB * 2 * 4 * NCH;
        const int dcq = tid & 7, sq = tid >> 3, sv = tid & 63, dcv = tid >> 6;
        u32x4 qv = {0u, 0u, 0u, 0u}, kv = qv, vv0 = qv, vv1 = qv; GatePre gp; gp.lr = (u32x2){0u, 0u}; gp.w = (f32x4){0.f, 0.f, 0.f, 0.f}; gp.bias = 0.f;
#define P5_LOAD(U) do { const int pc_ = (U) % NCH, t_ = (U) / NCH, h_ = t_ & 3, g_ = (t_ >> 2) & 1, b_ = t_ >> 3; const bf16* Pr_ = P + (size_t)(b_ * TP + pc_ * 64) * NPROJ; \
            const int qcol_ = g_ ? 1536 + h_ * 64 : h_ * 64, kcol_ = g_ ? 1792 + h_ * 64 : 256 + h_ * 64, vcol_ = g_ ? 2048 + h_ * 128 : 512 + h_ * 128; \
            qv = *(const u32x4*)(Pr_ + (size_t)sq * NPROJ + qcol_ + dcq * 8); kv = *(const u32x4*)(Pr_ + (size_t)sq * NPROJ + kcol_ + dcq * 8); \
            vv0 = *(const u32x4*)(Pr_ + (size_t)sv * NPROJ + vcol_ + dcv * 8); vv1 = *(const u32x4*)(Pr_ + (size_t)sv * NPROJ + vcol_ + (dcv + 8) * 8); \
            gp = gate_prefetch(g_, h_, Pr_, gkw, gkb, tid); } while (0)
        if (bid < NU) P5_LOAD(bid);
        for (int unit = bid; unit < NU; unit += G) {
            const int pc = unit % NCH, t = unit / NCH, h = t & 3, g = (t >> 2) & 1, b = t >> 3;
            const int r0 = b * TP + pc * 64;
            const int gcol = g ? 2560 + h * 128 : 1024 + h * 128;
            const float qscale = g ? 0.125f : 1.f, kscale = g ? 1.f : 0.125f;
            fill_cum3(cf, cb, lrs, wl, g, h, gp, theta, tid);
            { u32x4 o1, o2, o3, o4;
#pragma unroll
              for (int j2 = 0; j2 < 4; ++j2) {
                  const int d = dcq * 8 + 2 * j2;
                  const float f0 = cf[sq * CS + d], f1 = cf[sq * CS + d + 1], b0 = cb[sq * CS + d], b1 = cb[sq * CS + d + 1];
                  const float q0 = bflo(qv[j2]) * qscale, q1 = bfhi(qv[j2]) * qscale, k0 = bflo(kv[j2]) * kscale, k1 = bfhi(kv[j2]) * kscale;
                  o1[j2] = pk2(q0 * __expf(f0), q1 * __expf(f1)); o2[j2] = pk2(k0 * __expf(-f0), k1 * __expf(-f1));
                  o3[j2] = pk2(q0 * __expf(b0), q1 * __expf(b1)); o4[j2] = pk2(k0 * __expf(-b0), k1 * __expf(-b1));
              }
              *(u32x4*)(qdf + sq * 72 + dcq * 8) = o1; *(u32x4*)(kif + sq * 72 + dcq * 8) = o2; *(u32x4*)(qdb + sq * 72 + dcq * 8) = o3; *(u32x4*)(kib + sq * 72 + dcq * 8) = o4;
#pragma unroll
              for (int j = 0; j < 8; ++j) { const unsigned u0 = vv0[j >> 1], u1 = vv1[j >> 1];
                  vT[(dcv * 8 + j) * 72 + sv] = (bf16)((j & 1) ? (u0 >> 16) : (u0 & 0xffffu)); vT[((dcv + 8) * 8 + j) * 72 + sv] = (bf16)((j & 1) ? (u1 >> 16) : (u1 & 0xffffu)); }
            }
            __syncthreads();
            const int ct = wave & 3, eh = wave >> 2;
            const int seq0 = ((b * 2 + g) * 4 + h) * 2;
            const int nf = pc, nbk = (pc < 4) ? 3 - pc : 135 - pc;
            const bf16* Sf = ST + ((size_t)seq0 * NCH + nf) * 8192; const bf16* Sb = ST + ((size_t)(seq0 + 1) * NCH + nbk) * 8192;
            const int r = r0 + ct * 16 + l15;
            bf16x8 a2[4][2], a3[4][2]; u32x2 gv[4];
#pragma unroll
            for (int et = 0; et < 4; ++et) { const int e = (eh * 4 + et) * 16 + l15;
#pragma unroll
                for (int ks = 0; ks < 2; ++ks) { a2[et][ks] = *(const bf16x8*)(Sf + e * 64 + ks * 32 + quad * 8); a3[et][ks] = *(const bf16x8*)(Sb + e * 64 + ks * 32 + quad * 8); }
                gv[et] = *(const u32x2*)(P + (size_t)r * NPROJ + gcol + (eh * 4 + et) * 16 + quad * 4); }
            { bf16x8 af[2], ab[2];
#pragma unroll
              for (int ks = 0; ks < 2; ++ks) { af[ks] = *(const bf16x8*)(qdf + (ct * 16 + l15) * 72 + ks * 32 + quad * 8); ab[ks] = *(const bf16x8*)(qdb + (ct * 16 + l15) * 72 + ks * 32 + quad * 8); }
#pragma unroll
              for (int i = 0; i < 2; ++i) { const int st = (wave >> 2) * 2 + i;
                  pg8::f32x4 accf = {0.f, 0.f, 0.f, 0.f}, accb = {0.f, 0.f, 0.f, 0.f};
#pragma unroll
                  for (int ks = 0; ks < 2; ++ks) {
                      const bf16x8 bf_ = *(const bf16x8*)(kif + (st * 16 + l15) * 72 + ks * 32 + quad * 8), bb_ = *(const bf16x8*)(kib + (st * 16 + l15) * 72 + ks * 32 + quad * 8);
                      accf = MFMA16(af[ks], bf_, accf); accb = MFMA16(ab[ks], bb_, accb); }
                  const int scol = st * 16 + l15;
#pragma unroll
                  for (int rg = 0; rg < 4; ++rg) { const int c = ct * 16 + quad * 4 + rg; Am[c * 72 + scol] = (bf16)f2bf(scol <= c ? accf[rg] : accb[rg]); }
              }
            }
            if (unit + G < NU) P5_LOAD(unit + G);
            __syncthreads();
            { bf16x8 bA[2], bQf[2], bQb[2];
#pragma unroll
              for (int ks = 0; ks < 2; ++ks) { const int o = (ct * 16 + l15) * 72 + ks * 32 + quad * 8; bA[ks] = *(const bf16x8*)(Am + o); bQf[ks] = *(const bf16x8*)(qdf + o); bQb[ks] = *(const bf16x8*)(qdb + o); }
              pg8::f32x4 acc[4]; float ss = 0.f;
#pragma unroll
              for (int et = 0; et < 4; ++et) { const int e = (eh * 4 + et) * 16 + l15;
                  pg8::f32x4 c4 = {0.f, 0.f, 0.f, 0.f};
#pragma unroll
                  for (int ks = 0; ks < 2; ++ks) {
                      const bf16x8 a1 = *(const bf16x8*)(vT + e * 72 + ks * 32 + quad * 8);
                      c4 = MFMA16(a1, bA[ks], c4); c4 = MFMA16(a2[et][ks], bQf[ks], c4); c4 = MFMA16(a3[et][ks], bQb[ks], c4); }
                  acc[et] = c4; ss += (c4[0] * c4[0] + c4[1] * c4[1]) + (c4[2] * c4[2] + c4[3] * c4[3]); }
              ss = quad_sum(ss);
              if (quad == 0) red[eh * 64 + ct * 16 + l15] = ss;
              __syncthreads();
              const float tot = red[ct * 16 + l15] + red[64 + ct * 16 + l15];
              const float rinv = 1.f / sqrtf(tot * (1.f / 128.f) + 1e-6f);
#pragma unroll
              for (int et = 0; et < 4; ++et) { const int e0 = (eh * 4 + et) * 16 + quad * 4;
                  float gt[4] = {bflo(gv[et].x), bfhi(gv[et].x), bflo(gv[et].y), bfhi(gv[et].y)}; float y[4];
#pragma unroll
                  for (int i = 0; i < 4; ++i) { const float ng = g ? normg[e0 + i] : 1.f; const float sg = gt[i] * __builtin_amdgcn_rcpf(1.f + __expf(-gt[i])); y[i] = sg * acc[et][i] * rinv * ng; }
                  u32x2 o; o.x = pk2(y[0], y[1]); o.y = pk2(y[2], y[3]);
                  *(u32x2*)(H + (size_t)r * D + g * 512 + h * 128 + e0) = o; }
            }
            __syncthreads();
        }
#undef P5_LOAD
        if ((NU - bid + G - 1) / G < (NU + G - 1) / G) DRAIN_LATE((float*)(lds + wave * 8448), 2);
    }
#endif
PROBE_END(5)
    xcd_barrier(xbar);

PROBE_BEGIN(12)
    { pg8::Gemm g{H, WOUT0_T, R, D, D}; LatOrder S; S.init(D, G, bid); EpiResid<0, false> E{xin, ctx, VLAT, VCTX, nullptr, mod + 2 * 1024, nullptr, nullptr, nullptr};
      pg8::gemm_phase<EpiResid<0, false>, LatOrder, true, true>(ldsg, g, S, E); }
    { IDS
      ctx_resid_tiles<false>(H, WOUT0_T, D, ctx, VCTX, mod + 2 * 6144 + 2 * 1024, nullptr, nullptr, nullptr, (float*)lds, bid, G, tid, wave, l15, quad); }
PROBE_END(12)
    xcd_barrier(xbar);
PROBE_BEGIN(7)
    { IDS
    DRAIN_LATE((float*)(lds + wave * 8448), 1 << 30);
    ln_phase<false, false>(RST(0), VLAT, VCTX, nullptr, nullptr, ln_g, ln_b, mod + 3 * 1024, H, gw, NGW, lane);
    }
PROBE_END(7)
    xcd_barrier(xbar);
PROBE_BEGIN(11)
    { pg8::Gemm g{H, W1_0_T, R, FF, D}; LatOrder S; S.init(FF, G, bid); EpiStore<1> E{P, FF, FF};
      pg8::gemm_phase<EpiStore<1>, LatOrder, true, true>(ldsg, g, S, E); }
    { IDS
      ctx_up_tiles(H, W1_0_T, P, bid, G, wave, l15, quad); }
PROBE_END(11)
    xcd_barrier(xbar);
PROBE_BEGIN(9)
    { pg8::Gemm g{P, W2_0_T, R, D, FF}; LatOrder S; S.init(D, G, bid); EpiResid<1, false> E{VLAT, VCTX, VLAT, VCTX, nullptr, mod + 5 * 1024, RST(0), ln_g, ln_b};
      pg8::gemm_phase<EpiResid<1, false>, LatOrder, true, true>(ldsg, g, S, E); }
    { IDS
      ctx_resid_tiles<true>(P, W2_0_T, FF, VCTX, VCTX, mod + 2 * 6144 + 5 * 1024, RST(0), ln_g, ln_b, (float*)lds, bid, G, tid, wave, l15, quad); }
PROBE_END(9)
    xcd_barrier(xbar);
    { IDS
    ln_phase<false, false>(RST(1), VLAT, VCTX, nullptr, nullptr, ln_g + 1024, ln_b + 1024, mod + 3 * 6144, H, gw, NGW, lane);
    }
    xcd_barrier(xbar);

PROBE_BEGIN(13)
    { pg8::Gemm g{H, WQKV_T, R, NQKV, D}; pg8::StaticOrder S; S.init(R, NQKV, G, bid); EpiStore<0> E{P, NQKV, NQKV};
      pg8::gemm_phase<EpiStore<0>, pg8::StaticOrder, true, true>(ldsg, g, S, E); }
PROBE_END(13)
    xcd_barrier(xbar);

PROBE_BEGIN(6)
#ifndef NO_P12
    { IDS
        bf16* Qs = (bf16*)lds; bf16* Ks = (bf16*)(lds + 73728); bf16* Vt = (bf16*)(lds + 82944); float* ropes = (float*)(lds + 92160);
        for (int i = tid; i < 1024; i += 512) ((f32x4*)ropes)[i] = ((const f32x4*)rope)[i];
        PACC_DECL
        for (int unit = bid; unit < NB * 4 * 64; unit += G) {
            PACC_BEGIN(40)
            const int nb = unit & 63, kvh = (unit >> 6) & 3, b = unit >> 8;
#define ATT_VALID(t) ((t) < 4 || (unsigned)(nb - 1 + (((t) - 4) >> 1)) < 64u)
#define ATT_KPOS(t) ((nb - 1 + (((t) - 4) >> 1)) * 128 + (((t) - 4) & 1) * 64)
#define ATT_KROW(t) ((t) < 4 ? b * TP + (t) * 64 : b * TP + L + ATT_KPOS(t))
            const int keyk = tid >> 2, pck = tid & 3, c1k = (pck & 1) + (pck >> 1) * 4, keyv = tid & 63, dcv = tid >> 6;
            u32x4 pk1 = {0u, 0u, 0u, 0u}, pk2_ = pk1, pvv = pk1;
#define ATT_LOAD(t) do { const int kr_ = ATT_KROW(t); \
                if (tid < 256) { const bf16* src_ = P + (size_t)(kr_ + keyk) * NQKV + 1024 + kvh * 64; pk1 = *(const u32x4*)(src_ + c1k * 8); pk2_ = *(const u32x4*)(src_ + (c1k + 2) * 8); } \
                pvv = *(const u32x4*)(P + (size_t)(kr_ + keyv) * NQKV + 1280 + kvh * 64 + dcv * 8); } while (0)
            ATT_LOAD(0);
            __syncthreads();
#pragma unroll
            for (int i = 0; i < 4; ++i) {
                const int it = tid + i * 512, pcq = it & 3, row = it >> 2, g = row >> 7, qi = row & 127, pos = nb * 128 + qi;
                const bf16* src = P + (size_t)(b * TP + L + pos) * NQKV + (kvh * 4 + g) * 64;
                const int c1 = (pcq & 1) + (pcq >> 1) * 4;
                const u32x4 u1 = *(const u32x4*)(src + c1 * 8), u2 = *(const u32x4*)(src + (c1 + 2) * 8);
                const int pv = (pcq < 2) ? (pos >> 6) : (pos & 63);
                const f32x4* tab = (const f32x4*)(ropes + (pv * 16 + (c1 & 1) * 8) * 2);
                u32x4 o1, o2;
#pragma unroll
                for (int j2 = 0; j2 < 4; ++j2) { const f32x4 cs = tab[j2];
                    const float a0 = bflo(u1[j2]), a1 = bfhi(u1[j2]), b0 = bflo(u2[j2]), b1 = bfhi(u2[j2]);
                    o1[j2] = pk2((a0 * cs.x - b0 * cs.y) * QSC, (a1 * cs.z - b1 * cs.w) * QSC); o2[j2] = pk2((a0 * cs.y + b0 * cs.x) * QSC, (a1 * cs.w + b1 * cs.z) * QSC); }
                *(u32x4*)(Qs + row * 72 + c1 * 8) = o1; *(u32x4*)(Qs + row * 72 + (c1 + 2) * 8) = o2;
            }
            const int g = wave & 3, qh = wave >> 2, qrow0 = g * 128 + qh * 64, qpos0 = nb * 128 + qh * 64;
            float mrun[4], lrun[4]; pg8::f32x4 O[4][4];
            const float sk = sink[kvh * 4 + g] * 1.4426950408889634f;
#pragma unroll
            for (int qt = 0; qt < 4; ++qt) { mrun[qt] = sk; lrun[qt] = (quad == 0) ? 1.f : 0.f;
#pragma unroll
                for (int dt = 0; dt < 4; ++dt) O[dt][qt] = (pg8::f32x4){0.f, 0.f, 0.f, 0.f}; }
            PACC_END(40)
            int ti = 0;
            while (ti < 10) {
                PACC_BEGIN(41)
                const bool local = ti >= 4;
                const int kpos0 = local ? ATT_KPOS(ti) : 0;
                const int side = local ? ((ti - 4) >> 1) - 1 : 0;
                __syncthreads();
                if (tid < 256) {
                    u32x4 o1 = pk1, o2 = pk2_;
                    if (local) {
                        const int pos = kpos0 + keyk, pv = (pck < 2) ? (pos >> 6) : (pos & 63);
                        const f32x4* tab = (const f32x4*)(ropes + (pv * 16 + (c1k & 1) * 8) * 2);
#pragma unroll
                        for (int j2 = 0; j2 < 4; ++j2) { const f32x4 cs = tab[j2];
                            const float a0 = bflo(pk1[j2]), a1 = bfhi(pk1[j2]), b0 = bflo(pk2_[j2]), b1 = bfhi(pk2_[j2]);
                            o1[j2] = pk2(a0 * cs.x - b0 * cs.y, a1 * cs.z - b1 * cs.w); o2[j2] = pk2(a0 * cs.y + b0 * cs.x, a1 * cs.w + b1 * cs.z); }
                    }
                    *(u32x4*)(Ks + keyk * 72 + c1k * 8) = o1; *(u32x4*)(Ks + keyk * 72 + (c1k + 2) * 8) = o2;
                }
#pragma unroll
                for (int j = 0; j < 8; ++j) { const unsigned u = pvv[j >> 1]; Vt[(dcv * 8 + j) * 72 + keyv] = (bf16)((j & 1) ? (u >> 16) : (u & 0xffffu)); }
                __syncthreads();
                PACC_END(41)
                PACC_BEGIN(42)
                int tn = ti + 1;
                while (tn < 10 && !ATT_VALID(tn)) ++tn;
                if (tn < 10) ATT_LOAD(tn);
                if (!((side < 0 && ((ti - 4) & 1) == 0 && qh == 1) || (side > 0 && ((ti - 4) & 1) == 1 && qh == 0))) {
                bf16x8 kfr[4][2];
#pragma unroll
                for (int kt = 0; kt < 4; ++kt)
#pragma unroll
                    for (int ks = 0; ks < 2; ++ks) kfr[kt][ks] = *(const bf16x8*)(Ks + (kt * 16 + l15) * 72 + ks * 32 + quad * 8);
#pragma unroll
                for (int qt = 0; qt < 4; ++qt) {
                    pg8::f32x4 S[4];
#pragma unroll
                    for (int kt = 0; kt < 4; ++kt) S[kt] = (pg8::f32x4){0.f, 0.f, 0.f, 0.f};
#pragma unroll
                    for (int ks = 0; ks < 2; ++ks) { const bf16x8 qf = *(const bf16x8*)(Qs + (qrow0 + qt * 16 + l15) * 72 + ks * 32 + quad * 8);
#pragma unroll
                        for (int kt = 0; kt < 4; ++kt) S[kt] = MFMA16(kfr[kt][ks], qf, S[kt]); }
                    float mx = -INFINITY;
                    if (side < 0) {
                        const int tl = quad * 4 - (qpos0 + qt * 16 + l15 - kpos0 - 128);
#pragma unroll
                        for (int kt = 0; kt < 4; ++kt)
#pragma unroll
                            for (int rg = 0; rg < 4; ++rg) { const float sv_ = (tl >= -(kt * 16 + rg)) ? S[kt][rg] : -INFINITY; S[kt][rg] = sv_; mx = fmaxf(mx, sv_); }
                    } else if (side > 0) {
                        const int th = (qpos0 + qt * 16 + l15 - kpos0 + 128) - quad * 4;
#pragma unroll
                        for (int kt = 0; kt < 4; ++kt)
#pragma unroll
                            for (int rg = 0; rg < 4; ++rg) { const float sv_ = (th >= (kt * 16 + rg)) ? S[kt][rg] : -INFINITY; S[kt][rg] = sv_; mx = fmaxf(mx, sv_); }
                    } else {
#pragma unroll
                        for (int kt = 0; kt < 4; ++kt)
#pragma unroll
                            for (int rg = 0; rg < 4; ++rg) mx = fmaxf(mx, S[kt][rg]);
                    }
                    mx = quad_max(mx);
                    const float mnew = fmaxf(mrun[qt], mx), al = __builtin_amdgcn_exp2f(mrun[qt] - mnew); mrun[qt] = mnew;
                    float ps = 0.f;
#pragma unroll
                    for (int kt = 0; kt < 4; ++kt)
#pragma unroll
                        for (int rg = 0; rg < 4; ++rg) { const float p = __builtin_amdgcn_exp2f(S[kt][rg] - mnew); S[kt][rg] = p; ps += p; }
                    lrun[qt] = lrun[qt] * al + ps;
#pragma unroll
                    for (int dt = 0; dt < 4; ++dt) O[dt][qt] = O[dt][qt] * al;
#pragma unroll
                    for (int s2 = 0; s2 < 2; ++s2) {
                        u32x4 pw; pw.x = pk2(S[2 * s2][0], S[2 * s2][1]); pw.y = pk2(S[2 * s2][2], S[2 * s2][3]);
                        pw.z = pk2(S[2 * s2 + 1][0], S[2 * s2 + 1][1]); pw.w = pk2(S[2 * s2 + 1][2], S[2 * s2 + 1][3]);
                        const bf16x8 pf = __builtin_bit_cast(bf16x8, pw);
#pragma unroll
                        for (int dt = 0; dt < 4; ++dt) {
                            const s16x4 lo = *(const s16x4*)(Vt + (dt * 16 + l15) * 72 + s2 * 32 + quad * 4), hi = *(const s16x4*)(Vt + (dt * 16 + l15) * 72 + s2 * 32 + 16 + quad * 4);
                            O[dt][qt] = MFMA16(__builtin_shufflevector(lo, hi, 0, 1, 2, 3, 4, 5, 6, 7), pf, O[dt][qt]); }
                    }
                }
                }
                ti = tn;
                PACC_END(42)
            }
            PACC_BEGIN(43)
#pragma unroll
            for (int qt = 0; qt < 4; ++qt) {
                const float lt = quad_sum(lrun[qt]);
                const float inv = 1.f / lt;
                const int r = b * TP + L + qpos0 + qt * 16 + l15;
#pragma unroll
                for (int dt = 0; dt < 4; ++dt) { u32x2 o; o.x = pk2(O[dt][qt][0] * inv, O[dt][qt][1] * inv); o.y = pk2(O[dt][qt][2] * inv, O[dt][qt][3] * inv);
                    *(u32x2*)(H + (size_t)r * D + (kvh * 4 + g) * 64 + dt * 16 + quad * 4) = o; }
            }
            PACC_END(43)
#undef ATT_VALID
#undef ATT_KPOS
#undef ATT_KROW
#undef ATT_LOAD
        }
        PACC_SLEEP()
    }
#endif
PROBE_END(6)
    xcd_barrier(xbar);

PROBE_BEGIN(14)
    { pg8::Gemm g{H, WOUT1_T, R, D, D}; LatOrder S; S.init(D, G, bid); EpiResid<1, false> E{VLAT, VCTX, VLAT, VCTX, nullptr, mod + 3 * 6144 + 2 * 1024, RST(1), ln_g + 1024, ln_b + 1024};
      pg8::gemm_phase<EpiResid<1, false>, LatOrder, true, true>(ldsg, g, S, E); }
PROBE_END(14)
    xcd_barrier(xbar);
    { IDS
    ln_phase<false, true>(RST(2), VLAT, VCTX, nullptr, nullptr, ln_g + 2048, ln_b + 2048, mod + 3 * 6144 + 3 * 1024, H, gw, NGW, lane);
    }
    xcd_barrier(xbar);
PROBE_BEGIN(15)
    { pg8::Gemm g{H, W1_1_T, R, FF, D}; LatOrder S; S.init(FF, G, bid); EpiStore<1> E{P, FF, FF};
      pg8::gemm_phase<EpiStore<1>, LatOrder, true, true>(ldsg, g, S, E); }
PROBE_END(15)
    xcd_barrier(xbar);
PROBE_BEGIN(16)
    { pg8::Gemm g{P, W2_1_T, R, D, FF}; LatOrder S; S.init(D, G, bid); EpiResid<1, true> E{VLAT, VCTX, nullptr, nullptr, H, mod + 3 * 6144 + 5 * 1024, RST(2), ln_g + 2048, ln_b + 2048};
      pg8::gemm_phase<EpiResid<1, true>, LatOrder, true, true>(ldsg, g, S, E); }
PROBE_END(16)
    xcd_barrier(xbar);
    { IDS
    ln_phase<true, true>(nullptr, nullptr, nullptr, H, a.out, ln_g + 3072, ln_b + 3072, mod, H, gw, NGW, lane);
    }
}

extern "C" void kernel_launch(void* const* d_in, const int* in_sizes, int n_in, void* d_out, int out_size, void* d_ws, size_t ws_size, hipStream_t stream) {
    static int grid = 0;
    if (grid == 0) {
        if (n_in != 19 || out_size != NB * T * D || ws_size < WS_TOTAL) { fprintf(stderr, "kernel_launch: unexpected shapes (n_in %d out %d ws %zu)\n", n_in, out_size, ws_size); grid = -1; return; }
        int dev = 0, cus = 0, per_cu = 0;
        hipGetDevice(&dev); hipDeviceGetAttribute(&cus, hipDeviceAttributeMultiprocessorCount, dev);
        if (hipFuncSetAttribute((const void*)fwd_kernel, hipFuncAttributeMaxDynamicSharedMemorySize, LDS_BYTES) != hipSuccess) { fprintf(stderr, "kernel_launch: hipFuncSetAttribute failed\n"); grid = -1; return; }
        if (hipOccupancyMaxActiveBlocksPerMultiprocessor(&per_cu, (const void*)fwd_kernel, 512, LDS_BYTES) != hipSuccess || per_cu < 1) per_cu = 1;
        (void)hipGetLastError();
        grid = cus > 0 ? cus : 256;
    }
    if (grid < 0) return;
    Args a{};
    for (int i = 0; i < 19; ++i) a.in[i] = (const float*)d_in[i];
    a.out = (float*)d_out; a.ws = (unsigned char*)d_ws;
    if (hipMemsetAsync((char*)d_ws + OFF_XBAR, 0, 16384, stream) != hipSuccess) { fprintf(stderr, "kernel_launch: hipMemsetAsync of the barrier words failed\n"); return; }
    void* args[] = {&a};
    hipError_t e = hipLaunchCooperativeKernel((const void*)fwd_kernel, dim3(grid), dim3(512), args, LDS_BYTES, stream);
    if (e != hipSuccess) fprintf(stderr, "cooperative launch failed: %s (grid %d)\n", hipGetErrorString(e), grid);
}
```

```cpp
#include <hip/hip_runtime.h>
#include <hip/hip_cooperative_groups.h>
#include <cstdio>
#include <cstdint>
namespace cg = cooperative_groups;
namespace pg8 {
#define PG8_LAS __attribute__((address_space(3)))
typedef unsigned short bf16_t;
typedef short bf16x8 __attribute__((ext_vector_type(8)));
typedef float f32x4 __attribute__((ext_vector_type(4)));
typedef unsigned u32x4 __attribute__((ext_vector_type(4)));
constexpr int BM = 256, BK = 64, HALF = 128, HTB = HALF * BK * 2  , STAGE_BYTES = 8 * HTB, NXCD = 8, WGM = 8;

__host__ __device__ __forceinline__ int lds_byte(int r, int c) { const int st = (r >> 4) * 2 + (c >> 5), rr = r & 15, cc = c & 31, ob = rr * 64 + cc * 2; return st * 1024 + (ob ^ (((ob >> 9) & 1) << 5)); }
__host__ __device__ __forceinline__ void stage_rc(int b, int& R, int& C) { const int st = b / 1024, sb = b % 1024, swz = sb ^ (((sb >> 9) & 1) << 5); R = (st >> 1) * 16 + swz / 64; C = (st & 1) * 32 + (swz % 64) / 2; }
__host__ __device__ __forceinline__ int perm32(int rho) { const int n = rho >> 4, i = rho & 15; return 8 * (i >> 2) + 4 * n + (i & 3); }

struct Unit { int pm, pn; };
struct Gemm { const bf16_t* A; const bf16_t* Bt; int M, N, K; };

struct StaticOrder {
    int nM, nN, nwg, G, c;
    __host__ __device__ void init(int M, int N, int G_, int c_) { nM = M / BM; nN = N / BM; nwg = nM * nN; G = G_; c = c_; }
    __host__ __device__ bool next(int i, Unit& u) const {
        const long L = (long)i * G + c; if (L >= nwg) return false;
        int wgid = (int)L; { const int q = nwg / NXCD, r = nwg % NXCD, xcd = wgid % NXCD, off = wgid / NXCD; wgid = (xcd < r ? xcd * (q + 1) : r * (q + 1) + (xcd - r) * q) + off; }
        const int nig = WGM * nN, gid = wgid / nig, fm = gid * WGM, gsz = (nM - fm) < WGM ? (nM - fm) : WGM;
        u.pm = fm + ((wgid % nig) % gsz); u.pn = (wgid % nig) / gsz; return true;
    }
    __device__ __forceinline__ void a_ready(const Unit&) const {}
    __device__ __forceinline__ void done(const Unit&) const {}
};

__device__ __forceinline__ unsigned cvt_pk_bf16(float lo, float hi) { unsigned r; asm volatile("v_cvt_pk_bf16_f32 %0, %1, %2" : "=v"(r) : "v"(lo), "v"(hi)); return r; }

template <class Epi, class Sched, bool ALIGN_EPI = false, bool SP2 = false>
__device__ __forceinline__ void gemm_phase(PG8_LAS unsigned char* lds, const Gemm g, const Sched& S, const Epi& E) {
    int tid = threadIdx.x; asm volatile("" : "+v"(tid));
    const int wid = __builtin_amdgcn_readfirstlane(tid >> 6), lane = tid & 63, wr = wid >> 2, wc = wid & 3, fr = lane & 15, fq = lane >> 4;
    const int K = g.K, nt = K / BK;
    unsigned voffA[2], voffB[2];
#pragma unroll
    for (int i = 0; i < 2; ++i) { int R, C; stage_rc(tid * 16 + i * 8192, R, C); const int Rb = Epi::PERM ? ((R & ~31) + perm32(R & 31)) : R;
        voffA[i] = (unsigned)(R * K + C) * 2u; voffB[i] = (unsigned)(Rb * K + C) * 2u; }
    const size_t kstep = (size_t)(BK * 2);
    const size_t hstep = (size_t)HALF * K * 2;
    const size_t tstep = 2 * hstep;
    const unsigned ldsw = (unsigned)wid * 1024u;
    const int aoff = lds_byte(wr * 64 + fr, fq * 8), boff = lds_byte(wc * 32 + fr, fq * 8);
#define PG8_SA(b, h) (((b) * 2 + (h)) * HTB)
#define PG8_SB(b, h) ((4 + (b) * 2 + (h)) * HTB)
#define PG8_STAGE(bufoff, gbase, voff) do { _Pragma("unroll") for (int _i = 0; _i < 2; ++_i) \
        __builtin_amdgcn_global_load_lds((const unsigned*)((const char*)(gbase) + (voff)[_i]), (PG8_LAS unsigned*)(lds + (bufoff) + ldsw + _i * 8192), 16, 0, 0); } while (0)
#define PG8_LDA(dst, b, h) do { _Pragma("unroll") for (int m = 0; m < 4; ++m) _Pragma("unroll") for (int k = 0; k < 2; ++k) dst[m][k] = *(const PG8_LAS bf16x8*)(lds + PG8_SA(b, h) + aoff + m * 2048 + k * 1024); } while (0)
#define PG8_LDB(dst, b, h) do { _Pragma("unroll") for (int n = 0; n < 2; ++n) _Pragma("unroll") for (int k = 0; k < 2; ++k) dst[n][k] = *(const PG8_LAS bf16x8*)(lds + PG8_SB(b, h) + boff + n * 2048 + k * 1024); } while (0)
#define PG8_MMA(ai, bj, At, Bt) do { __builtin_amdgcn_s_setprio(1); _Pragma("unroll") for (int m = 0; m < 4; ++m) _Pragma("unroll") for (int n = 0; n < 2; ++n) _Pragma("unroll") for (int k = 0; k < 2; ++k) \
        acc[ai][bj][m][n] = __builtin_amdgcn_mfma_f32_16x16x32_bf16(Bt[n][k], At[m][k], acc[ai][bj][m][n], 0, 0, 0); __builtin_amdgcn_s_setprio(0); } while (0)
#define PG8_WAIT_V(n) asm volatile("s_waitcnt vmcnt(" #n ")" ::: "memory")
#define PG8_WAIT_L(n) asm volatile("s_waitcnt lgkmcnt(" #n ")" ::: "memory")
#define PG8_BAR __builtin_amdgcn_s_barrier()
#define PG8_SCHED __builtin_amdgcn_sched_barrier(0)
    Unit cur, nxt; int ui = 0;
    if (!S.next(0, cur)) return;
    f32x4 acc[2][2][4][2];
#pragma unroll
    for (int a = 0; a < 2; ++a)
#pragma unroll
        for (int b = 0; b < 2; ++b)
#pragma unroll
            for (int m = 0; m < 4; ++m)
#pragma unroll
                for (int n = 0; n < 2; ++n) acc[a][b][m][n] = (f32x4){0.f, 0.f, 0.f, 0.f};
    bf16x8 At[4][2], B0[2][2], B1[2][2];
    const char* cA = (const char*)g.A + (size_t)cur.pm * tstep; const char* cB = (const char*)g.Bt + (size_t)cur.pn * tstep;
    S.a_ready(cur);
    if constexpr (SP2) {
        PG8_STAGE(PG8_SB(0, 0), cB, voffB); PG8_STAGE(PG8_SB(0, 1), cB + hstep, voffB); PG8_STAGE(PG8_SA(0, 0), cA, voffA); PG8_STAGE(PG8_SA(0, 1), cA + hstep, voffA);
        if (wr == 1) PG8_BAR;
        PG8_WAIT_V(2); PG8_BAR;
        PG8_STAGE(PG8_SB(1, 0), cB + kstep, voffB); PG8_STAGE(PG8_SA(1, 0), cA + kstep, voffA); PG8_STAGE(PG8_SB(1, 1), cB + hstep + kstep, voffB);
        PG8_WAIT_V(6); PG8_BAR;
    } else {
        PG8_STAGE(PG8_SB(0, 0), cB, voffB); PG8_STAGE(PG8_SA(0, 0), cA, voffA); PG8_STAGE(PG8_SB(0, 1), cB + hstep, voffB); PG8_STAGE(PG8_SA(0, 1), cA + hstep, voffA);
        if (wr == 1) PG8_BAR;
        PG8_WAIT_V(4); PG8_BAR;
        PG8_STAGE(PG8_SB(1, 0), cB + kstep, voffB); PG8_STAGE(PG8_SA(1, 0), cA + kstep, voffA); PG8_STAGE(PG8_SB(1, 1), cB + hstep + kstep, voffB);
        PG8_WAIT_V(6); PG8_BAR;
    }
    for (;;) {
        const bool has_next = S.next(ui + 1, nxt);
        const char* nA = has_next ? (const char*)g.A + (size_t)nxt.pm * tstep : cA; const char* nB = has_next ? (const char*)g.Bt + (size_t)nxt.pn * tstep : cB;
        for (int t = 0; t < nt; t += 2) {
            const bool last = (t == nt - 2);
            const char* a1 = cA + (size_t)(t + 1) * kstep;
            const char* a2 = last ? nA : cA + (size_t)(t + 2) * kstep; const char* b2 = last ? nB : cB + (size_t)(t + 2) * kstep;
            const char* a3 = a2 + kstep; const char* b3 = b2 + kstep;
            if (last && has_next) S.a_ready(nxt);
            if constexpr (SP2) {
            PG8_LDB(B0, 0, 0); PG8_LDB(B1, 0, 1); PG8_SCHED; PG8_LDA(At, 0, 0); PG8_STAGE(PG8_SA(1, 1), a1 + hstep, voffA);
            PG8_WAIT_V(8); PG8_WAIT_L(0); PG8_BAR; PG8_MMA(0, 0, At, B0); PG8_MMA(0, 1, At, B1); PG8_BAR; PG8_SCHED;
            PG8_LDA(At, 0, 1); PG8_STAGE(PG8_SB(0, 0), b2, voffB); PG8_STAGE(PG8_SB(0, 1), b2 + hstep, voffB); PG8_STAGE(PG8_SA(0, 0), a2, voffA);
            PG8_WAIT_V(8); PG8_WAIT_L(0); PG8_BAR; PG8_MMA(1, 0, At, B0); PG8_MMA(1, 1, At, B1); PG8_BAR; PG8_SCHED;
            PG8_LDB(B0, 1, 0); PG8_LDB(B1, 1, 1); PG8_SCHED; PG8_LDA(At, 1, 0); PG8_STAGE(PG8_SA(0, 1), a2 + hstep, voffA);
            PG8_WAIT_V(8); PG8_WAIT_L(0); PG8_BAR; PG8_MMA(0, 0, At, B0); PG8_MMA(0, 1, At, B1); PG8_BAR; PG8_SCHED;
            PG8_LDA(At, 1, 1); PG8_STAGE(PG8_SB(1, 0), b3, voffB); PG8_STAGE(PG8_SB(1, 1), b3 + hstep, voffB); PG8_STAGE(PG8_SA(1, 0), a3, voffA);
            PG8_WAIT_V(8); PG8_WAIT_L(0); PG8_BAR; PG8_MMA(1, 0, At, B0); PG8_MMA(1, 1, At, B1); PG8_BAR; PG8_SCHED;
            } else {
            PG8_LDB(B0, 0, 0); PG8_SCHED; PG8_LDA(At, 0, 0); PG8_STAGE(PG8_SA(1, 1), a1 + hstep, voffA);
            PG8_WAIT_L(8); PG8_BAR; PG8_WAIT_L(0); PG8_MMA(0, 0, At, B0); PG8_BAR; PG8_SCHED;
            PG8_LDB(B1, 0, 1); PG8_STAGE(PG8_SB(0, 0), b2, voffB);
            PG8_BAR; PG8_WAIT_L(0); PG8_MMA(0, 1, At, B1); PG8_BAR;
            PG8_LDA(At, 0, 1); PG8_STAGE(PG8_SA(0, 0), a2, voffA);
            PG8_BAR; PG8_WAIT_L(0); PG8_MMA(1, 0, At, B0); PG8_BAR; PG8_SCHED;
            PG8_STAGE(PG8_SB(0, 1), b2 + hstep, voffB);
            PG8_WAIT_V(6); PG8_BAR; PG8_MMA(1, 1, At, B1); PG8_BAR;
            PG8_LDB(B0, 1, 0); PG8_SCHED; PG8_LDA(At, 1, 0); PG8_STAGE(PG8_SA(0, 1), a2 + hstep, voffA);
            PG8_WAIT_L(8); PG8_BAR; PG8_WAIT_L(0); PG8_MMA(0, 0, At, B0); PG8_BAR; PG8_SCHED;
            PG8_LDB(B1, 1, 1); PG8_STAGE(PG8_SB(1, 0), b3, voffB);
            PG8_BAR; PG8_WAIT_L(0); PG8_MMA(0, 1, At, B1); PG8_BAR;
            PG8_LDA(At, 1, 1); PG8_STAGE(PG8_SA(1, 0), a3, voffA);
            PG8_BAR; PG8_WAIT_L(0); PG8_MMA(1, 0, At, B0); PG8_BAR; PG8_SCHED;
            PG8_STAGE(PG8_SB(1, 1), b3 + hstep, voffB);
            PG8_WAIT_V(6); PG8_BAR; PG8_MMA(1, 1, At, B1); PG8_BAR;
            }
        }
        if constexpr (ALIGN_EPI) { if (wr == 0) PG8_BAR; }
        if constexpr (!Epi::AFTER_DRAIN) { E(acc, cur, wr, wc, fr, fq); S.done(cur); }
        if (!has_next) break;
#pragma unroll
        for (int a = 0; a < 2; ++a)
#pragma unroll
            for (int b = 0; b < 2; ++b)
#pragma unroll
                for (int m = 0; m < 4; ++m)
#pragma unroll
                    for (int n = 0; n < 2; ++n) acc[a][b][m][n] = (f32x4){0.f, 0.f, 0.f, 0.f};
        cur = nxt; cA = nA; cB = nB; ++ui;
        if constexpr (ALIGN_EPI) { if (wr == 1) PG8_BAR; }
    }
    PG8_WAIT_V(0);
    if constexpr (!ALIGN_EPI) { if (wr == 0) PG8_BAR; }
    PG8_BAR;
    if constexpr (Epi::AFTER_DRAIN) { E.fused(acc, cur, wr, wc, fr, fq, lds, wid, lane); S.done(cur); }
#undef PG8_SA
#undef PG8_SB
#undef PG8_STAGE
#undef PG8_LDA
#undef PG8_LDB
#undef PG8_MMA
#undef PG8_WAIT_V
#undef PG8_WAIT_L
#undef PG8_BAR
#undef PG8_SCHED
}
}

constexpr int NB = 2, T = 8192, L = 256, D = 1024, TP = T + L, R = NB * TP;
constexpr int FF = 4096, NPROJ = 3104, NPROJ_PAD = 3328, NQKV = 1536, NCH = TP / 64;
constexpr float ALPHA = 1.4142135623730951f;
constexpr int LDS_BYTES = 147456;

typedef unsigned short bf16;
typedef float f32x4 __attribute__((ext_vector_type(4)));
typedef short bf16x8 __attribute__((ext_vector_type(8)));
typedef short s16x4 __attribute__((ext_vector_type(4)));
typedef unsigned u32x4 __attribute__((ext_vector_type(4)));
typedef unsigned u32x2 __attribute__((ext_vector_type(2)));

constexpr size_t OFF_WIN = 0;
constexpr size_t OFF_WOUT0 = OFF_WIN + (size_t)NPROJ_PAD * D * 2;
constexpr size_t OFF_W1_0 = OFF_WOUT0 + (size_t)D * D * 2;
constexpr size_t OFF_W2_0 = OFF_W1_0 + (size_t)FF * D * 2;
constexpr size_t OFF_WQKV = OFF_W2_0 + (size_t)FF * D * 2;
constexpr size_t OFF_WOUT1 = OFF_WQKV + (size_t)NQKV * D * 2;
constexpr size_t OFF_W1_1 = OFF_WOUT1 + (size_t)D * D * 2;
constexpr size_t OFF_W2_1 = OFF_W1_1 + (size_t)FF * D * 2;
constexpr size_t OFF_MOD = OFF_W2_1 + (size_t)FF * D * 2;
constexpr size_t OFF_ROPE = OFF_MOD + 2 * 3 * 6144 * 4;
constexpr size_t OFF_BAR = OFF_ROPE + 128 * 16 * 8;
constexpr size_t OFF_XBAR = OFF_BAR + 256;
constexpr size_t OFF_RST = OFF_XBAR + 16384;
constexpr size_t OFF_XCTX = OFF_RST + (size_t)3 * R * 2 * 4;
constexpr size_t OFF_DEC = OFF_XCTX + (size_t)NB * L * D * 4;
constexpr size_t OFF_H = OFF_DEC + (size_t)32 * NCH * 64 * 4;
constexpr size_t OFF_P = OFF_H + (size_t)R * D * 2;
constexpr size_t OFF_ST = OFF_P + (size_t)R * NPROJ * 2;
constexpr size_t WS_TOTAL = OFF_ST + (size_t)32 * NCH * 8192 * 2;
static_assert(WS_TOTAL <= 268435456, "workspace map exceeds 256 MiB");
static_assert(OFF_P + (size_t)R * FF * 2 <= WS_TOTAL, "MLP hidden overlay");

typedef float f32x2_t __attribute__((ext_vector_type(2)));
typedef __bf16 bf16x2_t __attribute__((ext_vector_type(2)));
__device__ __forceinline__ unsigned pk2(float lo, float hi) { const f32x2_t v = {lo, hi}; const bf16x2_t b = __builtin_convertvector(v, bf16x2_t); return __builtin_bit_cast(unsigned, b); }
__device__ __forceinline__ unsigned f2bf(float f) { return pk2(f, f) & 0xffffu; }
__device__ __forceinline__ float bf2f(unsigned h) { return __uint_as_float(h << 16); }
__device__ __forceinline__ float bflo(unsigned u) { return __uint_as_float(u << 16); }
__device__ __forceinline__ float bfhi(unsigned u) { return __uint_as_float(u & 0xffff0000u); }
__device__ __forceinline__ float wave_sum(float v) {
#pragma unroll
    for (int o = 1; o < 64; o <<= 1) v += __shfl_xor(v, o);
    return v;
}
__device__ __forceinline__ float quad_max(float x) {
    const unsigned u = __float_as_uint(x);
    const auto r = __builtin_amdgcn_permlane32_swap(u, u, false, false);
    const float m = fmaxf(__uint_as_float(r[0]), __uint_as_float(r[1]));
    const unsigned v = __float_as_uint(m);
    const auto q = __builtin_amdgcn_permlane16_swap(v, v, false, false);
    return fmaxf(__uint_as_float(q[0]), __uint_as_float(q[1]));
}
__device__ __forceinline__ float quad_sum(float x) {
    const unsigned u = __float_as_uint(x);
    const auto r = __builtin_amdgcn_permlane32_swap(u, u, false, false);
    const float m = __uint_as_float(r[0]) + __uint_as_float(r[1]);
    const unsigned v = __float_as_uint(m);
    const auto q = __builtin_amdgcn_permlane16_swap(v, v, false, false);
    return __uint_as_float(q[0]) + __uint_as_float(q[1]);
}
#define MFMA16(a, b, c) __builtin_amdgcn_mfma_f32_16x16x32_bf16((a), (b), (c), 0, 0, 0)

__device__ __forceinline__ size_t row_off(int r, bool& isc, int& b) { b = (r >= TP) ? 1 : 0; const int p = r - b * TP; isc = p < L; return isc ? (size_t)(b * L + p) * D : (size_t)(b * T + p - L) * D; }

template <int ACT> struct EpiStore {
    static constexpr bool PERM = true, AFTER_DRAIN = false;
    bf16* O; int ldc; int ncols;
    __device__ __forceinline__ void operator()(const pg8::f32x4 (&acc)[2][2][4][2], const pg8::Unit& u, int wr, int wc, int fr, int fq) const {
        const int row0 = u.pm * 256 + wr * 64 + fr, col0 = u.pn * 256 + wc * 32 + 8 * fq;
#pragma unroll
        for (int ai = 0; ai < 2; ++ai)
#pragma unroll
            for (int m = 0; m < 4; ++m) {
                bf16* rowp = O + (size_t)(row0 + ai * 128 + m * 16) * ldc;
#pragma unroll
                for (int bj = 0; bj < 2; ++bj) {
                    const int col = col0 + bj * 128;
                    pg8::f32x4 v0 = acc[ai][bj][m][0], v1 = acc[ai][bj][m][1];
                    if (ACT == 1) {
#pragma unroll
                        for (int i = 0; i < 4; ++i) { float a = fmaxf(v0[i], 0.f), b = fmaxf(v1[i], 0.f); v0[i] = a * a; v1[i] = b * b; }
                    }
                    u32x4 w; w.x = pg8::cvt_pk_bf16(v0[0], v0[1]); w.y = pg8::cvt_pk_bf16(v0[2], v0[3]); w.z = pg8::cvt_pk_bf16(v1[0], v1[1]); w.w = pg8::cvt_pk_bf16(v1[2], v1[3]);
                    if (col < ncols) *(u32x4*)(rowp + col) = w;
                }
            }
    }
};
template <int SRC, bool DST_FIN> struct EpiResid {
    static constexpr bool PERM = true, AFTER_DRAIN = false;
    const void* src_lat; const void* src_ctx; bf16* dst_lat; bf16* dst_ctx; bf16* dst_fin; const float* gate;
    const float* rst; const float* lg; const float* lb;
    __device__ __forceinline__ void operator()(const pg8::f32x4 (&acc)[2][2][4][2], const pg8::Unit& u, int wr, int wc, int fr, int fq) const {
        const int row0 = u.pm * 256 + wr * 64 + fr, col0 = u.pn * 256 + wc * 32 + 8 * fq;
#pragma unroll
        for (int ai = 0; ai < 2; ++ai)
#pragma unroll
            for (int m = 0; m < 4; ++m) {
                const int row = row0 + ai * 128 + m * 16;
                bool isc; int b; const size_t off = row_off(row, isc, b);
                const float* gt = gate + (isc ? 2 : b) * 6144;
                float mean = 0.f, rstd = 1.f; if (SRC == 1) { mean = rst[2 * row]; rstd = rst[2 * row + 1]; }
#pragma unroll
                for (int bj = 0; bj < 2; ++bj) {
                    const int col = col0 + bj * 128;
                    f32x4 x0, x1;
                    if (SRC == 0) { const float* sp = (const float*)(isc ? src_ctx : src_lat) + off + col; x0 = *(const f32x4*)sp; x1 = *(const f32x4*)(sp + 4); }
                    else { const u32x4 w = *(const u32x4*)((const bf16*)(isc ? src_ctx : src_lat) + off + col);
                        x0 = (f32x4){bflo(w.x), bfhi(w.x), bflo(w.y), bfhi(w.y)}; x1 = (f32x4){bflo(w.z), bfhi(w.z), bflo(w.w), bfhi(w.w)};
                        x0 = (x0 - mean) * rstd * *(const f32x4*)(lg + col) + *(const f32x4*)(lb + col); x1 = (x1 - mean) * rstd * *(const f32x4*)(lg + col + 4) + *(const f32x4*)(lb + col + 4); }
                    const f32x4 g0 = *(const f32x4*)(gt + col), g1 = *(const f32x4*)(gt + col + 4);
                    const pg8::f32x4 a0 = acc[ai][bj][m][0], a1 = acc[ai][bj][m][1];
                    u32x4 o; o.x = pk2(ALPHA * x0.x + g0.x * a0[0], ALPHA * x0.y + g0.y * a0[1]); o.y = pk2(ALPHA * x0.z + g0.z * a0[2], ALPHA * x0.w + g0.w * a0[3]);
                    o.z = pk2(ALPHA * x1.x + g1.x * a1[0], ALPHA * x1.y + g1.y * a1[1]); o.w = pk2(ALPHA * x1.z + g1.z * a1[2], ALPHA * x1.w + g1.w * a1[3]);
                    bf16* dp = DST_FIN ? dst_fin + (size_t)row * D + col : (isc ? dst_ctx : dst_lat) + off + col;
                    *(u32x4*)dp = o;
                }
            }
    }
};

__device__ __forceinline__ void transpose_item(const float* __restrict__ W, int K, int N, bf16* WT, float* scr, int item, int lane) {
    const int nblk = N / 32, kb = item / nblk, nb = item % nblk, k0 = 64 * kb, n0 = 32 * nb;
#pragma unroll 8
    for (int i = 0; i < 32; ++i) { const int kk = 2 * i + (lane >> 5); scr[kk * 33 + (lane & 31)] = W[(size_t)(k0 + kk) * N + n0 + (lane & 31)]; }
    asm volatile("s_waitcnt lgkmcnt(0)" ::: "memory");
    const int c = lane & 7;
#pragma unroll
    for (int j = 0; j < 4; ++j) { const int n = (lane >> 3) + 8 * j; const float* s = scr + (8 * c) * 33 + n;
        u32x4 o; o.x = pk2(s[0 * 33], s[1 * 33]); o.y = pk2(s[2 * 33], s[3 * 33]); o.z = pk2(s[4 * 33], s[5 * 33]); o.w = pk2(s[6 * 33], s[7 * 33]);
        *(u32x4*)(WT + (size_t)(n0 + n) * K + k0 + 8 * c) = o; }
    asm volatile("s_waitcnt lgkmcnt(0)" ::: "memory");
}

template <bool LAST, bool SKIPCTX>
__device__ __forceinline__ void ln_phase(float* rst, const bf16* vlat, const bf16* vctx, const bf16* vfin, float* outp, const float* __restrict__ g, const float* __restrict__ bt, const float* __restrict__ modn, bf16* H, int gw, int NGW, int lane) {
    int r = gw;
    if (SKIPCTX) { while (r < R) { const int p = r >= TP ? r - TP : r; if (p >= L) break; r += NGW; } }
    u32x4 vn[2];
    if (r < R) { bool isc; int b; const size_t off = row_off(r, isc, b); const bf16* xr = LAST ? vfin + (size_t)r * D : (isc ? vctx : vlat) + off;
#pragma unroll
        for (int j = 0; j < 2; ++j) vn[j] = *(const u32x4*)(xr + lane * 8 + 512 * j); }
    while (r < R) {
        bool isc; int b; const size_t off = row_off(r, isc, b);
        float v[16];
#pragma unroll
        for (int j = 0; j < 2; ++j)
#pragma unroll
            for (int i = 0; i < 4; ++i) { v[j * 8 + 2 * i] = bflo(vn[j][i]); v[j * 8 + 2 * i + 1] = bfhi(vn[j][i]); }
        int rn = r + NGW;
        if (SKIPCTX) { while (rn < R) { const int p = rn >= TP ? rn - TP : rn; if (p >= L) break; rn += NGW; } }
        if (rn < R) { bool isc2; int b2; const size_t off2 = row_off(rn, isc2, b2); const bf16* xr2 = LAST ? vfin + (size_t)rn * D : (isc2 ? vctx : vlat) + off2;
#pragma unroll
            for (int j = 0; j < 2; ++j) vn[j] = *(const u32x4*)(xr2 + lane * 8 + 512 * j); }
        float s = 0.f;
#pragma unroll
        for (int i = 0; i < 16; ++i) s += v[i];
        const float mean = wave_sum(s) * (1.f / D); float s2 = 0.f;
#pragma unroll
        for (int i = 0; i < 16; ++i) { v[i] -= mean; s2 += v[i] * v[i]; }
        const float rstd = 1.f / sqrtf(wave_sum(s2) * (1.f / D) + 1e-5f);
        const float* md = modn + (isc ? 2 : b) * 6144;
        if (!LAST && lane == 0) { rst[2 * r] = mean; rst[2 * r + 1] = rstd; }
#pragma unroll
        for (int j = 0; j < 2; ++j) {
            const int idx = lane * 8 + 512 * j;
            float y[8];
#pragma unroll
            for (int q = 0; q < 2; ++q) { const f32x4 gg = *(const f32x4*)(g + idx + 4 * q), bb = *(const f32x4*)(bt + idx + 4 * q);
#pragma unroll
                for (int i = 0; i < 4; ++i) y[q * 4 + i] = v[j * 8 + q * 4 + i] * rstd * gg[i] + bb[i]; }
            if (LAST) { *(f32x4*)(outp + off + idx) = (f32x4){y[0], y[1], y[2], y[3]}; *(f32x4*)(outp + off + idx + 4) = (f32x4){y[4], y[5], y[6], y[7]}; }
            else {
                float h[8];
#pragma unroll
                for (int q = 0; q < 2; ++q) { const f32x4 sh = *(const f32x4*)(md + idx + 4 * q), sc = *(const f32x4*)(md + 1024 + idx + 4 * q);
#pragma unroll
                    for (int i = 0; i < 4; ++i) h[q * 4 + i] = y[q * 4 + i] * (sc[i] + 1.f) + sh[i]; }
                u32x4 o; o.x = pk2(h[0], h[1]); o.y = pk2(h[2], h[3]); o.z = pk2(h[4], h[5]); o.w = pk2(h[6], h[7]);
                *(u32x4*)(H + (size_t)r * D + idx) = o;
            }
        }
        r = rn;
    }
}

__device__ __forceinline__ float log_sigmoid(float z) { return fminf(z, 0.f) - __logf(1.f + __expf(-fabsf(z))); }

constexpr int CS = 65;
constexpr float QSC = 0.125f * 1.4426950408889634f;
struct GatePre { u32x2 lr; f32x4 w; float bias; };
__device__ __forceinline__ GatePre gate_prefetch(int g, int h, const bf16* Pr, const float* gkw, const float* gkb, int tid) {
    GatePre p; p.lr = (u32x2){0u, 0u}; p.w = (f32x4){0.f, 0.f, 0.f, 0.f}; p.bias = 0.f;
    if (g) { const int c = tid >> 3, part = tid & 7;
        p.lr = *(const u32x2*)(Pr + (size_t)c * NPROJ + 3072 + part * 4);
        const int idx = tid * 4, dir = idx >> 10, r = (idx >> 6) & 15, d = idx & 63;
        p.w = *(const f32x4*)(gkw + (dir * 16 + r) * 256 + h * 64 + d);
        if (tid < 128) p.bias = gkb[(tid >> 6) * 256 + h * 64 + (tid & 63)]; }
    return p;
}
__device__ __forceinline__ void fill_cum3(float* cf, float* cb, float* lrs, float* wl, int g, int h, const GatePre& gp, const float* theta, int tid) {
    if (g == 0) {
        const float lgf = log1pf(-expf(theta[h])), lgb = log1pf(-expf(theta[4 + h]));
        for (int i = tid; i < 4096; i += 512) { const int c = i >> 6, d = i & 63; cf[c * CS + d] = (float)(c + 1) * lgf; cb[c * CS + d] = (float)(64 - c) * lgb; }
        __syncthreads();
        return;
    }
    { const int c = tid >> 3, part = tid & 7;
      float* lp = lrs + c * 33 + part * 4; lp[0] = bflo(gp.lr.x); lp[1] = bfhi(gp.lr.x); lp[2] = bflo(gp.lr.y); lp[3] = bfhi(gp.lr.y);
      *(f32x4*)(wl + tid * 4) = gp.w;
      if (tid < 128) wl[2048 + tid] = gp.bias; }
    __syncthreads();
    { const int c = tid >> 3, dg = tid & 7;
#pragma unroll
      for (int dir = 0; dir < 2; ++dir) {
          f32x4 za = *(const f32x4*)(wl + 2048 + dir * 64 + dg * 8), zb = *(const f32x4*)(wl + 2048 + dir * 64 + dg * 8 + 4);
#pragma unroll
          for (int r = 0; r < 16; ++r) { const float lv = lrs[c * 33 + dir * 16 + r];
              za += lv * *(const f32x4*)(wl + (dir * 16 + r) * 64 + dg * 8); zb += lv * *(const f32x4*)(wl + (dir * 16 + r) * 64 + dg * 8 + 4); }
          float* dst = (dir ? cb : cf) + c * CS + dg * 8;
#pragma unroll
          for (int j = 0; j < 4; ++j) { dst[j] = log_sigmoid(za[j]) * (1.f / 16.f); dst[4 + j] = log_sigmoid(zb[j]) * (1.f / 16.f); } } }
    __syncthreads();
    if (tid < 128) {
        const int dir = tid >> 6; float* arr = (dir ? cb : cf) + (tid & 63);
        float run = 0.f;
#pragma unroll
        for (int hh = 0; hh < 2; ++hh) {
            float v[32];
            const int base = dir ? (1 - hh) * 32 : hh * 32;
#pragma unroll
            for (int c = 0; c < 32; ++c) v[c] = arr[(base + c) * CS];
            if (dir == 0) {
#pragma unroll
                for (int c = 0; c < 32; ++c) { run += v[c]; arr[(base + c) * CS] = run; }
            } else {
#pragma unroll
                for (int c = 31; c >= 0; --c) { run += v[c]; arr[(base + c) * CS] = run; }
            }
        }
    }
    __syncthreads();
}

__device__ __forceinline__ void fast_bar(unsigned* ctr, unsigned& target) {
    asm volatile("s_waitcnt vmcnt(0)" ::: "memory");
    __syncthreads();
    target += gridDim.x;
    if (threadIdx.x == 0) {
        __builtin_amdgcn_fence(__ATOMIC_RELEASE, "agent");
        asm volatile("s_waitcnt vmcnt(0)" ::: "memory");
        __hip_atomic_fetch_add(ctr, 1u, __ATOMIC_RELAXED, __HIP_MEMORY_SCOPE_AGENT);
        while (__hip_atomic_load(ctr, __ATOMIC_RELAXED, __HIP_MEMORY_SCOPE_AGENT) < target) __builtin_amdgcn_s_sleep(1);
        __builtin_amdgcn_fence(__ATOMIC_ACQUIRE, "agent");
        asm volatile("s_waitcnt vmcnt(0)" ::: "memory");
    }
    __syncthreads();
}
#define RLX_AGENT __ATOMIC_RELAXED, __HIP_MEMORY_SCOPE_AGENT
#define XB_TMO      128
#define XB_XCNT(j)  (256  + 64 * (j))
#define XB_XSUB(j)  (1280 + 64 * (j))
#define XB_XGEN(j)  (2304 + 64 * (j))
#define XB_TOP      3328
#define XB_TOPGEN   3392
#define XCD_BAR_WORDS 3456
#define XB_SPIN_CAP (1u << 18)

__device__ __forceinline__ unsigned xb_ld(unsigned* p)              { return __hip_atomic_load(p, __ATOMIC_RELAXED, __HIP_MEMORY_SCOPE_AGENT); }
__device__ __forceinline__ unsigned xb_add(unsigned* p, unsigned v) { return __hip_atomic_fetch_add(p, v, __ATOMIC_RELAXED, __HIP_MEMORY_SCOPE_AGENT); }
__device__ __forceinline__ unsigned xb_xcc_id() { return (unsigned)__builtin_amdgcn_s_getreg((3 << 11) | 20) & 0xFu; }
#define XB_SPIN(cond, bar) do { unsigned _sp = 0; while (cond) { __builtin_amdgcn_s_sleep(1); \
    if ((++_sp & 255u) == 0u) { if (xb_ld(&(bar)[XB_TMO])) break; if (_sp > XB_SPIN_CAP) { atomicAdd(&(bar)[XB_TMO], 1u); break; } } } } while (0)

struct XcdBarrier {
    unsigned* bar; unsigned x;
    volatile unsigned* st;
};

__device__ __forceinline__ XcdBarrier xcd_barrier_post(unsigned* bar, volatile unsigned* st) {
    XcdBarrier b; b.bar = bar; b.x = xb_xcc_id(); b.st = st;
    if (threadIdx.x == 0) (void)xb_add(&bar[XB_XCNT(b.x)], 1u);
    return b;
}
__device__ __forceinline__ void xcd_barrier_complete(unsigned* bar, unsigned x, unsigned& nloc, unsigned& nx) {
    const unsigned G = gridDim.x * gridDim.y * gridDim.z;
    unsigned sum, cnt, mine, sp = 0u;
    for (;;) {
        sum = 0u; cnt = 0u; mine = 0u;
#pragma unroll
        for (unsigned j = 0; j < 16; ++j) { const unsigned c = xb_ld(&bar[XB_XCNT(j)]); sum += c; cnt += (c > 0u) ? 1u : 0u; mine = (j == x) ? c : mine; }
        if (sum == G) break;
        __builtin_amdgcn_s_sleep(1);
        if ((++sp & 255u) == 0u) { if (xb_ld(&bar[XB_TMO])) break; if (sp > XB_SPIN_CAP) { atomicAdd(&bar[XB_TMO], 1u); break; } }
    }
    nloc = mine > 0u ? mine : 1u; nx = cnt > 0u ? cnt : 1u;
}

__device__ __forceinline__ void xcd_barrier(const XcdBarrier& b) {
    asm volatile("s_waitcnt vmcnt(0)" ::: "memory");
    __syncthreads();
    if (threadIdx.x == 0) {
        unsigned* bar = b.bar;
        __builtin_amdgcn_s_waitcnt(0);
        unsigned nloc = b.st[0], nx = b.st[1];
        if (nloc == 0u) { xcd_barrier_complete(bar, b.x, nloc, nx); b.st[0] = nloc; b.st[1] = nx; }
        const unsigned old = xb_add(&bar[XB_XSUB(b.x)], 1u);
        const unsigned gen = old / nloc;
        if (old + 1u == (gen + 1u) * nloc) {
            __builtin_amdgcn_fence(__ATOMIC_RELEASE, "agent");
            asm volatile("s_waitcnt vmcnt(0)" ::: "memory");
            const unsigned og = xb_add(&bar[XB_TOP], 1u);
            const unsigned tg = og / nx;
            if (og + 1u == (tg + 1u) * nx) xb_add(&bar[XB_TOPGEN], 1u);
            else XB_SPIN(xb_ld(&bar[XB_TOPGEN]) == tg, bar);
            __builtin_amdgcn_fence(__ATOMIC_ACQUIRE, "agent");
            xb_add(&bar[XB_XGEN(b.x)], 1u);
            asm volatile("s_waitcnt vmcnt(0)" ::: "memory");
        } else {
            XB_SPIN(xb_ld(&bar[XB_XGEN(b.x)]) == gen, bar);
            __builtin_amdgcn_fence(__ATOMIC_ACQUIRE, "agent");
            asm volatile("s_waitcnt vmcnt(0)" ::: "memory");
        }
    }
    __syncthreads();
}

struct LatOrder {
    pg8::StaticOrder S;
    __device__ void init(int N, int G, int c) { S.init(NB * T, N, G, c); }
    __device__ bool next(int i, pg8::Unit& u) const { if (!S.next(i, u)) return false; u.pm = u.pm + 1 + (u.pm >= 32 ? 1 : 0); return true; }
    __device__ __forceinline__ void a_ready(const pg8::Unit&) const {}
    __device__ __forceinline__ void done(const pg8::Unit&) const {}
};
#ifndef PROBE_SEL
#define PROBE_SEL 0
#endif
#ifndef PROBE_MUL
#define PROBE_MUL 3
#endif
#define PACC_DECL unsigned long long pacc = 0, pacc_t0 = 0; (void)pacc; (void)pacc_t0;
#define PACC_BEGIN(k) if (PROBE_SEL == (k)) pacc_t0 = __builtin_amdgcn_s_memrealtime();
#define PACC_END(k) if (PROBE_SEL == (k)) pacc += __builtin_amdgcn_s_memrealtime() - pacc_t0;
#define PACC_SLEEP() if (PROBE_SEL >= 40 && PROBE_SEL < 60) { const unsigned long long t1 = __builtin_amdgcn_s_memrealtime(), dt = pacc * PROBE_MUL; while (__builtin_amdgcn_s_memrealtime() - t1 < dt) __builtin_amdgcn_s_sleep(8); }
#define PROBE_BEGIN(k) unsigned long long pt0_##k = 0; if (PROBE_SEL == (k)) pt0_##k = __builtin_amdgcn_s_memrealtime();
#define PROBE_END(k) if (PROBE_SEL == (k)) { const unsigned long long t1 = __builtin_amdgcn_s_memrealtime(), dt = (t1 - pt0_##k) * PROBE_MUL; while (__builtin_amdgcn_s_memrealtime() - t1 < dt) __builtin_amdgcn_s_sleep(8); }


template <int XT, int YT>
__device__ __forceinline__ void frag_gemm(pg8::f32x4 (&acc)[XT][YT], const bf16* X, int ldx, const bf16* Y, int ldy, int k0, int k1, int l15, int quad) {
#pragma unroll 4
    for (int k = k0; k < k1; k += 32) {
        bf16x8 xf[XT], yf[YT];
#pragma unroll
        for (int i = 0; i < XT; ++i) xf[i] = *(const bf16x8*)(X + (size_t)(i * 16 + l15) * ldx + k + quad * 8);
#pragma unroll
        for (int j = 0; j < YT; ++j) yf[j] = *(const bf16x8*)(Y + (size_t)(j * 16 + l15) * ldy + k + quad * 8);
#pragma unroll
        for (int i = 0; i < XT; ++i)
#pragma unroll
            for (int j = 0; j < YT; ++j) acc[i][j] = MFMA16(xf[i], yf[j], acc[i][j]);
    }
}
template <bool SRC_LN>
__device__ __forceinline__ void ctx_resid_tiles(const bf16* A, const bf16* Bt, int K, const void* src_ctx, bf16* dst_ctx, const float* gate_ctx, const float* rst, const float* lg, const float* lb, float* part, int bid, int G, int tid, int wave, int l15, int quad) {
    for (int t = bid; t < 256; t += G) {
        const int rt = t >> 5, c0 = (t & 31) * 32, b = rt >> 2, p0 = (rt & 3) * 64, r0 = b * TP + p0;
        pg8::f32x4 acc[4][2];
#pragma unroll
        for (int i = 0; i < 4; ++i)
#pragma unroll
            for (int j = 0; j < 2; ++j) acc[i][j] = (pg8::f32x4){0.f, 0.f, 0.f, 0.f};
        const int ksl = K >> 3;
        frag_gemm<4, 2>(acc, A + (size_t)r0 * K, K, Bt + (size_t)c0 * K, K, wave * ksl, (wave + 1) * ksl, l15, quad);
        float* pw = part + wave * 2048;
#pragma unroll
        for (int i = 0; i < 4; ++i)
#pragma unroll
            for (int j = 0; j < 2; ++j)
#pragma unroll
                for (int rg = 0; rg < 4; ++rg) pw[(i * 16 + quad * 4 + rg) * 32 + j * 16 + l15] = acc[i][j][rg];
        __syncthreads();
        { const int row = tid >> 3, c4 = (tid & 7) * 4;
          f32x4 sum = *(const f32x4*)(part + row * 32 + c4);
#pragma unroll
          for (int w = 1; w < 8; ++w) sum += *(const f32x4*)(part + w * 2048 + row * 32 + c4);
          const size_t off = (size_t)(b * L + p0 + row) * D + c0 + c4;
          f32x4 x4; const f32x4 g4 = *(const f32x4*)(gate_ctx + c0 + c4);
          if (!SRC_LN) x4 = *(const f32x4*)((const float*)src_ctx + off);
          else { const int rU = r0 + row; const u32x2 w = *(const u32x2*)((const bf16*)src_ctx + off); x4 = (f32x4){bflo(w.x), bfhi(w.x), bflo(w.y), bfhi(w.y)};
              x4 = (x4 - rst[2 * rU]) * rst[2 * rU + 1] * *(const f32x4*)(lg + c0 + c4) + *(const f32x4*)(lb + c0 + c4); }
          const f32x4 vv = x4 * ALPHA + g4 * sum; u32x2 o; o.x = pk2(vv.x, vv.y); o.y = pk2(vv.z, vv.w);
          *(u32x2*)(dst_ctx + off) = o; }
        __syncthreads();
    }
}
__device__ __forceinline__ void ctx_up_tiles(const bf16* A, const bf16* Bt, bf16* O, int bid, int G, int wave, int l15, int quad) {
    for (int t = bid; t < 256; t += G) {
        const int rt = t >> 5, c0 = (t & 31) * 128 + (wave & 3) * 32, b = rt >> 2, r0 = b * TP + (rt & 3) * 64 + (wave >> 2) * 32;
        pg8::f32x4 acc[2][2];
#pragma unroll
        for (int i = 0; i < 2; ++i)
#pragma unroll
            for (int j = 0; j < 2; ++j) acc[i][j] = (pg8::f32x4){0.f, 0.f, 0.f, 0.f};
        frag_gemm<2, 2>(acc, Bt + (size_t)c0 * D, D, A + (size_t)r0 * D, D, 0, D, l15, quad);
#pragma unroll
        for (int i = 0; i < 2; ++i)
#pragma unroll
            for (int j = 0; j < 2; ++j) { float v[4];
#pragma unroll
                for (int rg = 0; rg < 4; ++rg) { const float a_ = fmaxf(acc[i][j][rg], 0.f); v[rg] = a_ * a_; }
                u32x2 o; o.x = pk2(v[0], v[1]); o.y = pk2(v[2], v[3]);
                *(u32x2*)(O + (size_t)(r0 + j * 16 + l15) * FF + c0 + i * 16 + quad * 4) = o; }
    }
}

template <int ACT>
__device__ __forceinline__ void ctx_ksplit_tiles(const bf16* A, const bf16* Bt, bf16* O, int ldo, int ntn, int ncols, float* part, int bid, int G, int tid, int wave, int l15, int quad) {
    for (int t = bid; t < 8 * ntn; t += G) {
        const int rt = t / ntn, c0 = (t % ntn) * 64, b = rt >> 2, r0 = b * TP + (rt & 3) * 64;
        pg8::f32x4 acc[4][4];
#pragma unroll
        for (int i = 0; i < 4; ++i)
#pragma unroll
            for (int j = 0; j < 4; ++j) acc[i][j] = (pg8::f32x4){0.f, 0.f, 0.f, 0.f};
        frag_gemm<4, 4>(acc, A + (size_t)r0 * D, D, Bt + (size_t)c0 * D, D, wave * 128, (wave + 1) * 128, l15, quad);
        float* pw = part + wave * 4096;
#pragma unroll
        for (int i = 0; i < 4; ++i)
#pragma unroll
            for (int j = 0; j < 4; ++j)
#pragma unroll
                for (int rg = 0; rg < 4; ++rg) pw[(i * 16 + quad * 4 + rg) * 64 + j * 16 + l15] = acc[i][j][rg];
        __syncthreads();
        { const int row = tid >> 3, c8 = (tid & 7) * 8;
          f32x4 s0 = *(const f32x4*)(part + row * 64 + c8), s1 = *(const f32x4*)(part + row * 64 + c8 + 4);
#pragma unroll
          for (int w = 1; w < 8; ++w) { s0 += *(const f32x4*)(part + w * 4096 + row * 64 + c8); s1 += *(const f32x4*)(part + w * 4096 + row * 64 + c8 + 4); }
          if (ACT == 1) {
#pragma unroll
              for (int k = 0; k < 4; ++k) { float a_ = fmaxf(s0[k], 0.f), b_ = fmaxf(s1[k], 0.f); s0[k] = a_ * a_; s1[k] = b_ * b_; } }
          u32x4 o; o.x = pk2(s0.x, s0.y); o.y = pk2(s0.z, s0.w); o.z = pk2(s1.x, s1.y); o.w = pk2(s1.z, s1.w);
          const int col = c0 + c8;
          if (col < ncols) *(u32x4*)(O + (size_t)(r0 + row) * ldo + col) = o; }
        __syncthreads();
    }
}

struct Args { const float* in[19]; float* out; unsigned char* ws; };

__global__ void __launch_bounds__(512, 2) fwd_kernel(Args a) {
    extern __shared__ __attribute__((aligned(16))) unsigned char lds[];
    cg::grid_group grid = cg::this_grid();
    const int G = gridDim.x, bid = blockIdx.x, NGW = G * 8;
#define IDS int tid = threadIdx.x; asm volatile("" : "+v"(tid)); const int lane = tid & 63, wave = __builtin_amdgcn_readfirstlane(tid >> 6), quad = lane >> 4, l15 = lane & 15, gw = bid * 8 + wave; (void)quad; (void)l15; (void)gw; (void)lane;
#define xin (a.in[0])
#define cvec (a.in[1])
#define ctx (a.in[2])
#define cctx (a.in[3])
#define w_mod (a.in[4])
#define b_mod (a.in[5])
#define ln_g (a.in[6])
#define ln_b (a.in[7])
#define theta (a.in[11])
#define gkw (a.in[12])
#define gkb (a.in[13])
#define normg (a.in[14])
#define sink (a.in[17])
#define WIN_T ((bf16*)(a.ws + OFF_WIN))
#define WOUT0_T ((bf16*)(a.ws + OFF_WOUT0))
#define W1_0_T ((bf16*)(a.ws + OFF_W1_0))
#define W2_0_T ((bf16*)(a.ws + OFF_W2_0))
#define WQKV_T ((bf16*)(a.ws + OFF_WQKV))
#define WOUT1_T ((bf16*)(a.ws + OFF_WOUT1))
#define W1_1_T ((bf16*)(a.ws + OFF_W1_1))
#define W2_1_T ((bf16*)(a.ws + OFF_W2_1))
#define mod ((float*)(a.ws + OFF_MOD))
#define rope ((float*)(a.ws + OFF_ROPE))
#define xctx ((float*)(a.ws + OFF_XCTX))
#define DEC ((float*)(a.ws + OFF_DEC))
#define H ((bf16*)(a.ws + OFF_H))
#define P ((bf16*)(a.ws + OFF_P))
#define ST ((bf16*)(a.ws + OFF_ST))
#define xlat (a.out)
#define RST(i) ((float*)(a.ws + OFF_RST) + (size_t)(i) * R * 2)
#define VLAT ((bf16*)a.out)
#define VCTX ((bf16*)(a.ws + OFF_XCTX))

#define LATE_ITEMS 9472
#define LATE_CHUNK 16
#define DRAIN_LATE(scr_, maxc_) do { int nclaim_ = 0; unsigned* qc_ = (unsigned*)(a.ws + OFF_XBAR) + 3584; volatile unsigned* qw_ = (volatile unsigned*)(lds + 131072 + 1024); \
        for (;;) { if (nclaim_++ >= (maxc_)) break; if (tid == 0) qw_[0] = __hip_atomic_fetch_add(qc_, (unsigned)LATE_CHUNK, __ATOMIC_RELAXED, __HIP_MEMORY_SCOPE_AGENT);     \
            __syncthreads(); const int base_ = (int)__builtin_amdgcn_readfirstlane(qw_[0]); __syncthreads(); \
            if (base_ >= LATE_ITEMS) break; \
            for (int k_ = wave; k_ < LATE_CHUNK; k_ += 8) { int r_ = base_ + k_; if (r_ >= LATE_ITEMS) break; \
                if (r_ < 2048) { transpose_item(a.in[8], 1024, FF, W1_0_T, (scr_), r_, lane); continue; } r_ -= 2048; \
                if (r_ < 2048) { transpose_item(a.in[9], FF, 1024, W2_0_T, (scr_), r_, lane); continue; } r_ -= 2048; \
                if (r_ < 768) { transpose_item(a.in[16], 1024, NQKV, WQKV_T, (scr_), r_, lane); continue; } r_ -= 768; \
                if (r_ < 512) { transpose_item(a.in[18], 1024, 1024, WOUT1_T, (scr_), r_, lane); continue; } r_ -= 512; \
                if (r_ < 2048) { transpose_item(a.in[8] + (size_t)1024 * FF, 1024, FF, W1_1_T, (scr_), r_, lane); continue; } r_ -= 2048; \
                transpose_item(a.in[9] + (size_t)FF * 1024, FF, 1024, W2_1_T, (scr_), r_, lane); } } } while (0)
    PG8_LAS unsigned char* ldsg = (PG8_LAS unsigned char*)lds;
    unsigned* barw = (unsigned*)(a.ws + OFF_BAR); unsigned bar_target = 0u; (void)barw; (void)bar_target;
    unsigned* xbw = (unsigned*)(a.ws + OFF_XBAR);
    volatile unsigned* xst = (volatile unsigned*)(lds + 131072 + 512);
    if (threadIdx.x == 0) { xst[0] = 0u; xst[1] = 0u; }
    XcdBarrier xbar = xcd_barrier_post(xbw, xst);
    if (a.ws == nullptr) grid.sync();

PROBE_BEGIN(1)
    { IDS
        float* sl = (float*)lds; float* red = (float*)(lds + 12288);
        for (int item = bid; item < 192; item += G) {
            for (int i = tid; i < 3072; i += 512) { const int j = i >> 10, k = i & 1023; const float v = (j < 2) ? cvec[j * 1024 + k] : cctx[k]; sl[i] = v / (1.f + expf(-v)); }
            __syncthreads();
            const int layer = item / 96, n0 = (item % 96) * 64;
            const float* W = w_mod + (size_t)layer * 1024 * 6144 + n0 + lane;
            float a0 = 0.f, a1 = 0.f, a2 = 0.f; const int k0 = wave * 128;
#pragma unroll 8
            for (int kk = 0; kk < 128; ++kk) { const int k = k0 + kk; const float w = W[(size_t)k * 6144]; a0 += sl[k] * w; a1 += sl[1024 + k] * w; a2 += sl[2048 + k] * w; }
            red[(wave * 3 + 0) * 64 + lane] = a0; red[(wave * 3 + 1) * 64 + lane] = a1; red[(wave * 3 + 2) * 64 + lane] = a2;
            __syncthreads();
            if (tid < 192) { const int j = tid >> 6, col = tid & 63; float s = b_mod[layer * 6144 + n0 + col];
#pragma unroll
                for (int w = 0; w < 8; ++w) s += red[(w * 3 + j) * 64 + col];
                mod[(layer * 3 + j) * 6144 + n0 + col] = s; }
            __syncthreads();
        }
        if (bid == G - 1 && tid < 16) {
            double f = 1.0; for (int i = 0; i < tid; ++i) f *= 0.56234132519034908;
            const double x2 = f * f; double cs = 1.0, sn = f, tc = 1.0, ts = f;
            for (int n = 1; n <= 12; ++n) { tc *= -x2 / (double)((2 * n - 1) * (2 * n)); cs += tc; ts *= -x2 / (double)((2 * n) * (2 * n + 1)); sn += ts; }
            double c = 1.0, s = 0.0;
            for (int p = 0; p < 128; ++p) { rope[(p * 16 + tid) * 2] = (float)c; rope[(p * 16 + tid) * 2 + 1] = (float)s; const double nc = c * cs - s * sn; s = s * cs + c * sn; c = nc; }
        }
        float* scr = (float*)(lds + 32768 + wave * 8448);
        for (int it = gw; it < 2064; it += NGW) {
            int r = it;
            if (r < 1552) { transpose_item(a.in[10], 1024, NPROJ, WIN_T, scr, r, lane); continue; } r -= 1552;
            transpose_item(a.in[15], 1024, 1024, WOUT0_T, scr, r, lane);
        }
        { u32x4* z = (u32x4*)(WIN_T + (size_t)NPROJ * D); const u32x4 zero = {0u, 0u, 0u, 0u};
          for (int i = bid * 512 + tid; i < (NPROJ_PAD - NPROJ) * D / 8; i += G * 512) z[i] = zero; }
    }
PROBE_END(1)
    xcd_barrier(xbar);


PROBE_BEGIN(2)
    { IDS
    for (int r = gw; r < R; r += 2 * NGW) {
        const int r2 = r + NGW; const bool has2 = r2 < R;
        bool isc, isc2; int b, b2; const size_t off = row_off(r, isc, b), off2 = row_off(has2 ? r2 : r, isc2, b2);
        const float* xr = (isc ? ctx : xin) + off; const float* md = mod + (isc ? 2 : b) * 6144;
        const float* xr2 = (isc2 ? ctx : xin) + off2; const float* md2 = mod + (isc2 ? 2 : b2) * 6144;
        f32x4 va[4], vb[4];
#pragma unroll
        for (int j = 0; j < 4; ++j) { va[j] = *(const f32x4*)(xr + lane * 4 + 256 * j); vb[j] = *(const f32x4*)(xr2 + lane * 4 + 256 * j); }
#pragma unroll
        for (int j = 0; j < 4; ++j) {
            const int idx = lane * 4 + 256 * j;
            { const f32x4 sh = *(const f32x4*)(md + idx), sc = *(const f32x4*)(md + 1024 + idx);
              const f32x4 h = va[j] * (sc + 1.f) + sh; u32x2 o; o.x = pk2(h.x, h.y); o.y = pk2(h.z, h.w);
              *(u32x2*)(H + (size_t)r * D + idx) = o; }
            if (has2) { const f32x4 sh = *(const f32x4*)(md2 + idx), sc = *(const f32x4*)(md2 + 1024 + idx);
              const f32x4 h = vb[j] * (sc + 1.f) + sh; u32x2 o; o.x = pk2(h.x, h.y); o.y = pk2(h.z, h.w);
              *(u32x2*)(H + (size_t)r2 * D + idx) = o; }
        }
    }
    }
PROBE_END(2)
    xcd_barrier(xbar);
    if (PROBE_SEL == 10) { for (int i = 0; i < 10; ++i) xcd_barrier(xbar); }

PROBE_BEGIN(8)
    { pg8::Gemm g{H, WIN_T, R, NPROJ_PAD, D}; pg8::StaticOrder S; S.init(R, NPROJ_PAD, G, bid); EpiStore<0> E{P, NPROJ, NPROJ};
      pg8::gemm_phase<EpiStore<0>, pg8::StaticOrder, true, true>(ldsg, g, S, E); }
PROBE_END(8)
    xcd_barrier(xbar);

PROBE_BEGIN(3)
#ifndef NO_P3
    { IDS
        float* cf = (float*)lds; float* cb = (float*)(lds + 16640); float* lrs = (float*)(lds + 33280); float* wl = (float*)(lds + 41728);
        bf16* kTf = (bf16*)(lds + 50432); bf16* kTb = (bf16*)(lds + 59648); bf16* vT = (bf16*)(lds + 68864);
        constexpr int NU = NB * 2 * 4 * NCH;
        const int s = tid & 63, dc = tid >> 6;
        u32x4 kv = {0u, 0u, 0u, 0u}, vv0 = kv, vv1 = kv; GatePre gp; gp.lr = (u32x2){0u, 0u}; gp.w = (f32x4){0.f, 0.f, 0.f, 0.f}; gp.bias = 0.f;
#define P3_LOAD(U) do { const int pc_ = (U) % NCH, t_ = (U) / NCH, h_ = t_ & 3, g_ = (t_ >> 2) & 1, b_ = t_ >> 3; const bf16* Pr_ = P + (size_t)(b_ * TP + pc_ * 64) * NPROJ; \
            const int kcol_ = g_ ? 1792 + h_ * 64 : 256 + h_ * 64, vcol_ = g_ ? 2048 + h_ * 128 : 512 + h_ * 128; \
            kv = *(const u32x4*)(Pr_ + (size_t)s * NPROJ + kcol_ + dc * 8); vv0 = *(const u32x4*)(Pr_ + (size_t)s * NPROJ + vcol_ + dc * 8); vv1 = *(const u32x4*)(Pr_ + (size_t)s * NPROJ + vcol_ + (dc + 8) * 8); \
            gp = gate_prefetch(g_, h_, Pr_, gkw, gkb, tid); } while (0)
        if (bid < NU) P3_LOAD(bid);
        for (int unit = bid; unit < NU; unit += G) {
            const int pc = unit % NCH, t = unit / NCH, h = t & 3, g = (t >> 2) & 1, b = t >> 3;
            const float kscale = g ? 1.f : 0.125f;
            fill_cum3(cf, cb, lrs, wl, g, h, gp, theta, tid);
            {
#pragma unroll
              for (int j = 0; j < 8; ++j) { const int d = dc * 8 + j; const unsigned u = kv[j >> 1]; const float kf = ((j & 1) ? bfhi(u) : bflo(u)) * kscale;
                  kTf[d * 72 + s] = (bf16)f2bf(kf * __expf(cf[63 * CS + d] - cf[s * CS + d]));
                  kTb[d * 72 + s] = (bf16)f2bf(kf * __expf(cb[d] - cb[s * CS + d])); }
#pragma unroll
              for (int j = 0; j < 8; ++j) { const unsigned u0 = vv0[j >> 1], u1 = vv1[j >> 1];
                  vT[(dc * 8 + j) * 72 + s] = (bf16)((j & 1) ? (u0 >> 16) : (u0 & 0xffffu)); vT[((dc + 8) * 8 + j) * 72 + s] = (bf16)((j & 1) ? (u1 >> 16) : (u1 & 0xffffu)); }
            }
            const int seq0 = ((b * 2 + g) * 4 + h) * 2;
            const int nf = pc, nbk = (pc < 4) ? 3 - pc : 135 - pc;
            if (tid < 128) { const int dir = tid >> 6, d = tid & 63;
                DEC[((size_t)(seq0 + dir) * NCH + (dir ? nbk : nf)) * 64 + d] = dir ? expf(cb[d]) : expf(cf[63 * CS + d]); }
            if (unit + G < NU) P3_LOAD(unit + G);
            __syncthreads();
            bf16x8 bfr[2];
#pragma unroll
            for (int ks = 0; ks < 2; ++ks) bfr[ks] = *(const bf16x8*)(vT + (wave * 16 + l15) * 72 + ks * 32 + quad * 8);
#pragma unroll
            for (int dir = 0; dir < 2; ++dir) {
                const bf16* kT = dir ? kTb : kTf;
                bf16* dst = ST + ((size_t)(seq0 + dir) * NCH + (dir ? nbk : nf)) * 8192 + (size_t)(wave * 16 + l15) * 64;
#pragma unroll
                for (int dt = 0; dt < 4; ++dt) {
                    pg8::f32x4 acc = {0.f, 0.f, 0.f, 0.f};
#pragma unroll
                    for (int ks = 0; ks < 2; ++ks) { const bf16x8 af = *(const bf16x8*)(kT + (dt * 16 + l15) * 72 + ks * 32 + quad * 8); acc = MFMA16(af, bfr[ks], acc); }
                    u32x2 o; o.x = pk2(acc[0], acc[1]); o.y = pk2(acc[2], acc[3]);
                    *(u32x2*)(dst + dt * 16 + quad * 4) = o;
                }
            }
            __syncthreads();
        }
#undef P3_LOAD
        if ((NU - bid + G - 1) / G < (NU + G - 1) / G) DRAIN_LATE((float*)(lds + wave * 8448), 1);
    }
#endif
PROBE_END(3)
    xcd_barrier(xbar);

PROBE_BEGIN(4)
    { IDS
    for (int i = bid * 512 + tid; i < 32 * 4096; i += G * 512) {
        const int seq = i >> 12, pi = i & 4095, d = (2 * pi) & 63;
        unsigned* sp = (unsigned*)(ST + (size_t)seq * NCH * 8192) + pi; const float* dp = DEC + (size_t)seq * NCH * 64 + d;
        float s0 = 0.f, s1 = 0.f;
#pragma unroll 4
        for (int n = 0; n < NCH; ++n) {
            const unsigned kv = sp[(size_t)n * 4096]; const float d0 = dp[n * 64], d1 = dp[n * 64 + 1];
            sp[(size_t)n * 4096] = pk2(s0, s1);
            s0 = d0 * s0 + bflo(kv); s1 = d1 * s1 + bfhi(kv);
        }
    }
    }
PROBE_END(4)
    xcd_barrier(xbar);

PROBE_BEGIN(5)
#ifndef NO_P5
    { IDS
        float* cf = (float*)lds; float* cb = (float*)(lds + 16640); float* lrs = (float*)(lds + 33280); float* wl = (float*)(lds + 41728);
        bf16* qdf = (bf16*)(lds + 50432); bf16* kif = (bf16*)(lds + 59648); bf16* qdb = (bf16*)(lds + 68864); bf16* kib = (bf16*)(lds + 78080);
        bf16* vT = (bf16*)(lds + 87296); bf16* Am = (bf16*)(lds + 105728); float* red = (float*)(lds + 114944);
        constexpr int NU = NB * 2 * 4 * NCH;
        const int dcq = tid & 7, sq = tid >> 3, sv = tid & 63, dcv = tid >> 6;
        u32x4 qv = {0u, 0u, 0u, 0u}, kv = qv, vv0 = qv, vv1 = qv; GatePre gp; gp.lr = (u32x2){0u, 0u}; gp.w = (f32x4){0.f, 0.f, 0.f, 0.f}; gp.bias = 0.f;
#define P5_LOAD(U) do { const int pc_ = (U) % NCH, t_ = (U) / NCH, h_ = t_ & 3, g_ = (t_ >> 2) & 1, b_ = t_ >> 3; const bf16* Pr_ = P + (size_t)(b_ * TP + pc_ * 64) * NPROJ; \
            const int qcol_ = g_ ? 1536 + h_ * 64 : h_ * 64, kcol_ = g_ ? 1792 + h_ * 64 : 256 + h_ * 64, vcol_ = g_ ? 2048 + h_ * 128 : 512 + h_ * 128; \
            qv = *(const u32x4*)(Pr_ + (size_t)sq * NPROJ + qcol_ + dcq * 8); kv = *(const u32x4*)(Pr_ + (size_t)sq * NPROJ + kcol_ + dcq * 8); \
            vv0 = *(const u32x4*)(Pr_ + (size_t)sv * NPROJ + vcol_ + dcv * 8); vv1 = *(const u32x4*)(Pr_ + (size_t)sv * NPROJ + vcol_ + (dcv + 8) * 8); \
            gp = gate_prefetch(g_, h_, Pr_, gkw, gkb, tid); } while (0)
        if (bid < NU) P5_LOAD(bid);
        for (int unit = bid; unit < NU; unit += G) {
            const int pc = unit % NCH, t = unit / NCH, h = t & 3, g = (t >> 2) & 1, b = t >> 3;
            const int r0 = b * TP + pc * 64;
            const int gcol = g ? 2560 + h * 128 : 1024 + h * 128;
            const float qscale = g ? 0.125f : 1.f, kscale = g ? 1.f : 0.125f;
            fill_cum3(cf, cb, lrs, wl, g, h, gp, theta, tid);
            { u32x4 o1, o2, o3, o4;
#pragma unroll
              for (int j2 = 0; j2 < 4; ++j2) {
                  const int d = dcq * 8 + 2 * j2;
                  const float f0 = cf[sq * CS + d], f1 = cf[sq * CS + d + 1], b0 = cb[sq * CS + d], b1 = cb[sq * CS + d + 1];
                  const float q0 = bflo(qv[j2]) * qscale, q1 = bfhi(qv[j2]) * qscale, k0 = bflo(kv[j2]) * kscale, k1 = bfhi(kv[j2]) * kscale;
                  o1[j2] = pk2(q0 * __expf(f0), q1 * __expf(f1)); o2[j2] = pk2(k0 * __expf(-f0), k1 * __expf(-f1));
                  o3[j2] = pk2(q0 * __expf(b0), q1 * __expf(b1)); o4[j2] = pk2(k0 * __expf(-b0), k1 * __expf(-b1));
              }
              *(u32x4*)(qdf + sq * 72 + dcq * 8) = o1; *(u32x4*)(kif + sq * 72 + dcq * 8) = o2; *(u32x4*)(qdb + sq * 72 + dcq * 8) = o3; *(u32x4*)(kib + sq * 72 + dcq * 8) = o4;
#pragma unroll
              for (int j = 0; j < 8; ++j) { const unsigned u0 = vv0[j >> 1], u1 = vv1[j >> 1];
                  vT[(dcv * 8 + j) * 72 + sv] = (bf16)((j & 1) ? (u0 >> 16) : (u0 & 0xffffu)); vT[((dcv + 8) * 8 + j) * 72 + sv] = (bf16)((j & 1) ? (u1 >> 16) : (u1 & 0xffffu)); }
            }
            __syncthreads();
            const int ct = wave & 3, eh = wave >> 2;
            const int seq0 = ((b * 2 + g) * 4 + h) * 2;
            const int nf = pc, nbk = (pc < 4) ? 3 - pc : 135 - pc;
            const bf16* Sf = ST + ((size_t)seq0 * NCH + nf) * 8192; const bf16* Sb = ST + ((size_t)(seq0 + 1) * NCH + nbk) * 8192;
            const int r = r0 + ct * 16 + l15;
            bf16x8 a2[4][2], a3[4][2]; u32x2 gv[4];
#pragma unroll
            for (int et = 0; et < 4; ++et) { const int e = (eh * 4 + et) * 16 + l15;
#pragma unroll
                for (int ks = 0; ks < 2; ++ks) { a2[et][ks] = *(const bf16x8*)(Sf + e * 64 + ks * 32 + quad * 8); a3[et][ks] = *(const bf16x8*)(Sb + e * 64 + ks * 32 + quad * 8); }
                gv[et] = *(const u32x2*)(P + (size_t)r * NPROJ + gcol + (eh * 4 + et) * 16 + quad * 4); }
            { bf16x8 af[2], ab[2];
#pragma unroll
              for (int ks = 0; ks < 2; ++ks) { af[ks] = *(const bf16x8*)(qdf + (ct * 16 + l15) * 72 + ks * 32 + quad * 8); ab[ks] = *(const bf16x8*)(qdb + (ct * 16 + l15) * 72 + ks * 32 + quad * 8); }
#pragma unroll
              for (int i = 0; i < 2; ++i) { const int st = (wave >> 2) * 2 + i;
                  pg8::f32x4 accf = {0.f, 0.f, 0.f, 0.f}, accb = {0.f, 0.f, 0.f, 0.f};
#pragma unroll
                  for (int ks = 0; ks < 2; ++ks) {
                      const bf16x8 bf_ = *(const bf16x8*)(kif + (st * 16 + l15) * 72 + ks * 32 + quad * 8), bb_ = *(const bf16x8*)(kib + (st * 16 + l15) * 72 + ks * 32 + quad * 8);
                      accf = MFMA16(af[ks], bf_, accf); accb = MFMA16(ab[ks], bb_, accb); }
                  const int scol = st * 16 + l15;
#pragma unroll
                  for (int rg = 0; rg < 4; ++rg) { const int c = ct * 16 + quad * 4 + rg; Am[c * 72 + scol] = (bf16)f2bf(scol <= c ? accf[rg] : accb[rg]); }
              }
            }
            if (unit + G < NU) P5_LOAD(unit + G);
            __syncthreads();
            { bf16x8 bA[2], bQf[2], bQb[2];
#pragma unroll
              for (int ks = 0; ks < 2; ++ks) { const int o = (ct * 16 + l15) * 72 + ks * 32 + quad * 8; bA[ks] = *(const bf16x8*)(Am + o); bQf[ks] = *(const bf16x8*)(qdf + o); bQb[ks] = *(const bf16x8*)(qdb + o); }
              pg8::f32x4 acc[4]; float ss = 0.f;
#pragma unroll
              for (int et = 0; et < 4; ++et) { const int e = (eh * 4 + et) * 16 + l15;
                  pg8::f32x4 c4 = {0.f, 0.f, 0.f, 0.f};
#pragma unroll
                  for (int ks = 0; ks < 2; ++ks) {
                      const bf16x8 a1 = *(const bf16x8*)(vT + e * 72 + ks * 32 + quad * 8);
                      c4 = MFMA16(a1, bA[ks], c4); c4 = MFMA16(a2[et][ks], bQf[ks], c4); c4 = MFMA16(a3[et][ks], bQb[ks], c4); }
                  acc[et] = c4; ss += (c4[0] * c4[0] + c4[1] * c4[1]) + (c4[2] * c4[2] + c4[3] * c4[3]); }
              ss = quad_sum(ss);
              if (quad == 0) red[eh * 64 + ct * 16 + l15] = ss;
              __syncthreads();
              const float tot = red[ct * 16 + l15] + red[64 + ct * 16 + l15];
              const float rinv = 1.f / sqrtf(tot * (1.f / 128.f) + 1e-6f);
#pragma unroll
              for (int et = 0; et < 4; ++et) { const int e0 = (eh * 4 + et) * 16 + quad * 4;
                  float gt[4] = {bflo(gv[et].x), bfhi(gv[et].x), bflo(gv[et].y), bfhi(gv[et].y)}; float y[4];
#pragma unroll
                  for (int i = 0; i < 4; ++i) { const float ng = g ? normg[e0 + i] : 1.f; const float sg = gt[i] * __builtin_amdgcn_rcpf(1.f + __expf(-gt[i])); y[i] = sg * acc[et][i] * rinv * ng; }
                  u32x2 o; o.x = pk2(y[0], y[1]); o.y = pk2(y[2], y[3]);
                  *(u32x2*)(H + (size_t)r * D + g * 512 + h * 128 + e0) = o; }
            }
            __syncthreads();
        }
#undef P5_LOAD
        if ((NU - bid + G - 1) / G < (NU + G - 1) / G) DRAIN_LATE((float*)(lds + wave * 8448), 2);
    }
#endif
PROBE_END(5)
    xcd_barrier(xbar);

PROBE_BEGIN(12)
    { pg8::Gemm g{H, WOUT0_T, R, D, D}; LatOrder S; S.init(D, G, bid); EpiResid<0, false> E{xin, ctx, VLAT, VCTX, nullptr, mod + 2 * 1024, nullptr, nullptr, nullptr};
      pg8::gemm_phase<EpiResid<0, false>, LatOrder, true, true>(ldsg, g, S, E); }
    { IDS
      ctx_resid_tiles<false>(H, WOUT0_T, D, ctx, VCTX, mod + 2 * 6144 + 2 * 1024, nullptr, nullptr, nullptr, (float*)lds, bid, G, tid, wave, l15, quad); }
PROBE_END(12)
    xcd_barrier(xbar);
PROBE_BEGIN(7)
    { IDS
    DRAIN_LATE((float*)(lds + wave * 8448), 1 << 30);
    ln_phase<false, false>(RST(0), VLAT, VCTX, nullptr, nullptr, ln_g, ln_b, mod + 3 * 1024, H, gw, NGW, lane);
    }
PROBE_END(7)
    xcd_barrier(xbar);
PROBE_BEGIN(11)
    { pg8::Gemm g{H, W1_0_T, R, FF, D}; LatOrder S; S.init(FF, G, bid); EpiStore<1> E{P, FF, FF};
      pg8::gemm_phase<EpiStore<1>, LatOrder, true, true>(ldsg, g, S, E); }
    { IDS
      ctx_ksplit_tiles<1>(H, W1_0_T, P, FF, 64, FF, (float*)lds, bid, G, tid, wave, l15, quad); }
PROBE_END(11)
    xcd_barrier(xbar);
PROBE_BEGIN(9)
    { pg8::Gemm g{P, W2_0_T, R, D, FF}; LatOrder S; S.init(D, G, bid); EpiResid<1, false> E{VLAT, VCTX, VLAT, VCTX, nullptr, mod + 5 * 1024, RST(0), ln_g, ln_b};
      pg8::gemm_phase<EpiResid<1, false>, LatOrder, true, true>(ldsg, g, S, E); }
    { IDS
      ctx_resid_tiles<true>(P, W2_0_T, FF, VCTX, VCTX, mod + 2 * 6144 + 5 * 1024, RST(0), ln_g, ln_b, (float*)lds, bid, G, tid, wave, l15, quad); }
PROBE_END(9)
    xcd_barrier(xbar);
    { IDS
    ln_phase<false, false>(RST(1), VLAT, VCTX, nullptr, nullptr, ln_g + 1024, ln_b + 1024, mod + 3 * 6144, H, gw, NGW, lane);
    }
    xcd_barrier(xbar);

PROBE_BEGIN(13)
    { pg8::Gemm g{H, WQKV_T, R, NQKV, D}; pg8::StaticOrder S; S.init(R, NQKV, G, bid); EpiStore<0> E{P, NQKV, NQKV};
      pg8::gemm_phase<EpiStore<0>, pg8::StaticOrder, true, true>(ldsg, g, S, E); }
PROBE_END(13)
    xcd_barrier(xbar);

PROBE_BEGIN(6)
#ifndef NO_P12
    { IDS
        bf16* Qs = (bf16*)lds; bf16* Ks = (bf16*)(lds + 73728); bf16* Vt = (bf16*)(lds + 82944); float* ropes = (float*)(lds + 92160);
        for (int i = tid; i < 1024; i += 512) ((f32x4*)ropes)[i] = ((const f32x4*)rope)[i];
        PACC_DECL
        for (int unit = bid; unit < NB * 4 * 64; unit += G) {
            PACC_BEGIN(40)
            const int nb = unit & 63, kvh = (unit >> 6) & 3, b = unit >> 8;
#define ATT_VALID(t) ((t) < 4 || (unsigned)(nb - 1 + (((t) - 4) >> 1)) < 64u)
#define ATT_KPOS(t) ((nb - 1 + (((t) - 4) >> 1)) * 128 + (((t) - 4) & 1) * 64)
#define ATT_KROW(t) ((t) < 4 ? b * TP + (t) * 64 : b * TP + L + ATT_KPOS(t))
            const int keyk = tid >> 2, pck = tid & 3, c1k = (pck & 1) + (pck >> 1) * 4, keyv = tid & 63, dcv = tid >> 6;
            u32x4 pk1 = {0u, 0u, 0u, 0u}, pk2_ = pk1, pvv = pk1;
#define ATT_LOAD(t) do { const int kr_ = ATT_KROW(t); \
                if (tid < 256) { const bf16* src_ = P + (size_t)(kr_ + keyk) * NQKV + 1024 + kvh * 64; pk1 = *(const u32x4*)(src_ + c1k * 8); pk2_ = *(const u32x4*)(src_ + (c1k + 2) * 8); } \
                pvv = *(const u32x4*)(P + (size_t)(kr_ + keyv) * NQKV + 1280 + kvh * 64 + dcv * 8); } while (0)
            ATT_LOAD(0);
            __syncthreads();
#pragma unroll
            for (int i = 0; i < 4; ++i) {
                const int it = tid + i * 512, pcq = it & 3, row = it >> 2, g = row >> 7, qi = row & 127, pos = nb * 128 + qi;
                const bf16* src = P + (size_t)(b * TP + L + pos) * NQKV + (kvh * 4 + g) * 64;
                const int c1 = (pcq & 1) + (pcq >> 1) * 4;
                const u32x4 u1 = *(const u32x4*)(src + c1 * 8), u2 = *(const u32x4*)(src + (c1 + 2) * 8);
                const int pv = (pcq < 2) ? (pos >> 6) : (pos & 63);
                const f32x4* tab = (const f32x4*)(ropes + (pv * 16 + (c1 & 1) * 8) * 2);
                u32x4 o1, o2;
#pragma unroll
                for (int j2 = 0; j2 < 4; ++j2) { const f32x4 cs = tab[j2];
                    const float a0 = bflo(u1[j2]), a1 = bfhi(u1[j2]), b0 = bflo(u2[j2]), b1 = bfhi(u2[j2]);
                    o1[j2] = pk2((a0 * cs.x - b0 * cs.y) * QSC, (a1 * cs.z - b1 * cs.w) * QSC); o2[j2] = pk2((a0 * cs.y + b0 * cs.x) * QSC, (a1 * cs.w + b1 * cs.z) * QSC); }
                *(u32x4*)(Qs + row * 72 + c1 * 8) = o1; *(u32x4*)(Qs + row * 72 + (c1 + 2) * 8) = o2;
            }
            const int g = wave & 3, qh = wave >> 2, qrow0 = g * 128 + qh * 64, qpos0 = nb * 128 + qh * 64;
            float mrun[4], lrun[4]; pg8::f32x4 O[4][4];
            const float sk = sink[kvh * 4 + g] * 1.4426950408889634f;
#pragma unroll
            for (int qt = 0; qt < 4; ++qt) { mrun[qt] = sk; lrun[qt] = (quad == 0) ? 1.f : 0.f;
#pragma unroll
                for (int dt = 0; dt < 4; ++dt) O[dt][qt] = (pg8::f32x4){0.f, 0.f, 0.f, 0.f}; }
            PACC_END(40)
            int ti = 0;
            while (ti < 10) {
                PACC_BEGIN(41)
                const bool local = ti >= 4;
                const int kpos0 = local ? ATT_KPOS(ti) : 0;
                const int side = local ? ((ti - 4) >> 1) - 1 : 0;
                __syncthreads();
                if (tid < 256) {
                    u32x4 o1 = pk1, o2 = pk2_;
                    if (local) {
                        const int pos = kpos0 + keyk, pv = (pck < 2) ? (pos >> 6) : (pos & 63);
                        const f32x4* tab = (const f32x4*)(ropes + (pv * 16 + (c1k & 1) * 8) * 2);
#pragma unroll
                        for (int j2 = 0; j2 < 4; ++j2) { const f32x4 cs = tab[j2];
                            const float a0 = bflo(pk1[j2]), a1 = bfhi(pk1[j2]), b0 = bflo(pk2_[j2]), b1 = bfhi(pk2_[j2]);
                            o1[j2] = pk2(a0 * cs.x - b0 * cs.y, a1 * cs.z - b1 * cs.w); o2[j2] = pk2(a0 * cs.y + b0 * cs.x, a1 * cs.w + b1 * cs.z); }
                    }
                    *(u32x4*)(Ks + keyk * 72 + c1k * 8) = o1; *(u32x4*)(Ks + keyk * 72 + (c1k + 2) * 8) = o2;
                }
#pragma unroll
                for (int j = 0; j < 8; ++j) { const unsigned u = pvv[j >> 1]; Vt[(dcv * 8 + j) * 72 + keyv] = (bf16)((j & 1) ? (u >> 16) : (u & 0xffffu)); }
                __syncthreads();
                PACC_END(41)
                PACC_BEGIN(42)
                int tn = ti + 1;
                while (tn < 10 && !ATT_VALID(tn)) ++tn;
                if (tn < 10) ATT_LOAD(tn);
                if (!((side < 0 && ((ti - 4) & 1) == 0 && qh == 1) || (side > 0 && ((ti - 4) & 1) == 1 && qh == 0))) {
                bf16x8 kfr[4][2];
#pragma unroll
                for (int kt = 0; kt < 4; ++kt)
#pragma unroll
                    for (int ks = 0; ks < 2; ++ks) kfr[kt][ks] = *(const bf16x8*)(Ks + (kt * 16 + l15) * 72 + ks * 32 + quad * 8);
#pragma unroll
                for (int qt = 0; qt < 4; ++qt) {
                    pg8::f32x4 S[4];
#pragma unroll
                    for (int kt = 0; kt < 4; ++kt) S[kt] = (pg8::f32x4){0.f, 0.f, 0.f, 0.f};
#pragma unroll
                    for (int ks = 0; ks < 2; ++ks) { const bf16x8 qf = *(const bf16x8*)(Qs + (qrow0 + qt * 16 + l15) * 72 + ks * 32 + quad * 8);
#pragma unroll
                        for (int kt = 0; kt < 4; ++kt) S[kt] = MFMA16(kfr[kt][ks], qf, S[kt]); }
                    float mx = -INFINITY;
                    if (side < 0 && ((ti - 4) & 1) == qh) {
                        const int tl = quad * 4 - (qpos0 + qt * 16 + l15 - kpos0 - 128);
#pragma unroll
                        for (int kt = 0; kt < 4; ++kt)
#pragma unroll
                            for (int rg = 0; rg < 4; ++rg) { const float sv_ = (tl >= -(kt * 16 + rg)) ? S[kt][rg] : -INFINITY; S[kt][rg] = sv_; mx = fmaxf(mx, sv_); }
                    } else if (side > 0 && ((ti - 4) & 1) == qh) {
                        const int th = (qpos0 + qt * 16 + l15 - kpos0 + 128) - quad * 4;
#pragma unroll
                        for (int kt = 0; kt < 4; ++kt)
#pragma unroll
                            for (int rg = 0; rg < 4; ++rg) { const float sv_ = (th >= (kt * 16 + rg)) ? S[kt][rg] : -INFINITY; S[kt][rg] = sv_; mx = fmaxf(mx, sv_); }
                    } else {
#pragma unroll
                        for (int kt = 0; kt < 4; ++kt)
#pragma unroll
                            for (int rg = 0; rg < 4; ++rg) mx = fmaxf(mx, S[kt][rg]);
                    }
                    mx = quad_max(mx);
                    const float mnew = fmaxf(mrun[qt], mx), al = __builtin_amdgcn_exp2f(mrun[qt] - mnew); mrun[qt] = mnew;
                    float ps = 0.f;
#pragma unroll
                    for (int kt = 0; kt < 4; ++kt)
#pragma unroll
                        for (int rg = 0; rg < 4; ++rg) { const float p = __builtin_amdgcn_exp2f(S[kt][rg] - mnew); S[kt][rg] = p; ps += p; }
                    lrun[qt] = lrun[qt] * al + ps;
#pragma unroll
                    for (int dt = 0; dt < 4; ++dt) O[dt][qt] = O[dt][qt] * al;
#pragma unroll
                    for (int s2 = 0; s2 < 2; ++s2) {
                        u32x4 pw; pw.x = pk2(S[2 * s2][0], S[2 * s2][1]); pw.y = pk2(S[2 * s2][2], S[2 * s2][3]);
                        pw.z = pk2(S[2 * s2 + 1][0], S[2 * s2 + 1][1]); pw.w = pk2(S[2 * s2 + 1][2], S[2 * s2 + 1][3]);
                        const bf16x8 pf = __builtin_bit_cast(bf16x8, pw);
#pragma unroll
                        for (int dt = 0; dt < 4; ++dt) {
                            const s16x4 lo = *(const s16x4*)(Vt + (dt * 16 + l15) * 72 + s2 * 32 + quad * 4), hi = *(const s16x4*)(Vt + (dt * 16 + l15) * 72 + s2 * 32 + 16 + quad * 4);
                            O[dt][qt] = MFMA16(__builtin_shufflevector(lo, hi, 0, 1, 2, 3, 4, 5, 6, 7), pf, O[dt][qt]); }
                    }
                }
                }
                ti = tn;
                PACC_END(42)
            }
            PACC_BEGIN(43)
#pragma unroll
            for (int qt = 0; qt < 4; ++qt) {
                const float lt = quad_sum(lrun[qt]);
                const float inv = 1.f / lt;
                const int r = b * TP + L + qpos0 + qt * 16 + l15;
#pragma unroll
                for (int dt = 0; dt < 4; ++dt) { u32x2 o; o.x = pk2(O[dt][qt][0] * inv, O[dt][qt][1] * inv); o.y = pk2(O[dt][qt][2] * inv, O[dt][qt][3] * inv);
                    *(u32x2*)(H + (size_t)r * D + (kvh * 4 + g) * 64 + dt * 16 + quad * 4) = o; }
            }
            PACC_END(43)
#undef ATT_VALID
#undef ATT_KPOS
#undef ATT_KROW
#undef ATT_LOAD
        }
        PACC_SLEEP()
    }
#endif
PROBE_END(6)
    xcd_barrier(xbar);

PROBE_BEGIN(14)
    { pg8::Gemm g{H, WOUT1_T, R, D, D}; LatOrder S; S.init(D, G, bid); EpiResid<1, false> E{VLAT, VCTX, VLAT, VCTX, nullptr, mod + 3 * 6144 + 2 * 1024, RST(1), ln_g + 1024, ln_b + 1024};
      pg8::gemm_phase<EpiResid<1, false>, LatOrder, true, true>(ldsg, g, S, E); }
PROBE_END(14)
    xcd_barrier(xbar);
    { IDS
    ln_phase<false, true>(RST(2), VLAT, VCTX, nullptr, nullptr, ln_g + 2048, ln_b + 2048, mod + 3 * 6144 + 3 * 1024, H, gw, NGW, lane);
    }
    xcd_barrier(xbar);
PROBE_BEGIN(15)
    { pg8::Gemm g{H, W1_1_T, R, FF, D}; LatOrder S; S.init(FF, G, bid); EpiStore<1> E{P, FF, FF};
      pg8::gemm_phase<EpiStore<1>, LatOrder, true, true>(ldsg, g, S, E); }
PROBE_END(15)
    xcd_barrier(xbar);
PROBE_BEGIN(16)
    { pg8::Gemm g{P, W2_1_T, R, D, FF}; LatOrder S; S.init(D, G, bid); EpiResid<1, true> E{VLAT, VCTX, nullptr, nullptr, H, mod + 3 * 6144 + 5 * 1024, RST(2), ln_g + 2048, ln_b + 2048};
      pg8::gemm_phase<EpiResid<1, true>, LatOrder, true, true>(ldsg, g, S, E); }
PROBE_END(16)
    xcd_barrier(xbar);
    { IDS
    ln_phase<true, true>(nullptr, nullptr, nullptr, H, a.out, ln_g + 3072, ln_b + 3072, mod, H, gw, NGW, lane);
    }
}

extern "C" void kernel_launch(void* const* d_in, const int* in_sizes, int n_in, void* d_out, int out_size, void* d_ws, size_t ws_size, hipStream_t stream) {
    static int grid = 0;
    if (grid == 0) {
        if (n_in != 19 || out_size != NB * T * D || ws_size < WS_TOTAL) { fprintf(stderr, "kernel_launch: unexpected shapes (n_in %d out %d ws %zu)\n", n_in, out_size, ws_size); grid = -1; return; }
        int dev = 0, cus = 0, per_cu = 0;
        hipGetDevice(&dev); hipDeviceGetAttribute(&cus, hipDeviceAttributeMultiprocessorCount, dev);
        if (hipFuncSetAttribute((const void*)fwd_kernel, hipFuncAttributeMaxDynamicSharedMemorySize, LDS_BYTES) != hipSuccess) { fprintf(stderr, "kernel_launch: hipFuncSetAttribute failed\n"); grid = -1; return; }
        if (hipOccupancyMaxActiveBlocksPerMultiprocessor(&per_cu, (const void*)fwd_kernel, 512, LDS_BYTES) != hipSuccess || per_cu < 1) per_cu = 1;
        (void)hipGetLastError();
        grid = cus > 0 ? cus : 256;
    }
    if (grid < 0) return;
    Args a{};
    for (int i = 0; i < 19; ++i) a.in[i] = (const float*)d_in[i];
    a.out = (float*)d_out; a.ws = (unsigned char*)d_ws;
    if (hipMemsetAsync((char*)d_ws + OFF_XBAR, 0, 16384, stream) != hipSuccess) { fprintf(stderr, "kernel_launch: hipMemsetAsync of the barrier words failed\n"); return; }
    void* args[] = {&a};
    hipError_t e = hipLaunchCooperativeKernel((const void*)fwd_kernel, dim3(grid), dim3(512), args, LDS_BYTES, stream);
    if (e != hipSuccess) fprintf(stderr, "cooperative launch failed: %s (grid %d)\n", hipGetErrorString(e), grid);
}
```

```cpp
#include <hip/hip_runtime.h>
#include <hip/hip_cooperative_groups.h>
#include <cstdio>
#include <cstdint>
namespace cg = cooperative_groups;
namespace pg8 {
#define PG8_LAS __attribute__((address_space(3)))
typedef unsigned short bf16_t;
typedef short bf16x8 __attribute__((ext_vector_type(8)));
typedef float f32x4 __attribute__((ext_vector_type(4)));
typedef unsigned u32x4 __attribute__((ext_vector_type(4)));
constexpr int BM = 256, BK = 64, HALF = 128, HTB = HALF * BK * 2  , STAGE_BYTES = 8 * HTB, NXCD = 8, WGM = 8;

__host__ __device__ __forceinline__ int lds_byte(int r, int c) { const int st = (r >> 4) * 2 + (c >> 5), rr = r & 15, cc = c & 31, ob = rr * 64 + cc * 2; return st * 1024 + (ob ^ (((ob >> 9) & 1) << 5)); }
__host__ __device__ __forceinline__ void stage_rc(int b, int& R, int& C) { const int st = b / 1024, sb = b % 1024, swz = sb ^ (((sb >> 9) & 1) << 5); R = (st >> 1) * 16 + swz / 64; C = (st & 1) * 32 + (swz % 64) / 2; }
__host__ __device__ __forceinline__ int perm32(int rho) { const int n = rho >> 4, i = rho & 15; return 8 * (i >> 2) + 4 * n + (i & 3); }

struct Unit { int pm, pn; };
struct Gemm { const bf16_t* A; const bf16_t* Bt; int M, N, K; };

struct StaticOrder {
    int nM, nN, nwg, G, c;
    __host__ __device__ void init(int M, int N, int G_, int c_) { nM = M / BM; nN = N / BM; nwg = nM * nN; G = G_; c = c_; }
    __host__ __device__ bool next(int i, Unit& u) const {
        const long L = (long)i * G + c; if (L >= nwg) return false;
        int wgid = (int)L; { const int q = nwg / NXCD, r = nwg % NXCD, xcd = wgid % NXCD, off = wgid / NXCD; wgid = (xcd < r ? xcd * (q + 1) : r * (q + 1) + (xcd - r) * q) + off; }
        const int nig = WGM * nN, gid = wgid / nig, fm = gid * WGM, gsz = (nM - fm) < WGM ? (nM - fm) : WGM;
        u.pm = fm + ((wgid % nig) % gsz); u.pn = (wgid % nig) / gsz; return true;
    }
    __device__ __forceinline__ void a_ready(const Unit&) const {}
    __device__ __forceinline__ void done(const Unit&) const {}
};

__device__ __forceinline__ unsigned cvt_pk_bf16(float lo, float hi) { unsigned r; asm volatile("v_cvt_pk_bf16_f32 %0, %1, %2" : "=v"(r) : "v"(lo), "v"(hi)); return r; }

template <class Epi, class Sched, bool ALIGN_EPI = false, bool SP2 = false>
__device__ __forceinline__ void gemm_phase(PG8_LAS unsigned char* lds, const Gemm g, const Sched& S, const Epi& E) {
    int tid = threadIdx.x; asm volatile("" : "+v"(tid));
    const int wid = __builtin_amdgcn_readfirstlane(tid >> 6), lane = tid & 63, wr = wid >> 2, wc = wid & 3, fr = lane & 15, fq = lane >> 4;
    const int K = g.K, nt = K / BK;
    unsigned voffA[2], voffB[2];
#pragma unroll
    for (int i = 0; i < 2; ++i) { int R, C; stage_rc(tid * 16 + i * 8192, R, C); const int Rb = Epi::PERM ? ((R & ~31) + perm32(R & 31)) : R;
        voffA[i] = (unsigned)(R * K + C) * 2u; voffB[i] = (unsigned)(Rb * K + C) * 2u; }
    const size_t kstep = (size_t)(BK * 2);
    const size_t hstep = (size_t)HALF * K * 2;
    const size_t tstep = 2 * hstep;
    const unsigned ldsw = (unsigned)wid * 1024u;
    const int aoff = lds_byte(wr * 64 + fr, fq * 8), boff = lds_byte(wc * 32 + fr, fq * 8);
#define PG8_SA(b, h) (((b) * 2 + (h)) * HTB)
#define PG8_SB(b, h) ((4 + (b) * 2 + (h)) * HTB)
#define PG8_STAGE(bufoff, gbase, voff) do { _Pragma("unroll") for (int _i = 0; _i < 2; ++_i) \
        __builtin_amdgcn_global_load_lds((const unsigned*)((const char*)(gbase) + (voff)[_i]), (PG8_LAS unsigned*)(lds + (bufoff) + ldsw + _i * 8192), 16, 0, 0); } while (0)
#define PG8_LDA(dst, b, h) do { _Pragma("unroll") for (int m = 0; m < 4; ++m) _Pragma("unroll") for (int k = 0; k < 2; ++k) dst[m][k] = *(const PG8_LAS bf16x8*)(lds + PG8_SA(b, h) + aoff + m * 2048 + k * 1024); } while (0)
#define PG8_LDB(dst, b, h) do { _Pragma("unroll") for (int n = 0; n < 2; ++n) _Pragma("unroll") for (int k = 0; k < 2; ++k) dst[n][k] = *(const PG8_LAS bf16x8*)(lds + PG8_SB(b, h) + boff + n * 2048 + k * 1024); } while (0)
#define PG8_MMA(ai, bj, At, Bt) do { __builtin_amdgcn_s_setprio(1); _Pragma("unroll") for (int m = 0; m < 4; ++m) _Pragma("unroll") for (int n = 0; n < 2; ++n) _Pragma("unroll") for (int k = 0; k < 2; ++k) \
        acc[ai][bj][m][n] = __builtin_amdgcn_mfma_f32_16x16x32_bf16(Bt[n][k], At[m][k], acc[ai][bj][m][n], 0, 0, 0); __builtin_amdgcn_s_setprio(0); } while (0)
#define PG8_WAIT_V(n) asm volatile("s_waitcnt vmcnt(" #n ")" ::: "memory")
#define PG8_WAIT_L(n) asm volatile("s_waitcnt lgkmcnt(" #n ")" ::: "memory")
#define PG8_BAR __builtin_amdgcn_s_barrier()
#define PG8_SCHED __builtin_amdgcn_sched_barrier(0)
    Unit cur, nxt; int ui = 0;
    if (!S.next(0, cur)) return;
    f32x4 acc[2][2][4][2];
#pragma unroll
    for (int a = 0; a < 2; ++a)
#pragma unroll
        for (int b = 0; b < 2; ++b)
#pragma unroll
            for (int m = 0; m < 4; ++m)
#pragma unroll
                for (int n = 0; n < 2; ++n) acc[a][b][m][n] = (f32x4){0.f, 0.f, 0.f, 0.f};
    bf16x8 At[4][2], B0[2][2], B1[2][2];
    const char* cA = (const char*)g.A + (size_t)cur.pm * tstep; const char* cB = (const char*)g.Bt + (size_t)cur.pn * tstep;
    S.a_ready(cur);
    if constexpr (SP2) {
        PG8_STAGE(PG8_SB(0, 0), cB, voffB); PG8_STAGE(PG8_SB(0, 1), cB + hstep, voffB); PG8_STAGE(PG8_SA(0, 0), cA, voffA); PG8_STAGE(PG8_SA(0, 1), cA + hstep, voffA);
        if (wr == 1) PG8_BAR;
        PG8_WAIT_V(2); PG8_BAR;
        PG8_STAGE(PG8_SB(1, 0), cB + kstep, voffB); PG8_STAGE(PG8_SA(1, 0), cA + kstep, voffA); PG8_STAGE(PG8_SB(1, 1), cB + hstep + kstep, voffB);
        PG8_WAIT_V(6); PG8_BAR;
    } else {
        PG8_STAGE(PG8_SB(0, 0), cB, voffB); PG8_STAGE(PG8_SA(0, 0), cA, voffA); PG8_STAGE(PG8_SB(0, 1), cB + hstep, voffB); PG8_STAGE(PG8_SA(0, 1), cA + hstep, voffA);
        if (wr == 1) PG8_BAR;
        PG8_WAIT_V(4); PG8_BAR;
        PG8_STAGE(PG8_SB(1, 0), cB + kstep, voffB); PG8_STAGE(PG8_SA(1, 0), cA + kstep, voffA); PG8_STAGE(PG8_SB(1, 1), cB + hstep + kstep, voffB);
        PG8_WAIT_V(6); PG8_BAR;
    }
    for (;;) {
        const bool has_next = S.next(ui + 1, nxt);
        const char* nA = has_next ? (const char*)g.A + (size_t)nxt.pm * tstep : cA; const char* nB = has_next ? (const char*)g.Bt + (size_t)nxt.pn * tstep : cB;
        for (int t = 0; t < nt; t += 2) {
            const bool last = (t == nt - 2);
            const char* a1 = cA + (size_t)(t + 1) * kstep;
            const char* a2 = last ? nA : cA + (size_t)(t + 2) * kstep; const char* b2 = last ? nB : cB + (size_t)(t + 2) * kstep;
            const char* a3 = a2 + kstep; const char* b3 = b2 + kstep;
            if (last && has_next) S.a_ready(nxt);
            if constexpr (SP2) {
            PG8_LDB(B0, 0, 0); PG8_LDB(B1, 0, 1); PG8_SCHED; PG8_LDA(At, 0, 0); PG8_STAGE(PG8_SA(1, 1), a1 + hstep, voffA);
            PG8_WAIT_V(8); PG8_WAIT_L(0); PG8_BAR; PG8_MMA(0, 0, At, B0); PG8_MMA(0, 1, At, B1); PG8_BAR; PG8_SCHED;
            PG8_LDA(At, 0, 1); PG8_STAGE(PG8_SB(0, 0), b2, voffB); PG8_STAGE(PG8_SB(0, 1), b2 + hstep, voffB); PG8_STAGE(PG8_SA(0, 0), a2, voffA);
            PG8_WAIT_V(8); PG8_WAIT_L(0); PG8_BAR; PG8_MMA(1, 0, At, B0); PG8_MMA(1, 1, At, B1); PG8_BAR; PG8_SCHED;
            PG8_LDB(B0, 1, 0); PG8_LDB(B1, 1, 1); PG8_SCHED; PG8_LDA(At, 1, 0); PG8_STAGE(PG8_SA(0, 1), a2 + hstep, voffA);
            PG8_WAIT_V(8); PG8_WAIT_L(0); PG8_BAR; PG8_MMA(0, 0, At, B0); PG8_MMA(0, 1, At, B1); PG8_BAR; PG8_SCHED;
            PG8_LDA(At, 1, 1); PG8_STAGE(PG8_SB(1, 0), b3, voffB); PG8_STAGE(PG8_SB(1, 1), b3 + hstep, voffB); PG8_STAGE(PG8_SA(1, 0), a3, voffA);
            PG8_WAIT_V(8); PG8_WAIT_L(0); PG8_BAR; PG8_MMA(1, 0, At, B0); PG8_MMA(1, 1, At, B1); PG8_BAR; PG8_SCHED;
            } else {
            PG8_LDB(B0, 0, 0); PG8_SCHED; PG8_LDA(At, 0, 0); PG8_STAGE(PG8_SA(1, 1), a1 + hstep, voffA);
            PG8_WAIT_L(8); PG8_BAR; PG8_WAIT_L(0); PG8_MMA(0, 0, At, B0); PG8_BAR; PG8_SCHED;
            PG8_LDB(B1, 0, 1); PG8_STAGE(PG8_SB(0, 0), b2, voffB);
            PG8_BAR; PG8_WAIT_L(0); PG8_MMA(0, 1, At, B1); PG8_BAR;
            PG8_LDA(At, 0, 1); PG8_STAGE(PG8_SA(0, 0), a2, voffA);
            PG8_BAR; PG8_WAIT_L(0); PG8_MMA(1, 0, At, B0); PG8_BAR; PG8_SCHED;
            PG8_STAGE(PG8_SB(0, 1), b2 + hstep, voffB);
            PG8_WAIT_V(6); PG8_BAR; PG8_MMA(1, 1, At, B1); PG8_BAR;
            PG8_LDB(B0, 1, 0); PG8_SCHED; PG8_LDA(At, 1, 0); PG8_STAGE(PG8_SA(0, 1), a2 + hstep, voffA);
            PG8_WAIT_L(8); PG8_BAR; PG8_WAIT_L(0); PG8_MMA(0, 0, At, B0); PG8_BAR; PG8_SCHED;
            PG8_LDB(B1, 1, 1); PG8_STAGE(PG8_SB(1, 0), b3, voffB);
            PG8_BAR; PG8_WAIT_L(0); PG8_MMA(0, 1, At, B1); PG8_BAR;
            PG8_LDA(At, 1, 1); PG8_STAGE(PG8_SA(1, 0), a3, voffA);
            PG8_BAR; PG8_WAIT_L(0); PG8_MMA(1, 0, At, B0); PG8_BAR; PG8_SCHED;
            PG8_STAGE(PG8_SB(1, 1), b3 + hstep, voffB);
            PG8_WAIT_V(6); PG8_BAR; PG8_MMA(1, 1, At, B1); PG8_BAR;
            }
        }
        if constexpr (ALIGN_EPI) { if (wr == 0) PG8_BAR; }
        if constexpr (!Epi::AFTER_DRAIN) { E(acc, cur, wr, wc, fr, fq); S.done(cur); }
        if (!has_next) break;
#pragma unroll
        for (int a = 0; a < 2; ++a)
#pragma unroll
            for (int b = 0; b < 2; ++b)
#pragma unroll
                for (int m = 0; m < 4; ++m)
#pragma unroll
                    for (int n = 0; n < 2; ++n) acc[a][b][m][n] = (f32x4){0.f, 0.f, 0.f, 0.f};
        cur = nxt; cA = nA; cB = nB; ++ui;
        if constexpr (ALIGN_EPI) { if (wr == 1) PG8_BAR; }
    }
    PG8_WAIT_V(0);
    if constexpr (!ALIGN_EPI) { if (wr == 0) PG8_BAR; }
    PG8_BAR;
    if constexpr (Epi::AFTER_DRAIN) { E.fused(acc, cur, wr, wc, fr, fq, lds, wid, lane); S.done(cur); }
#undef PG8_SA
#undef PG8_SB
#undef PG8_STAGE
#undef PG8_LDA
#undef PG8_LDB
#undef PG8_MMA
#undef PG8_WAIT_V
#undef PG8_WAIT_L
#undef PG8_BAR
#undef PG8_SCHED
}
}

constexpr int NB = 2, T = 8192, L = 256, D = 1024, TP = T + L, R = NB * TP;
constexpr int FF = 4096, NPROJ = 3104, NPROJ_PAD = 3328, NQKV = 1536, NCH = TP / 64;
constexpr float ALPHA = 1.4142135623730951f;
constexpr int LDS_BYTES = 147456;

typedef unsigned short bf16;
typedef float f32x4 __attribute__((ext_vector_type(4)));
typedef short bf16x8 __attribute__((ext_vector_type(8)));
typedef short s16x4 __attribute__((ext_vector_type(4)));
typedef unsigned u32x4 __attribute__((ext_vector_type(4)));
typedef unsigned u32x2 __attribute__((ext_vector_type(2)));

constexpr size_t OFF_WIN = 0;
constexpr size_t OFF_WOUT0 = OFF_WIN + (size_t)NPROJ_PAD * D * 2;
constexpr size_t OFF_W1_0 = OFF_WOUT0 + (size_t)D * D * 2;
constexpr size_t OFF_W2_0 = OFF_W1_0 + (size_t)FF * D * 2;
constexpr size_t OFF_WQKV = OFF_W2_0 + (size_t)FF * D * 2;
constexpr size_t OFF_WOUT1 = OFF_WQKV + (size_t)NQKV * D * 2;
constexpr size_t OFF_W1_1 = OFF_WOUT1 + (size_t)D * D * 2;
constexpr size_t OFF_W2_1 = OFF_W1_1 + (size_t)FF * D * 2;
constexpr size_t OFF_MOD = OFF_W2_1 + (size_t)FF * D * 2;
constexpr size_t OFF_ROPE = OFF_MOD + 2 * 3 * 6144 * 4;
constexpr size_t OFF_BAR = OFF_ROPE + 128 * 16 * 8;
constexpr size_t OFF_XBAR = OFF_BAR + 256;
constexpr size_t OFF_RST = OFF_XBAR + 16384;
constexpr size_t OFF_XCTX = OFF_RST + (size_t)3 * R * 2 * 4;
constexpr size_t OFF_DEC = OFF_XCTX + (size_t)NB * L * D * 4;
constexpr size_t OFF_H = OFF_DEC + (size_t)32 * NCH * 64 * 4;
constexpr size_t OFF_P = OFF_H + (size_t)R * D * 2;
constexpr size_t OFF_ST = OFF_P + (size_t)R * NPROJ * 2;
constexpr size_t WS_TOTAL = OFF_ST + (size_t)32 * NCH * 8192 * 2;
static_assert(WS_TOTAL <= 268435456, "workspace map exceeds 256 MiB");
static_assert(OFF_P + (size_t)R * FF * 2 <= WS_TOTAL, "MLP hidden overlay");

typedef float f32x2_t __attribute__((ext_vector_type(2)));
typedef __bf16 bf16x2_t __attribute__((ext_vector_type(2)));
__device__ __forceinline__ unsigned pk2(float lo, float hi) { const f32x2_t v = {lo, hi}; const bf16x2_t b = __builtin_convertvector(v, bf16x2_t); return __builtin_bit_cast(unsigned, b); }
__device__ __forceinline__ unsigned f2bf(float f) { return pk2(f, f) & 0xffffu; }
__device__ __forceinline__ float bf2f(unsigned h) { return __uint_as_float(h << 16); }
__device__ __forceinline__ float bflo(unsigned u) { return __uint_as_float(u << 16); }
__device__ __forceinline__ float bfhi(unsigned u) { return __uint_as_float(u & 0xffff0000u); }
__device__ __forceinline__ float wave_sum(float v) {
#pragma unroll
    for (int o = 1; o < 64; o <<= 1) v += __shfl_xor(v, o);
    return v;
}
__device__ __forceinline__ float quad_max(float x) {
    const unsigned u = __float_as_uint(x);
    const auto r = __builtin_amdgcn_permlane32_swap(u, u, false, false);
    const float m = fmaxf(__uint_as_float(r[0]), __uint_as_float(r[1]));
    const unsigned v = __float_as_uint(m);
    const auto q = __builtin_amdgcn_permlane16_swap(v, v, false, false);
    return fmaxf(__uint_as_float(q[0]), __uint_as_float(q[1]));
}
__device__ __forceinline__ float quad_sum(float x) {
    const unsigned u = __float_as_uint(x);
    const auto r = __builtin_amdgcn_permlane32_swap(u, u, false, false);
    const float m = __uint_as_float(r[0]) + __uint_as_float(r[1]);
    const unsigned v = __float_as_uint(m);
    const auto q = __builtin_amdgcn_permlane16_swap(v, v, false, false);
    return __uint_as_float(q[0]) + __uint_as_float(q[1]);
}
#define MFMA16(a, b, c) __builtin_amdgcn_mfma_f32_16x16x32_bf16((a), (b), (c), 0, 0, 0)

__device__ __forceinline__ size_t row_off(int r, bool& isc, int& b) { b = (r >= TP) ? 1 : 0; const int p = r - b * TP; isc = p < L; return isc ? (size_t)(b * L + p) * D : (size_t)(b * T + p - L) * D; }

template <int ACT> struct EpiStore {
    static constexpr bool PERM = true, AFTER_DRAIN = false;
    bf16* O; int ldc; int ncols;
    __device__ __forceinline__ void operator()(const pg8::f32x4 (&acc)[2][2][4][2], const pg8::Unit& u, int wr, int wc, int fr, int fq) const {
        const int row0 = u.pm * 256 + wr * 64 + fr, col0 = u.pn * 256 + wc * 32 + 8 * fq;
#pragma unroll
        for (int ai = 0; ai < 2; ++ai)
#pragma unroll
            for (int m = 0; m < 4; ++m) {
                bf16* rowp = O + (size_t)(row0 + ai * 128 + m * 16) * ldc;
#pragma unroll
                for (int bj = 0; bj < 2; ++bj) {
                    const int col = col0 + bj * 128;
                    pg8::f32x4 v0 = acc[ai][bj][m][0], v1 = acc[ai][bj][m][1];
                    if (ACT == 1) {
#pragma unroll
                        for (int i = 0; i < 4; ++i) { float a = fmaxf(v0[i], 0.f), b = fmaxf(v1[i], 0.f); v0[i] = a * a; v1[i] = b * b; }
                    }
                    u32x4 w; w.x = pg8::cvt_pk_bf16(v0[0], v0[1]); w.y = pg8::cvt_pk_bf16(v0[2], v0[3]); w.z = pg8::cvt_pk_bf16(v1[0], v1[1]); w.w = pg8::cvt_pk_bf16(v1[2], v1[3]);
                    if (col < ncols) *(u32x4*)(rowp + col) = w;
                }
            }
    }
};
template <int SRC, bool DST_FIN> struct EpiResid {
    static constexpr bool PERM = true, AFTER_DRAIN = false;
    const void* src_lat; const void* src_ctx; bf16* dst_lat; bf16* dst_ctx; bf16* dst_fin; const float* gate;
    const float* rst; const float* lg; const float* lb;
    __device__ __forceinline__ void operator()(const pg8::f32x4 (&acc)[2][2][4][2], const pg8::Unit& u, int wr, int wc, int fr, int fq) const {
        const int row0 = u.pm * 256 + wr * 64 + fr, col0 = u.pn * 256 + wc * 32 + 8 * fq;
#pragma unroll
        for (int ai = 0; ai < 2; ++ai)
#pragma unroll
            for (int m = 0; m < 4; ++m) {
                const int row = row0 + ai * 128 + m * 16;
                bool isc; int b; const size_t off = row_off(row, isc, b);
                const float* gt = gate + (isc ? 2 : b) * 6144;
                float mean = 0.f, rstd = 1.f; if (SRC == 1) { mean = rst[2 * row]; rstd = rst[2 * row + 1]; }
#pragma unroll
                for (int bj = 0; bj < 2; ++bj) {
                    const int col = col0 + bj * 128;
                    f32x4 x0, x1;
                    if (SRC == 0) { const float* sp = (const float*)(isc ? src_ctx : src_lat) + off + col; x0 = *(const f32x4*)sp; x1 = *(const f32x4*)(sp + 4); }
                    else { const u32x4 w = *(const u32x4*)((const bf16*)(isc ? src_ctx : src_lat) + off + col);
                        x0 = (f32x4){bflo(w.x), bfhi(w.x), bflo(w.y), bfhi(w.y)}; x1 = (f32x4){bflo(w.z), bfhi(w.z), bflo(w.w), bfhi(w.w)};
                        x0 = (x0 - mean) * rstd * *(const f32x4*)(lg + col) + *(const f32x4*)(lb + col); x1 = (x1 - mean) * rstd * *(const f32x4*)(lg + col + 4) + *(const f32x4*)(lb + col + 4); }
                    const f32x4 g0 = *(const f32x4*)(gt + col), g1 = *(const f32x4*)(gt + col + 4);
                    const pg8::f32x4 a0 = acc[ai][bj][m][0], a1 = acc[ai][bj][m][1];
                    u32x4 o; o.x = pk2(ALPHA * x0.x + g0.x * a0[0], ALPHA * x0.y + g0.y * a0[1]); o.y = pk2(ALPHA * x0.z + g0.z * a0[2], ALPHA * x0.w + g0.w * a0[3]);
                    o.z = pk2(ALPHA * x1.x + g1.x * a1[0], ALPHA * x1.y + g1.y * a1[1]); o.w = pk2(ALPHA * x1.z + g1.z * a1[2], ALPHA * x1.w + g1.w * a1[3]);
                    bf16* dp = DST_FIN ? dst_fin + (size_t)row * D + col : (isc ? dst_ctx : dst_lat) + off + col;
                    *(u32x4*)dp = o;
                }
            }
    }
};

__device__ __forceinline__ void transpose_item(const float* __restrict__ W, int K, int N, bf16* WT, float* scr, int item, int lane) {
    const int nblk = N / 32, kb = item / nblk, nb = item % nblk, k0 = 64 * kb, n0 = 32 * nb;
#pragma unroll 8
    for (int i = 0; i < 32; ++i) { const int kk = 2 * i + (lane >> 5); scr[kk * 33 + (lane & 31)] = W[(size_t)(k0 + kk) * N + n0 + (lane & 31)]; }
    asm volatile("s_waitcnt lgkmcnt(0)" ::: "memory");
    const int c = lane & 7;
#pragma unroll
    for (int j = 0; j < 4; ++j) { const int n = (lane >> 3) + 8 * j; const float* s = scr + (8 * c) * 33 + n;
        u32x4 o; o.x = pk2(s[0 * 33], s[1 * 33]); o.y = pk2(s[2 * 33], s[3 * 33]); o.z = pk2(s[4 * 33], s[5 * 33]); o.w = pk2(s[6 * 33], s[7 * 33]);
        *(u32x4*)(WT + (size_t)(n0 + n) * K + k0 + 8 * c) = o; }
    asm volatile("s_waitcnt lgkmcnt(0)" ::: "memory");
}

template <bool LAST, bool SKIPCTX>
__device__ __forceinline__ void ln_phase(float* rst, const bf16* vlat, const bf16* vctx, const bf16* vfin, float* outp, const float* __restrict__ g, const float* __restrict__ bt, const float* __restrict__ modn, bf16* H, int gw, int NGW, int lane) {
    int r = gw;
    if (SKIPCTX) { while (r < R) { const int p = r >= TP ? r - TP : r; if (p >= L) break; r += NGW; } }
    u32x4 vn[2];
    if (r < R) { bool isc; int b; const size_t off = row_off(r, isc, b); const bf16* xr = LAST ? vfin + (size_t)r * D : (isc ? vctx : vlat) + off;
#pragma unroll
        for (int j = 0; j < 2; ++j) vn[j] = *(const u32x4*)(xr + lane * 8 + 512 * j); }
    while (r < R) {
        bool isc; int b; const size_t off = row_off(r, isc, b);
        float v[16];
#pragma unroll
        for (int j = 0; j < 2; ++j)
#pragma unroll
            for (int i = 0; i < 4; ++i) { v[j * 8 + 2 * i] = bflo(vn[j][i]); v[j * 8 + 2 * i + 1] = bfhi(vn[j][i]); }
        int rn = r + NGW;
        if (SKIPCTX) { while (rn < R) { const int p = rn >= TP ? rn - TP : rn; if (p >= L) break; rn += NGW; } }
        if (rn < R) { bool isc2; int b2; const size_t off2 = row_off(rn, isc2, b2); const bf16* xr2 = LAST ? vfin + (size_t)rn * D : (isc2 ? vctx : vlat) + off2;
#pragma unroll
            for (int j = 0; j < 2; ++j) vn[j] = *(const u32x4*)(xr2 + lane * 8 + 512 * j); }
        float s = 0.f;
#pragma unroll
        for (int i = 0; i < 16; ++i) s += v[i];
        const float mean = wave_sum(s) * (1.f / D); float s2 = 0.f;
#pragma unroll
        for (int i = 0; i < 16; ++i) { v[i] -= mean; s2 += v[i] * v[i]; }
        const float rstd = 1.f / sqrtf(wave_sum(s2) * (1.f / D) + 1e-5f);
        const float* md = modn + (isc ? 2 : b) * 6144;
        if (!LAST && lane == 0) { rst[2 * r] = mean; rst[2 * r + 1] = rstd; }
#pragma unroll
        for (int j = 0; j < 2; ++j) {
            const int idx = lane * 8 + 512 * j;
            float y[8];
#pragma unroll
            for (int q = 0; q < 2; ++q) { const f32x4 gg = *(const f32x4*)(g + idx + 4 * q), bb = *(const f32x4*)(bt + idx + 4 * q);
#pragma unroll
                for (int i = 0; i < 4; ++i) y[q * 4 + i] = v[j * 8 + q * 4 + i] * rstd * gg[i] + bb[i]; }
            if (LAST) { *(f32x4*)(outp + off + idx) = (f32x4){y[0], y[1], y[2], y[3]}; *(f32x4*)(outp + off + idx + 4) = (f32x4){y[4], y[5], y[6], y[7]}; }
            else {
                float h[8];
#pragma unroll
                for (int q = 0; q < 2; ++q) { const f32x4 sh = *(const f32x4*)(md + idx + 4 * q), sc = *(const f32x4*)(md + 1024 + idx + 4 * q);
#pragma unroll
                    for (int i = 0; i < 4; ++i) h[q * 4 + i] = y[q * 4 + i] * (sc[i] + 1.f) + sh[i]; }
                u32x4 o; o.x = pk2(h[0], h[1]); o.y = pk2(h[2], h[3]); o.z = pk2(h[4], h[5]); o.w = pk2(h[6], h[7]);
                *(u32x4*)(H + (size_t)r * D + idx) = o;
            }
        }
        r = rn;
    }
}

__device__ __forceinline__ float log_sigmoid(float z) { return fminf(z, 0.f) - __logf(1.f + __expf(-fabsf(z))); }

constexpr int CS = 65;
constexpr float QSC = 0.125f * 1.4426950408889634f;
struct GatePre { u32x2 lr; f32x4 w; float bias; };
__device__ __forceinline__ GatePre gate_prefetch(int g, int h, const bf16* Pr, const float* gkw, const float* gkb, int tid) {
    GatePre p; p.lr = (u32x2){0u, 0u}; p.w = (f32x4){0.f, 0.f, 0.f, 0.f}; p.bias = 0.f;
    if (g) { const int c = tid >> 3, part = tid & 7;
        p.lr = *(const u32x2*)(Pr + (size_t)c * NPROJ + 3072 + part * 4);
        const int idx = tid * 4, dir = idx >> 10, r = (idx >> 6) & 15, d = idx & 63;
        p.w = *(const f32x4*)(gkw + (dir * 16 + r) * 256 + h * 64 + d);
        if (tid < 128) p.bias = gkb[(tid >> 6) * 256 + h * 64 + (tid & 63)]; }
    return p;
}
__device__ __forceinline__ void fill_cum3(float* cf, float* cb, float* lrs, float* wl, int g, int h, const GatePre& gp, const float* theta, int tid) {
    if (g == 0) {
        const float lgf = log1pf(-expf(theta[h])), lgb = log1pf(-expf(theta[4 + h]));
        for (int i = tid; i < 4096; i += 512) { const int c = i >> 6, d = i & 63; cf[c * CS + d] = (float)(c + 1) * lgf; cb[c * CS + d] = (float)(64 - c) * lgb; }
        __syncthreads();
        return;
    }
    { const int c = tid >> 3, part = tid & 7;
      float* lp = lrs + c * 33 + part * 4; lp[0] = bflo(gp.lr.x); lp[1] = bfhi(gp.lr.x); lp[2] = bflo(gp.lr.y); lp[3] = bfhi(gp.lr.y);
      *(f32x4*)(wl + tid * 4) = gp.w;
      if (tid < 128) wl[2048 + tid] = gp.bias; }
    __syncthreads();
    { const int c = tid >> 3, dg = tid & 7;
#pragma unroll
      for (int dir = 0; dir < 2; ++dir) {
          f32x4 za = *(const f32x4*)(wl + 2048 + dir * 64 + dg * 8), zb = *(const f32x4*)(wl + 2048 + dir * 64 + dg * 8 + 4);
#pragma unroll
          for (int r = 0; r < 16; ++r) { const float lv = lrs[c * 33 + dir * 16 + r];
              za += lv * *(const f32x4*)(wl + (dir * 16 + r) * 64 + dg * 8); zb += lv * *(const f32x4*)(wl + (dir * 16 + r) * 64 + dg * 8 + 4); }
          float* dst = (dir ? cb : cf) + c * CS + dg * 8;
#pragma unroll
          for (int j = 0; j < 4; ++j) { dst[j] = log_sigmoid(za[j]) * (1.f / 16.f); dst[4 + j] = log_sigmoid(zb[j]) * (1.f / 16.f); } } }
    __syncthreads();
    if (tid < 128) {
        const int dir = tid >> 6; float* arr = (dir ? cb : cf) + (tid & 63);
        float run = 0.f;
#pragma unroll
        for (int hh = 0; hh < 2; ++hh) {
            float v[32];
            const int base = dir ? (1 - hh) * 32 : hh * 32;
#pragma unroll
            for (int c = 0; c < 32; ++c) v[c] = arr[(base + c) * CS];
            if (dir == 0) {
#pragma unroll
                for (int c = 0; c < 32; ++c) { run += v[c]; arr[(base + c) * CS] = run; }
            } else {
#pragma unroll
                for (int c = 31; c >= 0; --c) { run += v[c]; arr[(base + c) * CS] = run; }
            }
        }
    }
    __syncthreads();
}

__device__ __forceinline__ void fast_bar(unsigned* ctr, unsigned& target) {
    asm volatile("s_waitcnt vmcnt(0)" ::: "memory");
    __syncthreads();
    target += gridDim.x;
    if (threadIdx.x == 0) {
        __builtin_amdgcn_fence(__ATOMIC_RELEASE, "agent");
        asm volatile("s_waitcnt vmcnt(0)" ::: "memory");
        __hip_atomic_fetch_add(ctr, 1u, __ATOMIC_RELAXED, __HIP_MEMORY_SCOPE_AGENT);
        while (__hip_atomic_load(ctr, __ATOMIC_RELAXED, __HIP_MEMORY_SCOPE_AGENT) < target) __builtin_amdgcn_s_sleep(1);
        __builtin_amdgcn_fence(__ATOMIC_ACQUIRE, "agent");
        asm volatile("s_waitcnt vmcnt(0)" ::: "memory");
    }
    __syncthreads();
}
#define RLX_AGENT __ATOMIC_RELAXED, __HIP_MEMORY_SCOPE_AGENT
#define XB_TMO      128
#define XB_XCNT(j)  (256  + 64 * (j))
#define XB_XSUB(j)  (1280 + 64 * (j))
#define XB_XGEN(j)  (2304 + 64 * (j))
#define XB_TOP      3328
#define XB_TOPGEN   3392
#define XCD_BAR_WORDS 3456
#define XB_SPIN_CAP (1u << 18)

__device__ __forceinline__ unsigned xb_ld(unsigned* p)              { return __hip_atomic_load(p, __ATOMIC_RELAXED, __HIP_MEMORY_SCOPE_AGENT); }
__device__ __forceinline__ unsigned xb_add(unsigned* p, unsigned v) { return __hip_atomic_fetch_add(p, v, __ATOMIC_RELAXED, __HIP_MEMORY_SCOPE_AGENT); }
__device__ __forceinline__ unsigned xb_xcc_id() { return (unsigned)__builtin_amdgcn_s_getreg((3 << 11) | 20) & 0xFu; }
#define XB_SPIN(cond, bar) do { unsigned _sp = 0; while (cond) { __builtin_amdgcn_s_sleep(1); \
    if ((++_sp & 255u) == 0u) { if (xb_ld(&(bar)[XB_TMO])) break; if (_sp > XB_SPIN_CAP) { atomicAdd(&(bar)[XB_TMO], 1u); break; } } } } while (0)

struct XcdBarrier {
    unsigned* bar; unsigned x;
    volatile unsigned* st;
};

__device__ __forceinline__ XcdBarrier xcd_barrier_post(unsigned* bar, volatile unsigned* st) {
    XcdBarrier b; b.bar = bar; b.x = xb_xcc_id(); b.st = st;
    if (threadIdx.x == 0) (void)xb_add(&bar[XB_XCNT(b.x)], 1u);
    return b;
}
__device__ __forceinline__ void xcd_barrier_complete(unsigned* bar, unsigned x, unsigned& nloc, unsigned& nx) {
    const unsigned G = gridDim.x * gridDim.y * gridDim.z;
    unsigned sum, cnt, mine, sp = 0u;
    for (;;) {
        sum = 0u; cnt = 0u; mine = 0u;
#pragma unroll
        for (unsigned j = 0; j < 16; ++j) { const unsigned c = xb_ld(&bar[XB_XCNT(j)]); sum += c; cnt += (c > 0u) ? 1u : 0u; mine = (j == x) ? c : mine; }
        if (sum == G) break;
        __builtin_amdgcn_s_sleep(1);
        if ((++sp & 255u) == 0u) { if (xb_ld(&bar[XB_TMO])) break; if (sp > XB_SPIN_CAP) { atomicAdd(&bar[XB_TMO], 1u); break; } }
    }
    nloc = mine > 0u ? mine : 1u; nx = cnt > 0u ? cnt : 1u;
}

__device__ __forceinline__ void xcd_barrier(const XcdBarrier& b) {
    asm volatile("s_waitcnt vmcnt(0)" ::: "memory");
    __syncthreads();
    if (threadIdx.x == 0) {
        unsigned* bar = b.bar;
        __builtin_amdgcn_s_waitcnt(0);
        unsigned nloc = b.st[0], nx = b.st[1];
        if (nloc == 0u) { xcd_barrier_complete(bar, b.x, nloc, nx); b.st[0] = nloc; b.st[1] = nx; }
        const unsigned old = xb_add(&bar[XB_XSUB(b.x)], 1u);
        const unsigned gen = old / nloc;
        if (old + 1u == (gen + 1u) * nloc) {
            __builtin_amdgcn_fence(__ATOMIC_RELEASE, "agent");
            asm volatile("s_waitcnt vmcnt(0)" ::: "memory");
            const unsigned og = xb_add(&bar[XB_TOP], 1u);
            const unsigned tg = og / nx;
            if (og + 1u == (tg + 1u) * nx) xb_add(&bar[XB_TOPGEN], 1u);
            else XB_SPIN(xb_ld(&bar[XB_TOPGEN]) == tg, bar);
            __builtin_amdgcn_fence(__ATOMIC_ACQUIRE, "agent");
            xb_add(&bar[XB_XGEN(b.x)], 1u);
            asm volatile("s_waitcnt vmcnt(0)" ::: "memory");
        } else {
            XB_SPIN(xb_ld(&bar[XB_XGEN(b.x)]) == gen, bar);
            __builtin_amdgcn_fence(__ATOMIC_ACQUIRE, "agent");
            asm volatile("s_waitcnt vmcnt(0)" ::: "memory");
        }
    }
    __syncthreads();
}

struct LatOrder {
    pg8::StaticOrder S;
    __device__ void init(int N, int G, int c) { S.init(NB * T, N, G, c); }
    __device__ bool next(int i, pg8::Unit& u) const { if (!S.next(i, u)) return false; u.pm = u.pm + 1 + (u.pm >= 32 ? 1 : 0); return true; }
    __device__ __forceinline__ void a_ready(const pg8::Unit&) const {}
    __device__ __forceinline__ void done(const pg8::Unit&) const {}
};
#ifndef PROBE_SEL
#define PROBE_SEL 0
#endif
#ifndef PROBE_MUL
#define PROBE_MUL 3
#endif
#define PACC_DECL unsigned long long pacc = 0, pacc_t0 = 0; (void)pacc; (void)pacc_t0;
#define PACC_BEGIN(k) if (PROBE_SEL == (k)) pacc_t0 = __builtin_amdgcn_s_memrealtime();
#define PACC_END(k) if (PROBE_SEL == (k)) pacc += __builtin_amdgcn_s_memrealtime() - pacc_t0;
#define PACC_SLEEP() if (PROBE_SEL >= 40 && PROBE_SEL < 60) { const unsigned long long t1 = __builtin_amdgcn_s_memrealtime(), dt = pacc * PROBE_MUL; while (__builtin_amdgcn_s_memrealtime() - t1 < dt) __builtin_amdgcn_s_sleep(8); }
#define PROBE_BEGIN(k) unsigned long long pt0_##k = 0; if (PROBE_SEL == (k)) pt0_##k = __builtin_amdgcn_s_memrealtime();
#define PROBE_END(k) if (PROBE_SEL == (k)) { const unsigned long long t1 = __builtin_amdgcn_s_memrealtime(), dt = (t1 - pt0_##k) * PROBE_MUL; while (__builtin_amdgcn_s_memrealtime() - t1 < dt) __builtin_amdgcn_s_sleep(8); }


template <int XT, int YT>
__device__ __forceinline__ void frag_gemm(pg8::f32x4 (&acc)[XT][YT], const bf16* X, int ldx, const bf16* Y, int ldy, int k0, int k1, int l15, int quad) {
#pragma unroll 4
    for (int k = k0; k < k1; k += 32) {
        bf16x8 xf[XT], yf[YT];
#pragma unroll
        for (int i = 0; i < XT; ++i) xf[i] = *(const bf16x8*)(X + (size_t)(i * 16 + l15) * ldx + k + quad * 8);
#pragma unroll
        for (int j = 0; j < YT; ++j) yf[j] = *(const bf16x8*)(Y + (size_t)(j * 16 + l15) * ldy + k + quad * 8);
#pragma unroll
        for (int i = 0; i < XT; ++i)
#pragma unroll
            for (int j = 0; j < YT; ++j) acc[i][j] = MFMA16(xf[i], yf[j], acc[i][j]);
    }
}
template <bool SRC_LN>
__device__ __forceinline__ void ctx_resid_tiles(const bf16* A, const bf16* Bt, int K, const void* src_ctx, bf16* dst_ctx, const float* gate_ctx, const float* rst, const float* lg, const float* lb, float* part, int bid, int G, int tid, int wave, int l15, int quad) {
    for (int t = bid; t < 256; t += G) {
        const int rt = t >> 5, c0 = (t & 31) * 32, b = rt >> 2, p0 = (rt & 3) * 64, r0 = b * TP + p0;
        pg8::f32x4 acc[4][2];
#pragma unroll
        for (int i = 0; i < 4; ++i)
#pragma unroll
            for (int j = 0; j < 2; ++j) acc[i][j] = (pg8::f32x4){0.f, 0.f, 0.f, 0.f};
        const int ksl = K >> 3;
        frag_gemm<4, 2>(acc, A + (size_t)r0 * K, K, Bt + (size_t)c0 * K, K, wave * ksl, (wave + 1) * ksl, l15, quad);
        float* pw = part + wave * 2048;
#pragma unroll
        for (int i = 0; i < 4; ++i)
#pragma unroll
            for (int j = 0; j < 2; ++j)
#pragma unroll
                for (int rg = 0; rg < 4; ++rg) pw[(i * 16 + quad * 4 + rg) * 32 + j * 16 + l15] = acc[i][j][rg];
        __syncthreads();
        { const int row = tid >> 3, c4 = (tid & 7) * 4;
          f32x4 sum = *(const f32x4*)(part + row * 32 + c4);
#pragma unroll
          for (int w = 1; w < 8; ++w) sum += *(const f32x4*)(part + w * 2048 + row * 32 + c4);
          const size_t off = (size_t)(b * L + p0 + row) * D + c0 + c4;
          f32x4 x4; const f32x4 g4 = *(const f32x4*)(gate_ctx + c0 + c4);
          if (!SRC_LN) x4 = *(const f32x4*)((const float*)src_ctx + off);
          else { const int rU = r0 + row; const u32x2 w = *(const u32x2*)((const bf16*)src_ctx + off); x4 = (f32x4){bflo(w.x), bfhi(w.x), bflo(w.y), bfhi(w.y)};
              x4 = (x4 - rst[2 * rU]) * rst[2 * rU + 1] * *(const f32x4*)(lg + c0 + c4) + *(const f32x4*)(lb + c0 + c4); }
          const f32x4 vv = x4 * ALPHA + g4 * sum; u32x2 o; o.x = pk2(vv.x, vv.y); o.y = pk2(vv.z, vv.w);
          *(u32x2*)(dst_ctx + off) = o; }
        __syncthreads();
    }
}
__device__ __forceinline__ void ctx_up_tiles(const bf16* A, const bf16* Bt, bf16* O, int bid, int G, int wave, int l15, int quad) {
    for (int t = bid; t < 256; t += G) {
        const int rt = t >> 5, c0 = (t & 31) * 128 + (wave & 3) * 32, b = rt >> 2, r0 = b * TP + (rt & 3) * 64 + (wave >> 2) * 32;
        pg8::f32x4 acc[2][2];
#pragma unroll
        for (int i = 0; i < 2; ++i)
#pragma unroll
            for (int j = 0; j < 2; ++j) acc[i][j] = (pg8::f32x4){0.f, 0.f, 0.f, 0.f};
        frag_gemm<2, 2>(acc, Bt + (size_t)c0 * D, D, A + (size_t)r0 * D, D, 0, D, l15, quad);
#pragma unroll
        for (int i = 0; i < 2; ++i)
#pragma unroll
            for (int j = 0; j < 2; ++j) { float v[4];
#pragma unroll
                for (int rg = 0; rg < 4; ++rg) { const float a_ = fmaxf(acc[i][j][rg], 0.f); v[rg] = a_ * a_; }
                u32x2 o; o.x = pk2(v[0], v[1]); o.y = pk2(v[2], v[3]);
                *(u32x2*)(O + (size_t)(r0 + j * 16 + l15) * FF + c0 + i * 16 + quad * 4) = o; }
    }
}

template <int ACT>
__device__ __forceinline__ void ctx_ksplit_tiles(const bf16* A, const bf16* Bt, bf16* O, int ldo, int ntn, int ncols, float* part, int bid, int G, int tid, int wave, int l15, int quad) {
    for (int t = bid; t < 8 * ntn; t += G) {
        const int rt = t / ntn, c0 = (t % ntn) * 64, b = rt >> 2, r0 = b * TP + (rt & 3) * 64;
        pg8::f32x4 acc[4][4];
#pragma unroll
        for (int i = 0; i < 4; ++i)
#pragma unroll
            for (int j = 0; j < 4; ++j) acc[i][j] = (pg8::f32x4){0.f, 0.f, 0.f, 0.f};
        frag_gemm<4, 4>(acc, A + (size_t)r0 * D, D, Bt + (size_t)c0 * D, D, wave * 128, (wave + 1) * 128, l15, quad);
        float* pw = part + wave * 4096;
#pragma unroll
        for (int i = 0; i < 4; ++i)
#pragma unroll
            for (int j = 0; j < 4; ++j)
#pragma unroll
                for (int rg = 0; rg < 4; ++rg) pw[(i * 16 + quad * 4 + rg) * 64 + j * 16 + l15] = acc[i][j][rg];
        __syncthreads();
        { const int row = tid >> 3, c8 = (tid & 7) * 8;
          f32x4 s0 = *(const f32x4*)(part + row * 64 + c8), s1 = *(const f32x4*)(part + row * 64 + c8 + 4);
#pragma unroll
          for (int w = 1; w < 8; ++w) { s0 += *(const f32x4*)(part + w * 4096 + row * 64 + c8); s1 += *(const f32x4*)(part + w * 4096 + row * 64 + c8 + 4); }
          if (ACT == 1) {
#pragma unroll
              for (int k = 0; k < 4; ++k) { float a_ = fmaxf(s0[k], 0.f), b_ = fmaxf(s1[k], 0.f); s0[k] = a_ * a_; s1[k] = b_ * b_; } }
          u32x4 o; o.x = pk2(s0.x, s0.y); o.y = pk2(s0.z, s0.w); o.z = pk2(s1.x, s1.y); o.w = pk2(s1.z, s1.w);
          const int col = c0 + c8;
          if (col < ncols) *(u32x4*)(O + (size_t)(r0 + row) * ldo + col) = o; }
        __syncthreads();
    }
}

struct Args { const float* in[19]; float* out; unsigned char* ws; };

__global__ void __launch_bounds__(512, 2) fwd_kernel(Args a) {
    extern __shared__ __attribute__((aligned(16))) unsigned char lds[];
    cg::grid_group grid = cg::this_grid();
    const int G = gridDim.x, bid = blockIdx.x, NGW = G * 8;
#define IDS int tid = threadIdx.x; asm volatile("" : "+v"(tid)); const int lane = tid & 63, wave = __builtin_amdgcn_readfirstlane(tid >> 6), quad = lane >> 4, l15 = lane & 15, gw = bid * 8 + wave; (void)quad; (void)l15; (void)gw; (void)lane;
#define xin (a.in[0])
#define cvec (a.in[1])
#define ctx (a.in[2])
#define cctx (a.in[3])
#define w_mod (a.in[4])
#define b_mod (a.in[5])
#define ln_g (a.in[6])
#define ln_b (a.in[7])
#define theta (a.in[11])
#define gkw (a.in[12])
#define gkb (a.in[13])
#define normg (a.in[14])
#define sink (a.in[17])
#define WIN_T ((bf16*)(a.ws + OFF_WIN))
#define WOUT0_T ((bf16*)(a.ws + OFF_WOUT0))
#define W1_0_T ((bf16*)(a.ws + OFF_W1_0))
#define W2_0_T ((bf16*)(a.ws + OFF_W2_0))
#define WQKV_T ((bf16*)(a.ws + OFF_WQKV))
#define WOUT1_T ((bf16*)(a.ws + OFF_WOUT1))
#define W1_1_T ((bf16*)(a.ws + OFF_W1_1))
#define W2_1_T ((bf16*)(a.ws + OFF_W2_1))
#define mod ((float*)(a.ws + OFF_MOD))
#define rope ((float*)(a.ws + OFF_ROPE))
#define xctx ((float*)(a.ws + OFF_XCTX))
#define DEC ((float*)(a.ws + OFF_DEC))
#define H ((bf16*)(a.ws + OFF_H))
#define P ((bf16*)(a.ws + OFF_P))
#define ST ((bf16*)(a.ws + OFF_ST))
#define xlat (a.out)
#define RST(i) ((float*)(a.ws + OFF_RST) + (size_t)(i) * R * 2)
#define VLAT ((bf16*)a.out)
#define VCTX ((bf16*)(a.ws + OFF_XCTX))

#define LATE_ITEMS 9472
#define LATE_CHUNK 16
#define DRAIN_LATE(scr_, maxc_) do { int nclaim_ = 0; unsigned* qc_ = (unsigned*)(a.ws + OFF_XBAR) + 3584; volatile unsigned* qw_ = (volatile unsigned*)(lds + 131072 + 1024); \
        for (;;) { if (nclaim_++ >= (maxc_)) break; if (tid == 0) qw_[0] = __hip_atomic_fetch_add(qc_, (unsigned)LATE_CHUNK, __ATOMIC_RELAXED, __HIP_MEMORY_SCOPE_AGENT);     \
            __syncthreads(); const int base_ = (int)__builtin_amdgcn_readfirstlane(qw_[0]); __syncthreads(); \
            if (base_ >= LATE_ITEMS) break; \
            for (int k_ = wave; k_ < LATE_CHUNK; k_ += 8) { int r_ = base_ + k_; if (r_ >= LATE_ITEMS) break; \
                if (r_ < 2048) { transpose_item(a.in[8], 1024, FF, W1_0_T, (scr_), r_, lane); continue; } r_ -= 2048; \
                if (r_ < 2048) { transpose_item(a.in[9], FF, 1024, W2_0_T, (scr_), r_, lane); continue; } r_ -= 2048; \
                if (r_ < 768) { transpose_item(a.in[16], 1024, NQKV, WQKV_T, (scr_), r_, lane); continue; } r_ -= 768; \
                if (r_ < 512) { transpose_item(a.in[18], 1024, 1024, WOUT1_T, (scr_), r_, lane); continue; } r_ -= 512; \
                if (r_ < 2048) { transpose_item(a.in[8] + (size_t)1024 * FF, 1024, FF, W1_1_T, (scr_), r_, lane); continue; } r_ -= 2048; \
                transpose_item(a.in[9] + (size_t)FF * 1024, FF, 1024, W2_1_T, (scr_), r_, lane); } } } while (0)
    PG8_LAS unsigned char* ldsg = (PG8_LAS unsigned char*)lds;
    unsigned* barw = (unsigned*)(a.ws + OFF_BAR); unsigned bar_target = 0u; (void)barw; (void)bar_target;
    unsigned* xbw = (unsigned*)(a.ws + OFF_XBAR);
    volatile unsigned* xst = (volatile unsigned*)(lds + 131072 + 512);
    if (threadIdx.x == 0) { xst[0] = 0u; xst[1] = 0u; }
    XcdBarrier xbar = xcd_barrier_post(xbw, xst);
    if (a.ws == nullptr) grid.sync();

PROBE_BEGIN(1)
    { IDS
        float* sl = (float*)lds; float* red = (float*)(lds + 12288);
        for (int item = bid; item < 192; item += G) {
            for (int i = tid; i < 3072; i += 512) { const int j = i >> 10, k = i & 1023; const float v = (j < 2) ? cvec[j * 1024 + k] : cctx[k]; sl[i] = v / (1.f + expf(-v)); }
            __syncthreads();
            const int layer = item / 96, n0 = (item % 96) * 64;
            const float* W = w_mod + (size_t)layer * 1024 * 6144 + n0 + lane;
            float a0 = 0.f, a1 = 0.f, a2 = 0.f; const int k0 = wave * 128;
#pragma unroll 8
            for (int kk = 0; kk < 128; ++kk) { const int k = k0 + kk; const float w = W[(size_t)k * 6144]; a0 += sl[k] * w; a1 += sl[1024 + k] * w; a2 += sl[2048 + k] * w; }
            red[(wave * 3 + 0) * 64 + lane] = a0; red[(wave * 3 + 1) * 64 + lane] = a1; red[(wave * 3 + 2) * 64 + lane] = a2;
            __syncthreads();
            if (tid < 192) { const int j = tid >> 6, col = tid & 63; float s = b_mod[layer * 6144 + n0 + col];
#pragma unroll
                for (int w = 0; w < 8; ++w) s += red[(w * 3 + j) * 64 + col];
                mod[(layer * 3 + j) * 6144 + n0 + col] = s; }
            __syncthreads();
        }
        if (bid == G - 1 && tid < 16) {
            double f = 1.0; for (int i = 0; i < tid; ++i) f *= 0.56234132519034908;
            const double x2 = f * f; double cs = 1.0, sn = f, tc = 1.0, ts = f;
            for (int n = 1; n <= 12; ++n) { tc *= -x2 / (double)((2 * n - 1) * (2 * n)); cs += tc; ts *= -x2 / (double)((2 * n) * (2 * n + 1)); sn += ts; }
            double c = 1.0, s = 0.0;
            for (int p = 0; p < 128; ++p) { rope[(p * 16 + tid) * 2] = (float)c; rope[(p * 16 + tid) * 2 + 1] = (float)s; const double nc = c * cs - s * sn; s = s * cs + c * sn; c = nc; }
        }
        float* scr = (float*)(lds + 32768 + wave * 8448);
        for (int it = gw; it < 2064; it += NGW) {
            int r = it;
            if (r < 1552) { transpose_item(a.in[10], 1024, NPROJ, WIN_T, scr, r, lane); continue; } r -= 1552;
            transpose_item(a.in[15], 1024, 1024, WOUT0_T, scr, r, lane);
        }
        { u32x4* z = (u32x4*)(WIN_T + (size_t)NPROJ * D); const u32x4 zero = {0u, 0u, 0u, 0u};
          for (int i = bid * 512 + tid; i < (NPROJ_PAD - NPROJ) * D / 8; i += G * 512) z[i] = zero; }
    }
PROBE_END(1)
    xcd_barrier(xbar);


PROBE_BEGIN(2)
    { IDS
    for (int r = gw; r < R; r += 2 * NGW) {
        const int r2 = r + NGW; const bool has2 = r2 < R;
        bool isc, isc2; int b, b2; const size_t off = row_off(r, isc, b), off2 = row_off(has2 ? r2 : r, isc2, b2);
        const float* xr = (isc ? ctx : xin) + off; const float* md = mod + (isc ? 2 : b) * 6144;
        const float* xr2 = (isc2 ? ctx : xin) + off2; const float* md2 = mod + (isc2 ? 2 : b2) * 6144;
        f32x4 va[4], vb[4];
#pragma unroll
        for (int j = 0; j < 4; ++j) { va[j] = *(const f32x4*)(xr + lane * 4 + 256 * j); vb[j] = *(const f32x4*)(xr2 + lane * 4 + 256 * j); }
#pragma unroll
        for (int j = 0; j < 4; ++j) {
            const int idx = lane * 4 + 256 * j;
            { const f32x4 sh = *(const f32x4*)(md + idx), sc = *(const f32x4*)(md + 1024 + idx);
              const f32x4 h = va[j] * (sc + 1.f) + sh; u32x2 o; o.x = pk2(h.x, h.y); o.y = pk2(h.z, h.w);
              *(u32x2*)(H + (size_t)r * D + idx) = o; }
            if (has2) { const f32x4 sh = *(const f32x4*)(md2 + idx), sc = *(const f32x4*)(md2 + 1024 + idx);
              const f32x4 h = vb[j] * (sc + 1.f) + sh; u32x2 o; o.x = pk2(h.x, h.y); o.y = pk2(h.z, h.w);
              *(u32x2*)(H + (size_t)r2 * D + idx) = o; }
        }
    }
    }
PROBE_END(2)
    xcd_barrier(xbar);
    if (PROBE_SEL == 10) { for (int i = 0; i < 10; ++i) xcd_barrier(xbar); }

PROBE_BEGIN(8)
    { pg8::Gemm g{H, WIN_T, R, NPROJ_PAD, D}; pg8::StaticOrder S; S.init(R, NPROJ_PAD, G, bid); EpiStore<0> E{P, NPROJ, NPROJ};
      pg8::gemm_phase<EpiStore<0>, pg8::StaticOrder, true, true>(ldsg, g, S, E); }
PROBE_END(8)
    xcd_barrier(xbar);

PROBE_BEGIN(3)
#ifndef NO_P3
    { IDS
        float* cf = (float*)lds; float* cb = (float*)(lds + 16640); float* lrs = (float*)(lds + 33280); float* wl = (float*)(lds + 41728);
        bf16* kTf = (bf16*)(lds + 50432); bf16* kTb = (bf16*)(lds + 59648); bf16* vT = (bf16*)(lds + 68864);
        constexpr int NU = NB * 2 * 4 * NCH;
        const int s = tid & 63, dc = tid >> 6;
        u32x4 kv = {0u, 0u, 0u, 0u}, vv0 = kv, vv1 = kv; GatePre gp; gp.lr = (u32x2){0u, 0u}; gp.w = (f32x4){0.f, 0.f, 0.f, 0.f}; gp.bias = 0.f;
#define P3_LOAD(U) do { const int pc_ = (U) % NCH, t_ = (U) / NCH, h_ = t_ & 3, g_ = 1 - (t_ >> 3), b_ = (t_ >> 2) & 1; const bf16* Pr_ = P + (size_t)(b_ * TP + pc_ * 64) * NPROJ; \
            const int kcol_ = g_ ? 1792 + h_ * 64 : 256 + h_ * 64, vcol_ = g_ ? 2048 + h_ * 128 : 512 + h_ * 128; \
            kv = *(const u32x4*)(Pr_ + (size_t)s * NPROJ + kcol_ + dc * 8); vv0 = *(const u32x4*)(Pr_ + (size_t)s * NPROJ + vcol_ + dc * 8); vv1 = *(const u32x4*)(Pr_ + (size_t)s * NPROJ + vcol_ + (dc + 8) * 8); \
            gp = gate_prefetch(g_, h_, Pr_, gkw, gkb, tid); } while (0)
        if (bid < NU) P3_LOAD(bid);
        for (int unit = bid; unit < NU; unit += G) {
            const int pc = unit % NCH, t = unit / NCH, h = t & 3, g = 1 - (t >> 3), b = (t >> 2) & 1;
            const float kscale = g ? 1.f : 0.125f;
            float lgf = 0.f, lgb = 0.f;
            if (g) fill_cum3(cf, cb, lrs, wl, g, h, gp, theta, tid);
            else { lgf = log1pf(-expf(theta[h])); lgb = log1pf(-expf(theta[4 + h])); }
            {
              if (g) {
#pragma unroll
              for (int j = 0; j < 8; ++j) { const int d = dc * 8 + j; const unsigned u = kv[j >> 1]; const float kf = ((j & 1) ? bfhi(u) : bflo(u)) * kscale;
                  kTf[d * 72 + s] = (bf16)f2bf(kf * __expf(cf[63 * CS + d] - cf[s * CS + d]));
                  kTb[d * 72 + s] = (bf16)f2bf(kf * __expf(cb[d] - cb[s * CS + d])); }
              } else { const float ef = __expf((float)(63 - s) * lgf) * kscale, eb = __expf((float)s * lgb) * kscale;
#pragma unroll
              for (int j = 0; j < 8; ++j) { const int d = dc * 8 + j; const unsigned u = kv[j >> 1]; const float kf = (j & 1) ? bfhi(u) : bflo(u);
                  kTf[d * 72 + s] = (bf16)f2bf(kf * ef); kTb[d * 72 + s] = (bf16)f2bf(kf * eb); }
              }
#pragma unroll
              for (int j = 0; j < 8; ++j) { const unsigned u0 = vv0[j >> 1], u1 = vv1[j >> 1];
                  vT[(dc * 8 + j) * 72 + s] = (bf16)((j & 1) ? (u0 >> 16) : (u0 & 0xffffu)); vT[((dc + 8) * 8 + j) * 72 + s] = (bf16)((j & 1) ? (u1 >> 16) : (u1 & 0xffffu)); }
            }
            const int seq0 = ((b * 2 + g) * 4 + h) * 2;
            const int nf = pc, nbk = (pc < 4) ? 3 - pc : 135 - pc;
            if (tid < 128) { const int dir = tid >> 6, d = tid & 63;
                DEC[((size_t)(seq0 + dir) * NCH + (dir ? nbk : nf)) * 64 + d] = g ? (dir ? expf(cb[d]) : expf(cf[63 * CS + d])) : expf(64.f * (dir ? lgb : lgf)); }
            if (unit + G < NU) P3_LOAD(unit + G);
            __syncthreads();
            bf16x8 bfr[2];
#pragma unroll
            for (int ks = 0; ks < 2; ++ks) bfr[ks] = *(const bf16x8*)(vT + (wave * 16 + l15) * 72 + ks * 32 + quad * 8);
#pragma unroll
            for (int dir = 0; dir < 2; ++dir) {
                const bf16* kT = dir ? kTb : kTf;
                bf16* dst = ST + ((size_t)(seq0 + dir) * NCH + (dir ? nbk : nf)) * 8192 + (size_t)(wave * 16 + l15) * 64;
#pragma unroll
                for (int dt = 0; dt < 4; ++dt) {
                    pg8::f32x4 acc = {0.f, 0.f, 0.f, 0.f};
#pragma unroll
                    for (int ks = 0; ks < 2; ++ks) { const bf16x8 af = *(const bf16x8*)(kT + (dt * 16 + l15) * 72 + ks * 32 + quad * 8); acc = MFMA16(af, bfr[ks], acc); }
                    u32x2 o; o.x = pk2(acc[0], acc[1]); o.y = pk2(acc[2], acc[3]);
                    *(u32x2*)(dst + dt * 16 + quad * 4) = o;
                }
            }
            __syncthreads();
        }
#undef P3_LOAD
        if ((NU - bid + G - 1) / G < (NU + G - 1) / G) DRAIN_LATE((float*)(lds + wave * 8448), 1);
    }
#endif
PROBE_END(3)
    xcd_barrier(xbar);

PROBE_BEGIN(4)
    { IDS
    for (int i = bid * 512 + tid; i < 32 * 4096; i += G * 512) {
        const int seq = i >> 12, pi = i & 4095, d = (2 * pi) & 63;
        unsigned* sp = (unsigned*)(ST + (size_t)seq * NCH * 8192) + pi; const float* dp = DEC + (size_t)seq * NCH * 64 + d;
        float s0 = 0.f, s1 = 0.f;
#pragma unroll 4
        for (int n = 0; n < NCH; ++n) {
            const unsigned kv = sp[(size_t)n * 4096]; const float d0 = dp[n * 64], d1 = dp[n * 64 + 1];
            sp[(size_t)n * 4096] = pk2(s0, s1);
            s0 = d0 * s0 + bflo(kv); s1 = d1 * s1 + bfhi(kv);
        }
    }
    }
PROBE_END(4)
    xcd_barrier(xbar);

PROBE_BEGIN(5)
#ifndef NO_P5
    { IDS
        float* cf = (float*)lds; float* cb = (float*)(lds + 16640); float* lrs = (float*)(lds + 33280); float* wl = (float*)(lds + 41728);
        bf16* qdf = (bf16*)(lds + 50432); bf16* kif = (bf16*)(lds + 59648); bf16* qdb = (bf16*)(lds + 68864); bf16* kib = (bf16*)(lds + 78080);
        bf16* vT = (bf16*)(lds + 87296); bf16* Am = (bf16*)(lds + 105728); float* red = (float*)(lds + 114944);
        constexpr int NU = NB * 2 * 4 * NCH;
        const int dcq = tid & 7, sq = tid >> 3, sv = tid & 63, dcv = tid >> 6;
        u32x4 qv = {0u, 0u, 0u, 0u}, kv = qv, vv0 = qv, vv1 = qv; GatePre gp; gp.lr = (u32x2){0u, 0u}; gp.w = (f32x4){0.f, 0.f, 0.f, 0.f}; gp.bias = 0.f;
#define P5_LOAD(U) do { const int pc_ = (U) % NCH, t_ = (U) / NCH, h_ = t_ & 3, g_ = 1 - (t_ >> 3), b_ = (t_ >> 2) & 1; const bf16* Pr_ = P + (size_t)(b_ * TP + pc_ * 64) * NPROJ; \
            const int qcol_ = g_ ? 1536 + h_ * 64 : h_ * 64, kcol_ = g_ ? 1792 + h_ * 64 : 256 + h_ * 64, vcol_ = g_ ? 2048 + h_ * 128 : 512 + h_ * 128; \
            qv = *(const u32x4*)(Pr_ + (size_t)sq * NPROJ + qcol_ + dcq * 8); kv = *(const u32x4*)(Pr_ + (size_t)sq * NPROJ + kcol_ + dcq * 8); \
            vv0 = *(const u32x4*)(Pr_ + (size_t)sv * NPROJ + vcol_ + dcv * 8); vv1 = *(const u32x4*)(Pr_ + (size_t)sv * NPROJ + vcol_ + (dcv + 8) * 8); \
            gp = gate_prefetch(g_, h_, Pr_, gkw, gkb, tid); } while (0)
        if (bid < NU) P5_LOAD(bid);
        for (int unit = bid; unit < NU; unit += G) {
            const int pc = unit % NCH, t = unit / NCH, h = t & 3, g = 1 - (t >> 3), b = (t >> 2) & 1;
            const int r0 = b * TP + pc * 64;
            const int gcol = g ? 2560 + h * 128 : 1024 + h * 128;
            const float qscale = g ? 0.125f : 1.f, kscale = g ? 1.f : 0.125f;
            if (g) fill_cum3(cf, cb, lrs, wl, g, h, gp, theta, tid);
            { u32x4 o1, o2, o3, o4;
              if (g) {
#pragma unroll
              for (int j2 = 0; j2 < 4; ++j2) {
                  const int d = dcq * 8 + 2 * j2;
                  const float f0 = cf[sq * CS + d], f1 = cf[sq * CS + d + 1], b0 = cb[sq * CS + d], b1 = cb[sq * CS + d + 1];
                  const float q0 = bflo(qv[j2]) * qscale, q1 = bfhi(qv[j2]) * qscale, k0 = bflo(kv[j2]) * kscale, k1 = bfhi(kv[j2]) * kscale;
                  o1[j2] = pk2(q0 * __expf(f0), q1 * __expf(f1)); o2[j2] = pk2(k0 * __expf(-f0), k1 * __expf(-f1));
                  o3[j2] = pk2(q0 * __expf(b0), q1 * __expf(b1)); o4[j2] = pk2(k0 * __expf(-b0), k1 * __expf(-b1));
              }
              } else {
                  const float lgf = log1pf(-expf(theta[h])), lgb = log1pf(-expf(theta[4 + h]));
                  const float cfr = (float)(sq + 1) * lgf, cbr = (float)(64 - sq) * lgb;
                  const float ef = __expf(cfr) * qscale, eif = __expf(-cfr) * kscale, eb = __expf(cbr) * qscale, eib = __expf(-cbr) * kscale;
#pragma unroll
                  for (int j2 = 0; j2 < 4; ++j2) { const float q0 = bflo(qv[j2]), q1 = bfhi(qv[j2]), k0 = bflo(kv[j2]), k1 = bfhi(kv[j2]);
                      o1[j2] = pk2(q0 * ef, q1 * ef); o2[j2] = pk2(k0 * eif, k1 * eif); o3[j2] = pk2(q0 * eb, q1 * eb); o4[j2] = pk2(k0 * eib, k1 * eib); }
              }
              *(u32x4*)(qdf + sq * 72 + dcq * 8) = o1; *(u32x4*)(kif + sq * 72 + dcq * 8) = o2; *(u32x4*)(qdb + sq * 72 + dcq * 8) = o3; *(u32x4*)(kib + sq * 72 + dcq * 8) = o4;
#pragma unroll
              for (int j = 0; j < 8; ++j) { const unsigned u0 = vv0[j >> 1], u1 = vv1[j >> 1];
                  vT[(dcv * 8 + j) * 72 + sv] = (bf16)((j & 1) ? (u0 >> 16) : (u0 & 0xffffu)); vT[((dcv + 8) * 8 + j) * 72 + sv] = (bf16)((j & 1) ? (u1 >> 16) : (u1 & 0xffffu)); }
            }
            __syncthreads();
            const int ct = wave & 3, eh = wave >> 2;
            const int seq0 = ((b * 2 + g) * 4 + h) * 2;
            const int nf = pc, nbk = (pc < 4) ? 3 - pc : 135 - pc;
            const bf16* Sf = ST + ((size_t)seq0 * NCH + nf) * 8192; const bf16* Sb = ST + ((size_t)(seq0 + 1) * NCH + nbk) * 8192;
            const int r = r0 + ct * 16 + l15;
            bf16x8 a2[4][2], a3[4][2]; u32x2 gv[4];
#pragma unroll
            for (int et = 0; et < 4; ++et) { const int e = (eh * 4 + et) * 16 + l15;
#pragma unroll
                for (int ks = 0; ks < 2; ++ks) { a2[et][ks] = *(const bf16x8*)(Sf + e * 64 + ks * 32 + quad * 8); a3[et][ks] = *(const bf16x8*)(Sb + e * 64 + ks * 32 + quad * 8); }
                gv[et] = *(const u32x2*)(P + (size_t)r * NPROJ + gcol + (eh * 4 + et) * 16 + quad * 4); }
            { bf16x8 af[2], ab[2];
#pragma unroll
              for (int ks = 0; ks < 2; ++ks) { af[ks] = *(const bf16x8*)(qdf + (ct * 16 + l15) * 72 + ks * 32 + quad * 8); ab[ks] = *(const bf16x8*)(qdb + (ct * 16 + l15) * 72 + ks * 32 + quad * 8); }
#pragma unroll
              for (int i = 0; i < 2; ++i) { const int st = (wave >> 2) * 2 + i;
                  pg8::f32x4 accf = {0.f, 0.f, 0.f, 0.f}, accb = {0.f, 0.f, 0.f, 0.f};
#pragma unroll
                  for (int ks = 0; ks < 2; ++ks) {
                      const bf16x8 bf_ = *(const bf16x8*)(kif + (st * 16 + l15) * 72 + ks * 32 + quad * 8), bb_ = *(const bf16x8*)(kib + (st * 16 + l15) * 72 + ks * 32 + quad * 8);
                      accf = MFMA16(af[ks], bf_, accf); accb = MFMA16(ab[ks], bb_, accb); }
                  const int scol = st * 16 + l15;
#pragma unroll
                  for (int rg = 0; rg < 4; ++rg) { const int c = ct * 16 + quad * 4 + rg; Am[c * 72 + scol] = (bf16)f2bf(scol <= c ? accf[rg] : accb[rg]); }
              }
            }
            if (unit + G < NU) P5_LOAD(unit + G);
            __syncthreads();
            { bf16x8 bA[2], bQf[2], bQb[2];
#pragma unroll
              for (int ks = 0; ks < 2; ++ks) { const int o = (ct * 16 + l15) * 72 + ks * 32 + quad * 8; bA[ks] = *(const bf16x8*)(Am + o); bQf[ks] = *(const bf16x8*)(qdf + o); bQb[ks] = *(const bf16x8*)(qdb + o); }
              pg8::f32x4 acc[4]; float ss = 0.f;
#pragma unroll
              for (int et = 0; et < 4; ++et) { const int e = (eh * 4 + et) * 16 + l15;
                  pg8::f32x4 c4 = {0.f, 0.f, 0.f, 0.f};
#pragma unroll
                  for (int ks = 0; ks < 2; ++ks) {
                      const bf16x8 a1 = *(const bf16x8*)(vT + e * 72 + ks * 32 + quad * 8);
                      c4 = MFMA16(a1, bA[ks], c4); c4 = MFMA16(a2[et][ks], bQf[ks], c4); c4 = MFMA16(a3[et][ks], bQb[ks], c4); }
                  acc[et] = c4; ss += (c4[0] * c4[0] + c4[1] * c4[1]) + (c4[2] * c4[2] + c4[3] * c4[3]); }
              ss = quad_sum(ss);
              if (quad == 0) red[eh * 64 + ct * 16 + l15] = ss;
              __syncthreads();
              const float tot = red[ct * 16 + l15] + red[64 + ct * 16 + l15];
              const float rinv = 1.f / sqrtf(tot * (1.f / 128.f) + 1e-6f);
#pragma unroll
              for (int et = 0; et < 4; ++et) { const int e0 = (eh * 4 + et) * 16 + quad * 4;
                  float gt[4] = {bflo(gv[et].x), bfhi(gv[et].x), bflo(gv[et].y), bfhi(gv[et].y)}; float y[4];
#pragma unroll
                  for (int i = 0; i < 4; ++i) { const float ng = g ? normg[e0 + i] : 1.f; const float sg = gt[i] * __builtin_amdgcn_rcpf(1.f + __expf(-gt[i])); y[i] = sg * acc[et][i] * rinv * ng; }
                  u32x2 o; o.x = pk2(y[0], y[1]); o.y = pk2(y[2], y[3]);
                  *(u32x2*)(H + (size_t)r * D + g * 512 + h * 128 + e0) = o; }
            }
            __syncthreads();
        }
#undef P5_LOAD
        if ((NU - bid + G - 1) / G < (NU + G - 1) / G) DRAIN_LATE((float*)(lds + wave * 8448), 2);
    }
#endif
PROBE_END(5)
    xcd_barrier(xbar);

PROBE_BEGIN(12)
    { pg8::Gemm g{H, WOUT0_T, R, D, D}; LatOrder S; S.init(D, G, bid); EpiResid<0, false> E{xin, ctx, VLAT, VCTX, nullptr, mod + 2 * 1024, nullptr, nullptr, nullptr};
      pg8::gemm_phase<EpiResid<0, false>, LatOrder, true, true>(ldsg, g, S, E); }
    { IDS
      ctx_resid_tiles<false>(H, WOUT0_T, D, ctx, VCTX, mod + 2 * 6144 + 2 * 1024, nullptr, nullptr, nullptr, (float*)lds, bid, G, tid, wave, l15, quad); }
PROBE_END(12)
    xcd_barrier(xbar);
PROBE_BEGIN(7)
    { IDS
    DRAIN_LATE((float*)(lds + wave * 8448), 1 << 30);
    ln_phase<false, false>(RST(0), VLAT, VCTX, nullptr, nullptr, ln_g, ln_b, mod + 3 * 1024, H, gw, NGW, lane);
    }
PROBE_END(7)
    xcd_barrier(xbar);
PROBE_BEGIN(11)
    { pg8::Gemm g{H, W1_0_T, R, FF, D}; LatOrder S; S.init(FF, G, bid); EpiStore<1> E{P, FF, FF};
      pg8::gemm_phase<EpiStore<1>, LatOrder, true, true>(ldsg, g, S, E); }
    { IDS
      ctx_ksplit_tiles<1>(H, W1_0_T, P, FF, 64, FF, (float*)lds, bid, G, tid, wave, l15, quad); }
PROBE_END(11)
    xcd_barrier(xbar);
PROBE_BEGIN(9)
    { pg8::Gemm g{P, W2_0_T, R, D, FF}; LatOrder S; S.init(D, G, bid); EpiResid<1, false> E{VLAT, VCTX, VLAT, VCTX, nullptr, mod + 5 * 1024, RST(0), ln_g, ln_b};
      pg8::gemm_phase<EpiResid<1, false>, LatOrder, true, true>(ldsg, g, S, E); }
    { IDS
      ctx_resid_tiles<true>(P, W2_0_T, FF, VCTX, VCTX, mod + 2 * 6144 + 5 * 1024, RST(0), ln_g, ln_b, (float*)lds, bid, G, tid, wave, l15, quad); }
PROBE_END(9)
    xcd_barrier(xbar);
    { IDS
    ln_phase<false, false>(RST(1), VLAT, VCTX, nullptr, nullptr, ln_g + 1024, ln_b + 1024, mod + 3 * 6144, H, gw, NGW, lane);
    }
    xcd_barrier(xbar);

PROBE_BEGIN(13)
    { pg8::Gemm g{H, WQKV_T, R, NQKV, D}; pg8::StaticOrder S; S.init(R, NQKV, G, bid); EpiStore<0> E{P, NQKV, NQKV};
      pg8::gemm_phase<EpiStore<0>, pg8::StaticOrder, true, true>(ldsg, g, S, E); }
PROBE_END(13)
    xcd_barrier(xbar);

PROBE_BEGIN(6)
#ifndef NO_P12
    { IDS
        bf16* Qs = (bf16*)lds; bf16* Ks = (bf16*)(lds + 73728); bf16* Vt = (bf16*)(lds + 82944); float* ropes = (float*)(lds + 92160);
        for (int i = tid; i < 1024; i += 512) ((f32x4*)ropes)[i] = ((const f32x4*)rope)[i];
        PACC_DECL
        for (int unit = bid; unit < NB * 4 * 64; unit += G) {
            PACC_BEGIN(40)
            const int nb = unit & 63, kvh = (unit >> 6) & 3, b = unit >> 8;
#define ATT_VALID(t) ((t) < 4 || (unsigned)(nb - 1 + (((t) - 4) >> 1)) < 64u)
#define ATT_KPOS(t) ((nb - 1 + (((t) - 4) >> 1)) * 128 + (((t) - 4) & 1) * 64)
#define ATT_KROW(t) ((t) < 4 ? b * TP + (t) * 64 : b * TP + L + ATT_KPOS(t))
            const int keyk = tid >> 2, pck = tid & 3, c1k = (pck & 1) + (pck >> 1) * 4, keyv = tid & 63, dcv = tid >> 6;
            u32x4 pk1 = {0u, 0u, 0u, 0u}, pk2_ = pk1, pvv = pk1;
#define ATT_LOAD(t) do { const int kr_ = ATT_KROW(t); \
                if (tid < 256) { const bf16* src_ = P + (size_t)(kr_ + keyk) * NQKV + 1024 + kvh * 64; pk1 = *(const u32x4*)(src_ + c1k * 8); pk2_ = *(const u32x4*)(src_ + (c1k + 2) * 8); } \
                pvv = *(const u32x4*)(P + (size_t)(kr_ + keyv) * NQKV + 1280 + kvh * 64 + dcv * 8); } while (0)
            ATT_LOAD(0);
            __syncthreads();
#pragma unroll
            for (int i = 0; i < 4; ++i) {
                const int it = tid + i * 512, pcq = it & 3, row = it >> 2, g = row >> 7, qi = row & 127, pos = nb * 128 + qi;
                const bf16* src = P + (size_t)(b * TP + L + pos) * NQKV + (kvh * 4 + g) * 64;
                const int c1 = (pcq & 1) + (pcq >> 1) * 4;
                const u32x4 u1 = *(const u32x4*)(src + c1 * 8), u2 = *(const u32x4*)(src + (c1 + 2) * 8);
                const int pv = (pcq < 2) ? (pos >> 6) : (pos & 63);
                const f32x4* tab = (const f32x4*)(ropes + (pv * 16 + (c1 & 1) * 8) * 2);
                u32x4 o1, o2;
#pragma unroll
                for (int j2 = 0; j2 < 4; ++j2) { const f32x4 cs = tab[j2];
                    const float a0 = bflo(u1[j2]), a1 = bfhi(u1[j2]), b0 = bflo(u2[j2]), b1 = bfhi(u2[j2]);
                    o1[j2] = pk2((a0 * cs.x - b0 * cs.y) * QSC, (a1 * cs.z - b1 * cs.w) * QSC); o2[j2] = pk2((a0 * cs.y + b0 * cs.x) * QSC, (a1 * cs.w + b1 * cs.z) * QSC); }
                *(u32x4*)(Qs + row * 72 + c1 * 8) = o1; *(u32x4*)(Qs + row * 72 + (c1 + 2) * 8) = o2;
            }
            const int g = wave & 3, qh = wave >> 2, qrow0 = g * 128 + qh * 64, qpos0 = nb * 128 + qh * 64;
            float mrun[4], lrun[4]; pg8::f32x4 O[4][4];
            const float sk = sink[kvh * 4 + g] * 1.4426950408889634f;
#pragma unroll
            for (int qt = 0; qt < 4; ++qt) { mrun[qt] = sk; lrun[qt] = (quad == 0) ? 1.f : 0.f;
#pragma unroll
                for (int dt = 0; dt < 4; ++dt) O[dt][qt] = (pg8::f32x4){0.f, 0.f, 0.f, 0.f}; }
            PACC_END(40)
            int ti = 0;
            while (ti < 10) {
                PACC_BEGIN(41)
                const bool local = ti >= 4;
                const int kpos0 = local ? ATT_KPOS(ti) : 0;
                const int side = local ? ((ti - 4) >> 1) - 1 : 0;
                __syncthreads();
                if (tid < 256) {
                    u32x4 o1 = pk1, o2 = pk2_;
                    if (local) {
                        const int pos = kpos0 + keyk, pv = (pck < 2) ? (pos >> 6) : (pos & 63);
                        const f32x4* tab = (const f32x4*)(ropes + (pv * 16 + (c1k & 1) * 8) * 2);
#pragma unroll
                        for (int j2 = 0; j2 < 4; ++j2) { const f32x4 cs = tab[j2];
                            const float a0 = bflo(pk1[j2]), a1 = bfhi(pk1[j2]), b0 = bflo(pk2_[j2]), b1 = bfhi(pk2_[j2]);
                            o1[j2] = pk2(a0 * cs.x - b0 * cs.y, a1 * cs.z - b1 * cs.w); o2[j2] = pk2(a0 * cs.y + b0 * cs.x, a1 * cs.w + b1 * cs.z); }
                    }
                    *(u32x4*)(Ks + keyk * 72 + c1k * 8) = o1; *(u32x4*)(Ks + keyk * 72 + (c1k + 2) * 8) = o2;
                }
#pragma unroll
                for (int j = 0; j < 8; ++j) { const unsigned u = pvv[j >> 1]; Vt[(dcv * 8 + j) * 72 + keyv] = (bf16)((j & 1) ? (u >> 16) : (u & 0xffffu)); }
                __syncthreads();
                PACC_END(41)
                PACC_BEGIN(42)
                int tn = ti + 1;
                while (tn < 10 && !ATT_VALID(tn)) ++tn;
                if (tn < 10) ATT_LOAD(tn);
                if (!((side < 0 && ((ti - 4) & 1) == 0 && qh == 1) || (side > 0 && ((ti - 4) & 1) == 1 && qh == 0))) {
                bf16x8 kfr[4][2];
#pragma unroll
                for (int kt = 0; kt < 4; ++kt)
#pragma unroll
                    for (int ks = 0; ks < 2; ++ks) kfr[kt][ks] = *(const bf16x8*)(Ks + (kt * 16 + l15) * 72 + ks * 32 + quad * 8);
#pragma unroll
                for (int qt = 0; qt < 4; ++qt) {
                    pg8::f32x4 S[4];
#pragma unroll
                    for (int kt = 0; kt < 4; ++kt) S[kt] = (pg8::f32x4){0.f, 0.f, 0.f, 0.f};
#pragma unroll
                    for (int ks = 0; ks < 2; ++ks) { const bf16x8 qf = *(const bf16x8*)(Qs + (qrow0 + qt * 16 + l15) * 72 + ks * 32 + quad * 8);
#pragma unroll
                        for (int kt = 0; kt < 4; ++kt) S[kt] = MFMA16(kfr[kt][ks], qf, S[kt]); }
                    float mx = -INFINITY;
                    if (side < 0 && ((ti - 4) & 1) == qh) {
                        const int tl = quad * 4 - (qpos0 + qt * 16 + l15 - kpos0 - 128);
#pragma unroll
                        for (int kt = 0; kt < 4; ++kt)
#pragma unroll
                            for (int rg = 0; rg < 4; ++rg) { const float sv_ = (tl >= -(kt * 16 + rg)) ? S[kt][rg] : -INFINITY; S[kt][rg] = sv_; mx = fmaxf(mx, sv_); }
                    } else if (side > 0 && ((ti - 4) & 1) == qh) {
                        const int th = (qpos0 + qt * 16 + l15 - kpos0 + 128) - quad * 4;
#pragma unroll
                        for (int kt = 0; kt < 4; ++kt)
#pragma unroll
                            for (int rg = 0; rg < 4; ++rg) { const float sv_ = (th >= (kt * 16 + rg)) ? S[kt][rg] : -INFINITY; S[kt][rg] = sv_; mx = fmaxf(mx, sv_); }
                    } else {
#pragma unroll
                        for (int kt = 0; kt < 4; ++kt)
#pragma unroll
                            for (int rg = 0; rg < 4; ++rg) mx = fmaxf(mx, S[kt][rg]);
                    }
                    mx = quad_max(mx);
                    const float mnew = fmaxf(mrun[qt], mx), al = __builtin_amdgcn_exp2f(mrun[qt] - mnew); mrun[qt] = mnew;
                    float ps = 0.f;
#pragma unroll
                    for (int kt = 0; kt < 4; ++kt)
#pragma unroll
                        for (int rg = 0; rg < 4; ++rg) { const float p = __builtin_amdgcn_exp2f(S[kt][rg] - mnew); S[kt][rg] = p; ps += p; }
                    lrun[qt] = lrun[qt] * al + ps;
#pragma unroll
                    for (int dt = 0; dt < 4; ++dt) O[dt][qt] = O[dt][qt] * al;
#pragma unroll
                    for (int s2 = 0; s2 < 2; ++s2) {
                        u32x4 pw; pw.x = pk2(S[2 * s2][0], S[2 * s2][1]); pw.y = pk2(S[2 * s2][2], S[2 * s2][3]);
                        pw.z = pk2(S[2 * s2 + 1][0], S[2 * s2 + 1][1]); pw.w = pk2(S[2 * s2 + 1][2], S[2 * s2 + 1][3]);
                        const bf16x8 pf = __builtin_bit_cast(bf16x8, pw);
#pragma unroll
                        for (int dt = 0; dt < 4; ++dt) {
                            const s16x4 lo = *(const s16x4*)(Vt + (dt * 16 + l15) * 72 + s2 * 32 + quad * 4), hi = *(const s16x4*)(Vt + (dt * 16 + l15) * 72 + s2 * 32 + 16 + quad * 4);
                            O[dt][qt] = MFMA16(__builtin_shufflevector(lo, hi, 0, 1, 2, 3, 4, 5, 6, 7), pf, O[dt][qt]); }
                    }
                }
                }
                ti = tn;
                PACC_END(42)
            }
            PACC_BEGIN(43)
#pragma unroll
            for (int qt = 0; qt < 4; ++qt) {
                const float lt = quad_sum(lrun[qt]);
                const float inv = 1.f / lt;
                const int r = b * TP + L + qpos0 + qt * 16 + l15;
#pragma unroll
                for (int dt = 0; dt < 4; ++dt) { u32x2 o; o.x = pk2(O[dt][qt][0] * inv, O[dt][qt][1] * inv); o.y = pk2(O[dt][qt][2] * inv, O[dt][qt][3] * inv);
                    *(u32x2*)(H + (size_t)r * D + (kvh * 4 + g) * 64 + dt * 16 + quad * 4) = o; }
            }
            PACC_END(43)
#undef ATT_VALID
#undef ATT_KPOS
#undef ATT_KROW
#undef ATT_LOAD
        }
        PACC_SLEEP()
    }
#endif
PROBE_END(6)
    xcd_barrier(xbar);

PROBE_BEGIN(14)
    { pg8::Gemm g{H, WOUT1_T, R, D, D}; LatOrder S; S.init(D, G, bid); EpiResid<1, false> E{VLAT, VCTX, VLAT, VCTX, nullptr, mod + 3 * 6144 + 2 * 1024, RST(1), ln_g + 1024, ln_b + 1024};
      pg8::gemm_phase<EpiResid<1, false>, LatOrder, true, true>(ldsg, g, S, E); }
PROBE_END(14)
    xcd_barrier(xbar);
    { IDS
    ln_phase<false, true>(RST(2), VLAT, VCTX, nullptr, nullptr, ln_g + 2048, ln_b + 2048, mod + 3 * 6144 + 3 * 1024, H, gw, NGW, lane);
    }
    xcd_barrier(xbar);
PROBE_BEGIN(15)
    { pg8::Gemm g{H, W1_1_T, R, FF, D}; LatOrder S; S.init(FF, G, bid); EpiStore<1> E{P, FF, FF};
      pg8::gemm_phase<EpiStore<1>, LatOrder, true, true>(ldsg, g, S, E); }
PROBE_END(15)
    xcd_barrier(xbar);
PROBE_BEGIN(16)
    { pg8::Gemm g{P, W2_1_T, R, D, FF}; LatOrder S; S.init(D, G, bid); EpiResid<1, true> E{VLAT, VCTX, nullptr, nullptr, H, mod + 3 * 6144 + 5 * 1024, RST(2), ln_g + 2048, ln_b + 2048};
      pg8::gemm_phase<EpiResid<1, true>, LatOrder, true, true>(ldsg, g, S, E); }
PROBE_END(16)
    xcd_barrier(xbar);
    { IDS
    ln_phase<true, true>(nullptr, nullptr, nullptr, H, a.out, ln_g + 3072, ln_b + 3072, mod, H, gw, NGW, lane);
    }
}

extern "C" void kernel_launch(void* const* d_in, const int* in_sizes, int n_in, void* d_out, int out_size, void* d_ws, size_t ws_size, hipStream_t stream) {
    static int grid = 0;
    if (grid == 0) {
        if (n_in != 19 || out_size != NB * T * D || ws_size < WS_TOTAL) { fprintf(stderr, "kernel_launch: unexpected shapes (n_in %d out %d ws %zu)\n", n_in, out_size, ws_size); grid = -1; return; }
        int dev = 0, cus = 0, per_cu = 0;
        hipGetDevice(&dev); hipDeviceGetAttribute(&cus, hipDeviceAttributeMultiprocessorCount, dev);
        if (hipFuncSetAttribute((const void*)fwd_kernel, hipFuncAttributeMaxDynamicSharedMemorySize, LDS_BYTES) != hipSuccess) { fprintf(stderr, "kernel_launch: hipFuncSetAttribute failed\n"); grid = -1; return; }
        if (hipOccupancyMaxActiveBlocksPerMultiprocessor(&per_cu, (const void*)fwd_kernel, 512, LDS_BYTES) != hipSuccess || per_cu < 1) per_cu = 1;
        (void)hipGetLastError();
        grid = cus > 0 ? cus : 256;
    }
    if (grid < 0) return;
    Args a{};
    for (int i = 0; i < 19; ++i) a.in[i] = (const float*)d_in[i];
    a.out = (float*)d_out; a.ws = (unsigned char*)d_ws;
    if (hipMemsetAsync((char*)d_ws + OFF_XBAR, 0, 16384, stream) != hipSuccess) { fprintf(stderr, "kernel_launch: hipMemsetAsync of the barrier words failed\n"); return; }
    void* args[] = {&a};
    hipError_t e = hipLaunchCooperativeKernel((const void*)fwd_kernel, dim3(grid), dim3(512), args, LDS_BYTES, stream);
    if (e != hipSuccess) fprintf(stderr, "cooperative launch failed: %s (grid %d)\n", hipGetErrorString(e), grid);
}
```

```cpp
#include <hip/hip_runtime.h>
#include <hip/hip_cooperative_groups.h>
#include <cstdio>
#include <cstdint>
namespace cg = cooperative_groups;
namespace pg8 {
#define PG8_LAS __attribute__((address_space(3)))
typedef unsigned short bf16_t;
typedef short bf16x8 __attribute__((ext_vector_type(8)));
typedef float f32x4 __attribute__((ext_vector_type(4)));
typedef unsigned u32x4 __attribute__((ext_vector_type(4)));
constexpr int BM = 256, BK = 64, HALF = 128, HTB = HALF * BK * 2  , STAGE_BYTES = 8 * HTB, NXCD = 8, WGM = 8;

__host__ __device__ __forceinline__ int lds_byte(int r, int c) { const int st = (r >> 4) * 2 + (c >> 5), rr = r & 15, cc = c & 31, ob = rr * 64 + cc * 2; return st * 1024 + (ob ^ (((ob >> 9) & 1) << 5)); }
__host__ __device__ __forceinline__ void stage_rc(int b, int& R, int& C) { const int st = b / 1024, sb = b % 1024, swz = sb ^ (((sb >> 9) & 1) << 5); R = (st >> 1) * 16 + swz / 64; C = (st & 1) * 32 + (swz % 64) / 2; }
__host__ __device__ __forceinline__ int perm32(int rho) { const int n = rho >> 4, i = rho & 15; return 8 * (i >> 2) + 4 * n + (i & 3); }

struct Unit { int pm, pn; };
struct Gemm { const bf16_t* A; const bf16_t* Bt; int M, N, K; };

struct StaticOrder {
    int nM, nN, nwg, G, c;
    __host__ __device__ void init(int M, int N, int G_, int c_) { nM = M / BM; nN = N / BM; nwg = nM * nN; G = G_; c = c_; }
    __host__ __device__ bool next(int i, Unit& u) const {
        const long L = (long)i * G + c; if (L >= nwg) return false;
        int wgid = (int)L; { const int q = nwg / NXCD, r = nwg % NXCD, xcd = wgid % NXCD, off = wgid / NXCD; wgid = (xcd < r ? xcd * (q + 1) : r * (q + 1) + (xcd - r) * q) + off; }
        const int nig = WGM * nN, gid = wgid / nig, fm = gid * WGM, gsz = (nM - fm) < WGM ? (nM - fm) : WGM;
        u.pm = fm + ((wgid % nig) % gsz); u.pn = (wgid % nig) / gsz; return true;
    }
    __device__ __forceinline__ void a_ready(const Unit&) const {}
    __device__ __forceinline__ void done(const Unit&) const {}
};

__device__ __forceinline__ unsigned cvt_pk_bf16(float lo, float hi) { unsigned r; asm volatile("v_cvt_pk_bf16_f32 %0, %1, %2" : "=v"(r) : "v"(lo), "v"(hi)); return r; }

template <class Epi, class Sched, bool ALIGN_EPI = false, bool SP2 = false>
__device__ __forceinline__ void gemm_phase(PG8_LAS unsigned char* lds, const Gemm g, const Sched& S, const Epi& E) {
    int tid = threadIdx.x; asm volatile("" : "+v"(tid));
    const int wid = __builtin_amdgcn_readfirstlane(tid >> 6), lane = tid & 63, wr = wid >> 2, wc = wid & 3, fr = lane & 15, fq = lane >> 4;
    const int K = g.K, nt = K / BK;
    unsigned voffA[2], voffB[2];
#pragma unroll
    for (int i = 0; i < 2; ++i) { int R, C; stage_rc(tid * 16 + i * 8192, R, C); const int Rb = Epi::PERM ? ((R & ~31) + perm32(R & 31)) : R;
        voffA[i] = (unsigned)(R * K + C) * 2u; voffB[i] = (unsigned)(Rb * K + C) * 2u; }
    const size_t kstep = (size_t)(BK * 2);
    const size_t hstep = (size_t)HALF * K * 2;
    const size_t tstep = 2 * hstep;
    const unsigned ldsw = (unsigned)wid * 1024u;
    const int aoff = lds_byte(wr * 64 + fr, fq * 8), boff = lds_byte(wc * 32 + fr, fq * 8);
#define PG8_SA(b, h) (((b) * 2 + (h)) * HTB)
#define PG8_SB(b, h) ((4 + (b) * 2 + (h)) * HTB)
#define PG8_STAGE(bufoff, gbase, voff) do { _Pragma("unroll") for (int _i = 0; _i < 2; ++_i) \
        __builtin_amdgcn_global_load_lds((const unsigned*)((const char*)(gbase) + (voff)[_i]), (PG8_LAS unsigned*)(lds + (bufoff) + ldsw + _i * 8192), 16, 0, 0); } while (0)
#define PG8_LDA(dst, b, h) do { _Pragma("unroll") for (int m = 0; m < 4; ++m) _Pragma("unroll") for (int k = 0; k < 2; ++k) dst[m][k] = *(const PG8_LAS bf16x8*)(lds + PG8_SA(b, h) + aoff + m * 2048 + k * 1024); } while (0)
#define PG8_LDB(dst, b, h) do { _Pragma("unroll") for (int n = 0; n < 2; ++n) _Pragma("unroll") for (int k = 0; k < 2; ++k) dst[n][k] = *(const PG8_LAS bf16x8*)(lds + PG8_SB(b, h) + boff + n * 2048 + k * 1024); } while (0)
#define PG8_MMA(ai, bj, At, Bt) do { __builtin_amdgcn_s_setprio(1); _Pragma("unroll") for (int m = 0; m < 4; ++m) _Pragma("unroll") for (int n = 0; n < 2; ++n) _Pragma("unroll") for (int k = 0; k < 2; ++k) \
        acc[ai][bj][m][n] = __builtin_amdgcn_mfma_f32_16x16x32_bf16(Bt[n][k], At[m][k], acc[ai][bj][m][n], 0, 0, 0); __builtin_amdgcn_s_setprio(0); } while (0)
#define PG8_WAIT_V(n) asm volatile("s_waitcnt vmcnt(" #n ")" ::: "memory")
#define PG8_WAIT_L(n) asm volatile("s_waitcnt lgkmcnt(" #n ")" ::: "memory")
#define PG8_BAR __builtin_amdgcn_s_barrier()
#define PG8_SCHED __builtin_amdgcn_sched_barrier(0)
    Unit cur, nxt; int ui = 0;
    if (!S.next(0, cur)) return;
    f32x4 acc[2][2][4][2];
#pragma unroll
    for (int a = 0; a < 2; ++a)
#pragma unroll
        for (int b = 0; b < 2; ++b)
#pragma unroll
            for (int m = 0; m < 4; ++m)
#pragma unroll
                for (int n = 0; n < 2; ++n) acc[a][b][m][n] = (f32x4){0.f, 0.f, 0.f, 0.f};
    bf16x8 At[4][2], B0[2][2], B1[2][2];
    const char* cA = (const char*)g.A + (size_t)cur.pm * tstep; const char* cB = (const char*)g.Bt + (size_t)cur.pn * tstep;
    S.a_ready(cur);
    if constexpr (SP2) {
        PG8_STAGE(PG8_SB(0, 0), cB, voffB); PG8_STAGE(PG8_SB(0, 1), cB + hstep, voffB); PG8_STAGE(PG8_SA(0, 0), cA, voffA); PG8_STAGE(PG8_SA(0, 1), cA + hstep, voffA);
        if (wr == 1) PG8_BAR;
        PG8_WAIT_V(2); PG8_BAR;
        PG8_STAGE(PG8_SB(1, 0), cB + kstep, voffB); PG8_STAGE(PG8_SA(1, 0), cA + kstep, voffA); PG8_STAGE(PG8_SB(1, 1), cB + hstep + kstep, voffB);
        PG8_WAIT_V(6); PG8_BAR;
    } else {
        PG8_STAGE(PG8_SB(0, 0), cB, voffB); PG8_STAGE(PG8_SA(0, 0), cA, voffA); PG8_STAGE(PG8_SB(0, 1), cB + hstep, voffB); PG8_STAGE(PG8_SA(0, 1), cA + hstep, voffA);
        if (wr == 1) PG8_BAR;
        PG8_WAIT_V(4); PG8_BAR;
        PG8_STAGE(PG8_SB(1, 0), cB + kstep, voffB); PG8_STAGE(PG8_SA(1, 0), cA + kstep, voffA); PG8_STAGE(PG8_SB(1, 1), cB + hstep + kstep, voffB);
        PG8_WAIT_V(6); PG8_BAR;
    }
    for (;;) {
        const bool has_next = S.next(ui + 1, nxt);
        const char* nA = has_next ? (const char*)g.A + (size_t)nxt.pm * tstep : cA; const char* nB = has_next ? (const char*)g.Bt + (size_t)nxt.pn * tstep : cB;
        for (int t = 0; t < nt; t += 2) {
            const bool last = (t == nt - 2);
            const char* a1 = cA + (size_t)(t + 1) * kstep;
            const char* a2 = last ? nA : cA + (size_t)(t + 2) * kstep; const char* b2 = last ? nB : cB + (size_t)(t + 2) * kstep;
            const char* a3 = a2 + kstep; const char* b3 = b2 + kstep;
            if (last && has_next) S.a_ready(nxt);
            if constexpr (SP2) {
            PG8_LDB(B0, 0, 0); PG8_LDB(B1, 0, 1); PG8_SCHED; PG8_LDA(At, 0, 0); PG8_STAGE(PG8_SA(1, 1), a1 + hstep, voffA);
            PG8_WAIT_V(8); PG8_WAIT_L(0); PG8_BAR; PG8_MMA(0, 0, At, B0); PG8_MMA(0, 1, At, B1); PG8_BAR; PG8_SCHED;
            PG8_LDA(At, 0, 1); PG8_STAGE(PG8_SB(0, 0), b2, voffB); PG8_STAGE(PG8_SB(0, 1), b2 + hstep, voffB); PG8_STAGE(PG8_SA(0, 0), a2, voffA);
            PG8_WAIT_V(8); PG8_WAIT_L(0); PG8_BAR; PG8_MMA(1, 0, At, B0); PG8_MMA(1, 1, At, B1); PG8_BAR; PG8_SCHED;
            PG8_LDB(B0, 1, 0); PG8_LDB(B1, 1, 1); PG8_SCHED; PG8_LDA(At, 1, 0); PG8_STAGE(PG8_SA(0, 1), a2 + hstep, voffA);
            PG8_WAIT_V(8); PG8_WAIT_L(0); PG8_BAR; PG8_MMA(0, 0, At, B0); PG8_MMA(0, 1, At, B1); PG8_BAR; PG8_SCHED;
            PG8_LDA(At, 1, 1); PG8_STAGE(PG8_SB(1, 0), b3, voffB); PG8_STAGE(PG8_SB(1, 1), b3 + hstep, voffB); PG8_STAGE(PG8_SA(1, 0), a3, voffA);
            PG8_WAIT_V(8); PG8_WAIT_L(0); PG8_BAR; PG8_MMA(1, 0, At, B0); PG8_MMA(1, 1, At, B1); PG8_BAR; PG8_SCHED;
            } else {
            PG8_LDB(B0, 0, 0); PG8_SCHED; PG8_LDA(At, 0, 0); PG8_STAGE(PG8_SA(1, 1), a1 + hstep, voffA);
            PG8_WAIT_L(8); PG8_BAR; PG8_WAIT_L(0); PG8_MMA(0, 0, At, B0); PG8_BAR; PG8_SCHED;
            PG8_LDB(B1, 0, 1); PG8_STAGE(PG8_SB(0, 0), b2, voffB);
            PG8_BAR; PG8_WAIT_L(0); PG8_MMA(0, 1, At, B1); PG8_BAR;
            PG8_LDA(At, 0, 1); PG8_STAGE(PG8_SA(0, 0), a2, voffA);
            PG8_BAR; PG8_WAIT_L(0); PG8_MMA(1, 0, At, B0); PG8_BAR; PG8_SCHED;
            PG8_STAGE(PG8_SB(0, 1), b2 + hstep, voffB);
            PG8_WAIT_V(6); PG8_BAR; PG8_MMA(1, 1, At, B1); PG8_BAR;
            PG8_LDB(B0, 1, 0); PG8_SCHED; PG8_LDA(At, 1, 0); PG8_STAGE(PG8_SA(0, 1), a2 + hstep, voffA);
            PG8_WAIT_L(8); PG8_BAR; PG8_WAIT_L(0); PG8_MMA(0, 0, At, B0); PG8_BAR; PG8_SCHED;
            PG8_LDB(B1, 1, 1); PG8_STAGE(PG8_SB(1, 0), b3, voffB);
            PG8_BAR; PG8_WAIT_L(0); PG8_MMA(0, 1, At, B1); PG8_BAR;
            PG8_LDA(At, 1, 1); PG8_STAGE(PG8_SA(1, 0), a3, voffA);
            PG8_BAR; PG8_WAIT_L(0); PG8_MMA(1, 0, At, B0); PG8_BAR; PG8_SCHED;
            PG8_STAGE(PG8_SB(1, 1), b3 + hstep, voffB);
            PG8_WAIT_V(6); PG8_BAR; PG8_MMA(1, 1, At, B1); PG8_BAR;
            }
        }
        if constexpr (ALIGN_EPI) { if (wr == 0) PG8_BAR; }
        if constexpr (!Epi::AFTER_DRAIN) { E(acc, cur, wr, wc, fr, fq); S.done(cur); }
        if (!has_next) break;
#pragma unroll
        for (int a = 0; a < 2; ++a)
#pragma unroll
            for (int b = 0; b < 2; ++b)
#pragma unroll
                for (int m = 0; m < 4; ++m)
#pragma unroll
                    for (int n = 0; n < 2; ++n) acc[a][b][m][n] = (f32x4){0.f, 0.f, 0.f, 0.f};
        cur = nxt; cA = nA; cB = nB; ++ui;
        if constexpr (ALIGN_EPI) { if (wr == 1) PG8_BAR; }
    }
    PG8_WAIT_V(0);
    if constexpr (!ALIGN_EPI) { if (wr == 0) PG8_BAR; }
    PG8_BAR;
    if constexpr (Epi::AFTER_DRAIN) { E.fused(acc, cur, wr, wc, fr, fq, lds, wid, lane); S.done(cur); }
#undef PG8_SA
#undef PG8_SB
#undef PG8_STAGE
#undef PG8_LDA
#undef PG8_LDB
#undef PG8_MMA
#undef PG8_WAIT_V
#undef PG8_WAIT_L
#undef PG8_BAR
#undef PG8_SCHED
}
}

constexpr int NB = 2, T = 8192, L = 256, D = 1024, TP = T + L, R = NB * TP;
constexpr int FF = 4096, NPROJ = 3104, NPROJ_PAD = 3328, NQKV = 1536, NCH = TP / 64;
constexpr float ALPHA = 1.4142135623730951f;
constexpr int LDS_BYTES = 147456;

typedef unsigned short bf16;
typedef float f32x4 __attribute__((ext_vector_type(4)));
typedef short bf16x8 __attribute__((ext_vector_type(8)));
typedef short s16x4 __attribute__((ext_vector_type(4)));
typedef unsigned u32x4 __attribute__((ext_vector_type(4)));
typedef unsigned u32x2 __attribute__((ext_vector_type(2)));

constexpr size_t OFF_WIN = 0;
constexpr size_t OFF_WOUT0 = OFF_WIN + (size_t)NPROJ_PAD * D * 2;
constexpr size_t OFF_W1_0 = OFF_WOUT0 + (size_t)D * D * 2;
constexpr size_t OFF_W2_0 = OFF_W1_0 + (size_t)FF * D * 2;
constexpr size_t OFF_WQKV = OFF_W2_0 + (size_t)FF * D * 2;
constexpr size_t OFF_WOUT1 = OFF_WQKV + (size_t)NQKV * D * 2;
constexpr size_t OFF_W1_1 = OFF_WOUT1 + (size_t)D * D * 2;
constexpr size_t OFF_W2_1 = OFF_W1_1 + (size_t)FF * D * 2;
constexpr size_t OFF_MOD = OFF_W2_1 + (size_t)FF * D * 2;
constexpr size_t OFF_ROPE = OFF_MOD + 2 * 3 * 6144 * 4;
constexpr size_t OFF_BAR = OFF_ROPE + 128 * 16 * 8;
constexpr size_t OFF_XBAR = OFF_BAR + 256;
constexpr size_t OFF_RST = OFF_XBAR + 16384;
constexpr size_t OFF_XCTX = OFF_RST + (size_t)3 * R * 2 * 4;
constexpr size_t OFF_DEC = OFF_XCTX + (size_t)NB * L * D * 4;
constexpr size_t OFF_H = OFF_DEC + (size_t)32 * NCH * 64 * 4;
constexpr size_t OFF_P = OFF_H + (size_t)R * D * 2;
constexpr size_t OFF_ST = OFF_P + (size_t)R * NPROJ * 2;
constexpr size_t WS_TOTAL = OFF_ST + (size_t)32 * NCH * 8192 * 2;
static_assert(WS_TOTAL <= 268435456, "workspace map exceeds 256 MiB");
static_assert(OFF_P + (size_t)R * FF * 2 <= WS_TOTAL, "MLP hidden overlay");

typedef float f32x2_t __attribute__((ext_vector_type(2)));
typedef __bf16 bf16x2_t __attribute__((ext_vector_type(2)));
__device__ __forceinline__ unsigned pk2(float lo, float hi) { const f32x2_t v = {lo, hi}; const bf16x2_t b = __builtin_convertvector(v, bf16x2_t); return __builtin_bit_cast(unsigned, b); }
__device__ __forceinline__ unsigned f2bf(float f) { return pk2(f, f) & 0xffffu; }
__device__ __forceinline__ float bf2f(unsigned h) { return __uint_as_float(h << 16); }
__device__ __forceinline__ float bflo(unsigned u) { return __uint_as_float(u << 16); }
__device__ __forceinline__ float bfhi(unsigned u) { return __uint_as_float(u & 0xffff0000u); }
__device__ __forceinline__ float quad_max(float x) {
    const unsigned u = __float_as_uint(x);
    const auto r = __builtin_amdgcn_permlane32_swap(u, u, false, false);
    const float m = fmaxf(__uint_as_float(r[0]), __uint_as_float(r[1]));
    const unsigned v = __float_as_uint(m);
    const auto q = __builtin_amdgcn_permlane16_swap(v, v, false, false);
    return fmaxf(__uint_as_float(q[0]), __uint_as_float(q[1]));
}
__device__ __forceinline__ float quad_sum(float x) {
    const unsigned u = __float_as_uint(x);
    const auto r = __builtin_amdgcn_permlane32_swap(u, u, false, false);
    const float m = __uint_as_float(r[0]) + __uint_as_float(r[1]);
    const unsigned v = __float_as_uint(m);
    const auto q = __builtin_amdgcn_permlane16_swap(v, v, false, false);
    return __uint_as_float(q[0]) + __uint_as_float(q[1]);
}
__device__ __forceinline__ float dpp_add(float v, int ctrl_sel) {
    const int u = __float_as_int(v);
    const int t = ctrl_sel == 0 ? __builtin_amdgcn_update_dpp(0, u, 0xB1, 0xF, 0xF, true) : ctrl_sel == 1 ? __builtin_amdgcn_update_dpp(0, u, 0x4E, 0xF, 0xF, true)
                : ctrl_sel == 2 ? __builtin_amdgcn_update_dpp(0, u, 0x141, 0xF, 0xF, true) : __builtin_amdgcn_update_dpp(0, u, 0x140, 0xF, 0xF, true);
    return v + __int_as_float(t);
}
__device__ __forceinline__ float wave_sum(float v) { v = dpp_add(v, 0); v = dpp_add(v, 1); v = dpp_add(v, 2); v = dpp_add(v, 3); return quad_sum(v); }
#define MFMA16(a, b, c) __builtin_amdgcn_mfma_f32_16x16x32_bf16((a), (b), (c), 0, 0, 0)

__device__ __forceinline__ size_t row_off(int r, bool& isc, int& b) { b = (r >= TP) ? 1 : 0; const int p = r - b * TP; isc = p < L; return isc ? (size_t)(b * L + p) * D : (size_t)(b * T + p - L) * D; }

template <int ACT> struct EpiStore {
    static constexpr bool PERM = true, AFTER_DRAIN = false;
    bf16* O; int ldc; int ncols;
    __device__ __forceinline__ void operator()(const pg8::f32x4 (&acc)[2][2][4][2], const pg8::Unit& u, int wr, int wc, int fr, int fq) const {
        const int row0 = u.pm * 256 + wr * 64 + fr, col0 = u.pn * 256 + wc * 32 + 8 * fq;
#pragma unroll
        for (int ai = 0; ai < 2; ++ai)
#pragma unroll
            for (int m = 0; m < 4; ++m) {
                bf16* rowp = O + (size_t)(row0 + ai * 128 + m * 16) * ldc;
#pragma unroll
                for (int bj = 0; bj < 2; ++bj) {
                    const int col = col0 + bj * 128;
                    pg8::f32x4 v0 = acc[ai][bj][m][0], v1 = acc[ai][bj][m][1];
                    if (ACT == 1) {
#pragma unroll
                        for (int i = 0; i < 4; ++i) { float a = fmaxf(v0[i], 0.f), b = fmaxf(v1[i], 0.f); v0[i] = a * a; v1[i] = b * b; }
                    }
                    u32x4 w; w.x = pg8::cvt_pk_bf16(v0[0], v0[1]); w.y = pg8::cvt_pk_bf16(v0[2], v0[3]); w.z = pg8::cvt_pk_bf16(v1[0], v1[1]); w.w = pg8::cvt_pk_bf16(v1[2], v1[3]);
                    if (col < ncols) *(u32x4*)(rowp + col) = w;
                }
            }
    }
};
template <int SRC, bool DST_FIN> struct EpiResid {
    static constexpr bool PERM = true, AFTER_DRAIN = false;
    const void* src_lat; const void* src_ctx; bf16* dst_lat; bf16* dst_ctx; bf16* dst_fin; const float* gate;
    const float* rst; const float* lg; const float* lb;
    __device__ __forceinline__ void operator()(const pg8::f32x4 (&acc)[2][2][4][2], const pg8::Unit& u, int wr, int wc, int fr, int fq) const {
        const int row0 = u.pm * 256 + wr * 64 + fr, col0 = u.pn * 256 + wc * 32 + 8 * fq;
#pragma unroll
        for (int ai = 0; ai < 2; ++ai)
#pragma unroll
            for (int m = 0; m < 4; ++m) {
                const int row = row0 + ai * 128 + m * 16;
                bool isc; int b; const size_t off = row_off(row, isc, b);
                const float* gt = gate + (isc ? 2 : b) * 6144;
                float mean = 0.f, rstd = 1.f; if (SRC == 1) { mean = rst[2 * row]; rstd = rst[2 * row + 1]; }
#pragma unroll
                for (int bj = 0; bj < 2; ++bj) {
                    const int col = col0 + bj * 128;
                    f32x4 x0, x1;
                    if (SRC == 0) { const float* sp = (const float*)(isc ? src_ctx : src_lat) + off + col; x0 = *(const f32x4*)sp; x1 = *(const f32x4*)(sp + 4); }
                    else { const u32x4 w = *(const u32x4*)((const bf16*)(isc ? src_ctx : src_lat) + off + col);
                        x0 = (f32x4){bflo(w.x), bfhi(w.x), bflo(w.y), bfhi(w.y)}; x1 = (f32x4){bflo(w.z), bfhi(w.z), bflo(w.w), bfhi(w.w)};
                        x0 = (x0 - mean) * rstd * *(const f32x4*)(lg + col) + *(const f32x4*)(lb + col); x1 = (x1 - mean) * rstd * *(const f32x4*)(lg + col + 4) + *(const f32x4*)(lb + col + 4); }
                    const f32x4 g0 = *(const f32x4*)(gt + col), g1 = *(const f32x4*)(gt + col + 4);
                    const pg8::f32x4 a0 = acc[ai][bj][m][0], a1 = acc[ai][bj][m][1];
                    u32x4 o; o.x = pk2(ALPHA * x0.x + g0.x * a0[0], ALPHA * x0.y + g0.y * a0[1]); o.y = pk2(ALPHA * x0.z + g0.z * a0[2], ALPHA * x0.w + g0.w * a0[3]);
                    o.z = pk2(ALPHA * x1.x + g1.x * a1[0], ALPHA * x1.y + g1.y * a1[1]); o.w = pk2(ALPHA * x1.z + g1.z * a1[2], ALPHA * x1.w + g1.w * a1[3]);
                    bf16* dp = DST_FIN ? dst_fin + (size_t)row * D + col : (isc ? dst_ctx : dst_lat) + off + col;
                    *(u32x4*)dp = o;
                }
            }
    }
};

__device__ __forceinline__ void transpose_item(const float* __restrict__ W, int K, int N, bf16* WT, float* scr, int item, int lane) {
    const int nblk = N / 32, kb = item / nblk, nb = item % nblk, k0 = 64 * kb, n0 = 32 * nb;
#pragma unroll 8
    for (int i = 0; i < 32; ++i) { const int kk = 2 * i + (lane >> 5); scr[kk * 33 + (lane & 31)] = W[(size_t)(k0 + kk) * N + n0 + (lane & 31)]; }
    asm volatile("s_waitcnt lgkmcnt(0)" ::: "memory");
    const int c = lane & 7;
#pragma unroll
    for (int j = 0; j < 4; ++j) { const int n = (lane >> 3) + 8 * j; const float* s = scr + (8 * c) * 33 + n;
        u32x4 o; o.x = pk2(s[0 * 33], s[1 * 33]); o.y = pk2(s[2 * 33], s[3 * 33]); o.z = pk2(s[4 * 33], s[5 * 33]); o.w = pk2(s[6 * 33], s[7 * 33]);
        *(u32x4*)(WT + (size_t)(n0 + n) * K + k0 + 8 * c) = o; }
    asm volatile("s_waitcnt lgkmcnt(0)" ::: "memory");
}

template <bool LAST, bool SKIPCTX>
__device__ __forceinline__ void ln_phase(float* rst, const bf16* vlat, const bf16* vctx, const bf16* vfin, float* outp, const float* __restrict__ g, const float* __restrict__ bt, const float* __restrict__ modn, bf16* H, int gw, int NGW, int lane) {
    int r = gw;
    if (SKIPCTX) { while (r < R) { const int p = r >= TP ? r - TP : r; if (p >= L) break; r += NGW; } }
    u32x4 vn[2];
    if (r < R) { bool isc; int b; const size_t off = row_off(r, isc, b); const bf16* xr = LAST ? vfin + (size_t)r * D : (isc ? vctx : vlat) + off;
#pragma unroll
        for (int j = 0; j < 2; ++j) vn[j] = *(const u32x4*)(xr + lane * 8 + 512 * j); }
    while (r < R) {
        bool isc; int b; const size_t off = row_off(r, isc, b);
        float v[16];
#pragma unroll
        for (int j = 0; j < 2; ++j)
#pragma unroll
            for (int i = 0; i < 4; ++i) { v[j * 8 + 2 * i] = bflo(vn[j][i]); v[j * 8 + 2 * i + 1] = bfhi(vn[j][i]); }
        int rn = r + NGW;
        if (SKIPCTX) { while (rn < R) { const int p = rn >= TP ? rn - TP : rn; if (p >= L) break; rn += NGW; } }
        if (rn < R) { bool isc2; int b2; const size_t off2 = row_off(rn, isc2, b2); const bf16* xr2 = LAST ? vfin + (size_t)rn * D : (isc2 ? vctx : vlat) + off2;
#pragma unroll
            for (int j = 0; j < 2; ++j) vn[j] = *(const u32x4*)(xr2 + lane * 8 + 512 * j); }
        float s = 0.f;
#pragma unroll
        for (int i = 0; i < 16; ++i) s += v[i];
        const float mean = wave_sum(s) * (1.f / D); float s2 = 0.f;
#pragma unroll
        for (int i = 0; i < 16; ++i) { v[i] -= mean; s2 += v[i] * v[i]; }
        const float rstd = 1.f / sqrtf(wave_sum(s2) * (1.f / D) + 1e-5f);
        const float* md = modn + (isc ? 2 : b) * 6144;
        if (!LAST && lane == 0) { rst[2 * r] = mean; rst[2 * r + 1] = rstd; }
#pragma unroll
        for (int j = 0; j < 2; ++j) {
            const int idx = lane * 8 + 512 * j;
            float y[8];
#pragma unroll
            for (int q = 0; q < 2; ++q) { const f32x4 gg = *(const f32x4*)(g + idx + 4 * q), bb = *(const f32x4*)(bt + idx + 4 * q);
#pragma unroll
                for (int i = 0; i < 4; ++i) y[q * 4 + i] = v[j * 8 + q * 4 + i] * rstd * gg[i] + bb[i]; }
            if (LAST) { *(f32x4*)(outp + off + idx) = (f32x4){y[0], y[1], y[2], y[3]}; *(f32x4*)(outp + off + idx + 4) = (f32x4){y[4], y[5], y[6], y[7]}; }
            else {
                float h[8];
#pragma unroll
                for (int q = 0; q < 2; ++q) { const f32x4 sh = *(const f32x4*)(md + idx + 4 * q), sc = *(const f32x4*)(md + 1024 + idx + 4 * q);
#pragma unroll
                    for (int i = 0; i < 4; ++i) h[q * 4 + i] = y[q * 4 + i] * (sc[i] + 1.f) + sh[i]; }
                u32x4 o; o.x = pk2(h[0], h[1]); o.y = pk2(h[2], h[3]); o.z = pk2(h[4], h[5]); o.w = pk2(h[6], h[7]);
                *(u32x4*)(H + (size_t)r * D + idx) = o;
            }
        }
        r = rn;
    }
}

__device__ __forceinline__ float log_sigmoid(float z) { return fminf(z, 0.f) - __logf(1.f + __expf(-fabsf(z))); }

constexpr int CS = 65;
constexpr float QSC = 0.125f * 1.4426950408889634f;
struct GatePre { u32x2 lr; f32x4 w; float bias; };
__device__ __forceinline__ GatePre gate_prefetch(int g, int h, const bf16* Pr, const float* gkw, const float* gkb, int tid) {
    GatePre p; p.lr = (u32x2){0u, 0u}; p.w = (f32x4){0.f, 0.f, 0.f, 0.f}; p.bias = 0.f;
    if (g) { const int c = tid >> 3, part = tid & 7;
        p.lr = *(const u32x2*)(Pr + (size_t)c * NPROJ + 3072 + part * 4);
        const int idx = tid * 4, dir = idx >> 10, r = (idx >> 6) & 15, d = idx & 63;
        p.w = *(const f32x4*)(gkw + (dir * 16 + r) * 256 + h * 64 + d);
        if (tid < 128) p.bias = gkb[(tid >> 6) * 256 + h * 64 + (tid & 63)]; }
    return p;
}
__device__ __forceinline__ void fill_cum3(float* cf, float* cb, float* lrs, float* wl, int g, int h, const GatePre& gp, const float* theta, int tid) {
    if (g == 0) {
        const float lgf = log1pf(-expf(theta[h])), lgb = log1pf(-expf(theta[4 + h]));
        for (int i = tid; i < 4096; i += 512) { const int c = i >> 6, d = i & 63; cf[c * CS + d] = (float)(c + 1) * lgf; cb[c * CS + d] = (float)(64 - c) * lgb; }
        __syncthreads();
        return;
    }
    { const int c = tid >> 3, part = tid & 7;
      float* lp = lrs + c * 33 + part * 4; lp[0] = bflo(gp.lr.x); lp[1] = bfhi(gp.lr.x); lp[2] = bflo(gp.lr.y); lp[3] = bfhi(gp.lr.y);
      *(f32x4*)(wl + tid * 4) = gp.w;
      if (tid < 128) wl[2048 + tid] = gp.bias; }
    __syncthreads();
    { const int c = tid >> 3, dg = tid & 7;
#pragma unroll
      for (int dir = 0; dir < 2; ++dir) {
          f32x4 za = *(const f32x4*)(wl + 2048 + dir * 64 + dg * 8), zb = *(const f32x4*)(wl + 2048 + dir * 64 + dg * 8 + 4);
#pragma unroll
          for (int r = 0; r < 16; ++r) { const float lv = lrs[c * 33 + dir * 16 + r];
              za += lv * *(const f32x4*)(wl + (dir * 16 + r) * 64 + dg * 8); zb += lv * *(const f32x4*)(wl + (dir * 16 + r) * 64 + dg * 8 + 4); }
          float* dst = (dir ? cb : cf) + c * CS + dg * 8;
#pragma unroll
          for (int j = 0; j < 4; ++j) { dst[j] = log_sigmoid(za[j]) * (1.f / 16.f); dst[4 + j] = log_sigmoid(zb[j]) * (1.f / 16.f); } } }
    __syncthreads();
    if (tid < 128) {
        const int dir = tid >> 6; float* arr = (dir ? cb : cf) + (tid & 63);
        float run = 0.f;
#pragma unroll
        for (int hh = 0; hh < 2; ++hh) {
            float v[32];
            const int base = dir ? (1 - hh) * 32 : hh * 32;
#pragma unroll
            for (int c = 0; c < 32; ++c) v[c] = arr[(base + c) * CS];
            if (dir == 0) {
#pragma unroll
                for (int c = 0; c < 32; ++c) { run += v[c]; arr[(base + c) * CS] = run; }
            } else {
#pragma unroll
                for (int c = 31; c >= 0; --c) { run += v[c]; arr[(base + c) * CS] = run; }
            }
        }
    }
    __syncthreads();
}

__device__ __forceinline__ void fast_bar(unsigned* ctr, unsigned& target) {
    asm volatile("s_waitcnt vmcnt(0)" ::: "memory");
    __syncthreads();
    target += gridDim.x;
    if (threadIdx.x == 0) {
        __builtin_amdgcn_fence(__ATOMIC_RELEASE, "agent");
        asm volatile("s_waitcnt vmcnt(0)" ::: "memory");
        __hip_atomic_fetch_add(ctr, 1u, __ATOMIC_RELAXED, __HIP_MEMORY_SCOPE_AGENT);
        while (__hip_atomic_load(ctr, __ATOMIC_RELAXED, __HIP_MEMORY_SCOPE_AGENT) < target) __builtin_amdgcn_s_sleep(1);
        __builtin_amdgcn_fence(__ATOMIC_ACQUIRE, "agent");
        asm volatile("s_waitcnt vmcnt(0)" ::: "memory");
    }
    __syncthreads();
}
#define RLX_AGENT __ATOMIC_RELAXED, __HIP_MEMORY_SCOPE_AGENT
#define XB_TMO      128
#define XB_XCNT(j)  (256  + 64 * (j))
#define XB_XSUB(j)  (1280 + 64 * (j))
#define XB_XGEN(j)  (2304 + 64 * (j))
#define XB_TOP      3328
#define XB_TOPGEN   3392
#define XCD_BAR_WORDS 3456
#define XB_SPIN_CAP (1u << 18)

__device__ __forceinline__ unsigned xb_ld(unsigned* p)              { return __hip_atomic_load(p, __ATOMIC_RELAXED, __HIP_MEMORY_SCOPE_AGENT); }
__device__ __forceinline__ unsigned xb_add(unsigned* p, unsigned v) { return __hip_atomic_fetch_add(p, v, __ATOMIC_RELAXED, __HIP_MEMORY_SCOPE_AGENT); }
__device__ __forceinline__ unsigned xb_xcc_id() { return (unsigned)__builtin_amdgcn_s_getreg((3 << 11) | 20) & 0xFu; }
#define XB_SPIN(cond, bar) do { unsigned _sp = 0; while (cond) { __builtin_amdgcn_s_sleep(1); \
    if ((++_sp & 255u) == 0u) { if (xb_ld(&(bar)[XB_TMO])) break; if (_sp > XB_SPIN_CAP) { atomicAdd(&(bar)[XB_TMO], 1u); break; } } } } while (0)

struct XcdBarrier {
    unsigned* bar; unsigned x;
    volatile unsigned* st;
};

__device__ __forceinline__ XcdBarrier xcd_barrier_post(unsigned* bar, volatile unsigned* st) {
    XcdBarrier b; b.bar = bar; b.x = xb_xcc_id(); b.st = st;
    if (threadIdx.x == 0) (void)xb_add(&bar[XB_XCNT(b.x)], 1u);
    return b;
}
__device__ __forceinline__ void xcd_barrier_complete(unsigned* bar, unsigned x, unsigned& nloc, unsigned& nx) {
    const unsigned G = gridDim.x * gridDim.y * gridDim.z;
    unsigned sum, cnt, mine, sp = 0u;
    for (;;) {
        sum = 0u; cnt = 0u; mine = 0u;
#pragma unroll
        for (unsigned j = 0; j < 16; ++j) { const unsigned c = xb_ld(&bar[XB_XCNT(j)]); sum += c; cnt += (c > 0u) ? 1u : 0u; mine = (j == x) ? c : mine; }
        if (sum == G) break;
        __builtin_amdgcn_s_sleep(1);
        if ((++sp & 255u) == 0u) { if (xb_ld(&bar[XB_TMO])) break; if (sp > XB_SPIN_CAP) { atomicAdd(&bar[XB_TMO], 1u); break; } }
    }
    nloc = mine > 0u ? mine : 1u; nx = cnt > 0u ? cnt : 1u;
}

__device__ __forceinline__ void xcd_barrier(const XcdBarrier& b) {
    asm volatile("s_waitcnt vmcnt(0)" ::: "memory");
    __syncthreads();
    if (threadIdx.x == 0) {
        unsigned* bar = b.bar;
        __builtin_amdgcn_s_waitcnt(0);
        unsigned nloc = b.st[0], nx = b.st[1];
        if (nloc == 0u) { xcd_barrier_complete(bar, b.x, nloc, nx); b.st[0] = nloc; b.st[1] = nx; }
        const unsigned old = xb_add(&bar[XB_XSUB(b.x)], 1u);
        const unsigned gen = old / nloc;
        if (old + 1u == (gen + 1u) * nloc) {
            __builtin_amdgcn_fence(__ATOMIC_RELEASE, "agent");
            asm volatile("s_waitcnt vmcnt(0)" ::: "memory");
            const unsigned og = xb_add(&bar[XB_TOP], 1u);
            const unsigned tg = og / nx;
            if (og + 1u == (tg + 1u) * nx) xb_add(&bar[XB_TOPGEN], 1u);
            else XB_SPIN(xb_ld(&bar[XB_TOPGEN]) == tg, bar);
            __builtin_amdgcn_fence(__ATOMIC_ACQUIRE, "agent");
            xb_add(&bar[XB_XGEN(b.x)], 1u);
            asm volatile("s_waitcnt vmcnt(0)" ::: "memory");
        } else {
            XB_SPIN(xb_ld(&bar[XB_XGEN(b.x)]) == gen, bar);
            __builtin_amdgcn_fence(__ATOMIC_ACQUIRE, "agent");
            asm volatile("s_waitcnt vmcnt(0)" ::: "memory");
        }
    }
    __syncthreads();
}

struct LatOrder {
    pg8::StaticOrder S;
    __device__ void init(int N, int G, int c) { S.init(NB * T, N, G, c); }
    __device__ bool next(int i, pg8::Unit& u) const { if (!S.next(i, u)) return false; u.pm = u.pm + 1 + (u.pm >= 32 ? 1 : 0); return true; }
    __device__ __forceinline__ void a_ready(const pg8::Unit&) const {}
    __device__ __forceinline__ void done(const pg8::Unit&) const {}
};
#ifndef PROBE_SEL
#define PROBE_SEL 0
#endif
#ifndef PROBE_MUL
#define PROBE_MUL 3
#endif
#define PACC_DECL unsigned long long pacc = 0, pacc_t0 = 0; (void)pacc; (void)pacc_t0;
#define PACC_BEGIN(k) if (PROBE_SEL == (k)) pacc_t0 = __builtin_amdgcn_s_memrealtime();
#define PACC_END(k) if (PROBE_SEL == (k)) pacc += __builtin_amdgcn_s_memrealtime() - pacc_t0;
#define PACC_SLEEP() if (PROBE_SEL >= 40 && PROBE_SEL < 60) { const unsigned long long t1 = __builtin_amdgcn_s_memrealtime(), dt = pacc * PROBE_MUL; while (__builtin_amdgcn_s_memrealtime() - t1 < dt) __builtin_amdgcn_s_sleep(8); }
#define PROBE_BEGIN(k) unsigned long long pt0_##k = 0; if (PROBE_SEL == (k)) pt0_##k = __builtin_amdgcn_s_memrealtime();
#define PROBE_END(k) if (PROBE_SEL == (k)) { const unsigned long long t1 = __builtin_amdgcn_s_memrealtime(), dt = (t1 - pt0_##k) * PROBE_MUL; while (__builtin_amdgcn_s_memrealtime() - t1 < dt) __builtin_amdgcn_s_sleep(8); }


template <int XT, int YT>
__device__ __forceinline__ void frag_gemm(pg8::f32x4 (&acc)[XT][YT], const bf16* X, int ldx, const bf16* Y, int ldy, int k0, int k1, int l15, int quad) {
#pragma unroll 4
    for (int k = k0; k < k1; k += 32) {
        bf16x8 xf[XT], yf[YT];
#pragma unroll
        for (int i = 0; i < XT; ++i) xf[i] = *(const bf16x8*)(X + (size_t)(i * 16 + l15) * ldx + k + quad * 8);
#pragma unroll
        for (int j = 0; j < YT; ++j) yf[j] = *(const bf16x8*)(Y + (size_t)(j * 16 + l15) * ldy + k + quad * 8);
#pragma unroll
        for (int i = 0; i < XT; ++i)
#pragma unroll
            for (int j = 0; j < YT; ++j) acc[i][j] = MFMA16(xf[i], yf[j], acc[i][j]);
    }
}
template <bool SRC_LN>
__device__ __forceinline__ void ctx_resid_tiles(const bf16* A, const bf16* Bt, int K, const void* src_ctx, bf16* dst_ctx, const float* gate_ctx, const float* rst, const float* lg, const float* lb, float* part, int bid, int G, int tid, int wave, int l15, int quad) {
    for (int t = bid; t < 256; t += G) {
        const int rt = t >> 5, c0 = (t & 31) * 32, b = rt >> 2, p0 = (rt & 3) * 64, r0 = b * TP + p0;
        pg8::f32x4 acc[4][2];
#pragma unroll
        for (int i = 0; i < 4; ++i)
#pragma unroll
            for (int j = 0; j < 2; ++j) acc[i][j] = (pg8::f32x4){0.f, 0.f, 0.f, 0.f};
        const int ksl = K >> 3;
        frag_gemm<4, 2>(acc, A + (size_t)r0 * K, K, Bt + (size_t)c0 * K, K, wave * ksl, (wave + 1) * ksl, l15, quad);
        float* pw = part + wave * 2048;
#pragma unroll
        for (int i = 0; i < 4; ++i)
#pragma unroll
            for (int j = 0; j < 2; ++j)
#pragma unroll
                for (int rg = 0; rg < 4; ++rg) pw[(i * 16 + quad * 4 + rg) * 32 + j * 16 + l15] = acc[i][j][rg];
        __syncthreads();
        { const int row = tid >> 3, c4 = (tid & 7) * 4;
          f32x4 sum = *(const f32x4*)(part + row * 32 + c4);
#pragma unroll
          for (int w = 1; w < 8; ++w) sum += *(const f32x4*)(part + w * 2048 + row * 32 + c4);
          const size_t off = (size_t)(b * L + p0 + row) * D + c0 + c4;
          f32x4 x4; const f32x4 g4 = *(const f32x4*)(gate_ctx + c0 + c4);
          if (!SRC_LN) x4 = *(const f32x4*)((const float*)src_ctx + off);
          else { const int rU = r0 + row; const u32x2 w = *(const u32x2*)((const bf16*)src_ctx + off); x4 = (f32x4){bflo(w.x), bfhi(w.x), bflo(w.y), bfhi(w.y)};
              x4 = (x4 - rst[2 * rU]) * rst[2 * rU + 1] * *(const f32x4*)(lg + c0 + c4) + *(const f32x4*)(lb + c0 + c4); }
          const f32x4 vv = x4 * ALPHA + g4 * sum; u32x2 o; o.x = pk2(vv.x, vv.y); o.y = pk2(vv.z, vv.w);
          *(u32x2*)(dst_ctx + off) = o; }
        __syncthreads();
    }
}
__device__ __forceinline__ void ctx_up_tiles(const bf16* A, const bf16* Bt, bf16* O, int bid, int G, int wave, int l15, int quad) {
    for (int t = bid; t < 256; t += G) {
        const int rt = t >> 5, c0 = (t & 31) * 128 + (wave & 3) * 32, b = rt >> 2, r0 = b * TP + (rt & 3) * 64 + (wave >> 2) * 32;
        pg8::f32x4 acc[2][2];
#pragma unroll
        for (int i = 0; i < 2; ++i)
#pragma unroll
            for (int j = 0; j < 2; ++j) acc[i][j] = (pg8::f32x4){0.f, 0.f, 0.f, 0.f};
        frag_gemm<2, 2>(acc, Bt + (size_t)c0 * D, D, A + (size_t)r0 * D, D, 0, D, l15, quad);
#pragma unroll
        for (int i = 0; i < 2; ++i)
#pragma unroll
            for (int j = 0; j < 2; ++j) { float v[4];
#pragma unroll
                for (int rg = 0; rg < 4; ++rg) { const float a_ = fmaxf(acc[i][j][rg], 0.f); v[rg] = a_ * a_; }
                u32x2 o; o.x = pk2(v[0], v[1]); o.y = pk2(v[2], v[3]);
                *(u32x2*)(O + (size_t)(r0 + j * 16 + l15) * FF + c0 + i * 16 + quad * 4) = o; }
    }
}

template <int ACT>
__device__ __forceinline__ void ctx_ksplit_tiles(const bf16* A, const bf16* Bt, bf16* O, int ldo, int ntn, int ncols, float* part, int bid, int G, int tid, int wave, int l15, int quad) {
    for (int t = bid; t < 8 * ntn; t += G) {
        const int rt = t / ntn, c0 = (t % ntn) * 64, b = rt >> 2, r0 = b * TP + (rt & 3) * 64;
        pg8::f32x4 acc[4][4];
#pragma unroll
        for (int i = 0; i < 4; ++i)
#pragma unroll
            for (int j = 0; j < 4; ++j) acc[i][j] = (pg8::f32x4){0.f, 0.f, 0.f, 0.f};
        frag_gemm<4, 4>(acc, A + (size_t)r0 * D, D, Bt + (size_t)c0 * D, D, wave * 128, (wave + 1) * 128, l15, quad);
        float* pw = part + wave * 4096;
#pragma unroll
        for (int i = 0; i < 4; ++i)
#pragma unroll
            for (int j = 0; j < 4; ++j)
#pragma unroll
                for (int rg = 0; rg < 4; ++rg) pw[(i * 16 + quad * 4 + rg) * 64 + j * 16 + l15] = acc[i][j][rg];
        __syncthreads();
        { const int row = tid >> 3, c8 = (tid & 7) * 8;
          f32x4 s0 = *(const f32x4*)(part + row * 64 + c8), s1 = *(const f32x4*)(part + row * 64 + c8 + 4);
#pragma unroll
          for (int w = 1; w < 8; ++w) { s0 += *(const f32x4*)(part + w * 4096 + row * 64 + c8); s1 += *(const f32x4*)(part + w * 4096 + row * 64 + c8 + 4); }
          if (ACT == 1) {
#pragma unroll
              for (int k = 0; k < 4; ++k) { float a_ = fmaxf(s0[k], 0.f), b_ = fmaxf(s1[k], 0.f); s0[k] = a_ * a_; s1[k] = b_ * b_; } }
          u32x4 o; o.x = pk2(s0.x, s0.y); o.y = pk2(s0.z, s0.w); o.z = pk2(s1.x, s1.y); o.w = pk2(s1.z, s1.w);
          const int col = c0 + c8;
          if (col < ncols) *(u32x4*)(O + (size_t)(r0 + row) * ldo + col) = o; }
        __syncthreads();
    }
}

struct Args { const float* in[19]; float* out; unsigned char* ws; };

__global__ void __launch_bounds__(512, 2) fwd_kernel(Args a) {
    extern __shared__ __attribute__((aligned(16))) unsigned char lds[];
    cg::grid_group grid = cg::this_grid();
    const int G = gridDim.x, bid = blockIdx.x, NGW = G * 8;
#define IDS int tid = threadIdx.x; asm volatile("" : "+v"(tid)); const int lane = tid & 63, wave = __builtin_amdgcn_readfirstlane(tid >> 6), quad = lane >> 4, l15 = lane & 15, gw = bid * 8 + wave; (void)quad; (void)l15; (void)gw; (void)lane;
#define xin (a.in[0])
#define cvec (a.in[1])
#define ctx (a.in[2])
#define cctx (a.in[3])
#define w_mod (a.in[4])
#define b_mod (a.in[5])
#define ln_g (a.in[6])
#define ln_b (a.in[7])
#define theta (a.in[11])
#define gkw (a.in[12])
#define gkb (a.in[13])
#define normg (a.in[14])
#define sink (a.in[17])
#define WIN_T ((bf16*)(a.ws + OFF_WIN))
#define WOUT0_T ((bf16*)(a.ws + OFF_WOUT0))
#define W1_0_T ((bf16*)(a.ws + OFF_W1_0))
#define W2_0_T ((bf16*)(a.ws + OFF_W2_0))
#define WQKV_T ((bf16*)(a.ws + OFF_WQKV))
#define WOUT1_T ((bf16*)(a.ws + OFF_WOUT1))
#define W1_1_T ((bf16*)(a.ws + OFF_W1_1))
#define W2_1_T ((bf16*)(a.ws + OFF_W2_1))
#define mod ((float*)(a.ws + OFF_MOD))
#define rope ((float*)(a.ws + OFF_ROPE))
#define xctx ((float*)(a.ws + OFF_XCTX))
#define DEC ((float*)(a.ws + OFF_DEC))
#define H ((bf16*)(a.ws + OFF_H))
#define P ((bf16*)(a.ws + OFF_P))
#define ST ((bf16*)(a.ws + OFF_ST))
#define xlat (a.out)
#define RST(i) ((float*)(a.ws + OFF_RST) + (size_t)(i) * R * 2)
#define VLAT ((bf16*)a.out)
#define VCTX ((bf16*)(a.ws + OFF_XCTX))

#define LATE_ITEMS 9472
#define LATE_CHUNK 16
#define DRAIN_LATE(scr_, maxc_) do { int nclaim_ = 0; unsigned* qc_ = (unsigned*)(a.ws + OFF_XBAR) + 3584; volatile unsigned* qw_ = (volatile unsigned*)(lds + 131072 + 1024); \
        for (;;) { if (nclaim_++ >= (maxc_)) break; if (tid == 0) qw_[0] = __hip_atomic_fetch_add(qc_, (unsigned)LATE_CHUNK, __ATOMIC_RELAXED, __HIP_MEMORY_SCOPE_AGENT);     \
            __syncthreads(); const int base_ = (int)__builtin_amdgcn_readfirstlane(qw_[0]); __syncthreads(); \
            if (base_ >= LATE_ITEMS) break; \
            for (int k_ = wave; k_ < LATE_CHUNK; k_ += 8) { int r_ = base_ + k_; if (r_ >= LATE_ITEMS) break; \
                if (r_ < 2048) { transpose_item(a.in[8], 1024, FF, W1_0_T, (scr_), r_, lane); continue; } r_ -= 2048; \
                if (r_ < 2048) { transpose_item(a.in[9], FF, 1024, W2_0_T, (scr_), r_, lane); continue; } r_ -= 2048; \
                if (r_ < 768) { transpose_item(a.in[16], 1024, NQKV, WQKV_T, (scr_), r_, lane); continue; } r_ -= 768; \
                if (r_ < 512) { transpose_item(a.in[18], 1024, 1024, WOUT1_T, (scr_), r_, lane); continue; } r_ -= 512; \
                if (r_ < 2048) { transpose_item(a.in[8] + (size_t)1024 * FF, 1024, FF, W1_1_T, (scr_), r_, lane); continue; } r_ -= 2048; \
                transpose_item(a.in[9] + (size_t)FF * 1024, FF, 1024, W2_1_T, (scr_), r_, lane); } } } while (0)
    PG8_LAS unsigned char* ldsg = (PG8_LAS unsigned char*)lds;
    unsigned* barw = (unsigned*)(a.ws + OFF_BAR); unsigned bar_target = 0u; (void)barw; (void)bar_target;
    unsigned* xbw = (unsigned*)(a.ws + OFF_XBAR);
    volatile unsigned* xst = (volatile unsigned*)(lds + 131072 + 512);
    if (threadIdx.x == 0) { xst[0] = 0u; xst[1] = 0u; }
    XcdBarrier xbar = xcd_barrier_post(xbw, xst);
    if (a.ws == nullptr) grid.sync();

PROBE_BEGIN(1)
    { IDS
        float* sl = (float*)lds; float* red = (float*)(lds + 12288);
        for (int item = bid; item < 192; item += G) {
            for (int i = tid; i < 3072; i += 512) { const int j = i >> 10, k = i & 1023; const float v = (j < 2) ? cvec[j * 1024 + k] : cctx[k]; sl[i] = v / (1.f + expf(-v)); }
            __syncthreads();
            const int layer = item / 96, n0 = (item % 96) * 64;
            const float* W = w_mod + (size_t)layer * 1024 * 6144 + n0 + lane;
            float a0 = 0.f, a1 = 0.f, a2 = 0.f; const int k0 = wave * 128;
#pragma unroll 8
            for (int kk = 0; kk < 128; ++kk) { const int k = k0 + kk; const float w = W[(size_t)k * 6144]; a0 += sl[k] * w; a1 += sl[1024 + k] * w; a2 += sl[2048 + k] * w; }
            red[(wave * 3 + 0) * 64 + lane] = a0; red[(wave * 3 + 1) * 64 + lane] = a1; red[(wave * 3 + 2) * 64 + lane] = a2;
            __syncthreads();
            if (tid < 192) { const int j = tid >> 6, col = tid & 63; float s = b_mod[layer * 6144 + n0 + col];
#pragma unroll
                for (int w = 0; w < 8; ++w) s += red[(w * 3 + j) * 64 + col];
                mod[(layer * 3 + j) * 6144 + n0 + col] = s; }
            __syncthreads();
        }
        if (bid == G - 1 && tid < 16) {
            double f = 1.0; for (int i = 0; i < tid; ++i) f *= 0.56234132519034908;
            const double x2 = f * f; double cs = 1.0, sn = f, tc = 1.0, ts = f;
            for (int n = 1; n <= 12; ++n) { tc *= -x2 / (double)((2 * n - 1) * (2 * n)); cs += tc; ts *= -x2 / (double)((2 * n) * (2 * n + 1)); sn += ts; }
            double c = 1.0, s = 0.0;
            for (int p = 0; p < 128; ++p) { rope[(p * 16 + tid) * 2] = (float)c; rope[(p * 16 + tid) * 2 + 1] = (float)s; const double nc = c * cs - s * sn; s = s * cs + c * sn; c = nc; }
        }
        float* scr = (float*)(lds + 32768 + wave * 8448);
        for (int it = gw; it < 2064; it += NGW) {
            int r = it;
            if (r < 1552) { transpose_item(a.in[10], 1024, NPROJ, WIN_T, scr, r, lane); continue; } r -= 1552;
            transpose_item(a.in[15], 1024, 1024, WOUT0_T, scr, r, lane);
        }
        { u32x4* z = (u32x4*)(WIN_T + (size_t)NPROJ * D); const u32x4 zero = {0u, 0u, 0u, 0u};
          for (int i = bid * 512 + tid; i < (NPROJ_PAD - NPROJ) * D / 8; i += G * 512) z[i] = zero; }
    }
PROBE_END(1)
    xcd_barrier(xbar);


PROBE_BEGIN(2)
    { IDS
    for (int r = gw; r < R; r += 2 * NGW) {
        const int r2 = r + NGW; const bool has2 = r2 < R;
        bool isc, isc2; int b, b2; const size_t off = row_off(r, isc, b), off2 = row_off(has2 ? r2 : r, isc2, b2);
        const float* xr = (isc ? ctx : xin) + off; const float* md = mod + (isc ? 2 : b) * 6144;
        const float* xr2 = (isc2 ? ctx : xin) + off2; const float* md2 = mod + (isc2 ? 2 : b2) * 6144;
        f32x4 va[4], vb[4];
#pragma unroll
        for (int j = 0; j < 4; ++j) { va[j] = *(const f32x4*)(xr + lane * 4 + 256 * j); vb[j] = *(const f32x4*)(xr2 + lane * 4 + 256 * j); }
#pragma unroll
        for (int j = 0; j < 4; ++j) {
            const int idx = lane * 4 + 256 * j;
            { const f32x4 sh = *(const f32x4*)(md + idx), sc = *(const f32x4*)(md + 1024 + idx);
              const f32x4 h = va[j] * (sc + 1.f) + sh; u32x2 o; o.x = pk2(h.x, h.y); o.y = pk2(h.z, h.w);
              *(u32x2*)(H + (size_t)r * D + idx) = o; }
            if (has2) { const f32x4 sh = *(const f32x4*)(md2 + idx), sc = *(const f32x4*)(md2 + 1024 + idx);
              const f32x4 h = vb[j] * (sc + 1.f) + sh; u32x2 o; o.x = pk2(h.x, h.y); o.y = pk2(h.z, h.w);
              *(u32x2*)(H + (size_t)r2 * D + idx) = o; }
        }
    }
    }
PROBE_END(2)
    xcd_barrier(xbar);
    if (PROBE_SEL == 10) { for (int i = 0; i < 10; ++i) xcd_barrier(xbar); }

PROBE_BEGIN(8)
    { pg8::Gemm g{H, WIN_T, R, NPROJ_PAD, D}; pg8::StaticOrder S; S.init(R, NPROJ_PAD, G, bid); EpiStore<0> E{P, NPROJ, NPROJ};
      pg8::gemm_phase<EpiStore<0>, pg8::StaticOrder, true, true>(ldsg, g, S, E); }
PROBE_END(8)
    xcd_barrier(xbar);

PROBE_BEGIN(3)
#ifndef NO_P3
    { IDS
        float* cf = (float*)lds; float* cb = (float*)(lds + 16640); float* lrs = (float*)(lds + 33280); float* wl = (float*)(lds + 41728);
        bf16* kTf = (bf16*)(lds + 50432); bf16* kTb = (bf16*)(lds + 59648); bf16* vT = (bf16*)(lds + 68864);
        constexpr int NU = NB * 2 * 4 * NCH;
        const int s = tid & 63, dc = tid >> 6;
        u32x4 kv = {0u, 0u, 0u, 0u}, vv0 = kv, vv1 = kv; GatePre gp; gp.lr = (u32x2){0u, 0u}; gp.w = (f32x4){0.f, 0.f, 0.f, 0.f}; gp.bias = 0.f;
#define P3_LOAD(U) do { const int pc_ = (U) % NCH, t_ = (U) / NCH, h_ = t_ & 3, g_ = 1 - (t_ >> 3), b_ = (t_ >> 2) & 1; const bf16* Pr_ = P + (size_t)(b_ * TP + pc_ * 64) * NPROJ; \
            const int kcol_ = g_ ? 1792 + h_ * 64 : 256 + h_ * 64, vcol_ = g_ ? 2048 + h_ * 128 : 512 + h_ * 128; \
            kv = *(const u32x4*)(Pr_ + (size_t)s * NPROJ + kcol_ + dc * 8); vv0 = *(const u32x4*)(Pr_ + (size_t)s * NPROJ + vcol_ + dc * 8); vv1 = *(const u32x4*)(Pr_ + (size_t)s * NPROJ + vcol_ + (dc + 8) * 8); \
            gp = gate_prefetch(g_, h_, Pr_, gkw, gkb, tid); } while (0)
        if (bid < NU) P3_LOAD(bid);
        for (int unit = bid; unit < NU; unit += G) {
            const int pc = unit % NCH, t = unit / NCH, h = t & 3, g = 1 - (t >> 3), b = (t >> 2) & 1;
            const float kscale = g ? 1.f : 0.125f;
            float lgf = 0.f, lgb = 0.f;
            if (g) fill_cum3(cf, cb, lrs, wl, g, h, gp, theta, tid);
            else { lgf = log1pf(-expf(theta[h])); lgb = log1pf(-expf(theta[4 + h])); }
            {
              if (g) {
#pragma unroll
              for (int j = 0; j < 8; ++j) { const int d = dc * 8 + j; const unsigned u = kv[j >> 1]; const float kf = ((j & 1) ? bfhi(u) : bflo(u)) * kscale;
                  kTf[d * 72 + s] = (bf16)f2bf(kf * __expf(cf[63 * CS + d] - cf[s * CS + d]));
                  kTb[d * 72 + s] = (bf16)f2bf(kf * __expf(cb[d] - cb[s * CS + d])); }
              } else { const float ef = __expf((float)(63 - s) * lgf) * kscale, eb = __expf((float)s * lgb) * kscale;
#pragma unroll
              for (int j = 0; j < 8; ++j) { const int d = dc * 8 + j; const unsigned u = kv[j >> 1]; const float kf = (j & 1) ? bfhi(u) : bflo(u);
                  kTf[d * 72 + s] = (bf16)f2bf(kf * ef); kTb[d * 72 + s] = (bf16)f2bf(kf * eb); }
              }
#pragma unroll
              for (int j = 0; j < 8; ++j) { const unsigned u0 = vv0[j >> 1], u1 = vv1[j >> 1];
                  vT[(dc * 8 + j) * 72 + s] = (bf16)((j & 1) ? (u0 >> 16) : (u0 & 0xffffu)); vT[((dc + 8) * 8 + j) * 72 + s] = (bf16)((j & 1) ? (u1 >> 16) : (u1 & 0xffffu)); }
            }
            const int seq0 = ((b * 2 + g) * 4 + h) * 2;
            const int nf = pc, nbk = (pc < 4) ? 3 - pc : 135 - pc;
            if (tid < 128) { const int dir = tid >> 6, d = tid & 63;
                DEC[((size_t)(seq0 + dir) * NCH + (dir ? nbk : nf)) * 64 + d] = g ? (dir ? expf(cb[d]) : expf(cf[63 * CS + d])) : expf(64.f * (dir ? lgb : lgf)); }
            if (unit + G < NU) P3_LOAD(unit + G);
            __syncthreads();
            bf16x8 bfr[2];
#pragma unroll
            for (int ks = 0; ks < 2; ++ks) bfr[ks] = *(const bf16x8*)(vT + (wave * 16 + l15) * 72 + ks * 32 + quad * 8);
#pragma unroll
            for (int dir = 0; dir < 2; ++dir) {
                const bf16* kT = dir ? kTb : kTf;
                bf16* dst = ST + ((size_t)(seq0 + dir) * NCH + (dir ? nbk : nf)) * 8192 + (size_t)(wave * 16 + l15) * 64;
#pragma unroll
                for (int dt = 0; dt < 4; ++dt) {
                    pg8::f32x4 acc = {0.f, 0.f, 0.f, 0.f};
#pragma unroll
                    for (int ks = 0; ks < 2; ++ks) { const bf16x8 af = *(const bf16x8*)(kT + (dt * 16 + l15) * 72 + ks * 32 + quad * 8); acc = MFMA16(af, bfr[ks], acc); }
                    u32x2 o; o.x = pk2(acc[0], acc[1]); o.y = pk2(acc[2], acc[3]);
                    *(u32x2*)(dst + dt * 16 + quad * 4) = o;
                }
            }
            __syncthreads();
        }
#undef P3_LOAD
        if ((NU - bid + G - 1) / G < (NU + G - 1) / G) DRAIN_LATE((float*)(lds + wave * 8448), 1);
    }
#endif
PROBE_END(3)
    xcd_barrier(xbar);

PROBE_BEGIN(4)
    { IDS
    for (int i = bid * 512 + tid; i < 32 * 4096; i += G * 512) {
        const int seq = i >> 12, pi = i & 4095, d = (2 * pi) & 63;
        unsigned* sp = (unsigned*)(ST + (size_t)seq * NCH * 8192) + pi; const float* dp = DEC + (size_t)seq * NCH * 64 + d;
        float s0 = 0.f, s1 = 0.f;
#pragma unroll 4
        for (int n = 0; n < NCH; ++n) {
            const unsigned kv = sp[(size_t)n * 4096]; const float d0 = dp[n * 64], d1 = dp[n * 64 + 1];
            sp[(size_t)n * 4096] = pk2(s0, s1);
            s0 = d0 * s0 + bflo(kv); s1 = d1 * s1 + bfhi(kv);
        }
    }
    }
PROBE_END(4)
    xcd_barrier(xbar);

PROBE_BEGIN(5)
#ifndef NO_P5
    { IDS
        float* cf = (float*)lds; float* cb = (float*)(lds + 16640); float* lrs = (float*)(lds + 33280); float* wl = (float*)(lds + 41728);
        bf16* qdf = (bf16*)(lds + 50432); bf16* kif = (bf16*)(lds + 59648); bf16* qdb = (bf16*)(lds + 68864); bf16* kib = (bf16*)(lds + 78080);
        bf16* vT = (bf16*)(lds + 87296); bf16* Am = (bf16*)(lds + 105728); float* red = (float*)(lds + 114944);
        constexpr int NU = NB * 2 * 4 * NCH;
        const int dcq = tid & 7, sq = tid >> 3, sv = tid & 63, dcv = tid >> 6;
        u32x4 qv = {0u, 0u, 0u, 0u}, kv = qv, vv0 = qv, vv1 = qv; GatePre gp; gp.lr = (u32x2){0u, 0u}; gp.w = (f32x4){0.f, 0.f, 0.f, 0.f}; gp.bias = 0.f;
#define P5_LOAD(U) do { const int pc_ = (U) % NCH, t_ = (U) / NCH, h_ = t_ & 3, g_ = 1 - (t_ >> 3), b_ = (t_ >> 2) & 1; const bf16* Pr_ = P + (size_t)(b_ * TP + pc_ * 64) * NPROJ; \
            const int qcol_ = g_ ? 1536 + h_ * 64 : h_ * 64, kcol_ = g_ ? 1792 + h_ * 64 : 256 + h_ * 64, vcol_ = g_ ? 2048 + h_ * 128 : 512 + h_ * 128; \
            qv = *(const u32x4*)(Pr_ + (size_t)sq * NPROJ + qcol_ + dcq * 8); kv = *(const u32x4*)(Pr_ + (size_t)sq * NPROJ + kcol_ + dcq * 8); \
            vv0 = *(const u32x4*)(Pr_ + (size_t)sv * NPROJ + vcol_ + dcv * 8); vv1 = *(const u32x4*)(Pr_ + (size_t)sv * NPROJ + vcol_ + (dcv + 8) * 8); \
            gp = gate_prefetch(g_, h_, Pr_, gkw, gkb, tid); } while (0)
        if (bid < NU) P5_LOAD(bid);
        for (int unit = bid; unit < NU; unit += G) {
            const int pc = unit % NCH, t = unit / NCH, h = t & 3, g = 1 - (t >> 3), b = (t >> 2) & 1;
            const int r0 = b * TP + pc * 64;
            const int gcol = g ? 2560 + h * 128 : 1024 + h * 128;
            const float qscale = g ? 0.125f : 1.f, kscale = g ? 1.f : 0.125f;
            if (g) fill_cum3(cf, cb, lrs, wl, g, h, gp, theta, tid);
            { u32x4 o1, o2, o3, o4;
              if (g) {
#pragma unroll
              for (int j2 = 0; j2 < 4; ++j2) {
                  const int d = dcq * 8 + 2 * j2;
                  const float f0 = cf[sq * CS + d], f1 = cf[sq * CS + d + 1], b0 = cb[sq * CS + d], b1 = cb[sq * CS + d + 1];
                  const float q0 = bflo(qv[j2]) * qscale, q1 = bfhi(qv[j2]) * qscale, k0 = bflo(kv[j2]) * kscale, k1 = bfhi(kv[j2]) * kscale;
                  o1[j2] = pk2(q0 * __expf(f0), q1 * __expf(f1)); o2[j2] = pk2(k0 * __expf(-f0), k1 * __expf(-f1));
                  o3[j2] = pk2(q0 * __expf(b0), q1 * __expf(b1)); o4[j2] = pk2(k0 * __expf(-b0), k1 * __expf(-b1));
              }
              } else {
                  const float lgf = log1pf(-expf(theta[h])), lgb = log1pf(-expf(theta[4 + h]));
                  const float cfr = (float)(sq + 1) * lgf, cbr = (float)(64 - sq) * lgb;
                  const float ef = __expf(cfr) * qscale, eif = __expf(-cfr) * kscale, eb = __expf(cbr) * qscale, eib = __expf(-cbr) * kscale;
#pragma unroll
                  for (int j2 = 0; j2 < 4; ++j2) { const float q0 = bflo(qv[j2]), q1 = bfhi(qv[j2]), k0 = bflo(kv[j2]), k1 = bfhi(kv[j2]);
                      o1[j2] = pk2(q0 * ef, q1 * ef); o2[j2] = pk2(k0 * eif, k1 * eif); o3[j2] = pk2(q0 * eb, q1 * eb); o4[j2] = pk2(k0 * eib, k1 * eib); }
              }
              *(u32x4*)(qdf + sq * 72 + dcq * 8) = o1; *(u32x4*)(kif + sq * 72 + dcq * 8) = o2; *(u32x4*)(qdb + sq * 72 + dcq * 8) = o3; *(u32x4*)(kib + sq * 72 + dcq * 8) = o4;
#pragma unroll
              for (int j = 0; j < 8; ++j) { const unsigned u0 = vv0[j >> 1], u1 = vv1[j >> 1];
                  vT[(dcv * 8 + j) * 72 + sv] = (bf16)((j & 1) ? (u0 >> 16) : (u0 & 0xffffu)); vT[((dcv + 8) * 8 + j) * 72 + sv] = (bf16)((j & 1) ? (u1 >> 16) : (u1 & 0xffffu)); }
            }
            __syncthreads();
            const int ct = wave & 3, eh = wave >> 2;
            const int seq0 = ((b * 2 + g) * 4 + h) * 2;
            const int nf = pc, nbk = (pc < 4) ? 3 - pc : 135 - pc;
            const bf16* Sf = ST + ((size_t)seq0 * NCH + nf) * 8192; const bf16* Sb = ST + ((size_t)(seq0 + 1) * NCH + nbk) * 8192;
            const int r = r0 + ct * 16 + l15;
            bf16x8 a2[4][2], a3[4][2]; u32x2 gv[4];
#pragma unroll
            for (int et = 0; et < 4; ++et) { const int e = (eh * 4 + et) * 16 + l15;
#pragma unroll
                for (int ks = 0; ks < 2; ++ks) { a2[et][ks] = *(const bf16x8*)(Sf + e * 64 + ks * 32 + quad * 8); a3[et][ks] = *(const bf16x8*)(Sb + e * 64 + ks * 32 + quad * 8); }
                gv[et] = *(const u32x2*)(P + (size_t)r * NPROJ + gcol + (eh * 4 + et) * 16 + quad * 4); }
            { bf16x8 af[2], ab[2];
#pragma unroll
              for (int ks = 0; ks < 2; ++ks) { af[ks] = *(const bf16x8*)(qdf + (ct * 16 + l15) * 72 + ks * 32 + quad * 8); ab[ks] = *(const bf16x8*)(qdb + (ct * 16 + l15) * 72 + ks * 32 + quad * 8); }
#pragma unroll
              for (int i = 0; i < 2; ++i) { const int st = (wave >> 2) * 2 + i;
                  pg8::f32x4 accf = {0.f, 0.f, 0.f, 0.f}, accb = {0.f, 0.f, 0.f, 0.f};
#pragma unroll
                  for (int ks = 0; ks < 2; ++ks) {
                      const bf16x8 bf_ = *(const bf16x8*)(kif + (st * 16 + l15) * 72 + ks * 32 + quad * 8), bb_ = *(const bf16x8*)(kib + (st * 16 + l15) * 72 + ks * 32 + quad * 8);
                      accf = MFMA16(af[ks], bf_, accf); accb = MFMA16(ab[ks], bb_, accb); }
                  const int scol = st * 16 + l15;
#pragma unroll
                  for (int rg = 0; rg < 4; ++rg) { const int c = ct * 16 + quad * 4 + rg; Am[c * 72 + scol] = (bf16)f2bf(scol <= c ? accf[rg] : accb[rg]); }
              }
            }
            if (unit + G < NU) P5_LOAD(unit + G);
            __syncthreads();
            { bf16x8 bA[2], bQf[2], bQb[2];
#pragma unroll
              for (int ks = 0; ks < 2; ++ks) { const int o = (ct * 16 + l15) * 72 + ks * 32 + quad * 8; bA[ks] = *(const bf16x8*)(Am + o); bQf[ks] = *(const bf16x8*)(qdf + o); bQb[ks] = *(const bf16x8*)(qdb + o); }
              pg8::f32x4 acc[4]; float ss = 0.f;
#pragma unroll
              for (int et = 0; et < 4; ++et) { const int e = (eh * 4 + et) * 16 + l15;
                  pg8::f32x4 c4 = {0.f, 0.f, 0.f, 0.f};
#pragma unroll
                  for (int ks = 0; ks < 2; ++ks) {
                      const bf16x8 a1 = *(const bf16x8*)(vT + e * 72 + ks * 32 + quad * 8);
                      c4 = MFMA16(a1, bA[ks], c4); c4 = MFMA16(a2[et][ks], bQf[ks], c4); c4 = MFMA16(a3[et][ks], bQb[ks], c4); }
                  acc[et] = c4; ss += (c4[0] * c4[0] + c4[1] * c4[1]) + (c4[2] * c4[2] + c4[3] * c4[3]); }
              ss = quad_sum(ss);
              if (quad == 0) red[eh * 64 + ct * 16 + l15] = ss;
              __syncthreads();
              const float tot = red[ct * 16 + l15] + red[64 + ct * 16 + l15];
              const float rinv = 1.f / sqrtf(tot * (1.f / 128.f) + 1e-6f);
#pragma unroll
              for (int et = 0; et < 4; ++et) { const int e0 = (eh * 4 + et) * 16 + quad * 4;
                  float gt[4] = {bflo(gv[et].x), bfhi(gv[et].x), bflo(gv[et].y), bfhi(gv[et].y)}; float y[4];
#pragma unroll
                  for (int i = 0; i < 4; ++i) { const float ng = g ? normg[e0 + i] : 1.f; const float sg = gt[i] * __builtin_amdgcn_rcpf(1.f + __expf(-gt[i])); y[i] = sg * acc[et][i] * rinv * ng; }
                  u32x2 o; o.x = pk2(y[0], y[1]); o.y = pk2(y[2], y[3]);
                  *(u32x2*)(H + (size_t)r * D + g * 512 + h * 128 + e0) = o; }
            }
            __syncthreads();
        }
#undef P5_LOAD
        if ((NU - bid + G - 1) / G < (NU + G - 1) / G) DRAIN_LATE((float*)(lds + wave * 8448), 2);
    }
#endif
PROBE_END(5)
    xcd_barrier(xbar);

PROBE_BEGIN(12)
    { pg8::Gemm g{H, WOUT0_T, R, D, D}; LatOrder S; S.init(D, G, bid); EpiResid<0, false> E{xin, ctx, VLAT, VCTX, nullptr, mod + 2 * 1024, nullptr, nullptr, nullptr};
      pg8::gemm_phase<EpiResid<0, false>, LatOrder, true, true>(ldsg, g, S, E); }
    { IDS
      ctx_resid_tiles<false>(H, WOUT0_T, D, ctx, VCTX, mod + 2 * 6144 + 2 * 1024, nullptr, nullptr, nullptr, (float*)lds, bid, G, tid, wave, l15, quad); }
PROBE_END(12)
    xcd_barrier(xbar);
PROBE_BEGIN(7)
    { IDS
    DRAIN_LATE((float*)(lds + wave * 8448), 1 << 30);
    ln_phase<false, false>(RST(0), VLAT, VCTX, nullptr, nullptr, ln_g, ln_b, mod + 3 * 1024, H, gw, NGW, lane);
    }
PROBE_END(7)
    xcd_barrier(xbar);
PROBE_BEGIN(11)
    { pg8::Gemm g{H, W1_0_T, R, FF, D}; LatOrder S; S.init(FF, G, bid); EpiStore<1> E{P, FF, FF};
      pg8::gemm_phase<EpiStore<1>, LatOrder, true, true>(ldsg, g, S, E); }
    { IDS
      ctx_ksplit_tiles<1>(H, W1_0_T, P, FF, 64, FF, (float*)lds, bid, G, tid, wave, l15, quad); }
PROBE_END(11)
    xcd_barrier(xbar);
PROBE_BEGIN(9)
    { pg8::Gemm g{P, W2_0_T, R, D, FF}; LatOrder S; S.init(D, G, bid); EpiResid<1, false> E{VLAT, VCTX, VLAT, VCTX, nullptr, mod + 5 * 1024, RST(0), ln_g, ln_b};
      pg8::gemm_phase<EpiResid<1, false>, LatOrder, true, true>(ldsg, g, S, E); }
    { IDS
      ctx_resid_tiles<true>(P, W2_0_T, FF, VCTX, VCTX, mod + 2 * 6144 + 5 * 1024, RST(0), ln_g, ln_b, (float*)lds, bid, G, tid, wave, l15, quad); }
PROBE_END(9)
    xcd_barrier(xbar);
    { IDS
    ln_phase<false, false>(RST(1), VLAT, VCTX, nullptr, nullptr, ln_g + 1024, ln_b + 1024, mod + 3 * 6144, H, gw, NGW, lane);
    }
    xcd_barrier(xbar);

PROBE_BEGIN(13)
    { pg8::Gemm g{H, WQKV_T, R, NQKV, D}; pg8::StaticOrder S; S.init(R, NQKV, G, bid); EpiStore<0> E{P, NQKV, NQKV};
      pg8::gemm_phase<EpiStore<0>, pg8::StaticOrder, true, true>(ldsg, g, S, E); }
PROBE_END(13)
    xcd_barrier(xbar);

PROBE_BEGIN(6)
#ifndef NO_P12
    { IDS
        bf16* Qs = (bf16*)lds; bf16* Ks = (bf16*)(lds + 73728); bf16* Vt = (bf16*)(lds + 82944); float* ropes = (float*)(lds + 92160);
        for (int i = tid; i < 1024; i += 512) ((f32x4*)ropes)[i] = ((const f32x4*)rope)[i];
        PACC_DECL
        for (int unit = bid; unit < NB * 4 * 64; unit += G) {
            PACC_BEGIN(40)
            const int nb = unit & 63, kvh = (unit >> 6) & 3, b = unit >> 8;
#define ATT_VALID(t) ((t) < 4 || (unsigned)(nb - 1 + (((t) - 4) >> 1)) < 64u)
#define ATT_KPOS(t) ((nb - 1 + (((t) - 4) >> 1)) * 128 + (((t) - 4) & 1) * 64)
#define ATT_KROW(t) ((t) < 4 ? b * TP + (t) * 64 : b * TP + L + ATT_KPOS(t))
            const int keyk = tid >> 2, pck = tid & 3, c1k = (pck & 1) + (pck >> 1) * 4, keyv = tid & 63, dcv = tid >> 6;
            u32x4 pk1 = {0u, 0u, 0u, 0u}, pk2_ = pk1, pvv = pk1;
#define ATT_LOAD(t) do { const int kr_ = ATT_KROW(t); \
                if (tid < 256) { const bf16* src_ = P + (size_t)(kr_ + keyk) * NQKV + 1024 + kvh * 64; pk1 = *(const u32x4*)(src_ + c1k * 8); pk2_ = *(const u32x4*)(src_ + (c1k + 2) * 8); } \
                pvv = *(const u32x4*)(P + (size_t)(kr_ + keyv) * NQKV + 1280 + kvh * 64 + dcv * 8); } while (0)
            ATT_LOAD(0);
            __syncthreads();
#pragma unroll
            for (int i = 0; i < 4; ++i) {
                const int it = tid + i * 512, pcq = it & 3, row = it >> 2, g = row >> 7, qi = row & 127, pos = nb * 128 + qi;
                const bf16* src = P + (size_t)(b * TP + L + pos) * NQKV + (kvh * 4 + g) * 64;
                const int c1 = (pcq & 1) + (pcq >> 1) * 4;
                const u32x4 u1 = *(const u32x4*)(src + c1 * 8), u2 = *(const u32x4*)(src + (c1 + 2) * 8);
                const int pv = (pcq < 2) ? (pos >> 6) : (pos & 63);
                const f32x4* tab = (const f32x4*)(ropes + (pv * 16 + (c1 & 1) * 8) * 2);
                u32x4 o1, o2;
#pragma unroll
                for (int j2 = 0; j2 < 4; ++j2) { const f32x4 cs = tab[j2];
                    const float a0 = bflo(u1[j2]), a1 = bfhi(u1[j2]), b0 = bflo(u2[j2]), b1 = bfhi(u2[j2]);
                    o1[j2] = pk2((a0 * cs.x - b0 * cs.y) * QSC, (a1 * cs.z - b1 * cs.w) * QSC); o2[j2] = pk2((a0 * cs.y + b0 * cs.x) * QSC, (a1 * cs.w + b1 * cs.z) * QSC); }
                *(u32x4*)(Qs + row * 72 + c1 * 8) = o1; *(u32x4*)(Qs + row * 72 + (c1 + 2) * 8) = o2;
            }
            const int g = wave & 3, qh = wave >> 2, qrow0 = g * 128 + qh * 64, qpos0 = nb * 128 + qh * 64;
            float mrun[4], lrun[4]; pg8::f32x4 O[4][4];
            const float sk = sink[kvh * 4 + g] * 1.4426950408889634f;
#pragma unroll
            for (int qt = 0; qt < 4; ++qt) { mrun[qt] = sk; lrun[qt] = (quad == 0) ? 1.f : 0.f;
#pragma unroll
                for (int dt = 0; dt < 4; ++dt) O[dt][qt] = (pg8::f32x4){0.f, 0.f, 0.f, 0.f}; }
            PACC_END(40)
            int ti = 0;
            while (ti < 10) {
                PACC_BEGIN(41)
                const bool local = ti >= 4;
                const int kpos0 = local ? ATT_KPOS(ti) : 0;
                const int side = local ? ((ti - 4) >> 1) - 1 : 0;
                __syncthreads();
                if (tid < 256) {
                    u32x4 o1 = pk1, o2 = pk2_;
                    if (local) {
                        const int pos = kpos0 + keyk, pv = (pck < 2) ? (pos >> 6) : (pos & 63);
                        const f32x4* tab = (const f32x4*)(ropes + (pv * 16 + (c1k & 1) * 8) * 2);
#pragma unroll
                        for (int j2 = 0; j2 < 4; ++j2) { const f32x4 cs = tab[j2];
                            const float a0 = bflo(pk1[j2]), a1 = bfhi(pk1[j2]), b0 = bflo(pk2_[j2]), b1 = bfhi(pk2_[j2]);
                            o1[j2] = pk2(a0 * cs.x - b0 * cs.y, a1 * cs.z - b1 * cs.w); o2[j2] = pk2(a0 * cs.y + b0 * cs.x, a1 * cs.w + b1 * cs.z); }
                    }
                    *(u32x4*)(Ks + keyk * 72 + c1k * 8) = o1; *(u32x4*)(Ks + keyk * 72 + (c1k + 2) * 8) = o2;
                }
#pragma unroll
                for (int j = 0; j < 8; ++j) { const unsigned u = pvv[j >> 1]; Vt[(dcv * 8 + j) * 72 + keyv] = (bf16)((j & 1) ? (u >> 16) : (u & 0xffffu)); }
                __syncthreads();
                PACC_END(41)
                PACC_BEGIN(42)
                int tn = ti + 1;
                while (tn < 10 && !ATT_VALID(tn)) ++tn;
                if (tn < 10) ATT_LOAD(tn);
                if (!((side < 0 && ((ti - 4) & 1) == 0 && qh == 1) || (side > 0 && ((ti - 4) & 1) == 1 && qh == 0))) {
                bf16x8 kfr[4][2];
#pragma unroll
                for (int kt = 0; kt < 4; ++kt)
#pragma unroll
                    for (int ks = 0; ks < 2; ++ks) kfr[kt][ks] = *(const bf16x8*)(Ks + (kt * 16 + l15) * 72 + ks * 32 + quad * 8);
#pragma unroll
                for (int qt = 0; qt < 4; ++qt) {
                    pg8::f32x4 S[4];
#pragma unroll
                    for (int kt = 0; kt < 4; ++kt) S[kt] = (pg8::f32x4){0.f, 0.f, 0.f, 0.f};
#pragma unroll
                    for (int ks = 0; ks < 2; ++ks) { const bf16x8 qf = *(const bf16x8*)(Qs + (qrow0 + qt * 16 + l15) * 72 + ks * 32 + quad * 8);
#pragma unroll
                        for (int kt = 0; kt < 4; ++kt) S[kt] = MFMA16(kfr[kt][ks], qf, S[kt]); }
                    float mx = -INFINITY;
                    if (side < 0 && ((ti - 4) & 1) == qh) {
                        const int tl = quad * 4 - (qpos0 + qt * 16 + l15 - kpos0 - 128);
#pragma unroll
                        for (int kt = 0; kt < 4; ++kt)
#pragma unroll
                            for (int rg = 0; rg < 4; ++rg) { const float sv_ = (tl >= -(kt * 16 + rg)) ? S[kt][rg] : -INFINITY; S[kt][rg] = sv_; mx = fmaxf(mx, sv_); }
                    } else if (side > 0 && ((ti - 4) & 1) == qh) {
                        const int th = (qpos0 + qt * 16 + l15 - kpos0 + 128) - quad * 4;
#pragma unroll
                        for (int kt = 0; kt < 4; ++kt)
#pragma unroll
                            for (int rg = 0; rg < 4; ++rg) { const float sv_ = (th >= (kt * 16 + rg)) ? S[kt][rg] : -INFINITY; S[kt][rg] = sv_; mx = fmaxf(mx, sv_); }
                    } else {
#pragma unroll
                        for (int kt = 0; kt < 4; ++kt)
#pragma unroll
                            for (int rg = 0; rg < 4; ++rg) mx = fmaxf(mx, S[kt][rg]);
                    }
                    mx = quad_max(mx);
                    const float mnew = fmaxf(mrun[qt], mx), al = __builtin_amdgcn_exp2f(mrun[qt] - mnew); mrun[qt] = mnew;
                    float ps = 0.f;
#pragma unroll
                    for (int kt = 0; kt < 4; ++kt)
#pragma unroll
                        for (int rg = 0; rg < 4; ++rg) { const float p = __builtin_amdgcn_exp2f(S[kt][rg] - mnew); S[kt][rg] = p; ps += p; }
                    lrun[qt] = lrun[qt] * al + ps;
#pragma unroll
                    for (int dt = 0; dt < 4; ++dt) O[dt][qt] = O[dt][qt] * al;
#pragma unroll
                    for (int s2 = 0; s2 < 2; ++s2) {
                        u32x4 pw; pw.x = pk2(S[2 * s2][0], S[2 * s2][1]); pw.y = pk2(S[2 * s2][2], S[2 * s2][3]);
                        pw.z = pk2(S[2 * s2 + 1][0], S[2 * s2 + 1][1]); pw.w = pk2(S[2 * s2 + 1][2], S[2 * s2 + 1][3]);
                        const bf16x8 pf = __builtin_bit_cast(bf16x8, pw);
#pragma unroll
                        for (int dt = 0; dt < 4; ++dt) {
                            const s16x4 lo = *(const s16x4*)(Vt + (dt * 16 + l15) * 72 + s2 * 32 + quad * 4), hi = *(const s16x4*)(Vt + (dt * 16 + l15) * 72 + s2 * 32 + 16 + quad * 4);
                            O[dt][qt] = MFMA16(__builtin_shufflevector(lo, hi, 0, 1, 2, 3, 4, 5, 6, 7), pf, O[dt][qt]); }
                    }
                }
                }
                ti = tn;
                PACC_END(42)
            }
            PACC_BEGIN(43)
#pragma unroll
            for (int qt = 0; qt < 4; ++qt) {
                const float lt = quad_sum(lrun[qt]);
                const float inv = 1.f / lt;
                const int r = b * TP + L + qpos0 + qt * 16 + l15;
#pragma unroll
                for (int dt = 0; dt < 4; ++dt) { u32x2 o; o.x = pk2(O[dt][qt][0] * inv, O[dt][qt][1] * inv); o.y = pk2(O[dt][qt][2] * inv, O[dt][qt][3] * inv);
                    *(u32x2*)(H + (size_t)r * D + (kvh * 4 + g) * 64 + dt * 16 + quad * 4) = o; }
            }
            PACC_END(43)
#undef ATT_VALID
#undef ATT_KPOS
#undef ATT_KROW
#undef ATT_LOAD
        }
        PACC_SLEEP()
    }
#endif
PROBE_END(6)
    xcd_barrier(xbar);

PROBE_BEGIN(14)
    { pg8::Gemm g{H, WOUT1_T, R, D, D}; LatOrder S; S.init(D, G, bid); EpiResid<1, false> E{VLAT, VCTX, VLAT, VCTX, nullptr, mod + 3 * 6144 + 2 * 1024, RST(1), ln_g + 1024, ln_b + 1024};
      pg8::gemm_phase<EpiResid<1, false>, LatOrder, true, true>(ldsg, g, S, E); }
PROBE_END(14)
    xcd_barrier(xbar);
    { IDS
    ln_phase<false, true>(RST(2), VLAT, VCTX, nullptr, nullptr, ln_g + 2048, ln_b + 2048, mod + 3 * 6144 + 3 * 1024, H, gw, NGW, lane);
    }
    xcd_barrier(xbar);
PROBE_BEGIN(15)
    { pg8::Gemm g{H, W1_1_T, R, FF, D}; LatOrder S; S.init(FF, G, bid); EpiStore<1> E{P, FF, FF};
      pg8::gemm_phase<EpiStore<1>, LatOrder, true, true>(ldsg, g, S, E); }
PROBE_END(15)
    xcd_barrier(xbar);
PROBE_BEGIN(16)
    { pg8::Gemm g{P, W2_1_T, R, D, FF}; LatOrder S; S.init(D, G, bid); EpiResid<1, true> E{VLAT, VCTX, nullptr, nullptr, H, mod + 3 * 6144 + 5 * 1024, RST(2), ln_g + 2048, ln_b + 2048};
      pg8::gemm_phase<EpiResid<1, true>, LatOrder, true, true>(ldsg, g, S, E); }
PROBE_END(16)
    xcd_barrier(xbar);
    { IDS
    ln_phase<true, true>(nullptr, nullptr, nullptr, H, a.out, ln_g + 3072, ln_b + 3072, mod, H, gw, NGW, lane);
    }
}

extern "C" void kernel_launch(void* const* d_in, const int* in_sizes, int n_in, void* d_out, int out_size, void* d_ws, size_t ws_size, hipStream_t stream) {
    static int grid = 0;
    if (grid == 0) {
        if (n_in != 19 || out_size != NB * T * D || ws_size < WS_TOTAL) { fprintf(stderr, "kernel_launch: unexpected shapes (n_in %d out %d ws %zu)\n", n_in, out_size, ws_size); grid = -1; return; }
        int dev = 0, cus = 0, per_cu = 0;
        hipGetDevice(&dev); hipDeviceGetAttribute(&cus, hipDeviceAttributeMultiprocessorCount, dev);
        if (hipFuncSetAttribute((const void*)fwd_kernel, hipFuncAttributeMaxDynamicSharedMemorySize, LDS_BYTES) != hipSuccess) { fprintf(stderr, "kernel_launch: hipFuncSetAttribute failed\n"); grid = -1; return; }
        if (hipOccupancyMaxActiveBlocksPerMultiprocessor(&per_cu, (const void*)fwd_kernel, 512, LDS_BYTES) != hipSuccess || per_cu < 1) per_cu = 1;
        (void)hipGetLastError();
        grid = cus > 0 ? cus : 256;
    }
    if (grid < 0) return;
    Args a{};
    for (int i = 0; i < 19; ++i) a.in[i] = (const float*)d_in[i];
    a.out = (float*)d_out; a.ws = (unsigned char*)d_ws;
    if (hipMemsetAsync((char*)d_ws + OFF_XBAR, 0, 16384, stream) != hipSuccess) { fprintf(stderr, "kernel_launch: hipMemsetAsync of the barrier words failed\n"); return; }
    void* args[] = {&a};
    hipError_t e = hipLaunchCooperativeKernel((const void*)fwd_kernel, dim3(grid), dim3(512), args, LDS_BYTES, stream);
    if (e != hipSuccess) fprintf(stderr, "cooperative launch failed: %s (grid %d)\n", hipGetErrorString(e), grid);
}
```

```cpp
#include <hip/hip_runtime.h>
#include <hip/hip_cooperative_groups.h>
#include <cstdio>
#include <cstdint>
namespace cg = cooperative_groups;
namespace pg8 {
#define PG8_LAS __attribute__((address_space(3)))
typedef unsigned short bf16_t;
typedef short bf16x8 __attribute__((ext_vector_type(8)));
typedef float f32x4 __attribute__((ext_vector_type(4)));
typedef unsigned u32x4 __attribute__((ext_vector_type(4)));
constexpr int BM = 256, BK = 64, HALF = 128, HTB = HALF * BK * 2  , STAGE_BYTES = 8 * HTB, NXCD = 8, WGM = 8;

__host__ __device__ __forceinline__ int lds_byte(int r, int c) { const int st = (r >> 4) * 2 + (c >> 5), rr = r & 15, cc = c & 31, ob = rr * 64 + cc * 2; return st * 1024 + (ob ^ (((ob >> 9) & 1) << 5)); }
__host__ __device__ __forceinline__ void stage_rc(int b, int& R, int& C) { const int st = b / 1024, sb = b % 1024, swz = sb ^ (((sb >> 9) & 1) << 5); R = (st >> 1) * 16 + swz / 64; C = (st & 1) * 32 + (swz % 64) / 2; }
__host__ __device__ __forceinline__ int perm32(int rho) { const int n = rho >> 4, i = rho & 15; return 8 * (i >> 2) + 4 * n + (i & 3); }

struct Unit { int pm, pn; };
struct Gemm { const bf16_t* A; const bf16_t* Bt; int M, N, K; };

struct StaticOrder {
    int nM, nN, nwg, G, c;
    __host__ __device__ void init(int M, int N, int G_, int c_) { nM = M / BM; nN = N / BM; nwg = nM * nN; G = G_; c = c_; }
    __host__ __device__ bool next(int i, Unit& u) const {
        const long L = (long)i * G + c; if (L >= nwg) return false;
        int wgid = (int)L; { const int q = nwg / NXCD, r = nwg % NXCD, xcd = wgid % NXCD, off = wgid / NXCD; wgid = (xcd < r ? xcd * (q + 1) : r * (q + 1) + (xcd - r) * q) + off; }
        const int nig = WGM * nN, gid = wgid / nig, fm = gid * WGM, gsz = (nM - fm) < WGM ? (nM - fm) : WGM;
        u.pm = fm + ((wgid % nig) % gsz); u.pn = (wgid % nig) / gsz; return true;
    }
    __device__ __forceinline__ void a_ready(const Unit&) const {}
    __device__ __forceinline__ void done(const Unit&) const {}
};

__device__ __forceinline__ unsigned cvt_pk_bf16(float lo, float hi) { unsigned r; asm volatile("v_cvt_pk_bf16_f32 %0, %1, %2" : "=v"(r) : "v"(lo), "v"(hi)); return r; }

template <class Epi, class Sched, bool ALIGN_EPI = false, bool SP2 = false>
__device__ __forceinline__ void gemm_phase(PG8_LAS unsigned char* lds, const Gemm g, const Sched& S, const Epi& E) {
    int tid = threadIdx.x; asm volatile("" : "+v"(tid));
    const int wid = __builtin_amdgcn_readfirstlane(tid >> 6), lane = tid & 63, wr = wid >> 2, wc = wid & 3, fr = lane & 15, fq = lane >> 4;
    const int K = g.K, nt = K / BK;
    unsigned voffA[2], voffB[2];
#pragma unroll
    for (int i = 0; i < 2; ++i) { int R, C; stage_rc(tid * 16 + i * 8192, R, C); const int Rb = Epi::PERM ? ((R & ~31) + perm32(R & 31)) : R;
        voffA[i] = (unsigned)(R * K + C) * 2u; voffB[i] = (unsigned)(Rb * K + C) * 2u; }
    const size_t kstep = (size_t)(BK * 2);
    const size_t hstep = (size_t)HALF * K * 2;
    const size_t tstep = 2 * hstep;
    const unsigned ldsw = (unsigned)wid * 1024u;
    const int aoff = lds_byte(wr * 64 + fr, fq * 8), boff = lds_byte(wc * 32 + fr, fq * 8);
#define PG8_SA(b, h) (((b) * 2 + (h)) * HTB)
#define PG8_SB(b, h) ((4 + (b) * 2 + (h)) * HTB)
#define PG8_STAGE(bufoff, gbase, voff) do { _Pragma("unroll") for (int _i = 0; _i < 2; ++_i) \
        __builtin_amdgcn_global_load_lds((const unsigned*)((const char*)(gbase) + (voff)[_i]), (PG8_LAS unsigned*)(lds + (bufoff) + ldsw + _i * 8192), 16, 0, 0); } while (0)
#define PG8_LDA(dst, b, h) do { _Pragma("unroll") for (int m = 0; m < 4; ++m) _Pragma("unroll") for (int k = 0; k < 2; ++k) dst[m][k] = *(const PG8_LAS bf16x8*)(lds + PG8_SA(b, h) + aoff + m * 2048 + k * 1024); } while (0)
#define PG8_LDB(dst, b, h) do { _Pragma("unroll") for (int n = 0; n < 2; ++n) _Pragma("unroll") for (int k = 0; k < 2; ++k) dst[n][k] = *(const PG8_LAS bf16x8*)(lds + PG8_SB(b, h) + boff + n * 2048 + k * 1024); } while (0)
#define PG8_MMA(ai, bj, At, Bt) do { __builtin_amdgcn_s_setprio(1); _Pragma("unroll") for (int m = 0; m < 4; ++m) _Pragma("unroll") for (int n = 0; n < 2; ++n) _Pragma("unroll") for (int k = 0; k < 2; ++k) \
        acc[ai][bj][m][n] = __builtin_amdgcn_mfma_f32_16x16x32_bf16(Bt[n][k], At[m][k], acc[ai][bj][m][n], 0, 0, 0); __builtin_amdgcn_s_setprio(0); } while (0)
#define PG8_WAIT_V(n) asm volatile("s_waitcnt vmcnt(" #n ")" ::: "memory")
#define PG8_WAIT_L(n) asm volatile("s_waitcnt lgkmcnt(" #n ")" ::: "memory")
#define PG8_BAR __builtin_amdgcn_s_barrier()
#define PG8_SCHED __builtin_amdgcn_sched_barrier(0)
    Unit cur, nxt; int ui = 0;
    if (!S.next(0, cur)) return;
    f32x4 acc[2][2][4][2];
#pragma unroll
    for (int a = 0; a < 2; ++a)
#pragma unroll
        for (int b = 0; b < 2; ++b)
#pragma unroll
            for (int m = 0; m < 4; ++m)
#pragma unroll
                for (int n = 0; n < 2; ++n) acc[a][b][m][n] = (f32x4){0.f, 0.f, 0.f, 0.f};
    bf16x8 At[4][2], B0[2][2], B1[2][2];
    const char* cA = (const char*)g.A + (size_t)cur.pm * tstep; const char* cB = (const char*)g.Bt + (size_t)cur.pn * tstep;
    S.a_ready(cur);
    if constexpr (SP2) {
        PG8_STAGE(PG8_SB(0, 0), cB, voffB); PG8_STAGE(PG8_SB(0, 1), cB + hstep, voffB); PG8_STAGE(PG8_SA(0, 0), cA, voffA); PG8_STAGE(PG8_SA(0, 1), cA + hstep, voffA);
        if (wr == 1) PG8_BAR;
        PG8_WAIT_V(2); PG8_BAR;
        PG8_STAGE(PG8_SB(1, 0), cB + kstep, voffB); PG8_STAGE(PG8_SA(1, 0), cA + kstep, voffA); PG8_STAGE(PG8_SB(1, 1), cB + hstep + kstep, voffB);
        PG8_WAIT_V(6); PG8_BAR;
    } else {
        PG8_STAGE(PG8_SB(0, 0), cB, voffB); PG8_STAGE(PG8_SA(0, 0), cA, voffA); PG8_STAGE(PG8_SB(0, 1), cB + hstep, voffB); PG8_STAGE(PG8_SA(0, 1), cA + hstep, voffA);
        if (wr == 1) PG8_BAR;
        PG8_WAIT_V(4); PG8_BAR;
        PG8_STAGE(PG8_SB(1, 0), cB + kstep, voffB); PG8_STAGE(PG8_SA(1, 0), cA + kstep, voffA); PG8_STAGE(PG8_SB(1, 1), cB + hstep + kstep, voffB);
        PG8_WAIT_V(6); PG8_BAR;
    }
    for (;;) {
        const bool has_next = S.next(ui + 1, nxt);
        const char* nA = has_next ? (const char*)g.A + (size_t)nxt.pm * tstep : cA; const char* nB = has_next ? (const char*)g.Bt + (size_t)nxt.pn * tstep : cB;
        for (int t = 0; t < nt; t += 2) {
            const bool last = (t == nt - 2);
            const char* a1 = cA + (size_t)(t + 1) * kstep;
            const char* a2 = last ? nA : cA + (size_t)(t + 2) * kstep; const char* b2 = last ? nB : cB + (size_t)(t + 2) * kstep;
            const char* a3 = a2 + kstep; const char* b3 = b2 + kstep;
            if (last && has_next) S.a_ready(nxt);
            if constexpr (SP2) {
            PG8_LDB(B0, 0, 0); PG8_LDB(B1, 0, 1); PG8_SCHED; PG8_LDA(At, 0, 0); PG8_STAGE(PG8_SA(1, 1), a1 + hstep, voffA);
            PG8_WAIT_V(8); PG8_WAIT_L(0); PG8_BAR; PG8_MMA(0, 0, At, B0); PG8_MMA(0, 1, At, B1); PG8_BAR; PG8_SCHED;
            PG8_LDA(At, 0, 1); PG8_STAGE(PG8_SB(0, 0), b2, voffB); PG8_STAGE(PG8_SB(0, 1), b2 + hstep, voffB); PG8_STAGE(PG8_SA(0, 0), a2, voffA);
            PG8_WAIT_V(8); PG8_WAIT_L(0); PG8_BAR; PG8_MMA(1, 0, At, B0); PG8_MMA(1, 1, At, B1); PG8_BAR; PG8_SCHED;
            PG8_LDB(B0, 1, 0); PG8_LDB(B1, 1, 1); PG8_SCHED; PG8_LDA(At, 1, 0); PG8_STAGE(PG8_SA(0, 1), a2 + hstep, voffA);
            PG8_WAIT_V(8); PG8_WAIT_L(0); PG8_BAR; PG8_MMA(0, 0, At, B0); PG8_MMA(0, 1, At, B1); PG8_BAR; PG8_SCHED;
            PG8_LDA(At, 1, 1); PG8_STAGE(PG8_SB(1, 0), b3, voffB); PG8_STAGE(PG8_SB(1, 1), b3 + hstep, voffB); PG8_STAGE(PG8_SA(1, 0), a3, voffA);
            PG8_WAIT_V(8); PG8_WAIT_L(0); PG8_BAR; PG8_MMA(1, 0, At, B0); PG8_MMA(1, 1, At, B1); PG8_BAR; PG8_SCHED;
            } else {
            PG8_LDB(B0, 0, 0); PG8_SCHED; PG8_LDA(At, 0, 0); PG8_STAGE(PG8_SA(1, 1), a1 + hstep, voffA);
            PG8_WAIT_L(8); PG8_BAR; PG8_WAIT_L(0); PG8_MMA(0, 0, At, B0); PG8_BAR; PG8_SCHED;
            PG8_LDB(B1, 0, 1); PG8_STAGE(PG8_SB(0, 0), b2, voffB);
            PG8_BAR; PG8_WAIT_L(0); PG8_MMA(0, 1, At, B1); PG8_BAR;
            PG8_LDA(At, 0, 1); PG8_STAGE(PG8_SA(0, 0), a2, voffA);
            PG8_BAR; PG8_WAIT_L(0); PG8_MMA(1, 0, At, B0); PG8_BAR; PG8_SCHED;
            PG8_STAGE(PG8_SB(0, 1), b2 + hstep, voffB);
            PG8_WAIT_V(6); PG8_BAR; PG8_MMA(1, 1, At, B1); PG8_BAR;
            PG8_LDB(B0, 1, 0); PG8_SCHED; PG8_LDA(At, 1, 0); PG8_STAGE(PG8_SA(0, 1), a2 + hstep, voffA);
            PG8_WAIT_L(8); PG8_BAR; PG8_WAIT_L(0); PG8_MMA(0, 0, At, B0); PG8_BAR; PG8_SCHED;
            PG8_LDB(B1, 1, 1); PG8_STAGE(PG8_SB(1, 0), b3, voffB);
            PG8_BAR; PG8_WAIT_L(0); PG8_MMA(0, 1, At, B1); PG8_BAR;
            PG8_LDA(At, 1, 1); PG8_STAGE(PG8_SA(1, 0), a3, voffA);
            PG8_BAR; PG8_WAIT_L(0); PG8_MMA(1, 0, At, B0); PG8_BAR; PG8_SCHED;
            PG8_STAGE(PG8_SB(1, 1), b3 + hstep, voffB);
            PG8_WAIT_V(6); PG8_BAR; PG8_MMA(1, 1, At, B1); PG8_BAR;
            }
        }
        if constexpr (ALIGN_EPI) { if (wr == 0) PG8_BAR; }
        if constexpr (!Epi::AFTER_DRAIN) { E(acc, cur, wr, wc, fr, fq); S.done(cur); }
        if (!has_next) break;
#pragma unroll
        for (int a = 0; a < 2; ++a)
#pragma unroll
            for (int b = 0; b < 2; ++b)
#pragma unroll
                for (int m = 0; m < 4; ++m)
#pragma unroll
                    for (int n = 0; n < 2; ++n) acc[a][b][m][n] = (f32x4){0.f, 0.f, 0.f, 0.f};
        cur = nxt; cA = nA; cB = nB; ++ui;
        if constexpr (ALIGN_EPI) { if (wr == 1) PG8_BAR; }
    }
    PG8_WAIT_V(0);
    if constexpr (!ALIGN_EPI) { if (wr == 0) PG8_BAR; }
    PG8_BAR;
    if constexpr (Epi::AFTER_DRAIN) { E.fused(acc, cur, wr, wc, fr, fq, lds, wid, lane); S.done(cur); }
#undef PG8_SA
#undef PG8_SB
#undef PG8_STAGE
#undef PG8_LDA
#undef PG8_LDB
#undef PG8_MMA
#undef PG8_WAIT_V
#undef PG8_WAIT_L
#undef PG8_BAR
#undef PG8_SCHED
}
}

constexpr int NB = 2, T = 8192, L = 256, D = 1024, TP = T + L, R = NB * TP;
constexpr int FF = 4096, NPROJ = 3104, NPROJ_PAD = 3328, NQKV = 1536, NCH = TP / 64;
constexpr float ALPHA = 1.4142135623730951f;
constexpr int LDS_BYTES = 147456;

typedef unsigned short bf16;
typedef float f32x4 __attribute__((ext_vector_type(4)));
typedef short bf16x8 __attribute__((ext_vector_type(8)));
typedef short s16x4 __attribute__((ext_vector_type(4)));
typedef unsigned u32x4 __attribute__((ext_vector_type(4)));
typedef unsigned u32x2 __attribute__((ext_vector_type(2)));

constexpr size_t OFF_WIN = 0;
constexpr size_t OFF_WOUT0 = OFF_WIN + (size_t)NPROJ_PAD * D * 2;
constexpr size_t OFF_W1_0 = OFF_WOUT0 + (size_t)D * D * 2;
constexpr size_t OFF_W2_0 = OFF_W1_0 + (size_t)FF * D * 2;
constexpr size_t OFF_WQKV = OFF_W2_0 + (size_t)FF * D * 2;
constexpr size_t OFF_WOUT1 = OFF_WQKV + (size_t)NQKV * D * 2;
constexpr size_t OFF_W1_1 = OFF_WOUT1 + (size_t)D * D * 2;
constexpr size_t OFF_W2_1 = OFF_W1_1 + (size_t)FF * D * 2;
constexpr size_t OFF_MOD = OFF_W2_1 + (size_t)FF * D * 2;
constexpr size_t OFF_ROPE = OFF_MOD + 2 * 3 * 6144 * 4;
constexpr size_t OFF_BAR = OFF_ROPE + 128 * 16 * 8;
constexpr size_t OFF_XBAR = OFF_BAR + 256;
constexpr size_t OFF_RST = OFF_XBAR + 16384;
constexpr size_t OFF_XCTX = OFF_RST + (size_t)3 * R * 2 * 4;
constexpr size_t OFF_DEC = OFF_XCTX + (size_t)NB * L * D * 4;
constexpr size_t OFF_H = OFF_DEC + (size_t)32 * NCH * 64 * 4;
constexpr size_t OFF_P = OFF_H + (size_t)R * D * 2;
constexpr size_t OFF_ST = OFF_P + (size_t)R * NPROJ * 2;
constexpr size_t WS_TOTAL = OFF_ST + (size_t)32 * NCH * 8192 * 2;
static_assert(WS_TOTAL <= 268435456, "workspace map exceeds 256 MiB");
static_assert(OFF_P + (size_t)R * FF * 2 <= WS_TOTAL, "MLP hidden overlay");

typedef float f32x2_t __attribute__((ext_vector_type(2)));
typedef __bf16 bf16x2_t __attribute__((ext_vector_type(2)));
__device__ __forceinline__ unsigned pk2(float lo, float hi) { const f32x2_t v = {lo, hi}; const bf16x2_t b = __builtin_convertvector(v, bf16x2_t); return __builtin_bit_cast(unsigned, b); }
__device__ __forceinline__ unsigned f2bf(float f) { return pk2(f, f) & 0xffffu; }
__device__ __forceinline__ float bf2f(unsigned h) { return __uint_as_float(h << 16); }
__device__ __forceinline__ float bflo(unsigned u) { return __uint_as_float(u << 16); }
__device__ __forceinline__ float bfhi(unsigned u) { return __uint_as_float(u & 0xffff0000u); }
__device__ __forceinline__ float quad_max(float x) {
    const unsigned u = __float_as_uint(x);
    const auto r = __builtin_amdgcn_permlane32_swap(u, u, false, false);
    const float m = fmaxf(__uint_as_float(r[0]), __uint_as_float(r[1]));
    const unsigned v = __float_as_uint(m);
    const auto q = __builtin_amdgcn_permlane16_swap(v, v, false, false);
    return fmaxf(__uint_as_float(q[0]), __uint_as_float(q[1]));
}
__device__ __forceinline__ float quad_sum(float x) {
    const unsigned u = __float_as_uint(x);
    const auto r = __builtin_amdgcn_permlane32_swap(u, u, false, false);
    const float m = __uint_as_float(r[0]) + __uint_as_float(r[1]);
    const unsigned v = __float_as_uint(m);
    const auto q = __builtin_amdgcn_permlane16_swap(v, v, false, false);
    return __uint_as_float(q[0]) + __uint_as_float(q[1]);
}
__device__ __forceinline__ float dpp_add(float v, int ctrl_sel) {
    const int u = __float_as_int(v);
    const int t = ctrl_sel == 0 ? __builtin_amdgcn_update_dpp(0, u, 0xB1, 0xF, 0xF, true) : ctrl_sel == 1 ? __builtin_amdgcn_update_dpp(0, u, 0x4E, 0xF, 0xF, true)
                : ctrl_sel == 2 ? __builtin_amdgcn_update_dpp(0, u, 0x141, 0xF, 0xF, true) : __builtin_amdgcn_update_dpp(0, u, 0x140, 0xF, 0xF, true);
    return v + __int_as_float(t);
}
__device__ __forceinline__ float wave_sum(float v) { v = dpp_add(v, 0); v = dpp_add(v, 1); v = dpp_add(v, 2); v = dpp_add(v, 3); return quad_sum(v); }
#define MFMA16(a, b, c) __builtin_amdgcn_mfma_f32_16x16x32_bf16((a), (b), (c), 0, 0, 0)

__device__ __forceinline__ size_t row_off(int r, bool& isc, int& b) { b = (r >= TP) ? 1 : 0; const int p = r - b * TP; isc = p < L; return isc ? (size_t)(b * L + p) * D : (size_t)(b * T + p - L) * D; }

template <int ACT> struct EpiStore {
    static constexpr bool PERM = true, AFTER_DRAIN = false;
    bf16* O; int ldc; int ncols;
    __device__ __forceinline__ void operator()(const pg8::f32x4 (&acc)[2][2][4][2], const pg8::Unit& u, int wr, int wc, int fr, int fq) const {
        const int row0 = u.pm * 256 + wr * 64 + fr, col0 = u.pn * 256 + wc * 32 + 8 * fq;
#pragma unroll
        for (int ai = 0; ai < 2; ++ai)
#pragma unroll
            for (int m = 0; m < 4; ++m) {
                bf16* rowp = O + (size_t)(row0 + ai * 128 + m * 16) * ldc;
#pragma unroll
                for (int bj = 0; bj < 2; ++bj) {
                    const int col = col0 + bj * 128;
                    pg8::f32x4 v0 = acc[ai][bj][m][0], v1 = acc[ai][bj][m][1];
                    if (ACT == 1) {
#pragma unroll
                        for (int i = 0; i < 4; ++i) { float a = fmaxf(v0[i], 0.f), b = fmaxf(v1[i], 0.f); v0[i] = a * a; v1[i] = b * b; }
                    }
                    u32x4 w; w.x = pg8::cvt_pk_bf16(v0[0], v0[1]); w.y = pg8::cvt_pk_bf16(v0[2], v0[3]); w.z = pg8::cvt_pk_bf16(v1[0], v1[1]); w.w = pg8::cvt_pk_bf16(v1[2], v1[3]);
                    if (col < ncols) *(u32x4*)(rowp + col) = w;
                }
            }
    }
};
template <int SRC, bool DST_FIN> struct EpiResid {
    static constexpr bool PERM = true, AFTER_DRAIN = false;
    const void* src_lat; const void* src_ctx; bf16* dst_lat; bf16* dst_ctx; bf16* dst_fin; const float* gate;
    const float* rst; const float* lg; const float* lb;
    __device__ __forceinline__ void operator()(const pg8::f32x4 (&acc)[2][2][4][2], const pg8::Unit& u, int wr, int wc, int fr, int fq) const {
        const int b = u.pm > 33 ? 1 : 0, col0 = u.pn * 256 + wc * 32 + 8 * fq, rt0 = wr * 64 + fr;
        const size_t lat0 = (size_t)(u.pm * 256 - b * TP - L + b * T);
        const float* gt = gate + b * 6144;
#pragma unroll
        for (int bj = 0; bj < 2; ++bj) {
            const int col = col0 + bj * 128;
            const f32x4 g0 = *(const f32x4*)(gt + col), g1 = *(const f32x4*)(gt + col + 4);
            f32x4 l0, l1, m0, m1;
            if (SRC == 1) { l0 = *(const f32x4*)(lg + col); l1 = *(const f32x4*)(lg + col + 4); m0 = *(const f32x4*)(lb + col); m1 = *(const f32x4*)(lb + col + 4); }
#pragma unroll
            for (int ai = 0; ai < 2; ++ai)
#pragma unroll
                for (int m = 0; m < 4; ++m) {
                    const int rt = rt0 + ai * 128 + m * 16, row = u.pm * 256 + rt; const size_t off = (lat0 + rt) * D + col;
                    f32x4 x0, x1;
                    if (SRC == 0) { const float* sp = (const float*)src_lat + off; x0 = *(const f32x4*)sp; x1 = *(const f32x4*)(sp + 4); }
                    else { const float mean = rst[2 * row], rstd = rst[2 * row + 1];
                        const u32x4 w = *(const u32x4*)((const bf16*)src_lat + off);
                        x0 = (f32x4){bflo(w.x), bfhi(w.x), bflo(w.y), bfhi(w.y)}; x1 = (f32x4){bflo(w.z), bfhi(w.z), bflo(w.w), bfhi(w.w)};
                        x0 = (x0 - mean) * rstd * l0 + m0; x1 = (x1 - mean) * rstd * l1 + m1; }
                    const pg8::f32x4 a0 = acc[ai][bj][m][0], a1 = acc[ai][bj][m][1];
                    u32x4 o; o.x = pk2(ALPHA * x0.x + g0.x * a0[0], ALPHA * x0.y + g0.y * a0[1]); o.y = pk2(ALPHA * x0.z + g0.z * a0[2], ALPHA * x0.w + g0.w * a0[3]);
                    o.z = pk2(ALPHA * x1.x + g1.x * a1[0], ALPHA * x1.y + g1.y * a1[1]); o.w = pk2(ALPHA * x1.z + g1.z * a1[2], ALPHA * x1.w + g1.w * a1[3]);
                    bf16* dp = DST_FIN ? dst_fin + (size_t)row * D + col : dst_lat + off;
                    *(u32x4*)dp = o;
                }
        }
    }
};

__device__ __forceinline__ void transpose_item(const float* __restrict__ W, int K, int N, bf16* WT, float* scr, int item, int lane) {
    const int nblk = N / 32, kb = item / nblk, nb = item % nblk, k0 = 64 * kb, n0 = 32 * nb;
#pragma unroll 8
    for (int i = 0; i < 32; ++i) { const int kk = 2 * i + (lane >> 5); scr[kk * 33 + (lane & 31)] = W[(size_t)(k0 + kk) * N + n0 + (lane & 31)]; }
    asm volatile("s_waitcnt lgkmcnt(0)" ::: "memory");
    const int c = lane & 7;
#pragma unroll
    for (int j = 0; j < 4; ++j) { const int n = (lane >> 3) + 8 * j; const float* s = scr + (8 * c) * 33 + n;
        u32x4 o; o.x = pk2(s[0 * 33], s[1 * 33]); o.y = pk2(s[2 * 33], s[3 * 33]); o.z = pk2(s[4 * 33], s[5 * 33]); o.w = pk2(s[6 * 33], s[7 * 33]);
        *(u32x4*)(WT + (size_t)(n0 + n) * K + k0 + 8 * c) = o; }
    asm volatile("s_waitcnt lgkmcnt(0)" ::: "memory");
}

template <bool LAST, bool SKIPCTX>
__device__ __forceinline__ void ln_phase(float* rst, const bf16* vlat, const bf16* vctx, const bf16* vfin, float* outp, const float* __restrict__ g, const float* __restrict__ bt, const float* __restrict__ modn, bf16* H, int gw, int NGW, int lane) {
    int r = gw;
    if (SKIPCTX) { while (r < R) { const int p = r >= TP ? r - TP : r; if (p >= L) break; r += NGW; } }
    u32x4 vn[2];
    if (r < R) { bool isc; int b; const size_t off = row_off(r, isc, b); const bf16* xr = LAST ? vfin + (size_t)r * D : (isc ? vctx : vlat) + off;
#pragma unroll
        for (int j = 0; j < 2; ++j) vn[j] = *(const u32x4*)(xr + lane * 8 + 512 * j); }
    while (r < R) {
        bool isc; int b; const size_t off = row_off(r, isc, b);
        float v[16];
#pragma unroll
        for (int j = 0; j < 2; ++j)
#pragma unroll
            for (int i = 0; i < 4; ++i) { v[j * 8 + 2 * i] = bflo(vn[j][i]); v[j * 8 + 2 * i + 1] = bfhi(vn[j][i]); }
        int rn = r + NGW;
        if (SKIPCTX) { while (rn < R) { const int p = rn >= TP ? rn - TP : rn; if (p >= L) break; rn += NGW; } }
        if (rn < R) { bool isc2; int b2; const size_t off2 = row_off(rn, isc2, b2); const bf16* xr2 = LAST ? vfin + (size_t)rn * D : (isc2 ? vctx : vlat) + off2;
#pragma unroll
            for (int j = 0; j < 2; ++j) vn[j] = *(const u32x4*)(xr2 + lane * 8 + 512 * j); }
        float s = 0.f;
#pragma unroll
        for (int i = 0; i < 16; ++i) s += v[i];
        const float mean = wave_sum(s) * (1.f / D); float s2 = 0.f;
#pragma unroll
        for (int i = 0; i < 16; ++i) { v[i] -= mean; s2 += v[i] * v[i]; }
        const float rstd = 1.f / sqrtf(wave_sum(s2) * (1.f / D) + 1e-5f);
        const float* md = modn + (isc ? 2 : b) * 6144;
        if (!LAST && lane == 0) { rst[2 * r] = mean; rst[2 * r + 1] = rstd; }
#pragma unroll
        for (int j = 0; j < 2; ++j) {
            const int idx = lane * 8 + 512 * j;
            float y[8];
#pragma unroll
            for (int q = 0; q < 2; ++q) { const f32x4 gg = *(const f32x4*)(g + idx + 4 * q), bb = *(const f32x4*)(bt + idx + 4 * q);
#pragma unroll
                for (int i = 0; i < 4; ++i) y[q * 4 + i] = v[j * 8 + q * 4 + i] * rstd * gg[i] + bb[i]; }
            if (LAST) { *(f32x4*)(outp + off + idx) = (f32x4){y[0], y[1], y[2], y[3]}; *(f32x4*)(outp + off + idx + 4) = (f32x4){y[4], y[5], y[6], y[7]}; }
            else {
                float h[8];
#pragma unroll
                for (int q = 0; q < 2; ++q) { const f32x4 sh = *(const f32x4*)(md + idx + 4 * q), sc = *(const f32x4*)(md + 1024 + idx + 4 * q);
#pragma unroll
                    for (int i = 0; i < 4; ++i) h[q * 4 + i] = y[q * 4 + i] * (sc[i] + 1.f) + sh[i]; }
                u32x4 o; o.x = pk2(h[0], h[1]); o.y = pk2(h[2], h[3]); o.z = pk2(h[4], h[5]); o.w = pk2(h[6], h[7]);
                *(u32x4*)(H + (size_t)r * D + idx) = o;
            }
        }
        r = rn;
    }
}

__device__ __forceinline__ float log_sigmoid(float z) { return fminf(z, 0.f) - __logf(1.f + __expf(-fabsf(z))); }

constexpr int CS = 65;
constexpr float QSC = 0.125f * 1.4426950408889634f;
struct GatePre { u32x2 lr; f32x4 w; float bias; };
__device__ __forceinline__ GatePre gate_prefetch(int g, int h, const bf16* Pr, const float* gkw, const float* gkb, int tid) {
    GatePre p; p.lr = (u32x2){0u, 0u}; p.w = (f32x4){0.f, 0.f, 0.f, 0.f}; p.bias = 0.f;
    if (g) { const int c = tid >> 3, part = tid & 7;
        p.lr = *(const u32x2*)(Pr + (size_t)c * NPROJ + 3072 + part * 4);
        const int idx = tid * 4, dir = idx >> 10, r = (idx >> 6) & 15, d = idx & 63;
        p.w = *(const f32x4*)(gkw + (dir * 16 + r) * 256 + h * 64 + d);
        if (tid < 128) p.bias = gkb[(tid >> 6) * 256 + h * 64 + (tid & 63)]; }
    return p;
}
__device__ __forceinline__ void fill_cum3(float* cf, float* cb, float* lrs, float* wl, int g, int h, const GatePre& gp, const float* theta, int tid) {
    if (g == 0) {
        const float lgf = log1pf(-expf(theta[h])), lgb = log1pf(-expf(theta[4 + h]));
        for (int i = tid; i < 4096; i += 512) { const int c = i >> 6, d = i & 63; cf[c * CS + d] = (float)(c + 1) * lgf; cb[c * CS + d] = (float)(64 - c) * lgb; }
        __syncthreads();
        return;
    }
    { const int c = tid >> 3, part = tid & 7;
      float* lp = lrs + c * 33 + part * 4; lp[0] = bflo(gp.lr.x); lp[1] = bfhi(gp.lr.x); lp[2] = bflo(gp.lr.y); lp[3] = bfhi(gp.lr.y);
      *(f32x4*)(wl + tid * 4) = gp.w;
      if (tid < 128) wl[2048 + tid] = gp.bias; }
    __syncthreads();
    { const int c = tid >> 3, dg = tid & 7;
#pragma unroll
      for (int dir = 0; dir < 2; ++dir) {
          f32x4 za = *(const f32x4*)(wl + 2048 + dir * 64 + dg * 8), zb = *(const f32x4*)(wl + 2048 + dir * 64 + dg * 8 + 4);
#pragma unroll
          for (int r = 0; r < 16; ++r) { const float lv = lrs[c * 33 + dir * 16 + r];
              za += lv * *(const f32x4*)(wl + (dir * 16 + r) * 64 + dg * 8); zb += lv * *(const f32x4*)(wl + (dir * 16 + r) * 64 + dg * 8 + 4); }
          float* dst = (dir ? cb : cf) + c * CS + dg * 8;
#pragma unroll
          for (int j = 0; j < 4; ++j) { dst[j] = log_sigmoid(za[j]) * (1.f / 16.f); dst[4 + j] = log_sigmoid(zb[j]) * (1.f / 16.f); } } }
    __syncthreads();
    if (tid < 128) {
        const int dir = tid >> 6; float* arr = (dir ? cb : cf) + (tid & 63);
        float run = 0.f;
#pragma unroll
        for (int hh = 0; hh < 2; ++hh) {
            float v[32];
            const int base = dir ? (1 - hh) * 32 : hh * 32;
#pragma unroll
            for (int c = 0; c < 32; ++c) v[c] = arr[(base + c) * CS];
            if (dir == 0) {
#pragma unroll
                for (int c = 0; c < 32; ++c) { run += v[c]; arr[(base + c) * CS] = run; }
            } else {
#pragma unroll
                for (int c = 31; c >= 0; --c) { run += v[c]; arr[(base + c) * CS] = run; }
            }
        }
    }
    __syncthreads();
}

__device__ __forceinline__ void fast_bar(unsigned* ctr, unsigned& target) {
    asm volatile("s_waitcnt vmcnt(0)" ::: "memory");
    __syncthreads();
    target += gridDim.x;
    if (threadIdx.x == 0) {
        __builtin_amdgcn_fence(__ATOMIC_RELEASE, "agent");
        asm volatile("s_waitcnt vmcnt(0)" ::: "memory");
        __hip_atomic_fetch_add(ctr, 1u, __ATOMIC_RELAXED, __HIP_MEMORY_SCOPE_AGENT);
        while (__hip_atomic_load(ctr, __ATOMIC_RELAXED, __HIP_MEMORY_SCOPE_AGENT) < target) __builtin_amdgcn_s_sleep(1);
        __builtin_amdgcn_fence(__ATOMIC_ACQUIRE, "agent");
        asm volatile("s_waitcnt vmcnt(0)" ::: "memory");
    }
    __syncthreads();
}
#define RLX_AGENT __ATOMIC_RELAXED, __HIP_MEMORY_SCOPE_AGENT
#define XB_TMO      128
#define XB_XCNT(j)  (256  + 64 * (j))
#define XB_XSUB(j)  (1280 + 64 * (j))
#define XB_XGEN(j)  (2304 + 64 * (j))
#define XB_TOP      3328
#define XB_TOPGEN   3392
#define XCD_BAR_WORDS 3456
#define XB_SPIN_CAP (1u << 18)

__device__ __forceinline__ unsigned xb_ld(unsigned* p)              { return __hip_atomic_load(p, __ATOMIC_RELAXED, __HIP_MEMORY_SCOPE_AGENT); }
__device__ __forceinline__ unsigned xb_add(unsigned* p, unsigned v) { return __hip_atomic_fetch_add(p, v, __ATOMIC_RELAXED, __HIP_MEMORY_SCOPE_AGENT); }
__device__ __forceinline__ unsigned xb_xcc_id() { return (unsigned)__builtin_amdgcn_s_getreg((3 << 11) | 20) & 0xFu; }
#define XB_SPIN(cond, bar) do { unsigned _sp = 0; while (cond) { __builtin_amdgcn_s_sleep(1); \
    if ((++_sp & 255u) == 0u) { if (xb_ld(&(bar)[XB_TMO])) break; if (_sp > XB_SPIN_CAP) { atomicAdd(&(bar)[XB_TMO], 1u); break; } } } } while (0)

struct XcdBarrier {
    unsigned* bar; unsigned x;
    volatile unsigned* st;
};

__device__ __forceinline__ XcdBarrier xcd_barrier_post(unsigned* bar, volatile unsigned* st) {
    XcdBarrier b; b.bar = bar; b.x = xb_xcc_id(); b.st = st;
    if (threadIdx.x == 0) (void)xb_add(&bar[XB_XCNT(b.x)], 1u);
    return b;
}
__device__ __forceinline__ void xcd_barrier_complete(unsigned* bar, unsigned x, unsigned& nloc, unsigned& nx) {
    const unsigned G = gridDim.x * gridDim.y * gridDim.z;
    unsigned sum, cnt, mine, sp = 0u;
    for (;;) {
        sum = 0u; cnt = 0u; mine = 0u;
#pragma unroll
        for (unsigned j = 0; j < 16; ++j) { const unsigned c = xb_ld(&bar[XB_XCNT(j)]); sum += c; cnt += (c > 0u) ? 1u : 0u; mine = (j == x) ? c : mine; }
        if (sum == G) break;
        __builtin_amdgcn_s_sleep(1);
        if ((++sp & 255u) == 0u) { if (xb_ld(&bar[XB_TMO])) break; if (sp > XB_SPIN_CAP) { atomicAdd(&bar[XB_TMO], 1u); break; } }
    }
    nloc = mine > 0u ? mine : 1u; nx = cnt > 0u ? cnt : 1u;
}

__device__ __forceinline__ void xcd_barrier(const XcdBarrier& b) {
    asm volatile("s_waitcnt vmcnt(0)" ::: "memory");
    __syncthreads();
    if (threadIdx.x == 0) {
        unsigned* bar = b.bar;
        __builtin_amdgcn_s_waitcnt(0);
        unsigned nloc = b.st[0], nx = b.st[1];
        if (nloc == 0u) { xcd_barrier_complete(bar, b.x, nloc, nx); b.st[0] = nloc; b.st[1] = nx; }
        const unsigned old = xb_add(&bar[XB_XSUB(b.x)], 1u);
        const unsigned gen = old / nloc;
        if (old + 1u == (gen + 1u) * nloc) {
            __builtin_amdgcn_fence(__ATOMIC_RELEASE, "agent");
            asm volatile("s_waitcnt vmcnt(0)" ::: "memory");
            const unsigned og = xb_add(&bar[XB_TOP], 1u);
            const unsigned tg = og / nx;
            if (og + 1u == (tg + 1u) * nx) xb_add(&bar[XB_TOPGEN], 1u);
            else XB_SPIN(xb_ld(&bar[XB_TOPGEN]) == tg, bar);
            __builtin_amdgcn_fence(__ATOMIC_ACQUIRE, "agent");
            xb_add(&bar[XB_XGEN(b.x)], 1u);
            asm volatile("s_waitcnt vmcnt(0)" ::: "memory");
        } else {
            XB_SPIN(xb_ld(&bar[XB_XGEN(b.x)]) == gen, bar);
            __builtin_amdgcn_fence(__ATOMIC_ACQUIRE, "agent");
            asm volatile("s_waitcnt vmcnt(0)" ::: "memory");
        }
    }
    __syncthreads();
}

struct LatOrder {
    pg8::StaticOrder S;
    __device__ void init(int N, int G, int c) { S.init(NB * T, N, G, c); }
    __device__ bool next(int i, pg8::Unit& u) const { if (!S.next(i, u)) return false; u.pm = u.pm + 1 + (u.pm >= 32 ? 1 : 0); return true; }
    __device__ __forceinline__ void a_ready(const pg8::Unit&) const {}
    __device__ __forceinline__ void done(const pg8::Unit&) const {}
};
#ifndef PROBE_SEL
#define PROBE_SEL 0
#endif
#ifndef PROBE_MUL
#define PROBE_MUL 3
#endif
#define PACC_DECL unsigned long long pacc = 0, pacc_t0 = 0; (void)pacc; (void)pacc_t0;
#define PACC_BEGIN(k) if (PROBE_SEL == (k)) pacc_t0 = __builtin_amdgcn_s_memrealtime();
#define PACC_END(k) if (PROBE_SEL == (k)) pacc += __builtin_amdgcn_s_memrealtime() - pacc_t0;
#define PACC_SLEEP() if (PROBE_SEL >= 40 && PROBE_SEL < 60) { const unsigned long long t1 = __builtin_amdgcn_s_memrealtime(), dt = pacc * PROBE_MUL; while (__builtin_amdgcn_s_memrealtime() - t1 < dt) __builtin_amdgcn_s_sleep(8); }
#define PROBE_BEGIN(k) unsigned long long pt0_##k = 0; if (PROBE_SEL == (k)) pt0_##k = __builtin_amdgcn_s_memrealtime();
#define PROBE_END(k) if (PROBE_SEL == (k)) { const unsigned long long t1 = __builtin_amdgcn_s_memrealtime(), dt = (t1 - pt0_##k) * PROBE_MUL; while (__builtin_amdgcn_s_memrealtime() - t1 < dt) __builtin_amdgcn_s_sleep(8); }


template <int XT, int YT>
__device__ __forceinline__ void frag_gemm(pg8::f32x4 (&acc)[XT][YT], const bf16* X, int ldx, const bf16* Y, int ldy, int k0, int k1, int l15, int quad) {
#pragma unroll 4
    for (int k = k0; k < k1; k += 32) {
        bf16x8 xf[XT], yf[YT];
#pragma unroll
        for (int i = 0; i < XT; ++i) xf[i] = *(const bf16x8*)(X + (size_t)(i * 16 + l15) * ldx + k + quad * 8);
#pragma unroll
        for (int j = 0; j < YT; ++j) yf[j] = *(const bf16x8*)(Y + (size_t)(j * 16 + l15) * ldy + k + quad * 8);
#pragma unroll
        for (int i = 0; i < XT; ++i)
#pragma unroll
            for (int j = 0; j < YT; ++j) acc[i][j] = MFMA16(xf[i], yf[j], acc[i][j]);
    }
}
template <bool SRC_LN>
__device__ __forceinline__ void ctx_resid_tiles(const bf16* A, const bf16* Bt, int K, const void* src_ctx, bf16* dst_ctx, const float* gate_ctx, const float* rst, const float* lg, const float* lb, float* part, int bid, int G, int tid, int wave, int l15, int quad) {
    for (int t = bid; t < 256; t += G) {
        const int rt = t >> 5, c0 = (t & 31) * 32, b = rt >> 2, p0 = (rt & 3) * 64, r0 = b * TP + p0;
        pg8::f32x4 acc[4][2];
#pragma unroll
        for (int i = 0; i < 4; ++i)
#pragma unroll
            for (int j = 0; j < 2; ++j) acc[i][j] = (pg8::f32x4){0.f, 0.f, 0.f, 0.f};
        const int ksl = K >> 3;
        frag_gemm<4, 2>(acc, A + (size_t)r0 * K, K, Bt + (size_t)c0 * K, K, wave * ksl, (wave + 1) * ksl, l15, quad);
        float* pw = part + wave * 2048;
#pragma unroll
        for (int i = 0; i < 4; ++i)
#pragma unroll
            for (int j = 0; j < 2; ++j)
#pragma unroll
                for (int rg = 0; rg < 4; ++rg) pw[(i * 16 + quad * 4 + rg) * 32 + j * 16 + l15] = acc[i][j][rg];
        __syncthreads();
        { const int row = tid >> 3, c4 = (tid & 7) * 4;
          f32x4 sum = *(const f32x4*)(part + row * 32 + c4);
#pragma unroll
          for (int w = 1; w < 8; ++w) sum += *(const f32x4*)(part + w * 2048 + row * 32 + c4);
          const size_t off = (size_t)(b * L + p0 + row) * D + c0 + c4;
          f32x4 x4; const f32x4 g4 = *(const f32x4*)(gate_ctx + c0 + c4);
          if (!SRC_LN) x4 = *(const f32x4*)((const float*)src_ctx + off);
          else { const int rU = r0 + row; const u32x2 w = *(const u32x2*)((const bf16*)src_ctx + off); x4 = (f32x4){bflo(w.x), bfhi(w.x), bflo(w.y), bfhi(w.y)};
              x4 = (x4 - rst[2 * rU]) * rst[2 * rU + 1] * *(const f32x4*)(lg + c0 + c4) + *(const f32x4*)(lb + c0 + c4); }
          const f32x4 vv = x4 * ALPHA + g4 * sum; u32x2 o; o.x = pk2(vv.x, vv.y); o.y = pk2(vv.z, vv.w);
          *(u32x2*)(dst_ctx + off) = o; }
        __syncthreads();
    }
}
__device__ __forceinline__ void ctx_up_tiles(const bf16* A, const bf16* Bt, bf16* O, int bid, int G, int wave, int l15, int quad) {
    for (int t = bid; t < 256; t += G) {
        const int rt = t >> 5, c0 = (t & 31) * 128 + (wave & 3) * 32, b = rt >> 2, r0 = b * TP + (rt & 3) * 64 + (wave >> 2) * 32;
        pg8::f32x4 acc[2][2];
#pragma unroll
        for (int i = 0; i < 2; ++i)
#pragma unroll
            for (int j = 0; j < 2; ++j) acc[i][j] = (pg8::f32x4){0.f, 0.f, 0.f, 0.f};
        frag_gemm<2, 2>(acc, Bt + (size_t)c0 * D, D, A + (size_t)r0 * D, D, 0, D, l15, quad);
#pragma unroll
        for (int i = 0; i < 2; ++i)
#pragma unroll
            for (int j = 0; j < 2; ++j) { float v[4];
#pragma unroll
                for (int rg = 0; rg < 4; ++rg) { const float a_ = fmaxf(acc[i][j][rg], 0.f); v[rg] = a_ * a_; }
                u32x2 o; o.x = pk2(v[0], v[1]); o.y = pk2(v[2], v[3]);
                *(u32x2*)(O + (size_t)(r0 + j * 16 + l15) * FF + c0 + i * 16 + quad * 4) = o; }
    }
}

template <int ACT>
__device__ __forceinline__ void ctx_ksplit_tiles(const bf16* A, const bf16* Bt, bf16* O, int ldo, int ntn, int ncols, float* part, int bid, int G, int tid, int wave, int l15, int quad) {
    for (int t = bid; t < 8 * ntn; t += G) {
        const int rt = t / ntn, c0 = (t % ntn) * 64, b = rt >> 2, r0 = b * TP + (rt & 3) * 64;
        pg8::f32x4 acc[4][4];
#pragma unroll
        for (int i = 0; i < 4; ++i)
#pragma unroll
            for (int j = 0; j < 4; ++j) acc[i][j] = (pg8::f32x4){0.f, 0.f, 0.f, 0.f};
        frag_gemm<4, 4>(acc, A + (size_t)r0 * D, D, Bt + (size_t)c0 * D, D, wave * 128, (wave + 1) * 128, l15, quad);
        float* pw = part + wave * 4096;
#pragma unroll
        for (int i = 0; i < 4; ++i)
#pragma unroll
            for (int j = 0; j < 4; ++j)
#pragma unroll
                for (int rg = 0; rg < 4; ++rg) pw[(i * 16 + quad * 4 + rg) * 64 + j * 16 + l15] = acc[i][j][rg];
        __syncthreads();
        { const int row = tid >> 3, c8 = (tid & 7) * 8;
          f32x4 s0 = *(const f32x4*)(part + row * 64 + c8), s1 = *(const f32x4*)(part + row * 64 + c8 + 4);
#pragma unroll
          for (int w = 1; w < 8; ++w) { s0 += *(const f32x4*)(part + w * 4096 + row * 64 + c8); s1 += *(const f32x4*)(part + w * 4096 + row * 64 + c8 + 4); }
          if (ACT == 1) {
#pragma unroll
              for (int k = 0; k < 4; ++k) { float a_ = fmaxf(s0[k], 0.f), b_ = fmaxf(s1[k], 0.f); s0[k] = a_ * a_; s1[k] = b_ * b_; } }
          u32x4 o; o.x = pk2(s0.x, s0.y); o.y = pk2(s0.z, s0.w); o.z = pk2(s1.x, s1.y); o.w = pk2(s1.z, s1.w);
          const int col = c0 + c8;
          if (col < ncols) *(u32x4*)(O + (size_t)(r0 + row) * ldo + col) = o; }
        __syncthreads();
    }
}

struct Args { const float* in[19]; float* out; unsigned char* ws; };

__global__ void __launch_bounds__(512, 2) fwd_kernel(Args a) {
    extern __shared__ __attribute__((aligned(16))) unsigned char lds[];
    cg::grid_group grid = cg::this_grid();
    const int G = gridDim.x, bid = blockIdx.x, NGW = G * 8;
#define IDS int tid = threadIdx.x; asm volatile("" : "+v"(tid)); const int lane = tid & 63, wave = __builtin_amdgcn_readfirstlane(tid >> 6), quad = lane >> 4, l15 = lane & 15, gw = bid * 8 + wave; (void)quad; (void)l15; (void)gw; (void)lane;
#define xin (a.in[0])
#define cvec (a.in[1])
#define ctx (a.in[2])
#define cctx (a.in[3])
#define w_mod (a.in[4])
#define b_mod (a.in[5])
#define ln_g (a.in[6])
#define ln_b (a.in[7])
#define theta (a.in[11])
#define gkw (a.in[12])
#define gkb (a.in[13])
#define normg (a.in[14])
#define sink (a.in[17])
#define WIN_T ((bf16*)(a.ws + OFF_WIN))
#define WOUT0_T ((bf16*)(a.ws + OFF_WOUT0))
#define W1_0_T ((bf16*)(a.ws + OFF_W1_0))
#define W2_0_T ((bf16*)(a.ws + OFF_W2_0))
#define WQKV_T ((bf16*)(a.ws + OFF_WQKV))
#define WOUT1_T ((bf16*)(a.ws + OFF_WOUT1))
#define W1_1_T ((bf16*)(a.ws + OFF_W1_1))
#define W2_1_T ((bf16*)(a.ws + OFF_W2_1))
#define mod ((float*)(a.ws + OFF_MOD))
#define rope ((float*)(a.ws + OFF_ROPE))
#define xctx ((float*)(a.ws + OFF_XCTX))
#define DEC ((float*)(a.ws + OFF_DEC))
#define H ((bf16*)(a.ws + OFF_H))
#define P ((bf16*)(a.ws + OFF_P))
#define ST ((bf16*)(a.ws + OFF_ST))
#define xlat (a.out)
#define RST(i) ((float*)(a.ws + OFF_RST) + (size_t)(i) * R * 2)
#define VLAT ((bf16*)a.out)
#define VCTX ((bf16*)(a.ws + OFF_XCTX))

#define LATE_ITEMS 9472
#define LATE_CHUNK 16
#define DRAIN_LATE(scr_, maxc_) do { int nclaim_ = 0; unsigned* qc_ = (unsigned*)(a.ws + OFF_XBAR) + 3584; volatile unsigned* qw_ = (volatile unsigned*)(lds + 131072 + 1024); \
        for (;;) { if (nclaim_++ >= (maxc_)) break; if (tid == 0) qw_[0] = __hip_atomic_fetch_add(qc_, (unsigned)LATE_CHUNK, __ATOMIC_RELAXED, __HIP_MEMORY_SCOPE_AGENT);     \
            __syncthreads(); const int base_ = (int)__builtin_amdgcn_readfirstlane(qw_[0]); __syncthreads(); \
            if (base_ >= LATE_ITEMS) break; \
            for (int k_ = wave; k_ < LATE_CHUNK; k_ += 8) { int r_ = base_ + k_; if (r_ >= LATE_ITEMS) break; \
                if (r_ < 2048) { transpose_item(a.in[8], 1024, FF, W1_0_T, (scr_), r_, lane); continue; } r_ -= 2048; \
                if (r_ < 2048) { transpose_item(a.in[9], FF, 1024, W2_0_T, (scr_), r_, lane); continue; } r_ -= 2048; \
                if (r_ < 768) { transpose_item(a.in[16], 1024, NQKV, WQKV_T, (scr_), r_, lane); continue; } r_ -= 768; \
                if (r_ < 512) { transpose_item(a.in[18], 1024, 1024, WOUT1_T, (scr_), r_, lane); continue; } r_ -= 512; \
                if (r_ < 2048) { transpose_item(a.in[8] + (size_t)1024 * FF, 1024, FF, W1_1_T, (scr_), r_, lane); continue; } r_ -= 2048; \
                transpose_item(a.in[9] + (size_t)FF * 1024, FF, 1024, W2_1_T, (scr_), r_, lane); } } } while (0)
    PG8_LAS unsigned char* ldsg = (PG8_LAS unsigned char*)lds;
    unsigned* barw = (unsigned*)(a.ws + OFF_BAR); unsigned bar_target = 0u; (void)barw; (void)bar_target;
    unsigned* xbw = (unsigned*)(a.ws + OFF_XBAR);
    volatile unsigned* xst = (volatile unsigned*)(lds + 131072 + 512);
    if (threadIdx.x == 0) { xst[0] = 0u; xst[1] = 0u; }
    XcdBarrier xbar = xcd_barrier_post(xbw, xst);
    if (a.ws == nullptr) grid.sync();

PROBE_BEGIN(1)
    { IDS
        float* sl = (float*)lds; float* red = (float*)(lds + 12288);
        for (int item = bid; item < 192; item += G) {
            for (int i = tid; i < 3072; i += 512) { const int j = i >> 10, k = i & 1023; const float v = (j < 2) ? cvec[j * 1024 + k] : cctx[k]; sl[i] = v / (1.f + expf(-v)); }
            __syncthreads();
            const int layer = item / 96, n0 = (item % 96) * 64;
            const float* W = w_mod + (size_t)layer * 1024 * 6144 + n0 + lane;
            float a0 = 0.f, a1 = 0.f, a2 = 0.f; const int k0 = wave * 128;
#pragma unroll 8
            for (int kk = 0; kk < 128; ++kk) { const int k = k0 + kk; const float w = W[(size_t)k * 6144]; a0 += sl[k] * w; a1 += sl[1024 + k] * w; a2 += sl[2048 + k] * w; }
            red[(wave * 3 + 0) * 64 + lane] = a0; red[(wave * 3 + 1) * 64 + lane] = a1; red[(wave * 3 + 2) * 64 + lane] = a2;
            __syncthreads();
            if (tid < 192) { const int j = tid >> 6, col = tid & 63; float s = b_mod[layer * 6144 + n0 + col];
#pragma unroll
                for (int w = 0; w < 8; ++w) s += red[(w * 3 + j) * 64 + col];
                mod[(layer * 3 + j) * 6144 + n0 + col] = s; }
            __syncthreads();
        }
        if (bid == G - 1 && tid < 16) {
            double f = 1.0; for (int i = 0; i < tid; ++i) f *= 0.56234132519034908;
            const double x2 = f * f; double cs = 1.0, sn = f, tc = 1.0, ts = f;
            for (int n = 1; n <= 12; ++n) { tc *= -x2 / (double)((2 * n - 1) * (2 * n)); cs += tc; ts *= -x2 / (double)((2 * n) * (2 * n + 1)); sn += ts; }
            double c = 1.0, s = 0.0;
            for (int p = 0; p < 128; ++p) { rope[(p * 16 + tid) * 2] = (float)c; rope[(p * 16 + tid) * 2 + 1] = (float)s; const double nc = c * cs - s * sn; s = s * cs + c * sn; c = nc; }
        }
        float* scr = (float*)(lds + 32768 + wave * 8448);
        for (int it = gw; it < 2064; it += NGW) {
            int r = it;
            if (r < 1552) { transpose_item(a.in[10], 1024, NPROJ, WIN_T, scr, r, lane); continue; } r -= 1552;
            transpose_item(a.in[15], 1024, 1024, WOUT0_T, scr, r, lane);
        }
        { u32x4* z = (u32x4*)(WIN_T + (size_t)NPROJ * D); const u32x4 zero = {0u, 0u, 0u, 0u};
          for (int i = bid * 512 + tid; i < (NPROJ_PAD - NPROJ) * D / 8; i += G * 512) z[i] = zero; }
    }
PROBE_END(1)
    xcd_barrier(xbar);


PROBE_BEGIN(2)
    { IDS
    for (int r = gw; r < R; r += 2 * NGW) {
        const int r2 = r + NGW; const bool has2 = r2 < R;
        bool isc, isc2; int b, b2; const size_t off = row_off(r, isc, b), off2 = row_off(has2 ? r2 : r, isc2, b2);
        const float* xr = (isc ? ctx : xin) + off; const float* md = mod + (isc ? 2 : b) * 6144;
        const float* xr2 = (isc2 ? ctx : xin) + off2; const float* md2 = mod + (isc2 ? 2 : b2) * 6144;
        f32x4 va[4], vb[4];
#pragma unroll
        for (int j = 0; j < 4; ++j) { va[j] = *(const f32x4*)(xr + lane * 4 + 256 * j); vb[j] = *(const f32x4*)(xr2 + lane * 4 + 256 * j); }
#pragma unroll
        for (int j = 0; j < 4; ++j) {
            const int idx = lane * 4 + 256 * j;
            { const f32x4 sh = *(const f32x4*)(md + idx), sc = *(const f32x4*)(md + 1024 + idx);
              const f32x4 h = va[j] * (sc + 1.f) + sh; u32x2 o; o.x = pk2(h.x, h.y); o.y = pk2(h.z, h.w);
              *(u32x2*)(H + (size_t)r * D + idx) = o; }
            if (has2) { const f32x4 sh = *(const f32x4*)(md2 + idx), sc = *(const f32x4*)(md2 + 1024 + idx);
              const f32x4 h = vb[j] * (sc + 1.f) + sh; u32x2 o; o.x = pk2(h.x, h.y); o.y = pk2(h.z, h.w);
              *(u32x2*)(H + (size_t)r2 * D + idx) = o; }
        }
    }
    }
PROBE_END(2)
    xcd_barrier(xbar);
    if (PROBE_SEL == 10) { for (int i = 0; i < 10; ++i) xcd_barrier(xbar); }

PROBE_BEGIN(8)
    { pg8::Gemm g{H, WIN_T, R, NPROJ_PAD, D}; pg8::StaticOrder S; S.init(R, NPROJ_PAD, G, bid); EpiStore<0> E{P, NPROJ, NPROJ};
      pg8::gemm_phase<EpiStore<0>, pg8::StaticOrder, true, true>(ldsg, g, S, E); }
PROBE_END(8)
    xcd_barrier(xbar);

PROBE_BEGIN(3)
#ifndef NO_P3
    { IDS
        float* cf = (float*)lds; float* cb = (float*)(lds + 16640); float* lrs = (float*)(lds + 33280); float* wl = (float*)(lds + 41728);
        bf16* kTf = (bf16*)(lds + 50432); bf16* kTb = (bf16*)(lds + 59648); bf16* vT = (bf16*)(lds + 68864);
        constexpr int NU = NB * 2 * 4 * NCH;
        const int s = tid & 63, dc = tid >> 6;
        u32x4 kv = {0u, 0u, 0u, 0u}, vv0 = kv, vv1 = kv; GatePre gp; gp.lr = (u32x2){0u, 0u}; gp.w = (f32x4){0.f, 0.f, 0.f, 0.f}; gp.bias = 0.f;
#define P3_LOAD(U) do { const int pc_ = (U) % NCH, t_ = (U) / NCH, h_ = t_ & 3, g_ = 1 - (t_ >> 3), b_ = (t_ >> 2) & 1; const bf16* Pr_ = P + (size_t)(b_ * TP + pc_ * 64) * NPROJ; \
            const int kcol_ = g_ ? 1792 + h_ * 64 : 256 + h_ * 64, vcol_ = g_ ? 2048 + h_ * 128 : 512 + h_ * 128; \
            kv = *(const u32x4*)(Pr_ + (size_t)s * NPROJ + kcol_ + dc * 8); vv0 = *(const u32x4*)(Pr_ + (size_t)s * NPROJ + vcol_ + dc * 8); vv1 = *(const u32x4*)(Pr_ + (size_t)s * NPROJ + vcol_ + (dc + 8) * 8); \
            gp = gate_prefetch(g_, h_, Pr_, gkw, gkb, tid); } while (0)
        if (bid < NU) P3_LOAD(bid);
        for (int unit = bid; unit < NU; unit += G) {
            const int pc = unit % NCH, t = unit / NCH, h = t & 3, g = 1 - (t >> 3), b = (t >> 2) & 1;
            const float kscale = g ? 1.f : 0.125f;
            float lgf = 0.f, lgb = 0.f;
            if (g) fill_cum3(cf, cb, lrs, wl, g, h, gp, theta, tid);
            else { lgf = log1pf(-expf(theta[h])); lgb = log1pf(-expf(theta[4 + h])); }
            {
              if (g) {
#pragma unroll
              for (int j = 0; j < 8; ++j) { const int d = dc * 8 + j; const unsigned u = kv[j >> 1]; const float kf = ((j & 1) ? bfhi(u) : bflo(u)) * kscale;
                  kTf[d * 72 + s] = (bf16)f2bf(kf * __expf(cf[63 * CS + d] - cf[s * CS + d]));
                  kTb[d * 72 + s] = (bf16)f2bf(kf * __expf(cb[d] - cb[s * CS + d])); }
              } else { const float ef = __expf((float)(63 - s) * lgf) * kscale, eb = __expf((float)s * lgb) * kscale;
#pragma unroll
              for (int j = 0; j < 8; ++j) { const int d = dc * 8 + j; const unsigned u = kv[j >> 1]; const float kf = (j & 1) ? bfhi(u) : bflo(u);
                  kTf[d * 72 + s] = (bf16)f2bf(kf * ef); kTb[d * 72 + s] = (bf16)f2bf(kf * eb); }
              }
#pragma unroll
              for (int j = 0; j < 8; ++j) { const unsigned u0 = vv0[j >> 1], u1 = vv1[j >> 1];
                  vT[(dc * 8 + j) * 72 + s] = (bf16)((j & 1) ? (u0 >> 16) : (u0 & 0xffffu)); vT[((dc + 8) * 8 + j) * 72 + s] = (bf16)((j & 1) ? (u1 >> 16) : (u1 & 0xffffu)); }
            }
            const int seq0 = ((b * 2 + g) * 4 + h) * 2;
            const int nf = pc, nbk = (pc < 4) ? 3 - pc : 135 - pc;
            if (tid < 128) { const int dir = tid >> 6, d = tid & 63;
                DEC[((size_t)(seq0 + dir) * NCH + (dir ? nbk : nf)) * 64 + d] = g ? (dir ? expf(cb[d]) : expf(cf[63 * CS + d])) : expf(64.f * (dir ? lgb : lgf)); }
            if (unit + G < NU) P3_LOAD(unit + G);
            __syncthreads();
            bf16x8 bfr[2];
#pragma unroll
            for (int ks = 0; ks < 2; ++ks) bfr[ks] = *(const bf16x8*)(vT + (wave * 16 + l15) * 72 + ks * 32 + quad * 8);
#pragma unroll
            for (int dir = 0; dir < 2; ++dir) {
                const bf16* kT = dir ? kTb : kTf;
                bf16* dst = ST + ((size_t)(seq0 + dir) * NCH + (dir ? nbk : nf)) * 8192 + (size_t)(wave * 16 + l15) * 64;
#pragma unroll
                for (int dt = 0; dt < 4; ++dt) {
                    pg8::f32x4 acc = {0.f, 0.f, 0.f, 0.f};
#pragma unroll
                    for (int ks = 0; ks < 2; ++ks) { const bf16x8 af = *(const bf16x8*)(kT + (dt * 16 + l15) * 72 + ks * 32 + quad * 8); acc = MFMA16(af, bfr[ks], acc); }
                    u32x2 o; o.x = pk2(acc[0], acc[1]); o.y = pk2(acc[2], acc[3]);
                    *(u32x2*)(dst + dt * 16 + quad * 4) = o;
                }
            }
            __syncthreads();
        }
#undef P3_LOAD
        if ((NU - bid + G - 1) / G < (NU + G - 1) / G) DRAIN_LATE((float*)(lds + wave * 8448), 1);
    }
#endif
PROBE_END(3)
    xcd_barrier(xbar);

PROBE_BEGIN(4)
    { IDS
    for (int i = bid * 512 + tid; i < 32 * 4096; i += G * 512) {
        const int seq = i >> 12, pi = i & 4095, d = (2 * pi) & 63;
        unsigned* sp = (unsigned*)(ST + (size_t)seq * NCH * 8192) + pi; const float* dp = DEC + (size_t)seq * NCH * 64 + d;
        float s0 = 0.f, s1 = 0.f;
#pragma unroll 4
        for (int n = 0; n < NCH; ++n) {
            const unsigned kv = sp[(size_t)n * 4096]; const float d0 = dp[n * 64], d1 = dp[n * 64 + 1];
            sp[(size_t)n * 4096] = pk2(s0, s1);
            s0 = d0 * s0 + bflo(kv); s1 = d1 * s1 + bfhi(kv);
        }
    }
    }
PROBE_END(4)
    xcd_barrier(xbar);

PROBE_BEGIN(5)
#ifndef NO_P5
    { IDS
        float* cf = (float*)lds; float* cb = (float*)(lds + 16640); float* lrs = (float*)(lds + 33280); float* wl = (float*)(lds + 41728);
        bf16* qdf = (bf16*)(lds + 50432); bf16* kif = (bf16*)(lds + 59648); bf16* qdb = (bf16*)(lds + 68864); bf16* kib = (bf16*)(lds + 78080);
        bf16* vT = (bf16*)(lds + 87296); bf16* Am = (bf16*)(lds + 105728); float* red = (float*)(lds + 114944);
        constexpr int NU = NB * 2 * 4 * NCH;
        const int dcq = tid & 7, sq = tid >> 3, sv = tid & 63, dcv = tid >> 6;
        u32x4 qv = {0u, 0u, 0u, 0u}, kv = qv, vv0 = qv, vv1 = qv; GatePre gp; gp.lr = (u32x2){0u, 0u}; gp.w = (f32x4){0.f, 0.f, 0.f, 0.f}; gp.bias = 0.f;
#define P5_LOAD(U) do { const int pc_ = (U) % NCH, t_ = (U) / NCH, h_ = t_ & 3, g_ = 1 - (t_ >> 3), b_ = (t_ >> 2) & 1; const bf16* Pr_ = P + (size_t)(b_ * TP + pc_ * 64) * NPROJ; \
            const int qcol_ = g_ ? 1536 + h_ * 64 : h_ * 64, kcol_ = g_ ? 1792 + h_ * 64 : 256 + h_ * 64, vcol_ = g_ ? 2048 + h_ * 128 : 512 + h_ * 128; \
            qv = *(const u32x4*)(Pr_ + (size_t)sq * NPROJ + qcol_ + dcq * 8); kv = *(const u32x4*)(Pr_ + (size_t)sq * NPROJ + kcol_ + dcq * 8); \
            vv0 = *(const u32x4*)(Pr_ + (size_t)sv * NPROJ + vcol_ + dcv * 8); vv1 = *(const u32x4*)(Pr_ + (size_t)sv * NPROJ + vcol_ + (dcv + 8) * 8); \
            gp = gate_prefetch(g_, h_, Pr_, gkw, gkb, tid); } while (0)
        if (bid < NU) P5_LOAD(bid);
        for (int unit = bid; unit < NU; unit += G) {
            const int pc = unit % NCH, t = unit / NCH, h = t & 3, g = 1 - (t >> 3), b = (t >> 2) & 1;
            const int r0 = b * TP + pc * 64;
            const int gcol = g ? 2560 + h * 128 : 1024 + h * 128;
            const float qscale = g ? 0.125f : 1.f, kscale = g ? 1.f : 0.125f;
            if (g) fill_cum3(cf, cb, lrs, wl, g, h, gp, theta, tid);
            { u32x4 o1, o2, o3, o4;
              if (g) {
#pragma unroll
              for (int j2 = 0; j2 < 4; ++j2) {
                  const int d = dcq * 8 + 2 * j2;
                  const float f0 = cf[sq * CS + d], f1 = cf[sq * CS + d + 1], b0 = cb[sq * CS + d], b1 = cb[sq * CS + d + 1];
                  const float q0 = bflo(qv[j2]) * qscale, q1 = bfhi(qv[j2]) * qscale, k0 = bflo(kv[j2]) * kscale, k1 = bfhi(kv[j2]) * kscale;
                  o1[j2] = pk2(q0 * __expf(f0), q1 * __expf(f1)); o2[j2] = pk2(k0 * __expf(-f0), k1 * __expf(-f1));
                  o3[j2] = pk2(q0 * __expf(b0), q1 * __expf(b1)); o4[j2] = pk2(k0 * __expf(-b0), k1 * __expf(-b1));
              }
              } else {
                  const float lgf = log1pf(-expf(theta[h])), lgb = log1pf(-expf(theta[4 + h]));
                  const float cfr = (float)(sq + 1) * lgf, cbr = (float)(64 - sq) * lgb;
                  const float ef = __expf(cfr) * qscale, eif = __expf(-cfr) * kscale, eb = __expf(cbr) * qscale, eib = __expf(-cbr) * kscale;
#pragma unroll
                  for (int j2 = 0; j2 < 4; ++j2) { const float q0 = bflo(qv[j2]), q1 = bfhi(qv[j2]), k0 = bflo(kv[j2]), k1 = bfhi(kv[j2]);
                      o1[j2] = pk2(q0 * ef, q1 * ef); o2[j2] = pk2(k0 * eif, k1 * eif); o3[j2] = pk2(q0 * eb, q1 * eb); o4[j2] = pk2(k0 * eib, k1 * eib); }
              }
              *(u32x4*)(qdf + sq * 72 + dcq * 8) = o1; *(u32x4*)(kif + sq * 72 + dcq * 8) = o2; *(u32x4*)(qdb + sq * 72 + dcq * 8) = o3; *(u32x4*)(kib + sq * 72 + dcq * 8) = o4;
#pragma unroll
              for (int j = 0; j < 8; ++j) { const unsigned u0 = vv0[j >> 1], u1 = vv1[j >> 1];
                  vT[(dcv * 8 + j) * 72 + sv] = (bf16)((j & 1) ? (u0 >> 16) : (u0 & 0xffffu)); vT[((dcv + 8) * 8 + j) * 72 + sv] = (bf16)((j & 1) ? (u1 >> 16) : (u1 & 0xffffu)); }
            }
            __syncthreads();
            const int ct = wave & 3, eh = wave >> 2;
            const int seq0 = ((b * 2 + g) * 4 + h) * 2;
            const int nf = pc, nbk = (pc < 4) ? 3 - pc : 135 - pc;
            const bf16* Sf = ST + ((size_t)seq0 * NCH + nf) * 8192; const bf16* Sb = ST + ((size_t)(seq0 + 1) * NCH + nbk) * 8192;
            const int r = r0 + ct * 16 + l15;
            bf16x8 a2[4][2], a3[4][2]; u32x2 gv[4];
#pragma unroll
            for (int et = 0; et < 4; ++et) { const int e = (eh * 4 + et) * 16 + l15;
#pragma unroll
                for (int ks = 0; ks < 2; ++ks) { a2[et][ks] = *(const bf16x8*)(Sf + e * 64 + ks * 32 + quad * 8); a3[et][ks] = *(const bf16x8*)(Sb + e * 64 + ks * 32 + quad * 8); }
                gv[et] = *(const u32x2*)(P + (size_t)r * NPROJ + gcol + (eh * 4 + et) * 16 + quad * 4); }
            { bf16x8 af[2], ab[2];
#pragma unroll
              for (int ks = 0; ks < 2; ++ks) { af[ks] = *(const bf16x8*)(qdf + (ct * 16 + l15) * 72 + ks * 32 + quad * 8); ab[ks] = *(const bf16x8*)(qdb + (ct * 16 + l15) * 72 + ks * 32 + quad * 8); }
#pragma unroll
              for (int i = 0; i < 2; ++i) { const int st = (wave >> 2) * 2 + i;
                  pg8::f32x4 accf = {0.f, 0.f, 0.f, 0.f}, accb = {0.f, 0.f, 0.f, 0.f};
#pragma unroll
                  for (int ks = 0; ks < 2; ++ks) {
                      const bf16x8 bf_ = *(const bf16x8*)(kif + (st * 16 + l15) * 72 + ks * 32 + quad * 8), bb_ = *(const bf16x8*)(kib + (st * 16 + l15) * 72 + ks * 32 + quad * 8);
                      accf = MFMA16(af[ks], bf_, accf); accb = MFMA16(ab[ks], bb_, accb); }
                  const int scol = st * 16 + l15;
#pragma unroll
                  for (int rg = 0; rg < 4; ++rg) { const int c = ct * 16 + quad * 4 + rg; Am[c * 72 + scol] = (bf16)f2bf(scol <= c ? accf[rg] : accb[rg]); }
              }
            }
            if (unit + G < NU) P5_LOAD(unit + G);
            __syncthreads();
            { bf16x8 bA[2], bQf[2], bQb[2];
#pragma unroll
              for (int ks = 0; ks < 2; ++ks) { const int o = (ct * 16 + l15) * 72 + ks * 32 + quad * 8; bA[ks] = *(const bf16x8*)(Am + o); bQf[ks] = *(const bf16x8*)(qdf + o); bQb[ks] = *(const bf16x8*)(qdb + o); }
              pg8::f32x4 acc[4]; float ss = 0.f;
#pragma unroll
              for (int et = 0; et < 4; ++et) { const int e = (eh * 4 + et) * 16 + l15;
                  pg8::f32x4 c4 = {0.f, 0.f, 0.f, 0.f};
#pragma unroll
                  for (int ks = 0; ks < 2; ++ks) {
                      const bf16x8 a1 = *(const bf16x8*)(vT + e * 72 + ks * 32 + quad * 8);
                      c4 = MFMA16(a1, bA[ks], c4); c4 = MFMA16(a2[et][ks], bQf[ks], c4); c4 = MFMA16(a3[et][ks], bQb[ks], c4); }
                  acc[et] = c4; ss += (c4[0] * c4[0] + c4[1] * c4[1]) + (c4[2] * c4[2] + c4[3] * c4[3]); }
              ss = quad_sum(ss);
              if (quad == 0) red[eh * 64 + ct * 16 + l15] = ss;
              __syncthreads();
              const float tot = red[ct * 16 + l15] + red[64 + ct * 16 + l15];
              const float rinv = 1.f / sqrtf(tot * (1.f / 128.f) + 1e-6f);
#pragma unroll
              for (int et = 0; et < 4; ++et) { const int e0 = (eh * 4 + et) * 16 + quad * 4;
                  float gt[4] = {bflo(gv[et].x), bfhi(gv[et].x), bflo(gv[et].y), bfhi(gv[et].y)}; float y[4];
#pragma unroll
                  for (int i = 0; i < 4; ++i) { const float ng = g ? normg[e0 + i] : 1.f; const float sg = gt[i] * __builtin_amdgcn_rcpf(1.f + __expf(-gt[i])); y[i] = sg * acc[et][i] * rinv * ng; }
                  u32x2 o; o.x = pk2(y[0], y[1]); o.y = pk2(y[2], y[3]);
                  *(u32x2*)(H + (size_t)r * D + g * 512 + h * 128 + e0) = o; }
            }
            __syncthreads();
        }
#undef P5_LOAD
        if ((NU - bid + G - 1) / G < (NU + G - 1) / G) DRAIN_LATE((float*)(lds + wave * 8448), 2);
    }
#endif
PROBE_END(5)
    xcd_barrier(xbar);

PROBE_BEGIN(12)
    { pg8::Gemm g{H, WOUT0_T, R, D, D}; LatOrder S; S.init(D, G, bid); EpiResid<0, false> E{xin, ctx, VLAT, VCTX, nullptr, mod + 2 * 1024, nullptr, nullptr, nullptr};
      pg8::gemm_phase<EpiResid<0, false>, LatOrder, true, true>(ldsg, g, S, E); }
    { IDS
      ctx_resid_tiles<false>(H, WOUT0_T, D, ctx, VCTX, mod + 2 * 6144 + 2 * 1024, nullptr, nullptr, nullptr, (float*)lds, bid, G, tid, wave, l15, quad); }
PROBE_END(12)
    xcd_barrier(xbar);
PROBE_BEGIN(7)
    { IDS
    DRAIN_LATE((float*)(lds + wave * 8448), 1 << 30);
    ln_phase<false, false>(RST(0), VLAT, VCTX, nullptr, nullptr, ln_g, ln_b, mod + 3 * 1024, H, gw, NGW, lane);
    }
PROBE_END(7)
    xcd_barrier(xbar);
PROBE_BEGIN(11)
    { pg8::Gemm g{H, W1_0_T, R, FF, D}; LatOrder S; S.init(FF, G, bid); EpiStore<1> E{P, FF, FF};
      pg8::gemm_phase<EpiStore<1>, LatOrder, true, true>(ldsg, g, S, E); }
    { IDS
      ctx_ksplit_tiles<1>(H, W1_0_T, P, FF, 64, FF, (float*)lds, bid, G, tid, wave, l15, quad); }
PROBE_END(11)
    xcd_barrier(xbar);
PROBE_BEGIN(9)
    { pg8::Gemm g{P, W2_0_T, R, D, FF}; LatOrder S; S.init(D, G, bid); EpiResid<1, false> E{VLAT, VCTX, VLAT, VCTX, nullptr, mod + 5 * 1024, RST(0), ln_g, ln_b};
      pg8::gemm_phase<EpiResid<1, false>, LatOrder, true, true>(ldsg, g, S, E); }
    { IDS
      ctx_resid_tiles<true>(P, W2_0_T, FF, VCTX, VCTX, mod + 2 * 6144 + 5 * 1024, RST(0), ln_g, ln_b, (float*)lds, bid, G, tid, wave, l15, quad); }
PROBE_END(9)
    xcd_barrier(xbar);
    { IDS
    ln_phase<false, false>(RST(1), VLAT, VCTX, nullptr, nullptr, ln_g + 1024, ln_b + 1024, mod + 3 * 6144, H, gw, NGW, lane);
    }
    xcd_barrier(xbar);

PROBE_BEGIN(13)
    { pg8::Gemm g{H, WQKV_T, R, NQKV, D}; pg8::StaticOrder S; S.init(R, NQKV, G, bid); EpiStore<0> E{P, NQKV, NQKV};
      pg8::gemm_phase<EpiStore<0>, pg8::StaticOrder, true, true>(ldsg, g, S, E); }
PROBE_END(13)
    xcd_barrier(xbar);

PROBE_BEGIN(6)
#ifndef NO_P12
    { IDS
        bf16* Qs = (bf16*)lds; bf16* Ks = (bf16*)(lds + 73728); bf16* Vt = (bf16*)(lds + 82944); float* ropes = (float*)(lds + 92160);
        for (int i = tid; i < 1024; i += 512) ((f32x4*)ropes)[i] = ((const f32x4*)rope)[i];
        PACC_DECL
        for (int unit = bid; unit < NB * 4 * 64; unit += G) {
            PACC_BEGIN(40)
            const int nb = unit & 63, kvh = (unit >> 6) & 3, b = unit >> 8;
#define ATT_VALID(t) ((t) < 4 || (unsigned)(nb - 1 + (((t) - 4) >> 1)) < 64u)
#define ATT_KPOS(t) ((nb - 1 + (((t) - 4) >> 1)) * 128 + (((t) - 4) & 1) * 64)
#define ATT_KROW(t) ((t) < 4 ? b * TP + (t) * 64 : b * TP + L + ATT_KPOS(t))
            const int keyk = tid >> 2, pck = tid & 3, c1k = (pck & 1) + (pck >> 1) * 4, keyv = tid & 63, dcv = tid >> 6;
            u32x4 pk1 = {0u, 0u, 0u, 0u}, pk2_ = pk1, pvv = pk1;
#define ATT_LOAD(t) do { const int kr_ = ATT_KROW(t); \
                if (tid < 256) { const bf16* src_ = P + (size_t)(kr_ + keyk) * NQKV + 1024 + kvh * 64; pk1 = *(const u32x4*)(src_ + c1k * 8); pk2_ = *(const u32x4*)(src_ + (c1k + 2) * 8); } \
                pvv = *(const u32x4*)(P + (size_t)(kr_ + keyv) * NQKV + 1280 + kvh * 64 + dcv * 8); } while (0)
            ATT_LOAD(0);
            __syncthreads();
#pragma unroll
            for (int i = 0; i < 4; ++i) {
                const int it = tid + i * 512, pcq = it & 3, row = it >> 2, g = row >> 7, qi = row & 127, pos = nb * 128 + qi;
                const bf16* src = P + (size_t)(b * TP + L + pos) * NQKV + (kvh * 4 + g) * 64;
                const int c1 = (pcq & 1) + (pcq >> 1) * 4;
                const u32x4 u1 = *(const u32x4*)(src + c1 * 8), u2 = *(const u32x4*)(src + (c1 + 2) * 8);
                const int pv = (pcq < 2) ? (pos >> 6) : (pos & 63);
                const f32x4* tab = (const f32x4*)(ropes + (pv * 16 + (c1 & 1) * 8) * 2);
                u32x4 o1, o2;
#pragma unroll
                for (int j2 = 0; j2 < 4; ++j2) { const f32x4 cs = tab[j2];
                    const float a0 = bflo(u1[j2]), a1 = bfhi(u1[j2]), b0 = bflo(u2[j2]), b1 = bfhi(u2[j2]);
                    o1[j2] = pk2((a0 * cs.x - b0 * cs.y) * QSC, (a1 * cs.z - b1 * cs.w) * QSC); o2[j2] = pk2((a0 * cs.y + b0 * cs.x) * QSC, (a1 * cs.w + b1 * cs.z) * QSC); }
                *(u32x4*)(Qs + row * 72 + c1 * 8) = o1; *(u32x4*)(Qs + row * 72 + (c1 + 2) * 8) = o2;
            }
            const int g = wave & 3, qh = wave >> 2, qrow0 = g * 128 + qh * 64, qpos0 = nb * 128 + qh * 64;
            float mrun[4], lrun[4]; pg8::f32x4 O[4][4];
            const float sk = sink[kvh * 4 + g] * 1.4426950408889634f;
#pragma unroll
            for (int qt = 0; qt < 4; ++qt) { mrun[qt] = sk; lrun[qt] = (quad == 0) ? 1.f : 0.f;
#pragma unroll
                for (int dt = 0; dt < 4; ++dt) O[dt][qt] = (pg8::f32x4){0.f, 0.f, 0.f, 0.f}; }
            PACC_END(40)
            int ti = 0;
            while (ti < 10) {
                PACC_BEGIN(41)
                const bool local = ti >= 4;
                const int kpos0 = local ? ATT_KPOS(ti) : 0;
                const int side = local ? ((ti - 4) >> 1) - 1 : 0;
                __syncthreads();
                if (tid < 256) {
                    u32x4 o1 = pk1, o2 = pk2_;
                    if (local) {
                        const int pos = kpos0 + keyk, pv = (pck < 2) ? (pos >> 6) : (pos & 63);
                        const f32x4* tab = (const f32x4*)(ropes + (pv * 16 + (c1k & 1) * 8) * 2);
#pragma unroll
                        for (int j2 = 0; j2 < 4; ++j2) { const f32x4 cs = tab[j2];
                            const float a0 = bflo(pk1[j2]), a1 = bfhi(pk1[j2]), b0 = bflo(pk2_[j2]), b1 = bfhi(pk2_[j2]);
                            o1[j2] = pk2(a0 * cs.x - b0 * cs.y, a1 * cs.z - b1 * cs.w); o2[j2] = pk2(a0 * cs.y + b0 * cs.x, a1 * cs.w + b1 * cs.z); }
                    }
                    *(u32x4*)(Ks + keyk * 72 + c1k * 8) = o1; *(u32x4*)(Ks + keyk * 72 + (c1k + 2) * 8) = o2;
                }
#pragma unroll
                for (int j = 0; j < 8; ++j) { const unsigned u = pvv[j >> 1]; Vt[(dcv * 8 + j) * 72 + keyv] = (bf16)((j & 1) ? (u >> 16) : (u & 0xffffu)); }
                __syncthreads();
                PACC_END(41)
                PACC_BEGIN(42)
                int tn = ti + 1;
                while (tn < 10 && !ATT_VALID(tn)) ++tn;
                if (tn < 10) ATT_LOAD(tn);
                if (!((side < 0 && ((ti - 4) & 1) == 0 && qh == 1) || (side > 0 && ((ti - 4) & 1) == 1 && qh == 0))) {
                bf16x8 kfr[4][2];
#pragma unroll
                for (int kt = 0; kt < 4; ++kt)
#pragma unroll
                    for (int ks = 0; ks < 2; ++ks) kfr[kt][ks] = *(const bf16x8*)(Ks + (kt * 16 + l15) * 72 + ks * 32 + quad * 8);
#pragma unroll
                for (int qt = 0; qt < 4; ++qt) {
                    pg8::f32x4 S[4];
#pragma unroll
                    for (int kt = 0; kt < 4; ++kt) S[kt] = (pg8::f32x4){0.f, 0.f, 0.f, 0.f};
#pragma unroll
                    for (int ks = 0; ks < 2; ++ks) { const bf16x8 qf = *(const bf16x8*)(Qs + (qrow0 + qt * 16 + l15) * 72 + ks * 32 + quad * 8);
#pragma unroll
                        for (int kt = 0; kt < 4; ++kt) S[kt] = MFMA16(kfr[kt][ks], qf, S[kt]); }
                    float mx = -INFINITY;
                    if (side < 0 && ((ti - 4) & 1) == qh) {
                        const int tl = quad * 4 - (qpos0 + qt * 16 + l15 - kpos0 - 128);
#pragma unroll
                        for (int kt = 0; kt < 4; ++kt)
#pragma unroll
                            for (int rg = 0; rg < 4; ++rg) { const float sv_ = (tl >= -(kt * 16 + rg)) ? S[kt][rg] : -INFINITY; S[kt][rg] = sv_; mx = fmaxf(mx, sv_); }
                    } else if (side > 0 && ((ti - 4) & 1) == qh) {
                        const int th = (qpos0 + qt * 16 + l15 - kpos0 + 128) - quad * 4;
#pragma unroll
                        for (int kt = 0; kt < 4; ++kt)
#pragma unroll
                            for (int rg = 0; rg < 4; ++rg) { const float sv_ = (th >= (kt * 16 + rg)) ? S[kt][rg] : -INFINITY; S[kt][rg] = sv_; mx = fmaxf(mx, sv_); }
                    } else {
#pragma unroll
                        for (int kt = 0; kt < 4; ++kt)
#pragma unroll
                            for (int rg = 0; rg < 4; ++rg) mx = fmaxf(mx, S[kt][rg]);
                    }
                    mx = quad_max(mx);
                    const float mnew = fmaxf(mrun[qt], mx), al = __builtin_amdgcn_exp2f(mrun[qt] - mnew); mrun[qt] = mnew;
                    float ps = 0.f;
#pragma unroll
                    for (int kt = 0; kt < 4; ++kt)
#pragma unroll
                        for (int rg = 0; rg < 4; ++rg) { const float p = __builtin_amdgcn_exp2f(S[kt][rg] - mnew); S[kt][rg] = p; ps += p; }
                    lrun[qt] = lrun[qt] * al + ps;
#pragma unroll
                    for (int dt = 0; dt < 4; ++dt) O[dt][qt] = O[dt][qt] * al;
#pragma unroll
                    for (int s2 = 0; s2 < 2; ++s2) {
                        u32x4 pw; pw.x = pk2(S[2 * s2][0], S[2 * s2][1]); pw.y = pk2(S[2 * s2][2], S[2 * s2][3]);
                        pw.z = pk2(S[2 * s2 + 1][0], S[2 * s2 + 1][1]); pw.w = pk2(S[2 * s2 + 1][2], S[2 * s2 + 1][3]);
                        const bf16x8 pf = __builtin_bit_cast(bf16x8, pw);
#pragma unroll
                        for (int dt = 0; dt < 4; ++dt) {
                            const s16x4 lo = *(const s16x4*)(Vt + (dt * 16 + l15) * 72 + s2 * 32 + quad * 4), hi = *(const s16x4*)(Vt + (dt * 16 + l15) * 72 + s2 * 32 + 16 + quad * 4);
                            O[dt][qt] = MFMA16(__builtin_shufflevector(lo, hi, 0, 1, 2, 3, 4, 5, 6, 7), pf, O[dt][qt]); }
                    }
                }
                }
                ti = tn;
                PACC_END(42)
            }
            PACC_BEGIN(43)
#pragma unroll
            for (int qt = 0; qt < 4; ++qt) {
                const float lt = quad_sum(lrun[qt]);
                const float inv = 1.f / lt;
                const int r = b * TP + L + qpos0 + qt * 16 + l15;
#pragma unroll
                for (int dt = 0; dt < 4; ++dt) { u32x2 o; o.x = pk2(O[dt][qt][0] * inv, O[dt][qt][1] * inv); o.y = pk2(O[dt][qt][2] * inv, O[dt][qt][3] * inv);
                    *(u32x2*)(H + (size_t)r * D + (kvh * 4 + g) * 64 + dt * 16 + quad * 4) = o; }
            }
            PACC_END(43)
#undef ATT_VALID
#undef ATT_KPOS
#undef ATT_KROW
#undef ATT_LOAD
        }
        PACC_SLEEP()
    }
#endif
PROBE_END(6)
    xcd_barrier(xbar);

PROBE_BEGIN(14)
    { pg8::Gemm g{H, WOUT1_T, R, D, D}; LatOrder S; S.init(D, G, bid); EpiResid<1, false> E{VLAT, VCTX, VLAT, VCTX, nullptr, mod + 3 * 6144 + 2 * 1024, RST(1), ln_g + 1024, ln_b + 1024};
      pg8::gemm_phase<EpiResid<1, false>, LatOrder, true, true>(ldsg, g, S, E); }
PROBE_END(14)
    xcd_barrier(xbar);
    { IDS
    ln_phase<false, true>(RST(2), VLAT, VCTX, nullptr, nullptr, ln_g + 2048, ln_b + 2048, mod + 3 * 6144 + 3 * 1024, H, gw, NGW, lane);
    }
    xcd_barrier(xbar);
PROBE_BEGIN(15)
    { pg8::Gemm g{H, W1_1_T, R, FF, D}; LatOrder S; S.init(FF, G, bid); EpiStore<1> E{P, FF, FF};
      pg8::gemm_phase<EpiStore<1>, LatOrder, true, true>(ldsg, g, S, E); }
PROBE_END(15)
    xcd_barrier(xbar);
PROBE_BEGIN(16)
    { pg8::Gemm g{P, W2_1_T, R, D, FF}; LatOrder S; S.init(D, G, bid); EpiResid<1, true> E{VLAT, VCTX, nullptr, nullptr, H, mod + 3 * 6144 + 5 * 1024, RST(2), ln_g + 2048, ln_b + 2048};
      pg8::gemm_phase<EpiResid<1, true>, LatOrder, true, true>(ldsg, g, S, E); }
PROBE_END(16)
    xcd_barrier(xbar);
    { IDS
    ln_phase<true, true>(nullptr, nullptr, nullptr, H, a.out, ln_g + 3072, ln_b + 3072, mod, H, gw, NGW, lane);
    }
}

extern "C" void kernel_launch(void* const* d_in, const int* in_sizes, int n_in, void* d_out, int out_size, void* d_ws, size_t ws_size, hipStream_t stream) {
    static int grid = 0;
    if (grid == 0) {
        if (n_in != 19 || out_size != NB * T * D || ws_size < WS_TOTAL) { fprintf(stderr, "kernel_launch: unexpected shapes (n_in %d out %d ws %zu)\n", n_in, out_size, ws_size); grid = -1; return; }
        int dev = 0, cus = 0, per_cu = 0;
        hipGetDevice(&dev); hipDeviceGetAttribute(&cus, hipDeviceAttributeMultiprocessorCount, dev);
        if (hipFuncSetAttribute((const void*)fwd_kernel, hipFuncAttributeMaxDynamicSharedMemorySize, LDS_BYTES) != hipSuccess) { fprintf(stderr, "kernel_launch: hipFuncSetAttribute failed\n"); grid = -1; return; }
        if (hipOccupancyMaxActiveBlocksPerMultiprocessor(&per_cu, (const void*)fwd_kernel, 512, LDS_BYTES) != hipSuccess || per_cu < 1) per_cu = 1;
        (void)hipGetLastError();
        grid = cus > 0 ? cus : 256;
    }
    if (grid < 0) return;
    Args a{};
    for (int i = 0; i < 19; ++i) a.in[i] = (const float*)d_in[i];
    a.out = (float*)d_out; a.ws = (unsigned char*)d_ws;
    if (hipMemsetAsync((char*)d_ws + OFF_XBAR, 0, 16384, stream) != hipSuccess) { fprintf(stderr, "kernel_launch: hipMemsetAsync of the barrier words failed\n"); return; }
    void* args[] = {&a};
    hipError_t e = hipLaunchCooperativeKernel((const void*)fwd_kernel, dim3(grid), dim3(512), args, LDS_BYTES, stream);
    if (e != hipSuccess) fprintf(stderr, "cooperative launch failed: %s (grid %d)\n", hipGetErrorString(e), grid);
}
```

```cpp
#include <hip/hip_runtime.h>
#include <hip/hip_cooperative_groups.h>
#include <cstdio>
#include <cstdint>
namespace cg = cooperative_groups;
namespace pg8 {
#define PG8_LAS __attribute__((address_space(3)))
typedef unsigned short bf16_t;
typedef short bf16x8 __attribute__((ext_vector_type(8)));
typedef float f32x4 __attribute__((ext_vector_type(4)));
typedef unsigned u32x4 __attribute__((ext_vector_type(4)));
constexpr int BM = 256, BK = 64, HALF = 128, HTB = HALF * BK * 2  , STAGE_BYTES = 8 * HTB, NXCD = 8, WGM = 8;

__host__ __device__ __forceinline__ int lds_byte(int r, int c) { const int st = (r >> 4) * 2 + (c >> 5), rr = r & 15, cc = c & 31, ob = rr * 64 + cc * 2; return st * 1024 + (ob ^ (((ob >> 9) & 1) << 5)); }
__host__ __device__ __forceinline__ void stage_rc(int b, int& R, int& C) { const int st = b / 1024, sb = b % 1024, swz = sb ^ (((sb >> 9) & 1) << 5); R = (st >> 1) * 16 + swz / 64; C = (st & 1) * 32 + (swz % 64) / 2; }
__host__ __device__ __forceinline__ int perm32(int rho) { const int n = rho >> 4, i = rho & 15; return 8 * (i >> 2) + 4 * n + (i & 3); }

struct Unit { int pm, pn; };
struct Gemm { const bf16_t* A; const bf16_t* Bt; int M, N, K; };

struct StaticOrder {
    int nM, nN, nwg, G, c;
    __host__ __device__ void init(int M, int N, int G_, int c_) { nM = M / BM; nN = N / BM; nwg = nM * nN; G = G_; c = c_; }
    __host__ __device__ bool next(int i, Unit& u) const {
        const long L = (long)i * G + c; if (L >= nwg) return false;
        int wgid = (int)L; { const int q = nwg / NXCD, r = nwg % NXCD, xcd = wgid % NXCD, off = wgid / NXCD; wgid = (xcd < r ? xcd * (q + 1) : r * (q + 1) + (xcd - r) * q) + off; }
        const int nig = WGM * nN, gid = wgid / nig, fm = gid * WGM, gsz = (nM - fm) < WGM ? (nM - fm) : WGM;
        u.pm = fm + ((wgid % nig) % gsz); u.pn = (wgid % nig) / gsz; return true;
    }
    __device__ __forceinline__ void a_ready(const Unit&) const {}
    __device__ __forceinline__ void done(const Unit&) const {}
};

__device__ __forceinline__ unsigned cvt_pk_bf16(float lo, float hi) { unsigned r; asm volatile("v_cvt_pk_bf16_f32 %0, %1, %2" : "=v"(r) : "v"(lo), "v"(hi)); return r; }

template <class Epi, class Sched, bool ALIGN_EPI = false, bool SP2 = false>
__device__ __forceinline__ void gemm_phase(PG8_LAS unsigned char* lds, const Gemm g, const Sched& S, const Epi& E) {
    int tid = threadIdx.x; asm volatile("" : "+v"(tid));
    const int wid = __builtin_amdgcn_readfirstlane(tid >> 6), lane = tid & 63, wr = wid >> 2, wc = wid & 3, fr = lane & 15, fq = lane >> 4;
    const int K = g.K, nt = K / BK;
    unsigned voffA[2], voffB[2];
#pragma unroll
    for (int i = 0; i < 2; ++i) { int R, C; stage_rc(tid * 16 + i * 8192, R, C); const int Rb = Epi::PERM ? ((R & ~31) + perm32(R & 31)) : R;
        voffA[i] = (unsigned)(R * K + C) * 2u; voffB[i] = (unsigned)(Rb * K + C) * 2u; }
    const size_t kstep = (size_t)(BK * 2);
    const size_t hstep = (size_t)HALF * K * 2;
    const size_t tstep = 2 * hstep;
    const unsigned ldsw = (unsigned)wid * 1024u;
    const int aoff = lds_byte(wr * 64 + fr, fq * 8), boff = lds_byte(wc * 32 + fr, fq * 8);
#define PG8_SA(b, h) (((b) * 2 + (h)) * HTB)
#define PG8_SB(b, h) ((4 + (b) * 2 + (h)) * HTB)
#define PG8_STAGE(bufoff, gbase, voff) do { _Pragma("unroll") for (int _i = 0; _i < 2; ++_i) \
        __builtin_amdgcn_global_load_lds((const unsigned*)((const char*)(gbase) + (voff)[_i]), (PG8_LAS unsigned*)(lds + (bufoff) + ldsw + _i * 8192), 16, 0, 0); } while (0)
#define PG8_LDA(dst, b, h) do { _Pragma("unroll") for (int m = 0; m < 4; ++m) _Pragma("unroll") for (int k = 0; k < 2; ++k) dst[m][k] = *(const PG8_LAS bf16x8*)(lds + PG8_SA(b, h) + aoff + m * 2048 + k * 1024); } while (0)
#define PG8_LDB(dst, b, h) do { _Pragma("unroll") for (int n = 0; n < 2; ++n) _Pragma("unroll") for (int k = 0; k < 2; ++k) dst[n][k] = *(const PG8_LAS bf16x8*)(lds + PG8_SB(b, h) + boff + n * 2048 + k * 1024); } while (0)
#define PG8_MMA(ai, bj, At, Bt) do { __builtin_amdgcn_s_setprio(1); _Pragma("unroll") for (int m = 0; m < 4; ++m) _Pragma("unroll") for (int n = 0; n < 2; ++n) _Pragma("unroll") for (int k = 0; k < 2; ++k) \
        acc[ai][bj][m][n] = __builtin_amdgcn_mfma_f32_16x16x32_bf16(Bt[n][k], At[m][k], acc[ai][bj][m][n], 0, 0, 0); __builtin_amdgcn_s_setprio(0); } while (0)
#define PG8_WAIT_V(n) asm volatile("s_waitcnt vmcnt(" #n ")" ::: "memory")
#define PG8_WAIT_L(n) asm volatile("s_waitcnt lgkmcnt(" #n ")" ::: "memory")
#define PG8_BAR __builtin_amdgcn_s_barrier()
#define PG8_SCHED __builtin_amdgcn_sched_barrier(0)
    Unit cur, nxt; int ui = 0;
    if (!S.next(0, cur)) return;
    f32x4 acc[2][2][4][2];
#pragma unroll
    for (int a = 0; a < 2; ++a)
#pragma unroll
        for (int b = 0; b < 2; ++b)
#pragma unroll
            for (int m = 0; m < 4; ++m)
#pragma unroll
                for (int n = 0; n < 2; ++n) acc[a][b][m][n] = (f32x4){0.f, 0.f, 0.f, 0.f};
    bf16x8 At[4][2], B0[2][2], B1[2][2];
    const char* cA = (const char*)g.A + (size_t)cur.pm * tstep; const char* cB = (const char*)g.Bt + (size_t)cur.pn * tstep;
    S.a_ready(cur);
    if constexpr (SP2) {
        PG8_STAGE(PG8_SB(0, 0), cB, voffB); PG8_STAGE(PG8_SB(0, 1), cB + hstep, voffB); PG8_STAGE(PG8_SA(0, 0), cA, voffA); PG8_STAGE(PG8_SA(0, 1), cA + hstep, voffA);
        if (wr == 1) PG8_BAR;
        PG8_WAIT_V(2); PG8_BAR;
        PG8_STAGE(PG8_SB(1, 0), cB + kstep, voffB); PG8_STAGE(PG8_SA(1, 0), cA + kstep, voffA); PG8_STAGE(PG8_SB(1, 1), cB + hstep + kstep, voffB);
        PG8_WAIT_V(6); PG8_BAR;
    } else {
        PG8_STAGE(PG8_SB(0, 0), cB, voffB); PG8_STAGE(PG8_SA(0, 0), cA, voffA); PG8_STAGE(PG8_SB(0, 1), cB + hstep, voffB); PG8_STAGE(PG8_SA(0, 1), cA + hstep, voffA);
        if (wr == 1) PG8_BAR;
        PG8_WAIT_V(4); PG8_BAR;
        PG8_STAGE(PG8_SB(1, 0), cB + kstep, voffB); PG8_STAGE(PG8_SA(1, 0), cA + kstep, voffA); PG8_STAGE(PG8_SB(1, 1), cB + hstep + kstep, voffB);
        PG8_WAIT_V(6); PG8_BAR;
    }
    for (;;) {
        const bool has_next = S.next(ui + 1, nxt);
        const char* nA = has_next ? (const char*)g.A + (size_t)nxt.pm * tstep : cA; const char* nB = has_next ? (const char*)g.Bt + (size_t)nxt.pn * tstep : cB;
        for (int t = 0; t < nt; t += 2) {
            const bool last = (t == nt - 2);
            const char* a1 = cA + (size_t)(t + 1) * kstep;
            const char* a2 = last ? nA : cA + (size_t)(t + 2) * kstep; const char* b2 = last ? nB : cB + (size_t)(t + 2) * kstep;
            const char* a3 = a2 + kstep; const char* b3 = b2 + kstep;
            if (last && has_next) S.a_ready(nxt);
            if constexpr (SP2) {
            PG8_LDB(B0, 0, 0); PG8_LDB(B1, 0, 1); PG8_SCHED; PG8_LDA(At, 0, 0); PG8_STAGE(PG8_SA(1, 1), a1 + hstep, voffA);
            PG8_WAIT_V(8); PG8_WAIT_L(0); PG8_BAR; PG8_MMA(0, 0, At, B0); PG8_MMA(0, 1, At, B1); PG8_BAR; PG8_SCHED;
            PG8_LDA(At, 0, 1); PG8_STAGE(PG8_SB(0, 0), b2, voffB); PG8_STAGE(PG8_SB(0, 1), b2 + hstep, voffB); PG8_STAGE(PG8_SA(0, 0), a2, voffA);
            PG8_WAIT_V(8); PG8_WAIT_L(0); PG8_BAR; PG8_MMA(1, 0, At, B0); PG8_MMA(1, 1, At, B1); PG8_BAR; PG8_SCHED;
            PG8_LDB(B0, 1, 0); PG8_LDB(B1, 1, 1); PG8_SCHED; PG8_LDA(At, 1, 0); PG8_STAGE(PG8_SA(0, 1), a2 + hstep, voffA);
            PG8_WAIT_V(8); PG8_WAIT_L(0); PG8_BAR; PG8_MMA(0, 0, At, B0); PG8_MMA(0, 1, At, B1); PG8_BAR; PG8_SCHED;
            PG8_LDA(At, 1, 1); PG8_STAGE(PG8_SB(1, 0), b3, voffB); PG8_STAGE(PG8_SB(1, 1), b3 + hstep, voffB); PG8_STAGE(PG8_SA(1, 0), a3, voffA);
            PG8_WAIT_V(8); PG8_WAIT_L(0); PG8_BAR; PG8_MMA(1, 0, At, B0); PG8_MMA(1, 1, At, B1); PG8_BAR; PG8_SCHED;
            } else {
            PG8_LDB(B0, 0, 0); PG8_SCHED; PG8_LDA(At, 0, 0); PG8_STAGE(PG8_SA(1, 1), a1 + hstep, voffA);
            PG8_WAIT_L(8); PG8_BAR; PG8_WAIT_L(0); PG8_MMA(0, 0, At, B0); PG8_BAR; PG8_SCHED;
            PG8_LDB(B1, 0, 1); PG8_STAGE(PG8_SB(0, 0), b2, voffB);
            PG8_BAR; PG8_WAIT_L(0); PG8_MMA(0, 1, At, B1); PG8_BAR;
            PG8_LDA(At, 0, 1); PG8_STAGE(PG8_SA(0, 0), a2, voffA);
            PG8_BAR; PG8_WAIT_L(0); PG8_MMA(1, 0, At, B0); PG8_BAR; PG8_SCHED;
            PG8_STAGE(PG8_SB(0, 1), b2 + hstep, voffB);
            PG8_WAIT_V(6); PG8_BAR; PG8_MMA(1, 1, At, B1); PG8_BAR;
            PG8_LDB(B0, 1, 0); PG8_SCHED; PG8_LDA(At, 1, 0); PG8_STAGE(PG8_SA(0, 1), a2 + hstep, voffA);
            PG8_WAIT_L(8); PG8_BAR; PG8_WAIT_L(0); PG8_MMA(0, 0, At, B0); PG8_BAR; PG8_SCHED;
            PG8_LDB(B1, 1, 1); PG8_STAGE(PG8_SB(1, 0), b3, voffB);
            PG8_BAR; PG8_WAIT_L(0); PG8_MMA(0, 1, At, B1); PG8_BAR;
            PG8_LDA(At, 1, 1); PG8_STAGE(PG8_SA(1, 0), a3, voffA);
            PG8_BAR; PG8_WAIT_L(0); PG8_MMA(1, 0, At, B0); PG8_BAR; PG8_SCHED;
            PG8_STAGE(PG8_SB(1, 1), b3 + hstep, voffB);
            PG8_WAIT_V(6); PG8_BAR; PG8_MMA(1, 1, At, B1); PG8_BAR;
            }
        }
        if constexpr (ALIGN_EPI) { if (wr == 0) PG8_BAR; }
        if constexpr (!Epi::AFTER_DRAIN) { E(acc, cur, wr, wc, fr, fq); S.done(cur); }
        if (!has_next) break;
#pragma unroll
        for (int a = 0; a < 2; ++a)
#pragma unroll
            for (int b = 0; b < 2; ++b)
#pragma unroll
                for (int m = 0; m < 4; ++m)
#pragma unroll
                    for (int n = 0; n < 2; ++n) acc[a][b][m][n] = (f32x4){0.f, 0.f, 0.f, 0.f};
        cur = nxt; cA = nA; cB = nB; ++ui;
        if constexpr (ALIGN_EPI) { if (wr == 1) PG8_BAR; }
    }
    PG8_WAIT_V(0);
    if constexpr (!ALIGN_EPI) { if (wr == 0) PG8_BAR; }
    PG8_BAR;
    if constexpr (Epi::AFTER_DRAIN) { E.fused(acc, cur, wr, wc, fr, fq, lds, wid, lane); S.done(cur); }
#undef PG8_SA
#undef PG8_SB
#undef PG8_STAGE
#undef PG8_LDA
#undef PG8_LDB
#undef PG8_MMA
#undef PG8_WAIT_V
#undef PG8_WAIT_L
#undef PG8_BAR
#undef PG8_SCHED
}
}

constexpr int NB = 2, T = 8192, L = 256, D = 1024, TP = T + L, R = NB * TP;
constexpr int FF = 4096, NPROJ = 3104, NPROJ_PAD = 3328, NQKV = 1536, NCH = TP / 64;
constexpr float ALPHA = 1.4142135623730951f;
constexpr int LDS_BYTES = 147456;

typedef unsigned short bf16;
typedef float f32x4 __attribute__((ext_vector_type(4)));
typedef short bf16x8 __attribute__((ext_vector_type(8)));
typedef short s16x4 __attribute__((ext_vector_type(4)));
typedef unsigned u32x4 __attribute__((ext_vector_type(4)));
typedef unsigned u32x2 __attribute__((ext_vector_type(2)));

constexpr size_t OFF_WIN = 0;
constexpr size_t OFF_WOUT0 = OFF_WIN + (size_t)NPROJ_PAD * D * 2;
constexpr size_t OFF_W1_0 = OFF_WOUT0 + (size_t)D * D * 2;
constexpr size_t OFF_W2_0 = OFF_W1_0 + (size_t)FF * D * 2;
constexpr size_t OFF_WQKV = OFF_W2_0 + (size_t)FF * D * 2;
constexpr size_t OFF_WOUT1 = OFF_WQKV + (size_t)NQKV * D * 2;
constexpr size_t OFF_W1_1 = OFF_WOUT1 + (size_t)D * D * 2;
constexpr size_t OFF_W2_1 = OFF_W1_1 + (size_t)FF * D * 2;
constexpr size_t OFF_MOD = OFF_W2_1 + (size_t)FF * D * 2;
constexpr size_t OFF_ROPE = OFF_MOD + 2 * 3 * 6144 * 4;
constexpr size_t OFF_BAR = OFF_ROPE + 128 * 16 * 8;
constexpr size_t OFF_XBAR = OFF_BAR + 256;
constexpr size_t OFF_RST = OFF_XBAR + 16384;
constexpr size_t OFF_XCTX = OFF_RST + (size_t)3 * R * 2 * 4;
constexpr size_t OFF_DEC = OFF_XCTX + (size_t)NB * L * D * 4;
constexpr size_t OFF_H = OFF_DEC + (size_t)32 * NCH * 64 * 4;
constexpr size_t OFF_P = OFF_H + (size_t)R * D * 2;
constexpr size_t OFF_ST = OFF_P + (size_t)R * NPROJ * 2;
constexpr size_t WS_TOTAL = OFF_ST + (size_t)32 * NCH * 8192 * 2;
static_assert(WS_TOTAL <= 268435456, "workspace map exceeds 256 MiB");
static_assert(OFF_P + (size_t)R * FF * 2 <= WS_TOTAL, "MLP hidden overlay");

typedef float f32x2_t __attribute__((ext_vector_type(2)));
typedef __bf16 bf16x2_t __attribute__((ext_vector_type(2)));
__device__ __forceinline__ unsigned pk2(float lo, float hi) { const f32x2_t v = {lo, hi}; const bf16x2_t b = __builtin_convertvector(v, bf16x2_t); return __builtin_bit_cast(unsigned, b); }
__device__ __forceinline__ unsigned f2bf(float f) { return pk2(f, f) & 0xffffu; }
__device__ __forceinline__ float bf2f(unsigned h) { return __uint_as_float(h << 16); }
__device__ __forceinline__ float bflo(unsigned u) { return __uint_as_float(u << 16); }
__device__ __forceinline__ float bfhi(unsigned u) { return __uint_as_float(u & 0xffff0000u); }
__device__ __forceinline__ float quad_max(float x) {
    const unsigned u = __float_as_uint(x);
    const auto r = __builtin_amdgcn_permlane32_swap(u, u, false, false);
    const float m = fmaxf(__uint_as_float(r[0]), __uint_as_float(r[1]));
    const unsigned v = __float_as_uint(m);
    const auto q = __builtin_amdgcn_permlane16_swap(v, v, false, false);
    return fmaxf(__uint_as_float(q[0]), __uint_as_float(q[1]));
}
__device__ __forceinline__ float quad_sum(float x) {
    const unsigned u = __float_as_uint(x);
    const auto r = __builtin_amdgcn_permlane32_swap(u, u, false, false);
    const float m = __uint_as_float(r[0]) + __uint_as_float(r[1]);
    const unsigned v = __float_as_uint(m);
    const auto q = __builtin_amdgcn_permlane16_swap(v, v, false, false);
    return __uint_as_float(q[0]) + __uint_as_float(q[1]);
}
__device__ __forceinline__ float dpp_add(float v, int ctrl_sel) {
    const int u = __float_as_int(v);
    const int t = ctrl_sel == 0 ? __builtin_amdgcn_update_dpp(0, u, 0xB1, 0xF, 0xF, true) : ctrl_sel == 1 ? __builtin_amdgcn_update_dpp(0, u, 0x4E, 0xF, 0xF, true)
                : ctrl_sel == 2 ? __builtin_amdgcn_update_dpp(0, u, 0x141, 0xF, 0xF, true) : __builtin_amdgcn_update_dpp(0, u, 0x140, 0xF, 0xF, true);
    return v + __int_as_float(t);
}
__device__ __forceinline__ float wave_sum(float v) { v = dpp_add(v, 0); v = dpp_add(v, 1); v = dpp_add(v, 2); v = dpp_add(v, 3); return quad_sum(v); }
#define MFMA16(a, b, c) __builtin_amdgcn_mfma_f32_16x16x32_bf16((a), (b), (c), 0, 0, 0)

__device__ __forceinline__ size_t row_off(int r, bool& isc, int& b) { b = (r >= TP) ? 1 : 0; const int p = r - b * TP; isc = p < L; return isc ? (size_t)(b * L + p) * D : (size_t)(b * T + p - L) * D; }

template <int ACT> struct EpiStore {
    static constexpr bool PERM = true, AFTER_DRAIN = false;
    bf16* O; int ldc; int ncols;
    __device__ __forceinline__ void operator()(const pg8::f32x4 (&acc)[2][2][4][2], const pg8::Unit& u, int wr, int wc, int fr, int fq) const {
        const int row0 = u.pm * 256 + wr * 64 + fr, col0 = u.pn * 256 + wc * 32 + 8 * fq;
#pragma unroll
        for (int ai = 0; ai < 2; ++ai)
#pragma unroll
            for (int m = 0; m < 4; ++m) {
                bf16* rowp = O + (size_t)(row0 + ai * 128 + m * 16) * ldc;
#pragma unroll
                for (int bj = 0; bj < 2; ++bj) {
                    const int col = col0 + bj * 128;
                    pg8::f32x4 v0 = acc[ai][bj][m][0], v1 = acc[ai][bj][m][1];
                    if (ACT == 1) {
#pragma unroll
                        for (int i = 0; i < 4; ++i) { float a = fmaxf(v0[i], 0.f), b = fmaxf(v1[i], 0.f); v0[i] = a * a; v1[i] = b * b; }
                    }
                    u32x4 w; w.x = pg8::cvt_pk_bf16(v0[0], v0[1]); w.y = pg8::cvt_pk_bf16(v0[2], v0[3]); w.z = pg8::cvt_pk_bf16(v1[0], v1[1]); w.w = pg8::cvt_pk_bf16(v1[2], v1[3]);
                    if (col < ncols) *(u32x4*)(rowp + col) = w;
                }
            }
    }
};
template <int SRC, bool DST_FIN> struct EpiResid {
    static constexpr bool PERM = true, AFTER_DRAIN = false;
    const void* src_lat; const void* src_ctx; bf16* dst_lat; bf16* dst_ctx; bf16* dst_fin; const float* gate;
    const float* rst; const float* lg; const float* lb;
    __device__ __forceinline__ void operator()(const pg8::f32x4 (&acc)[2][2][4][2], const pg8::Unit& u, int wr, int wc, int fr, int fq) const {
        const int b = u.pm > 33 ? 1 : 0, col0 = u.pn * 256 + wc * 32 + 8 * fq, rt0 = wr * 64 + fr;
        const size_t lat0 = (size_t)(u.pm * 256 - b * TP - L + b * T);
        const float* gt = gate + b * 6144;
#pragma unroll
        for (int bj = 0; bj < 2; ++bj) {
            const int col = col0 + bj * 128;
            const f32x4 g0 = *(const f32x4*)(gt + col), g1 = *(const f32x4*)(gt + col + 4);
            f32x4 l0, l1, m0, m1;
            if (SRC == 1) { l0 = *(const f32x4*)(lg + col); l1 = *(const f32x4*)(lg + col + 4); m0 = *(const f32x4*)(lb + col); m1 = *(const f32x4*)(lb + col + 4); }
#pragma unroll
            for (int ai = 0; ai < 2; ++ai)
#pragma unroll
                for (int m = 0; m < 4; ++m) {
                    const int rt = rt0 + ai * 128 + m * 16, row = u.pm * 256 + rt; const size_t off = (lat0 + rt) * D + col;
                    f32x4 x0, x1;
                    if (SRC == 0) { const float* sp = (const float*)src_lat + off; x0 = *(const f32x4*)sp; x1 = *(const f32x4*)(sp + 4); }
                    else { const float mean = rst[2 * row], rstd = rst[2 * row + 1];
                        const u32x4 w = *(const u32x4*)((const bf16*)src_lat + off);
                        x0 = (f32x4){bflo(w.x), bfhi(w.x), bflo(w.y), bfhi(w.y)}; x1 = (f32x4){bflo(w.z), bfhi(w.z), bflo(w.w), bfhi(w.w)};
                        x0 = (x0 - mean) * rstd * l0 + m0; x1 = (x1 - mean) * rstd * l1 + m1; }
                    const pg8::f32x4 a0 = acc[ai][bj][m][0], a1 = acc[ai][bj][m][1];
                    u32x4 o; o.x = pk2(ALPHA * x0.x + g0.x * a0[0], ALPHA * x0.y + g0.y * a0[1]); o.y = pk2(ALPHA * x0.z + g0.z * a0[2], ALPHA * x0.w + g0.w * a0[3]);
                    o.z = pk2(ALPHA * x1.x + g1.x * a1[0], ALPHA * x1.y + g1.y * a1[1]); o.w = pk2(ALPHA * x1.z + g1.z * a1[2], ALPHA * x1.w + g1.w * a1[3]);
                    bf16* dp = DST_FIN ? dst_fin + (size_t)row * D + col : dst_lat + off;
                    *(u32x4*)dp = o;
                }
        }
    }
};

__device__ __forceinline__ void transpose_item(const float* __restrict__ W, int K, int N, bf16* WT, float* scr, int item, int lane) {
    const int nblk = N / 32, kb = item / nblk, nb = item % nblk, k0 = 64 * kb, n0 = 32 * nb;
#pragma unroll 8
    for (int i = 0; i < 32; ++i) { const int kk = 2 * i + (lane >> 5); scr[kk * 33 + (lane & 31)] = W[(size_t)(k0 + kk) * N + n0 + (lane & 31)]; }
    asm volatile("s_waitcnt lgkmcnt(0)" ::: "memory");
    const int c = lane & 7;
#pragma unroll
    for (int j = 0; j < 4; ++j) { const int n = (lane >> 3) + 8 * j; const float* s = scr + (8 * c) * 33 + n;
        u32x4 o; o.x = pk2(s[0 * 33], s[1 * 33]); o.y = pk2(s[2 * 33], s[3 * 33]); o.z = pk2(s[4 * 33], s[5 * 33]); o.w = pk2(s[6 * 33], s[7 * 33]);
        *(u32x4*)(WT + (size_t)(n0 + n) * K + k0 + 8 * c) = o; }
    asm volatile("s_waitcnt lgkmcnt(0)" ::: "memory");
}

template <bool LAST, bool SKIPCTX>
__device__ __forceinline__ void ln_phase(float* rst, const bf16* vlat, const bf16* vctx, const bf16* vfin, float* outp, const float* __restrict__ g, const float* __restrict__ bt, const float* __restrict__ modn, bf16* H, int gw, int NGW, int lane) {
    int r = gw;
    if (SKIPCTX) { while (r < R) { const int p = r >= TP ? r - TP : r; if (p >= L) break; r += NGW; } }
    u32x4 vn[2];
    if (r < R) { bool isc; int b; const size_t off = row_off(r, isc, b); const bf16* xr = LAST ? vfin + (size_t)r * D : (isc ? vctx : vlat) + off;
#pragma unroll
        for (int j = 0; j < 2; ++j) vn[j] = *(const u32x4*)(xr + lane * 8 + 512 * j); }
    while (r < R) {
        bool isc; int b; const size_t off = row_off(r, isc, b);
        float v[16];
#pragma unroll
        for (int j = 0; j < 2; ++j)
#pragma unroll
            for (int i = 0; i < 4; ++i) { v[j * 8 + 2 * i] = bflo(vn[j][i]); v[j * 8 + 2 * i + 1] = bfhi(vn[j][i]); }
        int rn = r + NGW;
        if (SKIPCTX) { while (rn < R) { const int p = rn >= TP ? rn - TP : rn; if (p >= L) break; rn += NGW; } }
        if (rn < R) { bool isc2; int b2; const size_t off2 = row_off(rn, isc2, b2); const bf16* xr2 = LAST ? vfin + (size_t)rn * D : (isc2 ? vctx : vlat) + off2;
#pragma unroll
            for (int j = 0; j < 2; ++j) vn[j] = *(const u32x4*)(xr2 + lane * 8 + 512 * j); }
        float s = 0.f;
#pragma unroll
        for (int i = 0; i < 16; ++i) s += v[i];
        const float mean = wave_sum(s) * (1.f / D); float s2 = 0.f;
#pragma unroll
        for (int i = 0; i < 16; ++i) { v[i] -= mean; s2 += v[i] * v[i]; }
        const float rstd = 1.f / sqrtf(wave_sum(s2) * (1.f / D) + 1e-5f);
        const float* md = modn + (isc ? 2 : b) * 6144;
        if (!LAST && lane == 0) { rst[2 * r] = mean; rst[2 * r + 1] = rstd; }
#pragma unroll
        for (int j = 0; j < 2; ++j) {
            const int idx = lane * 8 + 512 * j;
            float y[8];
#pragma unroll
            for (int q = 0; q < 2; ++q) { const f32x4 gg = *(const f32x4*)(g + idx + 4 * q), bb = *(const f32x4*)(bt + idx + 4 * q);
#pragma unroll
                for (int i = 0; i < 4; ++i) y[q * 4 + i] = v[j * 8 + q * 4 + i] * rstd * gg[i] + bb[i]; }
            if (LAST) { *(f32x4*)(outp + off + idx) = (f32x4){y[0], y[1], y[2], y[3]}; *(f32x4*)(outp + off + idx + 4) = (f32x4){y[4], y[5], y[6], y[7]}; }
            else {
                float h[8];
#pragma unroll
                for (int q = 0; q < 2; ++q) { const f32x4 sh = *(const f32x4*)(md + idx + 4 * q), sc = *(const f32x4*)(md + 1024 + idx + 4 * q);
#pragma unroll
                    for (int i = 0; i < 4; ++i) h[q * 4 + i] = y[q * 4 + i] * (sc[i] + 1.f) + sh[i]; }
                u32x4 o; o.x = pk2(h[0], h[1]); o.y = pk2(h[2], h[3]); o.z = pk2(h[4], h[5]); o.w = pk2(h[6], h[7]);
                *(u32x4*)(H + (size_t)r * D + idx) = o;
            }
        }
        r = rn;
    }
}

__device__ __forceinline__ float log_sigmoid(float z) { return fminf(z, 0.f) - __logf(1.f + __expf(-fabsf(z))); }

constexpr int CS = 65;
constexpr float QSC = 0.125f * 1.4426950408889634f;
struct GatePre { u32x2 lr; f32x4 w; float bias; };
__device__ __forceinline__ GatePre gate_prefetch(int g, int h, const bf16* Pr, const float* gkw, const float* gkb, int tid) {
    GatePre p; p.lr = (u32x2){0u, 0u}; p.w = (f32x4){0.f, 0.f, 0.f, 0.f}; p.bias = 0.f;
    if (g) { const int c = tid >> 3, part = tid & 7;
        p.lr = *(const u32x2*)(Pr + (size_t)c * NPROJ + 3072 + part * 4);
        const int idx = tid * 4, dir = idx >> 10, r = (idx >> 6) & 15, d = idx & 63;
        p.w = *(const f32x4*)(gkw + (dir * 16 + r) * 256 + h * 64 + d);
        if (tid < 128) p.bias = gkb[(tid >> 6) * 256 + h * 64 + (tid & 63)]; }
    return p;
}
__device__ __forceinline__ void fill_cum3(float* cf, float* cb, float* lrs, float* wl, int g, int h, const GatePre& gp, const float* theta, int tid) {
    if (g == 0) {
        const float lgf = log1pf(-expf(theta[h])), lgb = log1pf(-expf(theta[4 + h]));
        for (int i = tid; i < 4096; i += 512) { const int c = i >> 6, d = i & 63; cf[c * CS + d] = (float)(c + 1) * lgf; cb[c * CS + d] = (float)(64 - c) * lgb; }
        __syncthreads();
        return;
    }
    { const int c = tid >> 3, part = tid & 7;
      float* lp = lrs + c * 33 + part * 4; lp[0] = bflo(gp.lr.x); lp[1] = bfhi(gp.lr.x); lp[2] = bflo(gp.lr.y); lp[3] = bfhi(gp.lr.y);
      *(f32x4*)(wl + tid * 4) = gp.w;
      if (tid < 128) wl[2048 + tid] = gp.bias; }
    __syncthreads();
    { const int c = tid >> 3, dg = tid & 7;
#pragma unroll
      for (int dir = 0; dir < 2; ++dir) {
          f32x4 za = *(const f32x4*)(wl + 2048 + dir * 64 + dg * 8), zb = *(const f32x4*)(wl + 2048 + dir * 64 + dg * 8 + 4);
#pragma unroll
          for (int r = 0; r < 16; ++r) { const float lv = lrs[c * 33 + dir * 16 + r];
              za += lv * *(const f32x4*)(wl + (dir * 16 + r) * 64 + dg * 8); zb += lv * *(const f32x4*)(wl + (dir * 16 + r) * 64 + dg * 8 + 4); }
          float* dst = (dir ? cb : cf) + c * CS + dg * 8;
#pragma unroll
          for (int j = 0; j < 4; ++j) { dst[j] = log_sigmoid(za[j]) * (1.f / 16.f); dst[4 + j] = log_sigmoid(zb[j]) * (1.f / 16.f); } } }
    __syncthreads();
    if (tid < 128) {
        const int dir = tid >> 6; float* arr = (dir ? cb : cf) + (tid & 63);
        float run = 0.f;
#pragma unroll
        for (int hh = 0; hh < 2; ++hh) {
            float v[32];
            const int base = dir ? (1 - hh) * 32 : hh * 32;
#pragma unroll
            for (int c = 0; c < 32; ++c) v[c] = arr[(base + c) * CS];
            if (dir == 0) {
#pragma unroll
                for (int c = 0; c < 32; ++c) { run += v[c]; arr[(base + c) * CS] = run; }
            } else {
#pragma unroll
                for (int c = 31; c >= 0; --c) { run += v[c]; arr[(base + c) * CS] = run; }
            }
        }
    }
    __syncthreads();
}

__device__ __forceinline__ void fast_bar(unsigned* ctr, unsigned& target) {
    asm volatile("s_waitcnt vmcnt(0)" ::: "memory");
    __syncthreads();
    target += gridDim.x;
    if (threadIdx.x == 0) {
        __builtin_amdgcn_fence(__ATOMIC_RELEASE, "agent");
        asm volatile("s_waitcnt vmcnt(0)" ::: "memory");
        __hip_atomic_fetch_add(ctr, 1u, __ATOMIC_RELAXED, __HIP_MEMORY_SCOPE_AGENT);
        while (__hip_atomic_load(ctr, __ATOMIC_RELAXED, __HIP_MEMORY_SCOPE_AGENT) < target) __builtin_amdgcn_s_sleep(1);
        __builtin_amdgcn_fence(__ATOMIC_ACQUIRE, "agent");
        asm volatile("s_waitcnt vmcnt(0)" ::: "memory");
    }
    __syncthreads();
}
#define RLX_AGENT __ATOMIC_RELAXED, __HIP_MEMORY_SCOPE_AGENT
#define XB_TMO      128
#define XB_XCNT(j)  (256  + 64 * (j))
#define XB_XSUB(j)  (1280 + 64 * (j))
#define XB_XGEN(j)  (2304 + 64 * (j))
#define XB_TOP      3328
#define XB_TOPGEN   3392
#define XCD_BAR_WORDS 3456
#define XB_SPIN_CAP (1u << 18)

__device__ __forceinline__ unsigned xb_ld(unsigned* p)              { return __hip_atomic_load(p, __ATOMIC_RELAXED, __HIP_MEMORY_SCOPE_AGENT); }
__device__ __forceinline__ unsigned xb_add(unsigned* p, unsigned v) { return __hip_atomic_fetch_add(p, v, __ATOMIC_RELAXED, __HIP_MEMORY_SCOPE_AGENT); }
__device__ __forceinline__ unsigned xb_xcc_id() { return (unsigned)__builtin_amdgcn_s_getreg((3 << 11) | 20) & 0xFu; }
#define XB_SPIN(cond, bar) do { unsigned _sp = 0; while (cond) { __builtin_amdgcn_s_sleep(1); \
    if ((++_sp & 255u) == 0u) { if (xb_ld(&(bar)[XB_TMO])) break; if (_sp > XB_SPIN_CAP) { atomicAdd(&(bar)[XB_TMO], 1u); break; } } } } while (0)

struct XcdBarrier {
    unsigned* bar; unsigned x;
    volatile unsigned* st;
};

__device__ __forceinline__ XcdBarrier xcd_barrier_post(unsigned* bar, volatile unsigned* st) {
    XcdBarrier b; b.bar = bar; b.x = xb_xcc_id(); b.st = st;
    if (threadIdx.x == 0) (void)xb_add(&bar[XB_XCNT(b.x)], 1u);
    return b;
}
__device__ __forceinline__ void xcd_barrier_complete(unsigned* bar, unsigned x, unsigned& nloc, unsigned& nx) {
    const unsigned G = gridDim.x * gridDim.y * gridDim.z;
    unsigned sum, cnt, mine, sp = 0u;
    for (;;) {
        sum = 0u; cnt = 0u; mine = 0u;
#pragma unroll
        for (unsigned j = 0; j < 16; ++j) { const unsigned c = xb_ld(&bar[XB_XCNT(j)]); sum += c; cnt += (c > 0u) ? 1u : 0u; mine = (j == x) ? c : mine; }
        if (sum == G) break;
        __builtin_amdgcn_s_sleep(1);
        if ((++sp & 255u) == 0u) { if (xb_ld(&bar[XB_TMO])) break; if (sp > XB_SPIN_CAP) { atomicAdd(&bar[XB_TMO], 1u); break; } }
    }
    nloc = mine > 0u ? mine : 1u; nx = cnt > 0u ? cnt : 1u;
}

__device__ __forceinline__ void xcd_barrier(const XcdBarrier& b) {
    asm volatile("s_waitcnt vmcnt(0)" ::: "memory");
    __syncthreads();
    if (threadIdx.x == 0) {
        unsigned* bar = b.bar;
        __builtin_amdgcn_s_waitcnt(0);
        unsigned nloc = b.st[0], nx = b.st[1];
        if (nloc == 0u) { xcd_barrier_complete(bar, b.x, nloc, nx); b.st[0] = nloc; b.st[1] = nx; }
        const unsigned old = xb_add(&bar[XB_XSUB(b.x)], 1u);
        const unsigned gen = old / nloc;
        if (old + 1u == (gen + 1u) * nloc) {
            __builtin_amdgcn_fence(__ATOMIC_RELEASE, "agent");
            asm volatile("s_waitcnt vmcnt(0)" ::: "memory");
            const unsigned og = xb_add(&bar[XB_TOP], 1u);
            const unsigned tg = og / nx;
            if (og + 1u == (tg + 1u) * nx) xb_add(&bar[XB_TOPGEN], 1u);
            else XB_SPIN(xb_ld(&bar[XB_TOPGEN]) == tg, bar);
            __builtin_amdgcn_fence(__ATOMIC_ACQUIRE, "agent");
            xb_add(&bar[XB_XGEN(b.x)], 1u);
            asm volatile("s_waitcnt vmcnt(0)" ::: "memory");
        } else {
            XB_SPIN(xb_ld(&bar[XB_XGEN(b.x)]) == gen, bar);
            __builtin_amdgcn_fence(__ATOMIC_ACQUIRE, "agent");
            asm volatile("s_waitcnt vmcnt(0)" ::: "memory");
        }
    }
    __syncthreads();
}

struct LatOrder {
    pg8::StaticOrder S;
    __device__ void init(int N, int G, int c) { S.init(NB * T, N, G, c); }
    __device__ bool next(int i, pg8::Unit& u) const { if (!S.next(i, u)) return false; u.pm = u.pm + 1 + (u.pm >= 32 ? 1 : 0); return true; }
    __device__ __forceinline__ void a_ready(const pg8::Unit&) const {}
    __device__ __forceinline__ void done(const pg8::Unit&) const {}
};
#ifndef PROBE_SEL
#define PROBE_SEL 0
#endif
#ifndef PROBE_MUL
#define PROBE_MUL 3
#endif
#define PACC_DECL unsigned long long pacc = 0, pacc_t0 = 0; (void)pacc; (void)pacc_t0;
#define PACC_BEGIN(k) if (PROBE_SEL == (k)) pacc_t0 = __builtin_amdgcn_s_memrealtime();
#define PACC_END(k) if (PROBE_SEL == (k)) pacc += __builtin_amdgcn_s_memrealtime() - pacc_t0;
#define PACC_SLEEP() if (PROBE_SEL >= 40 && PROBE_SEL < 60) { const unsigned long long t1 = __builtin_amdgcn_s_memrealtime(), dt = pacc * PROBE_MUL; while (__builtin_amdgcn_s_memrealtime() - t1 < dt) __builtin_amdgcn_s_sleep(8); }
#define PROBE_BEGIN(k) unsigned long long pt0_##k = 0; if (PROBE_SEL == (k)) pt0_##k = __builtin_amdgcn_s_memrealtime();
#define PROBE_END(k) if (PROBE_SEL == (k)) { const unsigned long long t1 = __builtin_amdgcn_s_memrealtime(), dt = (t1 - pt0_##k) * PROBE_MUL; while (__builtin_amdgcn_s_memrealtime() - t1 < dt) __builtin_amdgcn_s_sleep(8); }


template <int XT, int YT>
__device__ __forceinline__ void frag_gemm(pg8::f32x4 (&acc)[XT][YT], const bf16* X, int ldx, const bf16* Y, int ldy, int k0, int k1, int l15, int quad) {
#pragma unroll 4
    for (int k = k0; k < k1; k += 32) {
        bf16x8 xf[XT], yf[YT];
#pragma unroll
        for (int i = 0; i < XT; ++i) xf[i] = *(const bf16x8*)(X + (size_t)(i * 16 + l15) * ldx + k + quad * 8);
#pragma unroll
        for (int j = 0; j < YT; ++j) yf[j] = *(const bf16x8*)(Y + (size_t)(j * 16 + l15) * ldy + k + quad * 8);
#pragma unroll
        for (int i = 0; i < XT; ++i)
#pragma unroll
            for (int j = 0; j < YT; ++j) acc[i][j] = MFMA16(xf[i], yf[j], acc[i][j]);
    }
}
template <bool SRC_LN>
__device__ __forceinline__ void ctx_resid_tiles(const bf16* A, const bf16* Bt, int K, const void* src_ctx, bf16* dst_ctx, const float* gate_ctx, const float* rst, const float* lg, const float* lb, float* part, int bid, int G, int tid, int wave, int l15, int quad) {
    for (int t = bid; t < 256; t += G) {
        const int rt = t >> 5, c0 = (t & 31) * 32, b = rt >> 2, p0 = (rt & 3) * 64, r0 = b * TP + p0;
        pg8::f32x4 acc[4][2];
#pragma unroll
        for (int i = 0; i < 4; ++i)
#pragma unroll
            for (int j = 0; j < 2; ++j) acc[i][j] = (pg8::f32x4){0.f, 0.f, 0.f, 0.f};
        const int ksl = K >> 3;
        frag_gemm<4, 2>(acc, A + (size_t)r0 * K, K, Bt + (size_t)c0 * K, K, wave * ksl, (wave + 1) * ksl, l15, quad);
        float* pw = part + wave * 2048;
#pragma unroll
        for (int i = 0; i < 4; ++i)
#pragma unroll
            for (int j = 0; j < 2; ++j)
#pragma unroll
                for (int rg = 0; rg < 4; ++rg) pw[(i * 16 + quad * 4 + rg) * 32 + j * 16 + l15] = acc[i][j][rg];
        __syncthreads();
        { const int row = tid >> 3, c4 = (tid & 7) * 4;
          f32x4 sum = *(const f32x4*)(part + row * 32 + c4);
#pragma unroll
          for (int w = 1; w < 8; ++w) sum += *(const f32x4*)(part + w * 2048 + row * 32 + c4);
          const size_t off = (size_t)(b * L + p0 + row) * D + c0 + c4;
          f32x4 x4; const f32x4 g4 = *(const f32x4*)(gate_ctx + c0 + c4);
          if (!SRC_LN) x4 = *(const f32x4*)((const float*)src_ctx + off);
          else { const int rU = r0 + row; const u32x2 w = *(const u32x2*)((const bf16*)src_ctx + off); x4 = (f32x4){bflo(w.x), bfhi(w.x), bflo(w.y), bfhi(w.y)};
              x4 = (x4 - rst[2 * rU]) * rst[2 * rU + 1] * *(const f32x4*)(lg + c0 + c4) + *(const f32x4*)(lb + c0 + c4); }
          const f32x4 vv = x4 * ALPHA + g4 * sum; u32x2 o; o.x = pk2(vv.x, vv.y); o.y = pk2(vv.z, vv.w);
          *(u32x2*)(dst_ctx + off) = o; }
        __syncthreads();
    }
}
__device__ __forceinline__ void ctx_up_tiles(const bf16* A, const bf16* Bt, bf16* O, int bid, int G, int wave, int l15, int quad) {
    for (int t = bid; t < 256; t += G) {
        const int rt = t >> 5, c0 = (t & 31) * 128 + (wave & 3) * 32, b = rt >> 2, r0 = b * TP + (rt & 3) * 64 + (wave >> 2) * 32;
        pg8::f32x4 acc[2][2];
#pragma unroll
        for (int i = 0; i < 2; ++i)
#pragma unroll
            for (int j = 0; j < 2; ++j) acc[i][j] = (pg8::f32x4){0.f, 0.f, 0.f, 0.f};
        frag_gemm<2, 2>(acc, Bt + (size_t)c0 * D, D, A + (size_t)r0 * D, D, 0, D, l15, quad);
#pragma unroll
        for (int i = 0; i < 2; ++i)
#pragma unroll
            for (int j = 0; j < 2; ++j) { float v[4];
#pragma unroll
                for (int rg = 0; rg < 4; ++rg) { const float a_ = fmaxf(acc[i][j][rg], 0.f); v[rg] = a_ * a_; }
                u32x2 o; o.x = pk2(v[0], v[1]); o.y = pk2(v[2], v[3]);
                *(u32x2*)(O + (size_t)(r0 + j * 16 + l15) * FF + c0 + i * 16 + quad * 4) = o; }
    }
}

template <int ACT>
__device__ __forceinline__ void ctx_ksplit_tiles(const bf16* A, const bf16* Bt, bf16* O, int ldo, int ntn, int ncols, float* part, int bid, int G, int tid, int wave, int l15, int quad) {
    for (int t = bid; t < 8 * ntn; t += G) {
        const int rt = t / ntn, c0 = (t % ntn) * 64, b = rt >> 2, r0 = b * TP + (rt & 3) * 64;
        pg8::f32x4 acc[4][4];
#pragma unroll
        for (int i = 0; i < 4; ++i)
#pragma unroll
            for (int j = 0; j < 4; ++j) acc[i][j] = (pg8::f32x4){0.f, 0.f, 0.f, 0.f};
        frag_gemm<4, 4>(acc, A + (size_t)r0 * D, D, Bt + (size_t)c0 * D, D, wave * 128, (wave + 1) * 128, l15, quad);
        float* pw = part + wave * 4096;
#pragma unroll
        for (int i = 0; i < 4; ++i)
#pragma unroll
            for (int j = 0; j < 4; ++j)
#pragma unroll
                for (int rg = 0; rg < 4; ++rg) pw[(i * 16 + quad * 4 + rg) * 64 + j * 16 + l15] = acc[i][j][rg];
        __syncthreads();
        { const int row = tid >> 3, c8 = (tid & 7) * 8;
          f32x4 s0 = *(const f32x4*)(part + row * 64 + c8), s1 = *(const f32x4*)(part + row * 64 + c8 + 4);
#pragma unroll
          for (int w = 1; w < 8; ++w) { s0 += *(const f32x4*)(part + w * 4096 + row * 64 + c8); s1 += *(const f32x4*)(part + w * 4096 + row * 64 + c8 + 4); }
          if (ACT == 1) {
#pragma unroll
              for (int k = 0; k < 4; ++k) { float a_ = fmaxf(s0[k], 0.f), b_ = fmaxf(s1[k], 0.f); s0[k] = a_ * a_; s1[k] = b_ * b_; } }
          u32x4 o; o.x = pk2(s0.x, s0.y); o.y = pk2(s0.z, s0.w); o.z = pk2(s1.x, s1.y); o.w = pk2(s1.z, s1.w);
          const int col = c0 + c8;
          if (col < ncols) *(u32x4*)(O + (size_t)(r0 + row) * ldo + col) = o; }
        __syncthreads();
    }
}

struct Args { const float* in[19]; float* out; unsigned char* ws; };

__global__ void __launch_bounds__(512, 2) fwd_kernel(Args a) {
    extern __shared__ __attribute__((aligned(16))) unsigned char lds[];
    cg::grid_group grid = cg::this_grid();
    const int G = gridDim.x, bid = blockIdx.x, NGW = G * 8;
#define IDS int tid = threadIdx.x; asm volatile("" : "+v"(tid)); const int lane = tid & 63, wave = __builtin_amdgcn_readfirstlane(tid >> 6), quad = lane >> 4, l15 = lane & 15, gw = bid * 8 + wave; (void)quad; (void)l15; (void)gw; (void)lane;
#define xin (a.in[0])
#define cvec (a.in[1])
#define ctx (a.in[2])
#define cctx (a.in[3])
#define w_mod (a.in[4])
#define b_mod (a.in[5])
#define ln_g (a.in[6])
#define ln_b (a.in[7])
#define theta (a.in[11])
#define gkw (a.in[12])
#define gkb (a.in[13])
#define normg (a.in[14])
#define sink (a.in[17])
#define WIN_T ((bf16*)(a.ws + OFF_WIN))
#define WOUT0_T ((bf16*)(a.ws + OFF_WOUT0))
#define W1_0_T ((bf16*)(a.ws + OFF_W1_0))
#define W2_0_T ((bf16*)(a.ws + OFF_W2_0))
#define WQKV_T ((bf16*)(a.ws + OFF_WQKV))
#define WOUT1_T ((bf16*)(a.ws + OFF_WOUT1))
#define W1_1_T ((bf16*)(a.ws + OFF_W1_1))
#define W2_1_T ((bf16*)(a.ws + OFF_W2_1))
#define mod ((float*)(a.ws + OFF_MOD))
#define rope ((float*)(a.ws + OFF_ROPE))
#define xctx ((float*)(a.ws + OFF_XCTX))
#define DEC ((float*)(a.ws + OFF_DEC))
#define H ((bf16*)(a.ws + OFF_H))
#define P ((bf16*)(a.ws + OFF_P))
#define ST ((bf16*)(a.ws + OFF_ST))
#define xlat (a.out)
#define RST(i) ((float*)(a.ws + OFF_RST) + (size_t)(i) * R * 2)
#define VLAT ((bf16*)a.out)
#define VCTX ((bf16*)(a.ws + OFF_XCTX))

#define LATE_ITEMS 9472
#define LATE_CHUNK 16
#define DRAIN_LATE(scr_, maxc_) do { int nclaim_ = 0; unsigned* qc_ = (unsigned*)(a.ws + OFF_XBAR) + 3584; volatile unsigned* qw_ = (volatile unsigned*)(lds + 131072 + 1024); \
        for (;;) { if (nclaim_++ >= (maxc_)) break; if (tid == 0) qw_[0] = __hip_atomic_fetch_add(qc_, (unsigned)LATE_CHUNK, __ATOMIC_RELAXED, __HIP_MEMORY_SCOPE_AGENT);     \
            __syncthreads(); const int base_ = (int)__builtin_amdgcn_readfirstlane(qw_[0]); __syncthreads(); \
            if (base_ >= LATE_ITEMS) break; \
            for (int k_ = wave; k_ < LATE_CHUNK; k_ += 8) { int r_ = base_ + k_; if (r_ >= LATE_ITEMS) break; \
                if (r_ < 2048) { transpose_item(a.in[8], 1024, FF, W1_0_T, (scr_), r_, lane); continue; } r_ -= 2048; \
                if (r_ < 2048) { transpose_item(a.in[9], FF, 1024, W2_0_T, (scr_), r_, lane); continue; } r_ -= 2048; \
                if (r_ < 768) { transpose_item(a.in[16], 1024, NQKV, WQKV_T, (scr_), r_, lane); continue; } r_ -= 768; \
                if (r_ < 512) { transpose_item(a.in[18], 1024, 1024, WOUT1_T, (scr_), r_, lane); continue; } r_ -= 512; \
                if (r_ < 2048) { transpose_item(a.in[8] + (size_t)1024 * FF, 1024, FF, W1_1_T, (scr_), r_, lane); continue; } r_ -= 2048; \
                transpose_item(a.in[9] + (size_t)FF * 1024, FF, 1024, W2_1_T, (scr_), r_, lane); } } } while (0)
    PG8_LAS unsigned char* ldsg = (PG8_LAS unsigned char*)lds;
    unsigned* barw = (unsigned*)(a.ws + OFF_BAR); unsigned bar_target = 0u; (void)barw; (void)bar_target;
    unsigned* xbw = (unsigned*)(a.ws + OFF_XBAR);
    volatile unsigned* xst = (volatile unsigned*)(lds + 131072 + 512);
    if (threadIdx.x == 0) { xst[0] = 0u; xst[1] = 0u; }
    XcdBarrier xbar = xcd_barrier_post(xbw, xst);
    if (a.ws == nullptr) grid.sync();

PROBE_BEGIN(1)
    { IDS
        float* sl = (float*)lds; float* red = (float*)(lds + 12288);
        for (int item = bid; item < 192; item += G) {
            for (int i = tid; i < 3072; i += 512) { const int j = i >> 10, k = i & 1023; const float v = (j < 2) ? cvec[j * 1024 + k] : cctx[k]; sl[i] = v / (1.f + expf(-v)); }
            __syncthreads();
            const int layer = item / 96, n0 = (item % 96) * 64;
            const float* W = w_mod + (size_t)layer * 1024 * 6144 + n0 + lane;
            float a0 = 0.f, a1 = 0.f, a2 = 0.f; const int k0 = wave * 128;
#pragma unroll 8
            for (int kk = 0; kk < 128; ++kk) { const int k = k0 + kk; const float w = W[(size_t)k * 6144]; a0 += sl[k] * w; a1 += sl[1024 + k] * w; a2 += sl[2048 + k] * w; }
            red[(wave * 3 + 0) * 64 + lane] = a0; red[(wave * 3 + 1) * 64 + lane] = a1; red[(wave * 3 + 2) * 64 + lane] = a2;
            __syncthreads();
            if (tid < 192) { const int j = tid >> 6, col = tid & 63; float s = b_mod[layer * 6144 + n0 + col];
#pragma unroll
                for (int w = 0; w < 8; ++w) s += red[(w * 3 + j) * 64 + col];
                mod[(layer * 3 + j) * 6144 + n0 + col] = s; }
            __syncthreads();
        }
        if (bid == G - 1 && tid < 16) {
            double f = 1.0; for (int i = 0; i < tid; ++i) f *= 0.56234132519034908;
            const double x2 = f * f; double cs = 1.0, sn = f, tc = 1.0, ts = f;
            for (int n = 1; n <= 12; ++n) { tc *= -x2 / (double)((2 * n - 1) * (2 * n)); cs += tc; ts *= -x2 / (double)((2 * n) * (2 * n + 1)); sn += ts; }
            double c = 1.0, s = 0.0;
            for (int p = 0; p < 128; ++p) { rope[(p * 16 + tid) * 2] = (float)c; rope[(p * 16 + tid) * 2 + 1] = (float)s; const double nc = c * cs - s * sn; s = s * cs + c * sn; c = nc; }
        }
        float* scr = (float*)(lds + 32768 + wave * 8448);
        for (int it = gw; it < 2064; it += NGW) {
            int r = it;
            if (r < 1552) { transpose_item(a.in[10], 1024, NPROJ, WIN_T, scr, r, lane); continue; } r -= 1552;
            transpose_item(a.in[15], 1024, 1024, WOUT0_T, scr, r, lane);
        }
        { u32x4* z = (u32x4*)(WIN_T + (size_t)NPROJ * D); const u32x4 zero = {0u, 0u, 0u, 0u};
          for (int i = bid * 512 + tid; i < (NPROJ_PAD - NPROJ) * D / 8; i += G * 512) z[i] = zero; }
    }
PROBE_END(1)
    xcd_barrier(xbar);


PROBE_BEGIN(2)
    { IDS
    for (int r = gw; r < R; r += 2 * NGW) {
        const int r2 = r + NGW; const bool has2 = r2 < R;
        bool isc, isc2; int b, b2; const size_t off = row_off(r, isc, b), off2 = row_off(has2 ? r2 : r, isc2, b2);
        const float* xr = (isc ? ctx : xin) + off; const float* md = mod + (isc ? 2 : b) * 6144;
        const float* xr2 = (isc2 ? ctx : xin) + off2; const float* md2 = mod + (isc2 ? 2 : b2) * 6144;
        f32x4 va[4], vb[4];
#pragma unroll
        for (int j = 0; j < 4; ++j) { va[j] = *(const f32x4*)(xr + lane * 4 + 256 * j); vb[j] = *(const f32x4*)(xr2 + lane * 4 + 256 * j); }
#pragma unroll
        for (int j = 0; j < 4; ++j) {
            const int idx = lane * 4 + 256 * j;
            { const f32x4 sh = *(const f32x4*)(md + idx), sc = *(const f32x4*)(md + 1024 + idx);
              const f32x4 h = va[j] * (sc + 1.f) + sh; u32x2 o; o.x = pk2(h.x, h.y); o.y = pk2(h.z, h.w);
              *(u32x2*)(H + (size_t)r * D + idx) = o; }
            if (has2) { const f32x4 sh = *(const f32x4*)(md2 + idx), sc = *(const f32x4*)(md2 + 1024 + idx);
              const f32x4 h = vb[j] * (sc + 1.f) + sh; u32x2 o; o.x = pk2(h.x, h.y); o.y = pk2(h.z, h.w);
              *(u32x2*)(H + (size_t)r2 * D + idx) = o; }
        }
    }
    }
PROBE_END(2)
    xcd_barrier(xbar);
    if (PROBE_SEL == 10) { for (int i = 0; i < 10; ++i) xcd_barrier(xbar); }

PROBE_BEGIN(8)
    { pg8::Gemm g{H, WIN_T, R, NPROJ_PAD, D}; pg8::StaticOrder S; S.init(R, NPROJ_PAD, G, bid); EpiStore<0> E{P, NPROJ, NPROJ};
      pg8::gemm_phase<EpiStore<0>, pg8::StaticOrder, true, true>(ldsg, g, S, E); }
PROBE_END(8)
    xcd_barrier(xbar);

PROBE_BEGIN(3)
#ifndef NO_P3
    { IDS
        float* cf = (float*)lds; float* cb = (float*)(lds + 16640); float* lrs = (float*)(lds + 33280); float* wl = (float*)(lds + 41728);
        bf16* kTf = (bf16*)(lds + 50432); bf16* kTb = (bf16*)(lds + 59648); bf16* vT = (bf16*)(lds + 68864);
        constexpr int NU = NB * 2 * 4 * NCH;
        const int s = tid & 63, dc = tid >> 6;
        u32x4 kv = {0u, 0u, 0u, 0u}, vv0 = kv, vv1 = kv; GatePre gp; gp.lr = (u32x2){0u, 0u}; gp.w = (f32x4){0.f, 0.f, 0.f, 0.f}; gp.bias = 0.f;
#define P3_LOAD(U) do { const int pc_ = (U) % NCH, t_ = (U) / NCH, h_ = t_ & 3, g_ = 1 - (t_ >> 3), b_ = (t_ >> 2) & 1; const bf16* Pr_ = P + (size_t)(b_ * TP + pc_ * 64) * NPROJ; \
            const int kcol_ = g_ ? 1792 + h_ * 64 : 256 + h_ * 64, vcol_ = g_ ? 2048 + h_ * 128 : 512 + h_ * 128; \
            kv = *(const u32x4*)(Pr_ + (size_t)s * NPROJ + kcol_ + dc * 8); vv0 = *(const u32x4*)(Pr_ + (size_t)s * NPROJ + vcol_ + dc * 8); vv1 = *(const u32x4*)(Pr_ + (size_t)s * NPROJ + vcol_ + (dc + 8) * 8); \
            gp = gate_prefetch(g_, h_, Pr_, gkw, gkb, tid); } while (0)
        if (bid < NU) P3_LOAD(bid);
        for (int unit = bid; unit < NU; unit += G) {
            const int pc = unit % NCH, t = unit / NCH, h = t & 3, g = 1 - (t >> 3), b = (t >> 2) & 1;
            const float kscale = g ? 1.f : 0.125f;
            float lgf = 0.f, lgb = 0.f;
            if (g) fill_cum3(cf, cb, lrs, wl, g, h, gp, theta, tid);
            else { lgf = log1pf(-expf(theta[h])); lgb = log1pf(-expf(theta[4 + h])); }
            {
              if (g) {
#pragma unroll
              for (int j = 0; j < 8; ++j) { const int d = dc * 8 + j; const unsigned u = kv[j >> 1]; const float kf = ((j & 1) ? bfhi(u) : bflo(u)) * kscale;
                  kTf[d * 72 + s] = (bf16)f2bf(kf * __expf(cf[63 * CS + d] - cf[s * CS + d]));
                  kTb[d * 72 + s] = (bf16)f2bf(kf * __expf(cb[d] - cb[s * CS + d])); }
              } else { const float ef = __expf((float)(63 - s) * lgf) * kscale, eb = __expf((float)s * lgb) * kscale;
#pragma unroll
              for (int j = 0; j < 8; ++j) { const int d = dc * 8 + j; const unsigned u = kv[j >> 1]; const float kf = (j & 1) ? bfhi(u) : bflo(u);
                  kTf[d * 72 + s] = (bf16)f2bf(kf * ef); kTb[d * 72 + s] = (bf16)f2bf(kf * eb); }
              }
#pragma unroll
              for (int j = 0; j < 8; ++j) { const unsigned u0 = vv0[j >> 1], u1 = vv1[j >> 1];
                  vT[(dc * 8 + j) * 72 + s] = (bf16)((j & 1) ? (u0 >> 16) : (u0 & 0xffffu)); vT[((dc + 8) * 8 + j) * 72 + s] = (bf16)((j & 1) ? (u1 >> 16) : (u1 & 0xffffu)); }
            }
            const int seq0 = ((b * 2 + g) * 4 + h) * 2;
            const int nf = pc, nbk = (pc < 4) ? 3 - pc : 135 - pc;
            if (tid < 128) { const int dir = tid >> 6, d = tid & 63;
                DEC[((size_t)(seq0 + dir) * NCH + (dir ? nbk : nf)) * 64 + d] = g ? (dir ? expf(cb[d]) : expf(cf[63 * CS + d])) : expf(64.f * (dir ? lgb : lgf)); }
            if (unit + G < NU) P3_LOAD(unit + G);
            __syncthreads();
            bf16x8 bfr[2];
#pragma unroll
            for (int ks = 0; ks < 2; ++ks) bfr[ks] = *(const bf16x8*)(vT + (wave * 16 + l15) * 72 + ks * 32 + quad * 8);
#pragma unroll
            for (int dir = 0; dir < 2; ++dir) {
                const bf16* kT = dir ? kTb : kTf;
                bf16* dst = ST + ((size_t)(seq0 + dir) * NCH + (dir ? nbk : nf)) * 8192 + (size_t)(wave * 16 + l15) * 64;
#pragma unroll
                for (int dt = 0; dt < 4; ++dt) {
                    pg8::f32x4 acc = {0.f, 0.f, 0.f, 0.f};
#pragma unroll
                    for (int ks = 0; ks < 2; ++ks) { const bf16x8 af = *(const bf16x8*)(kT + (dt * 16 + l15) * 72 + ks * 32 + quad * 8); acc = MFMA16(af, bfr[ks], acc); }
                    u32x2 o; o.x = pk2(acc[0], acc[1]); o.y = pk2(acc[2], acc[3]);
                    *(u32x2*)(dst + dt * 16 + quad * 4) = o;
                }
            }
            __syncthreads();
        }
#undef P3_LOAD
        if ((NU - bid + G - 1) / G < (NU + G - 1) / G) DRAIN_LATE((float*)(lds + wave * 8448), 1);
    }
#endif
PROBE_END(3)
    xcd_barrier(xbar);

PROBE_BEGIN(4)
    { IDS
    for (int i = bid * 512 + tid; i < 32 * 4096; i += G * 512) {
        const int seq = i >> 12, pi = i & 4095, d = (2 * pi) & 63;
        unsigned* sp = (unsigned*)(ST + (size_t)seq * NCH * 8192) + pi; const float* dp = DEC + (size_t)seq * NCH * 64 + d;
        float s0 = 0.f, s1 = 0.f;
#pragma unroll 4
        for (int n = 0; n < NCH; ++n) {
            const unsigned kv = sp[(size_t)n * 4096]; const float d0 = dp[n * 64], d1 = dp[n * 64 + 1];
            sp[(size_t)n * 4096] = pk2(s0, s1);
            s0 = d0 * s0 + bflo(kv); s1 = d1 * s1 + bfhi(kv);
        }
    }
    }
PROBE_END(4)
    xcd_barrier(xbar);

PROBE_BEGIN(5)
#ifndef NO_P5
    { IDS
        float* cf = (float*)lds; float* cb = (float*)(lds + 16640); float* lrs = (float*)(lds + 33280); float* wl = (float*)(lds + 41728);
        bf16* qdf = (bf16*)(lds + 50432); bf16* kif = (bf16*)(lds + 59648); bf16* qdb = (bf16*)(lds + 68864); bf16* kib = (bf16*)(lds + 78080);
        bf16* vT = (bf16*)(lds + 87296); bf16* Am = (bf16*)(lds + 105728); float* red = (float*)(lds + 114944);
        constexpr int NU = NB * 2 * 4 * NCH;
        const int dcq = tid & 7, sq = tid >> 3, sv = tid & 63, dcv = tid >> 6;
        u32x4 qv = {0u, 0u, 0u, 0u}, kv = qv, vv0 = qv, vv1 = qv; GatePre gp; gp.lr = (u32x2){0u, 0u}; gp.w = (f32x4){0.f, 0.f, 0.f, 0.f}; gp.bias = 0.f;
#define P5_LOAD(U) do { const int pc_ = (U) % NCH, t_ = (U) / NCH, h_ = t_ & 3, g_ = 1 - (t_ >> 3), b_ = (t_ >> 2) & 1; const bf16* Pr_ = P + (size_t)(b_ * TP + pc_ * 64) * NPROJ; \
            const int qcol_ = g_ ? 1536 + h_ * 64 : h_ * 64, kcol_ = g_ ? 1792 + h_ * 64 : 256 + h_ * 64, vcol_ = g_ ? 2048 + h_ * 128 : 512 + h_ * 128; \
            qv = *(const u32x4*)(Pr_ + (size_t)sq * NPROJ + qcol_ + dcq * 8); kv = *(const u32x4*)(Pr_ + (size_t)sq * NPROJ + kcol_ + dcq * 8); \
            vv0 = *(const u32x4*)(Pr_ + (size_t)sv * NPROJ + vcol_ + dcv * 8); vv1 = *(const u32x4*)(Pr_ + (size_t)sv * NPROJ + vcol_ + (dcv + 8) * 8); \
            gp = gate_prefetch(g_, h_, Pr_, gkw, gkb, tid); } while (0)
        f32x4 ngv[4];
#pragma unroll
        for (int et = 0; et < 4; ++et) ngv[et] = *(const f32x4*)(normg + ((wave >> 2) * 4 + et) * 16 + quad * 4);
        if (bid < NU) P5_LOAD(bid);
        for (int unit = bid; unit < NU; unit += G) {
            const int pc = unit % NCH, t = unit / NCH, h = t & 3, g = 1 - (t >> 3), b = (t >> 2) & 1;
            const int r0 = b * TP + pc * 64;
            const int gcol = g ? 2560 + h * 128 : 1024 + h * 128;
            const float qscale = g ? 0.125f : 1.f, kscale = g ? 1.f : 0.125f;
            if (g) fill_cum3(cf, cb, lrs, wl, g, h, gp, theta, tid);
            { u32x4 o1, o2, o3, o4;
              if (g) {
#pragma unroll
              for (int j2 = 0; j2 < 4; ++j2) {
                  const int d = dcq * 8 + 2 * j2;
                  const float f0 = cf[sq * CS + d], f1 = cf[sq * CS + d + 1], b0 = cb[sq * CS + d], b1 = cb[sq * CS + d + 1];
                  const float q0 = bflo(qv[j2]) * qscale, q1 = bfhi(qv[j2]) * qscale, k0 = bflo(kv[j2]) * kscale, k1 = bfhi(kv[j2]) * kscale;
                  o1[j2] = pk2(q0 * __expf(f0), q1 * __expf(f1)); o2[j2] = pk2(k0 * __expf(-f0), k1 * __expf(-f1));
                  o3[j2] = pk2(q0 * __expf(b0), q1 * __expf(b1)); o4[j2] = pk2(k0 * __expf(-b0), k1 * __expf(-b1));
              }
              } else {
                  const float lgf = log1pf(-expf(theta[h])), lgb = log1pf(-expf(theta[4 + h]));
                  const float cfr = (float)(sq + 1) * lgf, cbr = (float)(64 - sq) * lgb;
                  const float ef = __expf(cfr) * qscale, eif = __expf(-cfr) * kscale, eb = __expf(cbr) * qscale, eib = __expf(-cbr) * kscale;
#pragma unroll
                  for (int j2 = 0; j2 < 4; ++j2) { const float q0 = bflo(qv[j2]), q1 = bfhi(qv[j2]), k0 = bflo(kv[j2]), k1 = bfhi(kv[j2]);
                      o1[j2] = pk2(q0 * ef, q1 * ef); o2[j2] = pk2(k0 * eif, k1 * eif); o3[j2] = pk2(q0 * eb, q1 * eb); o4[j2] = pk2(k0 * eib, k1 * eib); }
              }
              *(u32x4*)(qdf + sq * 72 + dcq * 8) = o1; *(u32x4*)(kif + sq * 72 + dcq * 8) = o2; *(u32x4*)(qdb + sq * 72 + dcq * 8) = o3; *(u32x4*)(kib + sq * 72 + dcq * 8) = o4;
#pragma unroll
              for (int j = 0; j < 8; ++j) { const unsigned u0 = vv0[j >> 1], u1 = vv1[j >> 1];
                  vT[(dcv * 8 + j) * 72 + sv] = (bf16)((j & 1) ? (u0 >> 16) : (u0 & 0xffffu)); vT[((dcv + 8) * 8 + j) * 72 + sv] = (bf16)((j & 1) ? (u1 >> 16) : (u1 & 0xffffu)); }
            }
            __syncthreads();
            const int ct = wave & 3, eh = wave >> 2;
            const int seq0 = ((b * 2 + g) * 4 + h) * 2;
            const int nf = pc, nbk = (pc < 4) ? 3 - pc : 135 - pc;
            const bf16* Sf = ST + ((size_t)seq0 * NCH + nf) * 8192; const bf16* Sb = ST + ((size_t)(seq0 + 1) * NCH + nbk) * 8192;
            const int r = r0 + ct * 16 + l15;
            bf16x8 a2[4][2], a3[4][2]; u32x2 gv[4];
#pragma unroll
            for (int et = 0; et < 4; ++et) { const int e = (eh * 4 + et) * 16 + l15;
#pragma unroll
                for (int ks = 0; ks < 2; ++ks) { a2[et][ks] = *(const bf16x8*)(Sf + e * 64 + ks * 32 + quad * 8); a3[et][ks] = *(const bf16x8*)(Sb + e * 64 + ks * 32 + quad * 8); }
                gv[et] = *(const u32x2*)(P + (size_t)r * NPROJ + gcol + (eh * 4 + et) * 16 + quad * 4); }
            { bf16x8 af[2], ab[2];
#pragma unroll
              for (int ks = 0; ks < 2; ++ks) { af[ks] = *(const bf16x8*)(qdf + (ct * 16 + l15) * 72 + ks * 32 + quad * 8); ab[ks] = *(const bf16x8*)(qdb + (ct * 16 + l15) * 72 + ks * 32 + quad * 8); }
#pragma unroll
              for (int i = 0; i < 2; ++i) { const int st = (wave >> 2) * 2 + i;
                  pg8::f32x4 accf = {0.f, 0.f, 0.f, 0.f}, accb = {0.f, 0.f, 0.f, 0.f};
#pragma unroll
                  for (int ks = 0; ks < 2; ++ks) {
                      const bf16x8 bf_ = *(const bf16x8*)(kif + (st * 16 + l15) * 72 + ks * 32 + quad * 8), bb_ = *(const bf16x8*)(kib + (st * 16 + l15) * 72 + ks * 32 + quad * 8);
                      accf = MFMA16(af[ks], bf_, accf); accb = MFMA16(ab[ks], bb_, accb); }
                  const int scol = st * 16 + l15;
#pragma unroll
                  for (int rg = 0; rg < 4; ++rg) { const int c = ct * 16 + quad * 4 + rg; Am[c * 72 + scol] = (bf16)f2bf(scol <= c ? accf[rg] : accb[rg]); }
              }
            }
            if (unit + G < NU) P5_LOAD(unit + G);
            __syncthreads();
            { bf16x8 bA[2], bQf[2], bQb[2];
#pragma unroll
              for (int ks = 0; ks < 2; ++ks) { const int o = (ct * 16 + l15) * 72 + ks * 32 + quad * 8; bA[ks] = *(const bf16x8*)(Am + o); bQf[ks] = *(const bf16x8*)(qdf + o); bQb[ks] = *(const bf16x8*)(qdb + o); }
              pg8::f32x4 acc[4]; float ss = 0.f;
#pragma unroll
              for (int et = 0; et < 4; ++et) { const int e = (eh * 4 + et) * 16 + l15;
                  pg8::f32x4 c4 = {0.f, 0.f, 0.f, 0.f};
#pragma unroll
                  for (int ks = 0; ks < 2; ++ks) {
                      const bf16x8 a1 = *(const bf16x8*)(vT + e * 72 + ks * 32 + quad * 8);
                      c4 = MFMA16(a1, bA[ks], c4); c4 = MFMA16(a2[et][ks], bQf[ks], c4); c4 = MFMA16(a3[et][ks], bQb[ks], c4); }
                  acc[et] = c4; ss += (c4[0] * c4[0] + c4[1] * c4[1]) + (c4[2] * c4[2] + c4[3] * c4[3]); }
              ss = quad_sum(ss);
              if (quad == 0) red[eh * 64 + ct * 16 + l15] = ss;
              __syncthreads();
              const float tot = red[ct * 16 + l15] + red[64 + ct * 16 + l15];
              const float rinv = 1.f / sqrtf(tot * (1.f / 128.f) + 1e-6f);
#pragma unroll
              for (int et = 0; et < 4; ++et) { const int e0 = (eh * 4 + et) * 16 + quad * 4;
                  float gt[4] = {bflo(gv[et].x), bfhi(gv[et].x), bflo(gv[et].y), bfhi(gv[et].y)}; float y[4];
#pragma unroll
                  for (int i = 0; i < 4; ++i) { const float ng = g ? ngv[et][i] : 1.f; const float sg = gt[i] * __builtin_amdgcn_rcpf(1.f + __expf(-gt[i])); y[i] = sg * acc[et][i] * rinv * ng; }
                  u32x2 o; o.x = pk2(y[0], y[1]); o.y = pk2(y[2], y[3]);
                  *(u32x2*)(H + (size_t)r * D + g * 512 + h * 128 + e0) = o; }
            }
            __syncthreads();
        }
#undef P5_LOAD
        if ((NU - bid + G - 1) / G < (NU + G - 1) / G) DRAIN_LATE((float*)(lds + wave * 8448), 2);
    }
#endif
PROBE_END(5)
    xcd_barrier(xbar);

PROBE_BEGIN(12)
    { pg8::Gemm g{H, WOUT0_T, R, D, D}; LatOrder S; S.init(D, G, bid); EpiResid<0, false> E{xin, ctx, VLAT, VCTX, nullptr, mod + 2 * 1024, nullptr, nullptr, nullptr};
      pg8::gemm_phase<EpiResid<0, false>, LatOrder, true, true>(ldsg, g, S, E); }
    { IDS
      ctx_resid_tiles<false>(H, WOUT0_T, D, ctx, VCTX, mod + 2 * 6144 + 2 * 1024, nullptr, nullptr, nullptr, (float*)lds, bid, G, tid, wave, l15, quad); }
PROBE_END(12)
    xcd_barrier(xbar);
PROBE_BEGIN(7)
    { IDS
    DRAIN_LATE((float*)(lds + wave * 8448), 1 << 30);
    ln_phase<false, false>(RST(0), VLAT, VCTX, nullptr, nullptr, ln_g, ln_b, mod + 3 * 1024, H, gw, NGW, lane);
    }
PROBE_END(7)
    xcd_barrier(xbar);
PROBE_BEGIN(11)
    { pg8::Gemm g{H, W1_0_T, R, FF, D}; LatOrder S; S.init(FF, G, bid); EpiStore<1> E{P, FF, FF};
      pg8::gemm_phase<EpiStore<1>, LatOrder, true, true>(ldsg, g, S, E); }
    { IDS
      ctx_ksplit_tiles<1>(H, W1_0_T, P, FF, 64, FF, (float*)lds, bid, G, tid, wave, l15, quad); }
PROBE_END(11)
    xcd_barrier(xbar);
PROBE_BEGIN(9)
    { pg8::Gemm g{P, W2_0_T, R, D, FF}; LatOrder S; S.init(D, G, bid); EpiResid<1, false> E{VLAT, VCTX, VLAT, VCTX, nullptr, mod + 5 * 1024, RST(0), ln_g, ln_b};
      pg8::gemm_phase<EpiResid<1, false>, LatOrder, true, true>(ldsg, g, S, E); }
    { IDS
      ctx_resid_tiles<true>(P, W2_0_T, FF, VCTX, VCTX, mod + 2 * 6144 + 5 * 1024, RST(0), ln_g, ln_b, (float*)lds, bid, G, tid, wave, l15, quad); }
PROBE_END(9)
    xcd_barrier(xbar);
    { IDS
    ln_phase<false, false>(RST(1), VLAT, VCTX, nullptr, nullptr, ln_g + 1024, ln_b + 1024, mod + 3 * 6144, H, gw, NGW, lane);
    }
    xcd_barrier(xbar);

PROBE_BEGIN(13)
    { pg8::Gemm g{H, WQKV_T, R, NQKV, D}; pg8::StaticOrder S; S.init(R, NQKV, G, bid); EpiStore<0> E{P, NQKV, NQKV};
      pg8::gemm_phase<EpiStore<0>, pg8::StaticOrder, true, true>(ldsg, g, S, E); }
PROBE_END(13)
    xcd_barrier(xbar);

PROBE_BEGIN(6)
#ifndef NO_P12
    { IDS
        bf16* Qs = (bf16*)lds; bf16* Ks = (bf16*)(lds + 73728); bf16* Vt = (bf16*)(lds + 82944); float* ropes = (float*)(lds + 92160);
        for (int i = tid; i < 1024; i += 512) ((f32x4*)ropes)[i] = ((const f32x4*)rope)[i];
        PACC_DECL
        for (int unit = bid; unit < NB * 4 * 64; unit += G) {
            PACC_BEGIN(40)
            const int nb = unit & 63, kvh = (unit >> 6) & 3, b = unit >> 8;
#define ATT_VALID(t) ((t) < 4 || (unsigned)(nb - 1 + (((t) - 4) >> 1)) < 64u)
#define ATT_KPOS(t) ((nb - 1 + (((t) - 4) >> 1)) * 128 + (((t) - 4) & 1) * 64)
#define ATT_KROW(t) ((t) < 4 ? b * TP + (t) * 64 : b * TP + L + ATT_KPOS(t))
            const int keyk = tid >> 2, pck = tid & 3, c1k = (pck & 1) + (pck >> 1) * 4, keyv = tid & 63, dcv = tid >> 6;
            u32x4 pk1 = {0u, 0u, 0u, 0u}, pk2_ = pk1, pvv = pk1;
#define ATT_LOAD(t) do { const int kr_ = ATT_KROW(t); \
                if (tid < 256) { const bf16* src_ = P + (size_t)(kr_ + keyk) * NQKV + 1024 + kvh * 64; pk1 = *(const u32x4*)(src_ + c1k * 8); pk2_ = *(const u32x4*)(src_ + (c1k + 2) * 8); } \
                pvv = *(const u32x4*)(P + (size_t)(kr_ + keyv) * NQKV + 1280 + kvh * 64 + dcv * 8); } while (0)
            ATT_LOAD(0);
            __syncthreads();
#pragma unroll
            for (int i = 0; i < 4; ++i) {
                const int it = tid + i * 512, pcq = it & 3, row = it >> 2, g = row >> 7, qi = row & 127, pos = nb * 128 + qi;
                const bf16* src = P + (size_t)(b * TP + L + pos) * NQKV + (kvh * 4 + g) * 64;
                const int c1 = (pcq & 1) + (pcq >> 1) * 4;
                const u32x4 u1 = *(const u32x4*)(src + c1 * 8), u2 = *(const u32x4*)(src + (c1 + 2) * 8);
                const int pv = (pcq < 2) ? (pos >> 6) : (pos & 63);
                const f32x4* tab = (const f32x4*)(ropes + (pv * 16 + (c1 & 1) * 8) * 2);
                u32x4 o1, o2;
#pragma unroll
                for (int j2 = 0; j2 < 4; ++j2) { const f32x4 cs = tab[j2];
                    const float a0 = bflo(u1[j2]), a1 = bfhi(u1[j2]), b0 = bflo(u2[j2]), b1 = bfhi(u2[j2]);
                    o1[j2] = pk2((a0 * cs.x - b0 * cs.y) * QSC, (a1 * cs.z - b1 * cs.w) * QSC); o2[j2] = pk2((a0 * cs.y + b0 * cs.x) * QSC, (a1 * cs.w + b1 * cs.z) * QSC); }
                *(u32x4*)(Qs + row * 72 + c1 * 8) = o1; *(u32x4*)(Qs + row * 72 + (c1 + 2) * 8) = o2;
            }
            const int g = wave & 3, qh = wave >> 2, qrow0 = g * 128 + qh * 64, qpos0 = nb * 128 + qh * 64;
            float mrun[4], lrun[4]; pg8::f32x4 O[4][4];
            const float sk = sink[kvh * 4 + g] * 1.4426950408889634f;
#pragma unroll
            for (int qt = 0; qt < 4; ++qt) { mrun[qt] = sk; lrun[qt] = (quad == 0) ? 1.f : 0.f;
#pragma unroll
                for (int dt = 0; dt < 4; ++dt) O[dt][qt] = (pg8::f32x4){0.f, 0.f, 0.f, 0.f}; }
            PACC_END(40)
            int ti = 0;
            while (ti < 10) {
                PACC_BEGIN(41)
                const bool local = ti >= 4;
                const int kpos0 = local ? ATT_KPOS(ti) : 0;
                const int side = local ? ((ti - 4) >> 1) - 1 : 0;
                __syncthreads();
                if (tid < 256) {
                    u32x4 o1 = pk1, o2 = pk2_;
                    if (local) {
                        const int pos = kpos0 + keyk, pv = (pck < 2) ? (pos >> 6) : (pos & 63);
                        const f32x4* tab = (const f32x4*)(ropes + (pv * 16 + (c1k & 1) * 8) * 2);
#pragma unroll
                        for (int j2 = 0; j2 < 4; ++j2) { const f32x4 cs = tab[j2];
                            const float a0 = bflo(pk1[j2]), a1 = bfhi(pk1[j2]), b0 = bflo(pk2_[j2]), b1 = bfhi(pk2_[j2]);
                            o1[j2] = pk2(a0 * cs.x - b0 * cs.y, a1 * cs.z - b1 * cs.w); o2[j2] = pk2(a0 * cs.y + b0 * cs.x, a1 * cs.w + b1 * cs.z); }
                    }
                    *(u32x4*)(Ks + keyk * 72 + c1k * 8) = o1; *(u32x4*)(Ks + keyk * 72 + (c1k + 2) * 8) = o2;
                }
#pragma unroll
                for (int j = 0; j < 8; ++j) { const unsigned u = pvv[j >> 1]; Vt[(dcv * 8 + j) * 72 + keyv] = (bf16)((j & 1) ? (u >> 16) : (u & 0xffffu)); }
                __syncthreads();
                PACC_END(41)
                PACC_BEGIN(42)
                int tn = ti + 1;
                while (tn < 10 && !ATT_VALID(tn)) ++tn;
                if (tn < 10) ATT_LOAD(tn);
                if (!((side < 0 && ((ti - 4) & 1) == 0 && qh == 1) || (side > 0 && ((ti - 4) & 1) == 1 && qh == 0))) {
                bf16x8 kfr[4][2];
#pragma unroll
                for (int kt = 0; kt < 4; ++kt)
#pragma unroll
                    for (int ks = 0; ks < 2; ++ks) kfr[kt][ks] = *(const bf16x8*)(Ks + (kt * 16 + l15) * 72 + ks * 32 + quad * 8);
#pragma unroll
                for (int qt = 0; qt < 4; ++qt) {
                    pg8::f32x4 S[4];
#pragma unroll
                    for (int kt = 0; kt < 4; ++kt) S[kt] = (pg8::f32x4){0.f, 0.f, 0.f, 0.f};
#pragma unroll
                    for (int ks = 0; ks < 2; ++ks) { const bf16x8 qf = *(const bf16x8*)(Qs + (qrow0 + qt * 16 + l15) * 72 + ks * 32 + quad * 8);
#pragma unroll
                        for (int kt = 0; kt < 4; ++kt) S[kt] = MFMA16(kfr[kt][ks], qf, S[kt]); }
                    float mx = -INFINITY;
                    if (side < 0 && ((ti - 4) & 1) == qh) {
                        const int tl = quad * 4 - (qpos0 + qt * 16 + l15 - kpos0 - 128);
#pragma unroll
                        for (int kt = 0; kt < 4; ++kt)
#pragma unroll
                            for (int rg = 0; rg < 4; ++rg) { const float sv_ = (tl >= -(kt * 16 + rg)) ? S[kt][rg] : -INFINITY; S[kt][rg] = sv_; mx = fmaxf(mx, sv_); }
                    } else if (side > 0 && ((ti - 4) & 1) == qh) {
                        const int th = (qpos0 + qt * 16 + l15 - kpos0 + 128) - quad * 4;
#pragma unroll
                        for (int kt = 0; kt < 4; ++kt)
#pragma unroll
                            for (int rg = 0; rg < 4; ++rg) { const float sv_ = (th >= (kt * 16 + rg)) ? S[kt][rg] : -INFINITY; S[kt][rg] = sv_; mx = fmaxf(mx, sv_); }
                    } else {
#pragma unroll
                        for (int kt = 0; kt < 4; ++kt)
#pragma unroll
                            for (int rg = 0; rg < 4; ++rg) mx = fmaxf(mx, S[kt][rg]);
                    }
                    mx = quad_max(mx);
                    const float mnew = fmaxf(mrun[qt], mx), al = __builtin_amdgcn_exp2f(mrun[qt] - mnew); mrun[qt] = mnew;
                    float ps = 0.f;
#pragma unroll
                    for (int kt = 0; kt < 4; ++kt)
#pragma unroll
                        for (int rg = 0; rg < 4; ++rg) { const float p = __builtin_amdgcn_exp2f(S[kt][rg] - mnew); S[kt][rg] = p; ps += p; }
                    lrun[qt] = lrun[qt] * al + ps;
#pragma unroll
                    for (int dt = 0; dt < 4; ++dt) O[dt][qt] = O[dt][qt] * al;
#pragma unroll
                    for (int s2 = 0; s2 < 2; ++s2) {
                        u32x4 pw; pw.x = pk2(S[2 * s2][0], S[2 * s2][1]); pw.y = pk2(S[2 * s2][2], S[2 * s2][3]);
                        pw.z = pk2(S[2 * s2 + 1][0], S[2 * s2 + 1][1]); pw.w = pk2(S[2 * s2 + 1][2], S[2 * s2 + 1][3]);
                        const bf16x8 pf = __builtin_bit_cast(bf16x8, pw);
#pragma unroll
                        for (int dt = 0; dt < 4; ++dt) {
                            const s16x4 lo = *(const s16x4*)(Vt + (dt * 16 + l15) * 72 + s2 * 32 + quad * 4), hi = *(const s16x4*)(Vt + (dt * 16 + l15) * 72 + s2 * 32 + 16 + quad * 4);
                            O[dt][qt] = MFMA16(__builtin_shufflevector(lo, hi, 0, 1, 2, 3, 4, 5, 6, 7), pf, O[dt][qt]); }
                    }
                }
                }
                ti = tn;
                PACC_END(42)
            }
            PACC_BEGIN(43)
#pragma unroll
            for (int qt = 0; qt < 4; ++qt) {
                const float lt = quad_sum(lrun[qt]);
                const float inv = 1.f / lt;
                const int r = b * TP + L + qpos0 + qt * 16 + l15;
#pragma unroll
                for (int dt = 0; dt < 4; ++dt) { u32x2 o; o.x = pk2(O[dt][qt][0] * inv, O[dt][qt][1] * inv); o.y = pk2(O[dt][qt][2] * inv, O[dt][qt][3] * inv);
                    *(u32x2*)(H + (size_t)r * D + (kvh * 4 + g) * 64 + dt * 16 + quad * 4) = o; }
            }
            PACC_END(43)
#undef ATT_VALID
#undef ATT_KPOS
#undef ATT_KROW
#undef ATT_LOAD
        }
        PACC_SLEEP()
    }
#endif
PROBE_END(6)
    xcd_barrier(xbar);

PROBE_BEGIN(14)
    { pg8::Gemm g{H, WOUT1_T, R, D, D}; LatOrder S; S.init(D, G, bid); EpiResid<1, false> E{VLAT, VCTX, VLAT, VCTX, nullptr, mod + 3 * 6144 + 2 * 1024, RST(1), ln_g + 1024, ln_b + 1024};
      pg8::gemm_phase<EpiResid<1, false>, LatOrder, true, true>(ldsg, g, S, E); }
PROBE_END(14)
    xcd_barrier(xbar);
    { IDS
    ln_phase<false, true>(RST(2), VLAT, VCTX, nullptr, nullptr, ln_g + 2048, ln_b + 2048, mod + 3 * 6144 + 3 * 1024, H, gw, NGW, lane);
    }
    xcd_barrier(xbar);
PROBE_BEGIN(15)
    { pg8::Gemm g{H, W1_1_T, R, FF, D}; LatOrder S; S.init(FF, G, bid); EpiStore<1> E{P, FF, FF};
      pg8::gemm_phase<EpiStore<1>, LatOrder, true, true>(ldsg, g, S, E); }
PROBE_END(15)
    xcd_barrier(xbar);
PROBE_BEGIN(16)
    { pg8::Gemm g{P, W2_1_T, R, D, FF}; LatOrder S; S.init(D, G, bid); EpiResid<1, true> E{VLAT, VCTX, nullptr, nullptr, H, mod + 3 * 6144 + 5 * 1024, RST(2), ln_g + 2048, ln_b + 2048};
      pg8::gemm_phase<EpiResid<1, true>, LatOrder, true, true>(ldsg, g, S, E); }
PROBE_END(16)
    xcd_barrier(xbar);
    { IDS
    ln_phase<true, true>(nullptr, nullptr, nullptr, H, a.out, ln_g + 3072, ln_b + 3072, mod, H, gw, NGW, lane);
    }
}

extern "C" void kernel_launch(void* const* d_in, const int* in_sizes, int n_in, void* d_out, int out_size, void* d_ws, size_t ws_size, hipStream_t stream) {
    static int grid = 0;
    if (grid == 0) {
        if (n_in != 19 || out_size != NB * T * D || ws_size < WS_TOTAL) { fprintf(stderr, "kernel_launch: unexpected shapes (n_in %d out %d ws %zu)\n", n_in, out_size, ws_size); grid = -1; return; }
        int dev = 0, cus = 0, per_cu = 0;
        hipGetDevice(&dev); hipDeviceGetAttribute(&cus, hipDeviceAttributeMultiprocessorCount, dev);
        if (hipFuncSetAttribute((const void*)fwd_kernel, hipFuncAttributeMaxDynamicSharedMemorySize, LDS_BYTES) != hipSuccess) { fprintf(stderr, "kernel_launch: hipFuncSetAttribute failed\n"); grid = -1; return; }
        if (hipOccupancyMaxActiveBlocksPerMultiprocessor(&per_cu, (const void*)fwd_kernel, 512, LDS_BYTES) != hipSuccess || per_cu < 1) per_cu = 1;
        (void)hipGetLastError();
        grid = cus > 0 ? cus : 256;
    }
    if (grid < 0) return;
    Args a{};
    for (int i = 0; i < 19; ++i) a.in[i] = (const float*)d_in[i];
    a.out = (float*)d_out; a.ws = (unsigned char*)d_ws;
    if (hipMemsetAsync((char*)d_ws + OFF_XBAR, 0, 16384, stream) != hipSuccess) { fprintf(stderr, "kernel_launch: hipMemsetAsync of the barrier words failed\n"); return; }
    void* args[] = {&a};
    hipError_t e = hipLaunchCooperativeKernel((const void*)fwd_kernel, dim3(grid), dim3(512), args, LDS_BYTES, stream);
    if (e != hipSuccess) fprintf(stderr, "cooperative launch failed: %s (grid %d)\n", hipGetErrorString(e), grid);
}
```

```cpp
#include <hip/hip_runtime.h>
#include <hip/hip_cooperative_groups.h>
#include <cstdio>
#include <cstdint>
namespace cg = cooperative_groups;
namespace pg8 {
#define PG8_LAS __attribute__((address_space(3)))
typedef unsigned short bf16_t;
typedef short bf16x8 __attribute__((ext_vector_type(8)));
typedef float f32x4 __attribute__((ext_vector_type(4)));
typedef unsigned u32x4 __attribute__((ext_vector_type(4)));
constexpr int BM = 256, BK = 64, HALF = 128, HTB = HALF * BK * 2  , STAGE_BYTES = 8 * HTB, NXCD = 8, WGM = 8;

__host__ __device__ __forceinline__ int lds_byte(int r, int c) { const int st = (r >> 4) * 2 + (c >> 5), rr = r & 15, cc = c & 31, ob = rr * 64 + cc * 2; return st * 1024 + (ob ^ (((ob >> 9) & 1) << 5)); }
__host__ __device__ __forceinline__ void stage_rc(int b, int& R, int& C) { const int st = b / 1024, sb = b % 1024, swz = sb ^ (((sb >> 9) & 1) << 5); R = (st >> 1) * 16 + swz / 64; C = (st & 1) * 32 + (swz % 64) / 2; }
__host__ __device__ __forceinline__ int perm32(int rho) { const int n = rho >> 4, i = rho & 15; return 8 * (i >> 2) + 4 * n + (i & 3); }

struct Unit { int pm, pn; };
struct Gemm { const bf16_t* A; const bf16_t* Bt; int M, N, K; };

struct StaticOrder {
    int nM, nN, nwg, G, c;
    __host__ __device__ void init(int M, int N, int G_, int c_) { nM = M / BM; nN = N / BM; nwg = nM * nN; G = G_; c = c_; }
    __host__ __device__ bool next(int i, Unit& u) const {
        const long L = (long)i * G + c; if (L >= nwg) return false;
        int wgid = (int)L; { const int q = nwg / NXCD, r = nwg % NXCD, xcd = wgid % NXCD, off = wgid / NXCD; wgid = (xcd < r ? xcd * (q + 1) : r * (q + 1) + (xcd - r) * q) + off; }
        const int nig = WGM * nN, gid = wgid / nig, fm = gid * WGM, gsz = (nM - fm) < WGM ? (nM - fm) : WGM;
        u.pm = fm + ((wgid % nig) % gsz); u.pn = (wgid % nig) / gsz; return true;
    }
    __device__ __forceinline__ void a_ready(const Unit&) const {}
    __device__ __forceinline__ void done(const Unit&) const {}
};

__device__ __forceinline__ unsigned cvt_pk_bf16(float lo, float hi) { unsigned r; asm volatile("v_cvt_pk_bf16_f32 %0, %1, %2" : "=v"(r) : "v"(lo), "v"(hi)); return r; }

template <class Epi, class Sched, bool ALIGN_EPI = false, bool SP2 = false>
__device__ __forceinline__ void gemm_phase(PG8_LAS unsigned char* lds, const Gemm g, const Sched& S, const Epi& E) {
    int tid = threadIdx.x; asm volatile("" : "+v"(tid));
    const int wid = __builtin_amdgcn_readfirstlane(tid >> 6), lane = tid & 63, wr = wid >> 2, wc = wid & 3, fr = lane & 15, fq = lane >> 4;
    const int K = g.K, nt = K / BK;
    unsigned voffA[2], voffB[2];
#pragma unroll
    for (int i = 0; i < 2; ++i) { int R, C; stage_rc(tid * 16 + i * 8192, R, C); const int Rb = Epi::PERM ? ((R & ~31) + perm32(R & 31)) : R;
        voffA[i] = (unsigned)(R * K + C) * 2u; voffB[i] = (unsigned)(Rb * K + C) * 2u; }
    const size_t kstep = (size_t)(BK * 2);
    const size_t hstep = (size_t)HALF * K * 2;
    const size_t tstep = 2 * hstep;
    const unsigned ldsw = (unsigned)wid * 1024u;
    const int aoff = lds_byte(wr * 64 + fr, fq * 8), boff = lds_byte(wc * 32 + fr, fq * 8);
#define PG8_SA(b, h) (((b) * 2 + (h)) * HTB)
#define PG8_SB(b, h) ((4 + (b) * 2 + (h)) * HTB)
#define PG8_STAGE(bufoff, gbase, voff) do { _Pragma("unroll") for (int _i = 0; _i < 2; ++_i) \
        __builtin_amdgcn_global_load_lds((const unsigned*)((const char*)(gbase) + (voff)[_i]), (PG8_LAS unsigned*)(lds + (bufoff) + ldsw + _i * 8192), 16, 0, 0); } while (0)
#define PG8_LDA(dst, b, h) do { _Pragma("unroll") for (int m = 0; m < 4; ++m) _Pragma("unroll") for (int k = 0; k < 2; ++k) dst[m][k] = *(const PG8_LAS bf16x8*)(lds + PG8_SA(b, h) + aoff + m * 2048 + k * 1024); } while (0)
#define PG8_LDB(dst, b, h) do { _Pragma("unroll") for (int n = 0; n < 2; ++n) _Pragma("unroll") for (int k = 0; k < 2; ++k) dst[n][k] = *(const PG8_LAS bf16x8*)(lds + PG8_SB(b, h) + boff + n * 2048 + k * 1024); } while (0)
#define PG8_MMA(ai, bj, At, Bt) do { __builtin_amdgcn_s_setprio(1); _Pragma("unroll") for (int m = 0; m < 4; ++m) _Pragma("unroll") for (int n = 0; n < 2; ++n) _Pragma("unroll") for (int k = 0; k < 2; ++k) \
        acc[ai][bj][m][n] = __builtin_amdgcn_mfma_f32_16x16x32_bf16(Bt[n][k], At[m][k], acc[ai][bj][m][n], 0, 0, 0); __builtin_amdgcn_s_setprio(0); } while (0)
#define PG8_WAIT_V(n) asm volatile("s_waitcnt vmcnt(" #n ")" ::: "memory")
#define PG8_WAIT_L(n) asm volatile("s_waitcnt lgkmcnt(" #n ")" ::: "memory")
#define PG8_BAR __builtin_amdgcn_s_barrier()
#define PG8_SCHED __builtin_amdgcn_sched_barrier(0)
    Unit cur, nxt; int ui = 0;
    if (!S.next(0, cur)) return;
    f32x4 acc[2][2][4][2];
#pragma unroll
    for (int a = 0; a < 2; ++a)
#pragma unroll
        for (int b = 0; b < 2; ++b)
#pragma unroll
            for (int m = 0; m < 4; ++m)
#pragma unroll
                for (int n = 0; n < 2; ++n) acc[a][b][m][n] = (f32x4){0.f, 0.f, 0.f, 0.f};
    bf16x8 At[4][2], B0[2][2], B1[2][2];
    const char* cA = (const char*)g.A + (size_t)cur.pm * tstep; const char* cB = (const char*)g.Bt + (size_t)cur.pn * tstep;
    S.a_ready(cur);
    if constexpr (SP2) {
        PG8_STAGE(PG8_SB(0, 0), cB, voffB); PG8_STAGE(PG8_SB(0, 1), cB + hstep, voffB); PG8_STAGE(PG8_SA(0, 0), cA, voffA); PG8_STAGE(PG8_SA(0, 1), cA + hstep, voffA);
        if (wr == 1) PG8_BAR;
        PG8_WAIT_V(2); PG8_BAR;
        PG8_STAGE(PG8_SB(1, 0), cB + kstep, voffB); PG8_STAGE(PG8_SA(1, 0), cA + kstep, voffA); PG8_STAGE(PG8_SB(1, 1), cB + hstep + kstep, voffB);
        PG8_WAIT_V(6); PG8_BAR;
    } else {
        PG8_STAGE(PG8_SB(0, 0), cB, voffB); PG8_STAGE(PG8_SA(0, 0), cA, voffA); PG8_STAGE(PG8_SB(0, 1), cB + hstep, voffB); PG8_STAGE(PG8_SA(0, 1), cA + hstep, voffA);
        if (wr == 1) PG8_BAR;
        PG8_WAIT_V(4); PG8_BAR;
        PG8_STAGE(PG8_SB(1, 0), cB + kstep, voffB); PG8_STAGE(PG8_SA(1, 0), cA + kstep, voffA); PG8_STAGE(PG8_SB(1, 1), cB + hstep + kstep, voffB);
        PG8_WAIT_V(6); PG8_BAR;
    }
    for (;;) {
        const bool has_next = S.next(ui + 1, nxt);
        const char* nA = has_next ? (const char*)g.A + (size_t)nxt.pm * tstep : cA; const char* nB = has_next ? (const char*)g.Bt + (size_t)nxt.pn * tstep : cB;
        for (int t = 0; t < nt; t += 2) {
            const bool last = (t == nt - 2);
            const char* a1 = cA + (size_t)(t + 1) * kstep;
            const char* a2 = last ? nA : cA + (size_t)(t + 2) * kstep; const char* b2 = last ? nB : cB + (size_t)(t + 2) * kstep;
            const char* a3 = a2 + kstep; const char* b3 = b2 + kstep;
            if (last && has_next) S.a_ready(nxt);
            if constexpr (SP2) {
            PG8_LDB(B0, 0, 0); PG8_LDB(B1, 0, 1); PG8_SCHED; PG8_LDA(At, 0, 0); PG8_STAGE(PG8_SA(1, 1), a1 + hstep, voffA);
            PG8_WAIT_V(8); PG8_WAIT_L(0); PG8_BAR; PG8_MMA(0, 0, At, B0); PG8_MMA(0, 1, At, B1); PG8_BAR; PG8_SCHED;
            PG8_LDA(At, 0, 1); PG8_STAGE(PG8_SB(0, 0), b2, voffB); PG8_STAGE(PG8_SB(0, 1), b2 + hstep, voffB); PG8_STAGE(PG8_SA(0, 0), a2, voffA);
            PG8_WAIT_V(8); PG8_WAIT_L(0); PG8_BAR; PG8_MMA(1, 0, At, B0); PG8_MMA(1, 1, At, B1); PG8_BAR; PG8_SCHED;
            PG8_LDB(B0, 1, 0); PG8_LDB(B1, 1, 1); PG8_SCHED; PG8_LDA(At, 1, 0); PG8_STAGE(PG8_SA(0, 1), a2 + hstep, voffA);
            PG8_WAIT_V(8); PG8_WAIT_L(0); PG8_BAR; PG8_MMA(0, 0, At, B0); PG8_MMA(0, 1, At, B1); PG8_BAR; PG8_SCHED;
            PG8_LDA(At, 1, 1); PG8_STAGE(PG8_SB(1, 0), b3, voffB); PG8_STAGE(PG8_SB(1, 1), b3 + hstep, voffB); PG8_STAGE(PG8_SA(1, 0), a3, voffA);
            PG8_WAIT_V(8); PG8_WAIT_L(0); PG8_BAR; PG8_MMA(1, 0, At, B0); PG8_MMA(1, 1, At, B1); PG8_BAR; PG8_SCHED;
            } else {
            PG8_LDB(B0, 0, 0); PG8_SCHED; PG8_LDA(At, 0, 0); PG8_STAGE(PG8_SA(1, 1), a1 + hstep, voffA);
            PG8_WAIT_L(8); PG8_BAR; PG8_WAIT_L(0); PG8_MMA(0, 0, At, B0); PG8_BAR; PG8_SCHED;
            PG8_LDB(B1, 0, 1); PG8_STAGE(PG8_SB(0, 0), b2, voffB);
            PG8_BAR; PG8_WAIT_L(0); PG8_MMA(0, 1, At, B1); PG8_BAR;
            PG8_LDA(At, 0, 1); PG8_STAGE(PG8_SA(0, 0), a2, voffA);
            PG8_BAR; PG8_WAIT_L(0); PG8_MMA(1, 0, At, B0); PG8_BAR; PG8_SCHED;
            PG8_STAGE(PG8_SB(0, 1), b2 + hstep, voffB);
            PG8_WAIT_V(6); PG8_BAR; PG8_MMA(1, 1, At, B1); PG8_BAR;
            PG8_LDB(B0, 1, 0); PG8_SCHED; PG8_LDA(At, 1, 0); PG8_STAGE(PG8_SA(0, 1), a2 + hstep, voffA);
            PG8_WAIT_L(8); PG8_BAR; PG8_WAIT_L(0); PG8_MMA(0, 0, At, B0); PG8_BAR; PG8_SCHED;
            PG8_LDB(B1, 1, 1); PG8_STAGE(PG8_SB(1, 0), b3, voffB);
            PG8_BAR; PG8_WAIT_L(0); PG8_MMA(0, 1, At, B1); PG8_BAR;
            PG8_LDA(At, 1, 1); PG8_STAGE(PG8_SA(1, 0), a3, voffA);
            PG8_BAR; PG8_WAIT_L(0); PG8_MMA(1, 0, At, B0); PG8_BAR; PG8_SCHED;
            PG8_STAGE(PG8_SB(1, 1), b3 + hstep, voffB);
            PG8_WAIT_V(6); PG8_BAR; PG8_MMA(1, 1, At, B1); PG8_BAR;
            }
        }
        if constexpr (ALIGN_EPI) { if (wr == 0) PG8_BAR; }
        if constexpr (!Epi::AFTER_DRAIN) { E(acc, cur, wr, wc, fr, fq); S.done(cur); }
        if (!has_next) break;
#pragma unroll
        for (int a = 0; a < 2; ++a)
#pragma unroll
            for (int b = 0; b < 2; ++b)
#pragma unroll
                for (int m = 0; m < 4; ++m)
#pragma unroll
                    for (int n = 0; n < 2; ++n) acc[a][b][m][n] = (f32x4){0.f, 0.f, 0.f, 0.f};
        cur = nxt; cA = nA; cB = nB; ++ui;
        if constexpr (ALIGN_EPI) { if (wr == 1) PG8_BAR; }
    }
    PG8_WAIT_V(0);
    if constexpr (!ALIGN_EPI) { if (wr == 0) PG8_BAR; }
    PG8_BAR;
    if constexpr (Epi::AFTER_DRAIN) { E.fused(acc, cur, wr, wc, fr, fq, lds, wid, lane); S.done(cur); }
#undef PG8_SA
#undef PG8_SB
#undef PG8_STAGE
#undef PG8_LDA
#undef PG8_LDB
#undef PG8_MMA
#undef PG8_WAIT_V
#undef PG8_WAIT_L
#undef PG8_BAR
#undef PG8_SCHED
}
}

constexpr int NB = 2, T = 8192, L = 256, D = 1024, TP = T + L, R = NB * TP;
constexpr int FF = 4096, NPROJ = 3104, NPROJ_PAD = 3328, NQKV = 1536, NCH = TP / 64;
constexpr float ALPHA = 1.4142135623730951f;
constexpr int LDS_BYTES = 147456;

typedef unsigned short bf16;
typedef float f32x4 __attribute__((ext_vector_type(4)));
typedef short bf16x8 __attribute__((ext_vector_type(8)));
typedef short s16x4 __attribute__((ext_vector_type(4)));
typedef unsigned u32x4 __attribute__((ext_vector_type(4)));
typedef unsigned u32x2 __attribute__((ext_vector_type(2)));

constexpr size_t OFF_WIN = 0;
constexpr size_t OFF_WOUT0 = OFF_WIN + (size_t)NPROJ_PAD * D * 2;
constexpr size_t OFF_W1_0 = OFF_WOUT0 + (size_t)D * D * 2;
constexpr size_t OFF_W2_0 = OFF_W1_0 + (size_t)FF * D * 2;
constexpr size_t OFF_WQKV = OFF_W2_0 + (size_t)FF * D * 2;
constexpr size_t OFF_WOUT1 = OFF_WQKV + (size_t)NQKV * D * 2;
constexpr size_t OFF_W1_1 = OFF_WOUT1 + (size_t)D * D * 2;
constexpr size_t OFF_W2_1 = OFF_W1_1 + (size_t)FF * D * 2;
constexpr size_t OFF_MOD = OFF_W2_1 + (size_t)FF * D * 2;
constexpr size_t OFF_ROPE = OFF_MOD + 2 * 3 * 6144 * 4;
constexpr size_t OFF_BAR = OFF_ROPE + 128 * 16 * 8;
constexpr size_t OFF_XBAR = OFF_BAR + 256;
constexpr size_t OFF_RST = OFF_XBAR + 16384;
constexpr size_t OFF_XCTX = OFF_RST + (size_t)3 * R * 2 * 4;
constexpr size_t OFF_DEC = OFF_XCTX + (size_t)NB * L * D * 4;
constexpr size_t OFF_H = OFF_DEC + (size_t)32 * NCH * 64 * 4;
constexpr size_t OFF_P = OFF_H + (size_t)R * D * 2;
constexpr size_t OFF_ST = OFF_P + (size_t)R * NPROJ * 2;
constexpr size_t WS_TOTAL = OFF_ST + (size_t)32 * NCH * 8192 * 2;
static_assert(WS_TOTAL <= 268435456, "workspace map exceeds 256 MiB");
static_assert(OFF_P + (size_t)R * FF * 2 <= WS_TOTAL, "MLP hidden overlay");

typedef float f32x2_t __attribute__((ext_vector_type(2)));
typedef __bf16 bf16x2_t __attribute__((ext_vector_type(2)));
__device__ __forceinline__ unsigned pk2(float lo, float hi) { const f32x2_t v = {lo, hi}; const bf16x2_t b = __builtin_convertvector(v, bf16x2_t); return __builtin_bit_cast(unsigned, b); }
__device__ __forceinline__ unsigned f2bf(float f) { return pk2(f, f) & 0xffffu; }
__device__ __forceinline__ float bf2f(unsigned h) { return __uint_as_float(h << 16); }
__device__ __forceinline__ float bflo(unsigned u) { return __uint_as_float(u << 16); }
__device__ __forceinline__ float bfhi(unsigned u) { return __uint_as_float(u & 0xffff0000u); }
__device__ __forceinline__ float quad_max(float x) {
    const unsigned u = __float_as_uint(x);
    const auto r = __builtin_amdgcn_permlane32_swap(u, u, false, false);
    const float m = fmaxf(__uint_as_float(r[0]), __uint_as_float(r[1]));
    const unsigned v = __float_as_uint(m);
    const auto q = __builtin_amdgcn_permlane16_swap(v, v, false, false);
    return fmaxf(__uint_as_float(q[0]), __uint_as_float(q[1]));
}
__device__ __forceinline__ float quad_sum(float x) {
    const unsigned u = __float_as_uint(x);
    const auto r = __builtin_amdgcn_permlane32_swap(u, u, false, false);
    const float m = __uint_as_float(r[0]) + __uint_as_float(r[1]);
    const unsigned v = __float_as_uint(m);
    const auto q = __builtin_amdgcn_permlane16_swap(v, v, false, false);
    return __uint_as_float(q[0]) + __uint_as_float(q[1]);
}
__device__ __forceinline__ float dpp_add(float v, int ctrl_sel) {
    const int u = __float_as_int(v);
    const int t = ctrl_sel == 0 ? __builtin_amdgcn_update_dpp(0, u, 0xB1, 0xF, 0xF, true) : ctrl_sel == 1 ? __builtin_amdgcn_update_dpp(0, u, 0x4E, 0xF, 0xF, true)
                : ctrl_sel == 2 ? __builtin_amdgcn_update_dpp(0, u, 0x141, 0xF, 0xF, true) : __builtin_amdgcn_update_dpp(0, u, 0x140, 0xF, 0xF, true);
    return v + __int_as_float(t);
}
__device__ __forceinline__ float wave_sum(float v) { v = dpp_add(v, 0); v = dpp_add(v, 1); v = dpp_add(v, 2); v = dpp_add(v, 3); return quad_sum(v); }
#define MFMA16(a, b, c) __builtin_amdgcn_mfma_f32_16x16x32_bf16((a), (b), (c), 0, 0, 0)

__device__ __forceinline__ size_t row_off(int r, bool& isc, int& b) { b = (r >= TP) ? 1 : 0; const int p = r - b * TP; isc = p < L; return isc ? (size_t)(b * L + p) * D : (size_t)(b * T + p - L) * D; }

template <int ACT> struct EpiStore {
    static constexpr bool PERM = true, AFTER_DRAIN = false;
    bf16* O; int ldc; int ncols;
    __device__ __forceinline__ void operator()(const pg8::f32x4 (&acc)[2][2][4][2], const pg8::Unit& u, int wr, int wc, int fr, int fq) const {
        const int row0 = u.pm * 256 + wr * 64 + fr, col0 = u.pn * 256 + wc * 32 + 8 * fq;
#pragma unroll
        for (int ai = 0; ai < 2; ++ai)
#pragma unroll
            for (int m = 0; m < 4; ++m) {
                bf16* rowp = O + (size_t)(row0 + ai * 128 + m * 16) * ldc;
#pragma unroll
                for (int bj = 0; bj < 2; ++bj) {
                    const int col = col0 + bj * 128;
                    pg8::f32x4 v0 = acc[ai][bj][m][0], v1 = acc[ai][bj][m][1];
                    if (ACT == 1) {
#pragma unroll
                        for (int i = 0; i < 4; ++i) { float a = fmaxf(v0[i], 0.f), b = fmaxf(v1[i], 0.f); v0[i] = a * a; v1[i] = b * b; }
                    }
                    u32x4 w; w.x = pg8::cvt_pk_bf16(v0[0], v0[1]); w.y = pg8::cvt_pk_bf16(v0[2], v0[3]); w.z = pg8::cvt_pk_bf16(v1[0], v1[1]); w.w = pg8::cvt_pk_bf16(v1[2], v1[3]);
                    if (col < ncols) *(u32x4*)(rowp + col) = w;
                }
            }
    }
};
template <int SRC, bool DST_FIN> struct EpiResid {
    static constexpr bool PERM = true, AFTER_DRAIN = false;
    const void* src_lat; const void* src_ctx; bf16* dst_lat; bf16* dst_ctx; bf16* dst_fin; const float* gate;
    const float* rst; const float* lg; const float* lb;
    __device__ __forceinline__ void operator()(const pg8::f32x4 (&acc)[2][2][4][2], const pg8::Unit& u, int wr, int wc, int fr, int fq) const {
        const int b = u.pm > 33 ? 1 : 0, col0 = u.pn * 256 + wc * 32 + 8 * fq, rt0 = wr * 64 + fr;
        const size_t lat0 = (size_t)(u.pm * 256 - b * TP - L + b * T);
        const float* gt = gate + b * 6144;
#pragma unroll
        for (int bj = 0; bj < 2; ++bj) {
            const int col = col0 + bj * 128;
            const f32x4 g0 = *(const f32x4*)(gt + col), g1 = *(const f32x4*)(gt + col + 4);
            f32x4 l0, l1, m0, m1;
            if (SRC == 1) { l0 = *(const f32x4*)(lg + col); l1 = *(const f32x4*)(lg + col + 4); m0 = *(const f32x4*)(lb + col); m1 = *(const f32x4*)(lb + col + 4); }
#pragma unroll
            for (int ai = 0; ai < 2; ++ai)
#pragma unroll
                for (int m = 0; m < 4; ++m) {
                    const int rt = rt0 + ai * 128 + m * 16, row = u.pm * 256 + rt; const size_t off = (lat0 + rt) * D + col;
                    f32x4 x0, x1;
                    if (SRC == 0) { const float* sp = (const float*)src_lat + off; x0 = *(const f32x4*)sp; x1 = *(const f32x4*)(sp + 4); }
                    else { const float mean = rst[2 * row], rstd = rst[2 * row + 1];
                        const u32x4 w = *(const u32x4*)((const bf16*)src_lat + off);
                        x0 = (f32x4){bflo(w.x), bfhi(w.x), bflo(w.y), bfhi(w.y)}; x1 = (f32x4){bflo(w.z), bfhi(w.z), bflo(w.w), bfhi(w.w)};
                        x0 = (x0 - mean) * rstd * l0 + m0; x1 = (x1 - mean) * rstd * l1 + m1; }
                    const pg8::f32x4 a0 = acc[ai][bj][m][0], a1 = acc[ai][bj][m][1];
                    u32x4 o; o.x = pk2(ALPHA * x0.x + g0.x * a0[0], ALPHA * x0.y + g0.y * a0[1]); o.y = pk2(ALPHA * x0.z + g0.z * a0[2], ALPHA * x0.w + g0.w * a0[3]);
                    o.z = pk2(ALPHA * x1.x + g1.x * a1[0], ALPHA * x1.y + g1.y * a1[1]); o.w = pk2(ALPHA * x1.z + g1.z * a1[2], ALPHA * x1.w + g1.w * a1[3]);
                    bf16* dp = DST_FIN ? dst_fin + (size_t)row * D + col : dst_lat + off;
                    *(u32x4*)dp = o;
                }
        }
    }
};

__device__ __forceinline__ void transpose_item(const float* __restrict__ W, int K, int N, bf16* WT, float* scr, int item, int lane) {
    const int nblk = N / 32, kb = item / nblk, nb = item % nblk, k0 = 64 * kb, n0 = 32 * nb;
#pragma unroll 8
    for (int i = 0; i < 32; ++i) { const int kk = 2 * i + (lane >> 5); scr[kk * 33 + (lane & 31)] = W[(size_t)(k0 + kk) * N + n0 + (lane & 31)]; }
    asm volatile("s_waitcnt lgkmcnt(0)" ::: "memory");
    const int c = lane & 7;
#pragma unroll
    for (int j = 0; j < 4; ++j) { const int n = (lane >> 3) + 8 * j; const float* s = scr + (8 * c) * 33 + n;
        u32x4 o; o.x = pk2(s[0 * 33], s[1 * 33]); o.y = pk2(s[2 * 33], s[3 * 33]); o.z = pk2(s[4 * 33], s[5 * 33]); o.w = pk2(s[6 * 33], s[7 * 33]);
        *(u32x4*)(WT + (size_t)(n0 + n) * K + k0 + 8 * c) = o; }
    asm volatile("s_waitcnt lgkmcnt(0)" ::: "memory");
}

template <bool LAST, bool SKIPCTX>
__device__ __forceinline__ void ln_phase(float* rst, const bf16* vlat, const bf16* vctx, const bf16* vfin, float* outp, const float* __restrict__ g, const float* __restrict__ bt, const float* __restrict__ modn, bf16* H, int gw, int NGW, int lane) {
    int r = gw;
    if (SKIPCTX) { while (r < R) { const int p = r >= TP ? r - TP : r; if (p >= L) break; r += NGW; } }
    u32x4 vn[2];
    if (r < R) { bool isc; int b; const size_t off = row_off(r, isc, b); const bf16* xr = LAST ? vfin + (size_t)r * D : (isc ? vctx : vlat) + off;
#pragma unroll
        for (int j = 0; j < 2; ++j) vn[j] = *(const u32x4*)(xr + lane * 8 + 512 * j); }
    while (r < R) {
        bool isc; int b; const size_t off = row_off(r, isc, b);
        float v[16];
#pragma unroll
        for (int j = 0; j < 2; ++j)
#pragma unroll
            for (int i = 0; i < 4; ++i) { v[j * 8 + 2 * i] = bflo(vn[j][i]); v[j * 8 + 2 * i + 1] = bfhi(vn[j][i]); }
        int rn = r + NGW;
        if (SKIPCTX) { while (rn < R) { const int p = rn >= TP ? rn - TP : rn; if (p >= L) break; rn += NGW; } }
        if (rn < R) { bool isc2; int b2; const size_t off2 = row_off(rn, isc2, b2); const bf16* xr2 = LAST ? vfin + (size_t)rn * D : (isc2 ? vctx : vlat) + off2;
#pragma unroll
            for (int j = 0; j < 2; ++j) vn[j] = *(const u32x4*)(xr2 + lane * 8 + 512 * j); }
        float s = 0.f;
#pragma unroll
        for (int i = 0; i < 16; ++i) s += v[i];
        const float mean = wave_sum(s) * (1.f / D); float s2 = 0.f;
#pragma unroll
        for (int i = 0; i < 16; ++i) { v[i] -= mean; s2 += v[i] * v[i]; }
        const float rstd = 1.f / sqrtf(wave_sum(s2) * (1.f / D) + 1e-5f);
        const float* md = modn + (isc ? 2 : b) * 6144;
        if (!LAST && lane == 0) { rst[2 * r] = mean; rst[2 * r + 1] = rstd; }
#pragma unroll
        for (int j = 0; j < 2; ++j) {
            const int idx = lane * 8 + 512 * j;
            float y[8];
#pragma unroll
            for (int q = 0; q < 2; ++q) { const f32x4 gg = *(const f32x4*)(g + idx + 4 * q), bb = *(const f32x4*)(bt + idx + 4 * q);
#pragma unroll
                for (int i = 0; i < 4; ++i) y[q * 4 + i] = v[j * 8 + q * 4 + i] * rstd * gg[i] + bb[i]; }
            if (LAST) { *(f32x4*)(outp + off + idx) = (f32x4){y[0], y[1], y[2], y[3]}; *(f32x4*)(outp + off + idx + 4) = (f32x4){y[4], y[5], y[6], y[7]}; }
            else {
                float h[8];
#pragma unroll
                for (int q = 0; q < 2; ++q) { const f32x4 sh = *(const f32x4*)(md + idx + 4 * q), sc = *(const f32x4*)(md + 1024 + idx + 4 * q);
#pragma unroll
                    for (int i = 0; i < 4; ++i) h[q * 4 + i] = y[q * 4 + i] * (sc[i] + 1.f) + sh[i]; }
                u32x4 o; o.x = pk2(h[0], h[1]); o.y = pk2(h[2], h[3]); o.z = pk2(h[4], h[5]); o.w = pk2(h[6], h[7]);
                *(u32x4*)(H + (size_t)r * D + idx) = o;
            }
        }
        r = rn;
    }
}

__device__ __forceinline__ float log_sigmoid(float z) { return fminf(z, 0.f) - __logf(1.f + __expf(-fabsf(z))); }

constexpr int CS = 65;
constexpr float QSC = 0.125f * 1.4426950408889634f;
struct GatePre { u32x2 lr; f32x4 w; float bias; };
__device__ __forceinline__ GatePre gate_prefetch(int g, int h, const bf16* Pr, const float* gkw, const float* gkb, int tid) {
    GatePre p; p.lr = (u32x2){0u, 0u}; p.w = (f32x4){0.f, 0.f, 0.f, 0.f}; p.bias = 0.f;
    if (g) { const int c = tid >> 3, part = tid & 7;
        p.lr = *(const u32x2*)(Pr + (size_t)c * NPROJ + 3072 + part * 4);
        const int idx = tid * 4, dir = idx >> 10, r = (idx >> 6) & 15, d = idx & 63;
        p.w = *(const f32x4*)(gkw + (dir * 16 + r) * 256 + h * 64 + d);
        if (tid < 128) p.bias = gkb[(tid >> 6) * 256 + h * 64 + (tid & 63)]; }
    return p;
}
__device__ __forceinline__ void fill_cum3(float* cf, float* cb, float* lrs, float* wl, int g, int h, const GatePre& gp, const float* theta, int tid) {
    if (g == 0) {
        const float lgf = log1pf(-expf(theta[h])), lgb = log1pf(-expf(theta[4 + h]));
        for (int i = tid; i < 4096; i += 512) { const int c = i >> 6, d = i & 63; cf[c * CS + d] = (float)(c + 1) * lgf; cb[c * CS + d] = (float)(64 - c) * lgb; }
        __syncthreads();
        return;
    }
    { const int c = tid >> 3, part = tid & 7;
      float* lp = lrs + c * 33 + part * 4; lp[0] = bflo(gp.lr.x); lp[1] = bfhi(gp.lr.x); lp[2] = bflo(gp.lr.y); lp[3] = bfhi(gp.lr.y);
      *(f32x4*)(wl + tid * 4) = gp.w;
      if (tid < 128) wl[2048 + tid] = gp.bias; }
    __syncthreads();
    { const int c = tid >> 3, dg = tid & 7;
#pragma unroll
      for (int dir = 0; dir < 2; ++dir) {
          f32x4 za = *(const f32x4*)(wl + 2048 + dir * 64 + dg * 8), zb = *(const f32x4*)(wl + 2048 + dir * 64 + dg * 8 + 4);
#pragma unroll
          for (int r = 0; r < 16; ++r) { const float lv = lrs[c * 33 + dir * 16 + r];
              za += lv * *(const f32x4*)(wl + (dir * 16 + r) * 64 + dg * 8); zb += lv * *(const f32x4*)(wl + (dir * 16 + r) * 64 + dg * 8 + 4); }
          float* dst = (dir ? cb : cf) + c * CS + dg * 8;
#pragma unroll
          for (int j = 0; j < 4; ++j) { dst[j] = log_sigmoid(za[j]) * (1.f / 16.f); dst[4 + j] = log_sigmoid(zb[j]) * (1.f / 16.f); } } }
    __syncthreads();
    if (tid < 128) {
        const int dir = tid >> 6; float* arr = (dir ? cb : cf) + (tid & 63);
        float run = 0.f;
#pragma unroll
        for (int hh = 0; hh < 2; ++hh) {
            float v[32];
            const int base = dir ? (1 - hh) * 32 : hh * 32;
#pragma unroll
            for (int c = 0; c < 32; ++c) v[c] = arr[(base + c) * CS];
            if (dir == 0) {
#pragma unroll
                for (int c = 0; c < 32; ++c) { run += v[c]; arr[(base + c) * CS] = run; }
            } else {
#pragma unroll
                for (int c = 31; c >= 0; --c) { run += v[c]; arr[(base + c) * CS] = run; }
            }
        }
    }
    __syncthreads();
}

__device__ __forceinline__ void fast_bar(unsigned* ctr, unsigned& target) {
    asm volatile("s_waitcnt vmcnt(0)" ::: "memory");
    __syncthreads();
    target += gridDim.x;
    if (threadIdx.x == 0) {
        __builtin_amdgcn_fence(__ATOMIC_RELEASE, "agent");
        asm volatile("s_waitcnt vmcnt(0)" ::: "memory");
        __hip_atomic_fetch_add(ctr, 1u, __ATOMIC_RELAXED, __HIP_MEMORY_SCOPE_AGENT);
        while (__hip_atomic_load(ctr, __ATOMIC_RELAXED, __HIP_MEMORY_SCOPE_AGENT) < target) __builtin_amdgcn_s_sleep(1);
        __builtin_amdgcn_fence(__ATOMIC_ACQUIRE, "agent");
        asm volatile("s_waitcnt vmcnt(0)" ::: "memory");
    }
    __syncthreads();
}
#define RLX_AGENT __ATOMIC_RELAXED, __HIP_MEMORY_SCOPE_AGENT
#define XB_TMO      128
#define XB_XCNT(j)  (256  + 64 * (j))
#define XB_XSUB(j)  (1280 + 64 * (j))
#define XB_XGEN(j)  (2304 + 64 * (j))
#define XB_TOP      3328
#define XB_TOPGEN   3392
#define XCD_BAR_WORDS 3456
#define XB_SPIN_CAP (1u << 18)

__device__ __forceinline__ unsigned xb_ld(unsigned* p)              { return __hip_atomic_load(p, __ATOMIC_RELAXED, __HIP_MEMORY_SCOPE_AGENT); }
__device__ __forceinline__ unsigned xb_add(unsigned* p, unsigned v) { return __hip_atomic_fetch_add(p, v, __ATOMIC_RELAXED, __HIP_MEMORY_SCOPE_AGENT); }
__device__ __forceinline__ unsigned xb_xcc_id() { return (unsigned)__builtin_amdgcn_s_getreg((3 << 11) | 20) & 0xFu; }
#define XB_SPIN(cond, bar) do { unsigned _sp = 0; while (cond) { __builtin_amdgcn_s_sleep(1); \
    if ((++_sp & 255u) == 0u) { if (xb_ld(&(bar)[XB_TMO])) break; if (_sp > XB_SPIN_CAP) { atomicAdd(&(bar)[XB_TMO], 1u); break; } } } } while (0)

struct XcdBarrier {
    unsigned* bar; unsigned x;
    volatile unsigned* st;
};

__device__ __forceinline__ XcdBarrier xcd_barrier_post(unsigned* bar, volatile unsigned* st) {
    XcdBarrier b; b.bar = bar; b.x = xb_xcc_id(); b.st = st;
    if (threadIdx.x == 0) (void)xb_add(&bar[XB_XCNT(b.x)], 1u);
    return b;
}
__device__ __forceinline__ void xcd_barrier_complete(unsigned* bar, unsigned x, unsigned& nloc, unsigned& nx) {
    const unsigned G = gridDim.x * gridDim.y * gridDim.z;
    unsigned sum, cnt, mine, sp = 0u;
    for (;;) {
        sum = 0u; cnt = 0u; mine = 0u;
#pragma unroll
        for (unsigned j = 0; j < 16; ++j) { const unsigned c = xb_ld(&bar[XB_XCNT(j)]); sum += c; cnt += (c > 0u) ? 1u : 0u; mine = (j == x) ? c : mine; }
        if (sum == G) break;
        __builtin_amdgcn_s_sleep(1);
        if ((++sp & 255u) == 0u) { if (xb_ld(&bar[XB_TMO])) break; if (sp > XB_SPIN_CAP) { atomicAdd(&bar[XB_TMO], 1u); break; } }
    }
    nloc = mine > 0u ? mine : 1u; nx = cnt > 0u ? cnt : 1u;
}

__device__ __forceinline__ void xcd_barrier(const XcdBarrier& b) {
    asm volatile("s_waitcnt vmcnt(0)" ::: "memory");
    __syncthreads();
    if (threadIdx.x == 0) {
        unsigned* bar = b.bar;
        __builtin_amdgcn_s_waitcnt(0);
        unsigned nloc = b.st[0], nx = b.st[1];
        if (nloc == 0u) { xcd_barrier_complete(bar, b.x, nloc, nx); b.st[0] = nloc; b.st[1] = nx; }
        const unsigned old = xb_add(&bar[XB_XSUB(b.x)], 1u);
        const unsigned gen = old / nloc;
        if (old + 1u == (gen + 1u) * nloc) {
            __builtin_amdgcn_fence(__ATOMIC_RELEASE, "agent");
            asm volatile("s_waitcnt vmcnt(0)" ::: "memory");
            const unsigned og = xb_add(&bar[XB_TOP], 1u);
            const unsigned tg = og / nx;
            if (og + 1u == (tg + 1u) * nx) xb_add(&bar[XB_TOPGEN], 1u);
            else XB_SPIN(xb_ld(&bar[XB_TOPGEN]) == tg, bar);
            __builtin_amdgcn_fence(__ATOMIC_ACQUIRE, "agent");
            xb_add(&bar[XB_XGEN(b.x)], 1u);
            asm volatile("s_waitcnt vmcnt(0)" ::: "memory");
        } else {
            XB_SPIN(xb_ld(&bar[XB_XGEN(b.x)]) == gen, bar);
            __builtin_amdgcn_fence(__ATOMIC_ACQUIRE, "agent");
            asm volatile("s_waitcnt vmcnt(0)" ::: "memory");
        }
    }
    __syncthreads();
}

struct LatOrder {
    pg8::StaticOrder S;
    __device__ void init(int N, int G, int c) { S.init(NB * T, N, G, c); }
    __device__ bool next(int i, pg8::Unit& u) const { if (!S.next(i, u)) return false; u.pm = u.pm + 1 + (u.pm >= 32 ? 1 : 0); return true; }
    __device__ __forceinline__ void a_ready(const pg8::Unit&) const {}
    __device__ __forceinline__ void done(const pg8::Unit&) const {}
};
#ifndef PROBE_SEL
#define PROBE_SEL 0
#endif
#ifndef PROBE_MUL
#define PROBE_MUL 3
#endif
#define PACC_DECL unsigned long long pacc = 0, pacc_t0 = 0; (void)pacc; (void)pacc_t0;
#define PACC_BEGIN(k) if (PROBE_SEL == (k)) pacc_t0 = __builtin_amdgcn_s_memrealtime();
#define PACC_END(k) if (PROBE_SEL == (k)) pacc += __builtin_amdgcn_s_memrealtime() - pacc_t0;
#define PACC_SLEEP() if (PROBE_SEL >= 40 && PROBE_SEL < 60) { const unsigned long long t1 = __builtin_amdgcn_s_memrealtime(), dt = pacc * PROBE_MUL; while (__builtin_amdgcn_s_memrealtime() - t1 < dt) __builtin_amdgcn_s_sleep(8); }
#define PROBE_BEGIN(k) unsigned long long pt0_##k = 0; if (PROBE_SEL == (k)) pt0_##k = __builtin_amdgcn_s_memrealtime();
#define PROBE_END(k) if (PROBE_SEL == (k)) { const unsigned long long t1 = __builtin_amdgcn_s_memrealtime(), dt = (t1 - pt0_##k) * PROBE_MUL; while (__builtin_amdgcn_s_memrealtime() - t1 < dt) __builtin_amdgcn_s_sleep(8); }


template <int XT, int YT>
__device__ __forceinline__ void frag_gemm(pg8::f32x4 (&acc)[XT][YT], const bf16* X, int ldx, const bf16* Y, int ldy, int k0, int k1, int l15, int quad) {
#pragma unroll 4
    for (int k = k0; k < k1; k += 32) {
        bf16x8 xf[XT], yf[YT];
#pragma unroll
        for (int i = 0; i < XT; ++i) xf[i] = *(const bf16x8*)(X + (size_t)(i * 16 + l15) * ldx + k + quad * 8);
#pragma unroll
        for (int j = 0; j < YT; ++j) yf[j] = *(const bf16x8*)(Y + (size_t)(j * 16 + l15) * ldy + k + quad * 8);
#pragma unroll
        for (int i = 0; i < XT; ++i)
#pragma unroll
            for (int j = 0; j < YT; ++j) acc[i][j] = MFMA16(xf[i], yf[j], acc[i][j]);
    }
}
template <bool SRC_LN>
__device__ __forceinline__ void ctx_resid_tiles(const bf16* A, const bf16* Bt, int K, const void* src_ctx, bf16* dst_ctx, const float* gate_ctx, const float* rst, const float* lg, const float* lb, float* part, int bid, int G, int tid, int wave, int l15, int quad) {
    for (int t = bid; t < 256; t += G) {
        const int rt = t >> 5, c0 = (t & 31) * 32, b = rt >> 2, p0 = (rt & 3) * 64, r0 = b * TP + p0;
        pg8::f32x4 acc[4][2];
#pragma unroll
        for (int i = 0; i < 4; ++i)
#pragma unroll
            for (int j = 0; j < 2; ++j) acc[i][j] = (pg8::f32x4){0.f, 0.f, 0.f, 0.f};
        const int ksl = K >> 3;
        frag_gemm<4, 2>(acc, A + (size_t)r0 * K, K, Bt + (size_t)c0 * K, K, wave * ksl, (wave + 1) * ksl, l15, quad);
        float* pw = part + wave * 2048;
#pragma unroll
        for (int i = 0; i < 4; ++i)
#pragma unroll
            for (int j = 0; j < 2; ++j)
#pragma unroll
                for (int rg = 0; rg < 4; ++rg) pw[(i * 16 + quad * 4 + rg) * 32 + j * 16 + l15] = acc[i][j][rg];
        __syncthreads();
        { const int row = tid >> 3, c4 = (tid & 7) * 4;
          f32x4 sum = *(const f32x4*)(part + row * 32 + c4);
#pragma unroll
          for (int w = 1; w < 8; ++w) sum += *(const f32x4*)(part + w * 2048 + row * 32 + c4);
          const size_t off = (size_t)(b * L + p0 + row) * D + c0 + c4;
          f32x4 x4; const f32x4 g4 = *(const f32x4*)(gate_ctx + c0 + c4);
          if (!SRC_LN) x4 = *(const f32x4*)((const float*)src_ctx + off);
          else { const int rU = r0 + row; const u32x2 w = *(const u32x2*)((const bf16*)src_ctx + off); x4 = (f32x4){bflo(w.x), bfhi(w.x), bflo(w.y), bfhi(w.y)};
              x4 = (x4 - rst[2 * rU]) * rst[2 * rU + 1] * *(const f32x4*)(lg + c0 + c4) + *(const f32x4*)(lb + c0 + c4); }
          const f32x4 vv = x4 * ALPHA + g4 * sum; u32x2 o; o.x = pk2(vv.x, vv.y); o.y = pk2(vv.z, vv.w);
          *(u32x2*)(dst_ctx + off) = o; }
        __syncthreads();
    }
}
__device__ __forceinline__ void ctx_up_tiles(const bf16* A, const bf16* Bt, bf16* O, int bid, int G, int wave, int l15, int quad) {
    for (int t = bid; t < 256; t += G) {
        const int rt = t >> 5, c0 = (t & 31) * 128 + (wave & 3) * 32, b = rt >> 2, r0 = b * TP + (rt & 3) * 64 + (wave >> 2) * 32;
        pg8::f32x4 acc[2][2];
#pragma unroll
        for (int i = 0; i < 2; ++i)
#pragma unroll
            for (int j = 0; j < 2; ++j) acc[i][j] = (pg8::f32x4){0.f, 0.f, 0.f, 0.f};
        frag_gemm<2, 2>(acc, Bt + (size_t)c0 * D, D, A + (size_t)r0 * D, D, 0, D, l15, quad);
#pragma unroll
        for (int i = 0; i < 2; ++i)
#pragma unroll
            for (int j = 0; j < 2; ++j) { float v[4];
#pragma unroll
                for (int rg = 0; rg < 4; ++rg) { const float a_ = fmaxf(acc[i][j][rg], 0.f); v[rg] = a_ * a_; }
                u32x2 o; o.x = pk2(v[0], v[1]); o.y = pk2(v[2], v[3]);
                *(u32x2*)(O + (size_t)(r0 + j * 16 + l15) * FF + c0 + i * 16 + quad * 4) = o; }
    }
}

template <int ACT>
__device__ __forceinline__ void ctx_ksplit_tiles(const bf16* A, const bf16* Bt, bf16* O, int ldo, int ntn, int ncols, float* part, int bid, int G, int tid, int wave, int l15, int quad) {
    for (int t = bid; t < 8 * ntn; t += G) {
        const int rt = t / ntn, c0 = (t % ntn) * 64, b = rt >> 2, r0 = b * TP + (rt & 3) * 64;
        pg8::f32x4 acc[4][4];
#pragma unroll
        for (int i = 0; i < 4; ++i)
#pragma unroll
            for (int j = 0; j < 4; ++j) acc[i][j] = (pg8::f32x4){0.f, 0.f, 0.f, 0.f};
        frag_gemm<4, 4>(acc, A + (size_t)r0 * D, D, Bt + (size_t)c0 * D, D, wave * 128, (wave + 1) * 128, l15, quad);
        float* pw = part + wave * 4096;
#pragma unroll
        for (int i = 0; i < 4; ++i)
#pragma unroll
            for (int j = 0; j < 4; ++j)
#pragma unroll
                for (int rg = 0; rg < 4; ++rg) pw[(i * 16 + quad * 4 + rg) * 64 + j * 16 + l15] = acc[i][j][rg];
        __syncthreads();
        { const int row = tid >> 3, c8 = (tid & 7) * 8;
          f32x4 s0 = *(const f32x4*)(part + row * 64 + c8), s1 = *(const f32x4*)(part + row * 64 + c8 + 4);
#pragma unroll
          for (int w = 1; w < 8; ++w) { s0 += *(const f32x4*)(part + w * 4096 + row * 64 + c8); s1 += *(const f32x4*)(part + w * 4096 + row * 64 + c8 + 4); }
          if (ACT == 1) {
#pragma unroll
              for (int k = 0; k < 4; ++k) { float a_ = fmaxf(s0[k], 0.f), b_ = fmaxf(s1[k], 0.f); s0[k] = a_ * a_; s1[k] = b_ * b_; } }
          u32x4 o; o.x = pk2(s0.x, s0.y); o.y = pk2(s0.z, s0.w); o.z = pk2(s1.x, s1.y); o.w = pk2(s1.z, s1.w);
          const int col = c0 + c8;
          if (col < ncols) *(u32x4*)(O + (size_t)(r0 + row) * ldo + col) = o; }
        __syncthreads();
    }
}

struct Args { const float* in[19]; float* out; unsigned char* ws; };

__global__ void __launch_bounds__(512, 2) fwd_kernel(Args a) {
    extern __shared__ __attribute__((aligned(16))) unsigned char lds[];
    cg::grid_group grid = cg::this_grid();
    const int G = gridDim.x, bid = blockIdx.x, NGW = G * 8;
#define IDS int tid = threadIdx.x; asm volatile("" : "+v"(tid)); const int lane = tid & 63, wave = __builtin_amdgcn_readfirstlane(tid >> 6), quad = lane >> 4, l15 = lane & 15, gw = bid * 8 + wave; (void)quad; (void)l15; (void)gw; (void)lane;
#define xin (a.in[0])
#define cvec (a.in[1])
#define ctx (a.in[2])
#define cctx (a.in[3])
#define w_mod (a.in[4])
#define b_mod (a.in[5])
#define ln_g (a.in[6])
#define ln_b (a.in[7])
#define theta (a.in[11])
#define gkw (a.in[12])
#define gkb (a.in[13])
#define normg (a.in[14])
#define sink (a.in[17])
#define WIN_T ((bf16*)(a.ws + OFF_WIN))
#define WOUT0_T ((bf16*)(a.ws + OFF_WOUT0))
#define W1_0_T ((bf16*)(a.ws + OFF_W1_0))
#define W2_0_T ((bf16*)(a.ws + OFF_W2_0))
#define WQKV_T ((bf16*)(a.ws + OFF_WQKV))
#define WOUT1_T ((bf16*)(a.ws + OFF_WOUT1))
#define W1_1_T ((bf16*)(a.ws + OFF_W1_1))
#define W2_1_T ((bf16*)(a.ws + OFF_W2_1))
#define mod ((float*)(a.ws + OFF_MOD))
#define rope ((float*)(a.ws + OFF_ROPE))
#define xctx ((float*)(a.ws + OFF_XCTX))
#define DEC ((float*)(a.ws + OFF_DEC))
#define H ((bf16*)(a.ws + OFF_H))
#define P ((bf16*)(a.ws + OFF_P))
#define ST ((bf16*)(a.ws + OFF_ST))
#define xlat (a.out)
#define RST(i) ((float*)(a.ws + OFF_RST) + (size_t)(i) * R * 2)
#define VLAT ((bf16*)a.out)
#define VCTX ((bf16*)(a.ws + OFF_XCTX))

#define LATE_ITEMS 9472
#define LATE_CHUNK 16
#define DRAIN_LATE(scr_, maxc_) do { int nclaim_ = 0; unsigned* qc_ = (unsigned*)(a.ws + OFF_XBAR) + 3584; volatile unsigned* qw_ = (volatile unsigned*)(lds + 131072 + 1024); \
        for (;;) { if (nclaim_++ >= (maxc_)) break; if (tid == 0) qw_[0] = __hip_atomic_fetch_add(qc_, (unsigned)LATE_CHUNK, __ATOMIC_RELAXED, __HIP_MEMORY_SCOPE_AGENT);     \
            __syncthreads(); const int base_ = (int)__builtin_amdgcn_readfirstlane(qw_[0]); __syncthreads(); \
            if (base_ >= LATE_ITEMS) break; \
            for (int k_ = wave; k_ < LATE_CHUNK; k_ += 8) { int r_ = base_ + k_; if (r_ >= LATE_ITEMS) break; \
                if (r_ < 2048) { transpose_item(a.in[8], 1024, FF, W1_0_T, (scr_), r_, lane); continue; } r_ -= 2048; \
                if (r_ < 2048) { transpose_item(a.in[9], FF, 1024, W2_0_T, (scr_), r_, lane); continue; } r_ -= 2048; \
                if (r_ < 768) { transpose_item(a.in[16], 1024, NQKV, WQKV_T, (scr_), r_, lane); continue; } r_ -= 768; \
                if (r_ < 512) { transpose_item(a.in[18], 1024, 1024, WOUT1_T, (scr_), r_, lane); continue; } r_ -= 512; \
                if (r_ < 2048) { transpose_item(a.in[8] + (size_t)1024 * FF, 1024, FF, W1_1_T, (scr_), r_, lane); continue; } r_ -= 2048; \
                transpose_item(a.in[9] + (size_t)FF * 1024, FF, 1024, W2_1_T, (scr_), r_, lane); } } } while (0)
    PG8_LAS unsigned char* ldsg = (PG8_LAS unsigned char*)lds;
    unsigned* barw = (unsigned*)(a.ws + OFF_BAR); unsigned bar_target = 0u; (void)barw; (void)bar_target;
    unsigned* xbw = (unsigned*)(a.ws + OFF_XBAR);
    volatile unsigned* xst = (volatile unsigned*)(lds + 131072 + 512);
    if (threadIdx.x == 0) { xst[0] = 0u; xst[1] = 0u; }
    XcdBarrier xbar = xcd_barrier_post(xbw, xst);
    if (a.ws == nullptr) grid.sync();

PROBE_BEGIN(1)
    { IDS
        float* sl = (float*)lds; float* red = (float*)(lds + 12288);
        for (int item = bid; item < 192; item += G) {
            for (int i = tid; i < 3072; i += 512) { const int j = i >> 10, k = i & 1023; const float v = (j < 2) ? cvec[j * 1024 + k] : cctx[k]; sl[i] = v / (1.f + expf(-v)); }
            __syncthreads();
            const int layer = item / 96, n0 = (item % 96) * 64;
            const float* W = w_mod + (size_t)layer * 1024 * 6144 + n0 + lane;
            float a0 = 0.f, a1 = 0.f, a2 = 0.f; const int k0 = wave * 128;
#pragma unroll 8
            for (int kk = 0; kk < 128; ++kk) { const int k = k0 + kk; const float w = W[(size_t)k * 6144]; a0 += sl[k] * w; a1 += sl[1024 + k] * w; a2 += sl[2048 + k] * w; }
            red[(wave * 3 + 0) * 64 + lane] = a0; red[(wave * 3 + 1) * 64 + lane] = a1; red[(wave * 3 + 2) * 64 + lane] = a2;
            __syncthreads();
            if (tid < 192) { const int j = tid >> 6, col = tid & 63; float s = b_mod[layer * 6144 + n0 + col];
#pragma unroll
                for (int w = 0; w < 8; ++w) s += red[(w * 3 + j) * 64 + col];
                mod[(layer * 3 + j) * 6144 + n0 + col] = s; }
            __syncthreads();
        }
        if (bid == G - 1 && tid < 16) {
            double f = 1.0; for (int i = 0; i < tid; ++i) f *= 0.56234132519034908;
            const double x2 = f * f; double cs = 1.0, sn = f, tc = 1.0, ts = f;
            for (int n = 1; n <= 12; ++n) { tc *= -x2 / (double)((2 * n - 1) * (2 * n)); cs += tc; ts *= -x2 / (double)((2 * n) * (2 * n + 1)); sn += ts; }
            double c = 1.0, s = 0.0;
            for (int p = 0; p < 128; ++p) { rope[(p * 16 + tid) * 2] = (float)c; rope[(p * 16 + tid) * 2 + 1] = (float)s; const double nc = c * cs - s * sn; s = s * cs + c * sn; c = nc; }
        }
        float* scr = (float*)(lds + 32768 + wave * 8448);
        for (int it = gw; it < 2064; it += NGW) {
            int r = it;
            if (r < 1552) { transpose_item(a.in[10], 1024, NPROJ, WIN_T, scr, r, lane); continue; } r -= 1552;
            transpose_item(a.in[15], 1024, 1024, WOUT0_T, scr, r, lane);
        }
        { u32x4* z = (u32x4*)(WIN_T + (size_t)NPROJ * D); const u32x4 zero = {0u, 0u, 0u, 0u};
          for (int i = bid * 512 + tid; i < (NPROJ_PAD - NPROJ) * D / 8; i += G * 512) z[i] = zero; }
    }
PROBE_END(1)
    xcd_barrier(xbar);


PROBE_BEGIN(2)
    { IDS
    for (int r = gw; r < R; r += 2 * NGW) {
        const int r2 = r + NGW; const bool has2 = r2 < R;
        bool isc, isc2; int b, b2; const size_t off = row_off(r, isc, b), off2 = row_off(has2 ? r2 : r, isc2, b2);
        const float* xr = (isc ? ctx : xin) + off; const float* md = mod + (isc ? 2 : b) * 6144;
        const float* xr2 = (isc2 ? ctx : xin) + off2; const float* md2 = mod + (isc2 ? 2 : b2) * 6144;
        f32x4 va[4], vb[4];
#pragma unroll
        for (int j = 0; j < 4; ++j) { va[j] = *(const f32x4*)(xr + lane * 4 + 256 * j); vb[j] = *(const f32x4*)(xr2 + lane * 4 + 256 * j); }
#pragma unroll
        for (int j = 0; j < 4; ++j) {
            const int idx = lane * 4 + 256 * j;
            { const f32x4 sh = *(const f32x4*)(md + idx), sc = *(const f32x4*)(md + 1024 + idx);
              const f32x4 h = va[j] * (sc + 1.f) + sh; u32x2 o; o.x = pk2(h.x, h.y); o.y = pk2(h.z, h.w);
              *(u32x2*)(H + (size_t)r * D + idx) = o; }
            if (has2) { const f32x4 sh = *(const f32x4*)(md2 + idx), sc = *(const f32x4*)(md2 + 1024 + idx);
              const f32x4 h = vb[j] * (sc + 1.f) + sh; u32x2 o; o.x = pk2(h.x, h.y); o.y = pk2(h.z, h.w);
              *(u32x2*)(H + (size_t)r2 * D + idx) = o; }
        }
    }
    }
PROBE_END(2)
    xcd_barrier(xbar);
    if (PROBE_SEL == 10) { for (int i = 0; i < 10; ++i) xcd_barrier(xbar); }

PROBE_BEGIN(8)
    { pg8::Gemm g{H, WIN_T, R, NPROJ_PAD, D}; pg8::StaticOrder S; S.init(R, NPROJ_PAD, G, bid); EpiStore<0> E{P, NPROJ, NPROJ};
      pg8::gemm_phase<EpiStore<0>, pg8::StaticOrder, true, true>(ldsg, g, S, E); }
PROBE_END(8)
    xcd_barrier(xbar);

PROBE_BEGIN(3)
#ifndef NO_P3
    { IDS
        float* cf = (float*)lds; float* cb = (float*)(lds + 16640); float* lrs = (float*)(lds + 33280); float* wl = (float*)(lds + 41728);
        bf16* kTf = (bf16*)(lds + 50432); bf16* kTb = (bf16*)(lds + 59648); bf16* vT = (bf16*)(lds + 68864);
        constexpr int NU = NB * 2 * 4 * NCH;
        const int s = tid & 63, dc = tid >> 6;
        u32x4 kv = {0u, 0u, 0u, 0u}, vv0 = kv, vv1 = kv; GatePre gp; gp.lr = (u32x2){0u, 0u}; gp.w = (f32x4){0.f, 0.f, 0.f, 0.f}; gp.bias = 0.f;
#define P3_LOAD(U) do { const int pc_ = (U) % NCH, t_ = (U) / NCH, h_ = t_ & 3, g_ = 1 - (t_ >> 3), b_ = (t_ >> 2) & 1; const bf16* Pr_ = P + (size_t)(b_ * TP + pc_ * 64) * NPROJ; \
            const int kcol_ = g_ ? 1792 + h_ * 64 : 256 + h_ * 64, vcol_ = g_ ? 2048 + h_ * 128 : 512 + h_ * 128; \
            kv = *(const u32x4*)(Pr_ + (size_t)s * NPROJ + kcol_ + dc * 8); vv0 = *(const u32x4*)(Pr_ + (size_t)s * NPROJ + vcol_ + dc * 8); vv1 = *(const u32x4*)(Pr_ + (size_t)s * NPROJ + vcol_ + (dc + 8) * 8); \
            gp = gate_prefetch(g_, h_, Pr_, gkw, gkb, tid); } while (0)
        float* lgs = (float*)(lds + 131072 + 2048);
        if (tid < 8) lgs[tid] = log1pf(-expf(theta[tid]));
        __syncthreads();
        if (bid < NU) P3_LOAD(bid);
        for (int unit = bid; unit < NU; unit += G) {
            const int pc = unit % NCH, t = unit / NCH, h = t & 3, g = 1 - (t >> 3), b = (t >> 2) & 1;
            const float kscale = g ? 1.f : 0.125f;
            float lgf = 0.f, lgb = 0.f;
            if (g) fill_cum3(cf, cb, lrs, wl, g, h, gp, theta, tid);
            else { lgf = lgs[h]; lgb = lgs[4 + h]; }
            {
              if (g) {
#pragma unroll
              for (int j = 0; j < 8; ++j) { const int d = dc * 8 + j; const unsigned u = kv[j >> 1]; const float kf = ((j & 1) ? bfhi(u) : bflo(u)) * kscale;
                  kTf[d * 72 + s] = (bf16)f2bf(kf * __expf(cf[63 * CS + d] - cf[s * CS + d]));
                  kTb[d * 72 + s] = (bf16)f2bf(kf * __expf(cb[d] - cb[s * CS + d])); }
              } else { const float ef = __expf((float)(63 - s) * lgf) * kscale, eb = __expf((float)s * lgb) * kscale;
#pragma unroll
              for (int j = 0; j < 8; ++j) { const int d = dc * 8 + j; const unsigned u = kv[j >> 1]; const float kf = (j & 1) ? bfhi(u) : bflo(u);
                  kTf[d * 72 + s] = (bf16)f2bf(kf * ef); kTb[d * 72 + s] = (bf16)f2bf(kf * eb); }
              }
#pragma unroll
              for (int j = 0; j < 8; ++j) { const unsigned u0 = vv0[j >> 1], u1 = vv1[j >> 1];
                  vT[(dc * 8 + j) * 72 + s] = (bf16)((j & 1) ? (u0 >> 16) : (u0 & 0xffffu)); vT[((dc + 8) * 8 + j) * 72 + s] = (bf16)((j & 1) ? (u1 >> 16) : (u1 & 0xffffu)); }
            }
            const int seq0 = ((b * 2 + g) * 4 + h) * 2;
            const int nf = pc, nbk = (pc < 4) ? 3 - pc : 135 - pc;
            if (tid < 128) { const int dir = tid >> 6, d = tid & 63;
                DEC[((size_t)(seq0 + dir) * NCH + (dir ? nbk : nf)) * 64 + d] = g ? (dir ? expf(cb[d]) : expf(cf[63 * CS + d])) : expf(64.f * (dir ? lgb : lgf)); }
            if (unit + G < NU) P3_LOAD(unit + G);
            __syncthreads();
            bf16x8 bfr[2];
#pragma unroll
            for (int ks = 0; ks < 2; ++ks) bfr[ks] = *(const bf16x8*)(vT + (wave * 16 + l15) * 72 + ks * 32 + quad * 8);
#pragma unroll
            for (int dir = 0; dir < 2; ++dir) {
                const bf16* kT = dir ? kTb : kTf;
                bf16* dst = ST + ((size_t)(seq0 + dir) * NCH + (dir ? nbk : nf)) * 8192 + (size_t)(wave * 16 + l15) * 64;
#pragma unroll
                for (int dt = 0; dt < 4; ++dt) {
                    pg8::f32x4 acc = {0.f, 0.f, 0.f, 0.f};
#pragma unroll
                    for (int ks = 0; ks < 2; ++ks) { const bf16x8 af = *(const bf16x8*)(kT + (dt * 16 + l15) * 72 + ks * 32 + quad * 8); acc = MFMA16(af, bfr[ks], acc); }
                    u32x2 o; o.x = pk2(acc[0], acc[1]); o.y = pk2(acc[2], acc[3]);
                    *(u32x2*)(dst + dt * 16 + quad * 4) = o;
                }
            }
            __syncthreads();
        }
#undef P3_LOAD
        if ((NU - bid + G - 1) / G < (NU + G - 1) / G) DRAIN_LATE((float*)(lds + wave * 8448), 1);
    }
#endif
PROBE_END(3)
    xcd_barrier(xbar);

PROBE_BEGIN(4)
    { IDS
    for (int i = bid * 512 + tid; i < 32 * 4096; i += G * 512) {
        const int seq = i >> 12, pi = i & 4095, d = (2 * pi) & 63;
        unsigned* sp = (unsigned*)(ST + (size_t)seq * NCH * 8192) + pi; const float* dp = DEC + (size_t)seq * NCH * 64 + d;
        float s0 = 0.f, s1 = 0.f;
#pragma unroll 4
        for (int n = 0; n < NCH; ++n) {
            const unsigned kv = sp[(size_t)n * 4096]; const float d0 = dp[n * 64], d1 = dp[n * 64 + 1];
            sp[(size_t)n * 4096] = pk2(s0, s1);
            s0 = d0 * s0 + bflo(kv); s1 = d1 * s1 + bfhi(kv);
        }
    }
    }
PROBE_END(4)
    xcd_barrier(xbar);

PROBE_BEGIN(5)
#ifndef NO_P5
    { IDS
        float* cf = (float*)lds; float* cb = (float*)(lds + 16640); float* lrs = (float*)(lds + 33280); float* wl = (float*)(lds + 41728);
        bf16* qdf = (bf16*)(lds + 50432); bf16* kif = (bf16*)(lds + 59648); bf16* qdb = (bf16*)(lds + 68864); bf16* kib = (bf16*)(lds + 78080);
        bf16* vT = (bf16*)(lds + 87296); bf16* Am = (bf16*)(lds + 105728); float* red = (float*)(lds + 114944);
        constexpr int NU = NB * 2 * 4 * NCH;
        const int dcq = tid & 7, sq = tid >> 3, sv = tid & 63, dcv = tid >> 6;
        u32x4 qv = {0u, 0u, 0u, 0u}, kv = qv, vv0 = qv, vv1 = qv; GatePre gp; gp.lr = (u32x2){0u, 0u}; gp.w = (f32x4){0.f, 0.f, 0.f, 0.f}; gp.bias = 0.f;
#define P5_LOAD(U) do { const int pc_ = (U) % NCH, t_ = (U) / NCH, h_ = t_ & 3, g_ = 1 - (t_ >> 3), b_ = (t_ >> 2) & 1; const bf16* Pr_ = P + (size_t)(b_ * TP + pc_ * 64) * NPROJ; \
            const int qcol_ = g_ ? 1536 + h_ * 64 : h_ * 64, kcol_ = g_ ? 1792 + h_ * 64 : 256 + h_ * 64, vcol_ = g_ ? 2048 + h_ * 128 : 512 + h_ * 128; \
            qv = *(const u32x4*)(Pr_ + (size_t)sq * NPROJ + qcol_ + dcq * 8); kv = *(const u32x4*)(Pr_ + (size_t)sq * NPROJ + kcol_ + dcq * 8); \
            vv0 = *(const u32x4*)(Pr_ + (size_t)sv * NPROJ + vcol_ + dcv * 8); vv1 = *(const u32x4*)(Pr_ + (size_t)sv * NPROJ + vcol_ + (dcv + 8) * 8); \
            gp = gate_prefetch(g_, h_, Pr_, gkw, gkb, tid); } while (0)
        f32x4 ngv[4];
#pragma unroll
        for (int et = 0; et < 4; ++et) ngv[et] = *(const f32x4*)(normg + ((wave >> 2) * 4 + et) * 16 + quad * 4);
        float* lgs = (float*)(lds + 131072 + 2048);
        if (tid < 8) lgs[tid] = log1pf(-expf(theta[tid]));
        __syncthreads();
        if (bid < NU) P5_LOAD(bid);
        for (int unit = bid; unit < NU; unit += G) {
            const int pc = unit % NCH, t = unit / NCH, h = t & 3, g = 1 - (t >> 3), b = (t >> 2) & 1;
            const int r0 = b * TP + pc * 64;
            const int gcol = g ? 2560 + h * 128 : 1024 + h * 128;
            const float qscale = g ? 0.125f : 1.f, kscale = g ? 1.f : 0.125f;
            if (g) fill_cum3(cf, cb, lrs, wl, g, h, gp, theta, tid);
            { u32x4 o1, o2, o3, o4;
              if (g) {
#pragma unroll
              for (int j2 = 0; j2 < 4; ++j2) {
                  const int d = dcq * 8 + 2 * j2;
                  const float f0 = cf[sq * CS + d], f1 = cf[sq * CS + d + 1], b0 = cb[sq * CS + d], b1 = cb[sq * CS + d + 1];
                  const float q0 = bflo(qv[j2]) * qscale, q1 = bfhi(qv[j2]) * qscale, k0 = bflo(kv[j2]) * kscale, k1 = bfhi(kv[j2]) * kscale;
                  o1[j2] = pk2(q0 * __expf(f0), q1 * __expf(f1)); o2[j2] = pk2(k0 * __expf(-f0), k1 * __expf(-f1));
                  o3[j2] = pk2(q0 * __expf(b0), q1 * __expf(b1)); o4[j2] = pk2(k0 * __expf(-b0), k1 * __expf(-b1));
              }
              } else {
                  const float lgf = lgs[h], lgb = lgs[4 + h];
                  const float cfr = (float)(sq + 1) * lgf, cbr = (float)(64 - sq) * lgb;
                  const float ef = __expf(cfr) * qscale, eif = __expf(-cfr) * kscale, eb = __expf(cbr) * qscale, eib = __expf(-cbr) * kscale;
#pragma unroll
                  for (int j2 = 0; j2 < 4; ++j2) { const float q0 = bflo(qv[j2]), q1 = bfhi(qv[j2]), k0 = bflo(kv[j2]), k1 = bfhi(kv[j2]);
                      o1[j2] = pk2(q0 * ef, q1 * ef); o2[j2] = pk2(k0 * eif, k1 * eif); o3[j2] = pk2(q0 * eb, q1 * eb); o4[j2] = pk2(k0 * eib, k1 * eib); }
              }
              *(u32x4*)(qdf + sq * 72 + dcq * 8) = o1; *(u32x4*)(kif + sq * 72 + dcq * 8) = o2; *(u32x4*)(qdb + sq * 72 + dcq * 8) = o3; *(u32x4*)(kib + sq * 72 + dcq * 8) = o4;
#pragma unroll
              for (int j = 0; j < 8; ++j) { const unsigned u0 = vv0[j >> 1], u1 = vv1[j >> 1];
                  vT[(dcv * 8 + j) * 72 + sv] = (bf16)((j & 1) ? (u0 >> 16) : (u0 & 0xffffu)); vT[((dcv + 8) * 8 + j) * 72 + sv] = (bf16)((j & 1) ? (u1 >> 16) : (u1 & 0xffffu)); }
            }
            __syncthreads();
            const int ct = wave & 3, eh = wave >> 2;
            const int seq0 = ((b * 2 + g) * 4 + h) * 2;
            const int nf = pc, nbk = (pc < 4) ? 3 - pc : 135 - pc;
            const bf16* Sf = ST + ((size_t)seq0 * NCH + nf) * 8192; const bf16* Sb = ST + ((size_t)(seq0 + 1) * NCH + nbk) * 8192;
            const int r = r0 + ct * 16 + l15;
            bf16x8 a2[4][2], a3[4][2]; u32x2 gv[4];
#pragma unroll
            for (int et = 0; et < 4; ++et) { const int e = (eh * 4 + et) * 16 + l15;
#pragma unroll
                for (int ks = 0; ks < 2; ++ks) { a2[et][ks] = *(const bf16x8*)(Sf + e * 64 + ks * 32 + quad * 8); a3[et][ks] = *(const bf16x8*)(Sb + e * 64 + ks * 32 + quad * 8); }
                gv[et] = *(const u32x2*)(P + (size_t)r * NPROJ + gcol + (eh * 4 + et) * 16 + quad * 4); }
            { bf16x8 af[2], ab[2];
#pragma unroll
              for (int ks = 0; ks < 2; ++ks) { af[ks] = *(const bf16x8*)(qdf + (ct * 16 + l15) * 72 + ks * 32 + quad * 8); ab[ks] = *(const bf16x8*)(qdb + (ct * 16 + l15) * 72 + ks * 32 + quad * 8); }
#pragma unroll
              for (int i = 0; i < 2; ++i) { const int st = (wave >> 2) * 2 + i;
                  pg8::f32x4 accf = {0.f, 0.f, 0.f, 0.f}, accb = {0.f, 0.f, 0.f, 0.f};
#pragma unroll
                  for (int ks = 0; ks < 2; ++ks) {
                      const bf16x8 bf_ = *(const bf16x8*)(kif + (st * 16 + l15) * 72 + ks * 32 + quad * 8), bb_ = *(const bf16x8*)(kib + (st * 16 + l15) * 72 + ks * 32 + quad * 8);
                      accf = MFMA16(af[ks], bf_, accf); accb = MFMA16(ab[ks], bb_, accb); }
                  const int scol = st * 16 + l15;
#pragma unroll
                  for (int rg = 0; rg < 4; ++rg) { const int c = ct * 16 + quad * 4 + rg; Am[c * 72 + scol] = (bf16)f2bf(scol <= c ? accf[rg] : accb[rg]); }
              }
            }
            if (unit + G < NU) P5_LOAD(unit + G);
            __syncthreads();
            { bf16x8 bA[2], bQf[2], bQb[2];
#pragma unroll
              for (int ks = 0; ks < 2; ++ks) { const int o = (ct * 16 + l15) * 72 + ks * 32 + quad * 8; bA[ks] = *(const bf16x8*)(Am + o); bQf[ks] = *(const bf16x8*)(qdf + o); bQb[ks] = *(const bf16x8*)(qdb + o); }
              pg8::f32x4 acc[4]; float ss = 0.f;
#pragma unroll
              for (int et = 0; et < 4; ++et) { const int e = (eh * 4 + et) * 16 + l15;
                  pg8::f32x4 c4 = {0.f, 0.f, 0.f, 0.f};
#pragma unroll
                  for (int ks = 0; ks < 2; ++ks) {
                      const bf16x8 a1 = *(const bf16x8*)(vT + e * 72 + ks * 32 + quad * 8);
                      c4 = MFMA16(a1, bA[ks], c4); c4 = MFMA16(a2[et][ks], bQf[ks], c4); c4 = MFMA16(a3[et][ks], bQb[ks], c4); }
                  acc[et] = c4; ss += (c4[0] * c4[0] + c4[1] * c4[1]) + (c4[2] * c4[2] + c4[3] * c4[3]); }
              ss = quad_sum(ss);
              if (quad == 0) red[eh * 64 + ct * 16 + l15] = ss;
              __syncthreads();
              const float tot = red[ct * 16 + l15] + red[64 + ct * 16 + l15];
              const float rinv = 1.f / sqrtf(tot * (1.f / 128.f) + 1e-6f);
#pragma unroll
              for (int et = 0; et < 4; ++et) { const int e0 = (eh * 4 + et) * 16 + quad * 4;
                  float gt[4] = {bflo(gv[et].x), bfhi(gv[et].x), bflo(gv[et].y), bfhi(gv[et].y)}; float y[4];
#pragma unroll
                  for (int i = 0; i < 4; ++i) { const float ng = g ? ngv[et][i] : 1.f; const float sg = gt[i] * __builtin_amdgcn_rcpf(1.f + __expf(-gt[i])); y[i] = sg * acc[et][i] * rinv * ng; }
                  u32x2 o; o.x = pk2(y[0], y[1]); o.y = pk2(y[2], y[3]);
                  *(u32x2*)(H + (size_t)r * D + g * 512 + h * 128 + e0) = o; }
            }
            __syncthreads();
        }
#undef P5_LOAD
        if ((NU - bid + G - 1) / G < (NU + G - 1) / G) DRAIN_LATE((float*)(lds + wave * 8448), 2);
    }
#endif
PROBE_END(5)
    xcd_barrier(xbar);

PROBE_BEGIN(12)
    { pg8::Gemm g{H, WOUT0_T, R, D, D}; LatOrder S; S.init(D, G, bid); EpiResid<0, false> E{xin, ctx, VLAT, VCTX, nullptr, mod + 2 * 1024, nullptr, nullptr, nullptr};
      pg8::gemm_phase<EpiResid<0, false>, LatOrder, true, true>(ldsg, g, S, E); }
    { IDS
      ctx_resid_tiles<false>(H, WOUT0_T, D, ctx, VCTX, mod + 2 * 6144 + 2 * 1024, nullptr, nullptr, nullptr, (float*)lds, bid, G, tid, wave, l15, quad); }
PROBE_END(12)
    xcd_barrier(xbar);
PROBE_BEGIN(7)
    { IDS
    DRAIN_LATE((float*)(lds + wave * 8448), 1 << 30);
    ln_phase<false, false>(RST(0), VLAT, VCTX, nullptr, nullptr, ln_g, ln_b, mod + 3 * 1024, H, gw, NGW, lane);
    }
PROBE_END(7)
    xcd_barrier(xbar);
PROBE_BEGIN(11)
    { pg8::Gemm g{H, W1_0_T, R, FF, D}; LatOrder S; S.init(FF, G, bid); EpiStore<1> E{P, FF, FF};
      pg8::gemm_phase<EpiStore<1>, LatOrder, true, true>(ldsg, g, S, E); }
    { IDS
      ctx_ksplit_tiles<1>(H, W1_0_T, P, FF, 64, FF, (float*)lds, bid, G, tid, wave, l15, quad); }
PROBE_END(11)
    xcd_barrier(xbar);
PROBE_BEGIN(9)
    { pg8::Gemm g{P, W2_0_T, R, D, FF}; LatOrder S; S.init(D, G, bid); EpiResid<1, false> E{VLAT, VCTX, VLAT, VCTX, nullptr, mod + 5 * 1024, RST(0), ln_g, ln_b};
      pg8::gemm_phase<EpiResid<1, false>, LatOrder, true, true>(ldsg, g, S, E); }
    { IDS
      ctx_resid_tiles<true>(P, W2_0_T, FF, VCTX, VCTX, mod + 2 * 6144 + 5 * 1024, RST(0), ln_g, ln_b, (float*)lds, bid, G, tid, wave, l15, quad); }
PROBE_END(9)
    xcd_barrier(xbar);
    { IDS
    ln_phase<false, false>(RST(1), VLAT, VCTX, nullptr, nullptr, ln_g + 1024, ln_b + 1024, mod + 3 * 6144, H, gw, NGW, lane);
    }
    xcd_barrier(xbar);

PROBE_BEGIN(13)
    { pg8::Gemm g{H, WQKV_T, R, NQKV, D}; pg8::StaticOrder S; S.init(R, NQKV, G, bid); EpiStore<0> E{P, NQKV, NQKV};
      pg8::gemm_phase<EpiStore<0>, pg8::StaticOrder, true, true>(ldsg, g, S, E); }
PROBE_END(13)
    xcd_barrier(xbar);

PROBE_BEGIN(6)
#ifndef NO_P12
    { IDS
        bf16* Qs = (bf16*)lds; bf16* Ks = (bf16*)(lds + 73728); bf16* Vt = (bf16*)(lds + 82944); float* ropes = (float*)(lds + 92160);
        for (int i = tid; i < 1024; i += 512) ((f32x4*)ropes)[i] = ((const f32x4*)rope)[i];
        PACC_DECL
        for (int unit = bid; unit < NB * 4 * 64; unit += G) {
            PACC_BEGIN(40)
            const int nb = unit & 63, kvh = (unit >> 6) & 3, b = unit >> 8;
#define ATT_VALID(t) ((t) < 4 || (unsigned)(nb - 1 + (((t) - 4) >> 1)) < 64u)
#define ATT_KPOS(t) ((nb - 1 + (((t) - 4) >> 1)) * 128 + (((t) - 4) & 1) * 64)
#define ATT_KROW(t) ((t) < 4 ? b * TP + (t) * 64 : b * TP + L + ATT_KPOS(t))
            const int keyk = tid >> 2, pck = tid & 3, c1k = (pck & 1) + (pck >> 1) * 4, keyv = tid & 63, dcv = tid >> 6;
            u32x4 pk1 = {0u, 0u, 0u, 0u}, pk2_ = pk1, pvv = pk1;
#define ATT_LOAD(t) do { const int kr_ = ATT_KROW(t); \
                if (tid < 256) { const bf16* src_ = P + (size_t)(kr_ + keyk) * NQKV + 1024 + kvh * 64; pk1 = *(const u32x4*)(src_ + c1k * 8); pk2_ = *(const u32x4*)(src_ + (c1k + 2) * 8); } \
                pvv = *(const u32x4*)(P + (size_t)(kr_ + keyv) * NQKV + 1280 + kvh * 64 + dcv * 8); } while (0)
            ATT_LOAD(0);
            __syncthreads();
#pragma unroll
            for (int i = 0; i < 4; ++i) {
                const int it = tid + i * 512, pcq = it & 3, row = it >> 2, g = row >> 7, qi = row & 127, pos = nb * 128 + qi;
                const bf16* src = P + (size_t)(b * TP + L + pos) * NQKV + (kvh * 4 + g) * 64;
                const int c1 = (pcq & 1) + (pcq >> 1) * 4;
                const u32x4 u1 = *(const u32x4*)(src + c1 * 8), u2 = *(const u32x4*)(src + (c1 + 2) * 8);
                const int pv = (pcq < 2) ? (pos >> 6) : (pos & 63);
                const f32x4* tab = (const f32x4*)(ropes + (pv * 16 + (c1 & 1) * 8) * 2);
                u32x4 o1, o2;
#pragma unroll
                for (int j2 = 0; j2 < 4; ++j2) { const f32x4 cs = tab[j2];
                    const float a0 = bflo(u1[j2]), a1 = bfhi(u1[j2]), b0 = bflo(u2[j2]), b1 = bfhi(u2[j2]);
                    o1[j2] = pk2((a0 * cs.x - b0 * cs.y) * QSC, (a1 * cs.z - b1 * cs.w) * QSC); o2[j2] = pk2((a0 * cs.y + b0 * cs.x) * QSC, (a1 * cs.w + b1 * cs.z) * QSC); }
                *(u32x4*)(Qs + row * 72 + c1 * 8) = o1; *(u32x4*)(Qs + row * 72 + (c1 + 2) * 8) = o2;
            }
            const int g = wave & 3, qh = wave >> 2, qrow0 = g * 128 + qh * 64, qpos0 = nb * 128 + qh * 64;
            float mrun[4], lrun[4]; pg8::f32x4 O[4][4];
            const float sk = sink[kvh * 4 + g] * 1.4426950408889634f;
#pragma unroll
            for (int qt = 0; qt < 4; ++qt) { mrun[qt] = sk; lrun[qt] = (quad == 0) ? 1.f : 0.f;
#pragma unroll
                for (int dt = 0; dt < 4; ++dt) O[dt][qt] = (pg8::f32x4){0.f, 0.f, 0.f, 0.f}; }
            PACC_END(40)
            int ti = 0;
            while (ti < 10) {
                PACC_BEGIN(41)
                const bool local = ti >= 4;
                const int kpos0 = local ? ATT_KPOS(ti) : 0;
                const int side = local ? ((ti - 4) >> 1) - 1 : 0;
                __syncthreads();
                if (tid < 256) {
                    u32x4 o1 = pk1, o2 = pk2_;
                    if (local) {
                        const int pos = kpos0 + keyk, pv = (pck < 2) ? (pos >> 6) : (pos & 63);
                        const f32x4* tab = (const f32x4*)(ropes + (pv * 16 + (c1k & 1) * 8) * 2);
#pragma unroll
                        for (int j2 = 0; j2 < 4; ++j2) { const f32x4 cs = tab[j2];
                            const float a0 = bflo(pk1[j2]), a1 = bfhi(pk1[j2]), b0 = bflo(pk2_[j2]), b1 = bfhi(pk2_[j2]);
                            o1[j2] = pk2(a0 * cs.x - b0 * cs.y, a1 * cs.z - b1 * cs.w); o2[j2] = pk2(a0 * cs.y + b0 * cs.x, a1 * cs.w + b1 * cs.z); }
                    }
                    *(u32x4*)(Ks + keyk * 72 + c1k * 8) = o1; *(u32x4*)(Ks + keyk * 72 + (c1k + 2) * 8) = o2;
                }
#pragma unroll
                for (int j = 0; j < 8; ++j) { const unsigned u = pvv[j >> 1]; Vt[(dcv * 8 + j) * 72 + keyv] = (bf16)((j & 1) ? (u >> 16) : (u & 0xffffu)); }
                __syncthreads();
                PACC_END(41)
                PACC_BEGIN(42)
                int tn = ti + 1;
                while (tn < 10 && !ATT_VALID(tn)) ++tn;
                if (tn < 10) ATT_LOAD(tn);
                if (!((side < 0 && ((ti - 4) & 1) == 0 && qh == 1) || (side > 0 && ((ti - 4) & 1) == 1 && qh == 0))) {
                bf16x8 kfr[4][2];
#pragma unroll
                for (int kt = 0; kt < 4; ++kt)
#pragma unroll
                    for (int ks = 0; ks < 2; ++ks) kfr[kt][ks] = *(const bf16x8*)(Ks + (kt * 16 + l15) * 72 + ks * 32 + quad * 8);
#pragma unroll
                for (int qt = 0; qt < 4; ++qt) {
                    pg8::f32x4 S[4];
#pragma unroll
                    for (int kt = 0; kt < 4; ++kt) S[kt] = (pg8::f32x4){0.f, 0.f, 0.f, 0.f};
#pragma unroll
                    for (int ks = 0; ks < 2; ++ks) { const bf16x8 qf = *(const bf16x8*)(Qs + (qrow0 + qt * 16 + l15) * 72 + ks * 32 + quad * 8);
#pragma unroll
                        for (int kt = 0; kt < 4; ++kt) S[kt] = MFMA16(kfr[kt][ks], qf, S[kt]); }
                    float mx = -INFINITY;
                    if (side < 0 && ((ti - 4) & 1) == qh) {
                        const int tl = quad * 4 - (qpos0 + qt * 16 + l15 - kpos0 - 128);
#pragma unroll
                        for (int kt = 0; kt < 4; ++kt)
#pragma unroll
                            for (int rg = 0; rg < 4; ++rg) { const float sv_ = (tl >= -(kt * 16 + rg)) ? S[kt][rg] : -INFINITY; S[kt][rg] = sv_; mx = fmaxf(mx, sv_); }
                    } else if (side > 0 && ((ti - 4) & 1) == qh) {
                        const int th = (qpos0 + qt * 16 + l15 - kpos0 + 128) - quad * 4;
#pragma unroll
                        for (int kt = 0; kt < 4; ++kt)
#pragma unroll
                            for (int rg = 0; rg < 4; ++rg) { const float sv_ = (th >= (kt * 16 + rg)) ? S[kt][rg] : -INFINITY; S[kt][rg] = sv_; mx = fmaxf(mx, sv_); }
                    } else {
#pragma unroll
                        for (int kt = 0; kt < 4; ++kt)
#pragma unroll
                            for (int rg = 0; rg < 4; ++rg) mx = fmaxf(mx, S[kt][rg]);
                    }
                    mx = quad_max(mx);
                    const float mnew = fmaxf(mrun[qt], mx), al = __builtin_amdgcn_exp2f(mrun[qt] - mnew); mrun[qt] = mnew;
                    float ps = 0.f;
#pragma unroll
                    for (int kt = 0; kt < 4; ++kt)
#pragma unroll
                        for (int rg = 0; rg < 4; ++rg) { const float p = __builtin_amdgcn_exp2f(S[kt][rg] - mnew); S[kt][rg] = p; ps += p; }
                    lrun[qt] = lrun[qt] * al + ps;
#pragma unroll
                    for (int dt = 0; dt < 4; ++dt) O[dt][qt] = O[dt][qt] * al;
#pragma unroll
                    for (int s2 = 0; s2 < 2; ++s2) {
                        u32x4 pw; pw.x = pk2(S[2 * s2][0], S[2 * s2][1]); pw.y = pk2(S[2 * s2][2], S[2 * s2][3]);
                        pw.z = pk2(S[2 * s2 + 1][0], S[2 * s2 + 1][1]); pw.w = pk2(S[2 * s2 + 1][2], S[2 * s2 + 1][3]);
                        const bf16x8 pf = __builtin_bit_cast(bf16x8, pw);
#pragma unroll
                        for (int dt = 0; dt < 4; ++dt) {
                            const s16x4 lo = *(const s16x4*)(Vt + (dt * 16 + l15) * 72 + s2 * 32 + quad * 4), hi = *(const s16x4*)(Vt + (dt * 16 + l15) * 72 + s2 * 32 + 16 + quad * 4);
                            O[dt][qt] = MFMA16(__builtin_shufflevector(lo, hi, 0, 1, 2, 3, 4, 5, 6, 7), pf, O[dt][qt]); }
                    }
                }
                }
                ti = tn;
                PACC_END(42)
            }
            PACC_BEGIN(43)
#pragma unroll
            for (int qt = 0; qt < 4; ++qt) {
                const float lt = quad_sum(lrun[qt]);
                const float inv = 1.f / lt;
                const int r = b * TP + L + qpos0 + qt * 16 + l15;
#pragma unroll
                for (int dt = 0; dt < 4; ++dt) { u32x2 o; o.x = pk2(O[dt][qt][0] * inv, O[dt][qt][1] * inv); o.y = pk2(O[dt][qt][2] * inv, O[dt][qt][3] * inv);
                    *(u32x2*)(H + (size_t)r * D + (kvh * 4 + g) * 64 + dt * 16 + quad * 4) = o; }
            }
            PACC_END(43)
#undef ATT_VALID
#undef ATT_KPOS
#undef ATT_KROW
#undef ATT_LOAD
        }
        PACC_SLEEP()
    }
#endif
PROBE_END(6)
    xcd_barrier(xbar);

PROBE_BEGIN(14)
    { pg8::Gemm g{H, WOUT1_T, R, D, D}; LatOrder S; S.init(D, G, bid); EpiResid<1, false> E{VLAT, VCTX, VLAT, VCTX, nullptr, mod + 3 * 6144 + 2 * 1024, RST(1), ln_g + 1024, ln_b + 1024};
      pg8::gemm_phase<EpiResid<1, false>, LatOrder, true, true>(ldsg, g, S, E); }
PROBE_END(14)
    xcd_barrier(xbar);
    { IDS
    ln_phase<false, true>(RST(2), VLAT, VCTX, nullptr, nullptr, ln_g + 2048, ln_b + 2048, mod + 3 * 6144 + 3 * 1024, H, gw, NGW, lane);
    }
    xcd_barrier(xbar);
PROBE_BEGIN(15)
    { pg8::Gemm g{H, W1_1_T, R, FF, D}; LatOrder S; S.init(FF, G, bid); EpiStore<1> E{P, FF, FF};
      pg8::gemm_phase<EpiStore<1>, LatOrder, true, true>(ldsg, g, S, E); }
PROBE_END(15)
    xcd_barrier(xbar);
PROBE_BEGIN(16)
    { pg8::Gemm g{P, W2_1_T, R, D, FF}; LatOrder S; S.init(D, G, bid); EpiResid<1, true> E{VLAT, VCTX, nullptr, nullptr, H, mod + 3 * 6144 + 5 * 1024, RST(2), ln_g + 2048, ln_b + 2048};
      pg8::gemm_phase<EpiResid<1, true>, LatOrder, true, true>(ldsg, g, S, E); }
PROBE_END(16)
    xcd_barrier(xbar);
    { IDS
    ln_phase<true, true>(nullptr, nullptr, nullptr, H, a.out, ln_g + 3072, ln_b + 3072, mod, H, gw, NGW, lane);
    }
}

extern "C" void kernel_launch(void* const* d_in, const int* in_sizes, int n_in, void* d_out, int out_size, void* d_ws, size_t ws_size, hipStream_t stream) {
    static int grid = 0;
    if (grid == 0) {
        if (n_in != 19 || out_size != NB * T * D || ws_size < WS_TOTAL) { fprintf(stderr, "kernel_launch: unexpected shapes (n_in %d out %d ws %zu)\n", n_in, out_size, ws_size); grid = -1; return; }
        int dev = 0, cus = 0, per_cu = 0;
        hipGetDevice(&dev); hipDeviceGetAttribute(&cus, hipDeviceAttributeMultiprocessorCount, dev);
        if (hipFuncSetAttribute((const void*)fwd_kernel, hipFuncAttributeMaxDynamicSharedMemorySize, LDS_BYTES) != hipSuccess) { fprintf(stderr, "kernel_launch: hipFuncSetAttribute failed\n"); grid = -1; return; }
        if (hipOccupancyMaxActiveBlocksPerMultiprocessor(&per_cu, (const void*)fwd_kernel, 512, LDS_BYTES) != hipSuccess || per_cu < 1) per_cu = 1;
        (void)hipGetLastError();
        grid = cus > 0 ? cus : 256;
    }
    if (grid < 0) return;
    Args a{};
    for (int i = 0; i < 19; ++i) a.in[i] = (const float*)d_in[i];
    a.out = (float*)d_out; a.ws = (unsigned char*)d_ws;
    if (hipMemsetAsync((char*)d_ws + OFF_XBAR, 0, 16384, stream) != hipSuccess) { fprintf(stderr, "kernel_launch: hipMemsetAsync of the barrier words failed\n"); return; }
    void* args[] = {&a};
    hipError_t e = hipLaunchCooperativeKernel((const void*)fwd_kernel, dim3(grid), dim3(512), args, LDS_BYTES, stream);
    if (e != hipSuccess) fprintf(stderr, "cooperative launch failed: %s (grid %d)\n", hipGetErrorString(e), grid);
}
```

```cpp
#include <hip/hip_runtime.h>
#include <hip/hip_cooperative_groups.h>
#include <cstdio>
#include <cstdint>
namespace cg = cooperative_groups;
namespace pg8 {
#define PG8_LAS __attribute__((address_space(3)))
typedef unsigned short bf16_t;
typedef short bf16x8 __attribute__((ext_vector_type(8)));
typedef float f32x4 __attribute__((ext_vector_type(4)));
typedef unsigned u32x4 __attribute__((ext_vector_type(4)));
constexpr int BM = 256, BK = 64, HALF = 128, HTB = HALF * BK * 2  , STAGE_BYTES = 8 * HTB, NXCD = 8, WGM = 8;

__host__ __device__ __forceinline__ int lds_byte(int r, int c) { const int st = (r >> 4) * 2 + (c >> 5), rr = r & 15, cc = c & 31, ob = rr * 64 + cc * 2; return st * 1024 + (ob ^ (((ob >> 9) & 1) << 5)); }
__host__ __device__ __forceinline__ void stage_rc(int b, int& R, int& C) { const int st = b / 1024, sb = b % 1024, swz = sb ^ (((sb >> 9) & 1) << 5); R = (st >> 1) * 16 + swz / 64; C = (st & 1) * 32 + (swz % 64) / 2; }
__host__ __device__ __forceinline__ int perm32(int rho) { const int n = rho >> 4, i = rho & 15; return 8 * (i >> 2) + 4 * n + (i & 3); }

struct Unit { int pm, pn; };
struct Gemm { const bf16_t* A; const bf16_t* Bt; int M, N, K; };

struct StaticOrder {
    int nM, nN, nwg, G, c;
    __host__ __device__ void init(int M, int N, int G_, int c_) { nM = M / BM; nN = N / BM; nwg = nM * nN; G = G_; c = c_; }
    __host__ __device__ bool next(int i, Unit& u) const {
        const long L = (long)i * G + c; if (L >= nwg) return false;
        int wgid = (int)L; { const int q = nwg / NXCD, r = nwg % NXCD, xcd = wgid % NXCD, off = wgid / NXCD; wgid = (xcd < r ? xcd * (q + 1) : r * (q + 1) + (xcd - r) * q) + off; }
        const int nig = WGM * nN, gid = wgid / nig, fm = gid * WGM, gsz = (nM - fm) < WGM ? (nM - fm) : WGM;
        u.pm = fm + ((wgid % nig) % gsz); u.pn = (wgid % nig) / gsz; return true;
    }
    __device__ __forceinline__ void a_ready(const Unit&) const {}
    __device__ __forceinline__ void done(const Unit&) const {}
};

__device__ __forceinline__ unsigned cvt_pk_bf16(float lo, float hi) { unsigned r; asm volatile("v_cvt_pk_bf16_f32 %0, %1, %2" : "=v"(r) : "v"(lo), "v"(hi)); return r; }

template <class Epi, class Sched, bool ALIGN_EPI = false, bool SP2 = false>
__device__ __forceinline__ void gemm_phase(PG8_LAS unsigned char* lds, const Gemm g, const Sched& S, const Epi& E) {
    int tid = threadIdx.x; asm volatile("" : "+v"(tid));
    const int wid = __builtin_amdgcn_readfirstlane(tid >> 6), lane = tid & 63, wr = wid >> 2, wc = wid & 3, fr = lane & 15, fq = lane >> 4;
    const int K = g.K, nt = K / BK;
    unsigned voffA[2], voffB[2];
#pragma unroll
    for (int i = 0; i < 2; ++i) { int R, C; stage_rc(tid * 16 + i * 8192, R, C); const int Rb = Epi::PERM ? ((R & ~31) + perm32(R & 31)) : R;
        voffA[i] = (unsigned)(R * K + C) * 2u; voffB[i] = (unsigned)(Rb * K + C) * 2u; }
    const size_t kstep = (size_t)(BK * 2);
    const size_t hstep = (size_t)HALF * K * 2;
    const size_t tstep = 2 * hstep;
    const unsigned ldsw = (unsigned)wid * 1024u;
    const int aoff = lds_byte(wr * 64 + fr, fq * 8), boff = lds_byte(wc * 32 + fr, fq * 8);
#define PG8_SA(b, h) (((b) * 2 + (h)) * HTB)
#define PG8_SB(b, h) ((4 + (b) * 2 + (h)) * HTB)
#define PG8_STAGE(bufoff, gbase, voff) do { _Pragma("unroll") for (int _i = 0; _i < 2; ++_i) \
        __builtin_amdgcn_global_load_lds((const unsigned*)((const char*)(gbase) + (voff)[_i]), (PG8_LAS unsigned*)(lds + (bufoff) + ldsw + _i * 8192), 16, 0, 0); } while (0)
#define PG8_LDA(dst, b, h) do { _Pragma("unroll") for (int m = 0; m < 4; ++m) _Pragma("unroll") for (int k = 0; k < 2; ++k) dst[m][k] = *(const PG8_LAS bf16x8*)(lds + PG8_SA(b, h) + aoff + m * 2048 + k * 1024); } while (0)
#define PG8_LDB(dst, b, h) do { _Pragma("unroll") for (int n = 0; n < 2; ++n) _Pragma("unroll") for (int k = 0; k < 2; ++k) dst[n][k] = *(const PG8_LAS bf16x8*)(lds + PG8_SB(b, h) + boff + n * 2048 + k * 1024); } while (0)
#define PG8_MMA(ai, bj, At, Bt) do { __builtin_amdgcn_s_setprio(1); _Pragma("unroll") for (int m = 0; m < 4; ++m) _Pragma("unroll") for (int n = 0; n < 2; ++n) _Pragma("unroll") for (int k = 0; k < 2; ++k) \
        acc[ai][bj][m][n] = __builtin_amdgcn_mfma_f32_16x16x32_bf16(Bt[n][k], At[m][k], acc[ai][bj][m][n], 0, 0, 0); __builtin_amdgcn_s_setprio(0); } while (0)
#define PG8_WAIT_V(n) asm volatile("s_waitcnt vmcnt(" #n ")" ::: "memory")
#define PG8_WAIT_L(n) asm volatile("s_waitcnt lgkmcnt(" #n ")" ::: "memory")
#define PG8_BAR __builtin_amdgcn_s_barrier()
#define PG8_SCHED __builtin_amdgcn_sched_barrier(0)
    Unit cur, nxt; int ui = 0;
    if (!S.next(0, cur)) return;
    f32x4 acc[2][2][4][2];
#pragma unroll
    for (int a = 0; a < 2; ++a)
#pragma unroll
        for (int b = 0; b < 2; ++b)
#pragma unroll
            for (int m = 0; m < 4; ++m)
#pragma unroll
                for (int n = 0; n < 2; ++n) acc[a][b][m][n] = (f32x4){0.f, 0.f, 0.f, 0.f};
    bf16x8 At[4][2], B0[2][2], B1[2][2];
    const char* cA = (const char*)g.A + (size_t)cur.pm * tstep; const char* cB = (const char*)g.Bt + (size_t)cur.pn * tstep;
    S.a_ready(cur);
    if constexpr (SP2) {
        PG8_STAGE(PG8_SB(0, 0), cB, voffB); PG8_STAGE(PG8_SB(0, 1), cB + hstep, voffB); PG8_STAGE(PG8_SA(0, 0), cA, voffA); PG8_STAGE(PG8_SA(0, 1), cA + hstep, voffA);
        if (wr == 1) PG8_BAR;
        PG8_WAIT_V(2); PG8_BAR;
        PG8_STAGE(PG8_SB(1, 0), cB + kstep, voffB); PG8_STAGE(PG8_SA(1, 0), cA + kstep, voffA); PG8_STAGE(PG8_SB(1, 1), cB + hstep + kstep, voffB);
        PG8_WAIT_V(6); PG8_BAR;
    } else {
        PG8_STAGE(PG8_SB(0, 0), cB, voffB); PG8_STAGE(PG8_SA(0, 0), cA, voffA); PG8_STAGE(PG8_SB(0, 1), cB + hstep, voffB); PG8_STAGE(PG8_SA(0, 1), cA + hstep, voffA);
        if (wr == 1) PG8_BAR;
        PG8_WAIT_V(4); PG8_BAR;
        PG8_STAGE(PG8_SB(1, 0), cB + kstep, voffB); PG8_STAGE(PG8_SA(1, 0), cA + kstep, voffA); PG8_STAGE(PG8_SB(1, 1), cB + hstep + kstep, voffB);
        PG8_WAIT_V(6); PG8_BAR;
    }
    for (;;) {
        const bool has_next = S.next(ui + 1, nxt);
        const char* nA = has_next ? (const char*)g.A + (size_t)nxt.pm * tstep : cA; const char* nB = has_next ? (const char*)g.Bt + (size_t)nxt.pn * tstep : cB;
        for (int t = 0; t < nt; t += 2) {
            const bool last = (t == nt - 2);
            const char* a1 = cA + (size_t)(t + 1) * kstep;
            const char* a2 = last ? nA : cA + (size_t)(t + 2) * kstep; const char* b2 = last ? nB : cB + (size_t)(t + 2) * kstep;
            const char* a3 = a2 + kstep; const char* b3 = b2 + kstep;
            if (last && has_next) S.a_ready(nxt);
            if constexpr (SP2) {
            PG8_LDB(B0, 0, 0); PG8_LDB(B1, 0, 1); PG8_SCHED; PG8_LDA(At, 0, 0); PG8_STAGE(PG8_SA(1, 1), a1 + hstep, voffA);
            PG8_WAIT_V(8); PG8_WAIT_L(0); PG8_BAR; PG8_MMA(0, 0, At, B0); PG8_MMA(0, 1, At, B1); PG8_BAR; PG8_SCHED;
            PG8_LDA(At, 0, 1); PG8_STAGE(PG8_SB(0, 0), b2, voffB); PG8_STAGE(PG8_SB(0, 1), b2 + hstep, voffB); PG8_STAGE(PG8_SA(0, 0), a2, voffA);
            PG8_WAIT_V(8); PG8_WAIT_L(0); PG8_BAR; PG8_MMA(1, 0, At, B0); PG8_MMA(1, 1, At, B1); PG8_BAR; PG8_SCHED;
            PG8_LDB(B0, 1, 0); PG8_LDB(B1, 1, 1); PG8_SCHED; PG8_LDA(At, 1, 0); PG8_STAGE(PG8_SA(0, 1), a2 + hstep, voffA);
            PG8_WAIT_V(8); PG8_WAIT_L(0); PG8_BAR; PG8_MMA(0, 0, At, B0); PG8_MMA(0, 1, At, B1); PG8_BAR; PG8_SCHED;
            PG8_LDA(At, 1, 1); PG8_STAGE(PG8_SB(1, 0), b3, voffB); PG8_STAGE(PG8_SB(1, 1), b3 + hstep, voffB); PG8_STAGE(PG8_SA(1, 0), a3, voffA);
            PG8_WAIT_V(8); PG8_WAIT_L(0); PG8_BAR; PG8_MMA(1, 0, At, B0); PG8_MMA(1, 1, At, B1); PG8_BAR; PG8_SCHED;
            } else {
            PG8_LDB(B0, 0, 0); PG8_SCHED; PG8_LDA(At, 0, 0); PG8_STAGE(PG8_SA(1, 1), a1 + hstep, voffA);
            PG8_WAIT_L(8); PG8_BAR; PG8_WAIT_L(0); PG8_MMA(0, 0, At, B0); PG8_BAR; PG8_SCHED;
            PG8_LDB(B1, 0, 1); PG8_STAGE(PG8_SB(0, 0), b2, voffB);
            PG8_BAR; PG8_WAIT_L(0); PG8_MMA(0, 1, At, B1); PG8_BAR;
            PG8_LDA(At, 0, 1); PG8_STAGE(PG8_SA(0, 0), a2, voffA);
            PG8_BAR; PG8_WAIT_L(0); PG8_MMA(1, 0, At, B0); PG8_BAR; PG8_SCHED;
            PG8_STAGE(PG8_SB(0, 1), b2 + hstep, voffB);
            PG8_WAIT_V(6); PG8_BAR; PG8_MMA(1, 1, At, B1); PG8_BAR;
            PG8_LDB(B0, 1, 0); PG8_SCHED; PG8_LDA(At, 1, 0); PG8_STAGE(PG8_SA(0, 1), a2 + hstep, voffA);
            PG8_WAIT_L(8); PG8_BAR; PG8_WAIT_L(0); PG8_MMA(0, 0, At, B0); PG8_BAR; PG8_SCHED;
            PG8_LDB(B1, 1, 1); PG8_STAGE(PG8_SB(1, 0), b3, voffB);
            PG8_BAR; PG8_WAIT_L(0); PG8_MMA(0, 1, At, B1); PG8_BAR;
            PG8_LDA(At, 1, 1); PG8_STAGE(PG8_SA(1, 0), a3, voffA);
            PG8_BAR; PG8_WAIT_L(0); PG8_MMA(1, 0, At, B0); PG8_BAR; PG8_SCHED;
            PG8_STAGE(PG8_SB(1, 1), b3 + hstep, voffB);
            PG8_WAIT_V(6); PG8_BAR; PG8_MMA(1, 1, At, B1); PG8_BAR;
            }
        }
        if constexpr (ALIGN_EPI) { if (wr == 0) PG8_BAR; }
        if constexpr (!Epi::AFTER_DRAIN) { E(acc, cur, wr, wc, fr, fq); S.done(cur); }
        if (!has_next) break;
#pragma unroll
        for (int a = 0; a < 2; ++a)
#pragma unroll
            for (int b = 0; b < 2; ++b)
#pragma unroll
                for (int m = 0; m < 4; ++m)
#pragma unroll
                    for (int n = 0; n < 2; ++n) acc[a][b][m][n] = (f32x4){0.f, 0.f, 0.f, 0.f};
        cur = nxt; cA = nA; cB = nB; ++ui;
        if constexpr (ALIGN_EPI) { if (wr == 1) PG8_BAR; }
    }
    PG8_WAIT_V(0);
    if constexpr (!ALIGN_EPI) { if (wr == 0) PG8_BAR; }
    PG8_BAR;
    if constexpr (Epi::AFTER_DRAIN) { E.fused(acc, cur, wr, wc, fr, fq, lds, wid, lane); S.done(cur); }
#undef PG8_SA
#undef PG8_SB
#undef PG8_STAGE
#undef PG8_LDA
#undef PG8_LDB
#undef PG8_MMA
#undef PG8_WAIT_V
#undef PG8_WAIT_L
#undef PG8_BAR
#undef PG8_SCHED
}
}

constexpr int NB = 2, T = 8192, L = 256, D = 1024, TP = T + L, R = NB * TP;
constexpr int FF = 4096, NPROJ = 3104, NPROJ_PAD = 3328, NQKV = 1536, NCH = TP / 64;
constexpr float ALPHA = 1.4142135623730951f;
constexpr int LDS_BYTES = 147456;

typedef unsigned short bf16;
typedef float f32x4 __attribute__((ext_vector_type(4)));
typedef short bf16x8 __attribute__((ext_vector_type(8)));
typedef short s16x4 __attribute__((ext_vector_type(4)));
typedef unsigned u32x4 __attribute__((ext_vector_type(4)));
typedef unsigned u32x2 __attribute__((ext_vector_type(2)));

constexpr size_t OFF_WIN = 0;
constexpr size_t OFF_WOUT0 = OFF_WIN + (size_t)NPROJ_PAD * D * 2;
constexpr size_t OFF_W1_0 = OFF_WOUT0 + (size_t)D * D * 2;
constexpr size_t OFF_W2_0 = OFF_W1_0 + (size_t)FF * D * 2;
constexpr size_t OFF_WQKV = OFF_W2_0 + (size_t)FF * D * 2;
constexpr size_t OFF_WOUT1 = OFF_WQKV + (size_t)NQKV * D * 2;
constexpr size_t OFF_W1_1 = OFF_WOUT1 + (size_t)D * D * 2;
constexpr size_t OFF_W2_1 = OFF_W1_1 + (size_t)FF * D * 2;
constexpr size_t OFF_MOD = OFF_W2_1 + (size_t)FF * D * 2;
constexpr size_t OFF_ROPE = OFF_MOD + 2 * 3 * 6144 * 4;
constexpr size_t OFF_BAR = OFF_ROPE + 128 * 16 * 8;
constexpr size_t OFF_XBAR = OFF_BAR + 256;
constexpr size_t OFF_RST = OFF_XBAR + 16384;
constexpr size_t OFF_XCTX = OFF_RST + (size_t)3 * R * 2 * 4;
constexpr size_t OFF_DEC = OFF_XCTX + (size_t)NB * L * D * 4;
constexpr size_t OFF_H = OFF_DEC + (size_t)32 * NCH * 64 * 4;
constexpr size_t OFF_P = OFF_H + (size_t)R * D * 2;
constexpr size_t OFF_ST = OFF_P + (size_t)R * NPROJ * 2;
constexpr size_t WS_TOTAL = OFF_ST + (size_t)32 * NCH * 8192 * 2;
static_assert(WS_TOTAL <= 268435456, "workspace map exceeds 256 MiB");
static_assert(OFF_P + (size_t)R * FF * 2 <= WS_TOTAL, "MLP hidden overlay");

typedef float f32x2_t __attribute__((ext_vector_type(2)));
typedef __bf16 bf16x2_t __attribute__((ext_vector_type(2)));
__device__ __forceinline__ unsigned pk2(float lo, float hi) { const f32x2_t v = {lo, hi}; const bf16x2_t b = __builtin_convertvector(v, bf16x2_t); return __builtin_bit_cast(unsigned, b); }
__device__ __forceinline__ unsigned f2bf(float f) { return pk2(f, f) & 0xffffu; }
__device__ __forceinline__ float bf2f(unsigned h) { return __uint_as_float(h << 16); }
__device__ __forceinline__ float bflo(unsigned u) { return __uint_as_float(u << 16); }
__device__ __forceinline__ float bfhi(unsigned u) { return __uint_as_float(u & 0xffff0000u); }
__device__ __forceinline__ float quad_max(float x) {
    const unsigned u = __float_as_uint(x);
    const auto r = __builtin_amdgcn_permlane32_swap(u, u, false, false);
    const float m = fmaxf(__uint_as_float(r[0]), __uint_as_float(r[1]));
    const unsigned v = __float_as_uint(m);
    const auto q = __builtin_amdgcn_permlane16_swap(v, v, false, false);
    return fmaxf(__uint_as_float(q[0]), __uint_as_float(q[1]));
}
__device__ __forceinline__ float quad_sum(float x) {
    const unsigned u = __float_as_uint(x);
    const auto r = __builtin_amdgcn_permlane32_swap(u, u, false, false);
    const float m = __uint_as_float(r[0]) + __uint_as_float(r[1]);
    const unsigned v = __float_as_uint(m);
    const auto q = __builtin_amdgcn_permlane16_swap(v, v, false, false);
    return __uint_as_float(q[0]) + __uint_as_float(q[1]);
}
__device__ __forceinline__ float dpp_add(float v, int ctrl_sel) {
    const int u = __float_as_int(v);
    const int t = ctrl_sel == 0 ? __builtin_amdgcn_update_dpp(0, u, 0xB1, 0xF, 0xF, true) : ctrl_sel == 1 ? __builtin_amdgcn_update_dpp(0, u, 0x4E, 0xF, 0xF, true)
                : ctrl_sel == 2 ? __builtin_amdgcn_update_dpp(0, u, 0x141, 0xF, 0xF, true) : __builtin_amdgcn_update_dpp(0, u, 0x140, 0xF, 0xF, true);
    return v + __int_as_float(t);
}
__device__ __forceinline__ float wave_sum(float v) { v = dpp_add(v, 0); v = dpp_add(v, 1); v = dpp_add(v, 2); v = dpp_add(v, 3); return quad_sum(v); }
#define MFMA16(a, b, c) __builtin_amdgcn_mfma_f32_16x16x32_bf16((a), (b), (c), 0, 0, 0)

__device__ __forceinline__ size_t row_off(int r, bool& isc, int& b) { b = (r >= TP) ? 1 : 0; const int p = r - b * TP; isc = p < L; return isc ? (size_t)(b * L + p) * D : (size_t)(b * T + p - L) * D; }

template <int ACT> struct EpiStore {
    static constexpr bool PERM = true, AFTER_DRAIN = false;
    bf16* O; int ldc; int ncols;
    __device__ __forceinline__ void operator()(const pg8::f32x4 (&acc)[2][2][4][2], const pg8::Unit& u, int wr, int wc, int fr, int fq) const {
        const int row0 = u.pm * 256 + wr * 64 + fr, col0 = u.pn * 256 + wc * 32 + 8 * fq;
#pragma unroll
        for (int ai = 0; ai < 2; ++ai)
#pragma unroll
            for (int m = 0; m < 4; ++m) {
                bf16* rowp = O + (size_t)(row0 + ai * 128 + m * 16) * ldc;
#pragma unroll
                for (int bj = 0; bj < 2; ++bj) {
                    const int col = col0 + bj * 128;
                    pg8::f32x4 v0 = acc[ai][bj][m][0], v1 = acc[ai][bj][m][1];
                    if (ACT == 1) {
#pragma unroll
                        for (int i = 0; i < 4; ++i) { float a = fmaxf(v0[i], 0.f), b = fmaxf(v1[i], 0.f); v0[i] = a * a; v1[i] = b * b; }
                    }
                    u32x4 w; w.x = pg8::cvt_pk_bf16(v0[0], v0[1]); w.y = pg8::cvt_pk_bf16(v0[2], v0[3]); w.z = pg8::cvt_pk_bf16(v1[0], v1[1]); w.w = pg8::cvt_pk_bf16(v1[2], v1[3]);
                    if (col < ncols) *(u32x4*)(rowp + col) = w;
                }
            }
    }
};
template <int SRC, bool DST_FIN> struct EpiResid {
    static constexpr bool PERM = true, AFTER_DRAIN = false;
    const void* src_lat; const void* src_ctx; bf16* dst_lat; bf16* dst_ctx; bf16* dst_fin; const float* gate;
    const float* rst; const float* lg; const float* lb;
    __device__ __forceinline__ void operator()(const pg8::f32x4 (&acc)[2][2][4][2], const pg8::Unit& u, int wr, int wc, int fr, int fq) const {
        const int b = u.pm > 33 ? 1 : 0, col0 = u.pn * 256 + wc * 32 + 8 * fq, rt0 = wr * 64 + fr;
        const size_t lat0 = (size_t)(u.pm * 256 - b * TP - L + b * T);
        const float* gt = gate + b * 6144;
#pragma unroll
        for (int bj = 0; bj < 2; ++bj) {
            const int col = col0 + bj * 128;
            const f32x4 g0 = *(const f32x4*)(gt + col), g1 = *(const f32x4*)(gt + col + 4);
            f32x4 l0, l1, m0, m1;
            if (SRC == 1) { l0 = *(const f32x4*)(lg + col); l1 = *(const f32x4*)(lg + col + 4); m0 = *(const f32x4*)(lb + col); m1 = *(const f32x4*)(lb + col + 4); }
#pragma unroll
            for (int ai = 0; ai < 2; ++ai)
#pragma unroll
                for (int m = 0; m < 4; ++m) {
                    const int rt = rt0 + ai * 128 + m * 16, row = u.pm * 256 + rt; const size_t off = (lat0 + rt) * D + col;
                    f32x4 x0, x1;
                    if (SRC == 0) { const float* sp = (const float*)src_lat + off; x0 = *(const f32x4*)sp; x1 = *(const f32x4*)(sp + 4); }
                    else { const float mean = rst[2 * row], rstd = rst[2 * row + 1];
                        const u32x4 w = *(const u32x4*)((const bf16*)src_lat + off);
                        x0 = (f32x4){bflo(w.x), bfhi(w.x), bflo(w.y), bfhi(w.y)}; x1 = (f32x4){bflo(w.z), bfhi(w.z), bflo(w.w), bfhi(w.w)};
                        x0 = (x0 - mean) * rstd * l0 + m0; x1 = (x1 - mean) * rstd * l1 + m1; }
                    const pg8::f32x4 a0 = acc[ai][bj][m][0], a1 = acc[ai][bj][m][1];
                    u32x4 o; o.x = pk2(ALPHA * x0.x + g0.x * a0[0], ALPHA * x0.y + g0.y * a0[1]); o.y = pk2(ALPHA * x0.z + g0.z * a0[2], ALPHA * x0.w + g0.w * a0[3]);
                    o.z = pk2(ALPHA * x1.x + g1.x * a1[0], ALPHA * x1.y + g1.y * a1[1]); o.w = pk2(ALPHA * x1.z + g1.z * a1[2], ALPHA * x1.w + g1.w * a1[3]);
                    bf16* dp = DST_FIN ? dst_fin + (size_t)row * D + col : dst_lat + off;
                    *(u32x4*)dp = o;
                }
        }
    }
};

__device__ __forceinline__ void transpose_item(const float* __restrict__ W, int K, int N, bf16* WT, float* scr, int item, int lane) {
    const int nblk = N / 32, kb = item / nblk, nb = item % nblk, k0 = 64 * kb, n0 = 32 * nb;
#pragma unroll 8
    for (int i = 0; i < 32; ++i) { const int kk = 2 * i + (lane >> 5); scr[kk * 33 + (lane & 31)] = W[(size_t)(k0 + kk) * N + n0 + (lane & 31)]; }
    asm volatile("s_waitcnt lgkmcnt(0)" ::: "memory");
    const int c = lane & 7;
#pragma unroll
    for (int j = 0; j < 4; ++j) { const int n = (lane >> 3) + 8 * j; const float* s = scr + (8 * c) * 33 + n;
        u32x4 o; o.x = pk2(s[0 * 33], s[1 * 33]); o.y = pk2(s[2 * 33], s[3 * 33]); o.z = pk2(s[4 * 33], s[5 * 33]); o.w = pk2(s[6 * 33], s[7 * 33]);
        *(u32x4*)(WT + (size_t)(n0 + n) * K + k0 + 8 * c) = o; }
    asm volatile("s_waitcnt lgkmcnt(0)" ::: "memory");
}

template <bool LAST, bool SKIPCTX>
__device__ __forceinline__ void ln_phase(float* rst, const bf16* vlat, const bf16* vctx, const bf16* vfin, float* outp, const float* __restrict__ g, const float* __restrict__ bt, const float* __restrict__ modn, bf16* H, int gw, int NGW, int lane) {
    int r = gw;
    if (SKIPCTX) { while (r < R) { const int p = r >= TP ? r - TP : r; if (p >= L) break; r += NGW; } }
    u32x4 vn[2];
    if (r < R) { bool isc; int b; const size_t off = row_off(r, isc, b); const bf16* xr = LAST ? vfin + (size_t)r * D : (isc ? vctx : vlat) + off;
#pragma unroll
        for (int j = 0; j < 2; ++j) vn[j] = *(const u32x4*)(xr + lane * 8 + 512 * j); }
    while (r < R) {
        bool isc; int b; const size_t off = row_off(r, isc, b);
        float v[16];
#pragma unroll
        for (int j = 0; j < 2; ++j)
#pragma unroll
            for (int i = 0; i < 4; ++i) { v[j * 8 + 2 * i] = bflo(vn[j][i]); v[j * 8 + 2 * i + 1] = bfhi(vn[j][i]); }
        int rn = r + NGW;
        if (SKIPCTX) { while (rn < R) { const int p = rn >= TP ? rn - TP : rn; if (p >= L) break; rn += NGW; } }
        if (rn < R) { bool isc2; int b2; const size_t off2 = row_off(rn, isc2, b2); const bf16* xr2 = LAST ? vfin + (size_t)rn * D : (isc2 ? vctx : vlat) + off2;
#pragma unroll
            for (int j = 0; j < 2; ++j) vn[j] = *(const u32x4*)(xr2 + lane * 8 + 512 * j); }
        float s = 0.f;
#pragma unroll
        for (int i = 0; i < 16; ++i) s += v[i];
        const float mean = wave_sum(s) * (1.f / D); float s2 = 0.f;
#pragma unroll
        for (int i = 0; i < 16; ++i) { v[i] -= mean; s2 += v[i] * v[i]; }
        const float rstd = 1.f / sqrtf(wave_sum(s2) * (1.f / D) + 1e-5f);
        const float* md = modn + (isc ? 2 : b) * 6144;
        if (!LAST && lane == 0) { rst[2 * r] = mean; rst[2 * r + 1] = rstd; }
#pragma unroll
        for (int j = 0; j < 2; ++j) {
            const int idx = lane * 8 + 512 * j;
            float y[8];
#pragma unroll
            for (int q = 0; q < 2; ++q) { const f32x4 gg = *(const f32x4*)(g + idx + 4 * q), bb = *(const f32x4*)(bt + idx + 4 * q);
#pragma unroll
                for (int i = 0; i < 4; ++i) y[q * 4 + i] = v[j * 8 + q * 4 + i] * rstd * gg[i] + bb[i]; }
            if (LAST) { *(f32x4*)(outp + off + idx) = (f32x4){y[0], y[1], y[2], y[3]}; *(f32x4*)(outp + off + idx + 4) = (f32x4){y[4], y[5], y[6], y[7]}; }
            else {
                float h[8];
#pragma unroll
                for (int q = 0; q < 2; ++q) { const f32x4 sh = *(const f32x4*)(md + idx + 4 * q), sc = *(const f32x4*)(md + 1024 + idx + 4 * q);
#pragma unroll
                    for (int i = 0; i < 4; ++i) h[q * 4 + i] = y[q * 4 + i] * (sc[i] + 1.f) + sh[i]; }
                u32x4 o; o.x = pk2(h[0], h[1]); o.y = pk2(h[2], h[3]); o.z = pk2(h[4], h[5]); o.w = pk2(h[6], h[7]);
                *(u32x4*)(H + (size_t)r * D + idx) = o;
            }
        }
        r = rn;
    }
}

__device__ __forceinline__ float log_sigmoid(float z) { return fminf(z, 0.f) - __logf(1.f + __expf(-fabsf(z))); }

constexpr int CS = 65;
constexpr float QSC = 0.125f * 1.4426950408889634f;
struct GatePre { u32x2 lr; f32x4 w; float bias; };
__device__ __forceinline__ GatePre gate_prefetch(int g, int h, const bf16* Pr, const float* gkw, const float* gkb, int tid) {
    GatePre p; p.lr = (u32x2){0u, 0u}; p.w = (f32x4){0.f, 0.f, 0.f, 0.f}; p.bias = 0.f;
    if (g) { const int c = tid >> 3, part = tid & 7;
        p.lr = *(const u32x2*)(Pr + (size_t)c * NPROJ + 3072 + part * 4);
        const int idx = tid * 4, dir = idx >> 10, r = (idx >> 6) & 15, d = idx & 63;
        p.w = *(const f32x4*)(gkw + (dir * 16 + r) * 256 + h * 64 + d);
        if (tid < 128) p.bias = gkb[(tid >> 6) * 256 + h * 64 + (tid & 63)]; }
    return p;
}
__device__ __forceinline__ void fill_cum3(float* cf, float* cb, float* lrs, float* wl, int g, int h, const GatePre& gp, const float* theta, int tid) {
    if (g == 0) {
        const float lgf = log1pf(-expf(theta[h])), lgb = log1pf(-expf(theta[4 + h]));
        for (int i = tid; i < 4096; i += 512) { const int c = i >> 6, d = i & 63; cf[c * CS + d] = (float)(c + 1) * lgf; cb[c * CS + d] = (float)(64 - c) * lgb; }
        __syncthreads();
        return;
    }
    { const int c = tid >> 3, part = tid & 7;
      float* lp = lrs + c * 33 + part * 4; lp[0] = bflo(gp.lr.x); lp[1] = bfhi(gp.lr.x); lp[2] = bflo(gp.lr.y); lp[3] = bfhi(gp.lr.y);
      *(f32x4*)(wl + tid * 4) = gp.w;
      if (tid < 128) wl[2048 + tid] = gp.bias; }
    __syncthreads();
    { const int c = tid >> 3, dg = tid & 7;
#pragma unroll
      for (int dir = 0; dir < 2; ++dir) {
          f32x4 za = *(const f32x4*)(wl + 2048 + dir * 64 + dg * 8), zb = *(const f32x4*)(wl + 2048 + dir * 64 + dg * 8 + 4);
#pragma unroll
          for (int r = 0; r < 16; ++r) { const float lv = lrs[c * 33 + dir * 16 + r];
              za += lv * *(const f32x4*)(wl + (dir * 16 + r) * 64 + dg * 8); zb += lv * *(const f32x4*)(wl + (dir * 16 + r) * 64 + dg * 8 + 4); }
          float* dst = (dir ? cb : cf) + c * CS + dg * 8;
#pragma unroll
          for (int j = 0; j < 4; ++j) { dst[j] = log_sigmoid(za[j]) * (1.f / 16.f); dst[4 + j] = log_sigmoid(zb[j]) * (1.f / 16.f); } } }
    __syncthreads();
    if (tid < 128) {
        const int dir = tid >> 6; float* arr = (dir ? cb : cf) + (tid & 63);
        float run = 0.f;
#pragma unroll
        for (int hh = 0; hh < 2; ++hh) {
            float v[32];
            const int base = dir ? (1 - hh) * 32 : hh * 32;
#pragma unroll
            for (int c = 0; c < 32; ++c) v[c] = arr[(base + c) * CS];
            if (dir == 0) {
#pragma unroll
                for (int c = 0; c < 32; ++c) { run += v[c]; arr[(base + c) * CS] = run; }
            } else {
#pragma unroll
                for (int c = 31; c >= 0; --c) { run += v[c]; arr[(base + c) * CS] = run; }
            }
        }
    }
    __syncthreads();
}

__device__ __forceinline__ void fast_bar(unsigned* ctr, unsigned& target) {
    asm volatile("s_waitcnt vmcnt(0)" ::: "memory");
    __syncthreads();
    target += gridDim.x;
    if (threadIdx.x == 0) {
        __builtin_amdgcn_fence(__ATOMIC_RELEASE, "agent");
        asm volatile("s_waitcnt vmcnt(0)" ::: "memory");
        __hip_atomic_fetch_add(ctr, 1u, __ATOMIC_RELAXED, __HIP_MEMORY_SCOPE_AGENT);
        while (__hip_atomic_load(ctr, __ATOMIC_RELAXED, __HIP_MEMORY_SCOPE_AGENT) < target) __builtin_amdgcn_s_sleep(1);
        __builtin_amdgcn_fence(__ATOMIC_ACQUIRE, "agent");
        asm volatile("s_waitcnt vmcnt(0)" ::: "memory");
    }
    __syncthreads();
}
#define RLX_AGENT __ATOMIC_RELAXED, __HIP_MEMORY_SCOPE_AGENT
#define XB_TMO      128
#define XB_XCNT(j)  (256  + 64 * (j))
#define XB_XSUB(j)  (1280 + 64 * (j))
#define XB_XGEN(j)  (2304 + 64 * (j))
#define XB_TOP      3328
#define XB_TOPGEN   3392
#define XCD_BAR_WORDS 3456
#define XB_SPIN_CAP (1u << 18)

__device__ __forceinline__ unsigned xb_ld(unsigned* p)              { return __hip_atomic_load(p, __ATOMIC_RELAXED, __HIP_MEMORY_SCOPE_AGENT); }
__device__ __forceinline__ unsigned xb_add(unsigned* p, unsigned v) { return __hip_atomic_fetch_add(p, v, __ATOMIC_RELAXED, __HIP_MEMORY_SCOPE_AGENT); }
__device__ __forceinline__ unsigned xb_xcc_id() { return (unsigned)__builtin_amdgcn_s_getreg((3 << 11) | 20) & 0xFu; }
#define XB_SPIN(cond, bar) do { unsigned _sp = 0; while (cond) { __builtin_amdgcn_s_sleep(1); \
    if ((++_sp & 255u) == 0u) { if (xb_ld(&(bar)[XB_TMO])) break; if (_sp > XB_SPIN_CAP) { atomicAdd(&(bar)[XB_TMO], 1u); break; } } } } while (0)

struct XcdBarrier {
    unsigned* bar; unsigned x;
    volatile unsigned* st;
};

__device__ __forceinline__ XcdBarrier xcd_barrier_post(unsigned* bar, volatile unsigned* st) {
    XcdBarrier b; b.bar = bar; b.x = xb_xcc_id(); b.st = st;
    if (threadIdx.x == 0) (void)xb_add(&bar[XB_XCNT(b.x)], 1u);
    return b;
}
__device__ __forceinline__ void xcd_barrier_complete(unsigned* bar, unsigned x, unsigned& nloc, unsigned& nx) {
    const unsigned G = gridDim.x * gridDim.y * gridDim.z;
    unsigned sum, cnt, mine, sp = 0u;
    for (;;) {
        sum = 0u; cnt = 0u; mine = 0u;
#pragma unroll
        for (unsigned j = 0; j < 16; ++j) { const unsigned c = xb_ld(&bar[XB_XCNT(j)]); sum += c; cnt += (c > 0u) ? 1u : 0u; mine = (j == x) ? c : mine; }
        if (sum == G) break;
        __builtin_amdgcn_s_sleep(1);
        if ((++sp & 255u) == 0u) { if (xb_ld(&bar[XB_TMO])) break; if (sp > XB_SPIN_CAP) { atomicAdd(&bar[XB_TMO], 1u); break; } }
    }
    nloc = mine > 0u ? mine : 1u; nx = cnt > 0u ? cnt : 1u;
}

__device__ __forceinline__ void xcd_barrier(const XcdBarrier& b) {
    asm volatile("s_waitcnt vmcnt(0)" ::: "memory");
    __syncthreads();
    if (threadIdx.x == 0) {
        unsigned* bar = b.bar;
        __builtin_amdgcn_s_waitcnt(0);
        unsigned nloc = b.st[0], nx = b.st[1];
        if (nloc == 0u) { xcd_barrier_complete(bar, b.x, nloc, nx); b.st[0] = nloc; b.st[1] = nx; }
        const unsigned old = xb_add(&bar[XB_XSUB(b.x)], 1u);
        const unsigned gen = old / nloc;
        if (old + 1u == (gen + 1u) * nloc) {
            __builtin_amdgcn_fence(__ATOMIC_RELEASE, "agent");
            asm volatile("s_waitcnt vmcnt(0)" ::: "memory");
            const unsigned og = xb_add(&bar[XB_TOP], 1u);
            const unsigned tg = og / nx;
            if (og + 1u == (tg + 1u) * nx) xb_add(&bar[XB_TOPGEN], 1u);
            else XB_SPIN(xb_ld(&bar[XB_TOPGEN]) == tg, bar);
            __builtin_amdgcn_fence(__ATOMIC_ACQUIRE, "agent");
            xb_add(&bar[XB_XGEN(b.x)], 1u);
            asm volatile("s_waitcnt vmcnt(0)" ::: "memory");
        } else {
            XB_SPIN(xb_ld(&bar[XB_XGEN(b.x)]) == gen, bar);
            __builtin_amdgcn_fence(__ATOMIC_ACQUIRE, "agent");
            asm volatile("s_waitcnt vmcnt(0)" ::: "memory");
        }
    }
    __syncthreads();
}

struct LatOrder {
    pg8::StaticOrder S;
    __device__ void init(int N, int G, int c) { S.init(NB * T, N, G, c); }
    __device__ bool next(int i, pg8::Unit& u) const { if (!S.next(i, u)) return false; u.pm = u.pm + 1 + (u.pm >= 32 ? 1 : 0); return true; }
    __device__ __forceinline__ void a_ready(const pg8::Unit&) const {}
    __device__ __forceinline__ void done(const pg8::Unit&) const {}
};
#ifndef PROBE_SEL
#define PROBE_SEL 0
#endif
#ifndef PROBE_MUL
#define PROBE_MUL 3
#endif
#define PACC_DECL unsigned long long pacc = 0, pacc_t0 = 0; (void)pacc; (void)pacc_t0;
#define PACC_BEGIN(k) if (PROBE_SEL == (k)) pacc_t0 = __builtin_amdgcn_s_memrealtime();
#define PACC_END(k) if (PROBE_SEL == (k)) pacc += __builtin_amdgcn_s_memrealtime() - pacc_t0;
#define PACC_SLEEP() if (PROBE_SEL >= 40 && PROBE_SEL < 60) { const unsigned long long t1 = __builtin_amdgcn_s_memrealtime(), dt = pacc * PROBE_MUL; while (__builtin_amdgcn_s_memrealtime() - t1 < dt) __builtin_amdgcn_s_sleep(8); }
#define PROBE_BEGIN(k) unsigned long long pt0_##k = 0; if (PROBE_SEL == (k)) pt0_##k = __builtin_amdgcn_s_memrealtime();
#define PROBE_END(k) if (PROBE_SEL == (k)) { const unsigned long long t1 = __builtin_amdgcn_s_memrealtime(), dt = (t1 - pt0_##k) * PROBE_MUL; while (__builtin_amdgcn_s_memrealtime() - t1 < dt) __builtin_amdgcn_s_sleep(8); }


template <int XT, int YT>
__device__ __forceinline__ void frag_gemm(pg8::f32x4 (&acc)[XT][YT], const bf16* X, int ldx, const bf16* Y, int ldy, int k0, int k1, int l15, int quad) {
#pragma unroll 4
    for (int k = k0; k < k1; k += 32) {
        bf16x8 xf[XT], yf[YT];
#pragma unroll
        for (int i = 0; i < XT; ++i) xf[i] = *(const bf16x8*)(X + (size_t)(i * 16 + l15) * ldx + k + quad * 8);
#pragma unroll
        for (int j = 0; j < YT; ++j) yf[j] = *(const bf16x8*)(Y + (size_t)(j * 16 + l15) * ldy + k + quad * 8);
#pragma unroll
        for (int i = 0; i < XT; ++i)
#pragma unroll
            for (int j = 0; j < YT; ++j) acc[i][j] = MFMA16(xf[i], yf[j], acc[i][j]);
    }
}
template <bool SRC_LN>
__device__ __forceinline__ void ctx_resid_tiles(const bf16* A, const bf16* Bt, int K, const void* src_ctx, bf16* dst_ctx, const float* gate_ctx, const float* rst, const float* lg, const float* lb, float* part, int bid, int G, int tid, int wave, int l15, int quad) {
    for (int t = bid; t < 256; t += G) {
        const int rt = t >> 5, c0 = (t & 31) * 32, b = rt >> 2, p0 = (rt & 3) * 64, r0 = b * TP + p0;
        pg8::f32x4 acc[4][2];
#pragma unroll
        for (int i = 0; i < 4; ++i)
#pragma unroll
            for (int j = 0; j < 2; ++j) acc[i][j] = (pg8::f32x4){0.f, 0.f, 0.f, 0.f};
        const int ksl = K >> 3;
        frag_gemm<4, 2>(acc, A + (size_t)r0 * K, K, Bt + (size_t)c0 * K, K, wave * ksl, (wave + 1) * ksl, l15, quad);
        float* pw = part + wave * 2048;
#pragma unroll
        for (int i = 0; i < 4; ++i)
#pragma unroll
            for (int j = 0; j < 2; ++j)
#pragma unroll
                for (int rg = 0; rg < 4; ++rg) pw[(i * 16 + quad * 4 + rg) * 32 + j * 16 + l15] = acc[i][j][rg];
        __syncthreads();
        { const int row = tid >> 3, c4 = (tid & 7) * 4;
          f32x4 sum = *(const f32x4*)(part + row * 32 + c4);
#pragma unroll
          for (int w = 1; w < 8; ++w) sum += *(const f32x4*)(part + w * 2048 + row * 32 + c4);
          const size_t off = (size_t)(b * L + p0 + row) * D + c0 + c4;
          f32x4 x4; const f32x4 g4 = *(const f32x4*)(gate_ctx + c0 + c4);
          if (!SRC_LN) x4 = *(const f32x4*)((const float*)src_ctx + off);
          else { const int rU = r0 + row; const u32x2 w = *(const u32x2*)((const bf16*)src_ctx + off); x4 = (f32x4){bflo(w.x), bfhi(w.x), bflo(w.y), bfhi(w.y)};
              x4 = (x4 - rst[2 * rU]) * rst[2 * rU + 1] * *(const f32x4*)(lg + c0 + c4) + *(const f32x4*)(lb + c0 + c4); }
          const f32x4 vv = x4 * ALPHA + g4 * sum; u32x2 o; o.x = pk2(vv.x, vv.y); o.y = pk2(vv.z, vv.w);
          *(u32x2*)(dst_ctx + off) = o; }
        __syncthreads();
    }
}
__device__ __forceinline__ void ctx_up_tiles(const bf16* A, const bf16* Bt, bf16* O, int bid, int G, int wave, int l15, int quad) {
    for (int t = bid; t < 256; t += G) {
        const int rt = t >> 5, c0 = (t & 31) * 128 + (wave & 3) * 32, b = rt >> 2, r0 = b * TP + (rt & 3) * 64 + (wave >> 2) * 32;
        pg8::f32x4 acc[2][2];
#pragma unroll
        for (int i = 0; i < 2; ++i)
#pragma unroll
            for (int j = 0; j < 2; ++j) acc[i][j] = (pg8::f32x4){0.f, 0.f, 0.f, 0.f};
        frag_gemm<2, 2>(acc, Bt + (size_t)c0 * D, D, A + (size_t)r0 * D, D, 0, D, l15, quad);
#pragma unroll
        for (int i = 0; i < 2; ++i)
#pragma unroll
            for (int j = 0; j < 2; ++j) { float v[4];
#pragma unroll
                for (int rg = 0; rg < 4; ++rg) { const float a_ = fmaxf(acc[i][j][rg], 0.f); v[rg] = a_ * a_; }
                u32x2 o; o.x = pk2(v[0], v[1]); o.y = pk2(v[2], v[3]);
                *(u32x2*)(O + (size_t)(r0 + j * 16 + l15) * FF + c0 + i * 16 + quad * 4) = o; }
    }
}

template <int ACT>
__device__ __forceinline__ void ctx_ksplit_tiles(const bf16* A, const bf16* Bt, bf16* O, int ldo, int ntn, int ncols, float* part, int bid, int G, int tid, int wave, int l15, int quad) {
    for (int t = bid; t < 8 * ntn; t += G) {
        const int rt = t / ntn, c0 = (t % ntn) * 64, b = rt >> 2, r0 = b * TP + (rt & 3) * 64;
        pg8::f32x4 acc[4][4];
#pragma unroll
        for (int i = 0; i < 4; ++i)
#pragma unroll
            for (int j = 0; j < 4; ++j) acc[i][j] = (pg8::f32x4){0.f, 0.f, 0.f, 0.f};
        frag_gemm<4, 4>(acc, A + (size_t)r0 * D, D, Bt + (size_t)c0 * D, D, wave * 128, (wave + 1) * 128, l15, quad);
        float* pw = part + wave * 4096;
#pragma unroll
        for (int i = 0; i < 4; ++i)
#pragma unroll
            for (int j = 0; j < 4; ++j)
#pragma unroll
                for (int rg = 0; rg < 4; ++rg) pw[(i * 16 + quad * 4 + rg) * 64 + j * 16 + l15] = acc[i][j][rg];
        __syncthreads();
        { const int row = tid >> 3, c8 = (tid & 7) * 8;
          f32x4 s0 = *(const f32x4*)(part + row * 64 + c8), s1 = *(const f32x4*)(part + row * 64 + c8 + 4);
#pragma unroll
          for (int w = 1; w < 8; ++w) { s0 += *(const f32x4*)(part + w * 4096 + row * 64 + c8); s1 += *(const f32x4*)(part + w * 4096 + row * 64 + c8 + 4); }
          if (ACT == 1) {
#pragma unroll
              for (int k = 0; k < 4; ++k) { float a_ = fmaxf(s0[k], 0.f), b_ = fmaxf(s1[k], 0.f); s0[k] = a_ * a_; s1[k] = b_ * b_; } }
          u32x4 o; o.x = pk2(s0.x, s0.y); o.y = pk2(s0.z, s0.w); o.z = pk2(s1.x, s1.y); o.w = pk2(s1.z, s1.w);
          const int col = c0 + c8;
          if (col < ncols) *(u32x4*)(O + (size_t)(r0 + row) * ldo + col) = o; }
        __syncthreads();
    }
}

struct Args { const float* in[19]; float* out; unsigned char* ws; };

__global__ void __launch_bounds__(512, 2) fwd_kernel(Args a) {
    extern __shared__ __attribute__((aligned(16))) unsigned char lds[];
    cg::grid_group grid = cg::this_grid();
    const int G = gridDim.x, bid = blockIdx.x, NGW = G * 8;
#define IDS int tid = threadIdx.x; asm volatile("" : "+v"(tid)); const int lane = tid & 63, wave = __builtin_amdgcn_readfirstlane(tid >> 6), quad = lane >> 4, l15 = lane & 15, gw = bid * 8 + wave; (void)quad; (void)l15; (void)gw; (void)lane;
#define xin (a.in[0])
#define cvec (a.in[1])
#define ctx (a.in[2])
#define cctx (a.in[3])
#define w_mod (a.in[4])
#define b_mod (a.in[5])
#define ln_g (a.in[6])
#define ln_b (a.in[7])
#define theta (a.in[11])
#define gkw (a.in[12])
#define gkb (a.in[13])
#define normg (a.in[14])
#define sink (a.in[17])
#define WIN_T ((bf16*)(a.ws + OFF_WIN))
#define WOUT0_T ((bf16*)(a.ws + OFF_WOUT0))
#define W1_0_T ((bf16*)(a.ws + OFF_W1_0))
#define W2_0_T ((bf16*)(a.ws + OFF_W2_0))
#define WQKV_T ((bf16*)(a.ws + OFF_WQKV))
#define WOUT1_T ((bf16*)(a.ws + OFF_WOUT1))
#define W1_1_T ((bf16*)(a.ws + OFF_W1_1))
#define W2_1_T ((bf16*)(a.ws + OFF_W2_1))
#define mod ((float*)(a.ws + OFF_MOD))
#define rope ((float*)(a.ws + OFF_ROPE))
#define xctx ((float*)(a.ws + OFF_XCTX))
#define DEC ((float*)(a.ws + OFF_DEC))
#define H ((bf16*)(a.ws + OFF_H))
#define P ((bf16*)(a.ws + OFF_P))
#define ST ((bf16*)(a.ws + OFF_ST))
#define xlat (a.out)
#define RST(i) ((float*)(a.ws + OFF_RST) + (size_t)(i) * R * 2)
#define VLAT ((bf16*)a.out)
#define VCTX ((bf16*)(a.ws + OFF_XCTX))

#define LATE_ITEMS 9472
#define LATE_CHUNK 16
#define DRAIN_LATE(scr_, maxc_) do { int nclaim_ = 0; unsigned* qc_ = (unsigned*)(a.ws + OFF_XBAR) + 3584; volatile unsigned* qw_ = (volatile unsigned*)(lds + 131072 + 1024); \
        for (;;) { if (nclaim_++ >= (maxc_)) break; if (tid == 0) qw_[0] = __hip_atomic_fetch_add(qc_, (unsigned)LATE_CHUNK, __ATOMIC_RELAXED, __HIP_MEMORY_SCOPE_AGENT);     \
            __syncthreads(); const int base_ = (int)__builtin_amdgcn_readfirstlane(qw_[0]); __syncthreads(); \
            if (base_ >= LATE_ITEMS) break; \
            for (int k_ = wave; k_ < LATE_CHUNK; k_ += 8) { int r_ = base_ + k_; if (r_ >= LATE_ITEMS) break; \
                if (r_ < 2048) { transpose_item(a.in[8], 1024, FF, W1_0_T, (scr_), r_, lane); continue; } r_ -= 2048; \
                if (r_ < 2048) { transpose_item(a.in[9], FF, 1024, W2_0_T, (scr_), r_, lane); continue; } r_ -= 2048; \
                if (r_ < 768) { transpose_item(a.in[16], 1024, NQKV, WQKV_T, (scr_), r_, lane); continue; } r_ -= 768; \
                if (r_ < 512) { transpose_item(a.in[18], 1024, 1024, WOUT1_T, (scr_), r_, lane); continue; } r_ -= 512; \
                if (r_ < 2048) { transpose_item(a.in[8] + (size_t)1024 * FF, 1024, FF, W1_1_T, (scr_), r_, lane); continue; } r_ -= 2048; \
                transpose_item(a.in[9] + (size_t)FF * 1024, FF, 1024, W2_1_T, (scr_), r_, lane); } } } while (0)
    PG8_LAS unsigned char* ldsg = (PG8_LAS unsigned char*)lds;
    unsigned* barw = (unsigned*)(a.ws + OFF_BAR); unsigned bar_target = 0u; (void)barw; (void)bar_target;
    unsigned* xbw = (unsigned*)(a.ws + OFF_XBAR);
    volatile unsigned* xst = (volatile unsigned*)(lds + 131072 + 512);
    if (threadIdx.x == 0) { xst[0] = 0u; xst[1] = 0u; }
    XcdBarrier xbar = xcd_barrier_post(xbw, xst);
    if (a.ws == nullptr) grid.sync();

PROBE_BEGIN(1)
    { IDS
        float* sl = (float*)lds; float* red = (float*)(lds + 12288);
        for (int item = bid; item < 192; item += G) {
            for (int i = tid; i < 3072; i += 512) { const int j = i >> 10, k = i & 1023; const float v = (j < 2) ? cvec[j * 1024 + k] : cctx[k]; sl[i] = v / (1.f + expf(-v)); }
            __syncthreads();
            const int layer = item / 96, n0 = (item % 96) * 64;
            const float* W = w_mod + (size_t)layer * 1024 * 6144 + n0 + lane;
            float a0 = 0.f, a1 = 0.f, a2 = 0.f; const int k0 = wave * 128;
#pragma unroll 8
            for (int kk = 0; kk < 128; ++kk) { const int k = k0 + kk; const float w = W[(size_t)k * 6144]; a0 += sl[k] * w; a1 += sl[1024 + k] * w; a2 += sl[2048 + k] * w; }
            red[(wave * 3 + 0) * 64 + lane] = a0; red[(wave * 3 + 1) * 64 + lane] = a1; red[(wave * 3 + 2) * 64 + lane] = a2;
            __syncthreads();
            if (tid < 192) { const int j = tid >> 6, col = tid & 63; float s = b_mod[layer * 6144 + n0 + col];
#pragma unroll
                for (int w = 0; w < 8; ++w) s += red[(w * 3 + j) * 64 + col];
                mod[(layer * 3 + j) * 6144 + n0 + col] = s; }
            __syncthreads();
        }
        if (bid == G - 1 && tid < 16) {
            double f = 1.0; for (int i = 0; i < tid; ++i) f *= 0.56234132519034908;
            const double x2 = f * f; double cs = 1.0, sn = f, tc = 1.0, ts = f;
            for (int n = 1; n <= 12; ++n) { tc *= -x2 / (double)((2 * n - 1) * (2 * n)); cs += tc; ts *= -x2 / (double)((2 * n) * (2 * n + 1)); sn += ts; }
            double c = 1.0, s = 0.0;
            for (int p = 0; p < 128; ++p) { rope[(p * 16 + tid) * 2] = (float)c; rope[(p * 16 + tid) * 2 + 1] = (float)s; const double nc = c * cs - s * sn; s = s * cs + c * sn; c = nc; }
        }
        float* scr = (float*)(lds + 32768 + wave * 8448);
        for (int it = gw; it < 2064; it += NGW) {
            int r = it;
            if (r < 1552) { transpose_item(a.in[10], 1024, NPROJ, WIN_T, scr, r, lane); continue; } r -= 1552;
            transpose_item(a.in[15], 1024, 1024, WOUT0_T, scr, r, lane);
        }
        { u32x4* z = (u32x4*)(WIN_T + (size_t)NPROJ * D); const u32x4 zero = {0u, 0u, 0u, 0u};
          for (int i = bid * 512 + tid; i < (NPROJ_PAD - NPROJ) * D / 8; i += G * 512) z[i] = zero; }
    }
PROBE_END(1)
    xcd_barrier(xbar);


PROBE_BEGIN(2)
    { IDS
    for (int r = gw; r < R; r += 2 * NGW) {
        const int r2 = r + NGW; const bool has2 = r2 < R;
        bool isc, isc2; int b, b2; const size_t off = row_off(r, isc, b), off2 = row_off(has2 ? r2 : r, isc2, b2);
        const float* xr = (isc ? ctx : xin) + off; const float* md = mod + (isc ? 2 : b) * 6144;
        const float* xr2 = (isc2 ? ctx : xin) + off2; const float* md2 = mod + (isc2 ? 2 : b2) * 6144;
        f32x4 va[4], vb[4];
#pragma unroll
        for (int j = 0; j < 4; ++j) { va[j] = *(const f32x4*)(xr + lane * 4 + 256 * j); vb[j] = *(const f32x4*)(xr2 + lane * 4 + 256 * j); }
#pragma unroll
        for (int j = 0; j < 4; ++j) {
            const int idx = lane * 4 + 256 * j;
            { const f32x4 sh = *(const f32x4*)(md + idx), sc = *(const f32x4*)(md + 1024 + idx);
              const f32x4 h = va[j] * (sc + 1.f) + sh; u32x2 o; o.x = pk2(h.x, h.y); o.y = pk2(h.z, h.w);
              *(u32x2*)(H + (size_t)r * D + idx) = o; }
            if (has2) { const f32x4 sh = *(const f32x4*)(md2 + idx), sc = *(const f32x4*)(md2 + 1024 + idx);
              const f32x4 h = vb[j] * (sc + 1.f) + sh; u32x2 o; o.x = pk2(h.x, h.y); o.y = pk2(h.z, h.w);
              *(u32x2*)(H + (size_t)r2 * D + idx) = o; }
        }
    }
    }
PROBE_END(2)
    xcd_barrier(xbar);
    if (PROBE_SEL == 10) { for (int i = 0; i < 10; ++i) xcd_barrier(xbar); }

PROBE_BEGIN(8)
    { pg8::Gemm g{H, WIN_T, R, NPROJ_PAD, D}; pg8::StaticOrder S; S.init(R, NPROJ_PAD, G, bid); EpiStore<0> E{P, NPROJ, NPROJ};
      pg8::gemm_phase<EpiStore<0>, pg8::StaticOrder, true, true>(ldsg, g, S, E); }
PROBE_END(8)
    xcd_barrier(xbar);

PROBE_BEGIN(3)
#ifndef NO_P3
    { IDS
        float* cf = (float*)lds; float* cb = (float*)(lds + 16640); float* lrs = (float*)(lds + 33280); float* wl = (float*)(lds + 41728);
        bf16* kTf = (bf16*)(lds + 50432); bf16* kTb = (bf16*)(lds + 59648); bf16* vT = (bf16*)(lds + 68864);
        constexpr int NU = NB * 2 * 4 * NCH;
        const int s = tid & 63, dc = tid >> 6;
        u32x4 kv = {0u, 0u, 0u, 0u}, vv0 = kv, vv1 = kv; GatePre gp; gp.lr = (u32x2){0u, 0u}; gp.w = (f32x4){0.f, 0.f, 0.f, 0.f}; gp.bias = 0.f;
#define P3_LOAD(U) do { const int pc_ = (U) % NCH, t_ = (U) / NCH, h_ = t_ & 3, g_ = 1 - (t_ >> 3), b_ = (t_ >> 2) & 1; const bf16* Pr_ = P + (size_t)(b_ * TP + pc_ * 64) * NPROJ; \
            const int kcol_ = g_ ? 1792 + h_ * 64 : 256 + h_ * 64, vcol_ = g_ ? 2048 + h_ * 128 : 512 + h_ * 128; \
            kv = *(const u32x4*)(Pr_ + (size_t)s * NPROJ + kcol_ + dc * 8); vv0 = *(const u32x4*)(Pr_ + (size_t)s * NPROJ + vcol_ + dc * 8); vv1 = *(const u32x4*)(Pr_ + (size_t)s * NPROJ + vcol_ + (dc + 8) * 8); \
            gp = gate_prefetch(g_, h_, Pr_, gkw, gkb, tid); } while (0)
        float* lgs = (float*)(lds + 131072 + 2048);
        if (tid < 8) lgs[tid] = log1pf(-expf(theta[tid]));
        __syncthreads();
        if (bid < NU) P3_LOAD(bid);
        for (int unit = bid; unit < NU; unit += G) {
            const int pc = unit % NCH, t = unit / NCH, h = t & 3, g = 1 - (t >> 3), b = (t >> 2) & 1;
            const float kscale = g ? 1.f : 0.125f;
            float lgf = 0.f, lgb = 0.f;
            if (g) fill_cum3(cf, cb, lrs, wl, g, h, gp, theta, tid);
            else { lgf = lgs[h]; lgb = lgs[4 + h]; }
            {
              if (g) {
#pragma unroll
              for (int j = 0; j < 8; ++j) { const int d = dc * 8 + j; const unsigned u = kv[j >> 1]; const float kf = ((j & 1) ? bfhi(u) : bflo(u)) * kscale;
                  kTf[d * 72 + s] = (bf16)f2bf(kf * __expf(cf[63 * CS + d] - cf[s * CS + d]));
                  kTb[d * 72 + s] = (bf16)f2bf(kf * __expf(cb[d] - cb[s * CS + d])); }
              } else { const float ef = __expf((float)(63 - s) * lgf) * kscale, eb = __expf((float)s * lgb) * kscale;
#pragma unroll
              for (int j = 0; j < 8; ++j) { const int d = dc * 8 + j; const unsigned u = kv[j >> 1]; const float kf = (j & 1) ? bfhi(u) : bflo(u);
                  kTf[d * 72 + s] = (bf16)f2bf(kf * ef); kTb[d * 72 + s] = (bf16)f2bf(kf * eb); }
              }
#pragma unroll
              for (int j = 0; j < 8; ++j) { const unsigned u0 = vv0[j >> 1], u1 = vv1[j >> 1];
                  vT[(dc * 8 + j) * 72 + s] = (bf16)((j & 1) ? (u0 >> 16) : (u0 & 0xffffu)); vT[((dc + 8) * 8 + j) * 72 + s] = (bf16)((j & 1) ? (u1 >> 16) : (u1 & 0xffffu)); }
            }
            const int seq0 = ((b * 2 + g) * 4 + h) * 2;
            const int nf = pc, nbk = (pc < 4) ? 3 - pc : 135 - pc;
            if (tid < 128) { const int dir = tid >> 6, d = tid & 63;
                DEC[((size_t)(seq0 + dir) * NCH + (dir ? nbk : nf)) * 64 + d] = g ? (dir ? expf(cb[d]) : expf(cf[63 * CS + d])) : expf(64.f * (dir ? lgb : lgf)); }
            if (unit + G < NU) P3_LOAD(unit + G);
            __syncthreads();
            bf16x8 bfr[2];
#pragma unroll
            for (int ks = 0; ks < 2; ++ks) bfr[ks] = *(const bf16x8*)(vT + (wave * 16 + l15) * 72 + ks * 32 + quad * 8);
#pragma unroll
            for (int dir = 0; dir < 2; ++dir) {
                const bf16* kT = dir ? kTb : kTf;
                bf16* dst = ST + ((size_t)(seq0 + dir) * NCH + (dir ? nbk : nf)) * 8192 + (size_t)(wave * 16 + l15) * 64;
#pragma unroll
                for (int dt = 0; dt < 4; ++dt) {
                    pg8::f32x4 acc = {0.f, 0.f, 0.f, 0.f};
#pragma unroll
                    for (int ks = 0; ks < 2; ++ks) { const bf16x8 af = *(const bf16x8*)(kT + (dt * 16 + l15) * 72 + ks * 32 + quad * 8); acc = MFMA16(af, bfr[ks], acc); }
                    u32x2 o; o.x = pk2(acc[0], acc[1]); o.y = pk2(acc[2], acc[3]);
                    *(u32x2*)(dst + dt * 16 + quad * 4) = o;
                }
            }
            __syncthreads();
        }
#undef P3_LOAD
        if ((NU - bid + G - 1) / G < (NU + G - 1) / G) DRAIN_LATE((float*)(lds + wave * 8448), 1);
    }
#endif
PROBE_END(3)
    xcd_barrier(xbar);

PROBE_BEGIN(4)
    { IDS
    for (int i = bid * 512 + tid; i < 32 * 4096; i += G * 512) {
        const int seq = i >> 12, pi = i & 4095, d = (2 * pi) & 63;
        unsigned* sp = (unsigned*)(ST + (size_t)seq * NCH * 8192) + pi; const float* dp = DEC + (size_t)seq * NCH * 64 + d;
        float s0 = 0.f, s1 = 0.f;
#pragma unroll 4
        for (int n = 0; n < NCH; ++n) {
            const unsigned kv = sp[(size_t)n * 4096]; const float d0 = dp[n * 64], d1 = dp[n * 64 + 1];
            sp[(size_t)n * 4096] = pk2(s0, s1);
            s0 = d0 * s0 + bflo(kv); s1 = d1 * s1 + bfhi(kv);
        }
    }
    }
PROBE_END(4)
    xcd_barrier(xbar);

PROBE_BEGIN(5)
#ifndef NO_P5
    { IDS
        float* cf = (float*)lds; float* cb = (float*)(lds + 16640); float* lrs = (float*)(lds + 33280); float* wl = (float*)(lds + 41728);
        bf16* qdf = (bf16*)(lds + 50432); bf16* kif = (bf16*)(lds + 59648); bf16* qdb = (bf16*)(lds + 68864); bf16* kib = (bf16*)(lds + 78080);
        bf16* vT = (bf16*)(lds + 87296); bf16* Am = (bf16*)(lds + 105728); float* red = (float*)(lds + 114944);
        constexpr int NU = NB * 2 * 4 * NCH;
        const int dcq = tid & 7, sq = tid >> 3, sv = tid & 63, dcv = tid >> 6;
        u32x4 qv = {0u, 0u, 0u, 0u}, kv = qv, vv0 = qv, vv1 = qv; GatePre gp; gp.lr = (u32x2){0u, 0u}; gp.w = (f32x4){0.f, 0.f, 0.f, 0.f}; gp.bias = 0.f;
#define P5_LOAD(U) do { const int pc_ = (U) % NCH, t_ = (U) / NCH, h_ = t_ & 3, g_ = 1 - (t_ >> 3), b_ = (t_ >> 2) & 1; const bf16* Pr_ = P + (size_t)(b_ * TP + pc_ * 64) * NPROJ; \
            const int qcol_ = g_ ? 1536 + h_ * 64 : h_ * 64, kcol_ = g_ ? 1792 + h_ * 64 : 256 + h_ * 64, vcol_ = g_ ? 2048 + h_ * 128 : 512 + h_ * 128; \
            qv = *(const u32x4*)(Pr_ + (size_t)sq * NPROJ + qcol_ + dcq * 8); kv = *(const u32x4*)(Pr_ + (size_t)sq * NPROJ + kcol_ + dcq * 8); \
            vv0 = *(const u32x4*)(Pr_ + (size_t)sv * NPROJ + vcol_ + dcv * 8); vv1 = *(const u32x4*)(Pr_ + (size_t)sv * NPROJ + vcol_ + (dcv + 8) * 8); \
            gp = gate_prefetch(g_, h_, Pr_, gkw, gkb, tid); } while (0)
        f32x4 ngv[4];
#pragma unroll
        for (int et = 0; et < 4; ++et) ngv[et] = *(const f32x4*)(normg + ((wave >> 2) * 4 + et) * 16 + quad * 4);
        float* lgs = (float*)(lds + 131072 + 2048);
        if (tid < 8) lgs[tid] = log1pf(-expf(theta[tid]));
        __syncthreads();
        if (bid < NU) P5_LOAD(bid);
        for (int unit = bid; unit < NU; unit += G) {
            const int pc = unit % NCH, t = unit / NCH, h = t & 3, g = 1 - (t >> 3), b = (t >> 2) & 1;
            const int r0 = b * TP + pc * 64;
            const int gcol = g ? 2560 + h * 128 : 1024 + h * 128;
            const float qscale = g ? 0.125f : 1.f, kscale = g ? 1.f : 0.125f;
            const int ct = wave & 3, eh = wave >> 2;
            const int seq0 = ((b * 2 + g) * 4 + h) * 2;
            const int nf = pc, nbk = (pc < 4) ? 3 - pc : 135 - pc;
            const bf16* Sf = ST + ((size_t)seq0 * NCH + nf) * 8192; const bf16* Sb = ST + ((size_t)(seq0 + 1) * NCH + nbk) * 8192;
            const int r = r0 + ct * 16 + l15;
            bf16x8 a2[4][2], a3[4][2]; u32x2 gv[4];
#pragma unroll
            for (int et = 0; et < 4; ++et) { const int e = (eh * 4 + et) * 16 + l15;
#pragma unroll
                for (int ks = 0; ks < 2; ++ks) { a2[et][ks] = *(const bf16x8*)(Sf + e * 64 + ks * 32 + quad * 8); a3[et][ks] = *(const bf16x8*)(Sb + e * 64 + ks * 32 + quad * 8); }
                gv[et] = *(const u32x2*)(P + (size_t)r * NPROJ + gcol + (eh * 4 + et) * 16 + quad * 4); }
            if (g) fill_cum3(cf, cb, lrs, wl, g, h, gp, theta, tid);
            { u32x4 o1, o2, o3, o4;
              if (g) {
#pragma unroll
              for (int j2 = 0; j2 < 4; ++j2) {
                  const int d = dcq * 8 + 2 * j2;
                  const float f0 = cf[sq * CS + d], f1 = cf[sq * CS + d + 1], b0 = cb[sq * CS + d], b1 = cb[sq * CS + d + 1];
                  const float q0 = bflo(qv[j2]) * qscale, q1 = bfhi(qv[j2]) * qscale, k0 = bflo(kv[j2]) * kscale, k1 = bfhi(kv[j2]) * kscale;
                  o1[j2] = pk2(q0 * __expf(f0), q1 * __expf(f1)); o2[j2] = pk2(k0 * __expf(-f0), k1 * __expf(-f1));
                  o3[j2] = pk2(q0 * __expf(b0), q1 * __expf(b1)); o4[j2] = pk2(k0 * __expf(-b0), k1 * __expf(-b1));
              }
              } else {
                  const float lgf = lgs[h], lgb = lgs[4 + h];
                  const float cfr = (float)(sq + 1) * lgf, cbr = (float)(64 - sq) * lgb;
                  const float ef = __expf(cfr) * qscale, eif = __expf(-cfr) * kscale, eb = __expf(cbr) * qscale, eib = __expf(-cbr) * kscale;
#pragma unroll
                  for (int j2 = 0; j2 < 4; ++j2) { const float q0 = bflo(qv[j2]), q1 = bfhi(qv[j2]), k0 = bflo(kv[j2]), k1 = bfhi(kv[j2]);
                      o1[j2] = pk2(q0 * ef, q1 * ef); o2[j2] = pk2(k0 * eif, k1 * eif); o3[j2] = pk2(q0 * eb, q1 * eb); o4[j2] = pk2(k0 * eib, k1 * eib); }
              }
              *(u32x4*)(qdf + sq * 72 + dcq * 8) = o1; *(u32x4*)(kif + sq * 72 + dcq * 8) = o2; *(u32x4*)(qdb + sq * 72 + dcq * 8) = o3; *(u32x4*)(kib + sq * 72 + dcq * 8) = o4;
#pragma unroll
              for (int j = 0; j < 8; ++j) { const unsigned u0 = vv0[j >> 1], u1 = vv1[j >> 1];
                  vT[(dcv * 8 + j) * 72 + sv] = (bf16)((j & 1) ? (u0 >> 16) : (u0 & 0xffffu)); vT[((dcv + 8) * 8 + j) * 72 + sv] = (bf16)((j & 1) ? (u1 >> 16) : (u1 & 0xffffu)); }
            }
            __syncthreads();
            { bf16x8 af[2], ab[2];
#pragma unroll
              for (int ks = 0; ks < 2; ++ks) { af[ks] = *(const bf16x8*)(qdf + (ct * 16 + l15) * 72 + ks * 32 + quad * 8); ab[ks] = *(const bf16x8*)(qdb + (ct * 16 + l15) * 72 + ks * 32 + quad * 8); }
#pragma unroll
              for (int i = 0; i < 2; ++i) { const int st = (wave >> 2) * 2 + i;
                  pg8::f32x4 accf = {0.f, 0.f, 0.f, 0.f}, accb = {0.f, 0.f, 0.f, 0.f};
#pragma unroll
                  for (int ks = 0; ks < 2; ++ks) {
                      const bf16x8 bf_ = *(const bf16x8*)(kif + (st * 16 + l15) * 72 + ks * 32 + quad * 8), bb_ = *(const bf16x8*)(kib + (st * 16 + l15) * 72 + ks * 32 + quad * 8);
                      accf = MFMA16(af[ks], bf_, accf); accb = MFMA16(ab[ks], bb_, accb); }
                  const int scol = st * 16 + l15;
#pragma unroll
                  for (int rg = 0; rg < 4; ++rg) { const int c = ct * 16 + quad * 4 + rg; Am[c * 72 + scol] = (bf16)f2bf(scol <= c ? accf[rg] : accb[rg]); }
              }
            }
            if (unit + G < NU) P5_LOAD(unit + G);
            __syncthreads();
            { bf16x8 bA[2], bQf[2], bQb[2];
#pragma unroll
              for (int ks = 0; ks < 2; ++ks) { const int o = (ct * 16 + l15) * 72 + ks * 32 + quad * 8; bA[ks] = *(const bf16x8*)(Am + o); bQf[ks] = *(const bf16x8*)(qdf + o); bQb[ks] = *(const bf16x8*)(qdb + o); }
              pg8::f32x4 acc[4]; float ss = 0.f;
#pragma unroll
              for (int et = 0; et < 4; ++et) { const int e = (eh * 4 + et) * 16 + l15;
                  pg8::f32x4 c4 = {0.f, 0.f, 0.f, 0.f};
#pragma unroll
                  for (int ks = 0; ks < 2; ++ks) {
                      const bf16x8 a1 = *(const bf16x8*)(vT + e * 72 + ks * 32 + quad * 8);
                      c4 = MFMA16(a1, bA[ks], c4); c4 = MFMA16(a2[et][ks], bQf[ks], c4); c4 = MFMA16(a3[et][ks], bQb[ks], c4); }
                  acc[et] = c4; ss += (c4[0] * c4[0] + c4[1] * c4[1]) + (c4[2] * c4[2] + c4[3] * c4[3]); }
              ss = quad_sum(ss);
              if (quad == 0) red[eh * 64 + ct * 16 + l15] = ss;
              __syncthreads();
              const float tot = red[ct * 16 + l15] + red[64 + ct * 16 + l15];
              const float rinv = 1.f / sqrtf(tot * (1.f / 128.f) + 1e-6f);
#pragma unroll
              for (int et = 0; et < 4; ++et) { const int e0 = (eh * 4 + et) * 16 + quad * 4;
                  float gt[4] = {bflo(gv[et].x), bfhi(gv[et].x), bflo(gv[et].y), bfhi(gv[et].y)}; float y[4];
#pragma unroll
                  for (int i = 0; i < 4; ++i) { const float ng = g ? ngv[et][i] : 1.f; const float sg = gt[i] * __builtin_amdgcn_rcpf(1.f + __expf(-gt[i])); y[i] = sg * acc[et][i] * rinv * ng; }
                  u32x2 o; o.x = pk2(y[0], y[1]); o.y = pk2(y[2], y[3]);
                  *(u32x2*)(H + (size_t)r * D + g * 512 + h * 128 + e0) = o; }
            }
            __syncthreads();
        }
#undef P5_LOAD
        if ((NU - bid + G - 1) / G < (NU + G - 1) / G) DRAIN_LATE((float*)(lds + wave * 8448), 2);
    }
#endif
PROBE_END(5)
    xcd_barrier(xbar);

PROBE_BEGIN(12)
    { pg8::Gemm g{H, WOUT0_T, R, D, D}; LatOrder S; S.init(D, G, bid); EpiResid<0, false> E{xin, ctx, VLAT, VCTX, nullptr, mod + 2 * 1024, nullptr, nullptr, nullptr};
      pg8::gemm_phase<EpiResid<0, false>, LatOrder, true, true>(ldsg, g, S, E); }
    { IDS
      ctx_resid_tiles<false>(H, WOUT0_T, D, ctx, VCTX, mod + 2 * 6144 + 2 * 1024, nullptr, nullptr, nullptr, (float*)lds, bid, G, tid, wave, l15, quad); }
PROBE_END(12)
    xcd_barrier(xbar);
PROBE_BEGIN(7)
    { IDS
    DRAIN_LATE((float*)(lds + wave * 8448), 1 << 30);
    ln_phase<false, false>(RST(0), VLAT, VCTX, nullptr, nullptr, ln_g, ln_b, mod + 3 * 1024, H, gw, NGW, lane);
    }
PROBE_END(7)
    xcd_barrier(xbar);
PROBE_BEGIN(11)
    { pg8::Gemm g{H, W1_0_T, R, FF, D}; LatOrder S; S.init(FF, G, bid); EpiStore<1> E{P, FF, FF};
      pg8::gemm_phase<EpiStore<1>, LatOrder, true, true>(ldsg, g, S, E); }
    { IDS
      ctx_ksplit_tiles<1>(H, W1_0_T, P, FF, 64, FF, (float*)lds, bid, G, tid, wave, l15, quad); }
PROBE_END(11)
    xcd_barrier(xbar);
PROBE_BEGIN(9)
    { pg8::Gemm g{P, W2_0_T, R, D, FF}; LatOrder S; S.init(D, G, bid); EpiResid<1, false> E{VLAT, VCTX, VLAT, VCTX, nullptr, mod + 5 * 1024, RST(0), ln_g, ln_b};
      pg8::gemm_phase<EpiResid<1, false>, LatOrder, true, true>(ldsg, g, S, E); }
    { IDS
      ctx_resid_tiles<true>(P, W2_0_T, FF, VCTX, VCTX, mod + 2 * 6144 + 5 * 1024, RST(0), ln_g, ln_b, (float*)lds, bid, G, tid, wave, l15, quad); }
PROBE_END(9)
    xcd_barrier(xbar);
    { IDS
    ln_phase<false, false>(RST(1), VLAT, VCTX, nullptr, nullptr, ln_g + 1024, ln_b + 1024, mod + 3 * 6144, H, gw, NGW, lane);
    }
    xcd_barrier(xbar);

PROBE_BEGIN(13)
    { pg8::Gemm g{H, WQKV_T, R, NQKV, D}; pg8::StaticOrder S; S.init(R, NQKV, G, bid); EpiStore<0> E{P, NQKV, NQKV};
      pg8::gemm_phase<EpiStore<0>, pg8::StaticOrder, true, true>(ldsg, g, S, E); }
PROBE_END(13)
    xcd_barrier(xbar);

PROBE_BEGIN(6)
#ifndef NO_P12
    { IDS
        bf16* Qs = (bf16*)lds; bf16* Ks = (bf16*)(lds + 73728); bf16* Vt = (bf16*)(lds + 82944); float* ropes = (float*)(lds + 92160);
        for (int i = tid; i < 1024; i += 512) ((f32x4*)ropes)[i] = ((const f32x4*)rope)[i];
        PACC_DECL
        for (int unit = bid; unit < NB * 4 * 64; unit += G) {
            PACC_BEGIN(40)
            const int nb = unit & 63, kvh = (unit >> 6) & 3, b = unit >> 8;
#define ATT_VALID(t) ((t) < 4 || (unsigned)(nb - 1 + (((t) - 4) >> 1)) < 64u)
#define ATT_KPOS(t) ((nb - 1 + (((t) - 4) >> 1)) * 128 + (((t) - 4) & 1) * 64)
#define ATT_KROW(t) ((t) < 4 ? b * TP + (t) * 64 : b * TP + L + ATT_KPOS(t))
            const int keyk = tid >> 2, pck = tid & 3, c1k = (pck & 1) + (pck >> 1) * 4, keyv = tid & 63, dcv = tid >> 6;
            u32x4 pk1 = {0u, 0u, 0u, 0u}, pk2_ = pk1, pvv = pk1;
#define ATT_LOAD(t) do { const int kr_ = ATT_KROW(t); \
                if (tid < 256) { const bf16* src_ = P + (size_t)(kr_ + keyk) * NQKV + 1024 + kvh * 64; pk1 = *(const u32x4*)(src_ + c1k * 8); pk2_ = *(const u32x4*)(src_ + (c1k + 2) * 8); } \
                pvv = *(const u32x4*)(P + (size_t)(kr_ + keyv) * NQKV + 1280 + kvh * 64 + dcv * 8); } while (0)
            ATT_LOAD(0);
            __syncthreads();
#pragma unroll
            for (int i = 0; i < 4; ++i) {
                const int it = tid + i * 512, pcq = it & 3, row = it >> 2, g = row >> 7, qi = row & 127, pos = nb * 128 + qi;
                const bf16* src = P + (size_t)(b * TP + L + pos) * NQKV + (kvh * 4 + g) * 64;
                const int c1 = (pcq & 1) + (pcq >> 1) * 4;
                const u32x4 u1 = *(const u32x4*)(src + c1 * 8), u2 = *(const u32x4*)(src + (c1 + 2) * 8);
                const int pv = (pcq < 2) ? (pos >> 6) : (pos & 63);
                const f32x4* tab = (const f32x4*)(ropes + (pv * 16 + (c1 & 1) * 8) * 2);
                u32x4 o1, o2;
#pragma unroll
                for (int j2 = 0; j2 < 4; ++j2) { const f32x4 cs = tab[j2];
                    const float a0 = bflo(u1[j2]), a1 = bfhi(u1[j2]), b0 = bflo(u2[j2]), b1 = bfhi(u2[j2]);
                    o1[j2] = pk2((a0 * cs.x - b0 * cs.y) * QSC, (a1 * cs.z - b1 * cs.w) * QSC); o2[j2] = pk2((a0 * cs.y + b0 * cs.x) * QSC, (a1 * cs.w + b1 * cs.z) * QSC); }
                *(u32x4*)(Qs + row * 72 + c1 * 8) = o1; *(u32x4*)(Qs + row * 72 + (c1 + 2) * 8) = o2;
            }
            const int g = wave & 3, qh = wave >> 2, qrow0 = g * 128 + qh * 64, qpos0 = nb * 128 + qh * 64;
            float mrun[4], lrun[4]; pg8::f32x4 O[4][4];
            const float sk = sink[kvh * 4 + g] * 1.4426950408889634f;
#pragma unroll
            for (int qt = 0; qt < 4; ++qt) { mrun[qt] = sk; lrun[qt] = (quad == 0) ? 1.f : 0.f;
#pragma unroll
                for (int dt = 0; dt < 4; ++dt) O[dt][qt] = (pg8::f32x4){0.f, 0.f, 0.f, 0.f}; }
            PACC_END(40)
            int ti = 0;
            while (ti < 10) {
                PACC_BEGIN(41)
                const bool local = ti >= 4;
                const int kpos0 = local ? ATT_KPOS(ti) : 0;
                const int side = local ? ((ti - 4) >> 1) - 1 : 0;
                __syncthreads();
                if (tid < 256) {
                    u32x4 o1 = pk1, o2 = pk2_;
                    if (local) {
                        const int pos = kpos0 + keyk, pv = (pck < 2) ? (pos >> 6) : (pos & 63);
                        const f32x4* tab = (const f32x4*)(ropes + (pv * 16 + (c1k & 1) * 8) * 2);
#pragma unroll
                        for (int j2 = 0; j2 < 4; ++j2) { const f32x4 cs = tab[j2];
                            const float a0 = bflo(pk1[j2]), a1 = bfhi(pk1[j2]), b0 = bflo(pk2_[j2]), b1 = bfhi(pk2_[j2]);
                            o1[j2] = pk2(a0 * cs.x - b0 * cs.y, a1 * cs.z - b1 * cs.w); o2[j2] = pk2(a0 * cs.y + b0 * cs.x, a1 * cs.w + b1 * cs.z); }
                    }
                    *(u32x4*)(Ks + keyk * 72 + c1k * 8) = o1; *(u32x4*)(Ks + keyk * 72 + (c1k + 2) * 8) = o2;
                }
#pragma unroll
                for (int j = 0; j < 8; ++j) { const unsigned u = pvv[j >> 1]; Vt[(dcv * 8 + j) * 72 + keyv] = (bf16)((j & 1) ? (u >> 16) : (u & 0xffffu)); }
                __syncthreads();
                PACC_END(41)
                PACC_BEGIN(42)
                int tn = ti + 1;
                while (tn < 10 && !ATT_VALID(tn)) ++tn;
                if (tn < 10) ATT_LOAD(tn);
                if (!((side < 0 && ((ti - 4) & 1) == 0 && qh == 1) || (side > 0 && ((ti - 4) & 1) == 1 && qh == 0))) {
                bf16x8 kfr[4][2];
#pragma unroll
                for (int kt = 0; kt < 4; ++kt)
#pragma unroll
                    for (int ks = 0; ks < 2; ++ks) kfr[kt][ks] = *(const bf16x8*)(Ks + (kt * 16 + l15) * 72 + ks * 32 + quad * 8);
#pragma unroll
                for (int qt = 0; qt < 4; ++qt) {
                    pg8::f32x4 S[4];
#pragma unroll
                    for (int kt = 0; kt < 4; ++kt) S[kt] = (pg8::f32x4){0.f, 0.f, 0.f, 0.f};
#pragma unroll
                    for (int ks = 0; ks < 2; ++ks) { const bf16x8 qf = *(const bf16x8*)(Qs + (qrow0 + qt * 16 + l15) * 72 + ks * 32 + quad * 8);
#pragma unroll
                        for (int kt = 0; kt < 4; ++kt) S[kt] = MFMA16(kfr[kt][ks], qf, S[kt]); }
                    float mx = -INFINITY;
                    if (side < 0 && ((ti - 4) & 1) == qh) {
                        const int tl = quad * 4 - (qpos0 + qt * 16 + l15 - kpos0 - 128);
#pragma unroll
                        for (int kt = 0; kt < 4; ++kt)
#pragma unroll
                            for (int rg = 0; rg < 4; ++rg) { const float sv_ = (tl >= -(kt * 16 + rg)) ? S[kt][rg] : -INFINITY; S[kt][rg] = sv_; mx = fmaxf(mx, sv_); }
                    } else if (side > 0 && ((ti - 4) & 1) == qh) {
                        const int th = (qpos0 + qt * 16 + l15 - kpos0 + 128) - quad * 4;
#pragma unroll
                        for (int kt = 0; kt < 4; ++kt)
#pragma unroll
                            for (int rg = 0; rg < 4; ++rg) { const float sv_ = (th >= (kt * 16 + rg)) ? S[kt][rg] : -INFINITY; S[kt][rg] = sv_; mx = fmaxf(mx, sv_); }
                    } else {
#pragma unroll
                        for (int kt = 0; kt < 4; ++kt)
#pragma unroll
                            for (int rg = 0; rg < 4; ++rg) mx = fmaxf(mx, S[kt][rg]);
                    }
                    mx = quad_max(mx);
                    const float mnew = fmaxf(mrun[qt], mx), al = __builtin_amdgcn_exp2f(mrun[qt] - mnew); mrun[qt] = mnew;
                    float ps = 0.f;
#pragma unroll
                    for (int kt = 0; kt < 4; ++kt)
#pragma unroll
                        for (int rg = 0; rg < 4; ++rg) { const float p = __builtin_amdgcn_exp2f(S[kt][rg] - mnew); S[kt][rg] = p; ps += p; }
                    lrun[qt] = lrun[qt] * al + ps;
#pragma unroll
                    for (int dt = 0; dt < 4; ++dt) O[dt][qt] = O[dt][qt] * al;
#pragma unroll
                    for (int s2 = 0; s2 < 2; ++s2) {
                        u32x4 pw; pw.x = pk2(S[2 * s2][0], S[2 * s2][1]); pw.y = pk2(S[2 * s2][2], S[2 * s2][3]);
                        pw.z = pk2(S[2 * s2 + 1][0], S[2 * s2 + 1][1]); pw.w = pk2(S[2 * s2 + 1][2], S[2 * s2 + 1][3]);
                        const bf16x8 pf = __builtin_bit_cast(bf16x8, pw);
#pragma unroll
                        for (int dt = 0; dt < 4; ++dt) {
                            const s16x4 lo = *(const s16x4*)(Vt + (dt * 16 + l15) * 72 + s2 * 32 + quad * 4), hi = *(const s16x4*)(Vt + (dt * 16 + l15) * 72 + s2 * 32 + 16 + quad * 4);
                            O[dt][qt] = MFMA16(__builtin_shufflevector(lo, hi, 0, 1, 2, 3, 4, 5, 6, 7), pf, O[dt][qt]); }
                    }
                }
                }
                ti = tn;
                PACC_END(42)
            }
            PACC_BEGIN(43)
#pragma unroll
            for (int qt = 0; qt < 4; ++qt) {
                const float lt = quad_sum(lrun[qt]);
                const float inv = 1.f / lt;
                const int r = b * TP + L + qpos0 + qt * 16 + l15;
#pragma unroll
                for (int dt = 0; dt < 4; ++dt) { u32x2 o; o.x = pk2(O[dt][qt][0] * inv, O[dt][qt][1] * inv); o.y = pk2(O[dt][qt][2] * inv, O[dt][qt][3] * inv);
                    *(u32x2*)(H + (size_t)r * D + (kvh * 4 + g) * 64 + dt * 16 + quad * 4) = o; }
            }
            PACC_END(43)
#undef ATT_VALID
#undef ATT_KPOS
#undef ATT_KROW
#undef ATT_LOAD
        }
        PACC_SLEEP()
    }
#endif
PROBE_END(6)
    xcd_barrier(xbar);

PROBE_BEGIN(14)
    { pg8::Gemm g{H, WOUT1_T, R, D, D}; LatOrder S; S.init(D, G, bid); EpiResid<1, false> E{VLAT, VCTX, VLAT, VCTX, nullptr, mod + 3 * 6144 + 2 * 1024, RST(1), ln_g + 1024, ln_b + 1024};
      pg8::gemm_phase<EpiResid<1, false>, LatOrder, true, true>(ldsg, g, S, E); }
PROBE_END(14)
    xcd_barrier(xbar);
    { IDS
    ln_phase<false, true>(RST(2), VLAT, VCTX, nullptr, nullptr, ln_g + 2048, ln_b + 2048, mod + 3 * 6144 + 3 * 1024, H, gw, NGW, lane);
    }
    xcd_barrier(xbar);
PROBE_BEGIN(15)
    { pg8::Gemm g{H, W1_1_T, R, FF, D}; LatOrder S; S.init(FF, G, bid); EpiStore<1> E{P, FF, FF};
      pg8::gemm_phase<EpiStore<1>, LatOrder, true, true>(ldsg, g, S, E); }
PROBE_END(15)
    xcd_barrier(xbar);
PROBE_BEGIN(16)
    { pg8::Gemm g{P, W2_1_T, R, D, FF}; LatOrder S; S.init(D, G, bid); EpiResid<1, true> E{VLAT, VCTX, nullptr, nullptr, H, mod + 3 * 6144 + 5 * 1024, RST(2), ln_g + 2048, ln_b + 2048};
      pg8::gemm_phase<EpiResid<1, true>, LatOrder, true, true>(ldsg, g, S, E); }
PROBE_END(16)
    xcd_barrier(xbar);
    { IDS
    ln_phase<true, true>(nullptr, nullptr, nullptr, H, a.out, ln_g + 3072, ln_b + 3072, mod, H, gw, NGW, lane);
    }
}

extern "C" void kernel_launch(void* const* d_in, const int* in_sizes, int n_in, void* d_out, int out_size, void* d_ws, size_t ws_size, hipStream_t stream) {
    static int grid = 0;
    if (grid == 0) {
        if (n_in != 19 || out_size != NB * T * D || ws_size < WS_TOTAL) { fprintf(stderr, "kernel_launch: unexpected shapes (n_in %d out %d ws %zu)\n", n_in, out_size, ws_size); grid = -1; return; }
        int dev = 0, cus = 0, per_cu = 0;
        hipGetDevice(&dev); hipDeviceGetAttribute(&cus, hipDeviceAttributeMultiprocessorCount, dev);
        if (hipFuncSetAttribute((const void*)fwd_kernel, hipFuncAttributeMaxDynamicSharedMemorySize, LDS_BYTES) != hipSuccess) { fprintf(stderr, "kernel_launch: hipFuncSetAttribute failed\n"); grid = -1; return; }
        if (hipOccupancyMaxActiveBlocksPerMultiprocessor(&per_cu, (const void*)fwd_kernel, 512, LDS_BYTES) != hipSuccess || per_cu < 1) per_cu = 1;
        (void)hipGetLastError();
        grid = cus > 0 ? cus : 256;
    }
    if (grid < 0) return;
    Args a{};
    for (int i = 0; i < 19; ++i) a.in[i] = (const float*)d_in[i];
    a.out = (float*)d_out; a.ws = (unsigned char*)d_ws;
    if (hipMemsetAsync((char*)d_ws + OFF_XBAR, 0, 16384, stream) != hipSuccess) { fprintf(stderr, "kernel_launch: hipMemsetAsync of the barrier words failed\n"); return; }
    void* args[] = {&a};
    hipError_t e = hipLaunchCooperativeKernel((const void*)fwd_kernel, dim3(grid), dim3(512), args, LDS_BYTES, stream);
    if (e != hipSuccess) fprintf(stderr, "cooperative launch failed: %s (grid %d)\n", hipGetErrorString(e), grid);
}
```

```cpp
#include <hip/hip_runtime.h>
#include <hip/hip_cooperative_groups.h>
#include <cstdio>
#include <cstdint>
namespace cg = cooperative_groups;
namespace pg8 {
#define PG8_LAS __attribute__((address_space(3)))
typedef unsigned short bf16_t;
typedef short bf16x8 __attribute__((ext_vector_type(8)));
typedef float f32x4 __attribute__((ext_vector_type(4)));
typedef unsigned u32x4 __attribute__((ext_vector_type(4)));
constexpr int BM = 256, BK = 64, HALF = 128, HTB = HALF * BK * 2  , STAGE_BYTES = 8 * HTB, NXCD = 8, WGM = 8;

__host__ __device__ __forceinline__ int lds_byte(int r, int c) { const int st = (r >> 4) * 2 + (c >> 5), rr = r & 15, cc = c & 31, ob = rr * 64 + cc * 2; return st * 1024 + (ob ^ (((ob >> 9) & 1) << 5)); }
__host__ __device__ __forceinline__ void stage_rc(int b, int& R, int& C) { const int st = b / 1024, sb = b % 1024, swz = sb ^ (((sb >> 9) & 1) << 5); R = (st >> 1) * 16 + swz / 64; C = (st & 1) * 32 + (swz % 64) / 2; }
__host__ __device__ __forceinline__ int perm32(int rho) { const int n = rho >> 4, i = rho & 15; return 8 * (i >> 2) + 4 * n + (i & 3); }

struct Unit { int pm, pn; };
struct Gemm { const bf16_t* A; const bf16_t* Bt; int M, N, K; };

struct StaticOrder {
    int nM, nN, nwg, G, c;
    __host__ __device__ void init(int M, int N, int G_, int c_) { nM = M / BM; nN = N / BM; nwg = nM * nN; G = G_; c = c_; }
    __host__ __device__ bool next(int i, Unit& u) const {
        const long L = (long)i * G + c; if (L >= nwg) return false;
        int wgid = (int)L; { const int q = nwg / NXCD, r = nwg % NXCD, xcd = wgid % NXCD, off = wgid / NXCD; wgid = (xcd < r ? xcd * (q + 1) : r * (q + 1) + (xcd - r) * q) + off; }
        const int nig = WGM * nN, gid = wgid / nig, fm = gid * WGM, gsz = (nM - fm) < WGM ? (nM - fm) : WGM;
        u.pm = fm + ((wgid % nig) % gsz); u.pn = (wgid % nig) / gsz; return true;
    }
    __device__ __forceinline__ void a_ready(const Unit&) const {}
    __device__ __forceinline__ void done(const Unit&) const {}
};

__device__ __forceinline__ unsigned cvt_pk_bf16(float lo, float hi) { unsigned r; asm volatile("v_cvt_pk_bf16_f32 %0, %1, %2" : "=v"(r) : "v"(lo), "v"(hi)); return r; }

template <class Epi, class Sched, bool ALIGN_EPI = false, bool SP2 = false>
__device__ __forceinline__ void gemm_phase(PG8_LAS unsigned char* lds, const Gemm g, const Sched& S, const Epi& E) {
    int tid = threadIdx.x; asm volatile("" : "+v"(tid));
    const int wid = __builtin_amdgcn_readfirstlane(tid >> 6), lane = tid & 63, wr = wid >> 2, wc = wid & 3, fr = lane & 15, fq = lane >> 4;
    const int K = g.K, nt = K / BK;
    unsigned voffA[2], voffB[2];
#pragma unroll
    for (int i = 0; i < 2; ++i) { int R, C; stage_rc(tid * 16 + i * 8192, R, C); const int Rb = Epi::PERM ? ((R & ~31) + perm32(R & 31)) : R;
        voffA[i] = (unsigned)(R * K + C) * 2u; voffB[i] = (unsigned)(Rb * K + C) * 2u; }
    const size_t kstep = (size_t)(BK * 2);
    const size_t hstep = (size_t)HALF * K * 2;
    const size_t tstep = 2 * hstep;
    const unsigned ldsw = (unsigned)wid * 1024u;
    const int aoff = lds_byte(wr * 64 + fr, fq * 8), boff = lds_byte(wc * 32 + fr, fq * 8);
#define PG8_SA(b, h) (((b) * 2 + (h)) * HTB)
#define PG8_SB(b, h) ((4 + (b) * 2 + (h)) * HTB)
#define PG8_STAGE(bufoff, gbase, voff) do { _Pragma("unroll") for (int _i = 0; _i < 2; ++_i) \
        __builtin_amdgcn_global_load_lds((const unsigned*)((const char*)(gbase) + (voff)[_i]), (PG8_LAS unsigned*)(lds + (bufoff) + ldsw + _i * 8192), 16, 0, 0); } while (0)
#define PG8_LDA(dst, b, h) do { _Pragma("unroll") for (int m = 0; m < 4; ++m) _Pragma("unroll") for (int k = 0; k < 2; ++k) dst[m][k] = *(const PG8_LAS bf16x8*)(lds + PG8_SA(b, h) + aoff + m * 2048 + k * 1024); } while (0)
#define PG8_LDB(dst, b, h) do { _Pragma("unroll") for (int n = 0; n < 2; ++n) _Pragma("unroll") for (int k = 0; k < 2; ++k) dst[n][k] = *(const PG8_LAS bf16x8*)(lds + PG8_SB(b, h) + boff + n * 2048 + k * 1024); } while (0)
#define PG8_MMA(ai, bj, At, Bt) do { __builtin_amdgcn_s_setprio(1); _Pragma("unroll") for (int m = 0; m < 4; ++m) _Pragma("unroll") for (int n = 0; n < 2; ++n) _Pragma("unroll") for (int k = 0; k < 2; ++k) \
        acc[ai][bj][m][n] = __builtin_amdgcn_mfma_f32_16x16x32_bf16(Bt[n][k], At[m][k], acc[ai][bj][m][n], 0, 0, 0); __builtin_amdgcn_s_setprio(0); } while (0)
#define PG8_WAIT_V(n) asm volatile("s_waitcnt vmcnt(" #n ")" ::: "memory")
#define PG8_WAIT_L(n) asm volatile("s_waitcnt lgkmcnt(" #n ")" ::: "memory")
#define PG8_BAR __builtin_amdgcn_s_barrier()
#define PG8_SCHED __builtin_amdgcn_sched_barrier(0)
    Unit cur, nxt; int ui = 0;
    if (!S.next(0, cur)) return;
    f32x4 acc[2][2][4][2];
#pragma unroll
    for (int a = 0; a < 2; ++a)
#pragma unroll
        for (int b = 0; b < 2; ++b)
#pragma unroll
            for (int m = 0; m < 4; ++m)
#pragma unroll
                for (int n = 0; n < 2; ++n) acc[a][b][m][n] = (f32x4){0.f, 0.f, 0.f, 0.f};
    bf16x8 At[4][2], B0[2][2], B1[2][2];
    const char* cA = (const char*)g.A + (size_t)cur.pm * tstep; const char* cB = (const char*)g.Bt + (size_t)cur.pn * tstep;
    S.a_ready(cur);
    if constexpr (SP2) {
        PG8_STAGE(PG8_SB(0, 0), cB, voffB); PG8_STAGE(PG8_SB(0, 1), cB + hstep, voffB); PG8_STAGE(PG8_SA(0, 0), cA, voffA); PG8_STAGE(PG8_SA(0, 1), cA + hstep, voffA);
        if (wr == 1) PG8_BAR;
        PG8_WAIT_V(2); PG8_BAR;
        PG8_STAGE(PG8_SB(1, 0), cB + kstep, voffB); PG8_STAGE(PG8_SA(1, 0), cA + kstep, voffA); PG8_STAGE(PG8_SB(1, 1), cB + hstep + kstep, voffB);
        PG8_WAIT_V(6); PG8_BAR;
    } else {
        PG8_STAGE(PG8_SB(0, 0), cB, voffB); PG8_STAGE(PG8_SA(0, 0), cA, voffA); PG8_STAGE(PG8_SB(0, 1), cB + hstep, voffB); PG8_STAGE(PG8_SA(0, 1), cA + hstep, voffA);
        if (wr == 1) PG8_BAR;
        PG8_WAIT_V(4); PG8_BAR;
        PG8_STAGE(PG8_SB(1, 0), cB + kstep, voffB); PG8_STAGE(PG8_SA(1, 0), cA + kstep, voffA); PG8_STAGE(PG8_SB(1, 1), cB + hstep + kstep, voffB);
        PG8_WAIT_V(6); PG8_BAR;
    }
    for (;;) {
        const bool has_next = S.next(ui + 1, nxt);
        const char* nA = has_next ? (const char*)g.A + (size_t)nxt.pm * tstep : cA; const char* nB = has_next ? (const char*)g.Bt + (size_t)nxt.pn * tstep : cB;
        for (int t = 0; t < nt; t += 2) {
            const bool last = (t == nt - 2);
            const char* a1 = cA + (size_t)(t + 1) * kstep;
            const char* a2 = last ? nA : cA + (size_t)(t + 2) * kstep; const char* b2 = last ? nB : cB + (size_t)(t + 2) * kstep;
            const char* a3 = a2 + kstep; const char* b3 = b2 + kstep;
            if (last && has_next) S.a_ready(nxt);
            if constexpr (SP2) {
            PG8_LDB(B0, 0, 0); PG8_LDB(B1, 0, 1); PG8_SCHED; PG8_LDA(At, 0, 0); PG8_STAGE(PG8_SA(1, 1), a1 + hstep, voffA);
            PG8_WAIT_V(8); PG8_WAIT_L(0); PG8_BAR; PG8_MMA(0, 0, At, B0); PG8_MMA(0, 1, At, B1); PG8_BAR; PG8_SCHED;
            PG8_LDA(At, 0, 1); PG8_STAGE(PG8_SB(0, 0), b2, voffB); PG8_STAGE(PG8_SB(0, 1), b2 + hstep, voffB); PG8_STAGE(PG8_SA(0, 0), a2, voffA);
            PG8_WAIT_V(8); PG8_WAIT_L(0); PG8_BAR; PG8_MMA(1, 0, At, B0); PG8_MMA(1, 1, At, B1); PG8_BAR; PG8_SCHED;
            PG8_LDB(B0, 1, 0); PG8_LDB(B1, 1, 1); PG8_SCHED; PG8_LDA(At, 1, 0); PG8_STAGE(PG8_SA(0, 1), a2 + hstep, voffA);
            PG8_WAIT_V(8); PG8_WAIT_L(0); PG8_BAR; PG8_MMA(0, 0, At, B0); PG8_MMA(0, 1, At, B1); PG8_BAR; PG8_SCHED;
            PG8_LDA(At, 1, 1); PG8_STAGE(PG8_SB(1, 0), b3, voffB); PG8_STAGE(PG8_SB(1, 1), b3 + hstep, voffB); PG8_STAGE(PG8_SA(1, 0), a3, voffA);
            PG8_WAIT_V(8); PG8_WAIT_L(0); PG8_BAR; PG8_MMA(1, 0, At, B0); PG8_MMA(1, 1, At, B1); PG8_BAR; PG8_SCHED;
            } else {
            PG8_LDB(B0, 0, 0); PG8_SCHED; PG8_LDA(At, 0, 0); PG8_STAGE(PG8_SA(1, 1), a1 + hstep, voffA);
            PG8_WAIT_L(8); PG8_BAR; PG8_WAIT_L(0); PG8_MMA(0, 0, At, B0); PG8_BAR; PG8_SCHED;
            PG8_LDB(B1, 0, 1); PG8_STAGE(PG8_SB(0, 0), b2, voffB);
            PG8_BAR; PG8_WAIT_L(0); PG8_MMA(0, 1, At, B1); PG8_BAR;
            PG8_LDA(At, 0, 1); PG8_STAGE(PG8_SA(0, 0), a2, voffA);
            PG8_BAR; PG8_WAIT_L(0); PG8_MMA(1, 0, At, B0); PG8_BAR; PG8_SCHED;
            PG8_STAGE(PG8_SB(0, 1), b2 + hstep, voffB);
            PG8_WAIT_V(6); PG8_BAR; PG8_MMA(1, 1, At, B1); PG8_BAR;
            PG8_LDB(B0, 1, 0); PG8_SCHED; PG8_LDA(At, 1, 0); PG8_STAGE(PG8_SA(0, 1), a2 + hstep, voffA);
            PG8_WAIT_L(8); PG8_BAR; PG8_WAIT_L(0); PG8_MMA(0, 0, At, B0); PG8_BAR; PG8_SCHED;
            PG8_LDB(B1, 1, 1); PG8_STAGE(PG8_SB(1, 0), b3, voffB);
            PG8_BAR; PG8_WAIT_L(0); PG8_MMA(0, 1, At, B1); PG8_BAR;
            PG8_LDA(At, 1, 1); PG8_STAGE(PG8_SA(1, 0), a3, voffA);
            PG8_BAR; PG8_WAIT_L(0); PG8_MMA(1, 0, At, B0); PG8_BAR; PG8_SCHED;
            PG8_STAGE(PG8_SB(1, 1), b3 + hstep, voffB);
            PG8_WAIT_V(6); PG8_BAR; PG8_MMA(1, 1, At, B1); PG8_BAR;
            }
        }
        if constexpr (ALIGN_EPI) { if (wr == 0) PG8_BAR; }
        if constexpr (!Epi::AFTER_DRAIN) { E(acc, cur, wr, wc, fr, fq); S.done(cur); }
        if (!has_next) break;
#pragma unroll
        for (int a = 0; a < 2; ++a)
#pragma unroll
            for (int b = 0; b < 2; ++b)
#pragma unroll
                for (int m = 0; m < 4; ++m)
#pragma unroll
                    for (int n = 0; n < 2; ++n) acc[a][b][m][n] = (f32x4){0.f, 0.f, 0.f, 0.f};
        cur = nxt; cA = nA; cB = nB; ++ui;
        if constexpr (ALIGN_EPI) { if (wr == 1) PG8_BAR; }
    }
    PG8_WAIT_V(0);
    if constexpr (!ALIGN_EPI) { if (wr == 0) PG8_BAR; }
    PG8_BAR;
    if constexpr (Epi::AFTER_DRAIN) { E.fused(acc, cur, wr, wc, fr, fq, lds, wid, lane); S.done(cur); }
#undef PG8_SA
#undef PG8_SB
#undef PG8_STAGE
#undef PG8_LDA
#undef PG8_LDB
#undef PG8_MMA
#undef PG8_WAIT_V
#undef PG8_WAIT_L
#undef PG8_BAR
#undef PG8_SCHED
}
}

constexpr int NB = 2, T = 8192, L = 256, D = 1024, TP = T + L, R = NB * TP;
constexpr int FF = 4096, NPROJ = 3104, NPROJ_PAD = 3328, NQKV = 1536, NCH = TP / 64;
constexpr float ALPHA = 1.4142135623730951f;
constexpr int LDS_BYTES = 147456;

typedef unsigned short bf16;
typedef float f32x4 __attribute__((ext_vector_type(4)));
typedef short bf16x8 __attribute__((ext_vector_type(8)));
typedef short s16x4 __attribute__((ext_vector_type(4)));
typedef unsigned u32x4 __attribute__((ext_vector_type(4)));
typedef unsigned u32x2 __attribute__((ext_vector_type(2)));

constexpr size_t OFF_WIN = 0;
constexpr size_t OFF_WOUT0 = OFF_WIN + (size_t)NPROJ_PAD * D * 2;
constexpr size_t OFF_W1_0 = OFF_WOUT0 + (size_t)D * D * 2;
constexpr size_t OFF_W2_0 = OFF_W1_0 + (size_t)FF * D * 2;
constexpr size_t OFF_WQKV = OFF_W2_0 + (size_t)FF * D * 2;
constexpr size_t OFF_WOUT1 = OFF_WQKV + (size_t)NQKV * D * 2;
constexpr size_t OFF_W1_1 = OFF_WOUT1 + (size_t)D * D * 2;
constexpr size_t OFF_W2_1 = OFF_W1_1 + (size_t)FF * D * 2;
constexpr size_t OFF_MOD = OFF_W2_1 + (size_t)FF * D * 2;
constexpr size_t OFF_ROPE = OFF_MOD + 2 * 3 * 6144 * 4;
constexpr size_t OFF_BAR = OFF_ROPE + 128 * 16 * 8;
constexpr size_t OFF_XBAR = OFF_BAR + 256;
constexpr size_t OFF_RST = OFF_XBAR + 16384;
constexpr size_t OFF_XCTX = OFF_RST + (size_t)3 * R * 2 * 4;
constexpr size_t OFF_DEC = OFF_XCTX + (size_t)NB * L * D * 4;
constexpr size_t OFF_H = OFF_DEC + (size_t)32 * NCH * 64 * 4;
constexpr size_t OFF_P = OFF_H + (size_t)R * D * 2;
constexpr size_t OFF_ST = OFF_P + (size_t)R * NPROJ * 2;
constexpr size_t WS_TOTAL = OFF_ST + (size_t)32 * NCH * 8192 * 2;
static_assert(WS_TOTAL <= 268435456, "workspace map exceeds 256 MiB");
static_assert(OFF_P + (size_t)R * FF * 2 <= WS_TOTAL, "MLP hidden overlay");

typedef float f32x2_t __attribute__((ext_vector_type(2)));
typedef __bf16 bf16x2_t __attribute__((ext_vector_type(2)));
__device__ __forceinline__ unsigned pk2(float lo, float hi) { const f32x2_t v = {lo, hi}; const bf16x2_t b = __builtin_convertvector(v, bf16x2_t); return __builtin_bit_cast(unsigned, b); }
__device__ __forceinline__ unsigned f2bf(float f) { return pk2(f, f) & 0xffffu; }
__device__ __forceinline__ float bf2f(unsigned h) { return __uint_as_float(h << 16); }
__device__ __forceinline__ float bflo(unsigned u) { return __uint_as_float(u << 16); }
__device__ __forceinline__ float bfhi(unsigned u) { return __uint_as_float(u & 0xffff0000u); }
__device__ __forceinline__ float quad_max(float x) {
    const unsigned u = __float_as_uint(x);
    const auto r = __builtin_amdgcn_permlane32_swap(u, u, false, false);
    const float m = fmaxf(__uint_as_float(r[0]), __uint_as_float(r[1]));
    const unsigned v = __float_as_uint(m);
    const auto q = __builtin_amdgcn_permlane16_swap(v, v, false, false);
    return fmaxf(__uint_as_float(q[0]), __uint_as_float(q[1]));
}
__device__ __forceinline__ float quad_sum(float x) {
    const unsigned u = __float_as_uint(x);
    const auto r = __builtin_amdgcn_permlane32_swap(u, u, false, false);
    const float m = __uint_as_float(r[0]) + __uint_as_float(r[1]);
    const unsigned v = __float_as_uint(m);
    const auto q = __builtin_amdgcn_permlane16_swap(v, v, false, false);
    return __uint_as_float(q[0]) + __uint_as_float(q[1]);
}
__device__ __forceinline__ float dpp_add(float v, int ctrl_sel) {
    const int u = __float_as_int(v);
    const int t = ctrl_sel == 0 ? __builtin_amdgcn_update_dpp(0, u, 0xB1, 0xF, 0xF, true) : ctrl_sel == 1 ? __builtin_amdgcn_update_dpp(0, u, 0x4E, 0xF, 0xF, true)
                : ctrl_sel == 2 ? __builtin_amdgcn_update_dpp(0, u, 0x141, 0xF, 0xF, true) : __builtin_amdgcn_update_dpp(0, u, 0x140, 0xF, 0xF, true);
    return v + __int_as_float(t);
}
__device__ __forceinline__ float wave_sum(float v) { v = dpp_add(v, 0); v = dpp_add(v, 1); v = dpp_add(v, 2); v = dpp_add(v, 3); return quad_sum(v); }
#define MFMA16(a, b, c) __builtin_amdgcn_mfma_f32_16x16x32_bf16((a), (b), (c), 0, 0, 0)

__device__ __forceinline__ size_t row_off(int r, bool& isc, int& b) { b = (r >= TP) ? 1 : 0; const int p = r - b * TP; isc = p < L; return isc ? (size_t)(b * L + p) * D : (size_t)(b * T + p - L) * D; }

template <int ACT> struct EpiStore {
    static constexpr bool PERM = true, AFTER_DRAIN = false;
    bf16* O; int ldc; int ncols;
    __device__ __forceinline__ void operator()(const pg8::f32x4 (&acc)[2][2][4][2], const pg8::Unit& u, int wr, int wc, int fr, int fq) const {
        const int row0 = u.pm * 256 + wr * 64 + fr, col0 = u.pn * 256 + wc * 32 + 8 * fq;
#pragma unroll
        for (int ai = 0; ai < 2; ++ai)
#pragma unroll
            for (int m = 0; m < 4; ++m) {
                bf16* rowp = O + (size_t)(row0 + ai * 128 + m * 16) * ldc;
#pragma unroll
                for (int bj = 0; bj < 2; ++bj) {
                    const int col = col0 + bj * 128;
                    pg8::f32x4 v0 = acc[ai][bj][m][0], v1 = acc[ai][bj][m][1];
                    if (ACT == 1) {
#pragma unroll
                        for (int i = 0; i < 4; ++i) { float a = fmaxf(v0[i], 0.f), b = fmaxf(v1[i], 0.f); v0[i] = a * a; v1[i] = b * b; }
                    }
                    u32x4 w; w.x = pg8::cvt_pk_bf16(v0[0], v0[1]); w.y = pg8::cvt_pk_bf16(v0[2], v0[3]); w.z = pg8::cvt_pk_bf16(v1[0], v1[1]); w.w = pg8::cvt_pk_bf16(v1[2], v1[3]);
                    if (col < ncols) *(u32x4*)(rowp + col) = w;
                }
            }
    }
};
template <int SRC, bool DST_FIN> struct EpiResid {
    static constexpr bool PERM = true, AFTER_DRAIN = false;
    const void* src_lat; const void* src_ctx; bf16* dst_lat; bf16* dst_ctx; bf16* dst_fin; const float* gate;
    const float* rst; const float* lg; const float* lb;
    __device__ __forceinline__ void operator()(const pg8::f32x4 (&acc)[2][2][4][2], const pg8::Unit& u, int wr, int wc, int fr, int fq) const {
        const int b = u.pm > 33 ? 1 : 0, col0 = u.pn * 256 + wc * 32 + 8 * fq, rt0 = wr * 64 + fr;
        const size_t lat0 = (size_t)(u.pm * 256 - b * TP - L + b * T);
        const float* gt = gate + b * 6144;
#pragma unroll
        for (int bj = 0; bj < 2; ++bj) {
            const int col = col0 + bj * 128;
            const f32x4 g0 = *(const f32x4*)(gt + col), g1 = *(const f32x4*)(gt + col + 4);
            f32x4 l0, l1, m0, m1;
            if (SRC == 1) { l0 = *(const f32x4*)(lg + col); l1 = *(const f32x4*)(lg + col + 4); m0 = *(const f32x4*)(lb + col); m1 = *(const f32x4*)(lb + col + 4); }
#pragma unroll
            for (int ai = 0; ai < 2; ++ai)
#pragma unroll
                for (int m = 0; m < 4; ++m) {
                    const int rt = rt0 + ai * 128 + m * 16, row = u.pm * 256 + rt; const size_t off = (lat0 + rt) * D + col;
                    f32x4 x0, x1;
                    if (SRC == 0) { const float* sp = (const float*)src_lat + off; x0 = *(const f32x4*)sp; x1 = *(const f32x4*)(sp + 4); }
                    else { const float mean = rst[2 * row], rstd = rst[2 * row + 1];
                        const u32x4 w = *(const u32x4*)((const bf16*)src_lat + off);
                        x0 = (f32x4){bflo(w.x), bfhi(w.x), bflo(w.y), bfhi(w.y)}; x1 = (f32x4){bflo(w.z), bfhi(w.z), bflo(w.w), bfhi(w.w)};
                        x0 = (x0 - mean) * rstd * l0 + m0; x1 = (x1 - mean) * rstd * l1 + m1; }
                    const pg8::f32x4 a0 = acc[ai][bj][m][0], a1 = acc[ai][bj][m][1];
                    u32x4 o; o.x = pk2(ALPHA * x0.x + g0.x * a0[0], ALPHA * x0.y + g0.y * a0[1]); o.y = pk2(ALPHA * x0.z + g0.z * a0[2], ALPHA * x0.w + g0.w * a0[3]);
                    o.z = pk2(ALPHA * x1.x + g1.x * a1[0], ALPHA * x1.y + g1.y * a1[1]); o.w = pk2(ALPHA * x1.z + g1.z * a1[2], ALPHA * x1.w + g1.w * a1[3]);
                    bf16* dp = DST_FIN ? dst_fin + (size_t)row * D + col : dst_lat + off;
                    *(u32x4*)dp = o;
                }
        }
    }
};

__device__ __forceinline__ void transpose_item(const float* __restrict__ W, int K, int N, bf16* WT, float* scr, int item, int lane) {
    const int nblk = N / 32, kb = item / nblk, nb = item % nblk, k0 = 64 * kb, n0 = 32 * nb;
#pragma unroll 8
    for (int i = 0; i < 32; ++i) { const int kk = 2 * i + (lane >> 5); scr[kk * 33 + (lane & 31)] = W[(size_t)(k0 + kk) * N + n0 + (lane & 31)]; }
    asm volatile("s_waitcnt lgkmcnt(0)" ::: "memory");
    const int c = lane & 7;
#pragma unroll
    for (int j = 0; j < 4; ++j) { const int n = (lane >> 3) + 8 * j; const float* s = scr + (8 * c) * 33 + n;
        u32x4 o; o.x = pk2(s[0 * 33], s[1 * 33]); o.y = pk2(s[2 * 33], s[3 * 33]); o.z = pk2(s[4 * 33], s[5 * 33]); o.w = pk2(s[6 * 33], s[7 * 33]);
        *(u32x4*)(WT + (size_t)(n0 + n) * K + k0 + 8 * c) = o; }
    asm volatile("s_waitcnt lgkmcnt(0)" ::: "memory");
}

template <bool LAST, bool SKIPCTX>
__device__ __forceinline__ void ln_phase(float* rst, const bf16* vlat, const bf16* vctx, const bf16* vfin, float* outp, const float* __restrict__ g, const float* __restrict__ bt, const float* __restrict__ modn, bf16* H, int gw, int NGW, int lane) {
    int r = gw;
    if (SKIPCTX) { while (r < R) { const int p = r >= TP ? r - TP : r; if (p >= L) break; r += NGW; } }
    u32x4 vn[2];
    if (r < R) { bool isc; int b; const size_t off = row_off(r, isc, b); const bf16* xr = LAST ? vfin + (size_t)r * D : (isc ? vctx : vlat) + off;
#pragma unroll
        for (int j = 0; j < 2; ++j) vn[j] = *(const u32x4*)(xr + lane * 8 + 512 * j); }
    while (r < R) {
        bool isc; int b; const size_t off = row_off(r, isc, b);
        float v[16];
#pragma unroll
        for (int j = 0; j < 2; ++j)
#pragma unroll
            for (int i = 0; i < 4; ++i) { v[j * 8 + 2 * i] = bflo(vn[j][i]); v[j * 8 + 2 * i + 1] = bfhi(vn[j][i]); }
        int rn = r + NGW;
        if (SKIPCTX) { while (rn < R) { const int p = rn >= TP ? rn - TP : rn; if (p >= L) break; rn += NGW; } }
        if (rn < R) { bool isc2; int b2; const size_t off2 = row_off(rn, isc2, b2); const bf16* xr2 = LAST ? vfin + (size_t)rn * D : (isc2 ? vctx : vlat) + off2;
#pragma unroll
            for (int j = 0; j < 2; ++j) vn[j] = *(const u32x4*)(xr2 + lane * 8 + 512 * j); }
        float s = 0.f;
#pragma unroll
        for (int i = 0; i < 16; ++i) s += v[i];
        const float mean = wave_sum(s) * (1.f / D); float s2 = 0.f;
#pragma unroll
        for (int i = 0; i < 16; ++i) { v[i] -= mean; s2 += v[i] * v[i]; }
        const float rstd = 1.f / sqrtf(wave_sum(s2) * (1.f / D) + 1e-5f);
        const float* md = modn + (isc ? 2 : b) * 6144;
        if (!LAST && lane == 0) { rst[2 * r] = mean; rst[2 * r + 1] = rstd; }
#pragma unroll
        for (int j = 0; j < 2; ++j) {
            const int idx = lane * 8 + 512 * j;
            float y[8];
#pragma unroll
            for (int q = 0; q < 2; ++q) { const f32x4 gg = *(const f32x4*)(g + idx + 4 * q), bb = *(const f32x4*)(bt + idx + 4 * q);
#pragma unroll
                for (int i = 0; i < 4; ++i) y[q * 4 + i] = v[j * 8 + q * 4 + i] * rstd * gg[i] + bb[i]; }
            if (LAST) { *(f32x4*)(outp + off + idx) = (f32x4){y[0], y[1], y[2], y[3]}; *(f32x4*)(outp + off + idx + 4) = (f32x4){y[4], y[5], y[6], y[7]}; }
            else {
                float h[8];
#pragma unroll
                for (int q = 0; q < 2; ++q) { const f32x4 sh = *(const f32x4*)(md + idx + 4 * q), sc = *(const f32x4*)(md + 1024 + idx + 4 * q);
#pragma unroll
                    for (int i = 0; i < 4; ++i) h[q * 4 + i] = y[q * 4 + i] * (sc[i] + 1.f) + sh[i]; }
                u32x4 o; o.x = pk2(h[0], h[1]); o.y = pk2(h[2], h[3]); o.z = pk2(h[4], h[5]); o.w = pk2(h[6], h[7]);
                *(u32x4*)(H + (size_t)r * D + idx) = o;
            }
        }
        r = rn;
    }
}

__device__ __forceinline__ float log_sigmoid(float z) { return fminf(z, 0.f) - __logf(1.f + __expf(-fabsf(z))); }

constexpr int CS = 65;
constexpr float QSC = 0.125f * 1.4426950408889634f;
struct GatePre { u32x2 lr; f32x4 w; float bias; };
__device__ __forceinline__ GatePre gate_prefetch(int g, int h, const bf16* Pr, const float* gkw, const float* gkb, int tid) {
    GatePre p; p.lr = (u32x2){0u, 0u}; p.w = (f32x4){0.f, 0.f, 0.f, 0.f}; p.bias = 0.f;
    if (g) { const int c = tid >> 3, part = tid & 7;
        p.lr = *(const u32x2*)(Pr + (size_t)c * NPROJ + 3072 + part * 4);
        const int idx = tid * 4, dir = idx >> 10, r = (idx >> 6) & 15, d = idx & 63;
        p.w = *(const f32x4*)(gkw + (dir * 16 + r) * 256 + h * 64 + d);
        if (tid < 128) p.bias = gkb[(tid >> 6) * 256 + h * 64 + (tid & 63)]; }
    return p;
}
__device__ __forceinline__ void fill_cum3(float* cf, float* cb, float* lrs, float* wl, int g, int h, const GatePre& gp, const float* theta, int tid) {
    if (g == 0) {
        const float lgf = log1pf(-expf(theta[h])), lgb = log1pf(-expf(theta[4 + h]));
        for (int i = tid; i < 4096; i += 512) { const int c = i >> 6, d = i & 63; cf[c * CS + d] = (float)(c + 1) * lgf; cb[c * CS + d] = (float)(64 - c) * lgb; }
        __syncthreads();
        return;
    }
    { const int c = tid >> 3, part = tid & 7;
      float* lp = lrs + c * 33 + part * 4; lp[0] = bflo(gp.lr.x); lp[1] = bfhi(gp.lr.x); lp[2] = bflo(gp.lr.y); lp[3] = bfhi(gp.lr.y);
      *(f32x4*)(wl + tid * 4) = gp.w;
      if (tid < 128) wl[2048 + tid] = gp.bias; }
    __syncthreads();
    { const int c = tid >> 3, dg = tid & 7;
#pragma unroll
      for (int dir = 0; dir < 2; ++dir) {
          f32x4 za = *(const f32x4*)(wl + 2048 + dir * 64 + dg * 8), zb = *(const f32x4*)(wl + 2048 + dir * 64 + dg * 8 + 4);
#pragma unroll
          for (int r = 0; r < 16; ++r) { const float lv = lrs[c * 33 + dir * 16 + r];
              za += lv * *(const f32x4*)(wl + (dir * 16 + r) * 64 + dg * 8); zb += lv * *(const f32x4*)(wl + (dir * 16 + r) * 64 + dg * 8 + 4); }
          float* dst = (dir ? cb : cf) + c * CS + dg * 8;
#pragma unroll
          for (int j = 0; j < 4; ++j) { dst[j] = log_sigmoid(za[j]) * (1.f / 16.f); dst[4 + j] = log_sigmoid(zb[j]) * (1.f / 16.f); } } }
    __syncthreads();
    if (tid < 128) {
        const int dir = tid >> 6; float* arr = (dir ? cb : cf) + (tid & 63);
        float run = 0.f;
#pragma unroll
        for (int hh = 0; hh < 2; ++hh) {
            float v[32];
            const int base = dir ? (1 - hh) * 32 : hh * 32;
#pragma unroll
            for (int c = 0; c < 32; ++c) v[c] = arr[(base + c) * CS];
            if (dir == 0) {
#pragma unroll
                for (int c = 0; c < 32; ++c) { run += v[c]; arr[(base + c) * CS] = run; }
            } else {
#pragma unroll
                for (int c = 31; c >= 0; --c) { run += v[c]; arr[(base + c) * CS] = run; }
            }
        }
    }
    __syncthreads();
}

__device__ __forceinline__ void fast_bar(unsigned* ctr, unsigned& target) {
    asm volatile("s_waitcnt vmcnt(0)" ::: "memory");
    __syncthreads();
    target += gridDim.x;
    if (threadIdx.x == 0) {
        __builtin_amdgcn_fence(__ATOMIC_RELEASE, "agent");
        asm volatile("s_waitcnt vmcnt(0)" ::: "memory");
        __hip_atomic_fetch_add(ctr, 1u, __ATOMIC_RELAXED, __HIP_MEMORY_SCOPE_AGENT);
        while (__hip_atomic_load(ctr, __ATOMIC_RELAXED, __HIP_MEMORY_SCOPE_AGENT) < target) __builtin_amdgcn_s_sleep(1);
        __builtin_amdgcn_fence(__ATOMIC_ACQUIRE, "agent");
        asm volatile("s_waitcnt vmcnt(0)" ::: "memory");
    }
    __syncthreads();
}
#define RLX_AGENT __ATOMIC_RELAXED, __HIP_MEMORY_SCOPE_AGENT
#define XB_TMO      128
#define XB_XCNT(j)  (256  + 64 * (j))
#define XB_XSUB(j)  (1280 + 64 * (j))
#define XB_XGEN(j)  (2304 + 64 * (j))
#define XB_TOP      3328
#define XB_TOPGEN   3392
#define XCD_BAR_WORDS 3456
#define XB_SPIN_CAP (1u << 18)

__device__ __forceinline__ unsigned xb_ld(unsigned* p)              { return __hip_atomic_load(p, __ATOMIC_RELAXED, __HIP_MEMORY_SCOPE_AGENT); }
__device__ __forceinline__ unsigned xb_add(unsigned* p, unsigned v) { return __hip_atomic_fetch_add(p, v, __ATOMIC_RELAXED, __HIP_MEMORY_SCOPE_AGENT); }
__device__ __forceinline__ unsigned xb_xcc_id() { return (unsigned)__builtin_amdgcn_s_getreg((3 << 11) | 20) & 0xFu; }
#define XB_SPIN(cond, bar) do { unsigned _sp = 0; while (cond) { __builtin_amdgcn_s_sleep(1); \
    if ((++_sp & 255u) == 0u) { if (xb_ld(&(bar)[XB_TMO])) break; if (_sp > XB_SPIN_CAP) { atomicAdd(&(bar)[XB_TMO], 1u); break; } } } } while (0)

struct XcdBarrier {
    unsigned* bar; unsigned x;
    volatile unsigned* st;
};

__device__ __forceinline__ XcdBarrier xcd_barrier_post(unsigned* bar, volatile unsigned* st) {
    XcdBarrier b; b.bar = bar; b.x = xb_xcc_id(); b.st = st;
    if (threadIdx.x == 0) (void)xb_add(&bar[XB_XCNT(b.x)], 1u);
    return b;
}
__device__ __forceinline__ void xcd_barrier_complete(unsigned* bar, unsigned x, unsigned& nloc, unsigned& nx) {
    const unsigned G = gridDim.x * gridDim.y * gridDim.z;
    unsigned sum, cnt, mine, sp = 0u;
    for (;;) {
        sum = 0u; cnt = 0u; mine = 0u;
#pragma unroll
        for (unsigned j = 0; j < 16; ++j) { const unsigned c = xb_ld(&bar[XB_XCNT(j)]); sum += c; cnt += (c > 0u) ? 1u : 0u; mine = (j == x) ? c : mine; }
        if (sum == G) break;
        __builtin_amdgcn_s_sleep(1);
        if ((++sp & 255u) == 0u) { if (xb_ld(&bar[XB_TMO])) break; if (sp > XB_SPIN_CAP) { atomicAdd(&bar[XB_TMO], 1u); break; } }
    }
    nloc = mine > 0u ? mine : 1u; nx = cnt > 0u ? cnt : 1u;
}

__device__ __forceinline__ void xcd_barrier(const XcdBarrier& b) {
    asm volatile("s_waitcnt vmcnt(0)" ::: "memory");
    __syncthreads();
    if (threadIdx.x == 0) {
        unsigned* bar = b.bar;
        __builtin_amdgcn_s_waitcnt(0);
        unsigned nloc = b.st[0], nx = b.st[1];
        if (nloc == 0u) { xcd_barrier_complete(bar, b.x, nloc, nx); b.st[0] = nloc; b.st[1] = nx; }
        const unsigned old = xb_add(&bar[XB_XSUB(b.x)], 1u);
        const unsigned gen = old / nloc;
        if (old + 1u == (gen + 1u) * nloc) {
            __builtin_amdgcn_fence(__ATOMIC_RELEASE, "agent");
            asm volatile("s_waitcnt vmcnt(0)" ::: "memory");
            const unsigned og = xb_add(&bar[XB_TOP], 1u);
            const unsigned tg = og / nx;
            if (og + 1u == (tg + 1u) * nx) xb_add(&bar[XB_TOPGEN], 1u);
            else XB_SPIN(xb_ld(&bar[XB_TOPGEN]) == tg, bar);
            __builtin_amdgcn_fence(__ATOMIC_ACQUIRE, "agent");
            xb_add(&bar[XB_XGEN(b.x)], 1u);
            asm volatile("s_waitcnt vmcnt(0)" ::: "memory");
        } else {
            XB_SPIN(xb_ld(&bar[XB_XGEN(b.x)]) == gen, bar);
            __builtin_amdgcn_fence(__ATOMIC_ACQUIRE, "agent");
            asm volatile("s_waitcnt vmcnt(0)" ::: "memory");
        }
    }
    __syncthreads();
}

struct LatOrder {
    pg8::StaticOrder S;
    __device__ void init(int N, int G, int c) { S.init(NB * T, N, G, c); }
    __device__ bool next(int i, pg8::Unit& u) const { if (!S.next(i, u)) return false; u.pm = u.pm + 1 + (u.pm >= 32 ? 1 : 0); return true; }
    __device__ __forceinline__ void a_ready(const pg8::Unit&) const {}
    __device__ __forceinline__ void done(const pg8::Unit&) const {}
};
#ifndef PROBE_SEL
#define PROBE_SEL 0
#endif
#ifndef PROBE_MUL
#define PROBE_MUL 3
#endif
#define PACC_DECL unsigned long long pacc = 0, pacc_t0 = 0; (void)pacc; (void)pacc_t0;
#define PACC_BEGIN(k) if (PROBE_SEL == (k)) pacc_t0 = __builtin_amdgcn_s_memrealtime();
#define PACC_END(k) if (PROBE_SEL == (k)) pacc += __builtin_amdgcn_s_memrealtime() - pacc_t0;
#define PACC_SLEEP() if (PROBE_SEL >= 40 && PROBE_SEL < 60) { const unsigned long long t1 = __builtin_amdgcn_s_memrealtime(), dt = pacc * PROBE_MUL; while (__builtin_amdgcn_s_memrealtime() - t1 < dt) __builtin_amdgcn_s_sleep(8); }
#define PROBE_BEGIN(k) unsigned long long pt0_##k = 0; if (PROBE_SEL == (k)) pt0_##k = __builtin_amdgcn_s_memrealtime();
#define PROBE_END(k) if (PROBE_SEL == (k)) { const unsigned long long t1 = __builtin_amdgcn_s_memrealtime(), dt = (t1 - pt0_##k) * PROBE_MUL; while (__builtin_amdgcn_s_memrealtime() - t1 < dt) __builtin_amdgcn_s_sleep(8); }


template <int XT, int YT>
__device__ __forceinline__ void frag_gemm(pg8::f32x4 (&acc)[XT][YT], const bf16* X, int ldx, const bf16* Y, int ldy, int k0, int k1, int l15, int quad) {
#pragma unroll 4
    for (int k = k0; k < k1; k += 32) {
        bf16x8 xf[XT], yf[YT];
#pragma unroll
        for (int i = 0; i < XT; ++i) xf[i] = *(const bf16x8*)(X + (size_t)(i * 16 + l15) * ldx + k + quad * 8);
#pragma unroll
        for (int j = 0; j < YT; ++j) yf[j] = *(const bf16x8*)(Y + (size_t)(j * 16 + l15) * ldy + k + quad * 8);
#pragma unroll
        for (int i = 0; i < XT; ++i)
#pragma unroll
            for (int j = 0; j < YT; ++j) acc[i][j] = MFMA16(xf[i], yf[j], acc[i][j]);
    }
}
template <bool SRC_LN>
__device__ __forceinline__ void ctx_resid_tiles(const bf16* A, const bf16* Bt, int K, const void* src_ctx, bf16* dst_ctx, const float* gate_ctx, const float* rst, const float* lg, const float* lb, float* part, int bid, int G, int tid, int wave, int l15, int quad) {
    for (int t = bid; t < 256; t += G) {
        const int rt = t >> 5, c0 = (t & 31) * 32, b = rt >> 2, p0 = (rt & 3) * 64, r0 = b * TP + p0;
        pg8::f32x4 acc[4][2];
#pragma unroll
        for (int i = 0; i < 4; ++i)
#pragma unroll
            for (int j = 0; j < 2; ++j) acc[i][j] = (pg8::f32x4){0.f, 0.f, 0.f, 0.f};
        const int ksl = K >> 3;
        frag_gemm<4, 2>(acc, A + (size_t)r0 * K, K, Bt + (size_t)c0 * K, K, wave * ksl, (wave + 1) * ksl, l15, quad);
        float* pw = part + wave * 2048;
#pragma unroll
        for (int i = 0; i < 4; ++i)
#pragma unroll
            for (int j = 0; j < 2; ++j)
#pragma unroll
                for (int rg = 0; rg < 4; ++rg) pw[(i * 16 + quad * 4 + rg) * 32 + j * 16 + l15] = acc[i][j][rg];
        __syncthreads();
        { const int row = tid >> 3, c4 = (tid & 7) * 4;
          f32x4 sum = *(const f32x4*)(part + row * 32 + c4);
#pragma unroll
          for (int w = 1; w < 8; ++w) sum += *(const f32x4*)(part + w * 2048 + row * 32 + c4);
          const size_t off = (size_t)(b * L + p0 + row) * D + c0 + c4;
          f32x4 x4; const f32x4 g4 = *(const f32x4*)(gate_ctx + c0 + c4);
          if (!SRC_LN) x4 = *(const f32x4*)((const float*)src_ctx + off);
          else { const int rU = r0 + row; const u32x2 w = *(const u32x2*)((const bf16*)src_ctx + off); x4 = (f32x4){bflo(w.x), bfhi(w.x), bflo(w.y), bfhi(w.y)};
              x4 = (x4 - rst[2 * rU]) * rst[2 * rU + 1] * *(const f32x4*)(lg + c0 + c4) + *(const f32x4*)(lb + c0 + c4); }
          const f32x4 vv = x4 * ALPHA + g4 * sum; u32x2 o; o.x = pk2(vv.x, vv.y); o.y = pk2(vv.z, vv.w);
          *(u32x2*)(dst_ctx + off) = o; }
        __syncthreads();
    }
}
__device__ __forceinline__ void ctx_up_tiles(const bf16* A, const bf16* Bt, bf16* O, int bid, int G, int wave, int l15, int quad) {
    for (int t = bid; t < 256; t += G) {
        const int rt = t >> 5, c0 = (t & 31) * 128 + (wave & 3) * 32, b = rt >> 2, r0 = b * TP + (rt & 3) * 64 + (wave >> 2) * 32;
        pg8::f32x4 acc[2][2];
#pragma unroll
        for (int i = 0; i < 2; ++i)
#pragma unroll
            for (int j = 0; j < 2; ++j) acc[i][j] = (pg8::f32x4){0.f, 0.f, 0.f, 0.f};
        frag_gemm<2, 2>(acc, Bt + (size_t)c0 * D, D, A + (size_t)r0 * D, D, 0, D, l15, quad);
#pragma unroll
        for (int i = 0; i < 2; ++i)
#pragma unroll
            for (int j = 0; j < 2; ++j) { float v[4];
#pragma unroll
                for (int rg = 0; rg < 4; ++rg) { const float a_ = fmaxf(acc[i][j][rg], 0.f); v[rg] = a_ * a_; }
                u32x2 o; o.x = pk2(v[0], v[1]); o.y = pk2(v[2], v[3]);
                *(u32x2*)(O + (size_t)(r0 + j * 16 + l15) * FF + c0 + i * 16 + quad * 4) = o; }
    }
}

template <int ACT>
__device__ __forceinline__ void ctx_ksplit_tiles(const bf16* A, const bf16* Bt, bf16* O, int ldo, int ntn, int ncols, float* part, int bid, int G, int tid, int wave, int l15, int quad) {
    for (int t = bid; t < 8 * ntn; t += G) {
        const int rt = t / ntn, c0 = (t % ntn) * 64, b = rt >> 2, r0 = b * TP + (rt & 3) * 64;
        pg8::f32x4 acc[4][4];
#pragma unroll
        for (int i = 0; i < 4; ++i)
#pragma unroll
            for (int j = 0; j < 4; ++j) acc[i][j] = (pg8::f32x4){0.f, 0.f, 0.f, 0.f};
        frag_gemm<4, 4>(acc, A + (size_t)r0 * D, D, Bt + (size_t)c0 * D, D, wave * 128, (wave + 1) * 128, l15, quad);
        float* pw = part + wave * 4096;
#pragma unroll
        for (int i = 0; i < 4; ++i)
#pragma unroll
            for (int j = 0; j < 4; ++j)
#pragma unroll
                for (int rg = 0; rg < 4; ++rg) pw[(i * 16 + quad * 4 + rg) * 64 + j * 16 + l15] = acc[i][j][rg];
        __syncthreads();
        { const int row = tid >> 3, c8 = (tid & 7) * 8;
          f32x4 s0 = *(const f32x4*)(part + row * 64 + c8), s1 = *(const f32x4*)(part + row * 64 + c8 + 4);
#pragma unroll
          for (int w = 1; w < 8; ++w) { s0 += *(const f32x4*)(part + w * 4096 + row * 64 + c8); s1 += *(const f32x4*)(part + w * 4096 + row * 64 + c8 + 4); }
          if (ACT == 1) {
#pragma unroll
              for (int k = 0; k < 4; ++k) { float a_ = fmaxf(s0[k], 0.f), b_ = fmaxf(s1[k], 0.f); s0[k] = a_ * a_; s1[k] = b_ * b_; } }
          u32x4 o; o.x = pk2(s0.x, s0.y); o.y = pk2(s0.z, s0.w); o.z = pk2(s1.x, s1.y); o.w = pk2(s1.z, s1.w);
          const int col = c0 + c8;
          if (col < ncols) *(u32x4*)(O + (size_t)(r0 + row) * ldo + col) = o; }
        __syncthreads();
    }
}

struct Args { const float* in[19]; float* out; unsigned char* ws; };

__global__ void __launch_bounds__(512, 2) fwd_kernel(Args a) {
    extern __shared__ __attribute__((aligned(16))) unsigned char lds[];
    cg::grid_group grid = cg::this_grid();
    const int G = gridDim.x, bid = blockIdx.x, NGW = G * 8;
#define IDS int tid = threadIdx.x; asm volatile("" : "+v"(tid)); const int lane = tid & 63, wave = __builtin_amdgcn_readfirstlane(tid >> 6), quad = lane >> 4, l15 = lane & 15, gw = bid * 8 + wave; (void)quad; (void)l15; (void)gw; (void)lane;
#define xin (a.in[0])
#define cvec (a.in[1])
#define ctx (a.in[2])
#define cctx (a.in[3])
#define w_mod (a.in[4])
#define b_mod (a.in[5])
#define ln_g (a.in[6])
#define ln_b (a.in[7])
#define theta (a.in[11])
#define gkw (a.in[12])
#define gkb (a.in[13])
#define normg (a.in[14])
#define sink (a.in[17])
#define WIN_T ((bf16*)(a.ws + OFF_WIN))
#define WOUT0_T ((bf16*)(a.ws + OFF_WOUT0))
#define W1_0_T ((bf16*)(a.ws + OFF_W1_0))
#define W2_0_T ((bf16*)(a.ws + OFF_W2_0))
#define WQKV_T ((bf16*)(a.ws + OFF_WQKV))
#define WOUT1_T ((bf16*)(a.ws + OFF_WOUT1))
#define W1_1_T ((bf16*)(a.ws + OFF_W1_1))
#define W2_1_T ((bf16*)(a.ws + OFF_W2_1))
#define mod ((float*)(a.ws + OFF_MOD))
#define rope ((float*)(a.ws + OFF_ROPE))
#define xctx ((float*)(a.ws + OFF_XCTX))
#define DEC ((float*)(a.ws + OFF_DEC))
#define H ((bf16*)(a.ws + OFF_H))
#define P ((bf16*)(a.ws + OFF_P))
#define ST ((bf16*)(a.ws + OFF_ST))
#define xlat (a.out)
#define RST(i) ((float*)(a.ws + OFF_RST) + (size_t)(i) * R * 2)
#define VLAT ((bf16*)a.out)
#define VCTX ((bf16*)(a.ws + OFF_XCTX))

#define LATE_ITEMS 9472
#define LATE_CHUNK 16
#define DRAIN_LATE(scr_, maxc_) do { int nclaim_ = 0; unsigned* qc_ = (unsigned*)(a.ws + OFF_XBAR) + 3584; volatile unsigned* qw_ = (volatile unsigned*)(lds + 131072 + 1024); \
        for (;;) { if (nclaim_++ >= (maxc_)) break; if (tid == 0) qw_[0] = __hip_atomic_fetch_add(qc_, (unsigned)LATE_CHUNK, __ATOMIC_RELAXED, __HIP_MEMORY_SCOPE_AGENT);     \
            __syncthreads(); const int base_ = (int)__builtin_amdgcn_readfirstlane(qw_[0]); __syncthreads(); \
            if (base_ >= LATE_ITEMS) break; \
            for (int k_ = wave; k_ < LATE_CHUNK; k_ += 8) { int r_ = base_ + k_; if (r_ >= LATE_ITEMS) break; \
                if (r_ < 2048) { transpose_item(a.in[8], 1024, FF, W1_0_T, (scr_), r_, lane); continue; } r_ -= 2048; \
                if (r_ < 2048) { transpose_item(a.in[9], FF, 1024, W2_0_T, (scr_), r_, lane); continue; } r_ -= 2048; \
                if (r_ < 768) { transpose_item(a.in[16], 1024, NQKV, WQKV_T, (scr_), r_, lane); continue; } r_ -= 768; \
                if (r_ < 512) { transpose_item(a.in[18], 1024, 1024, WOUT1_T, (scr_), r_, lane); continue; } r_ -= 512; \
                if (r_ < 2048) { transpose_item(a.in[8] + (size_t)1024 * FF, 1024, FF, W1_1_T, (scr_), r_, lane); continue; } r_ -= 2048; \
                transpose_item(a.in[9] + (size_t)FF * 1024, FF, 1024, W2_1_T, (scr_), r_, lane); } } } while (0)
    PG8_LAS unsigned char* ldsg = (PG8_LAS unsigned char*)lds;
    unsigned* barw = (unsigned*)(a.ws + OFF_BAR); unsigned bar_target = 0u; (void)barw; (void)bar_target;
    unsigned* xbw = (unsigned*)(a.ws + OFF_XBAR);
    volatile unsigned* xst = (volatile unsigned*)(lds + 131072 + 512);
    if (threadIdx.x == 0) { xst[0] = 0u; xst[1] = 0u; }
    XcdBarrier xbar = xcd_barrier_post(xbw, xst);
    if (a.ws == nullptr) grid.sync();

PROBE_BEGIN(1)
    { IDS
        float* sl = (float*)lds; float* red = (float*)(lds + 12288);
        for (int item = bid; item < 192; item += G) {
            for (int i = tid; i < 3072; i += 512) { const int j = i >> 10, k = i & 1023; const float v = (j < 2) ? cvec[j * 1024 + k] : cctx[k]; sl[i] = v / (1.f + expf(-v)); }
            __syncthreads();
            const int layer = item / 96, n0 = (item % 96) * 64;
            const float* W = w_mod + (size_t)layer * 1024 * 6144 + n0 + lane;
            float a0 = 0.f, a1 = 0.f, a2 = 0.f; const int k0 = wave * 128;
#pragma unroll 8
            for (int kk = 0; kk < 128; ++kk) { const int k = k0 + kk; const float w = W[(size_t)k * 6144]; a0 += sl[k] * w; a1 += sl[1024 + k] * w; a2 += sl[2048 + k] * w; }
            red[(wave * 3 + 0) * 64 + lane] = a0; red[(wave * 3 + 1) * 64 + lane] = a1; red[(wave * 3 + 2) * 64 + lane] = a2;
            __syncthreads();
            if (tid < 192) { const int j = tid >> 6, col = tid & 63; float s = b_mod[layer * 6144 + n0 + col];
#pragma unroll
                for (int w = 0; w < 8; ++w) s += red[(w * 3 + j) * 64 + col];
                mod[(layer * 3 + j) * 6144 + n0 + col] = s; }
            __syncthreads();
        }
        if (bid == G - 1 && tid < 16) {
            double f = 1.0; for (int i = 0; i < tid; ++i) f *= 0.56234132519034908;
            const double x2 = f * f; double cs = 1.0, sn = f, tc = 1.0, ts = f;
            for (int n = 1; n <= 12; ++n) { tc *= -x2 / (double)((2 * n - 1) * (2 * n)); cs += tc; ts *= -x2 / (double)((2 * n) * (2 * n + 1)); sn += ts; }
            double c = 1.0, s = 0.0;
            for (int p = 0; p < 128; ++p) { rope[(p * 16 + tid) * 2] = (float)c; rope[(p * 16 + tid) * 2 + 1] = (float)s; const double nc = c * cs - s * sn; s = s * cs + c * sn; c = nc; }
        }
        float* scr = (float*)(lds + 32768 + wave * 8448);
        for (int it = gw; it < 2064; it += NGW) {
            int r = it;
            if (r < 1552) { transpose_item(a.in[10], 1024, NPROJ, WIN_T, scr, r, lane); continue; } r -= 1552;
            transpose_item(a.in[15], 1024, 1024, WOUT0_T, scr, r, lane);
        }
        { u32x4* z = (u32x4*)(WIN_T + (size_t)NPROJ * D); const u32x4 zero = {0u, 0u, 0u, 0u};
          for (int i = bid * 512 + tid; i < (NPROJ_PAD - NPROJ) * D / 8; i += G * 512) z[i] = zero; }
    }
PROBE_END(1)
    xcd_barrier(xbar);


PROBE_BEGIN(2)
    { IDS
    for (int r = gw; r < R; r += 2 * NGW) {
        const int r2 = r + NGW; const bool has2 = r2 < R;
        bool isc, isc2; int b, b2; const size_t off = row_off(r, isc, b), off2 = row_off(has2 ? r2 : r, isc2, b2);
        const float* xr = (isc ? ctx : xin) + off; const float* md = mod + (isc ? 2 : b) * 6144;
        const float* xr2 = (isc2 ? ctx : xin) + off2; const float* md2 = mod + (isc2 ? 2 : b2) * 6144;
        f32x4 va[4], vb[4];
#pragma unroll
        for (int j = 0; j < 4; ++j) { va[j] = *(const f32x4*)(xr + lane * 4 + 256 * j); vb[j] = *(const f32x4*)(xr2 + lane * 4 + 256 * j); }
#pragma unroll
        for (int j = 0; j < 4; ++j) {
            const int idx = lane * 4 + 256 * j;
            { const f32x4 sh = *(const f32x4*)(md + idx), sc = *(const f32x4*)(md + 1024 + idx);
              const f32x4 h = va[j] * (sc + 1.f) + sh; u32x2 o; o.x = pk2(h.x, h.y); o.y = pk2(h.z, h.w);
              *(u32x2*)(H + (size_t)r * D + idx) = o; }
            if (has2) { const f32x4 sh = *(const f32x4*)(md2 + idx), sc = *(const f32x4*)(md2 + 1024 + idx);
              const f32x4 h = vb[j] * (sc + 1.f) + sh; u32x2 o; o.x = pk2(h.x, h.y); o.y = pk2(h.z, h.w);
              *(u32x2*)(H + (size_t)r2 * D + idx) = o; }
        }
    }
    }
PROBE_END(2)
    xcd_barrier(xbar);
    if (PROBE_SEL == 10) { for (int i = 0; i < 10; ++i) xcd_barrier(xbar); }

PROBE_BEGIN(8)
    { pg8::Gemm g{H, WIN_T, R, NPROJ_PAD, D}; pg8::StaticOrder S; S.init(R, NPROJ_PAD, G, bid); EpiStore<0> E{P, NPROJ, NPROJ};
      pg8::gemm_phase<EpiStore<0>, pg8::StaticOrder, true, true>(ldsg, g, S, E); }
PROBE_END(8)
    xcd_barrier(xbar);

PROBE_BEGIN(3)
#ifndef NO_P3
    { IDS
        float* cf = (float*)lds; float* cb = (float*)(lds + 16640); float* lrs = (float*)(lds + 33280); float* wl = (float*)(lds + 41728);
        bf16* kTf = (bf16*)(lds + 50432); bf16* kTb = (bf16*)(lds + 59648); bf16* vT = (bf16*)(lds + 68864);
        constexpr int NU = NB * 2 * 4 * NCH;
        const int s = tid & 63, dc = tid >> 6;
        u32x4 kv = {0u, 0u, 0u, 0u}, vv0 = kv, vv1 = kv; GatePre gp; gp.lr = (u32x2){0u, 0u}; gp.w = (f32x4){0.f, 0.f, 0.f, 0.f}; gp.bias = 0.f;
#define P3_LOAD(U) do { const int pc_ = (U) % NCH, t_ = (U) / NCH, h_ = t_ & 3, g_ = 1 - (t_ >> 3), b_ = (t_ >> 2) & 1; const bf16* Pr_ = P + (size_t)(b_ * TP + pc_ * 64) * NPROJ; \
            const int kcol_ = g_ ? 1792 + h_ * 64 : 256 + h_ * 64, vcol_ = g_ ? 2048 + h_ * 128 : 512 + h_ * 128; \
            kv = *(const u32x4*)(Pr_ + (size_t)s * NPROJ + kcol_ + dc * 8); vv0 = *(const u32x4*)(Pr_ + (size_t)s * NPROJ + vcol_ + dc * 8); vv1 = *(const u32x4*)(Pr_ + (size_t)s * NPROJ + vcol_ + (dc + 8) * 8); \
            gp = gate_prefetch(g_, h_, Pr_, gkw, gkb, tid); } while (0)
        float* lgs = (float*)(lds + 131072 + 2048);
        if (tid < 8) lgs[tid] = log1pf(-expf(theta[tid]));
        __syncthreads();
        if (bid < NU) P3_LOAD(bid);
        for (int unit = bid; unit < NU; unit += G) {
            const int pc = unit % NCH, t = unit / NCH, h = t & 3, g = 1 - (t >> 3), b = (t >> 2) & 1;
            const float kscale = g ? 1.f : 0.125f;
            float lgf = 0.f, lgb = 0.f;
            if (g) fill_cum3(cf, cb, lrs, wl, g, h, gp, theta, tid);
            else { lgf = lgs[h]; lgb = lgs[4 + h]; }
            {
              if (g) {
#pragma unroll
              for (int j = 0; j < 8; ++j) { const int d = dc * 8 + j; const unsigned u = kv[j >> 1]; const float kf = ((j & 1) ? bfhi(u) : bflo(u)) * kscale;
                  kTf[d * 72 + s] = (bf16)f2bf(kf * __expf(cf[63 * CS + d] - cf[s * CS + d]));
                  kTb[d * 72 + s] = (bf16)f2bf(kf * __expf(cb[d] - cb[s * CS + d])); }
              } else { const float ef = __expf((float)(63 - s) * lgf) * kscale, eb = __expf((float)s * lgb) * kscale;
#pragma unroll
              for (int j = 0; j < 8; ++j) { const int d = dc * 8 + j; const unsigned u = kv[j >> 1]; const float kf = (j & 1) ? bfhi(u) : bflo(u);
                  kTf[d * 72 + s] = (bf16)f2bf(kf * ef); kTb[d * 72 + s] = (bf16)f2bf(kf * eb); }
              }
#pragma unroll
              for (int j = 0; j < 8; ++j) { const unsigned u0 = vv0[j >> 1], u1 = vv1[j >> 1];
                  vT[(dc * 8 + j) * 72 + s] = (bf16)((j & 1) ? (u0 >> 16) : (u0 & 0xffffu)); vT[((dc + 8) * 8 + j) * 72 + s] = (bf16)((j & 1) ? (u1 >> 16) : (u1 & 0xffffu)); }
            }
            const int seq0 = ((b * 2 + g) * 4 + h) * 2;
            const int nf = pc, nbk = (pc < 4) ? 3 - pc : 135 - pc;
            if (tid < 128) { const int dir = tid >> 6, d = tid & 63;
                DEC[((size_t)(seq0 + dir) * NCH + (dir ? nbk : nf)) * 64 + d] = g ? (dir ? expf(cb[d]) : expf(cf[63 * CS + d])) : expf(64.f * (dir ? lgb : lgf)); }
            if (unit + G < NU) P3_LOAD(unit + G);
            __syncthreads();
            bf16x8 bfr[2];
#pragma unroll
            for (int ks = 0; ks < 2; ++ks) bfr[ks] = *(const bf16x8*)(vT + (wave * 16 + l15) * 72 + ks * 32 + quad * 8);
#pragma unroll
            for (int dir = 0; dir < 2; ++dir) {
                const bf16* kT = dir ? kTb : kTf;
                bf16* dst = ST + ((size_t)(seq0 + dir) * NCH + (dir ? nbk : nf)) * 8192 + (size_t)(wave * 16 + l15) * 64;
#pragma unroll
                for (int dt = 0; dt < 4; ++dt) {
                    pg8::f32x4 acc = {0.f, 0.f, 0.f, 0.f};
#pragma unroll
                    for (int ks = 0; ks < 2; ++ks) { const bf16x8 af = *(const bf16x8*)(kT + (dt * 16 + l15) * 72 + ks * 32 + quad * 8); acc = MFMA16(af, bfr[ks], acc); }
                    u32x2 o; o.x = pk2(acc[0], acc[1]); o.y = pk2(acc[2], acc[3]);
                    *(u32x2*)(dst + dt * 16 + quad * 4) = o;
                }
            }
            __syncthreads();
        }
#undef P3_LOAD
        if ((NU - bid + G - 1) / G < (NU + G - 1) / G) DRAIN_LATE((float*)(lds + wave * 8448), 1);
    }
#endif
PROBE_END(3)
    xcd_barrier(xbar);

PROBE_BEGIN(4)
    { IDS
    for (int i = bid * 512 + tid; i < 32 * 4096; i += G * 512) {
        const int seq = i >> 12, pi = i & 4095, d = (2 * pi) & 63;
        unsigned* sp = (unsigned*)(ST + (size_t)seq * NCH * 8192) + pi; const float* dp = DEC + (size_t)seq * NCH * 64 + d;
        float s0 = 0.f, s1 = 0.f;
#pragma unroll 12
        for (int n = 0; n < NCH; ++n) {
            const unsigned kv = sp[(size_t)n * 4096]; const float d0 = dp[n * 64], d1 = dp[n * 64 + 1];
            sp[(size_t)n * 4096] = pk2(s0, s1);
            s0 = d0 * s0 + bflo(kv); s1 = d1 * s1 + bfhi(kv);
        }
    }
    }
PROBE_END(4)
    xcd_barrier(xbar);

PROBE_BEGIN(5)
#ifndef NO_P5
    { IDS
        float* cf = (float*)lds; float* cb = (float*)(lds + 16640); float* lrs = (float*)(lds + 33280); float* wl = (float*)(lds + 41728);
        bf16* qdf = (bf16*)(lds + 50432); bf16* kif = (bf16*)(lds + 59648); bf16* qdb = (bf16*)(lds + 68864); bf16* kib = (bf16*)(lds + 78080);
        bf16* vT = (bf16*)(lds + 87296); bf16* Am = (bf16*)(lds + 105728); float* red = (float*)(lds + 114944);
        constexpr int NU = NB * 2 * 4 * NCH;
        const int dcq = tid & 7, sq = tid >> 3, sv = tid & 63, dcv = tid >> 6;
        u32x4 qv = {0u, 0u, 0u, 0u}, kv = qv, vv0 = qv, vv1 = qv; GatePre gp; gp.lr = (u32x2){0u, 0u}; gp.w = (f32x4){0.f, 0.f, 0.f, 0.f}; gp.bias = 0.f;
#define P5_LOAD(U) do { const int pc_ = (U) % NCH, t_ = (U) / NCH, h_ = t_ & 3, g_ = 1 - (t_ >> 3), b_ = (t_ >> 2) & 1; const bf16* Pr_ = P + (size_t)(b_ * TP + pc_ * 64) * NPROJ; \
            const int qcol_ = g_ ? 1536 + h_ * 64 : h_ * 64, kcol_ = g_ ? 1792 + h_ * 64 : 256 + h_ * 64, vcol_ = g_ ? 2048 + h_ * 128 : 512 + h_ * 128; \
            qv = *(const u32x4*)(Pr_ + (size_t)sq * NPROJ + qcol_ + dcq * 8); kv = *(const u32x4*)(Pr_ + (size_t)sq * NPROJ + kcol_ + dcq * 8); \
            vv0 = *(const u32x4*)(Pr_ + (size_t)sv * NPROJ + vcol_ + dcv * 8); vv1 = *(const u32x4*)(Pr_ + (size_t)sv * NPROJ + vcol_ + (dcv + 8) * 8); \
            gp = gate_prefetch(g_, h_, Pr_, gkw, gkb, tid); } while (0)
        f32x4 ngv[4];
#pragma unroll
        for (int et = 0; et < 4; ++et) ngv[et] = *(const f32x4*)(normg + ((wave >> 2) * 4 + et) * 16 + quad * 4);
        float* lgs = (float*)(lds + 131072 + 2048);
        if (tid < 8) lgs[tid] = log1pf(-expf(theta[tid]));
        __syncthreads();
        if (bid < NU) P5_LOAD(bid);
        for (int unit = bid; unit < NU; unit += G) {
            const int pc = unit % NCH, t = unit / NCH, h = t & 3, g = 1 - (t >> 3), b = (t >> 2) & 1;
            const int r0 = b * TP + pc * 64;
            const int gcol = g ? 2560 + h * 128 : 1024 + h * 128;
            const float qscale = g ? 0.125f : 1.f, kscale = g ? 1.f : 0.125f;
            const int ct = wave & 3, eh = wave >> 2;
            const int seq0 = ((b * 2 + g) * 4 + h) * 2;
            const int nf = pc, nbk = (pc < 4) ? 3 - pc : 135 - pc;
            const bf16* Sf = ST + ((size_t)seq0 * NCH + nf) * 8192; const bf16* Sb = ST + ((size_t)(seq0 + 1) * NCH + nbk) * 8192;
            const int r = r0 + ct * 16 + l15;
            bf16x8 a2[4][2], a3[4][2]; u32x2 gv[4];
#pragma unroll
            for (int et = 0; et < 4; ++et) { const int e = (eh * 4 + et) * 16 + l15;
#pragma unroll
                for (int ks = 0; ks < 2; ++ks) { a2[et][ks] = *(const bf16x8*)(Sf + e * 64 + ks * 32 + quad * 8); a3[et][ks] = *(const bf16x8*)(Sb + e * 64 + ks * 32 + quad * 8); }
                gv[et] = *(const u32x2*)(P + (size_t)r * NPROJ + gcol + (eh * 4 + et) * 16 + quad * 4); }
            if (g) fill_cum3(cf, cb, lrs, wl, g, h, gp, theta, tid);
            { u32x4 o1, o2, o3, o4;
              if (g) {
#pragma unroll
              for (int j2 = 0; j2 < 4; ++j2) {
                  const int d = dcq * 8 + 2 * j2;
                  const float f0 = cf[sq * CS + d], f1 = cf[sq * CS + d + 1], b0 = cb[sq * CS + d], b1 = cb[sq * CS + d + 1];
                  const float q0 = bflo(qv[j2]) * qscale, q1 = bfhi(qv[j2]) * qscale, k0 = bflo(kv[j2]) * kscale, k1 = bfhi(kv[j2]) * kscale;
                  o1[j2] = pk2(q0 * __expf(f0), q1 * __expf(f1)); o2[j2] = pk2(k0 * __expf(-f0), k1 * __expf(-f1));
                  o3[j2] = pk2(q0 * __expf(b0), q1 * __expf(b1)); o4[j2] = pk2(k0 * __expf(-b0), k1 * __expf(-b1));
              }
              } else {
                  const float lgf = lgs[h], lgb = lgs[4 + h];
                  const float cfr = (float)(sq + 1) * lgf, cbr = (float)(64 - sq) * lgb;
                  const float ef = __expf(cfr) * qscale, eif = __expf(-cfr) * kscale, eb = __expf(cbr) * qscale, eib = __expf(-cbr) * kscale;
#pragma unroll
                  for (int j2 = 0; j2 < 4; ++j2) { const float q0 = bflo(qv[j2]), q1 = bfhi(qv[j2]), k0 = bflo(kv[j2]), k1 = bfhi(kv[j2]);
                      o1[j2] = pk2(q0 * ef, q1 * ef); o2[j2] = pk2(k0 * eif, k1 * eif); o3[j2] = pk2(q0 * eb, q1 * eb); o4[j2] = pk2(k0 * eib, k1 * eib); }
              }
              *(u32x4*)(qdf + sq * 72 + dcq * 8) = o1; *(u32x4*)(kif + sq * 72 + dcq * 8) = o2; *(u32x4*)(qdb + sq * 72 + dcq * 8) = o3; *(u32x4*)(kib + sq * 72 + dcq * 8) = o4;
#pragma unroll
              for (int j = 0; j < 8; ++j) { const unsigned u0 = vv0[j >> 1], u1 = vv1[j >> 1];
                  vT[(dcv * 8 + j) * 72 + sv] = (bf16)((j & 1) ? (u0 >> 16) : (u0 & 0xffffu)); vT[((dcv + 8) * 8 + j) * 72 + sv] = (bf16)((j & 1) ? (u1 >> 16) : (u1 & 0xffffu)); }
            }
            __syncthreads();
            { bf16x8 af[2], ab[2];
#pragma unroll
              for (int ks = 0; ks < 2; ++ks) { af[ks] = *(const bf16x8*)(qdf + (ct * 16 + l15) * 72 + ks * 32 + quad * 8); ab[ks] = *(const bf16x8*)(qdb + (ct * 16 + l15) * 72 + ks * 32 + quad * 8); }
#pragma unroll
              for (int i = 0; i < 2; ++i) { const int st = (wave >> 2) * 2 + i;
                  pg8::f32x4 accf = {0.f, 0.f, 0.f, 0.f}, accb = {0.f, 0.f, 0.f, 0.f};
#pragma unroll
                  for (int ks = 0; ks < 2; ++ks) {
                      const bf16x8 bf_ = *(const bf16x8*)(kif + (st * 16 + l15) * 72 + ks * 32 + quad * 8), bb_ = *(const bf16x8*)(kib + (st * 16 + l15) * 72 + ks * 32 + quad * 8);
                      accf = MFMA16(af[ks], bf_, accf); accb = MFMA16(ab[ks], bb_, accb); }
                  const int scol = st * 16 + l15;
#pragma unroll
                  for (int rg = 0; rg < 4; ++rg) { const int c = ct * 16 + quad * 4 + rg; Am[c * 72 + scol] = (bf16)f2bf(scol <= c ? accf[rg] : accb[rg]); }
              }
            }
            if (unit + G < NU) P5_LOAD(unit + G);
            __syncthreads();
            { bf16x8 bA[2], bQf[2], bQb[2];
#pragma unroll
              for (int ks = 0; ks < 2; ++ks) { const int o = (ct * 16 + l15) * 72 + ks * 32 + quad * 8; bA[ks] = *(const bf16x8*)(Am + o); bQf[ks] = *(const bf16x8*)(qdf + o); bQb[ks] = *(const bf16x8*)(qdb + o); }
              pg8::f32x4 acc[4]; float ss = 0.f;
#pragma unroll
              for (int et = 0; et < 4; ++et) { const int e = (eh * 4 + et) * 16 + l15;
                  pg8::f32x4 c4 = {0.f, 0.f, 0.f, 0.f};
#pragma unroll
                  for (int ks = 0; ks < 2; ++ks) {
                      const bf16x8 a1 = *(const bf16x8*)(vT + e * 72 + ks * 32 + quad * 8);
                      c4 = MFMA16(a1, bA[ks], c4); c4 = MFMA16(a2[et][ks], bQf[ks], c4); c4 = MFMA16(a3[et][ks], bQb[ks], c4); }
                  acc[et] = c4; ss += (c4[0] * c4[0] + c4[1] * c4[1]) + (c4[2] * c4[2] + c4[3] * c4[3]); }
              ss = quad_sum(ss);
              if (quad == 0) red[eh * 64 + ct * 16 + l15] = ss;
              __syncthreads();
              const float tot = red[ct * 16 + l15] + red[64 + ct * 16 + l15];
              const float rinv = 1.f / sqrtf(tot * (1.f / 128.f) + 1e-6f);
#pragma unroll
              for (int et = 0; et < 4; ++et) { const int e0 = (eh * 4 + et) * 16 + quad * 4;
                  float gt[4] = {bflo(gv[et].x), bfhi(gv[et].x), bflo(gv[et].y), bfhi(gv[et].y)}; float y[4];
#pragma unroll
                  for (int i = 0; i < 4; ++i) { const float ng = g ? ngv[et][i] : 1.f; const float sg = gt[i] * __builtin_amdgcn_rcpf(1.f + __expf(-gt[i])); y[i] = sg * acc[et][i] * rinv * ng; }
                  u32x2 o; o.x = pk2(y[0], y[1]); o.y = pk2(y[2], y[3]);
                  *(u32x2*)(H + (size_t)r * D + g * 512 + h * 128 + e0) = o; }
            }
            __syncthreads();
        }
#undef P5_LOAD
        if ((NU - bid + G - 1) / G < (NU + G - 1) / G) DRAIN_LATE((float*)(lds + wave * 8448), 2);
    }
#endif
PROBE_END(5)
    xcd_barrier(xbar);

PROBE_BEGIN(12)
    { pg8::Gemm g{H, WOUT0_T, R, D, D}; LatOrder S; S.init(D, G, bid); EpiResid<0, false> E{xin, ctx, VLAT, VCTX, nullptr, mod + 2 * 1024, nullptr, nullptr, nullptr};
      pg8::gemm_phase<EpiResid<0, false>, LatOrder, true, true>(ldsg, g, S, E); }
    { IDS
      ctx_resid_tiles<false>(H, WOUT0_T, D, ctx, VCTX, mod + 2 * 6144 + 2 * 1024, nullptr, nullptr, nullptr, (float*)lds, bid, G, tid, wave, l15, quad); }
PROBE_END(12)
    xcd_barrier(xbar);
PROBE_BEGIN(7)
    { IDS
    DRAIN_LATE((float*)(lds + wave * 8448), 1 << 30);
    ln_phase<false, false>(RST(0), VLAT, VCTX, nullptr, nullptr, ln_g, ln_b, mod + 3 * 1024, H, gw, NGW, lane);
    }
PROBE_END(7)
    xcd_barrier(xbar);
PROBE_BEGIN(11)
    { pg8::Gemm g{H, W1_0_T, R, FF, D}; LatOrder S; S.init(FF, G, bid); EpiStore<1> E{P, FF, FF};
      pg8::gemm_phase<EpiStore<1>, LatOrder, true, true>(ldsg, g, S, E); }
    { IDS
      ctx_ksplit_tiles<1>(H, W1_0_T, P, FF, 64, FF, (float*)lds, bid, G, tid, wave, l15, quad); }
PROBE_END(11)
    xcd_barrier(xbar);
PROBE_BEGIN(9)
    { pg8::Gemm g{P, W2_0_T, R, D, FF}; LatOrder S; S.init(D, G, bid); EpiResid<1, false> E{VLAT, VCTX, VLAT, VCTX, nullptr, mod + 5 * 1024, RST(0), ln_g, ln_b};
      pg8::gemm_phase<EpiResid<1, false>, LatOrder, true, true>(ldsg, g, S, E); }
    { IDS
      ctx_resid_tiles<true>(P, W2_0_T, FF, VCTX, VCTX, mod + 2 * 6144 + 5 * 1024, RST(0), ln_g, ln_b, (float*)lds, bid, G, tid, wave, l15, quad); }
PROBE_END(9)
    xcd_barrier(xbar);
    { IDS
    ln_phase<false, false>(RST(1), VLAT, VCTX, nullptr, nullptr, ln_g + 1024, ln_b + 1024, mod + 3 * 6144, H, gw, NGW, lane);
    }
    xcd_barrier(xbar);

PROBE_BEGIN(13)
    { pg8::Gemm g{H, WQKV_T, R, NQKV, D}; pg8::StaticOrder S; S.init(R, NQKV, G, bid); EpiStore<0> E{P, NQKV, NQKV};
      pg8::gemm_phase<EpiStore<0>, pg8::StaticOrder, true, true>(ldsg, g, S, E); }
PROBE_END(13)
    xcd_barrier(xbar);

PROBE_BEGIN(6)
#ifndef NO_P12
    { IDS
        bf16* Qs = (bf16*)lds; bf16* Ks = (bf16*)(lds + 73728); bf16* Vt = (bf16*)(lds + 82944); float* ropes = (float*)(lds + 92160);
        for (int i = tid; i < 1024; i += 512) ((f32x4*)ropes)[i] = ((const f32x4*)rope)[i];
        PACC_DECL
        for (int unit = bid; unit < NB * 4 * 64; unit += G) {
            PACC_BEGIN(40)
            const int nb = unit & 63, kvh = (unit >> 6) & 3, b = unit >> 8;
#define ATT_VALID(t) ((t) < 4 || (unsigned)(nb - 1 + (((t) - 4) >> 1)) < 64u)
#define ATT_KPOS(t) ((nb - 1 + (((t) - 4) >> 1)) * 128 + (((t) - 4) & 1) * 64)
#define ATT_KROW(t) ((t) < 4 ? b * TP + (t) * 64 : b * TP + L + ATT_KPOS(t))
            const int keyk = tid >> 2, pck = tid & 3, c1k = (pck & 1) + (pck >> 1) * 4, keyv = tid & 63, dcv = tid >> 6;
            u32x4 pk1 = {0u, 0u, 0u, 0u}, pk2_ = pk1, pvv = pk1;
#define ATT_LOAD(t) do { const int kr_ = ATT_KROW(t); \
                if (tid < 256) { const bf16* src_ = P + (size_t)(kr_ + keyk) * NQKV + 1024 + kvh * 64; pk1 = *(const u32x4*)(src_ + c1k * 8); pk2_ = *(const u32x4*)(src_ + (c1k + 2) * 8); } \
                pvv = *(const u32x4*)(P + (size_t)(kr_ + keyv) * NQKV + 1280 + kvh * 64 + dcv * 8); } while (0)
            ATT_LOAD(0);
            __syncthreads();
#pragma unroll
            for (int i = 0; i < 4; ++i) {
                const int it = tid + i * 512, pcq = it & 3, row = it >> 2, g = row >> 7, qi = row & 127, pos = nb * 128 + qi;
                const bf16* src = P + (size_t)(b * TP + L + pos) * NQKV + (kvh * 4 + g) * 64;
                const int c1 = (pcq & 1) + (pcq >> 1) * 4;
                const u32x4 u1 = *(const u32x4*)(src + c1 * 8), u2 = *(const u32x4*)(src + (c1 + 2) * 8);
                const int pv = (pcq < 2) ? (pos >> 6) : (pos & 63);
                const f32x4* tab = (const f32x4*)(ropes + (pv * 16 + (c1 & 1) * 8) * 2);
                u32x4 o1, o2;
#pragma unroll
                for (int j2 = 0; j2 < 4; ++j2) { const f32x4 cs = tab[j2];
                    const float a0 = bflo(u1[j2]), a1 = bfhi(u1[j2]), b0 = bflo(u2[j2]), b1 = bfhi(u2[j2]);
                    o1[j2] = pk2((a0 * cs.x - b0 * cs.y) * QSC, (a1 * cs.z - b1 * cs.w) * QSC); o2[j2] = pk2((a0 * cs.y + b0 * cs.x) * QSC, (a1 * cs.w + b1 * cs.z) * QSC); }
                *(u32x4*)(Qs + row * 72 + c1 * 8) = o1; *(u32x4*)(Qs + row * 72 + (c1 + 2) * 8) = o2;
            }
            const int g = wave & 3, qh = wave >> 2, qrow0 = g * 128 + qh * 64, qpos0 = nb * 128 + qh * 64;
            float mrun[4], lrun[4]; pg8::f32x4 O[4][4];
            const float sk = sink[kvh * 4 + g] * 1.4426950408889634f;
#pragma unroll
            for (int qt = 0; qt < 4; ++qt) { mrun[qt] = sk; lrun[qt] = (quad == 0) ? 1.f : 0.f;
#pragma unroll
                for (int dt = 0; dt < 4; ++dt) O[dt][qt] = (pg8::f32x4){0.f, 0.f, 0.f, 0.f}; }
            PACC_END(40)
            int ti = 0;
            while (ti < 10) {
                PACC_BEGIN(41)
                const bool local = ti >= 4;
                const int kpos0 = local ? ATT_KPOS(ti) : 0;
                const int side = local ? ((ti - 4) >> 1) - 1 : 0;
                __syncthreads();
                if (tid < 256) {
                    u32x4 o1 = pk1, o2 = pk2_;
                    if (local) {
                        const int pos = kpos0 + keyk, pv = (pck < 2) ? (pos >> 6) : (pos & 63);
                        const f32x4* tab = (const f32x4*)(ropes + (pv * 16 + (c1k & 1) * 8) * 2);
#pragma unroll
                        for (int j2 = 0; j2 < 4; ++j2) { const f32x4 cs = tab[j2];
                            const float a0 = bflo(pk1[j2]), a1 = bfhi(pk1[j2]), b0 = bflo(pk2_[j2]), b1 = bfhi(pk2_[j2]);
                            o1[j2] = pk2(a0 * cs.x - b0 * cs.y, a1 * cs.z - b1 * cs.w); o2[j2] = pk2(a0 * cs.y + b0 * cs.x, a1 * cs.w + b1 * cs.z); }
                    }
                    *(u32x4*)(Ks + keyk * 72 + c1k * 8) = o1; *(u32x4*)(Ks + keyk * 72 + (c1k + 2) * 8) = o2;
                }
#pragma unroll
                for (int j = 0; j < 8; ++j) { const unsigned u = pvv[j >> 1]; Vt[(dcv * 8 + j) * 72 + keyv] = (bf16)((j & 1) ? (u >> 16) : (u & 0xffffu)); }
                __syncthreads();
                PACC_END(41)
                PACC_BEGIN(42)
                int tn = ti + 1;
                while (tn < 10 && !ATT_VALID(tn)) ++tn;
                if (tn < 10) ATT_LOAD(tn);
                if (!((side < 0 && ((ti - 4) & 1) == 0 && qh == 1) || (side > 0 && ((ti - 4) & 1) == 1 && qh == 0))) {
                bf16x8 kfr[4][2];
#pragma unroll
                for (int kt = 0; kt < 4; ++kt)
#pragma unroll
                    for (int ks = 0; ks < 2; ++ks) kfr[kt][ks] = *(const bf16x8*)(Ks + (kt * 16 + l15) * 72 + ks * 32 + quad * 8);
#pragma unroll
                for (int qt = 0; qt < 4; ++qt) {
                    pg8::f32x4 S[4];
#pragma unroll
                    for (int kt = 0; kt < 4; ++kt) S[kt] = (pg8::f32x4){0.f, 0.f, 0.f, 0.f};
#pragma unroll
                    for (int ks = 0; ks < 2; ++ks) { const bf16x8 qf = *(const bf16x8*)(Qs + (qrow0 + qt * 16 + l15) * 72 + ks * 32 + quad * 8);
#pragma unroll
                        for (int kt = 0; kt < 4; ++kt) S[kt] = MFMA16(kfr[kt][ks], qf, S[kt]); }
                    float mx = -INFINITY;
                    if (side < 0 && ((ti - 4) & 1) == qh) {
                        const int tl = quad * 4 - (qpos0 + qt * 16 + l15 - kpos0 - 128);
#pragma unroll
                        for (int kt = 0; kt < 4; ++kt)
#pragma unroll
                            for (int rg = 0; rg < 4; ++rg) { const float sv_ = (tl >= -(kt * 16 + rg)) ? S[kt][rg] : -INFINITY; S[kt][rg] = sv_; mx = fmaxf(mx, sv_); }
                    } else if (side > 0 && ((ti - 4) & 1) == qh) {
                        const int th = (qpos0 + qt * 16 + l15 - kpos0 + 128) - quad * 4;
#pragma unroll
                        for (int kt = 0; kt < 4; ++kt)
#pragma unroll
                            for (int rg = 0; rg < 4; ++rg) { const float sv_ = (th >= (kt * 16 + rg)) ? S[kt][rg] : -INFINITY; S[kt][rg] = sv_; mx = fmaxf(mx, sv_); }
                    } else {
#pragma unroll
                        for (int kt = 0; kt < 4; ++kt)
#pragma unroll
                            for (int rg = 0; rg < 4; ++rg) mx = fmaxf(mx, S[kt][rg]);
                    }
                    mx = quad_max(mx);
                    const float mnew = fmaxf(mrun[qt], mx), al = __builtin_amdgcn_exp2f(mrun[qt] - mnew); mrun[qt] = mnew;
                    float ps = 0.f;
#pragma unroll
                    for (int kt = 0; kt < 4; ++kt)
#pragma unroll
                        for (int rg = 0; rg < 4; ++rg) { const float p = __builtin_amdgcn_exp2f(S[kt][rg] - mnew); S[kt][rg] = p; ps += p; }
                    lrun[qt] = lrun[qt] * al + ps;
#pragma unroll
                    for (int dt = 0; dt < 4; ++dt) O[dt][qt] = O[dt][qt] * al;
#pragma unroll
                    for (int s2 = 0; s2 < 2; ++s2) {
                        u32x4 pw; pw.x = pk2(S[2 * s2][0], S[2 * s2][1]); pw.y = pk2(S[2 * s2][2], S[2 * s2][3]);
                        pw.z = pk2(S[2 * s2 + 1][0], S[2 * s2 + 1][1]); pw.w = pk2(S[2 * s2 + 1][2], S[2 * s2 + 1][3]);
                        const bf16x8 pf = __builtin_bit_cast(bf16x8, pw);
#pragma unroll
                        for (int dt = 0; dt < 4; ++dt) {
                            const s16x4 lo = *(const s16x4*)(Vt + (dt * 16 + l15) * 72 + s2 * 32 + quad * 4), hi = *(const s16x4*)(Vt + (dt * 16 + l15) * 72 + s2 * 32 + 16 + quad * 4);
                            O[dt][qt] = MFMA16(__builtin_shufflevector(lo, hi, 0, 1, 2, 3, 4, 5, 6, 7), pf, O[dt][qt]); }
                    }
                }
                }
                ti = tn;
                PACC_END(42)
            }
            PACC_BEGIN(43)
#pragma unroll
            for (int qt = 0; qt < 4; ++qt) {
                const float lt = quad_sum(lrun[qt]);
                const float inv = 1.f / lt;
                const int r = b * TP + L + qpos0 + qt * 16 + l15;
#pragma unroll
                for (int dt = 0; dt < 4; ++dt) { u32x2 o; o.x = pk2(O[dt][qt][0] * inv, O[dt][qt][1] * inv); o.y = pk2(O[dt][qt][2] * inv, O[dt][qt][3] * inv);
                    *(u32x2*)(H + (size_t)r * D + (kvh * 4 + g) * 64 + dt * 16 + quad * 4) = o; }
            }
            PACC_END(43)
#undef ATT_VALID
#undef ATT_KPOS
#undef ATT_KROW
#undef ATT_LOAD
        }
        PACC_SLEEP()
    }
#endif
PROBE_END(6)
    xcd_barrier(xbar);

PROBE_BEGIN(14)
    { pg8::Gemm g{H, WOUT1_T, R, D, D}; LatOrder S; S.init(D, G, bid); EpiResid<1, false> E{VLAT, VCTX, VLAT, VCTX, nullptr, mod + 3 * 6144 + 2 * 1024, RST(1), ln_g + 1024, ln_b + 1024};
      pg8::gemm_phase<EpiResid<1, false>, LatOrder, true, true>(ldsg, g, S, E); }
PROBE_END(14)
    xcd_barrier(xbar);
    { IDS
    ln_phase<false, true>(RST(2), VLAT, VCTX, nullptr, nullptr, ln_g + 2048, ln_b + 2048, mod + 3 * 6144 + 3 * 1024, H, gw, NGW, lane);
    }
    xcd_barrier(xbar);
PROBE_BEGIN(15)
    { pg8::Gemm g{H, W1_1_T, R, FF, D}; LatOrder S; S.init(FF, G, bid); EpiStore<1> E{P, FF, FF};
      pg8::gemm_phase<EpiStore<1>, LatOrder, true, true>(ldsg, g, S, E); }
PROBE_END(15)
    xcd_barrier(xbar);
PROBE_BEGIN(16)
    { pg8::Gemm g{P, W2_1_T, R, D, FF}; LatOrder S; S.init(D, G, bid); EpiResid<1, true> E{VLAT, VCTX, nullptr, nullptr, H, mod + 3 * 6144 + 5 * 1024, RST(2), ln_g + 2048, ln_b + 2048};
      pg8::gemm_phase<EpiResid<1, true>, LatOrder, true, true>(ldsg, g, S, E); }
PROBE_END(16)
    xcd_barrier(xbar);
    { IDS
    ln_phase<true, true>(nullptr, nullptr, nullptr, H, a.out, ln_g + 3072, ln_b + 3072, mod, H, gw, NGW, lane);
    }
}

extern "C" void kernel_launch(void* const* d_in, const int* in_sizes, int n_in, void* d_out, int out_size, void* d_ws, size_t ws_size, hipStream_t stream) {
    static int grid = 0;
    if (grid == 0) {
        if (n_in != 19 || out_size != NB * T * D || ws_size < WS_TOTAL) { fprintf(stderr, "kernel_launch: unexpected shapes (n_in %d out %d ws %zu)\n", n_in, out_size, ws_size); grid = -1; return; }
        int dev = 0, cus = 0, per_cu = 0;
        hipGetDevice(&dev); hipDeviceGetAttribute(&cus, hipDeviceAttributeMultiprocessorCount, dev);
        if (hipFuncSetAttribute((const void*)fwd_kernel, hipFuncAttributeMaxDynamicSharedMemorySize, LDS_BYTES) != hipSuccess) { fprintf(stderr, "kernel_launch: hipFuncSetAttribute failed\n"); grid = -1; return; }
        if (hipOccupancyMaxActiveBlocksPerMultiprocessor(&per_cu, (const void*)fwd_kernel, 512, LDS_BYTES) != hipSuccess || per_cu < 1) per_cu = 1;
        (void)hipGetLastError();
        grid = cus > 0 ? cus : 256;
    }
    if (grid < 0) return;
    Args a{};
    for (int i = 0; i < 19; ++i) a.in[i] = (const float*)d_in[i];
    a.out = (float*)d_out; a.ws = (unsigned char*)d_ws;
    if (hipMemsetAsync((char*)d_ws + OFF_XBAR, 0, 16384, stream) != hipSuccess) { fprintf(stderr, "kernel_launch: hipMemsetAsync of the barrier words failed\n"); return; }
    void* args[] = {&a};
    hipError_t e = hipLaunchCooperativeKernel((const void*)fwd_kernel, dim3(grid), dim3(512), args, LDS_BYTES, stream);
    if (e != hipSuccess) fprintf(stderr, "cooperative launch failed: %s (grid %d)\n", hipGetErrorString(e), grid);
}
```

```cpp
#include <hip/hip_runtime.h>
#include <hip/hip_cooperative_groups.h>
#include <cstdio>
#include <cstdint>
namespace cg = cooperative_groups;
namespace pg8 {
#define PG8_LAS __attribute__((address_space(3)))
typedef unsigned short bf16_t;
typedef short bf16x8 __attribute__((ext_vector_type(8)));
typedef float f32x4 __attribute__((ext_vector_type(4)));
typedef unsigned u32x4 __attribute__((ext_vector_type(4)));
constexpr int BM = 256, BK = 64, HALF = 128, HTB = HALF * BK * 2  , STAGE_BYTES = 8 * HTB, NXCD = 8, WGM = 8;

__host__ __device__ __forceinline__ int lds_byte(int r, int c) { const int st = (r >> 4) * 2 + (c >> 5), rr = r & 15, cc = c & 31, ob = rr * 64 + cc * 2; return st * 1024 + (ob ^ (((ob >> 9) & 1) << 5)); }
__host__ __device__ __forceinline__ void stage_rc(int b, int& R, int& C) { const int st = b / 1024, sb = b % 1024, swz = sb ^ (((sb >> 9) & 1) << 5); R = (st >> 1) * 16 + swz / 64; C = (st & 1) * 32 + (swz % 64) / 2; }
__host__ __device__ __forceinline__ int perm32(int rho) { const int n = rho >> 4, i = rho & 15; return 8 * (i >> 2) + 4 * n + (i & 3); }

struct Unit { int pm, pn; };
struct Gemm { const bf16_t* A; const bf16_t* Bt; int M, N, K; };

struct StaticOrder {
    int nM, nN, nwg, G, c;
    __host__ __device__ void init(int M, int N, int G_, int c_) { nM = M / BM; nN = N / BM; nwg = nM * nN; G = G_; c = c_; }
    __host__ __device__ bool next(int i, Unit& u) const {
        const long L = (long)i * G + c; if (L >= nwg) return false;
        int wgid = (int)L; { const int q = nwg / NXCD, r = nwg % NXCD, xcd = wgid % NXCD, off = wgid / NXCD; wgid = (xcd < r ? xcd * (q + 1) : r * (q + 1) + (xcd - r) * q) + off; }
        const int nig = WGM * nN, gid = wgid / nig, fm = gid * WGM, gsz = (nM - fm) < WGM ? (nM - fm) : WGM;
        u.pm = fm + ((wgid % nig) % gsz); u.pn = (wgid % nig) / gsz; return true;
    }
    __device__ __forceinline__ void a_ready(const Unit&) const {}
    __device__ __forceinline__ void done(const Unit&) const {}
};

__device__ __forceinline__ unsigned cvt_pk_bf16(float lo, float hi) { unsigned r; asm volatile("v_cvt_pk_bf16_f32 %0, %1, %2" : "=v"(r) : "v"(lo), "v"(hi)); return r; }

template <class Epi, class Sched, bool ALIGN_EPI = false, bool SP2 = false>
__device__ __forceinline__ void gemm_phase(PG8_LAS unsigned char* lds, const Gemm g, const Sched& S, const Epi& E) {
    int tid = threadIdx.x; asm volatile("" : "+v"(tid));
    const int wid = __builtin_amdgcn_readfirstlane(tid >> 6), lane = tid & 63, wr = wid >> 2, wc = wid & 3, fr = lane & 15, fq = lane >> 4;
    const int K = g.K, nt = K / BK;
    unsigned voffA[2], voffB[2];
#pragma unroll
    for (int i = 0; i < 2; ++i) { int R, C; stage_rc(tid * 16 + i * 8192, R, C); const int Rb = Epi::PERM ? ((R & ~31) + perm32(R & 31)) : R;
        voffA[i] = (unsigned)(R * K + C) * 2u; voffB[i] = (unsigned)(Rb * K + C) * 2u; }
    const size_t kstep = (size_t)(BK * 2);
    const size_t hstep = (size_t)HALF * K * 2;
    const size_t tstep = 2 * hstep;
    const unsigned ldsw = (unsigned)wid * 1024u;
    const int aoff = lds_byte(wr * 64 + fr, fq * 8), boff = lds_byte(wc * 32 + fr, fq * 8);
#define PG8_SA(b, h) (((b) * 2 + (h)) * HTB)
#define PG8_SB(b, h) ((4 + (b) * 2 + (h)) * HTB)
#define PG8_STAGE(bufoff, gbase, voff) do { _Pragma("unroll") for (int _i = 0; _i < 2; ++_i) \
        __builtin_amdgcn_global_load_lds((const unsigned*)((const char*)(gbase) + (voff)[_i]), (PG8_LAS unsigned*)(lds + (bufoff) + ldsw + _i * 8192), 16, 0, 0); } while (0)
#define PG8_LDA(dst, b, h) do { _Pragma("unroll") for (int m = 0; m < 4; ++m) _Pragma("unroll") for (int k = 0; k < 2; ++k) dst[m][k] = *(const PG8_LAS bf16x8*)(lds + PG8_SA(b, h) + aoff + m * 2048 + k * 1024); } while (0)
#define PG8_LDB(dst, b, h) do { _Pragma("unroll") for (int n = 0; n < 2; ++n) _Pragma("unroll") for (int k = 0; k < 2; ++k) dst[n][k] = *(const PG8_LAS bf16x8*)(lds + PG8_SB(b, h) + boff + n * 2048 + k * 1024); } while (0)
#define PG8_MMA(ai, bj, At, Bt) do { __builtin_amdgcn_s_setprio(1); _Pragma("unroll") for (int m = 0; m < 4; ++m) _Pragma("unroll") for (int n = 0; n < 2; ++n) _Pragma("unroll") for (int k = 0; k < 2; ++k) \
        acc[ai][bj][m][n] = __builtin_amdgcn_mfma_f32_16x16x32_bf16(Bt[n][k], At[m][k], acc[ai][bj][m][n], 0, 0, 0); __builtin_amdgcn_s_setprio(0); } while (0)
#define PG8_WAIT_V(n) asm volatile("s_waitcnt vmcnt(" #n ")" ::: "memory")
#define PG8_WAIT_L(n) asm volatile("s_waitcnt lgkmcnt(" #n ")" ::: "memory")
#define PG8_BAR __builtin_amdgcn_s_barrier()
#define PG8_SCHED __builtin_amdgcn_sched_barrier(0)
    Unit cur, nxt; int ui = 0;
    if (!S.next(0, cur)) return;
    f32x4 acc[2][2][4][2];
#pragma unroll
    for (int a = 0; a < 2; ++a)
#pragma unroll
        for (int b = 0; b < 2; ++b)
#pragma unroll
            for (int m = 0; m < 4; ++m)
#pragma unroll
                for (int n = 0; n < 2; ++n) acc[a][b][m][n] = (f32x4){0.f, 0.f, 0.f, 0.f};
    bf16x8 At[4][2], B0[2][2], B1[2][2];
    const char* cA = (const char*)g.A + (size_t)cur.pm * tstep; const char* cB = (const char*)g.Bt + (size_t)cur.pn * tstep;
    S.a_ready(cur);
    if constexpr (SP2) {
        PG8_STAGE(PG8_SB(0, 0), cB, voffB); PG8_STAGE(PG8_SB(0, 1), cB + hstep, voffB); PG8_STAGE(PG8_SA(0, 0), cA, voffA); PG8_STAGE(PG8_SA(0, 1), cA + hstep, voffA);
        if (wr == 1) PG8_BAR;
        PG8_WAIT_V(2); PG8_BAR;
        PG8_STAGE(PG8_SB(1, 0), cB + kstep, voffB); PG8_STAGE(PG8_SA(1, 0), cA + kstep, voffA); PG8_STAGE(PG8_SB(1, 1), cB + hstep + kstep, voffB);
        PG8_WAIT_V(6); PG8_BAR;
    } else {
        PG8_STAGE(PG8_SB(0, 0), cB, voffB); PG8_STAGE(PG8_SA(0, 0), cA, voffA); PG8_STAGE(PG8_SB(0, 1), cB + hstep, voffB); PG8_STAGE(PG8_SA(0, 1), cA + hstep, voffA);
        if (wr == 1) PG8_BAR;
        PG8_WAIT_V(4); PG8_BAR;
        PG8_STAGE(PG8_SB(1, 0), cB + kstep, voffB); PG8_STAGE(PG8_SA(1, 0), cA + kstep, voffA); PG8_STAGE(PG8_SB(1, 1), cB + hstep + kstep, voffB);
        PG8_WAIT_V(6); PG8_BAR;
    }
    for (;;) {
        const bool has_next = S.next(ui + 1, nxt);
        const char* nA = has_next ? (const char*)g.A + (size_t)nxt.pm * tstep : cA; const char* nB = has_next ? (const char*)g.Bt + (size_t)nxt.pn * tstep : cB;
        for (int t = 0; t < nt; t += 2) {
            const bool last = (t == nt - 2);
            const char* a1 = cA + (size_t)(t + 1) * kstep;
            const char* a2 = last ? nA : cA + (size_t)(t + 2) * kstep; const char* b2 = last ? nB : cB + (size_t)(t + 2) * kstep;
            const char* a3 = a2 + kstep; const char* b3 = b2 + kstep;
            if (last && has_next) S.a_ready(nxt);
            if constexpr (SP2) {
            PG8_LDB(B0, 0, 0); PG8_LDB(B1, 0, 1); PG8_SCHED; PG8_LDA(At, 0, 0); PG8_STAGE(PG8_SA(1, 1), a1 + hstep, voffA);
            PG8_WAIT_V(8); PG8_WAIT_L(0); PG8_BAR; PG8_MMA(0, 0, At, B0); PG8_MMA(0, 1, At, B1); PG8_BAR; PG8_SCHED;
            PG8_LDA(At, 0, 1); PG8_STAGE(PG8_SB(0, 0), b2, voffB); PG8_STAGE(PG8_SB(0, 1), b2 + hstep, voffB); PG8_STAGE(PG8_SA(0, 0), a2, voffA);
            PG8_WAIT_V(8); PG8_WAIT_L(0); PG8_BAR; PG8_MMA(1, 0, At, B0); PG8_MMA(1, 1, At, B1); PG8_BAR; PG8_SCHED;
            PG8_LDB(B0, 1, 0); PG8_LDB(B1, 1, 1); PG8_SCHED; PG8_LDA(At, 1, 0); PG8_STAGE(PG8_SA(0, 1), a2 + hstep, voffA);
            PG8_WAIT_V(8); PG8_WAIT_L(0); PG8_BAR; PG8_MMA(0, 0, At, B0); PG8_MMA(0, 1, At, B1); PG8_BAR; PG8_SCHED;
            PG8_LDA(At, 1, 1); PG8_STAGE(PG8_SB(1, 0), b3, voffB); PG8_STAGE(PG8_SB(1, 1), b3 + hstep, voffB); PG8_STAGE(PG8_SA(1, 0), a3, voffA);
            PG8_WAIT_V(8); PG8_WAIT_L(0); PG8_BAR; PG8_MMA(1, 0, At, B0); PG8_MMA(1, 1, At, B1); PG8_BAR; PG8_SCHED;
            } else {
            PG8_LDB(B0, 0, 0); PG8_SCHED; PG8_LDA(At, 0, 0); PG8_STAGE(PG8_SA(1, 1), a1 + hstep, voffA);
            PG8_WAIT_L(8); PG8_BAR; PG8_WAIT_L(0); PG8_MMA(0, 0, At, B0); PG8_BAR; PG8_SCHED;
            PG8_LDB(B1, 0, 1); PG8_STAGE(PG8_SB(0, 0), b2, voffB);
            PG8_BAR; PG8_WAIT_L(0); PG8_MMA(0, 1, At, B1); PG8_BAR;
            PG8_LDA(At, 0, 1); PG8_STAGE(PG8_SA(0, 0), a2, voffA);
            PG8_BAR; PG8_WAIT_L(0); PG8_MMA(1, 0, At, B0); PG8_BAR; PG8_SCHED;
            PG8_STAGE(PG8_SB(0, 1), b2 + hstep, voffB);
            PG8_WAIT_V(6); PG8_BAR; PG8_MMA(1, 1, At, B1); PG8_BAR;
            PG8_LDB(B0, 1, 0); PG8_SCHED; PG8_LDA(At, 1, 0); PG8_STAGE(PG8_SA(0, 1), a2 + hstep, voffA);
            PG8_WAIT_L(8); PG8_BAR; PG8_WAIT_L(0); PG8_MMA(0, 0, At, B0); PG8_BAR; PG8_SCHED;
            PG8_LDB(B1, 1, 1); PG8_STAGE(PG8_SB(1, 0), b3, voffB);
            PG8_BAR; PG8_WAIT_L(0); PG8_MMA(0, 1, At, B1); PG8_BAR;
            PG8_LDA(At, 1, 1); PG8_STAGE(PG8_SA(1, 0), a3, voffA);
            PG8_BAR; PG8_WAIT_L(0); PG8_MMA(1, 0, At, B0); PG8_BAR; PG8_SCHED;
            PG8_STAGE(PG8_SB(1, 1), b3 + hstep, voffB);
            PG8_WAIT_V(6); PG8_BAR; PG8_MMA(1, 1, At, B1); PG8_BAR;
            }
        }
        if constexpr (ALIGN_EPI) { if (wr == 0) PG8_BAR; }
        if constexpr (!Epi::AFTER_DRAIN) { E(acc, cur, wr, wc, fr, fq); S.done(cur); }
        if (!has_next) break;
#pragma unroll
        for (int a = 0; a < 2; ++a)
#pragma unroll
            for (int b = 0; b < 2; ++b)
#pragma unroll
                for (int m = 0; m < 4; ++m)
#pragma unroll
                    for (int n = 0; n < 2; ++n) acc[a][b][m][n] = (f32x4){0.f, 0.f, 0.f, 0.f};
        cur = nxt; cA = nA; cB = nB; ++ui;
        if constexpr (ALIGN_EPI) { if (wr == 1) PG8_BAR; }
    }
    PG8_WAIT_V(0);
    if constexpr (!ALIGN_EPI) { if (wr == 0) PG8_BAR; }
    PG8_BAR;
    if constexpr (Epi::AFTER_DRAIN) { E.fused(acc, cur, wr, wc, fr, fq, lds, wid, lane); S.done(cur); }
#undef PG8_SA
#undef PG8_SB
#undef PG8_STAGE
#undef PG8_LDA
#undef PG8_LDB
#undef PG8_MMA
#undef PG8_WAIT_V
#undef PG8_WAIT_L
#undef PG8_BAR
#undef PG8_SCHED
}
}

constexpr int NB = 2, T = 8192, L = 256, D = 1024, TP = T + L, R = NB * TP;
constexpr int FF = 4096, NPROJ = 3104, NPROJ_PAD = 3328, NQKV = 1536, NCH = TP / 64;
constexpr float ALPHA = 1.4142135623730951f;
constexpr int LDS_BYTES = 147456;

typedef unsigned short bf16;
typedef float f32x4 __attribute__((ext_vector_type(4)));
typedef short bf16x8 __attribute__((ext_vector_type(8)));
typedef short s16x4 __attribute__((ext_vector_type(4)));
typedef unsigned u32x4 __attribute__((ext_vector_type(4)));
typedef unsigned u32x2 __attribute__((ext_vector_type(2)));

constexpr size_t OFF_WIN = 0;
constexpr size_t OFF_WOUT0 = OFF_WIN + (size_t)NPROJ_PAD * D * 2;
constexpr size_t OFF_W1_0 = OFF_WOUT0 + (size_t)D * D * 2;
constexpr size_t OFF_W2_0 = OFF_W1_0 + (size_t)FF * D * 2;
constexpr size_t OFF_WQKV = OFF_W2_0 + (size_t)FF * D * 2;
constexpr size_t OFF_WOUT1 = OFF_WQKV + (size_t)NQKV * D * 2;
constexpr size_t OFF_W1_1 = OFF_WOUT1 + (size_t)D * D * 2;
constexpr size_t OFF_W2_1 = OFF_W1_1 + (size_t)FF * D * 2;
constexpr size_t OFF_MOD = OFF_W2_1 + (size_t)FF * D * 2;
constexpr size_t OFF_ROPE = OFF_MOD + 2 * 3 * 6144 * 4;
constexpr size_t OFF_BAR = OFF_ROPE + 128 * 16 * 8;
constexpr size_t OFF_XBAR = OFF_BAR + 256;
constexpr size_t OFF_RST = OFF_XBAR + 16384;
constexpr size_t OFF_XCTX = OFF_RST + (size_t)3 * R * 2 * 4;
constexpr size_t OFF_DEC = OFF_XCTX + (size_t)NB * L * D * 4;
constexpr size_t OFF_H = OFF_DEC + (size_t)32 * NCH * 64 * 4;
constexpr size_t OFF_P = OFF_H + (size_t)R * D * 2;
constexpr size_t OFF_ST = OFF_P + (size_t)R * NPROJ * 2;
constexpr size_t WS_TOTAL = OFF_ST + (size_t)32 * NCH * 8192 * 2;
static_assert(WS_TOTAL <= 268435456, "workspace map exceeds 256 MiB");
static_assert(OFF_P + (size_t)R * FF * 2 <= WS_TOTAL, "MLP hidden overlay");

typedef float f32x2_t __attribute__((ext_vector_type(2)));
typedef __bf16 bf16x2_t __attribute__((ext_vector_type(2)));
__device__ __forceinline__ unsigned pk2(float lo, float hi) { const f32x2_t v = {lo, hi}; const bf16x2_t b = __builtin_convertvector(v, bf16x2_t); return __builtin_bit_cast(unsigned, b); }
__device__ __forceinline__ unsigned f2bf(float f) { return pk2(f, f) & 0xffffu; }
__device__ __forceinline__ float bf2f(unsigned h) { return __uint_as_float(h << 16); }
__device__ __forceinline__ float bflo(unsigned u) { return __uint_as_float(u << 16); }
__device__ __forceinline__ float bfhi(unsigned u) { return __uint_as_float(u & 0xffff0000u); }
__device__ __forceinline__ float quad_max(float x) {
    const unsigned u = __float_as_uint(x);
    const auto r = __builtin_amdgcn_permlane32_swap(u, u, false, false);
    const float m = fmaxf(__uint_as_float(r[0]), __uint_as_float(r[1]));
    const unsigned v = __float_as_uint(m);
    const auto q = __builtin_amdgcn_permlane16_swap(v, v, false, false);
    return fmaxf(__uint_as_float(q[0]), __uint_as_float(q[1]));
}
__device__ __forceinline__ float quad_sum(float x) {
    const unsigned u = __float_as_uint(x);
    const auto r = __builtin_amdgcn_permlane32_swap(u, u, false, false);
    const float m = __uint_as_float(r[0]) + __uint_as_float(r[1]);
    const unsigned v = __float_as_uint(m);
    const auto q = __builtin_amdgcn_permlane16_swap(v, v, false, false);
    return __uint_as_float(q[0]) + __uint_as_float(q[1]);
}
__device__ __forceinline__ float dpp_add(float v, int ctrl_sel) {
    const int u = __float_as_int(v);
    const int t = ctrl_sel == 0 ? __builtin_amdgcn_update_dpp(0, u, 0xB1, 0xF, 0xF, true) : ctrl_sel == 1 ? __builtin_amdgcn_update_dpp(0, u, 0x4E, 0xF, 0xF, true)
                : ctrl_sel == 2 ? __builtin_amdgcn_update_dpp(0, u, 0x141, 0xF, 0xF, true) : __builtin_amdgcn_update_dpp(0, u, 0x140, 0xF, 0xF, true);
    return v + __int_as_float(t);
}
__device__ __forceinline__ float wave_sum(float v) { v = dpp_add(v, 0); v = dpp_add(v, 1); v = dpp_add(v, 2); v = dpp_add(v, 3); return quad_sum(v); }
#define MFMA16(a, b, c) __builtin_amdgcn_mfma_f32_16x16x32_bf16((a), (b), (c), 0, 0, 0)

__device__ __forceinline__ size_t row_off(int r, bool& isc, int& b) { b = (r >= TP) ? 1 : 0; const int p = r - b * TP; isc = p < L; return isc ? (size_t)(b * L + p) * D : (size_t)(b * T + p - L) * D; }

template <int ACT> struct EpiStore {
    static constexpr bool PERM = true, AFTER_DRAIN = false;
    bf16* O; int ldc; int ncols;
    __device__ __forceinline__ void operator()(const pg8::f32x4 (&acc)[2][2][4][2], const pg8::Unit& u, int wr, int wc, int fr, int fq) const {
        const int row0 = u.pm * 256 + wr * 64 + fr, col0 = u.pn * 256 + wc * 32 + 8 * fq;
#pragma unroll
        for (int ai = 0; ai < 2; ++ai)
#pragma unroll
            for (int m = 0; m < 4; ++m) {
                bf16* rowp = O + (size_t)(row0 + ai * 128 + m * 16) * ldc;
#pragma unroll
                for (int bj = 0; bj < 2; ++bj) {
                    const int col = col0 + bj * 128;
                    pg8::f32x4 v0 = acc[ai][bj][m][0], v1 = acc[ai][bj][m][1];
                    if (ACT == 1) {
#pragma unroll
                        for (int i = 0; i < 4; ++i) { float a = fmaxf(v0[i], 0.f), b = fmaxf(v1[i], 0.f); v0[i] = a * a; v1[i] = b * b; }
                    }
                    u32x4 w; w.x = pg8::cvt_pk_bf16(v0[0], v0[1]); w.y = pg8::cvt_pk_bf16(v0[2], v0[3]); w.z = pg8::cvt_pk_bf16(v1[0], v1[1]); w.w = pg8::cvt_pk_bf16(v1[2], v1[3]);
                    if (col < ncols) *(u32x4*)(rowp + col) = w;
                }
            }
    }
};
template <int SRC, bool DST_FIN> struct EpiResid {
    static constexpr bool PERM = true, AFTER_DRAIN = false;
    const void* src_lat; const void* src_ctx; bf16* dst_lat; bf16* dst_ctx; bf16* dst_fin; const float* gate;
    const float* rst; const float* lg; const float* lb;
    __device__ __forceinline__ void operator()(const pg8::f32x4 (&acc)[2][2][4][2], const pg8::Unit& u, int wr, int wc, int fr, int fq) const {
        const int b = u.pm > 33 ? 1 : 0, col0 = u.pn * 256 + wc * 32 + 8 * fq, rt0 = wr * 64 + fr;
        const size_t lat0 = (size_t)(u.pm * 256 - b * TP - L + b * T);
        const float* gt = gate + b * 6144;
#pragma unroll
        for (int bj = 0; bj < 2; ++bj) {
            const int col = col0 + bj * 128;
            const f32x4 g0 = *(const f32x4*)(gt + col), g1 = *(const f32x4*)(gt + col + 4);
            f32x4 l0, l1, m0, m1;
            if (SRC == 1) { l0 = *(const f32x4*)(lg + col); l1 = *(const f32x4*)(lg + col + 4); m0 = *(const f32x4*)(lb + col); m1 = *(const f32x4*)(lb + col + 4); }
#pragma unroll
            for (int ai = 0; ai < 2; ++ai)
#pragma unroll
                for (int m = 0; m < 4; ++m) {
                    const int rt = rt0 + ai * 128 + m * 16, row = u.pm * 256 + rt; const size_t off = (lat0 + rt) * D + col;
                    f32x4 x0, x1;
                    if (SRC == 0) { const float* sp = (const float*)src_lat + off; x0 = *(const f32x4*)sp; x1 = *(const f32x4*)(sp + 4); }
                    else { const float mean = rst[2 * row], rstd = rst[2 * row + 1];
                        const u32x4 w = *(const u32x4*)((const bf16*)src_lat + off);
                        x0 = (f32x4){bflo(w.x), bfhi(w.x), bflo(w.y), bfhi(w.y)}; x1 = (f32x4){bflo(w.z), bfhi(w.z), bflo(w.w), bfhi(w.w)};
                        x0 = (x0 - mean) * rstd * l0 + m0; x1 = (x1 - mean) * rstd * l1 + m1; }
                    const pg8::f32x4 a0 = acc[ai][bj][m][0], a1 = acc[ai][bj][m][1];
                    u32x4 o; o.x = pk2(ALPHA * x0.x + g0.x * a0[0], ALPHA * x0.y + g0.y * a0[1]); o.y = pk2(ALPHA * x0.z + g0.z * a0[2], ALPHA * x0.w + g0.w * a0[3]);
                    o.z = pk2(ALPHA * x1.x + g1.x * a1[0], ALPHA * x1.y + g1.y * a1[1]); o.w = pk2(ALPHA * x1.z + g1.z * a1[2], ALPHA * x1.w + g1.w * a1[3]);
                    bf16* dp = DST_FIN ? dst_fin + (size_t)row * D + col : dst_lat + off;
                    *(u32x4*)dp = o;
                }
        }
    }
};

__device__ __forceinline__ void transpose_item(const float* __restrict__ W, int K, int N, bf16* WT, float* scr, int item, int lane) {
    const int nblk = N / 32, kb = item / nblk, nb = item % nblk, k0 = 64 * kb, n0 = 32 * nb;
#pragma unroll 8
    for (int i = 0; i < 32; ++i) { const int kk = 2 * i + (lane >> 5); scr[kk * 33 + (lane & 31)] = W[(size_t)(k0 + kk) * N + n0 + (lane & 31)]; }
    asm volatile("s_waitcnt lgkmcnt(0)" ::: "memory");
    const int c = lane & 7;
#pragma unroll
    for (int j = 0; j < 4; ++j) { const int n = (lane >> 3) + 8 * j; const float* s = scr + (8 * c) * 33 + n;
        u32x4 o; o.x = pk2(s[0 * 33], s[1 * 33]); o.y = pk2(s[2 * 33], s[3 * 33]); o.z = pk2(s[4 * 33], s[5 * 33]); o.w = pk2(s[6 * 33], s[7 * 33]);
        *(u32x4*)(WT + (size_t)(n0 + n) * K + k0 + 8 * c) = o; }
    asm volatile("s_waitcnt lgkmcnt(0)" ::: "memory");
}

template <bool LAST, bool SKIPCTX>
__device__ __forceinline__ void ln_phase(float* rst, const bf16* vlat, const bf16* vctx, const bf16* vfin, float* outp, const float* __restrict__ g, const float* __restrict__ bt, const float* __restrict__ modn, bf16* H, int gw, int NGW, int lane) {
    int r = gw;
    if (SKIPCTX) { while (r < R) { const int p = r >= TP ? r - TP : r; if (p >= L) break; r += NGW; } }
    u32x4 vn[2];
    if (r < R) { bool isc; int b; const size_t off = row_off(r, isc, b); const bf16* xr = LAST ? vfin + (size_t)r * D : (isc ? vctx : vlat) + off;
#pragma unroll
        for (int j = 0; j < 2; ++j) vn[j] = *(const u32x4*)(xr + lane * 8 + 512 * j); }
    while (r < R) {
        bool isc; int b; const size_t off = row_off(r, isc, b);
        float v[16];
#pragma unroll
        for (int j = 0; j < 2; ++j)
#pragma unroll
            for (int i = 0; i < 4; ++i) { v[j * 8 + 2 * i] = bflo(vn[j][i]); v[j * 8 + 2 * i + 1] = bfhi(vn[j][i]); }
        int rn = r + NGW;
        if (SKIPCTX) { while (rn < R) { const int p = rn >= TP ? rn - TP : rn; if (p >= L) break; rn += NGW; } }
        if (rn < R) { bool isc2; int b2; const size_t off2 = row_off(rn, isc2, b2); const bf16* xr2 = LAST ? vfin + (size_t)rn * D : (isc2 ? vctx : vlat) + off2;
#pragma unroll
            for (int j = 0; j < 2; ++j) vn[j] = *(const u32x4*)(xr2 + lane * 8 + 512 * j); }
        float s = 0.f;
#pragma unroll
        for (int i = 0; i < 16; ++i) s += v[i];
        const float mean = wave_sum(s) * (1.f / D); float s2 = 0.f;
#pragma unroll
        for (int i = 0; i < 16; ++i) { v[i] -= mean; s2 += v[i] * v[i]; }
        const float rstd = 1.f / sqrtf(wave_sum(s2) * (1.f / D) + 1e-5f);
        const float* md = modn + (isc ? 2 : b) * 6144;
        if (!LAST && lane == 0) { rst[2 * r] = mean; rst[2 * r + 1] = rstd; }
#pragma unroll
        for (int j = 0; j < 2; ++j) {
            const int idx = lane * 8 + 512 * j;
            float y[8];
#pragma unroll
            for (int q = 0; q < 2; ++q) { const f32x4 gg = *(const f32x4*)(g + idx + 4 * q), bb = *(const f32x4*)(bt + idx + 4 * q);
#pragma unroll
                for (int i = 0; i < 4; ++i) y[q * 4 + i] = v[j * 8 + q * 4 + i] * rstd * gg[i] + bb[i]; }
            if (LAST) { *(f32x4*)(outp + off + idx) = (f32x4){y[0], y[1], y[2], y[3]}; *(f32x4*)(outp + off + idx + 4) = (f32x4){y[4], y[5], y[6], y[7]}; }
            else {
                float h[8];
#pragma unroll
                for (int q = 0; q < 2; ++q) { const f32x4 sh = *(const f32x4*)(md + idx + 4 * q), sc = *(const f32x4*)(md + 1024 + idx + 4 * q);
#pragma unroll
                    for (int i = 0; i < 4; ++i) h[q * 4 + i] = y[q * 4 + i] * (sc[i] + 1.f) + sh[i]; }
                u32x4 o; o.x = pk2(h[0], h[1]); o.y = pk2(h[2], h[3]); o.z = pk2(h[4], h[5]); o.w = pk2(h[6], h[7]);
                *(u32x4*)(H + (size_t)r * D + idx) = o;
            }
        }
        r = rn;
    }
}

__device__ __forceinline__ float log_sigmoid(float z) { return fminf(z, 0.f) - __logf(1.f + __expf(-fabsf(z))); }

constexpr int CS = 65;
constexpr float QSC = 0.125f * 1.4426950408889634f;
struct GatePre { u32x2 lr; f32x4 w; float bias; };
__device__ __forceinline__ GatePre gate_prefetch(int g, int h, const bf16* Pr, const float* gkw, const float* gkb, int tid) {
    GatePre p; p.lr = (u32x2){0u, 0u}; p.w = (f32x4){0.f, 0.f, 0.f, 0.f}; p.bias = 0.f;
    if (g) { const int c = tid >> 3, part = tid & 7;
        p.lr = *(const u32x2*)(Pr + (size_t)c * NPROJ + 3072 + part * 4);
        const int idx = tid * 4, dir = idx >> 10, r = (idx >> 6) & 15, d = idx & 63;
        p.w = *(const f32x4*)(gkw + (dir * 16 + r) * 256 + h * 64 + d);
        if (tid < 128) p.bias = gkb[(tid >> 6) * 256 + h * 64 + (tid & 63)]; }
    return p;
}
__device__ __forceinline__ void fill_cum3(float* cf, float* cb, float* lrs, float* wl, int g, int h, const GatePre& gp, const float* theta, int tid) {
    if (g == 0) {
        const float lgf = log1pf(-expf(theta[h])), lgb = log1pf(-expf(theta[4 + h]));
        for (int i = tid; i < 4096; i += 512) { const int c = i >> 6, d = i & 63; cf[c * CS + d] = (float)(c + 1) * lgf; cb[c * CS + d] = (float)(64 - c) * lgb; }
        __syncthreads();
        return;
    }
    { const int c = tid >> 3, part = tid & 7;
      float* lp = lrs + c * 33 + part * 4; lp[0] = bflo(gp.lr.x); lp[1] = bfhi(gp.lr.x); lp[2] = bflo(gp.lr.y); lp[3] = bfhi(gp.lr.y);
      *(f32x4*)(wl + tid * 4) = gp.w;
      if (tid < 128) wl[2048 + tid] = gp.bias; }
    __syncthreads();
    { const int c = tid >> 3, dg = tid & 7;
#pragma unroll
      for (int dir = 0; dir < 2; ++dir) {
          f32x4 za = *(const f32x4*)(wl + 2048 + dir * 64 + dg * 8), zb = *(const f32x4*)(wl + 2048 + dir * 64 + dg * 8 + 4);
#pragma unroll
          for (int r = 0; r < 16; ++r) { const float lv = lrs[c * 33 + dir * 16 + r];
              za += lv * *(const f32x4*)(wl + (dir * 16 + r) * 64 + dg * 8); zb += lv * *(const f32x4*)(wl + (dir * 16 + r) * 64 + dg * 8 + 4); }
          float* dst = (dir ? cb : cf) + c * CS + dg * 8;
#pragma unroll
          for (int j = 0; j < 4; ++j) { dst[j] = log_sigmoid(za[j]) * (1.f / 16.f); dst[4 + j] = log_sigmoid(zb[j]) * (1.f / 16.f); } } }
    __syncthreads();
    if (tid < 128) {
        const int dir = tid >> 6; float* arr = (dir ? cb : cf) + (tid & 63);
        float run = 0.f;
#pragma unroll
        for (int hh = 0; hh < 2; ++hh) {
            float v[32];
            const int base = dir ? (1 - hh) * 32 : hh * 32;
#pragma unroll
            for (int c = 0; c < 32; ++c) v[c] = arr[(base + c) * CS];
            if (dir == 0) {
#pragma unroll
                for (int c = 0; c < 32; ++c) { run += v[c]; arr[(base + c) * CS] = run; }
            } else {
#pragma unroll
                for (int c = 31; c >= 0; --c) { run += v[c]; arr[(base + c) * CS] = run; }
            }
        }
    }
    __syncthreads();
}

__device__ __forceinline__ void fast_bar(unsigned* ctr, unsigned& target) {
    asm volatile("s_waitcnt vmcnt(0)" ::: "memory");
    __syncthreads();
    target += gridDim.x;
    if (threadIdx.x == 0) {
        __builtin_amdgcn_fence(__ATOMIC_RELEASE, "agent");
        asm volatile("s_waitcnt vmcnt(0)" ::: "memory");
        __hip_atomic_fetch_add(ctr, 1u, __ATOMIC_RELAXED, __HIP_MEMORY_SCOPE_AGENT);
        while (__hip_atomic_load(ctr, __ATOMIC_RELAXED, __HIP_MEMORY_SCOPE_AGENT) < target) __builtin_amdgcn_s_sleep(1);
        __builtin_amdgcn_fence(__ATOMIC_ACQUIRE, "agent");
        asm volatile("s_waitcnt vmcnt(0)" ::: "memory");
    }
    __syncthreads();
}
#define RLX_AGENT __ATOMIC_RELAXED, __HIP_MEMORY_SCOPE_AGENT
#define XB_TMO      128
#define XB_XCNT(j)  (256  + 64 * (j))
#define XB_XSUB(j)  (1280 + 64 * (j))
#define XB_XGEN(j)  (2304 + 64 * (j))
#define XB_TOP      3328
#define XB_TOPGEN   3392
#define XCD_BAR_WORDS 3456
#define XB_SPIN_CAP (1u << 18)

__device__ __forceinline__ unsigned xb_ld(unsigned* p)              { return __hip_atomic_load(p, __ATOMIC_RELAXED, __HIP_MEMORY_SCOPE_AGENT); }
__device__ __forceinline__ unsigned xb_add(unsigned* p, unsigned v) { return __hip_atomic_fetch_add(p, v, __ATOMIC_RELAXED, __HIP_MEMORY_SCOPE_AGENT); }
__device__ __forceinline__ unsigned xb_xcc_id() { return (unsigned)__builtin_amdgcn_s_getreg((3 << 11) | 20) & 0xFu; }
#define XB_SPIN(cond, bar) do { unsigned _sp = 0; while (cond) { __builtin_amdgcn_s_sleep(1); \
    if ((++_sp & 255u) == 0u) { if (xb_ld(&(bar)[XB_TMO])) break; if (_sp > XB_SPIN_CAP) { atomicAdd(&(bar)[XB_TMO], 1u); break; } } } } while (0)

struct XcdBarrier {
    unsigned* bar; unsigned x;
    volatile unsigned* st;
};

__device__ __forceinline__ XcdBarrier xcd_barrier_post(unsigned* bar, volatile unsigned* st) {
    XcdBarrier b; b.bar = bar; b.x = xb_xcc_id(); b.st = st;
    if (threadIdx.x == 0) (void)xb_add(&bar[XB_XCNT(b.x)], 1u);
    return b;
}
__device__ __forceinline__ void xcd_barrier_complete(unsigned* bar, unsigned x, unsigned& nloc, unsigned& nx) {
    const unsigned G = gridDim.x * gridDim.y * gridDim.z;
    unsigned sum, cnt, mine, sp = 0u;
    for (;;) {
        sum = 0u; cnt = 0u; mine = 0u;
#pragma unroll
        for (unsigned j = 0; j < 16; ++j) { const unsigned c = xb_ld(&bar[XB_XCNT(j)]); sum += c; cnt += (c > 0u) ? 1u : 0u; mine = (j == x) ? c : mine; }
        if (sum == G) break;
        __builtin_amdgcn_s_sleep(1);
        if ((++sp & 255u) == 0u) { if (xb_ld(&bar[XB_TMO])) break; if (sp > XB_SPIN_CAP) { atomicAdd(&bar[XB_TMO], 1u); break; } }
    }
    nloc = mine > 0u ? mine : 1u; nx = cnt > 0u ? cnt : 1u;
}

__device__ __forceinline__ void xcd_barrier(const XcdBarrier& b) {
    asm volatile("s_waitcnt vmcnt(0)" ::: "memory");
    __syncthreads();
    if (threadIdx.x == 0) {
        unsigned* bar = b.bar;
        __builtin_amdgcn_s_waitcnt(0);
        unsigned nloc = b.st[0], nx = b.st[1];
        if (nloc == 0u) { xcd_barrier_complete(bar, b.x, nloc, nx); b.st[0] = nloc; b.st[1] = nx; }
        const unsigned old = xb_add(&bar[XB_XSUB(b.x)], 1u);
        const unsigned gen = old / nloc;
        if (old + 1u == (gen + 1u) * nloc) {
            __builtin_amdgcn_fence(__ATOMIC_RELEASE, "agent");
            asm volatile("s_waitcnt vmcnt(0)" ::: "memory");
            const unsigned og = xb_add(&bar[XB_TOP], 1u);
            const unsigned tg = og / nx;
            if (og + 1u == (tg + 1u) * nx) xb_add(&bar[XB_TOPGEN], 1u);
            else XB_SPIN(xb_ld(&bar[XB_TOPGEN]) == tg, bar);
            __builtin_amdgcn_fence(__ATOMIC_ACQUIRE, "agent");
            xb_add(&bar[XB_XGEN(b.x)], 1u);
            asm volatile("s_waitcnt vmcnt(0)" ::: "memory");
        } else {
            XB_SPIN(xb_ld(&bar[XB_XGEN(b.x)]) == gen, bar);
            __builtin_amdgcn_fence(__ATOMIC_ACQUIRE, "agent");
            asm volatile("s_waitcnt vmcnt(0)" ::: "memory");
        }
    }
    __syncthreads();
}

struct LatOrder {
    pg8::StaticOrder S;
    __device__ void init(int N, int G, int c) { S.init(NB * T, N, G, c); }
    __device__ bool next(int i, pg8::Unit& u) const { if (!S.next(i, u)) return false; u.pm = u.pm + 1 + (u.pm >= 32 ? 1 : 0); return true; }
    __device__ __forceinline__ void a_ready(const pg8::Unit&) const {}
    __device__ __forceinline__ void done(const pg8::Unit&) const {}
};
#ifndef PROBE_SEL
#define PROBE_SEL 0
#endif
#ifndef PROBE_MUL
#define PROBE_MUL 3
#endif
#define PACC_DECL unsigned long long pacc = 0, pacc_t0 = 0; (void)pacc; (void)pacc_t0;
#define PACC_BEGIN(k) if (PROBE_SEL == (k)) pacc_t0 = __builtin_amdgcn_s_memrealtime();
#define PACC_END(k) if (PROBE_SEL == (k)) pacc += __builtin_amdgcn_s_memrealtime() - pacc_t0;
#define PACC_SLEEP() if (PROBE_SEL >= 40 && PROBE_SEL < 60) { const unsigned long long t1 = __builtin_amdgcn_s_memrealtime(), dt = pacc * PROBE_MUL; while (__builtin_amdgcn_s_memrealtime() - t1 < dt) __builtin_amdgcn_s_sleep(8); }
#define PROBE_BEGIN(k) unsigned long long pt0_##k = 0; if (PROBE_SEL == (k)) pt0_##k = __builtin_amdgcn_s_memrealtime();
#define PROBE_END(k) if (PROBE_SEL == (k)) { const unsigned long long t1 = __builtin_amdgcn_s_memrealtime(), dt = (t1 - pt0_##k) * PROBE_MUL; while (__builtin_amdgcn_s_memrealtime() - t1 < dt) __builtin_amdgcn_s_sleep(8); }


template <int XT, int YT>
__device__ __forceinline__ void frag_gemm(pg8::f32x4 (&acc)[XT][YT], const bf16* X, int ldx, const bf16* Y, int ldy, int k0, int k1, int l15, int quad) {
#pragma unroll 4
    for (int k = k0; k < k1; k += 32) {
        bf16x8 xf[XT], yf[YT];
#pragma unroll
        for (int i = 0; i < XT; ++i) xf[i] = *(const bf16x8*)(X + (size_t)(i * 16 + l15) * ldx + k + quad * 8);
#pragma unroll
        for (int j = 0; j < YT; ++j) yf[j] = *(const bf16x8*)(Y + (size_t)(j * 16 + l15) * ldy + k + quad * 8);
#pragma unroll
        for (int i = 0; i < XT; ++i)
#pragma unroll
            for (int j = 0; j < YT; ++j) acc[i][j] = MFMA16(xf[i], yf[j], acc[i][j]);
    }
}
template <bool SRC_LN>
__device__ __forceinline__ void ctx_resid_tiles(const bf16* A, const bf16* Bt, int K, const void* src_ctx, bf16* dst_ctx, const float* gate_ctx, const float* rst, const float* lg, const float* lb, float* part, int bid, int G, int tid, int wave, int l15, int quad) {
    for (int t = bid; t < 256; t += G) {
        const int rt = t >> 5, c0 = (t & 31) * 32, b = rt >> 2, p0 = (rt & 3) * 64, r0 = b * TP + p0;
        pg8::f32x4 acc[4][2];
#pragma unroll
        for (int i = 0; i < 4; ++i)
#pragma unroll
            for (int j = 0; j < 2; ++j) acc[i][j] = (pg8::f32x4){0.f, 0.f, 0.f, 0.f};
        const int ksl = K >> 3;
        frag_gemm<4, 2>(acc, A + (size_t)r0 * K, K, Bt + (size_t)c0 * K, K, wave * ksl, (wave + 1) * ksl, l15, quad);
        float* pw = part + wave * 2048;
#pragma unroll
        for (int i = 0; i < 4; ++i)
#pragma unroll
            for (int j = 0; j < 2; ++j)
#pragma unroll
                for (int rg = 0; rg < 4; ++rg) pw[(i * 16 + quad * 4 + rg) * 32 + j * 16 + l15] = acc[i][j][rg];
        __syncthreads();
        { const int row = tid >> 3, c4 = (tid & 7) * 4;
          f32x4 sum = *(const f32x4*)(part + row * 32 + c4);
#pragma unroll
          for (int w = 1; w < 8; ++w) sum += *(const f32x4*)(part + w * 2048 + row * 32 + c4);
          const size_t off = (size_t)(b * L + p0 + row) * D + c0 + c4;
          f32x4 x4; const f32x4 g4 = *(const f32x4*)(gate_ctx + c0 + c4);
          if (!SRC_LN) x4 = *(const f32x4*)((const float*)src_ctx + off);
          else { const int rU = r0 + row; const u32x2 w = *(const u32x2*)((const bf16*)src_ctx + off); x4 = (f32x4){bflo(w.x), bfhi(w.x), bflo(w.y), bfhi(w.y)};
              x4 = (x4 - rst[2 * rU]) * rst[2 * rU + 1] * *(const f32x4*)(lg + c0 + c4) + *(const f32x4*)(lb + c0 + c4); }
          const f32x4 vv = x4 * ALPHA + g4 * sum; u32x2 o; o.x = pk2(vv.x, vv.y); o.y = pk2(vv.z, vv.w);
          *(u32x2*)(dst_ctx + off) = o; }
        __syncthreads();
    }
}
__device__ __forceinline__ void ctx_up_tiles(const bf16* A, const bf16* Bt, bf16* O, int bid, int G, int wave, int l15, int quad) {
    for (int t = bid; t < 256; t += G) {
        const int rt = t >> 5, c0 = (t & 31) * 128 + (wave & 3) * 32, b = rt >> 2, r0 = b * TP + (rt & 3) * 64 + (wave >> 2) * 32;
        pg8::f32x4 acc[2][2];
#pragma unroll
        for (int i = 0; i < 2; ++i)
#pragma unroll
            for (int j = 0; j < 2; ++j) acc[i][j] = (pg8::f32x4){0.f, 0.f, 0.f, 0.f};
        frag_gemm<2, 2>(acc, Bt + (size_t)c0 * D, D, A + (size_t)r0 * D, D, 0, D, l15, quad);
#pragma unroll
        for (int i = 0; i < 2; ++i)
#pragma unroll
            for (int j = 0; j < 2; ++j) { float v[4];
#pragma unroll
                for (int rg = 0; rg < 4; ++rg) { const float a_ = fmaxf(acc[i][j][rg], 0.f); v[rg] = a_ * a_; }
                u32x2 o; o.x = pk2(v[0], v[1]); o.y = pk2(v[2], v[3]);
                *(u32x2*)(O + (size_t)(r0 + j * 16 + l15) * FF + c0 + i * 16 + quad * 4) = o; }
    }
}

template <int ACT>
__device__ __forceinline__ void ctx_ksplit_tiles(const bf16* A, const bf16* Bt, bf16* O, int ldo, int ntn, int ncols, float* part, int bid, int G, int tid, int wave, int l15, int quad) {
    for (int t = bid; t < 8 * ntn; t += G) {
        const int rt = t / ntn, c0 = (t % ntn) * 64, b = rt >> 2, r0 = b * TP + (rt & 3) * 64;
        pg8::f32x4 acc[4][4];
#pragma unroll
        for (int i = 0; i < 4; ++i)
#pragma unroll
            for (int j = 0; j < 4; ++j) acc[i][j] = (pg8::f32x4){0.f, 0.f, 0.f, 0.f};
        frag_gemm<4, 4>(acc, A + (size_t)r0 * D, D, Bt + (size_t)c0 * D, D, wave * 128, (wave + 1) * 128, l15, quad);
        float* pw = part + wave * 4096;
#pragma unroll
        for (int i = 0; i < 4; ++i)
#pragma unroll
            for (int j = 0; j < 4; ++j)
#pragma unroll
                for (int rg = 0; rg < 4; ++rg) pw[(i * 16 + quad * 4 + rg) * 64 + j * 16 + l15] = acc[i][j][rg];
        __syncthreads();
        { const int row = tid >> 3, c8 = (tid & 7) * 8;
          f32x4 s0 = *(const f32x4*)(part + row * 64 + c8), s1 = *(const f32x4*)(part + row * 64 + c8 + 4);
#pragma unroll
          for (int w = 1; w < 8; ++w) { s0 += *(const f32x4*)(part + w * 4096 + row * 64 + c8); s1 += *(const f32x4*)(part + w * 4096 + row * 64 + c8 + 4); }
          if (ACT == 1) {
#pragma unroll
              for (int k = 0; k < 4; ++k) { float a_ = fmaxf(s0[k], 0.f), b_ = fmaxf(s1[k], 0.f); s0[k] = a_ * a_; s1[k] = b_ * b_; } }
          u32x4 o; o.x = pk2(s0.x, s0.y); o.y = pk2(s0.z, s0.w); o.z = pk2(s1.x, s1.y); o.w = pk2(s1.z, s1.w);
          const int col = c0 + c8;
          if (col < ncols) *(u32x4*)(O + (size_t)(r0 + row) * ldo + col) = o; }
        __syncthreads();
    }
}

struct Args { const float* in[19]; float* out; unsigned char* ws; };

__global__ void __launch_bounds__(512, 2) fwd_kernel(Args a) {
    extern __shared__ __attribute__((aligned(16))) unsigned char lds[];
    cg::grid_group grid = cg::this_grid();
    const int G = gridDim.x, bid = blockIdx.x, NGW = G * 8;
#define IDS int tid = threadIdx.x; asm volatile("" : "+v"(tid)); const int lane = tid & 63, wave = __builtin_amdgcn_readfirstlane(tid >> 6), quad = lane >> 4, l15 = lane & 15, gw = bid * 8 + wave; (void)quad; (void)l15; (void)gw; (void)lane;
#define xin (a.in[0])
#define cvec (a.in[1])
#define ctx (a.in[2])
#define cctx (a.in[3])
#define w_mod (a.in[4])
#define b_mod (a.in[5])
#define ln_g (a.in[6])
#define ln_b (a.in[7])
#define theta (a.in[11])
#define gkw (a.in[12])
#define gkb (a.in[13])
#define normg (a.in[14])
#define sink (a.in[17])
#define WIN_T ((bf16*)(a.ws + OFF_WIN))
#define WOUT0_T ((bf16*)(a.ws + OFF_WOUT0))
#define W1_0_T ((bf16*)(a.ws + OFF_W1_0))
#define W2_0_T ((bf16*)(a.ws + OFF_W2_0))
#define WQKV_T ((bf16*)(a.ws + OFF_WQKV))
#define WOUT1_T ((bf16*)(a.ws + OFF_WOUT1))
#define W1_1_T ((bf16*)(a.ws + OFF_W1_1))
#define W2_1_T ((bf16*)(a.ws + OFF_W2_1))
#define mod ((float*)(a.ws + OFF_MOD))
#define rope ((float*)(a.ws + OFF_ROPE))
#define xctx ((float*)(a.ws + OFF_XCTX))
#define DEC ((float*)(a.ws + OFF_DEC))
#define H ((bf16*)(a.ws + OFF_H))
#define P ((bf16*)(a.ws + OFF_P))
#define ST ((bf16*)(a.ws + OFF_ST))
#define xlat (a.out)
#define RST(i) ((float*)(a.ws + OFF_RST) + (size_t)(i) * R * 2)
#define VLAT ((bf16*)a.out)
#define VCTX ((bf16*)(a.ws + OFF_XCTX))

#define LATE_ITEMS 9472
#define LATE_CHUNK 16
#define DRAIN_LATE(scr_, maxc_) do { int nclaim_ = 0; unsigned* qc_ = (unsigned*)(a.ws + OFF_XBAR) + 3584; volatile unsigned* qw_ = (volatile unsigned*)(lds + 131072 + 1024); \
        for (;;) { if (nclaim_++ >= (maxc_)) break; if (tid == 0) qw_[0] = __hip_atomic_fetch_add(qc_, (unsigned)LATE_CHUNK, __ATOMIC_RELAXED, __HIP_MEMORY_SCOPE_AGENT);     \
            __syncthreads(); const int base_ = (int)__builtin_amdgcn_readfirstlane(qw_[0]); __syncthreads(); \
            if (base_ >= LATE_ITEMS) break; \
            for (int k_ = wave; k_ < LATE_CHUNK; k_ += 8) { int r_ = base_ + k_; if (r_ >= LATE_ITEMS) break; \
                if (r_ < 2048) { transpose_item(a.in[8], 1024, FF, W1_0_T, (scr_), r_, lane); continue; } r_ -= 2048; \
                if (r_ < 2048) { transpose_item(a.in[9], FF, 1024, W2_0_T, (scr_), r_, lane); continue; } r_ -= 2048; \
                if (r_ < 768) { transpose_item(a.in[16], 1024, NQKV, WQKV_T, (scr_), r_, lane); continue; } r_ -= 768; \
                if (r_ < 512) { transpose_item(a.in[18], 1024, 1024, WOUT1_T, (scr_), r_, lane); continue; } r_ -= 512; \
                if (r_ < 2048) { transpose_item(a.in[8] + (size_t)1024 * FF, 1024, FF, W1_1_T, (scr_), r_, lane); continue; } r_ -= 2048; \
                transpose_item(a.in[9] + (size_t)FF * 1024, FF, 1024, W2_1_T, (scr_), r_, lane); } } } while (0)
    PG8_LAS unsigned char* ldsg = (PG8_LAS unsigned char*)lds;
    unsigned* barw = (unsigned*)(a.ws + OFF_BAR); unsigned bar_target = 0u; (void)barw; (void)bar_target;
    unsigned* xbw = (unsigned*)(a.ws + OFF_XBAR);
    volatile unsigned* xst = (volatile unsigned*)(lds + 131072 + 512);
    if (threadIdx.x == 0) { xst[0] = 0u; xst[1] = 0u; }
    XcdBarrier xbar = xcd_barrier_post(xbw, xst);
    if (a.ws == nullptr) grid.sync();

PROBE_BEGIN(1)
    { IDS
        float* sl = (float*)lds; float* red = (float*)(lds + 12288);
        for (int item = bid; item < 192; item += G) {
            for (int i = tid; i < 3072; i += 512) { const int j = i >> 10, k = i & 1023; const float v = (j < 2) ? cvec[j * 1024 + k] : cctx[k]; sl[i] = v / (1.f + expf(-v)); }
            __syncthreads();
            const int layer = item / 96, n0 = (item % 96) * 64;
            const float* W = w_mod + (size_t)layer * 1024 * 6144 + n0 + lane;
            float a0 = 0.f, a1 = 0.f, a2 = 0.f; const int k0 = wave * 128;
#pragma unroll 8
            for (int kk = 0; kk < 128; ++kk) { const int k = k0 + kk; const float w = W[(size_t)k * 6144]; a0 += sl[k] * w; a1 += sl[1024 + k] * w; a2 += sl[2048 + k] * w; }
            red[(wave * 3 + 0) * 64 + lane] = a0; red[(wave * 3 + 1) * 64 + lane] = a1; red[(wave * 3 + 2) * 64 + lane] = a2;
            __syncthreads();
            if (tid < 192) { const int j = tid >> 6, col = tid & 63; float s = b_mod[layer * 6144 + n0 + col];
#pragma unroll
                for (int w = 0; w < 8; ++w) s += red[(w * 3 + j) * 64 + col];
                mod[(layer * 3 + j) * 6144 + n0 + col] = s; }
            __syncthreads();
        }
        if (bid == G - 1 && tid < 16) {
            double f = 1.0; for (int i = 0; i < tid; ++i) f *= 0.56234132519034908;
            const double x2 = f * f; double cs = 1.0, sn = f, tc = 1.0, ts = f;
            for (int n = 1; n <= 12; ++n) { tc *= -x2 / (double)((2 * n - 1) * (2 * n)); cs += tc; ts *= -x2 / (double)((2 * n) * (2 * n + 1)); sn += ts; }
            double c = 1.0, s = 0.0;
            for (int p = 0; p < 128; ++p) { rope[(p * 16 + tid) * 2] = (float)c; rope[(p * 16 + tid) * 2 + 1] = (float)s; const double nc = c * cs - s * sn; s = s * cs + c * sn; c = nc; }
        }
        float* scr = (float*)(lds + 32768 + wave * 8448);
        for (int it = gw; it < 2064; it += NGW) {
            int r = it;
            if (r < 1552) { transpose_item(a.in[10], 1024, NPROJ, WIN_T, scr, r, lane); continue; } r -= 1552;
            transpose_item(a.in[15], 1024, 1024, WOUT0_T, scr, r, lane);
        }
        { u32x4* z = (u32x4*)(WIN_T + (size_t)NPROJ * D); const u32x4 zero = {0u, 0u, 0u, 0u};
          for (int i = bid * 512 + tid; i < (NPROJ_PAD - NPROJ) * D / 8; i += G * 512) z[i] = zero; }
    }
PROBE_END(1)
    xcd_barrier(xbar);


PROBE_BEGIN(2)
    { IDS
    for (int r = gw; r < R; r += 2 * NGW) {
        const int r2 = r + NGW; const bool has2 = r2 < R;
        bool isc, isc2; int b, b2; const size_t off = row_off(r, isc, b), off2 = row_off(has2 ? r2 : r, isc2, b2);
        const float* xr = (isc ? ctx : xin) + off; const float* md = mod + (isc ? 2 : b) * 6144;
        const float* xr2 = (isc2 ? ctx : xin) + off2; const float* md2 = mod + (isc2 ? 2 : b2) * 6144;
        f32x4 va[4], vb[4];
#pragma unroll
        for (int j = 0; j < 4; ++j) { va[j] = *(const f32x4*)(xr + lane * 4 + 256 * j); vb[j] = *(const f32x4*)(xr2 + lane * 4 + 256 * j); }
#pragma unroll
        for (int j = 0; j < 4; ++j) {
            const int idx = lane * 4 + 256 * j;
            { const f32x4 sh = *(const f32x4*)(md + idx), sc = *(const f32x4*)(md + 1024 + idx);
              const f32x4 h = va[j] * (sc + 1.f) + sh; u32x2 o; o.x = pk2(h.x, h.y); o.y = pk2(h.z, h.w);
              *(u32x2*)(H + (size_t)r * D + idx) = o; }
            if (has2) { const f32x4 sh = *(const f32x4*)(md2 + idx), sc = *(const f32x4*)(md2 + 1024 + idx);
              const f32x4 h = vb[j] * (sc + 1.f) + sh; u32x2 o; o.x = pk2(h.x, h.y); o.y = pk2(h.z, h.w);
              *(u32x2*)(H + (size_t)r2 * D + idx) = o; }
        }
    }
    }
PROBE_END(2)
    xcd_barrier(xbar);
    if (PROBE_SEL == 10) { for (int i = 0; i < 10; ++i) xcd_barrier(xbar); }

PROBE_BEGIN(8)
    { pg8::Gemm g{H, WIN_T, R, NPROJ_PAD, D}; pg8::StaticOrder S; S.init(R, NPROJ_PAD, G, bid); EpiStore<0> E{P, NPROJ, NPROJ};
      pg8::gemm_phase<EpiStore<0>, pg8::StaticOrder, true, true>(ldsg, g, S, E); }
PROBE_END(8)
    xcd_barrier(xbar);

PROBE_BEGIN(3)
#ifndef NO_P3
    { IDS
        float* cf = (float*)lds; float* cb = (float*)(lds + 16640); float* lrs = (float*)(lds + 33280); float* wl = (float*)(lds + 41728);
        bf16* kTf = (bf16*)(lds + 50432); bf16* kTb = (bf16*)(lds + 59648); bf16* vT = (bf16*)(lds + 68864);
        constexpr int NU = NB * 2 * 4 * NCH;
        const int s = tid & 63, dc = tid >> 6;
        u32x4 kv = {0u, 0u, 0u, 0u}, vv0 = kv, vv1 = kv; GatePre gp; gp.lr = (u32x2){0u, 0u}; gp.w = (f32x4){0.f, 0.f, 0.f, 0.f}; gp.bias = 0.f;
#define P3_LOAD(U, GP_) do { const int pc_ = (U) % NCH, t_ = (U) / NCH, h_ = t_ & 3, g_ = 1 - (t_ >> 3), b_ = (t_ >> 2) & 1; const bf16* Pr_ = P + (size_t)(b_ * TP + pc_ * 64) * NPROJ; \
            const int kcol_ = g_ ? 1792 + h_ * 64 : 256 + h_ * 64, vcol_ = g_ ? 2048 + h_ * 128 : 512 + h_ * 128; \
            kv = *(const u32x4*)(Pr_ + (size_t)s * NPROJ + kcol_ + dc * 8); vv0 = *(const u32x4*)(Pr_ + (size_t)s * NPROJ + vcol_ + dc * 8); vv1 = *(const u32x4*)(Pr_ + (size_t)s * NPROJ + vcol_ + (dc + 8) * 8); \
            if (GP_) gp = gate_prefetch(g_, h_, Pr_, gkw, gkb, tid); } while (0)
#define P3_GATE(U) do { const int pc_ = (U) % NCH, t_ = (U) / NCH, h_ = t_ & 3, g_ = 1 - (t_ >> 3), b_ = (t_ >> 2) & 1; gp = gate_prefetch(g_, h_, P + (size_t)(b_ * TP + pc_ * 64) * NPROJ, gkw, gkb, tid); } while (0)
        float* lgs = (float*)(lds + 131072 + 2048);
        if (tid < 8) lgs[tid] = log1pf(-expf(theta[tid]));
        __syncthreads();
        if (bid < NU) P3_LOAD(bid, true);
        for (int unit = bid; unit < NU; unit += G) {
            const int pc = unit % NCH, t = unit / NCH, h = t & 3, g = 1 - (t >> 3), b = (t >> 2) & 1;
            const float kscale = g ? 1.f : 0.125f;
            float lgf = 0.f, lgb = 0.f;
            if (g) fill_cum3(cf, cb, lrs, wl, g, h, gp, theta, tid);
            else { lgf = lgs[h]; lgb = lgs[4 + h]; }
            if (unit + G < NU) P3_GATE(unit + G);
            {
              if (g) {
#pragma unroll
              for (int j = 0; j < 8; ++j) { const int d = dc * 8 + j; const unsigned u = kv[j >> 1]; const float kf = ((j & 1) ? bfhi(u) : bflo(u)) * kscale;
                  kTf[d * 72 + s] = (bf16)f2bf(kf * __expf(cf[63 * CS + d] - cf[s * CS + d]));
                  kTb[d * 72 + s] = (bf16)f2bf(kf * __expf(cb[d] - cb[s * CS + d])); }
              } else { const float ef = __expf((float)(63 - s) * lgf) * kscale, eb = __expf((float)s * lgb) * kscale;
#pragma unroll
              for (int j = 0; j < 8; ++j) { const int d = dc * 8 + j; const unsigned u = kv[j >> 1]; const float kf = (j & 1) ? bfhi(u) : bflo(u);
                  kTf[d * 72 + s] = (bf16)f2bf(kf * ef); kTb[d * 72 + s] = (bf16)f2bf(kf * eb); }
              }
#pragma unroll
              for (int j = 0; j < 8; ++j) { const unsigned u0 = vv0[j >> 1], u1 = vv1[j >> 1];
                  vT[(dc * 8 + j) * 72 + s] = (bf16)((j & 1) ? (u0 >> 16) : (u0 & 0xffffu)); vT[((dc + 8) * 8 + j) * 72 + s] = (bf16)((j & 1) ? (u1 >> 16) : (u1 & 0xffffu)); }
            }
            const int seq0 = ((b * 2 + g) * 4 + h) * 2;
            const int nf = pc, nbk = (pc < 4) ? 3 - pc : 135 - pc;
            if (tid < 128) { const int dir = tid >> 6, d = tid & 63;
                DEC[((size_t)(seq0 + dir) * NCH + (dir ? nbk : nf)) * 64 + d] = g ? (dir ? expf(cb[d]) : expf(cf[63 * CS + d])) : expf(64.f * (dir ? lgb : lgf)); }
            if (unit + G < NU) P3_LOAD(unit + G, false);
            __syncthreads();
            bf16x8 bfr[2];
#pragma unroll
            for (int ks = 0; ks < 2; ++ks) bfr[ks] = *(const bf16x8*)(vT + (wave * 16 + l15) * 72 + ks * 32 + quad * 8);
#pragma unroll
            for (int dir = 0; dir < 2; ++dir) {
                const bf16* kT = dir ? kTb : kTf;
                bf16* dst = ST + ((size_t)(seq0 + dir) * NCH + (dir ? nbk : nf)) * 8192 + (size_t)(wave * 16 + l15) * 64;
#pragma unroll
                for (int dt = 0; dt < 4; ++dt) {
                    pg8::f32x4 acc = {0.f, 0.f, 0.f, 0.f};
#pragma unroll
                    for (int ks = 0; ks < 2; ++ks) { const bf16x8 af = *(const bf16x8*)(kT + (dt * 16 + l15) * 72 + ks * 32 + quad * 8); acc = MFMA16(af, bfr[ks], acc); }
                    u32x2 o; o.x = pk2(acc[0], acc[1]); o.y = pk2(acc[2], acc[3]);
                    *(u32x2*)(dst + dt * 16 + quad * 4) = o;
                }
            }
            __syncthreads();
        }
#undef P3_LOAD
#undef P3_GATE
        if ((NU - bid + G - 1) / G < (NU + G - 1) / G) DRAIN_LATE((float*)(lds + wave * 8448), 1);
    }
#endif
PROBE_END(3)
    xcd_barrier(xbar);

PROBE_BEGIN(4)
    { IDS
    for (int i = bid * 512 + tid; i < 32 * 4096; i += G * 512) {
        const int seq = i >> 12, pi = i & 4095, d = (2 * pi) & 63;
        unsigned* sp = (unsigned*)(ST + (size_t)seq * NCH * 8192) + pi; const float* dp = DEC + (size_t)seq * NCH * 64 + d;
        float s0 = 0.f, s1 = 0.f;
#pragma unroll 12
        for (int n = 0; n < NCH; ++n) {
            const unsigned kv = sp[(size_t)n * 4096]; const float d0 = dp[n * 64], d1 = dp[n * 64 + 1];
            sp[(size_t)n * 4096] = pk2(s0, s1);
            s0 = d0 * s0 + bflo(kv); s1 = d1 * s1 + bfhi(kv);
        }
    }
    }
PROBE_END(4)
    xcd_barrier(xbar);

PROBE_BEGIN(5)
#ifndef NO_P5
    { IDS
        float* cf = (float*)lds; float* cb = (float*)(lds + 16640); float* lrs = (float*)(lds + 33280); float* wl = (float*)(lds + 41728);
        bf16* qdf = (bf16*)(lds + 50432); bf16* kif = (bf16*)(lds + 59648); bf16* qdb = (bf16*)(lds + 68864); bf16* kib = (bf16*)(lds + 78080);
        bf16* vT = (bf16*)(lds + 87296); bf16* Am = (bf16*)(lds + 105728); float* red = (float*)(lds + 114944);
        constexpr int NU = NB * 2 * 4 * NCH;
        const int dcq = tid & 7, sq = tid >> 3, sv = tid & 63, dcv = tid >> 6;
        u32x4 qv = {0u, 0u, 0u, 0u}, kv = qv, vv0 = qv, vv1 = qv; GatePre gp; gp.lr = (u32x2){0u, 0u}; gp.w = (f32x4){0.f, 0.f, 0.f, 0.f}; gp.bias = 0.f;
#define P5_LOAD(U) do { const int pc_ = (U) % NCH, t_ = (U) / NCH, h_ = t_ & 3, g_ = 1 - (t_ >> 3), b_ = (t_ >> 2) & 1; const bf16* Pr_ = P + (size_t)(b_ * TP + pc_ * 64) * NPROJ; \
            const int qcol_ = g_ ? 1536 + h_ * 64 : h_ * 64, kcol_ = g_ ? 1792 + h_ * 64 : 256 + h_ * 64, vcol_ = g_ ? 2048 + h_ * 128 : 512 + h_ * 128; \
            qv = *(const u32x4*)(Pr_ + (size_t)sq * NPROJ + qcol_ + dcq * 8); kv = *(const u32x4*)(Pr_ + (size_t)sq * NPROJ + kcol_ + dcq * 8); \
            vv0 = *(const u32x4*)(Pr_ + (size_t)sv * NPROJ + vcol_ + dcv * 8); vv1 = *(const u32x4*)(Pr_ + (size_t)sv * NPROJ + vcol_ + (dcv + 8) * 8); \
            gp = gate_prefetch(g_, h_, Pr_, gkw, gkb, tid); } while (0)
        f32x4 ngv[4];
#pragma unroll
        for (int et = 0; et < 4; ++et) ngv[et] = *(const f32x4*)(normg + ((wave >> 2) * 4 + et) * 16 + quad * 4);
        float* lgs = (float*)(lds + 131072 + 2048);
        if (tid < 8) lgs[tid] = log1pf(-expf(theta[tid]));
        __syncthreads();
        if (bid < NU) P5_LOAD(bid);
        for (int unit = bid; unit < NU; unit += G) {
            const int pc = unit % NCH, t = unit / NCH, h = t & 3, g = 1 - (t >> 3), b = (t >> 2) & 1;
            const int r0 = b * TP + pc * 64;
            const int gcol = g ? 2560 + h * 128 : 1024 + h * 128;
            const float qscale = g ? 0.125f : 1.f, kscale = g ? 1.f : 0.125f;
            const int ct = wave & 3, eh = wave >> 2;
            const int seq0 = ((b * 2 + g) * 4 + h) * 2;
            const int nf = pc, nbk = (pc < 4) ? 3 - pc : 135 - pc;
            const bf16* Sf = ST + ((size_t)seq0 * NCH + nf) * 8192; const bf16* Sb = ST + ((size_t)(seq0 + 1) * NCH + nbk) * 8192;
            const int r = r0 + ct * 16 + l15;
            bf16x8 a2[4][2], a3[4][2]; u32x2 gv[4];
#pragma unroll
            for (int et = 0; et < 4; ++et) { const int e = (eh * 4 + et) * 16 + l15;
#pragma unroll
                for (int ks = 0; ks < 2; ++ks) { a2[et][ks] = *(const bf16x8*)(Sf + e * 64 + ks * 32 + quad * 8); a3[et][ks] = *(const bf16x8*)(Sb + e * 64 + ks * 32 + quad * 8); }
                gv[et] = *(const u32x2*)(P + (size_t)r * NPROJ + gcol + (eh * 4 + et) * 16 + quad * 4); }
            if (g) fill_cum3(cf, cb, lrs, wl, g, h, gp, theta, tid);
            { u32x4 o1, o2, o3, o4;
              if (g) {
#pragma unroll
              for (int j2 = 0; j2 < 4; ++j2) {
                  const int d = dcq * 8 + 2 * j2;
                  const float f0 = cf[sq * CS + d], f1 = cf[sq * CS + d + 1], b0 = cb[sq * CS + d], b1 = cb[sq * CS + d + 1];
                  const float q0 = bflo(qv[j2]) * qscale, q1 = bfhi(qv[j2]) * qscale, k0 = bflo(kv[j2]) * kscale, k1 = bfhi(kv[j2]) * kscale;
                  o1[j2] = pk2(q0 * __expf(f0), q1 * __expf(f1)); o2[j2] = pk2(k0 * __expf(-f0), k1 * __expf(-f1));
                  o3[j2] = pk2(q0 * __expf(b0), q1 * __expf(b1)); o4[j2] = pk2(k0 * __expf(-b0), k1 * __expf(-b1));
              }
              } else {
                  const float lgf = lgs[h], lgb = lgs[4 + h];
                  const float cfr = (float)(sq + 1) * lgf, cbr = (float)(64 - sq) * lgb;
                  const float ef = __expf(cfr) * qscale, eif = __expf(-cfr) * kscale, eb = __expf(cbr) * qscale, eib = __expf(-cbr) * kscale;
#pragma unroll
                  for (int j2 = 0; j2 < 4; ++j2) { const float q0 = bflo(qv[j2]), q1 = bfhi(qv[j2]), k0 = bflo(kv[j2]), k1 = bfhi(kv[j2]);
                      o1[j2] = pk2(q0 * ef, q1 * ef); o2[j2] = pk2(k0 * eif, k1 * eif); o3[j2] = pk2(q0 * eb, q1 * eb); o4[j2] = pk2(k0 * eib, k1 * eib); }
              }
              *(u32x4*)(qdf + sq * 72 + dcq * 8) = o1; *(u32x4*)(kif + sq * 72 + dcq * 8) = o2; *(u32x4*)(qdb + sq * 72 + dcq * 8) = o3; *(u32x4*)(kib + sq * 72 + dcq * 8) = o4;
#pragma unroll
              for (int j = 0; j < 8; ++j) { const unsigned u0 = vv0[j >> 1], u1 = vv1[j >> 1];
                  vT[(dcv * 8 + j) * 72 + sv] = (bf16)((j & 1) ? (u0 >> 16) : (u0 & 0xffffu)); vT[((dcv + 8) * 8 + j) * 72 + sv] = (bf16)((j & 1) ? (u1 >> 16) : (u1 & 0xffffu)); }
            }
            __syncthreads();
            { bf16x8 af[2], ab[2];
#pragma unroll
              for (int ks = 0; ks < 2; ++ks) { af[ks] = *(const bf16x8*)(qdf + (ct * 16 + l15) * 72 + ks * 32 + quad * 8); ab[ks] = *(const bf16x8*)(qdb + (ct * 16 + l15) * 72 + ks * 32 + quad * 8); }
#pragma unroll
              for (int i = 0; i < 2; ++i) { const int st = (wave >> 2) * 2 + i;
                  pg8::f32x4 accf = {0.f, 0.f, 0.f, 0.f}, accb = {0.f, 0.f, 0.f, 0.f};
#pragma unroll
                  for (int ks = 0; ks < 2; ++ks) {
                      const bf16x8 bf_ = *(const bf16x8*)(kif + (st * 16 + l15) * 72 + ks * 32 + quad * 8), bb_ = *(const bf16x8*)(kib + (st * 16 + l15) * 72 + ks * 32 + quad * 8);
                      accf = MFMA16(af[ks], bf_, accf); accb = MFMA16(ab[ks], bb_, accb); }
                  const int scol = st * 16 + l15;
#pragma unroll
                  for (int rg = 0; rg < 4; ++rg) { const int c = ct * 16 + quad * 4 + rg; Am[c * 72 + scol] = (bf16)f2bf(scol <= c ? accf[rg] : accb[rg]); }
              }
            }
            if (unit + G < NU) P5_LOAD(unit + G);
            __syncthreads();
            { bf16x8 bA[2], bQf[2], bQb[2];
#pragma unroll
              for (int ks = 0; ks < 2; ++ks) { const int o = (ct * 16 + l15) * 72 + ks * 32 + quad * 8; bA[ks] = *(const bf16x8*)(Am + o); bQf[ks] = *(const bf16x8*)(qdf + o); bQb[ks] = *(const bf16x8*)(qdb + o); }
              pg8::f32x4 acc[4]; float ss = 0.f;
#pragma unroll
              for (int et = 0; et < 4; ++et) { const int e = (eh * 4 + et) * 16 + l15;
                  pg8::f32x4 c4 = {0.f, 0.f, 0.f, 0.f};
#pragma unroll
                  for (int ks = 0; ks < 2; ++ks) {
                      const bf16x8 a1 = *(const bf16x8*)(vT + e * 72 + ks * 32 + quad * 8);
                      c4 = MFMA16(a1, bA[ks], c4); c4 = MFMA16(a2[et][ks], bQf[ks], c4); c4 = MFMA16(a3[et][ks], bQb[ks], c4); }
                  acc[et] = c4; ss += (c4[0] * c4[0] + c4[1] * c4[1]) + (c4[2] * c4[2] + c4[3] * c4[3]); }
              ss = quad_sum(ss);
              if (quad == 0) red[eh * 64 + ct * 16 + l15] = ss;
              __syncthreads();
              const float tot = red[ct * 16 + l15] + red[64 + ct * 16 + l15];
              const float rinv = 1.f / sqrtf(tot * (1.f / 128.f) + 1e-6f);
#pragma unroll
              for (int et = 0; et < 4; ++et) { const int e0 = (eh * 4 + et) * 16 + quad * 4;
                  float gt[4] = {bflo(gv[et].x), bfhi(gv[et].x), bflo(gv[et].y), bfhi(gv[et].y)}; float y[4];
#pragma unroll
                  for (int i = 0; i < 4; ++i) { const float ng = g ? ngv[et][i] : 1.f; const float sg = gt[i] * __builtin_amdgcn_rcpf(1.f + __expf(-gt[i])); y[i] = sg * acc[et][i] * rinv * ng; }
                  u32x2 o; o.x = pk2(y[0], y[1]); o.y = pk2(y[2], y[3]);
                  *(u32x2*)(H + (size_t)r * D + g * 512 + h * 128 + e0) = o; }
            }
            __syncthreads();
        }
#undef P5_LOAD
        if ((NU - bid + G - 1) / G < (NU + G - 1) / G) DRAIN_LATE((float*)(lds + wave * 8448), 2);
    }
#endif
PROBE_END(5)
    xcd_barrier(xbar);

PROBE_BEGIN(12)
    { pg8::Gemm g{H, WOUT0_T, R, D, D}; LatOrder S; S.init(D, G, bid); EpiResid<0, false> E{xin, ctx, VLAT, VCTX, nullptr, mod + 2 * 1024, nullptr, nullptr, nullptr};
      pg8::gemm_phase<EpiResid<0, false>, LatOrder, true, true>(ldsg, g, S, E); }
    { IDS
      ctx_resid_tiles<false>(H, WOUT0_T, D, ctx, VCTX, mod + 2 * 6144 + 2 * 1024, nullptr, nullptr, nullptr, (float*)lds, bid, G, tid, wave, l15, quad); }
PROBE_END(12)
    xcd_barrier(xbar);
PROBE_BEGIN(7)
    { IDS
    DRAIN_LATE((float*)(lds + wave * 8448), 1 << 30);
    ln_phase<false, false>(RST(0), VLAT, VCTX, nullptr, nullptr, ln_g, ln_b, mod + 3 * 1024, H, gw, NGW, lane);
    }
PROBE_END(7)
    xcd_barrier(xbar);
PROBE_BEGIN(11)
    { pg8::Gemm g{H, W1_0_T, R, FF, D}; LatOrder S; S.init(FF, G, bid); EpiStore<1> E{P, FF, FF};
      pg8::gemm_phase<EpiStore<1>, LatOrder, true, true>(ldsg, g, S, E); }
    { IDS
      ctx_ksplit_tiles<1>(H, W1_0_T, P, FF, 64, FF, (float*)lds, bid, G, tid, wave, l15, quad); }
PROBE_END(11)
    xcd_barrier(xbar);
PROBE_BEGIN(9)
    { pg8::Gemm g{P, W2_0_T, R, D, FF}; LatOrder S; S.init(D, G, bid); EpiResid<1, false> E{VLAT, VCTX, VLAT, VCTX, nullptr, mod + 5 * 1024, RST(0), ln_g, ln_b};
      pg8::gemm_phase<EpiResid<1, false>, LatOrder, true, true>(ldsg, g, S, E); }
    { IDS
      ctx_resid_tiles<true>(P, W2_0_T, FF, VCTX, VCTX, mod + 2 * 6144 + 5 * 1024, RST(0), ln_g, ln_b, (float*)lds, bid, G, tid, wave, l15, quad); }
PROBE_END(9)
    xcd_barrier(xbar);
    { IDS
    ln_phase<false, false>(RST(1), VLAT, VCTX, nullptr, nullptr, ln_g + 1024, ln_b + 1024, mod + 3 * 6144, H, gw, NGW, lane);
    }
    xcd_barrier(xbar);

PROBE_BEGIN(13)
    { pg8::Gemm g{H, WQKV_T, R, NQKV, D}; pg8::StaticOrder S; S.init(R, NQKV, G, bid); EpiStore<0> E{P, NQKV, NQKV};
      pg8::gemm_phase<EpiStore<0>, pg8::StaticOrder, true, true>(ldsg, g, S, E); }
PROBE_END(13)
    xcd_barrier(xbar);

PROBE_BEGIN(6)
#ifndef NO_P12
    { IDS
        bf16* Qs = (bf16*)lds; bf16* Ks = (bf16*)(lds + 73728); bf16* Vt = (bf16*)(lds + 82944); float* ropes = (float*)(lds + 92160);
        for (int i = tid; i < 1024; i += 512) ((f32x4*)ropes)[i] = ((const f32x4*)rope)[i];
        PACC_DECL
        for (int unit = bid; unit < NB * 4 * 64; unit += G) {
            PACC_BEGIN(40)
            const int nb = unit & 63, kvh = (unit >> 6) & 3, b = unit >> 8;
#define ATT_VALID(t) ((t) < 4 || (unsigned)(nb - 1 + (((t) - 4) >> 1)) < 64u)
#define ATT_KPOS(t) ((nb - 1 + (((t) - 4) >> 1)) * 128 + (((t) - 4) & 1) * 64)
#define ATT_KROW(t) ((t) < 4 ? b * TP + (t) * 64 : b * TP + L + ATT_KPOS(t))
            const int keyk = tid >> 2, pck = tid & 3, c1k = (pck & 1) + (pck >> 1) * 4, keyv = tid & 63, dcv = tid >> 6;
            u32x4 pk1 = {0u, 0u, 0u, 0u}, pk2_ = pk1, pvv = pk1;
#define ATT_LOAD(t) do { const int kr_ = ATT_KROW(t); \
                if (tid < 256) { const bf16* src_ = P + (size_t)(kr_ + keyk) * NQKV + 1024 + kvh * 64; pk1 = *(const u32x4*)(src_ + c1k * 8); pk2_ = *(const u32x4*)(src_ + (c1k + 2) * 8); } \
                pvv = *(const u32x4*)(P + (size_t)(kr_ + keyv) * NQKV + 1280 + kvh * 64 + dcv * 8); } while (0)
            ATT_LOAD(0);
            __syncthreads();
#pragma unroll
            for (int i = 0; i < 4; ++i) {
                const int it = tid + i * 512, pcq = it & 3, row = it >> 2, g = row >> 7, qi = row & 127, pos = nb * 128 + qi;
                const bf16* src = P + (size_t)(b * TP + L + pos) * NQKV + (kvh * 4 + g) * 64;
                const int c1 = (pcq & 1) + (pcq >> 1) * 4;
                const u32x4 u1 = *(const u32x4*)(src + c1 * 8), u2 = *(const u32x4*)(src + (c1 + 2) * 8);
                const int pv = (pcq < 2) ? (pos >> 6) : (pos & 63);
                const f32x4* tab = (const f32x4*)(ropes + (pv * 16 + (c1 & 1) * 8) * 2);
                u32x4 o1, o2;
#pragma unroll
                for (int j2 = 0; j2 < 4; ++j2) { const f32x4 cs = tab[j2];
                    const float a0 = bflo(u1[j2]), a1 = bfhi(u1[j2]), b0 = bflo(u2[j2]), b1 = bfhi(u2[j2]);
                    o1[j2] = pk2((a0 * cs.x - b0 * cs.y) * QSC, (a1 * cs.z - b1 * cs.w) * QSC); o2[j2] = pk2((a0 * cs.y + b0 * cs.x) * QSC, (a1 * cs.w + b1 * cs.z) * QSC); }
                *(u32x4*)(Qs + row * 72 + c1 * 8) = o1; *(u32x4*)(Qs + row * 72 + (c1 + 2) * 8) = o2;
            }
            const int g = wave & 3, qh = wave >> 2, qrow0 = g * 128 + qh * 64, qpos0 = nb * 128 + qh * 64;
            float mrun[4], lrun[4]; pg8::f32x4 O[4][4];
            const float sk = sink[kvh * 4 + g] * 1.4426950408889634f;
#pragma unroll
            for (int qt = 0; qt < 4; ++qt) { mrun[qt] = sk; lrun[qt] = (quad == 0) ? 1.f : 0.f;
#pragma unroll
                for (int dt = 0; dt < 4; ++dt) O[dt][qt] = (pg8::f32x4){0.f, 0.f, 0.f, 0.f}; }
            PACC_END(40)
            int ti = 0;
            while (ti < 10) {
                PACC_BEGIN(41)
                const bool local = ti >= 4;
                const int kpos0 = local ? ATT_KPOS(ti) : 0;
                const int side = local ? ((ti - 4) >> 1) - 1 : 0;
                __syncthreads();
                if (tid < 256) {
                    u32x4 o1 = pk1, o2 = pk2_;
                    if (local) {
                        const int pos = kpos0 + keyk, pv = (pck < 2) ? (pos >> 6) : (pos & 63);
                        const f32x4* tab = (const f32x4*)(ropes + (pv * 16 + (c1k & 1) * 8) * 2);
#pragma unroll
                        for (int j2 = 0; j2 < 4; ++j2) { const f32x4 cs = tab[j2];
                            const float a0 = bflo(pk1[j2]), a1 = bfhi(pk1[j2]), b0 = bflo(pk2_[j2]), b1 = bfhi(pk2_[j2]);
                            o1[j2] = pk2(a0 * cs.x - b0 * cs.y, a1 * cs.z - b1 * cs.w); o2[j2] = pk2(a0 * cs.y + b0 * cs.x, a1 * cs.w + b1 * cs.z); }
                    }
                    *(u32x4*)(Ks + keyk * 72 + c1k * 8) = o1; *(u32x4*)(Ks + keyk * 72 + (c1k + 2) * 8) = o2;
                }
#pragma unroll
                for (int j = 0; j < 8; ++j) { const unsigned u = pvv[j >> 1]; Vt[(dcv * 8 + j) * 72 + keyv] = (bf16)((j & 1) ? (u >> 16) : (u & 0xffffu)); }
                __syncthreads();
                PACC_END(41)
                PACC_BEGIN(42)
                int tn = ti + 1;
                while (tn < 10 && !ATT_VALID(tn)) ++tn;
                if (tn < 10) ATT_LOAD(tn);
                if (!((side < 0 && ((ti - 4) & 1) == 0 && qh == 1) || (side > 0 && ((ti - 4) & 1) == 1 && qh == 0))) {
                bf16x8 kfr[4][2];
#pragma unroll
                for (int kt = 0; kt < 4; ++kt)
#pragma unroll
                    for (int ks = 0; ks < 2; ++ks) kfr[kt][ks] = *(const bf16x8*)(Ks + (kt * 16 + l15) * 72 + ks * 32 + quad * 8);
#pragma unroll
                for (int qt = 0; qt < 4; ++qt) {
                    pg8::f32x4 S[4];
#pragma unroll
                    for (int kt = 0; kt < 4; ++kt) S[kt] = (pg8::f32x4){0.f, 0.f, 0.f, 0.f};
#pragma unroll
                    for (int ks = 0; ks < 2; ++ks) { const bf16x8 qf = *(const bf16x8*)(Qs + (qrow0 + qt * 16 + l15) * 72 + ks * 32 + quad * 8);
#pragma unroll
                        for (int kt = 0; kt < 4; ++kt) S[kt] = MFMA16(kfr[kt][ks], qf, S[kt]); }
                    float mx = -INFINITY;
                    if (side < 0 && ((ti - 4) & 1) == qh) {
                        const int tl = quad * 4 - (qpos0 + qt * 16 + l15 - kpos0 - 128);
#pragma unroll
                        for (int kt = 0; kt < 4; ++kt)
#pragma unroll
                            for (int rg = 0; rg < 4; ++rg) { const float sv_ = (tl >= -(kt * 16 + rg)) ? S[kt][rg] : -INFINITY; S[kt][rg] = sv_; mx = fmaxf(mx, sv_); }
                    } else if (side > 0 && ((ti - 4) & 1) == qh) {
                        const int th = (qpos0 + qt * 16 + l15 - kpos0 + 128) - quad * 4;
#pragma unroll
                        for (int kt = 0; kt < 4; ++kt)
#pragma unroll
                            for (int rg = 0; rg < 4; ++rg) { const float sv_ = (th >= (kt * 16 + rg)) ? S[kt][rg] : -INFINITY; S[kt][rg] = sv_; mx = fmaxf(mx, sv_); }
                    } else {
#pragma unroll
                        for (int kt = 0; kt < 4; ++kt)
#pragma unroll
                            for (int rg = 0; rg < 4; ++rg) mx = fmaxf(mx, S[kt][rg]);
                    }
                    mx = quad_max(mx);
                    const float mnew = fmaxf(mrun[qt], mx), al = __builtin_amdgcn_exp2f(mrun[qt] - mnew); mrun[qt] = mnew;
                    float ps = 0.f;
#pragma unroll
                    for (int kt = 0; kt < 4; ++kt)
#pragma unroll
                        for (int rg = 0; rg < 4; ++rg) { const float p = __builtin_amdgcn_exp2f(S[kt][rg] - mnew); S[kt][rg] = p; ps += p; }
                    lrun[qt] = lrun[qt] * al + ps;
#pragma unroll
                    for (int dt = 0; dt < 4; ++dt) O[dt][qt] = O[dt][qt] * al;
#pragma unroll
                    for (int s2 = 0; s2 < 2; ++s2) {
                        u32x4 pw; pw.x = pk2(S[2 * s2][0], S[2 * s2][1]); pw.y = pk2(S[2 * s2][2], S[2 * s2][3]);
                        pw.z = pk2(S[2 * s2 + 1][0], S[2 * s2 + 1][1]); pw.w = pk2(S[2 * s2 + 1][2], S[2 * s2 + 1][3]);
                        const bf16x8 pf = __builtin_bit_cast(bf16x8, pw);
#pragma unroll
                        for (int dt = 0; dt < 4; ++dt) {
                            const s16x4 lo = *(const s16x4*)(Vt + (dt * 16 + l15) * 72 + s2 * 32 + quad * 4), hi = *(const s16x4*)(Vt + (dt * 16 + l15) * 72 + s2 * 32 + 16 + quad * 4);
                            O[dt][qt] = MFMA16(__builtin_shufflevector(lo, hi, 0, 1, 2, 3, 4, 5, 6, 7), pf, O[dt][qt]); }
                    }
                }
                }
                ti = tn;
                PACC_END(42)
            }
            PACC_BEGIN(43)
#pragma unroll
            for (int qt = 0; qt < 4; ++qt) {
                const float lt = quad_sum(lrun[qt]);
                const float inv = 1.f / lt;
                const int r = b * TP + L + qpos0 + qt * 16 + l15;
#pragma unroll
                for (int dt = 0; dt < 4; ++dt) { u32x2 o; o.x = pk2(O[dt][qt][0] * inv, O[dt][qt][1] * inv); o.y = pk2(O[dt][qt][2] * inv, O[dt][qt][3] * inv);
                    *(u32x2*)(H + (size_t)r * D + (kvh * 4 + g) * 64 + dt * 16 + quad * 4) = o; }
            }
            PACC_END(43)
#undef ATT_VALID
#undef ATT_KPOS
#undef ATT_KROW
#undef ATT_LOAD
        }
        PACC_SLEEP()
    }
#endif
PROBE_END(6)
    xcd_barrier(xbar);

PROBE_BEGIN(14)
    { pg8::Gemm g{H, WOUT1_T, R, D, D}; LatOrder S; S.init(D, G, bid); EpiResid<1, false> E{VLAT, VCTX, VLAT, VCTX, nullptr, mod + 3 * 6144 + 2 * 1024, RST(1), ln_g + 1024, ln_b + 1024};
      pg8::gemm_phase<EpiResid<1, false>, LatOrder, true, true>(ldsg, g, S, E); }
PROBE_END(14)
    xcd_barrier(xbar);
    { IDS
    ln_phase<false, true>(RST(2), VLAT, VCTX, nullptr, nullptr, ln_g + 2048, ln_b + 2048, mod + 3 * 6144 + 3 * 1024, H, gw, NGW, lane);
    }
    xcd_barrier(xbar);
PROBE_BEGIN(15)
    { pg8::Gemm g{H, W1_1_T, R, FF, D}; LatOrder S; S.init(FF, G, bid); EpiStore<1> E{P, FF, FF};
      pg8::gemm_phase<EpiStore<1>, LatOrder, true, true>(ldsg, g, S, E); }
PROBE_END(15)
    xcd_barrier(xbar);
PROBE_BEGIN(16)
    { pg8::Gemm g{P, W2_1_T, R, D, FF}; LatOrder S; S.init(D, G, bid); EpiResid<1, true> E{VLAT, VCTX, nullptr, nullptr, H, mod + 3 * 6144 + 5 * 1024, RST(2), ln_g + 2048, ln_b + 2048};
      pg8::gemm_phase<EpiResid<1, true>, LatOrder, true, true>(ldsg, g, S, E); }
PROBE_END(16)
    xcd_barrier(xbar);
    { IDS
    ln_phase<true, true>(nullptr, nullptr, nullptr, H, a.out, ln_g + 3072, ln_b + 3072, mod, H, gw, NGW, lane);
    }
}

extern "C" void kernel_launch(void* const* d_in, const int* in_sizes, int n_in, void* d_out, int out_size, void* d_ws, size_t ws_size, hipStream_t stream) {
    static int grid = 0;
    if (grid == 0) {
        if (n_in != 19 || out_size != NB * T * D || ws_size < WS_TOTAL) { fprintf(stderr, "kernel_launch: unexpected shapes (n_in %d out %d ws %zu)\n", n_in, out_size, ws_size); grid = -1; return; }
        int dev = 0, cus = 0, per_cu = 0;
        hipGetDevice(&dev); hipDeviceGetAttribute(&cus, hipDeviceAttributeMultiprocessorCount, dev);
        if (hipFuncSetAttribute((const void*)fwd_kernel, hipFuncAttributeMaxDynamicSharedMemorySize, LDS_BYTES) != hipSuccess) { fprintf(stderr, "kernel_launch: hipFuncSetAttribute failed\n"); grid = -1; return; }
        if (hipOccupancyMaxActiveBlocksPerMultiprocessor(&per_cu, (const void*)fwd_kernel, 512, LDS_BYTES) != hipSuccess || per_cu < 1) per_cu = 1;
        (void)hipGetLastError();
        grid = cus > 0 ? cus : 256;
    }
    if (grid < 0) return;
    Args a{};
    for (int i = 0; i < 19; ++i) a.in[i] = (const float*)d_in[i];
    a.out = (float*)d_out; a.ws = (unsigned char*)d_ws;
    if (hipMemsetAsync((char*)d_ws + OFF_XBAR, 0, 16384, stream) != hipSuccess) { fprintf(stderr, "kernel_launch: hipMemsetAsync of the barrier words failed\n"); return; }
    void* args[] = {&a};
    hipError_t e = hipLaunchCooperativeKernel((const void*)fwd_kernel, dim3(grid), dim3(512), args, LDS_BYTES, stream);
    if (e != hipSuccess) fprintf(stderr, "cooperative launch failed: %s (grid %d)\n", hipGetErrorString(e), grid);
}
```
